# Optimizing an MI355X kernel written in HIP

```python
import jax, jax.numpy as jnp
from jax import lax
import numpy as np

D_MODEL = 1024
BATCH = 8
SEQ = 2048
DEPTH = 1
DEC_BATCH = 128
DEC_SEQ = 4
PAST_LEN = 16384
PAGE_SIZE = 128

N_META = 16
C_CONV = D_MODEL
K_CONV = 31
N_HEADS = 8
D_HEAD = 128
D_QK = N_HEADS * D_HEAD
D_QKV = 3 * D_QK
K_SHORT = 4
CHUNK = 64
D_FF = 4 * D_MODEL
EPS = 1e-6
D_IN = 2 * C_CONV + D_QKV + D_QK + 2 * N_HEADS + 2 * D_MODEL

kernel_name = "conformer_gdn_parallel_hybrid_step"


def rms_norm(x, g):
    xf = x.astype(jnp.float32)
    y = xf * lax.rsqrt(jnp.mean(xf * xf, axis=-1, keepdims=True) + EPS)
    return (y * g.astype(jnp.float32)).astype(x.dtype)


def layer_norm(x, g, b):
    xf = x.astype(jnp.float32)
    mu = jnp.mean(xf, axis=-1, keepdims=True)
    var = jnp.mean(jnp.square(xf - mu), axis=-1, keepdims=True)
    y = (xf - mu) * lax.rsqrt(var + EPS)
    return (y * g.astype(jnp.float32) + b.astype(jnp.float32)).astype(x.dtype)


def l2_normalize(x):
    return x * lax.rsqrt(jnp.sum(x * x, axis=-1, keepdims=True) + 1e-6)


def causal_depthwise_conv(x, buf, w):
    ext = jnp.concatenate([buf.astype(x.dtype), x], axis=1)
    y = lax.conv_general_dilated(ext, w[:, None, :].astype(x.dtype), window_strides=(1,),
                                 padding='VALID', dimension_numbers=('NWC', 'WIO', 'NWC'),
                                 feature_group_count=x.shape[-1])
    return y, ext[:, -(w.shape[0] - 1):]


def gdn_intra(q, k, v, beta, g):
    L = q.shape[-2]
    G = jnp.cumsum(g, axis=-1)
    pos = jnp.arange(L)
    causal = pos[:, None] >= pos[None, :]
    decay = jnp.exp(jnp.where(causal, G[..., :, None] - G[..., None, :], -jnp.inf))
    M = beta[..., :, None] * jnp.einsum('...id,...jd->...ij', k, k) * decay
    A = jnp.tril(M, -1) + jnp.eye(L, dtype=M.dtype)
    rhs = jnp.concatenate([v * beta[..., None], k * (beta * jnp.exp(G))[..., None]], axis=-1)
    sol = lax.linalg.triangular_solve(A, rhs, left_side=True, lower=True, unit_diagonal=True)
    value, kcum = sol[..., :v.shape[-1]], sol[..., v.shape[-1]:]
    attn = jnp.einsum('...id,...jd->...ij', q, k) * decay
    q_dec = q * jnp.exp(G)[..., None]
    g_last = G[..., -1]
    k_dec = k * jnp.exp(g_last[..., None] - G)[..., None]
    return value, kcum, attn, q_dec, k_dec, jnp.exp(g_last)


def gdn_inter(S, value, kcum, attn, q_dec, k_dec, last):
    u = value - jnp.einsum('...ld,...de->...le', kcum, S)
    o = jnp.einsum('...ld,...de->...le', q_dec, S) + jnp.einsum('...ij,...je->...ie', attn, u)
    S = S * last[..., None, None] + jnp.einsum('...ld,...le->...de', k_dec, u)
    return S, o


def gated_delta(q, k, v, beta, g, S0, n_lead, chunk):
    B, H, T, _ = q.shape
    S = S0
    outs = []
    if n_lead > 0:
        S, o_lead = gdn_inter(S, *gdn_intra(q[:, :, :n_lead], k[:, :, :n_lead], v[:, :, :n_lead],
                                             beta[:, :, :n_lead], g[:, :, :n_lead]))
        outs.append(o_lead)
    nc = (T - n_lead) // chunk

    def blocks(a):
        a = a[:, :, n_lead:]
        a = a.reshape((B, H, nc, chunk) + a.shape[3:])
        return jnp.moveaxis(a, 2, 0)

    intra = gdn_intra(blocks(q), blocks(k), blocks(v), blocks(beta), blocks(g))
    S, o = lax.scan(lambda s, xs: gdn_inter(s, *xs), S, intra)
    o = jnp.moveaxis(o, 0, 2).reshape(B, H, nc * chunk, v.shape[-1])
    outs.append(o)
    return jnp.concatenate(outs, axis=2), S


def layer(x, conv_buf, qkv_buf, S0, n_lead, chunk, g_mix, w_in, w_dw, b_dw, ln_g, ln_b, w_cout,
          w_short, a_log, dt_bias, g_head, w_dout, w_o, g_mlp, w_up, w_down):
    Bx, T, _ = x.shape
    f32 = jnp.float32
    h = rms_norm(x, g_mix)
    proj = h @ w_in
    cuts = np.cumsum([C_CONV, C_CONV, D_QKV, D_QK, N_HEADS, N_HEADS, D_MODEL]).tolist()
    glu_a, glu_b, qkv, z, b_raw, a_raw, gate_c, gate_d = jnp.split(proj, cuts, axis=-1)

    glu = glu_a * jax.nn.sigmoid(glu_b)
    c, new_conv = causal_depthwise_conv(glu, conv_buf, w_dw)
    c = jax.nn.silu(layer_norm(c + b_dw, ln_g, ln_b))
    conv_out = c @ w_cout

    qkv_c, new_qkv = causal_depthwise_conv(qkv, qkv_buf, w_short)
    qkv_c = jax.nn.silu(qkv_c).astype(f32)
    q, k, v = jnp.split(qkv_c, 3, axis=-1)
    heads = lambda a: a.reshape(Bx, T, N_HEADS, D_HEAD).transpose(0, 2, 1, 3)
    q = l2_normalize(heads(q)) * (D_HEAD ** -0.5)
    k = l2_normalize(heads(k))
    v = heads(v)
    beta = jax.nn.sigmoid(b_raw.astype(f32)).transpose(0, 2, 1)
    g = (-jnp.exp(a_log.astype(f32)) * jax.nn.softplus(a_raw.astype(f32) + dt_bias.astype(f32))).transpose(0, 2, 1)
    o, S_new = gated_delta(q, k, v, beta, g, S0.astype(f32), n_lead, chunk)
    o = o.transpose(0, 2, 1, 3)
    o = rms_norm(o, g_head) * jax.nn.silu(z.astype(f32).reshape(Bx, T, N_HEADS, D_HEAD))
    dn_out = o.reshape(Bx, T, D_QK).astype(x.dtype) @ w_dout

    mix = jax.nn.sigmoid(gate_c) * conv_out + jax.nn.sigmoid(gate_d) * dn_out
    x = x + mix @ w_o
    hm = rms_norm(x, g_mlp) @ w_up
    x = x + jnp.square(jax.nn.relu(hm)) @ w_down
    return x, new_conv, new_qkv, S_new.astype(S0.dtype)


def setup_inputs(seed: int = 0) -> dict:
    key = jax.random.key(seed)
    ks = jax.random.split(key, 24)
    f32 = jnp.float32
    nrm = lambda k, shape, s: jax.random.normal(k, shape, f32) * s
    return {
        "x_prompt": nrm(ks[0], (BATCH, SEQ, D_MODEL), 1.0),
        "x_sample": nrm(ks[1], (DEC_BATCH, DEC_SEQ, D_MODEL), 1.0),
        "state_conv": nrm(ks[2], (DEPTH, DEC_BATCH, K_CONV - 1, C_CONV), 0.5),
        "state_qkv_conv": nrm(ks[3], (DEPTH, DEC_BATCH, K_SHORT - 1, D_QKV), 1.0),
        "state_delta": nrm(ks[4], (DEPTH, DEC_BATCH, N_HEADS, D_HEAD, D_HEAD), 0.5),
        "meta_tokens": nrm(ks[5], (N_META, D_MODEL), 1.0),
        "g_mix": 1.0 + nrm(ks[6], (DEPTH, D_MODEL), 0.01),
        "w_in": nrm(ks[7], (DEPTH, D_MODEL, D_IN), D_MODEL ** -0.5),
        "w_dw": nrm(ks[8], (DEPTH, K_CONV, C_CONV), K_CONV ** -0.5),
        "b_dw": nrm(ks[9], (DEPTH, C_CONV), 0.01),
        "ln_g": 1.0 + nrm(ks[10], (DEPTH, C_CONV), 0.01),
        "ln_b": nrm(ks[11], (DEPTH, C_CONV), 0.01),
        "w_cout": nrm(ks[12], (DEPTH, C_CONV, D_MODEL), C_CONV ** -0.5),
        "w_short": nrm(ks[13], (DEPTH, K_SHORT, D_QKV), K_SHORT ** -0.5),
        "a_log": jnp.log(jax.random.uniform(ks[14], (DEPTH, N_HEADS), f32, 1.0, 16.0)),
        "dt_bias": nrm(ks[15], (DEPTH, N_HEADS), 0.5),
        "g_head": 1.0 + nrm(ks[16], (DEPTH, D_HEAD), 0.01),
        "w_dout": nrm(ks[17], (DEPTH, D_QK, D_MODEL), D_QK ** -0.5),
        "w_o": nrm(ks[18], (DEPTH, D_MODEL, D_MODEL), D_MODEL ** -0.5),
        "g_mlp": 1.0 + nrm(ks[19], (DEPTH, D_MODEL), 0.01),
        "w_up": nrm(ks[20], (DEPTH, D_MODEL, D_FF), D_MODEL ** -0.5),
        "w_down": nrm(ks[21], (DEPTH, D_FF, D_MODEL), D_FF ** -0.5),
        "g_final": 1.0 + nrm(ks[22], (D_MODEL,), 0.01),
    }


def reference(x_prompt, x_sample, state_conv, state_qkv_conv, state_delta, meta_tokens, g_mix, w_in,
              w_dw, b_dw, ln_g, ln_b, w_cout, w_short, a_log, dt_bias, g_head, w_dout, w_o, g_mlp,
              w_up, w_down, g_final):
    Bp = x_prompt.shape[0]
    meta = jnp.broadcast_to(meta_tokens.astype(x_prompt.dtype)[None], (Bp, N_META, D_MODEL))
    xp = jnp.concatenate([meta, x_prompt], axis=1)
    xs = x_sample
    pc_l, pq_l, pS_l, sc_l, sq_l, sS_l = [], [], [], [], [], []
    for l in range(DEPTH):
        params = (g_mix[l], w_in[l], w_dw[l], b_dw[l], ln_g[l], ln_b[l], w_cout[l], w_short[l],
                  a_log[l], dt_bias[l], g_head[l], w_dout[l], w_o[l], g_mlp[l], w_up[l], w_down[l])
        zc = jnp.zeros((Bp, K_CONV - 1, C_CONV), xp.dtype)
        zq = jnp.zeros((Bp, K_SHORT - 1, D_QKV), xp.dtype)
        zS = jnp.zeros((Bp, N_HEADS, D_HEAD, D_HEAD), state_delta.dtype)
        xp, pc, pq, pS = layer(xp, zc, zq, zS, N_META, CHUNK, *params)
        xs, sc, sq, sS = layer(xs, state_conv[l], state_qkv_conv[l], state_delta[l], 0, xs.shape[1], *params)
        pc_l.append(pc); pq_l.append(pq); pS_l.append(pS)
        sc_l.append(sc); sq_l.append(sq); sS_l.append(sS)
    y_prompt = rms_norm(xp[:, N_META:], g_final)
    y_sample = rms_norm(xs, g_final)
    prompt_conv = jnp.stack(pc_l)
    prompt_qkv_conv = jnp.stack(pq_l)
    prompt_delta = jnp.stack(pS_l)
    sample_conv = jnp.stack(sc_l)
    sample_qkv_conv = jnp.stack(sq_l)
    sample_delta = jnp.stack(sS_l)
    return (y_prompt, y_sample, prompt_conv, prompt_qkv_conv, prompt_delta, sample_conv, sample_qkv_conv, sample_delta)
```

```cpp
#include <hip/hip_runtime.h>
#include <cstdio>
#include <cstdint>

#ifndef MK_N_LAUNCHES
#define MK_N_LAUNCHES 0
#endif

namespace pg8 {
#define PG8_LAS __attribute__((address_space(3)))
typedef unsigned short bf16_t;
typedef short bf16x8 __attribute__((ext_vector_type(8)));
typedef float f32x4 __attribute__((ext_vector_type(4)));
typedef unsigned u32x4 __attribute__((ext_vector_type(4)));
constexpr int BM = 256, BK = 64, HALF = 128, HTB = HALF * BK * 2, STAGE_BYTES = 8 * HTB, NXCD = 8, WGM = 8;

__host__ __device__ __forceinline__ int lds_byte(int r, int c) { const int st = (r >> 4) * 2 + (c >> 5), rr = r & 15, cc = c & 31, ob = rr * 64 + cc * 2; return st * 1024 + (ob ^ (((ob >> 9) & 1) << 5)); }
__host__ __device__ __forceinline__ void stage_rc(int b, int& R, int& C) { const int st = b / 1024, sb = b % 1024, swz = sb ^ (((sb >> 9) & 1) << 5); R = (st >> 1) * 16 + swz / 64; C = (st & 1) * 32 + (swz % 64) / 2; }
__host__ __device__ __forceinline__ int perm32(int rho) { const int n = rho >> 4, i = rho & 15; return 8 * (i >> 2) + 4 * n + (i & 3); }

struct Unit { int pm, pn; };
struct Gemm { const bf16_t* A; const bf16_t* Bt; int M, N, K; };

struct StaticOrder {
    int nM, nN, nwg, G, c;
    __host__ __device__ void init(int M, int N, int G_, int c_) { nM = M / BM; nN = N / BM; nwg = nM * nN; G = G_; c = c_; }
    __host__ __device__ bool next(int i, Unit& u) const {
        const long L = (long)i * G + c; if (L >= nwg) return false;
        int wgid = (int)L; { const int q = nwg / NXCD, r = nwg % NXCD, xcd = wgid % NXCD, off = wgid / NXCD; wgid = (xcd < r ? xcd * (q + 1) : r * (q + 1) + (xcd - r) * q) + off; }
        const int nig = WGM * nN, gid = wgid / nig, fm = gid * WGM, gsz = (nM - fm) < WGM ? (nM - fm) : WGM;
        u.pm = fm + ((wgid % nig) % gsz); u.pn = (wgid % nig) / gsz; return true;
    }
    __device__ __forceinline__ void a_ready(const Unit&) const {}
    __device__ __forceinline__ void done(const Unit&) const {}
};

__device__ __forceinline__ unsigned cvt_pk_bf16(float lo, float hi) { unsigned r; asm volatile("v_cvt_pk_bf16_f32 %0, %1, %2" : "=v"(r) : "v"(lo), "v"(hi)); return r; }

template <class Epi, class Sched, bool ALIGN_EPI = false, bool SP2 = false>
__device__ __forceinline__ void gemm_phase(PG8_LAS unsigned char* lds, const Gemm g, const Sched& S, const Epi& E) {
    const int tid = threadIdx.x, wid = __builtin_amdgcn_readfirstlane(tid >> 6), lane = tid & 63, wr = wid >> 2, wc = wid & 3, fr = lane & 15, fq = lane >> 4;
    const int K = g.K, nt = K / BK;
    unsigned voffA[2], voffB[2];
#pragma unroll
    for (int i = 0; i < 2; ++i) { int R, C; stage_rc(tid * 16 + i * 8192, R, C); const int Rb = Epi::PERM ? ((R & ~31) + perm32(R & 31)) : R;
        voffA[i] = (unsigned)(R * K + C) * 2u; voffB[i] = (unsigned)(Rb * K + C) * 2u; }
    const size_t kstep = (size_t)(BK * 2);
    const size_t hstep = (size_t)HALF * K * 2;
    const size_t tstep = 2 * hstep;
    const unsigned ldsw = (unsigned)wid * 1024u;
    const int aoff = lds_byte(wr * 64 + fr, fq * 8), boff = lds_byte(wc * 32 + fr, fq * 8);
#define PG8_SA(b, h) (((b) * 2 + (h)) * HTB)
#define PG8_SB(b, h) ((4 + (b) * 2 + (h)) * HTB)
#define PG8_STAGE(bufoff, gbase, voff) do { _Pragma("unroll") for (int _i = 0; _i < 2; ++_i) \
        __builtin_amdgcn_global_load_lds((const unsigned*)((const char*)(gbase) + (voff)[_i]), (PG8_LAS unsigned*)(lds + (bufoff) + ldsw + _i * 8192), 16, 0, 0); } while (0)
#define PG8_LDA(dst, b, h) do { _Pragma("unroll") for (int m = 0; m < 4; ++m) _Pragma("unroll") for (int k = 0; k < 2; ++k) dst[m][k] = *(const PG8_LAS bf16x8*)(lds + PG8_SA(b, h) + aoff + m * 2048 + k * 1024); } while (0)
#define PG8_LDB(dst, b, h) do { _Pragma("unroll") for (int n = 0; n < 2; ++n) _Pragma("unroll") for (int k = 0; k < 2; ++k) dst[n][k] = *(const PG8_LAS bf16x8*)(lds + PG8_SB(b, h) + boff + n * 2048 + k * 1024); } while (0)
#define PG8_MMA(ai, bj, At, Bt) do { __builtin_amdgcn_s_setprio(1); _Pragma("unroll") for (int m = 0; m < 4; ++m) _Pragma("unroll") for (int n = 0; n < 2; ++n) _Pragma("unroll") for (int k = 0; k < 2; ++k) \
        acc[ai][bj][m][n] = __builtin_amdgcn_mfma_f32_16x16x32_bf16(Bt[n][k], At[m][k], acc[ai][bj][m][n], 0, 0, 0); __builtin_amdgcn_s_setprio(0); } while (0)
#define PG8_WAIT_V(n) asm volatile("s_waitcnt vmcnt(" #n ")" ::: "memory")
#define PG8_WAIT_L(n) asm volatile("s_waitcnt lgkmcnt(" #n ")" ::: "memory")
#define PG8_BAR __builtin_amdgcn_s_barrier()
#define PG8_SCHED __builtin_amdgcn_sched_barrier(0)
    Unit cur, nxt; int ui = 0;
    if (!S.next(0, cur)) return;
    f32x4 acc[2][2][4][2];
#pragma unroll
    for (int a = 0; a < 2; ++a)
#pragma unroll
        for (int b = 0; b < 2; ++b)
#pragma unroll
            for (int m = 0; m < 4; ++m)
#pragma unroll
                for (int n = 0; n < 2; ++n) acc[a][b][m][n] = (f32x4){0.f, 0.f, 0.f, 0.f};
    bf16x8 At[4][2], B0[2][2], B1[2][2];
    const char* cA = (const char*)g.A + (size_t)cur.pm * tstep; const char* cB = (const char*)g.Bt + (size_t)cur.pn * tstep;
    S.a_ready(cur);
    if constexpr (SP2) {
        PG8_STAGE(PG8_SB(0, 0), cB, voffB); PG8_STAGE(PG8_SB(0, 1), cB + hstep, voffB); PG8_STAGE(PG8_SA(0, 0), cA, voffA); PG8_STAGE(PG8_SA(0, 1), cA + hstep, voffA);
        if (wr == 1) PG8_BAR;
        PG8_WAIT_V(2); PG8_BAR;
        PG8_STAGE(PG8_SB(1, 0), cB + kstep, voffB); PG8_STAGE(PG8_SA(1, 0), cA + kstep, voffA); PG8_STAGE(PG8_SB(1, 1), cB + hstep + kstep, voffB);
        PG8_WAIT_V(6); PG8_BAR;
    } else {
        PG8_STAGE(PG8_SB(0, 0), cB, voffB); PG8_STAGE(PG8_SA(0, 0), cA, voffA); PG8_STAGE(PG8_SB(0, 1), cB + hstep, voffB); PG8_STAGE(PG8_SA(0, 1), cA + hstep, voffA);
        if (wr == 1) PG8_BAR;
        PG8_WAIT_V(4); PG8_BAR;
        PG8_STAGE(PG8_SB(1, 0), cB + kstep, voffB); PG8_STAGE(PG8_SA(1, 0), cA + kstep, voffA); PG8_STAGE(PG8_SB(1, 1), cB + hstep + kstep, voffB);
        PG8_WAIT_V(6); PG8_BAR;
    }
    for (;;) {
        const bool has_next = S.next(ui + 1, nxt);
        const char* nA = has_next ? (const char*)g.A + (size_t)nxt.pm * tstep : cA; const char* nB = has_next ? (const char*)g.Bt + (size_t)nxt.pn * tstep : cB;
        for (int t = 0; t < nt; t += 2) {
            const bool last = (t == nt - 2);
            const char* a1 = cA + (size_t)(t + 1) * kstep;
            const char* a2 = last ? nA : cA + (size_t)(t + 2) * kstep; const char* b2 = last ? nB : cB + (size_t)(t + 2) * kstep;
            const char* a3 = a2 + kstep; const char* b3 = b2 + kstep;
            if (last && has_next) S.a_ready(nxt);
            if constexpr (SP2) {
            PG8_LDB(B0, 0, 0); PG8_LDB(B1, 0, 1); PG8_SCHED; PG8_LDA(At, 0, 0); PG8_STAGE(PG8_SA(1, 1), a1 + hstep, voffA);
            PG8_WAIT_V(8); PG8_WAIT_L(0); PG8_BAR; PG8_MMA(0, 0, At, B0); PG8_MMA(0, 1, At, B1); PG8_BAR; PG8_SCHED;
            PG8_LDA(At, 0, 1); PG8_STAGE(PG8_SB(0, 0), b2, voffB); PG8_STAGE(PG8_SB(0, 1), b2 + hstep, voffB); PG8_STAGE(PG8_SA(0, 0), a2, voffA);
            PG8_WAIT_V(8); PG8_WAIT_L(0); PG8_BAR; PG8_MMA(1, 0, At, B0); PG8_MMA(1, 1, At, B1); PG8_BAR; PG8_SCHED;
            PG8_LDB(B0, 1, 0); PG8_LDB(B1, 1, 1); PG8_SCHED; PG8_LDA(At, 1, 0); PG8_STAGE(PG8_SA(0, 1), a2 + hstep, voffA);
            PG8_WAIT_V(8); PG8_WAIT_L(0); PG8_BAR; PG8_MMA(0, 0, At, B0); PG8_MMA(0, 1, At, B1); PG8_BAR; PG8_SCHED;
            PG8_LDA(At, 1, 1); PG8_STAGE(PG8_SB(1, 0), b3, voffB); PG8_STAGE(PG8_SB(1, 1), b3 + hstep, voffB); PG8_STAGE(PG8_SA(1, 0), a3, voffA);
            PG8_WAIT_V(8); PG8_WAIT_L(0); PG8_BAR; PG8_MMA(1, 0, At, B0); PG8_MMA(1, 1, At, B1); PG8_BAR; PG8_SCHED;
            } else {
            PG8_LDB(B0, 0, 0); PG8_SCHED; PG8_LDA(At, 0, 0); PG8_STAGE(PG8_SA(1, 1), a1 + hstep, voffA);
            PG8_WAIT_L(8); PG8_BAR; PG8_WAIT_L(0); PG8_MMA(0, 0, At, B0); PG8_BAR; PG8_SCHED;
            PG8_LDB(B1, 0, 1); PG8_STAGE(PG8_SB(0, 0), b2, voffB);
            PG8_BAR; PG8_WAIT_L(0); PG8_MMA(0, 1, At, B1); PG8_BAR;
            PG8_LDA(At, 0, 1); PG8_STAGE(PG8_SA(0, 0), a2, voffA);
            PG8_BAR; PG8_WAIT_L(0); PG8_MMA(1, 0, At, B0); PG8_BAR; PG8_SCHED;
            PG8_STAGE(PG8_SB(0, 1), b2 + hstep, voffB);
            PG8_WAIT_V(6); PG8_BAR; PG8_MMA(1, 1, At, B1); PG8_BAR;
            PG8_LDB(B0, 1, 0); PG8_SCHED; PG8_LDA(At, 1, 0); PG8_STAGE(PG8_SA(0, 1), a2 + hstep, voffA);
            PG8_WAIT_L(8); PG8_BAR; PG8_WAIT_L(0); PG8_MMA(0, 0, At, B0); PG8_BAR; PG8_SCHED;
            PG8_LDB(B1, 1, 1); PG8_STAGE(PG8_SB(1, 0), b3, voffB);
            PG8_BAR; PG8_WAIT_L(0); PG8_MMA(0, 1, At, B1); PG8_BAR;
            PG8_LDA(At, 1, 1); PG8_STAGE(PG8_SA(1, 0), a3, voffA);
            PG8_BAR; PG8_WAIT_L(0); PG8_MMA(1, 0, At, B0); PG8_BAR; PG8_SCHED;
            PG8_STAGE(PG8_SB(1, 1), b3 + hstep, voffB);
            PG8_WAIT_V(6); PG8_BAR; PG8_MMA(1, 1, At, B1); PG8_BAR;
            }
        }
        if constexpr (ALIGN_EPI) { if (wr == 0) PG8_BAR; }
        E(acc, cur, wr, wc, fr, fq); S.done(cur);
        if (!has_next) break;
#pragma unroll
        for (int a = 0; a < 2; ++a)
#pragma unroll
            for (int b = 0; b < 2; ++b)
#pragma unroll
                for (int m = 0; m < 4; ++m)
#pragma unroll
                    for (int n = 0; n < 2; ++n) acc[a][b][m][n] = (f32x4){0.f, 0.f, 0.f, 0.f};
        cur = nxt; cA = nA; cB = nB; ++ui;
        if constexpr (ALIGN_EPI) { if (wr == 1) PG8_BAR; }
    }
    PG8_WAIT_V(0);
    if constexpr (!ALIGN_EPI) { if (wr == 0) PG8_BAR; }
    PG8_BAR;
#undef PG8_SA
#undef PG8_SB
#undef PG8_STAGE
#undef PG8_LDA
#undef PG8_LDB
#undef PG8_MMA
#undef PG8_WAIT_V
#undef PG8_WAIT_L
#undef PG8_BAR
#undef PG8_SCHED
}
}

constexpr int NWAVES = 8;
constexpr int DM = 1024, BP = 8, SEQ = 2048, NMETA = 16, TP = SEQ + NMETA, BS = 128, TS = 4;
constexpr int RP = BP * TP;
constexpr int RS = BS * TS;
constexpr int MR = RP + RS;
constexpr int MP = 17152;
constexpr int M2 = BP * SEQ + RS;
constexpr int NH = 8, DH = 128, DQKV = 3072, DFF = 4096, KC = 31, KS = 4;
constexpr int NIN = 8448;
constexpr int DIN = 8208;
constexpr float EPS = 1e-6f;

constexpr size_t O_YP = 0, O_YS = 16777216, O_PC = 17301504, O_PQ = 17547264, O_PD = 17620992, O_SC = 18669568, O_SQ = 22601728, O_SD = 23781376, O_END = 40558592;

constexpr size_t MiB = 1u << 20;
constexpr size_t WS_CTL = 0, CTL_ZERO_BYTES = 1 * MiB;
constexpr size_t WS_BETAG = 1 * MiB;
constexpr size_t WS_WC = 8 * MiB, WS_WD = 10 * MiB, WS_WO = 12 * MiB, WS_WUP = 14 * MiB, WS_WDN = 22 * MiB;
constexpr size_t WS_GLU = 30 * MiB;
constexpr size_t WS_QKV = 64 * MiB;
constexpr size_t WS_ZS = 165 * MiB;
constexpr size_t WS_H = 199 * MiB;
constexpr size_t WS_WIN = 233 * MiB;
constexpr size_t WS_MIX = WS_GLU, WS_XG = WS_QKV, WS_HM = 100 * MiB, WS_C = WS_H;
constexpr size_t WS_END = 256 * MiB;
static_assert(WS_WIN + (size_t)NIN * DM * 2 <= WS_END, "ws map");
static_assert(WS_HM + (size_t)M2 * DFF * 2 <= 233 * MiB, "ws map hm");
constexpr int CW_TMO = 0, CW_CODE = 1, CW_BAR = 4096;

constexpr int RING_OFF = 0, RING_BYTES = 131072;
constexpr int LDSCTL_OFF = RING_BYTES, MISC_OFF = LDSCTL_OFF + 320;
constexpr int LDS_BYTES = 147456;

#define GAS __attribute__((address_space(1)))
#define LAS __attribute__((address_space(3)))
typedef unsigned short bf16;
typedef unsigned v4u __attribute__((ext_vector_type(4)));
typedef unsigned v2u __attribute__((ext_vector_type(2)));
typedef float f32x4 __attribute__((ext_vector_type(4)));
typedef float f32x2 __attribute__((ext_vector_type(2)));
typedef GAS unsigned gu32;
#define RLX_AGENT __ATOMIC_RELAXED, __HIP_MEMORY_SCOPE_AGENT
#define LDS_WAIT() asm volatile("s_waitcnt lgkmcnt(0)" ::: "memory")
#define VM_WAIT() asm volatile("s_waitcnt vmcnt(0)" ::: "memory")
__device__ __forceinline__ unsigned f2bf(float f) { unsigned u = __builtin_bit_cast(unsigned, f); return (u + 0x7fffu + ((u >> 16) & 1u)) >> 16; }
__device__ __forceinline__ unsigned pk2(float lo, float hi) { return f2bf(lo) | (f2bf(hi) << 16); }
__device__ __forceinline__ float bflo(unsigned w) { return __builtin_bit_cast(float, w << 16); }
__device__ __forceinline__ float bfhi(unsigned w) { return __builtin_bit_cast(float, w & 0xffff0000u); }
__device__ __forceinline__ float bf1(bf16 b) { return __builtin_bit_cast(float, ((unsigned)b) << 16); }
__device__ __forceinline__ float sigmoidf_(float x) { return __builtin_amdgcn_rcpf(1.f + __expf(-x)); }
__device__ __forceinline__ float siluf_(float x) { return x * sigmoidf_(x); }

#define XB_TMO      128
#define XB_XCNT(j)  (256  + 64 * (j))
#define XB_XSUB(j)  (1280 + 64 * (j))
#define XB_XGEN(j)  (2304 + 64 * (j))
#define XB_TOP      3328
#define XB_TOPGEN   3392
#define XCD_BAR_WORDS 3456
#define XB_SPIN_CAP (1u << 18)
__device__ __forceinline__ unsigned xb_ld(unsigned* p)              { return __hip_atomic_load(p, __ATOMIC_RELAXED, __HIP_MEMORY_SCOPE_AGENT); }
__device__ __forceinline__ unsigned xb_add(unsigned* p, unsigned v) { return __hip_atomic_fetch_add(p, v, __ATOMIC_RELAXED, __HIP_MEMORY_SCOPE_AGENT); }
__device__ __forceinline__ unsigned xb_xcc_id() { return (unsigned)__builtin_amdgcn_s_getreg((3 << 11) | 20) & 0xFu; }
#define XB_SPIN(cond, bar) do { unsigned _sp = 0; while (cond) { __builtin_amdgcn_s_sleep(1); \
    if ((++_sp & 255u) == 0u) { if (xb_ld(&(bar)[XB_TMO])) break; if (_sp > XB_SPIN_CAP) { atomicAdd(&(bar)[XB_TMO], 1u); break; } } } } while (0)
struct XcdBarrier { unsigned* bar; unsigned x; volatile LAS unsigned* st; };
__device__ __forceinline__ XcdBarrier xcd_barrier_post(unsigned* bar, volatile LAS unsigned* st) {
    XcdBarrier b; b.bar = bar; b.x = xb_xcc_id(); b.st = st;
    if (threadIdx.x == 0) (void)xb_add(&bar[XB_XCNT(b.x)], 1u);
    return b;
}
__device__ __forceinline__ void xcd_barrier_complete(unsigned* bar, unsigned x, unsigned& nloc, unsigned& nx) {
    const unsigned G = gridDim.x * gridDim.y * gridDim.z;
    unsigned sum, cnt, mine, sp = 0u;
    for (;;) {
        sum = 0u; cnt = 0u; mine = 0u;
#pragma unroll
        for (unsigned j = 0; j < 16; ++j) { const unsigned c = xb_ld(&bar[XB_XCNT(j)]); sum += c; cnt += (c > 0u) ? 1u : 0u; mine = (j == x) ? c : mine; }
        if (sum == G) break;
        __builtin_amdgcn_s_sleep(1);
        if ((++sp & 255u) == 0u) { if (xb_ld(&bar[XB_TMO])) break; if (sp > XB_SPIN_CAP) { atomicAdd(&bar[XB_TMO], 1u); break; } }
    }
    nloc = mine > 0u ? mine : 1u; nx = cnt > 0u ? cnt : 1u;
}
__device__ __forceinline__ void xcd_barrier(const XcdBarrier& b) {
    asm volatile("s_waitcnt vmcnt(0)" ::: "memory");
    __syncthreads();
    if (threadIdx.x == 0) {
        unsigned* bar = b.bar;
        __builtin_amdgcn_s_waitcnt(0);
        unsigned nloc = b.st[0], nx = b.st[1];
        if (nloc == 0u) { xcd_barrier_complete(bar, b.x, nloc, nx); b.st[0] = nloc; b.st[1] = nx; }
        const unsigned old = xb_add(&bar[XB_XSUB(b.x)], 1u);
        const unsigned gen = old / nloc;
        if (old + 1u == (gen + 1u) * nloc) {
            __builtin_amdgcn_fence(__ATOMIC_RELEASE, "agent");
            asm volatile("s_waitcnt vmcnt(0)" ::: "memory");
            const unsigned og = xb_add(&bar[XB_TOP], 1u);
            const unsigned tg = og / nx;
            if (og + 1u == (tg + 1u) * nx) xb_add(&bar[XB_TOPGEN], 1u);
            else XB_SPIN(xb_ld(&bar[XB_TOPGEN]) == tg, bar);
            __builtin_amdgcn_fence(__ATOMIC_ACQUIRE, "agent");
            xb_add(&bar[XB_XGEN(b.x)], 1u);
            asm volatile("s_waitcnt vmcnt(0)" ::: "memory");
        } else {
            XB_SPIN(xb_ld(&bar[XB_XGEN(b.x)]) == gen, bar);
            __builtin_amdgcn_fence(__ATOMIC_ACQUIRE, "agent");
            asm volatile("s_waitcnt vmcnt(0)" ::: "memory");
        }
    }
    __syncthreads();
}

struct Args { const float* in[23]; float* out; unsigned char* ws; int ph_lo, ph_hi; };

__device__ __forceinline__ float wave_sum(float v) {
#pragma unroll
    for (int o = 1; o < 64; o <<= 1) v += __shfl_xor(v, o);
    return v;
}
__device__ __forceinline__ int compact_row(int r) {
    if (r >= MR) return -1;
    if (r >= RP) return r - RP + BP * SEQ;
    const int b = r / TP, t = r - b * TP;
    return t < NMETA ? -1 : r - NMETA * (b + 1);
}

__device__ __forceinline__ void p0_transpose_item(const float* W, int Nsrc, int K, bf16* WT, int dst_row0, int src_col0, int nvalid, LAS float* scr, int kb, int lane) {
    const int k0 = 64 * kb, cidx = lane & 31;
#pragma unroll 8
    for (int i = 0; i < 32; ++i) { const int kk = 2 * i + (lane >> 5); float v = 0.f; if (cidx < nvalid) v = W[(size_t)(k0 + kk) * Nsrc + src_col0 + cidx]; scr[kk * 33 + cidx] = v; }
    LDS_WAIT(); asm volatile("" ::: "memory");
    const int c = lane & 7;
#pragma unroll
    for (int j = 0; j < 4; ++j) { const int n = (lane >> 3) + 8 * j; const LAS float* s = scr + (8 * c) * 33 + n;
        v4u o; o.x = pk2(s[0 * 33], s[1 * 33]); o.y = pk2(s[2 * 33], s[3 * 33]); o.z = pk2(s[4 * 33], s[5 * 33]); o.w = pk2(s[6 * 33], s[7 * 33]);
        *(GAS v4u*)(WT + (size_t)(dst_row0 + n) * K + k0 + 8 * c) = o; }
    LDS_WAIT(); asm volatile("" ::: "memory");
}
__device__ __forceinline__ void win_src(int nb, int& src, int& nvalid) {
    const int pn = nb >> 3, o = (nb & 7) * 32; nvalid = 32;
    if (pn < 8) src = (o < 128) ? 128 * pn + o : 1024 + 128 * pn + (o - 128);
    else if (pn < 20) src = 2048 + 256 * (pn - 8) + o;
    else if (pn < 24) src = 5120 + 256 * (pn - 20) + o;
    else if (pn < 28) src = 6160 + 256 * (pn - 24) + o;
    else if (pn < 32) src = 7184 + 256 * (pn - 28) + o;
    else { src = 6144; nvalid = (o == 0) ? 16 : 0; }
}
__device__ __forceinline__ void rms_row_to_bf16(const float* xrow, const float* gain, bf16* orow, int lane) {
    const GAS f32x4* xr = (const GAS f32x4*)xrow + lane; const GAS f32x4* gr = (const GAS f32x4*)gain + lane;
    f32x4 v[4]; float s = 0.f;
#pragma unroll
    for (int j = 0; j < 4; ++j) { v[j] = xr[64 * j]; s += (v[j].x * v[j].x + v[j].y * v[j].y) + (v[j].z * v[j].z + v[j].w * v[j].w); }
    const float rstd = 1.f / sqrtf(wave_sum(s) * (1.f / DM) + EPS);
    GAS unsigned long long* o8 = (GAS unsigned long long*)orow + lane;
#pragma unroll
    for (int j = 0; j < 4; ++j) { const f32x4 g = gr[64 * j]; o8[64 * j] = (unsigned long long)pk2(v[j].x * rstd * g.x, v[j].y * rstd * g.y) | ((unsigned long long)pk2(v[j].z * rstd * g.z, v[j].w * rstd * g.w) << 32); }
}

typedef pg8::f32x4 A4;
struct EpiIn {
    static constexpr bool PERM = true;
    bf16 *GLU, *QKV, *ZS, *SGC, *SGD; float* BETAG; const float *a_log, *dt_bias;
    __device__ __forceinline__ void operator()(const A4 (&acc)[2][2][4][2], const pg8::Unit& u, int wr, int wc, int fr, int fq) const {
        const int pn = u.pn, row0 = u.pm * 256 + wr * 64 + fr, cw = 32 * wc + 8 * fq;
        if (pn < 8) {
#pragma unroll
            for (int ai = 0; ai < 2; ++ai)
#pragma unroll
                for (int m = 0; m < 4; ++m) { const int r = row0 + ai * 128 + m * 16; float o[8];
#pragma unroll
                    for (int n = 0; n < 2; ++n)
#pragma unroll
                        for (int j = 0; j < 4; ++j) o[4 * n + j] = acc[ai][0][m][n][j] * sigmoidf_(acc[ai][1][m][n][j]);
                    v4u w; w.x = pk2(o[0], o[1]); w.y = pk2(o[2], o[3]); w.z = pk2(o[4], o[5]); w.w = pk2(o[6], o[7]);
                    *(GAS v4u*)(GLU + (size_t)r * DM + 128 * pn + cw) = w; }
        } else if (pn < 24) {
            const bool isz = pn >= 20; bf16* dst = isz ? ZS : QKV; const int ld = isz ? DM : DQKV, cb = isz ? 256 * (pn - 20) : 256 * (pn - 8);
#pragma unroll
            for (int ai = 0; ai < 2; ++ai)
#pragma unroll
                for (int m = 0; m < 4; ++m) { const int r = row0 + ai * 128 + m * 16;
#pragma unroll
                    for (int bj = 0; bj < 2; ++bj) { float o[8];
#pragma unroll
                        for (int n = 0; n < 2; ++n)
#pragma unroll
                            for (int j = 0; j < 4; ++j) { const float v = acc[ai][bj][m][n][j]; o[4 * n + j] = isz ? siluf_(v) : v; }
                        v4u w; w.x = pk2(o[0], o[1]); w.y = pk2(o[2], o[3]); w.z = pk2(o[4], o[5]); w.w = pk2(o[6], o[7]);
                        *(GAS v4u*)(dst + (size_t)r * ld + cb + 128 * bj + cw) = w; } }
        } else if (pn < 32) {
            bf16* dst = pn < 28 ? SGC : SGD; const int cb = 256 * ((pn - 24) & 3);
#pragma unroll
            for (int ai = 0; ai < 2; ++ai)
#pragma unroll
                for (int m = 0; m < 4; ++m) { const int rc = compact_row(row0 + ai * 128 + m * 16); if (rc < 0) continue;
#pragma unroll
                    for (int bj = 0; bj < 2; ++bj) { float o[8];
#pragma unroll
                        for (int n = 0; n < 2; ++n)
#pragma unroll
                            for (int j = 0; j < 4; ++j) o[4 * n + j] = sigmoidf_(acc[ai][bj][m][n][j]);
                        v4u w; w.x = pk2(o[0], o[1]); w.y = pk2(o[2], o[3]); w.z = pk2(o[4], o[5]); w.w = pk2(o[6], o[7]);
                        *(GAS v4u*)(dst + (size_t)rc * DM + cb + 128 * bj + cw) = w; } }
        } else {
            if (wc == 0 && fq < 2) {
#pragma unroll
                for (int ai = 0; ai < 2; ++ai)
#pragma unroll
                    for (int m = 0; m < 4; ++m) { const int r = row0 + ai * 128 + m * 16; float o[8];
#pragma unroll
                        for (int n = 0; n < 2; ++n)
#pragma unroll
                            for (int j = 0; j < 4; ++j) { const int h = 4 * n + j; const float v = acc[ai][0][m][n][j];
                                if (fq == 0) o[h] = 1.f / (1.f + expf(-v));
                                else { const float xx = v + dt_bias[h]; const float sp = xx > 20.f ? xx : log1pf(expf(xx)); o[h] = -expf(a_log[h]) * sp; } }
                        GAS f32x4* p = (GAS f32x4*)(BETAG + (size_t)r * 16 + 8 * fq);
                        p[0] = (f32x4){o[0], o[1], o[2], o[3]}; p[1] = (f32x4){o[4], o[5], o[6], o[7]}; }
            }
        }
    }
};
template <int MODE> struct EpiGate {
    static constexpr bool PERM = true;
    bf16 *SG, *MA, *OUT;
    __device__ __forceinline__ void operator()(const A4 (&acc)[2][2][4][2], const pg8::Unit& u, int wr, int wc, int fr, int fq) const {
        const int row0 = u.pm * 256 + wr * 64 + fr, c0 = 256 * u.pn + 32 * wc + 8 * fq;
#pragma unroll
        for (int ai = 0; ai < 2; ++ai)
#pragma unroll
            for (int m = 0; m < 4; ++m) { const int rc = compact_row(row0 + ai * 128 + m * 16); if (rc < 0) continue;
#pragma unroll
                for (int bj = 0; bj < 2; ++bj) { const size_t off = (size_t)rc * DM + c0 + 128 * bj;
                    const v4u g = *(const GAS v4u*)(SG + off); float o[8];
                    const A4 a0 = acc[ai][bj][m][0], a1 = acc[ai][bj][m][1];
                    o[0] = bflo(g.x) * a0[0]; o[1] = bfhi(g.x) * a0[1]; o[2] = bflo(g.y) * a0[2]; o[3] = bfhi(g.y) * a0[3];
                    o[4] = bflo(g.z) * a1[0]; o[5] = bfhi(g.z) * a1[1]; o[6] = bflo(g.w) * a1[2]; o[7] = bfhi(g.w) * a1[3];
                    if (MODE == 1) { const v4u q = *(const GAS v4u*)(MA + off);
                        o[0] += bflo(q.x); o[1] += bfhi(q.x); o[2] += bflo(q.y); o[3] += bfhi(q.y); o[4] += bflo(q.z); o[5] += bfhi(q.z); o[6] += bflo(q.w); o[7] += bfhi(q.w); }
                    v4u w; w.x = pk2(o[0], o[1]); w.y = pk2(o[2], o[3]); w.z = pk2(o[4], o[5]); w.w = pk2(o[6], o[7]);
                    *(GAS v4u*)(OUT + off) = w; } }
    }
};
template <int MODE> struct EpiRes {
    static constexpr bool PERM = false;
    const float *xp, *xs; float* out;
    __device__ __forceinline__ void operator()(const A4 (&acc)[2][2][4][2], const pg8::Unit& u, int wr, int wc, int fr, int fq) const {
        const int row0 = u.pm * 256 + wr * 64 + fr, c0 = 256 * u.pn + 32 * wc + 4 * fq;
#pragma unroll
        for (int ai = 0; ai < 2; ++ai)
#pragma unroll
            for (int m = 0; m < 4; ++m) { const int r = row0 + ai * 128 + m * 16;
                const float* base = MODE == 0 ? (r < BP * SEQ ? xp + (size_t)r * DM : xs + (size_t)(r - BP * SEQ) * DM) : out + (size_t)r * DM;
                float* orow = out + (size_t)r * DM;
#pragma unroll
                for (int bj = 0; bj < 2; ++bj)
#pragma unroll
                    for (int n = 0; n < 2; ++n) { const int c = c0 + 128 * bj + 16 * n; const f32x4 b = *(const GAS f32x4*)(base + c); *(GAS f32x4*)(orow + c) = b + acc[ai][bj][m][n]; } }
    }
};
struct EpiUp {
    static constexpr bool PERM = true;
    bf16* HM;
    __device__ __forceinline__ void operator()(const A4 (&acc)[2][2][4][2], const pg8::Unit& u, int wr, int wc, int fr, int fq) const {
        const int row0 = u.pm * 256 + wr * 64 + fr, c0 = 256 * u.pn + 32 * wc + 8 * fq;
#pragma unroll
        for (int ai = 0; ai < 2; ++ai)
#pragma unroll
            for (int m = 0; m < 4; ++m) { const int r = row0 + ai * 128 + m * 16;
#pragma unroll
                for (int bj = 0; bj < 2; ++bj) { float o[8];
#pragma unroll
                    for (int n = 0; n < 2; ++n)
#pragma unroll
                        for (int j = 0; j < 4; ++j) { const float v = fmaxf(acc[ai][bj][m][n][j], 0.f); o[4 * n + j] = v * v; }
                    v4u w; w.x = pk2(o[0], o[1]); w.y = pk2(o[2], o[3]); w.z = pk2(o[4], o[5]); w.w = pk2(o[6], o[7]);
                    *(GAS v4u*)(HM + (size_t)r * DFF + c0 + 128 * bj) = w; } }
    }
};

__device__ __forceinline__ void conv_unit(const Args& a, LAS unsigned char* lds, int kind, int b, int run) {
    asm volatile("" ::: "memory");
    const int tid = threadIdx.x, lane = tid & 63, wave = tid >> 6; int ch = 2 * tid; asm volatile("" : "+v"(ch));
    const unsigned char* ws = a.ws;
    const bf16* GLU = (const bf16*)(ws + WS_GLU); bf16* C = (bf16*)(a.ws + WS_C);
    const float* w_dw = a.in[8];
    LAS float* red = (LAS float*)lds;
    f32x2 w[KC]; unsigned win[KC];
#pragma unroll
    for (int i = 0; i < KC; ++i) w[i] = *(const GAS f32x2*)(w_dw + (size_t)i * DM + ch);
    const f32x2 bdw = *(const GAS f32x2*)(a.in[9] + ch), lng = *(const GAS f32x2*)(a.in[10] + ch), lnb = *(const GAS f32x2*)(a.in[11] + ch);
    int row0, ntok; bool last_run;
    win[0] = 0u;
    if (kind == 0) { constexpr int RUN = TP / 8; row0 = b * TP + run * RUN; ntok = RUN; last_run = (run == 7);
#pragma unroll
        for (int i = 1; i < KC; ++i) { if (run == 0) win[i] = 0u; else win[i] = *(const GAS unsigned*)(GLU + (size_t)(row0 - KC + i) * DM + ch); }
    } else { row0 = RP + b * TS; ntok = TS; last_run = true;
        const float* st = a.in[2] + (size_t)b * (KC - 1) * DM;
#pragma unroll
        for (int i = 1; i < KC; ++i) { const f32x2 v = *(const GAS f32x2*)(st + (size_t)(i - 1) * DM + ch); win[i] = pk2(v.x, v.y); }
    }
    for (int t = 0; t < ntok; ++t) {
        const unsigned v = *(const GAS unsigned*)(GLU + (size_t)(row0 + t) * DM + ch);
#pragma unroll
        for (int i = 0; i < KC - 1; ++i) win[i] = win[i + 1];
        win[KC - 1] = v;
        float y0 = bdw.x, y1 = bdw.y;
#pragma unroll
        for (int i = 0; i < KC; ++i) { y0 += w[i].x * bflo(win[i]); y1 += w[i].y * bfhi(win[i]); }
        float s1 = wave_sum(y0 + y1), s2 = wave_sum(y0 * y0 + y1 * y1);
        LAS float* rb = red + (t & 1) * 16;
        if (lane == 0) { rb[wave * 2] = s1; rb[wave * 2 + 1] = s2; }
        __syncthreads();
        float t1 = 0.f, t2 = 0.f;
#pragma unroll
        for (int i = 0; i < 8; ++i) { t1 += rb[2 * i]; t2 += rb[2 * i + 1]; }
        const float mu = t1 * (1.f / DM), var = fmaxf(t2 * (1.f / DM) - mu * mu, 0.f), rstd = 1.f / sqrtf(var + EPS);
        const float z0 = (y0 - mu) * rstd * lng.x + lnb.x, z1 = (y1 - mu) * rstd * lng.y + lnb.y;
        *(GAS unsigned*)(C + (size_t)(row0 + t) * DM + ch) = pk2(siluf_(z0), siluf_(z1));
    }
    if (last_run) { float* o = a.out + (kind == 0 ? O_PC : O_SC) + (size_t)b * (KC - 1) * DM;
        if (kind == 0) {
#pragma unroll
            for (int i = 1; i < KC; ++i) *(GAS f32x2*)(o + (size_t)(i - 1) * DM + ch) = (f32x2){bflo(win[i]), bfhi(win[i])};
        } else {
            const float* st = a.in[2] + (size_t)b * (KC - 1) * DM;
#pragma unroll
            for (int i = 0; i < KC - 1 - TS; ++i) *(GAS f32x2*)(o + (size_t)i * DM + ch) = *(const GAS f32x2*)(st + (size_t)(i + TS) * DM + ch);
#pragma unroll
            for (int i = KC - TS; i < KC; ++i) *(GAS f32x2*)(o + (size_t)(i - 1) * DM + ch) = (f32x2){bflo(win[i]), bfhi(win[i])};
        }
    }
    __syncthreads();
}

__device__ __forceinline__ void delta_item(const Args& a, LAS unsigned char* lds, int item, bool sample) {
    asm volatile("" ::: "memory");
    const int tid = threadIdx.x, lane = tid & 63, sub = tid >> 7, wu = (tid >> 6) & 1; int j = tid & 127; asm volatile("" : "+v"(j));
    const int unit = item * 4 + sub, b = unit >> 3, h = unit & 7;
    const int T = sample ? TS : TP, row0 = sample ? RP + b * TS : b * TP;
    const bf16* QKV = (const bf16*)(a.ws + WS_QKV); bf16* ZS = (bf16*)(a.ws + WS_ZS); const float* BETAG = (const float*)(a.ws + WS_BETAG);
    LAS float* kq = (LAS float*)lds + sub * 256;
    LAS float* red = (LAS float*)lds + 1024 + sub * 4;
    LAS float* red2 = (LAS float*)lds + 1024 + 16 + sub * 2;
    float S[DH];
    if (sample) { const float* s0 = a.in[4] + ((size_t)(b * NH + h) * DH) * DH + j;
#pragma unroll
        for (int d = 0; d < DH; ++d) S[d] = s0[(size_t)d * DH];
    } else {
#pragma unroll
        for (int d = 0; d < DH; ++d) S[d] = 0.f;
    }
    const int cq = h * DH + j, ck = DM + cq, cv = 2 * DM + cq;
    float wq[KS], wk[KS], wv[KS];
#pragma unroll
    for (int i = 0; i < KS; ++i) { wq[i] = a.in[13][i * DQKV + cq]; wk[i] = a.in[13][i * DQKV + ck]; wv[i] = a.in[13][i * DQKV + cv]; }
    float hq[3], hk[3], hv[3];
#pragma unroll
    for (int i = 0; i < 3; ++i) { if (sample) { const float* st = a.in[3] + ((size_t)b * 3 + i) * DQKV; hq[i] = st[cq]; hk[i] = st[ck]; hv[i] = st[cv]; } else { hq[i] = 0.f; hk[i] = 0.f; hv[i] = 0.f; } }
    const float gh = a.in[16][j];
    for (int t = 0; t < T; ++t) {
        const size_t row = (size_t)(row0 + t);
        const float qp = bf1(QKV[row * DQKV + cq]), kp = bf1(QKV[row * DQKV + ck]), vp = bf1(QKV[row * DQKV + cv]);
        const float qc = siluf_(wq[0] * hq[0] + wq[1] * hq[1] + wq[2] * hq[2] + wq[3] * qp);
        const float kc = siluf_(wk[0] * hk[0] + wk[1] * hk[1] + wk[2] * hk[2] + wk[3] * kp);
        const float vc = siluf_(wv[0] * hv[0] + wv[1] * hv[1] + wv[2] * hv[2] + wv[3] * vp);
        hq[0] = hq[1]; hq[1] = hq[2]; hq[2] = qp; hk[0] = hk[1]; hk[1] = hk[2]; hk[2] = kp; hv[0] = hv[1]; hv[1] = hv[2]; hv[2] = vp;
        const float sq = wave_sum(qc * qc), sk = wave_sum(kc * kc);
        kq[j] = kc; kq[128 + j] = qc;
        if (lane == 0) { red[wu * 2] = sq; red[wu * 2 + 1] = sk; }
        const float beta = BETAG[row * 16 + h], gg = BETAG[row * 16 + 8 + h];
        const float zs = bf1(ZS[row * DM + cq]);
        __syncthreads();
        const float nq = (1.f / sqrtf(red[0] + red[2] + 1e-6f)) * 0.08838834764831845f, nk = 1.f / sqrtf(red[1] + red[3] + 1e-6f);
        const float alpha = expf(gg);
        float ks0 = 0.f, ks1 = 0.f, ks2 = 0.f, ks3 = 0.f;
#pragma unroll
        for (int d = 0; d < DH; d += 4) { const f32x4 kk = *(const LAS f32x4*)(kq + d); ks0 += kk.x * S[d]; ks1 += kk.y * S[d + 1]; ks2 += kk.z * S[d + 2]; ks3 += kk.w * S[d + 3];
            if ((d & 31) == 28) asm volatile("" ::: "memory"); }
        const float kS = (ks0 + ks1) + (ks2 + ks3);
        const float u = beta * (vc - alpha * nk * kS), un = nk * u;
        float o0 = 0.f, o1 = 0.f, o2 = 0.f, o3 = 0.f;
#pragma unroll
        for (int d = 0; d < DH; d += 4) { const f32x4 kk = *(const LAS f32x4*)(kq + d); const f32x4 qq = *(const LAS f32x4*)(kq + 128 + d);
            S[d] = alpha * S[d] + kk.x * un; S[d + 1] = alpha * S[d + 1] + kk.y * un; S[d + 2] = alpha * S[d + 2] + kk.z * un; S[d + 3] = alpha * S[d + 3] + kk.w * un;
            o0 += qq.x * S[d]; o1 += qq.y * S[d + 1]; o2 += qq.z * S[d + 2]; o3 += qq.w * S[d + 3];
            if ((d & 15) == 12) asm volatile("" ::: "memory"); }
        const float o = ((o0 + o1) + (o2 + o3)) * nq;
        const float so = wave_sum(o * o);
        if (lane == 0) red2[wu] = so;
        __syncthreads();
        const float rms = 1.f / sqrtf((red2[0] + red2[1]) * (1.f / DH) + EPS);
        ZS[row * DM + cq] = (bf16)f2bf(o * rms * gh * zs);
    }
    { float* so = a.out + (sample ? O_SD : O_PD) + ((size_t)(b * NH + h) * DH) * DH + j;
#pragma unroll
        for (int d = 0; d < DH; ++d) so[(size_t)d * DH] = S[d];
      float* qo = a.out + (sample ? O_SQ : O_PQ) + (size_t)b * 3 * DQKV;
#pragma unroll
        for (int i = 0; i < 3; ++i) { qo[i * DQKV + cq] = hq[i]; qo[i * DQKV + ck] = hk[i]; qo[i * DQKV + cv] = hv[i]; }
    }
    __syncthreads();
}

constexpr int NPHASES = 10;
__global__ void __launch_bounds__(NWAVES * 64, 2) fwd_kernel(Args args) {
    extern __shared__ __attribute__((aligned(16))) unsigned char lds_raw[];
    LAS unsigned char* lds = (LAS unsigned char*)lds_raw;
    volatile LAS unsigned* MISC = (volatile LAS unsigned*)(lds + MISC_OFF);
    const int tid = threadIdx.x, lane = tid & 63, wave = __builtin_amdgcn_readfirstlane(tid >> 6);
    const int G = gridDim.x, bx = blockIdx.x;
    const int vcu = (G % 8 == 0) ? (bx % 8) * (G / 8) + bx / 8 : bx;
    unsigned char* ws = args.ws;
    gu32* ctl = (gu32*)(ws + WS_CTL);
    for (int u = tid; u < (LDS_BYTES - LDSCTL_OFF) / 4; u += NWAVES * 64) ((LAS unsigned*)(lds + LDSCTL_OFF))[u] = 0u;
    __syncthreads();
    XcdBarrier bar; bar.bar = (unsigned*)(ctl + CW_BAR); bar.x = 0; bar.st = nullptr;
    const int lo = args.ph_lo, hi = args.ph_hi;
    if (hi - lo > 1) bar = xcd_barrier_post((unsigned*)(ctl + CW_BAR), MISC + 8);
#ifndef PH_MASK
#define PH_MASK 0x3ff
#endif
#define IN(k) (((PH_MASK >> (k)) & 1) && lo <= (k) && (k) < hi)
#define SEAM(k) do { if (IN(k) && IN((k) + 1)) xcd_barrier(bar); } while (0)
    bf16* WIN = (bf16*)(ws + WS_WIN); bf16* WC = (bf16*)(ws + WS_WC); bf16* WD = (bf16*)(ws + WS_WD); bf16* WO = (bf16*)(ws + WS_WO); bf16* WUP = (bf16*)(ws + WS_WUP); bf16* WDN = (bf16*)(ws + WS_WDN);
    bf16* H = (bf16*)(ws + WS_H); bf16* GLU = (bf16*)(ws + WS_GLU); bf16* QKV = (bf16*)(ws + WS_QKV); bf16* ZS = (bf16*)(ws + WS_ZS);
    bf16* SGC = (bf16*)args.out; bf16* SGD = (bf16*)args.out + (size_t)M2 * DM;
    bf16* MIX = (bf16*)(ws + WS_MIX); bf16* XG = (bf16*)(ws + WS_XG); bf16* HM = (bf16*)(ws + WS_HM); bf16* C = (bf16*)(ws + WS_C);
    float* BETAG = (float*)(ws + WS_BETAG);
    const int gw = vcu * NWAVES + wave, NGW = G * NWAVES;

    if (IN(0)) {
        LAS float* scr = (LAS float*)(lds + RING_OFF + wave * 16384);
        constexpr int I_IN = 16 * (NIN / 32), I_SQ = 16 * 32, I_UP = 16 * (DFF / 32), I_DN = (DFF / 64) * 32;
        constexpr int NITEMS = I_IN + 3 * I_SQ + I_UP + I_DN;
        for (int it = gw; it < NITEMS; it += NGW) {
            int r = it;
            if (r < I_IN) { const int nb = r >> 4, kb = r & 15; int src, nv; win_src(nb, src, nv); p0_transpose_item(args.in[7], DIN, DM, WIN, nb * 32, src, nv, scr, kb, lane); continue; } r -= I_IN;
            if (r < I_SQ) { p0_transpose_item(args.in[12], DM, DM, WC, (r >> 4) * 32, (r >> 4) * 32, 32, scr, r & 15, lane); continue; } r -= I_SQ;
            if (r < I_SQ) { p0_transpose_item(args.in[17], DM, DM, WD, (r >> 4) * 32, (r >> 4) * 32, 32, scr, r & 15, lane); continue; } r -= I_SQ;
            if (r < I_SQ) { p0_transpose_item(args.in[18], DM, DM, WO, (r >> 4) * 32, (r >> 4) * 32, 32, scr, r & 15, lane); continue; } r -= I_SQ;
            if (r < I_UP) { p0_transpose_item(args.in[20], DFF, DM, WUP, (r >> 4) * 32, (r >> 4) * 32, 32, scr, r & 15, lane); continue; } r -= I_UP;
            p0_transpose_item(args.in[21], DM, DFF, WDN, (r >> 6) * 32, (r >> 6) * 32, 32, scr, r & 63, lane);
        }
        for (int m = gw; m < MP; m += NGW) {
            if (m >= MR) { GAS unsigned long long* o8 = (GAS unsigned long long*)(H + (size_t)m * DM) + lane;
#pragma unroll
                for (int jj = 0; jj < 4; ++jj) o8[64 * jj] = 0ull; continue; }
            const float* src;
            if (m >= RP) src = args.in[1] + (size_t)(m - RP) * DM;
            else { const int b = m / TP, t = m - b * TP; src = t < NMETA ? args.in[5] + (size_t)t * DM : args.in[0] + ((size_t)b * SEQ + (t - NMETA)) * DM; }
            rms_row_to_bf16(src, args.in[6], H + (size_t)m * DM, lane);
        }
    }
    SEAM(0);
    if (IN(1)) {
        pg8::Gemm g{H, WIN, MP, NIN, DM}; pg8::StaticOrder S; S.init(MP, NIN, G, bx);
        EpiIn E{GLU, QKV, ZS, SGC, SGD, BETAG, args.in[14], args.in[15]};
        pg8::gemm_phase<EpiIn, pg8::StaticOrder, true, true>(lds + RING_OFF, g, S, E);
    }
    SEAM(1);
    if (IN(2)) {
        if (bx < 16) delta_item(args, lds, bx, false);
        else {
            for (int it = bx - 16; it < 64 + 128 + 256; it += G - 16) {
#ifndef NO_CONV
                if (it < 64) conv_unit(args, lds, 0, it >> 3, it & 7);
                else if (it < 192) conv_unit(args, lds, 1, it - 64, 0);
#else
                if (it < 192) {}
#endif
                else delta_item(args, lds, it - 192, true);
            }
        }
    }
    SEAM(2);
    if (IN(3)) {
        pg8::Gemm g{C, WC, MP, DM, DM}; pg8::StaticOrder S; S.init(MP, DM, G, bx);
        EpiGate<0> E{SGC, nullptr, SGC};
        pg8::gemm_phase<EpiGate<0>, pg8::StaticOrder, true, true>(lds + RING_OFF, g, S, E);
    }
    SEAM(3);
    if (IN(4)) {
        pg8::Gemm g{ZS, WD, MP, DM, DM}; pg8::StaticOrder S; S.init(MP, DM, G, bx);
        EpiGate<1> E{SGD, SGC, MIX};
        pg8::gemm_phase<EpiGate<1>, pg8::StaticOrder, true, true>(lds + RING_OFF, g, S, E);
    }
    SEAM(4);
    if (IN(5)) {
        pg8::Gemm g{MIX, WO, M2, DM, DM}; pg8::StaticOrder S; S.init(M2, DM, G, bx);
        EpiRes<0> E{args.in[0], args.in[1], args.out};
        pg8::gemm_phase<EpiRes<0>, pg8::StaticOrder, true, true>(lds + RING_OFF, g, S, E);
    }
    SEAM(5);
    if (IN(6)) {
        for (int m = gw; m < M2; m += NGW) rms_row_to_bf16(args.out + (size_t)m * DM, args.in[19], XG + (size_t)m * DM, lane);
    }
    SEAM(6);
    if (IN(7)) {
        pg8::Gemm g{XG, WUP, M2, DFF, DM}; pg8::StaticOrder S; S.init(M2, DFF, G, bx);
        EpiUp E{HM};
        pg8::gemm_phase<EpiUp, pg8::StaticOrder, true, true>(lds + RING_OFF, g, S, E);
    }
    SEAM(7);
    if (IN(8)) {
        pg8::Gemm g{HM, WDN, M2, DM, DFF}; pg8::StaticOrder S; S.init(M2, DM, G, bx);
        EpiRes<1> E{nullptr, nullptr, args.out};
        pg8::gemm_phase<EpiRes<1>, pg8::StaticOrder, true, true>(lds + RING_OFF, g, S, E);
    }
    SEAM(8);
    if (IN(9)) {
        for (int m = gw; m < M2; m += NGW) {
            float* xrow = args.out + (size_t)m * DM;
            GAS f32x4* xr = (GAS f32x4*)xrow + lane; const GAS f32x4* gr = (const GAS f32x4*)args.in[22] + lane;
            f32x4 v[4]; float s = 0.f;
#pragma unroll
            for (int jj = 0; jj < 4; ++jj) { v[jj] = xr[64 * jj]; s += (v[jj].x * v[jj].x + v[jj].y * v[jj].y) + (v[jj].z * v[jj].z + v[jj].w * v[jj].w); }
            const float rstd = 1.f / sqrtf(wave_sum(s) * (1.f / DM) + EPS);
#pragma unroll
            for (int jj = 0; jj < 4; ++jj) xr[64 * jj] = v[jj] * rstd * gr[64 * jj];
        }
    }
#undef IN
#undef SEAM
}

extern "C" void kernel_launch(void* const* d_in, const int* in_sizes, int n_in, void* d_out, int out_size, void* d_ws, size_t ws_size, hipStream_t stream) {
    static int grid = 0;
    if (grid == 0) {
        if (n_in != 23 || (size_t)out_size != O_END || ws_size < WS_END) { fprintf(stderr, "kernel_launch: unexpected shapes n_in %d out %d ws %zu\n", n_in, out_size, ws_size); grid = -1; return; }
        int dev = 0, cus = 0, per_cu = 0;
        if (hipGetDevice(&dev) != hipSuccess || hipDeviceGetAttribute(&cus, hipDeviceAttributeMultiprocessorCount, dev) != hipSuccess) { grid = -1; return; }
        if (hipFuncSetAttribute((const void*)fwd_kernel, hipFuncAttributeMaxDynamicSharedMemorySize, LDS_BYTES) != hipSuccess) { fprintf(stderr, "kernel_launch: hipFuncSetAttribute failed\n"); grid = -1; return; }
        if (hipOccupancyMaxActiveBlocksPerMultiprocessor(&per_cu, (const void*)fwd_kernel, NWAVES * 64, LDS_BYTES) != hipSuccess || per_cu < 1)
            fprintf(stderr, "kernel_launch: occupancy query reports %d\n", per_cu);
        (void)hipGetLastError();
        grid = cus;
    }
    if (grid < 0) return;
    if (hipMemsetAsync((char*)d_ws + WS_CTL, 0, CTL_ZERO_BYTES, stream) != hipSuccess) return;
    Args a{};
    for (int i = 0; i < 23; ++i) a.in[i] = (const float*)d_in[i];
    a.out = (float*)d_out; a.ws = (unsigned char*)d_ws;
#if MK_N_LAUNCHES == 1
    a.ph_lo = 0; a.ph_hi = NPHASES;
    hipLaunchKernelGGL(fwd_kernel, dim3(grid), dim3(NWAVES * 64), LDS_BYTES, stream, a);
#else
    for (int p = 0; p < NPHASES; ++p) { a.ph_lo = p; a.ph_hi = p + 1; hipLaunchKernelGGL(fwd_kernel, dim3(grid), dim3(NWAVES * 64), LDS_BYTES, stream, a); }
#endif
}
```

```cpp
#include <hip/hip_runtime.h>
#include <cstdio>
#include <cstdint>

#ifndef MK_N_LAUNCHES
#define MK_N_LAUNCHES 1
#endif

namespace pg8 {
#define PG8_LAS __attribute__((address_space(3)))
typedef unsigned short bf16_t;
typedef short bf16x8 __attribute__((ext_vector_type(8)));
typedef float f32x4 __attribute__((ext_vector_type(4)));
typedef unsigned u32x4 __attribute__((ext_vector_type(4)));
constexpr int BM = 256, BK = 64, HALF = 128, HTB = HALF * BK * 2, STAGE_BYTES = 8 * HTB, NXCD = 8, WGM = 8;

__host__ __device__ __forceinline__ int lds_byte(int r, int c) { const int st = (r >> 4) * 2 + (c >> 5), rr = r & 15, cc = c & 31, ob = rr * 64 + cc * 2; return st * 1024 + (ob ^ (((ob >> 9) & 1) << 5)); }
__host__ __device__ __forceinline__ void stage_rc(int b, int& R, int& C) { const int st = b / 1024, sb = b % 1024, swz = sb ^ (((sb >> 9) & 1) << 5); R = (st >> 1) * 16 + swz / 64; C = (st & 1) * 32 + (swz % 64) / 2; }
__host__ __device__ __forceinline__ int perm32(int rho) { const int n = rho >> 4, i = rho & 15; return 8 * (i >> 2) + 4 * n + (i & 3); }

struct Unit { int pm, pn; };
struct Gemm { const bf16_t* A; const bf16_t* Bt; int M, N, K; };

struct StaticOrder {
    int nM, nN, nwg, G, c;
    __host__ __device__ void init(int M, int N, int G_, int c_) { nM = M / BM; nN = N / BM; nwg = nM * nN; G = G_; c = c_; }
    __host__ __device__ bool next(int i, Unit& u) const {
        const long L = (long)i * G + c; if (L >= nwg) return false;
        int wgid = (int)L; { const int q = nwg / NXCD, r = nwg % NXCD, xcd = wgid % NXCD, off = wgid / NXCD; wgid = (xcd < r ? xcd * (q + 1) : r * (q + 1) + (xcd - r) * q) + off; }
        const int nig = WGM * nN, gid = wgid / nig, fm = gid * WGM, gsz = (nM - fm) < WGM ? (nM - fm) : WGM;
        u.pm = fm + ((wgid % nig) % gsz); u.pn = (wgid % nig) / gsz; return true;
    }
    __device__ __forceinline__ void a_ready(const Unit&) const {}
    __device__ __forceinline__ void done(const Unit&) const {}
};

__device__ __forceinline__ unsigned cvt_pk_bf16(float lo, float hi) { unsigned r; asm volatile("v_cvt_pk_bf16_f32 %0, %1, %2" : "=v"(r) : "v"(lo), "v"(hi)); return r; }

template <class Epi, class Sched, bool ALIGN_EPI = false, bool SP2 = false>
__device__ __forceinline__ void gemm_phase(PG8_LAS unsigned char* lds, const Gemm g, const Sched& S, const Epi& E) {
    const int tid = threadIdx.x, wid = __builtin_amdgcn_readfirstlane(tid >> 6), lane = tid & 63, wr = wid >> 2, wc = wid & 3, fr = lane & 15, fq = lane >> 4;
    const int K = g.K, nt = K / BK;
    unsigned voffA[2], voffB[2];
#pragma unroll
    for (int i = 0; i < 2; ++i) { int R, C; stage_rc(tid * 16 + i * 8192, R, C); const int Rb = Epi::PERM ? ((R & ~31) + perm32(R & 31)) : R;
        voffA[i] = (unsigned)(R * K + C) * 2u; voffB[i] = (unsigned)(Rb * K + C) * 2u; }
    const size_t kstep = (size_t)(BK * 2);
    const size_t hstep = (size_t)HALF * K * 2;
    const size_t tstep = 2 * hstep;
    const unsigned ldsw = (unsigned)wid * 1024u;
    const int aoff = lds_byte(wr * 64 + fr, fq * 8), boff = lds_byte(wc * 32 + fr, fq * 8);
#define PG8_SA(b, h) (((b) * 2 + (h)) * HTB)
#define PG8_SB(b, h) ((4 + (b) * 2 + (h)) * HTB)
#define PG8_STAGE(bufoff, gbase, voff) do { _Pragma("unroll") for (int _i = 0; _i < 2; ++_i) \
        __builtin_amdgcn_global_load_lds((const unsigned*)((const char*)(gbase) + (voff)[_i]), (PG8_LAS unsigned*)(lds + (bufoff) + ldsw + _i * 8192), 16, 0, 0); } while (0)
#define PG8_LDA(dst, b, h) do { _Pragma("unroll") for (int m = 0; m < 4; ++m) _Pragma("unroll") for (int k = 0; k < 2; ++k) dst[m][k] = *(const PG8_LAS bf16x8*)(lds + PG8_SA(b, h) + aoff + m * 2048 + k * 1024); } while (0)
#define PG8_LDB(dst, b, h) do { _Pragma("unroll") for (int n = 0; n < 2; ++n) _Pragma("unroll") for (int k = 0; k < 2; ++k) dst[n][k] = *(const PG8_LAS bf16x8*)(lds + PG8_SB(b, h) + boff + n * 2048 + k * 1024); } while (0)
#define PG8_MMA(ai, bj, At, Bt) do { __builtin_amdgcn_s_setprio(1); _Pragma("unroll") for (int m = 0; m < 4; ++m) _Pragma("unroll") for (int n = 0; n < 2; ++n) _Pragma("unroll") for (int k = 0; k < 2; ++k) \
        acc[ai][bj][m][n] = __builtin_amdgcn_mfma_f32_16x16x32_bf16(Bt[n][k], At[m][k], acc[ai][bj][m][n], 0, 0, 0); __builtin_amdgcn_s_setprio(0); } while (0)
#define PG8_WAIT_V(n) asm volatile("s_waitcnt vmcnt(" #n ")" ::: "memory")
#define PG8_WAIT_L(n) asm volatile("s_waitcnt lgkmcnt(" #n ")" ::: "memory")
#define PG8_BAR __builtin_amdgcn_s_barrier()
#define PG8_SCHED __builtin_amdgcn_sched_barrier(0)
    Unit cur, nxt; int ui = 0;
    if (!S.next(0, cur)) return;
    f32x4 acc[2][2][4][2];
#pragma unroll
    for (int a = 0; a < 2; ++a)
#pragma unroll
        for (int b = 0; b < 2; ++b)
#pragma unroll
            for (int m = 0; m < 4; ++m)
#pragma unroll
                for (int n = 0; n < 2; ++n) acc[a][b][m][n] = (f32x4){0.f, 0.f, 0.f, 0.f};
    bf16x8 At[4][2], B0[2][2], B1[2][2];
    const char* cA = (const char*)g.A + (size_t)cur.pm * tstep; const char* cB = (const char*)g.Bt + (size_t)cur.pn * tstep;
    S.a_ready(cur);
    if constexpr (SP2) {
        PG8_STAGE(PG8_SB(0, 0), cB, voffB); PG8_STAGE(PG8_SB(0, 1), cB + hstep, voffB); PG8_STAGE(PG8_SA(0, 0), cA, voffA); PG8_STAGE(PG8_SA(0, 1), cA + hstep, voffA);
        if (wr == 1) PG8_BAR;
        PG8_WAIT_V(2); PG8_BAR;
        PG8_STAGE(PG8_SB(1, 0), cB + kstep, voffB); PG8_STAGE(PG8_SA(1, 0), cA + kstep, voffA); PG8_STAGE(PG8_SB(1, 1), cB + hstep + kstep, voffB);
        PG8_WAIT_V(6); PG8_BAR;
    } else {
        PG8_STAGE(PG8_SB(0, 0), cB, voffB); PG8_STAGE(PG8_SA(0, 0), cA, voffA); PG8_STAGE(PG8_SB(0, 1), cB + hstep, voffB); PG8_STAGE(PG8_SA(0, 1), cA + hstep, voffA);
        if (wr == 1) PG8_BAR;
        PG8_WAIT_V(4); PG8_BAR;
        PG8_STAGE(PG8_SB(1, 0), cB + kstep, voffB); PG8_STAGE(PG8_SA(1, 0), cA + kstep, voffA); PG8_STAGE(PG8_SB(1, 1), cB + hstep + kstep, voffB);
        PG8_WAIT_V(6); PG8_BAR;
    }
    for (;;) {
        const bool has_next = S.next(ui + 1, nxt);
        const char* nA = has_next ? (const char*)g.A + (size_t)nxt.pm * tstep : cA; const char* nB = has_next ? (const char*)g.Bt + (size_t)nxt.pn * tstep : cB;
        for (int t = 0; t < nt; t += 2) {
            const bool last = (t == nt - 2);
            const char* a1 = cA + (size_t)(t + 1) * kstep;
            const char* a2 = last ? nA : cA + (size_t)(t + 2) * kstep; const char* b2 = last ? nB : cB + (size_t)(t + 2) * kstep;
            const char* a3 = a2 + kstep; const char* b3 = b2 + kstep;
            if (last && has_next) S.a_ready(nxt);
            if constexpr (SP2) {
            PG8_LDB(B0, 0, 0); PG8_LDB(B1, 0, 1); PG8_SCHED; PG8_LDA(At, 0, 0); PG8_STAGE(PG8_SA(1, 1), a1 + hstep, voffA);
            PG8_WAIT_V(8); PG8_WAIT_L(0); PG8_BAR; PG8_MMA(0, 0, At, B0); PG8_MMA(0, 1, At, B1); PG8_BAR; PG8_SCHED;
            PG8_LDA(At, 0, 1); PG8_STAGE(PG8_SB(0, 0), b2, voffB); PG8_STAGE(PG8_SB(0, 1), b2 + hstep, voffB); PG8_STAGE(PG8_SA(0, 0), a2, voffA);
            PG8_WAIT_V(8); PG8_WAIT_L(0); PG8_BAR; PG8_MMA(1, 0, At, B0); PG8_MMA(1, 1, At, B1); PG8_BAR; PG8_SCHED;
            PG8_LDB(B0, 1, 0); PG8_LDB(B1, 1, 1); PG8_SCHED; PG8_LDA(At, 1, 0); PG8_STAGE(PG8_SA(0, 1), a2 + hstep, voffA);
            PG8_WAIT_V(8); PG8_WAIT_L(0); PG8_BAR; PG8_MMA(0, 0, At, B0); PG8_MMA(0, 1, At, B1); PG8_BAR; PG8_SCHED;
            PG8_LDA(At, 1, 1); PG8_STAGE(PG8_SB(1, 0), b3, voffB); PG8_STAGE(PG8_SB(1, 1), b3 + hstep, voffB); PG8_STAGE(PG8_SA(1, 0), a3, voffA);
            PG8_WAIT_V(8); PG8_WAIT_L(0); PG8_BAR; PG8_MMA(1, 0, At, B0); PG8_MMA(1, 1, At, B1); PG8_BAR; PG8_SCHED;
            } else {
            PG8_LDB(B0, 0, 0); PG8_SCHED; PG8_LDA(At, 0, 0); PG8_STAGE(PG8_SA(1, 1), a1 + hstep, voffA);
            PG8_WAIT_L(8); PG8_BAR; PG8_WAIT_L(0); PG8_MMA(0, 0, At, B0); PG8_BAR; PG8_SCHED;
            PG8_LDB(B1, 0, 1); PG8_STAGE(PG8_SB(0, 0), b2, voffB);
            PG8_BAR; PG8_WAIT_L(0); PG8_MMA(0, 1, At, B1); PG8_BAR;
            PG8_LDA(At, 0, 1); PG8_STAGE(PG8_SA(0, 0), a2, voffA);
            PG8_BAR; PG8_WAIT_L(0); PG8_MMA(1, 0, At, B0); PG8_BAR; PG8_SCHED;
            PG8_STAGE(PG8_SB(0, 1), b2 + hstep, voffB);
            PG8_WAIT_V(6); PG8_BAR; PG8_MMA(1, 1, At, B1); PG8_BAR;
            PG8_LDB(B0, 1, 0); PG8_SCHED; PG8_LDA(At, 1, 0); PG8_STAGE(PG8_SA(0, 1), a2 + hstep, voffA);
            PG8_WAIT_L(8); PG8_BAR; PG8_WAIT_L(0); PG8_MMA(0, 0, At, B0); PG8_BAR; PG8_SCHED;
            PG8_LDB(B1, 1, 1); PG8_STAGE(PG8_SB(1, 0), b3, voffB);
            PG8_BAR; PG8_WAIT_L(0); PG8_MMA(0, 1, At, B1); PG8_BAR;
            PG8_LDA(At, 1, 1); PG8_STAGE(PG8_SA(1, 0), a3, voffA);
            PG8_BAR; PG8_WAIT_L(0); PG8_MMA(1, 0, At, B0); PG8_BAR; PG8_SCHED;
            PG8_STAGE(PG8_SB(1, 1), b3 + hstep, voffB);
            PG8_WAIT_V(6); PG8_BAR; PG8_MMA(1, 1, At, B1); PG8_BAR;
            }
        }
        if constexpr (ALIGN_EPI) { if (wr == 0) PG8_BAR; }
        E(acc, cur, wr, wc, fr, fq); S.done(cur);
        if (!has_next) break;
#pragma unroll
        for (int a = 0; a < 2; ++a)
#pragma unroll
            for (int b = 0; b < 2; ++b)
#pragma unroll
                for (int m = 0; m < 4; ++m)
#pragma unroll
                    for (int n = 0; n < 2; ++n) acc[a][b][m][n] = (f32x4){0.f, 0.f, 0.f, 0.f};
        cur = nxt; cA = nA; cB = nB; ++ui;
        if constexpr (ALIGN_EPI) { if (wr == 1) PG8_BAR; }
    }
    PG8_WAIT_V(0);
    if constexpr (!ALIGN_EPI) { if (wr == 0) PG8_BAR; }
    PG8_BAR;
#undef PG8_SA
#undef PG8_SB
#undef PG8_STAGE
#undef PG8_LDA
#undef PG8_LDB
#undef PG8_MMA
#undef PG8_WAIT_V
#undef PG8_WAIT_L
#undef PG8_BAR
#undef PG8_SCHED
}
}

constexpr int NWAVES = 8;
constexpr int DM = 1024, BP = 8, SEQ = 2048, NMETA = 16, TP = SEQ + NMETA, BS = 128, TS = 4;
constexpr int RP = BP * TP;
constexpr int RS = BS * TS;
constexpr int MR = RP + RS;
constexpr int MP = 17152;
constexpr int M2 = BP * SEQ + RS;
constexpr int NH = 8, DH = 128, DQKV = 3072, DFF = 4096, KC = 31, KS = 4;
constexpr int NIN = 8448;
constexpr int DIN = 8208;
constexpr float EPS = 1e-6f;

constexpr size_t O_YP = 0, O_YS = 16777216, O_PC = 17301504, O_PQ = 17547264, O_PD = 17620992, O_SC = 18669568, O_SQ = 22601728, O_SD = 23781376, O_END = 40558592;

constexpr size_t MiB = 1u << 20;
constexpr size_t WS_CTL = 0, CTL_ZERO_BYTES = 1 * MiB;
constexpr size_t WS_BETAG = 1 * MiB;
constexpr size_t WS_WC = 8 * MiB, WS_WD = 10 * MiB, WS_WO = 12 * MiB, WS_WUP = 14 * MiB, WS_WDN = 22 * MiB;
constexpr size_t WS_GLU = 30 * MiB;
constexpr size_t WS_QKV = 64 * MiB;
constexpr size_t WS_ZS = 165 * MiB;
constexpr size_t WS_H = 199 * MiB;
constexpr size_t WS_WIN = 233 * MiB;
constexpr size_t WS_MIX = WS_GLU, WS_XG = WS_QKV, WS_HM = 100 * MiB, WS_C = WS_H;
constexpr size_t WS_END = 256 * MiB;
static_assert(WS_WIN + (size_t)NIN * DM * 2 <= WS_END, "ws map");
static_assert(WS_HM + (size_t)M2 * DFF * 2 <= 233 * MiB, "ws map hm");
constexpr int CW_TMO = 0, CW_CODE = 1, CW_BAR = 4096;

constexpr int RING_OFF = 0, RING_BYTES = 131072;
constexpr int LDSCTL_OFF = RING_BYTES, MISC_OFF = LDSCTL_OFF + 320;
constexpr int LDS_BYTES = 147456;

#define GAS __attribute__((address_space(1)))
#define LAS __attribute__((address_space(3)))
typedef unsigned short bf16;
typedef unsigned v4u __attribute__((ext_vector_type(4)));
typedef unsigned v2u __attribute__((ext_vector_type(2)));
typedef float f32x4 __attribute__((ext_vector_type(4)));
typedef float f32x2 __attribute__((ext_vector_type(2)));
typedef GAS unsigned gu32;
#define RLX_AGENT __ATOMIC_RELAXED, __HIP_MEMORY_SCOPE_AGENT
#define LDS_WAIT() asm volatile("s_waitcnt lgkmcnt(0)" ::: "memory")
#define VM_WAIT() asm volatile("s_waitcnt vmcnt(0)" ::: "memory")
__device__ __forceinline__ unsigned f2bf(float f) { unsigned u = __builtin_bit_cast(unsigned, f); return (u + 0x7fffu + ((u >> 16) & 1u)) >> 16; }
__device__ __forceinline__ unsigned pk2(float lo, float hi) { return f2bf(lo) | (f2bf(hi) << 16); }
__device__ __forceinline__ float bflo(unsigned w) { return __builtin_bit_cast(float, w << 16); }
__device__ __forceinline__ float bfhi(unsigned w) { return __builtin_bit_cast(float, w & 0xffff0000u); }
__device__ __forceinline__ float bf1(bf16 b) { return __builtin_bit_cast(float, ((unsigned)b) << 16); }
__device__ __forceinline__ float sigmoidf_(float x) { return __builtin_amdgcn_rcpf(1.f + __expf(-x)); }
__device__ __forceinline__ float siluf_(float x) { return x * sigmoidf_(x); }

#define XB_TMO      128
#define XB_XCNT(j)  (256  + 64 * (j))
#define XB_XSUB(j)  (1280 + 64 * (j))
#define XB_XGEN(j)  (2304 + 64 * (j))
#define XB_TOP      3328
#define XB_TOPGEN   3392
#define XCD_BAR_WORDS 3456
#define XB_SPIN_CAP (1u << 18)
__device__ __forceinline__ unsigned xb_ld(unsigned* p)              { return __hip_atomic_load(p, __ATOMIC_RELAXED, __HIP_MEMORY_SCOPE_AGENT); }
__device__ __forceinline__ unsigned xb_add(unsigned* p, unsigned v) { return __hip_atomic_fetch_add(p, v, __ATOMIC_RELAXED, __HIP_MEMORY_SCOPE_AGENT); }
__device__ __forceinline__ unsigned xb_xcc_id() { return (unsigned)__builtin_amdgcn_s_getreg((3 << 11) | 20) & 0xFu; }
#define XB_SPIN(cond, bar) do { unsigned _sp = 0; while (cond) { __builtin_amdgcn_s_sleep(1); \
    if ((++_sp & 255u) == 0u) { if (xb_ld(&(bar)[XB_TMO])) break; if (_sp > XB_SPIN_CAP) { atomicAdd(&(bar)[XB_TMO], 1u); break; } } } } while (0)
struct XcdBarrier { unsigned* bar; unsigned x; volatile LAS unsigned* st; };
__device__ __forceinline__ XcdBarrier xcd_barrier_post(unsigned* bar, volatile LAS unsigned* st) {
    XcdBarrier b; b.bar = bar; b.x = xb_xcc_id(); b.st = st;
    if (threadIdx.x == 0) (void)xb_add(&bar[XB_XCNT(b.x)], 1u);
    return b;
}
__device__ __forceinline__ void xcd_barrier_complete(unsigned* bar, unsigned x, unsigned& nloc, unsigned& nx) {
    const unsigned G = gridDim.x * gridDim.y * gridDim.z;
    unsigned sum, cnt, mine, sp = 0u;
    for (;;) {
        sum = 0u; cnt = 0u; mine = 0u;
#pragma unroll
        for (unsigned j = 0; j < 16; ++j) { const unsigned c = xb_ld(&bar[XB_XCNT(j)]); sum += c; cnt += (c > 0u) ? 1u : 0u; mine = (j == x) ? c : mine; }
        if (sum == G) break;
        __builtin_amdgcn_s_sleep(1);
        if ((++sp & 255u) == 0u) { if (xb_ld(&bar[XB_TMO])) break; if (sp > XB_SPIN_CAP) { atomicAdd(&bar[XB_TMO], 1u); break; } }
    }
    nloc = mine > 0u ? mine : 1u; nx = cnt > 0u ? cnt : 1u;
}
__device__ __forceinline__ void xcd_barrier(const XcdBarrier& b) {
    asm volatile("s_waitcnt vmcnt(0)" ::: "memory");
    __syncthreads();
    if (threadIdx.x == 0) {
        unsigned* bar = b.bar;
        __builtin_amdgcn_s_waitcnt(0);
        unsigned nloc = b.st[0], nx = b.st[1];
        if (nloc == 0u) { xcd_barrier_complete(bar, b.x, nloc, nx); b.st[0] = nloc; b.st[1] = nx; }
        const unsigned old = xb_add(&bar[XB_XSUB(b.x)], 1u);
        const unsigned gen = old / nloc;
        if (old + 1u == (gen + 1u) * nloc) {
            __builtin_amdgcn_fence(__ATOMIC_RELEASE, "agent");
            asm volatile("s_waitcnt vmcnt(0)" ::: "memory");
            const unsigned og = xb_add(&bar[XB_TOP], 1u);
            const unsigned tg = og / nx;
            if (og + 1u == (tg + 1u) * nx) xb_add(&bar[XB_TOPGEN], 1u);
            else XB_SPIN(xb_ld(&bar[XB_TOPGEN]) == tg, bar);
            __builtin_amdgcn_fence(__ATOMIC_ACQUIRE, "agent");
            xb_add(&bar[XB_XGEN(b.x)], 1u);
            asm volatile("s_waitcnt vmcnt(0)" ::: "memory");
        } else {
            XB_SPIN(xb_ld(&bar[XB_XGEN(b.x)]) == gen, bar);
            __builtin_amdgcn_fence(__ATOMIC_ACQUIRE, "agent");
            asm volatile("s_waitcnt vmcnt(0)" ::: "memory");
        }
    }
    __syncthreads();
}

struct Args { const float* in[23]; float* out; unsigned char* ws; int ph_lo, ph_hi; };

__device__ __forceinline__ float wave_sum(float v) {
#pragma unroll
    for (int o = 1; o < 64; o <<= 1) v += __shfl_xor(v, o);
    return v;
}
__device__ __forceinline__ int compact_row(int r) {
    if (r >= MR) return -1;
    if (r >= RP) return r - RP + BP * SEQ;
    const int b = r / TP, t = r - b * TP;
    return t < NMETA ? -1 : r - NMETA * (b + 1);
}

__device__ __forceinline__ void p0_transpose_item(const float* W, int Nsrc, int K, bf16* WT, int dst_row0, int src_col0, int nvalid, LAS float* scr, int kb, int lane) {
    const int k0 = 64 * kb, cidx = lane & 31;
#pragma unroll 8
    for (int i = 0; i < 32; ++i) { const int kk = 2 * i + (lane >> 5); float v = 0.f; if (cidx < nvalid) v = W[(size_t)(k0 + kk) * Nsrc + src_col0 + cidx]; scr[kk * 33 + cidx] = v; }
    LDS_WAIT(); asm volatile("" ::: "memory");
    const int c = lane & 7;
#pragma unroll
    for (int j = 0; j < 4; ++j) { const int n = (lane >> 3) + 8 * j; const LAS float* s = scr + (8 * c) * 33 + n;
        v4u o; o.x = pk2(s[0 * 33], s[1 * 33]); o.y = pk2(s[2 * 33], s[3 * 33]); o.z = pk2(s[4 * 33], s[5 * 33]); o.w = pk2(s[6 * 33], s[7 * 33]);
        *(GAS v4u*)(WT + (size_t)(dst_row0 + n) * K + k0 + 8 * c) = o; }
    LDS_WAIT(); asm volatile("" ::: "memory");
}
__device__ __forceinline__ void win_src(int nb, int& src, int& nvalid) {
    const int pn = nb >> 3, o = (nb & 7) * 32; nvalid = 32;
    if (pn < 8) src = (o < 128) ? 128 * pn + o : 1024 + 128 * pn + (o - 128);
    else if (pn < 20) src = 2048 + 256 * (pn - 8) + o;
    else if (pn < 24) src = 5120 + 256 * (pn - 20) + o;
    else if (pn < 28) src = 6160 + 256 * (pn - 24) + o;
    else if (pn < 32) src = 7184 + 256 * (pn - 28) + o;
    else { src = 6144; nvalid = (o == 0) ? 16 : 0; }
}
__device__ __forceinline__ void rms_row_to_bf16(const float* xrow, const float* gain, bf16* orow, int lane) {
    const GAS f32x4* xr = (const GAS f32x4*)xrow + lane; const GAS f32x4* gr = (const GAS f32x4*)gain + lane;
    f32x4 v[4]; float s = 0.f;
#pragma unroll
    for (int j = 0; j < 4; ++j) { v[j] = xr[64 * j]; s += (v[j].x * v[j].x + v[j].y * v[j].y) + (v[j].z * v[j].z + v[j].w * v[j].w); }
    const float rstd = 1.f / sqrtf(wave_sum(s) * (1.f / DM) + EPS);
    GAS unsigned long long* o8 = (GAS unsigned long long*)orow + lane;
#pragma unroll
    for (int j = 0; j < 4; ++j) { const f32x4 g = gr[64 * j]; o8[64 * j] = (unsigned long long)pk2(v[j].x * rstd * g.x, v[j].y * rstd * g.y) | ((unsigned long long)pk2(v[j].z * rstd * g.z, v[j].w * rstd * g.w) << 32); }
}

typedef pg8::f32x4 A4;
struct EpiIn {
    static constexpr bool PERM = true;
    bf16 *GLU, *QKV, *ZS, *SGC, *SGD; float* BETAG; const float *a_log, *dt_bias;
    __device__ __forceinline__ void operator()(const A4 (&acc)[2][2][4][2], const pg8::Unit& u, int wr, int wc, int fr, int fq) const {
        const int pn = u.pn, row0 = u.pm * 256 + wr * 64 + fr, cw = 32 * wc + 8 * fq;
        if (pn < 8) {
#pragma unroll
            for (int ai = 0; ai < 2; ++ai)
#pragma unroll
                for (int m = 0; m < 4; ++m) { const int r = row0 + ai * 128 + m * 16; float o[8];
#pragma unroll
                    for (int n = 0; n < 2; ++n)
#pragma unroll
                        for (int j = 0; j < 4; ++j) o[4 * n + j] = acc[ai][0][m][n][j] * sigmoidf_(acc[ai][1][m][n][j]);
                    v4u w; w.x = pk2(o[0], o[1]); w.y = pk2(o[2], o[3]); w.z = pk2(o[4], o[5]); w.w = pk2(o[6], o[7]);
                    *(GAS v4u*)(GLU + (size_t)r * DM + 128 * pn + cw) = w; }
        } else if (pn < 24) {
            const bool isz = pn >= 20; bf16* dst = isz ? ZS : QKV; const int ld = isz ? DM : DQKV, cb = isz ? 256 * (pn - 20) : 256 * (pn - 8);
#pragma unroll
            for (int ai = 0; ai < 2; ++ai)
#pragma unroll
                for (int m = 0; m < 4; ++m) { const int r = row0 + ai * 128 + m * 16;
#pragma unroll
                    for (int bj = 0; bj < 2; ++bj) { float o[8];
#pragma unroll
                        for (int n = 0; n < 2; ++n)
#pragma unroll
                            for (int j = 0; j < 4; ++j) { const float v = acc[ai][bj][m][n][j]; o[4 * n + j] = isz ? siluf_(v) : v; }
                        v4u w; w.x = pk2(o[0], o[1]); w.y = pk2(o[2], o[3]); w.z = pk2(o[4], o[5]); w.w = pk2(o[6], o[7]);
                        *(GAS v4u*)(dst + (size_t)r * ld + cb + 128 * bj + cw) = w; } }
        } else if (pn < 32) {
            bf16* dst = pn < 28 ? SGC : SGD; const int cb = 256 * ((pn - 24) & 3);
#pragma unroll
            for (int ai = 0; ai < 2; ++ai)
#pragma unroll
                for (int m = 0; m < 4; ++m) { const int rc = compact_row(row0 + ai * 128 + m * 16); if (rc < 0) continue;
#pragma unroll
                    for (int bj = 0; bj < 2; ++bj) { float o[8];
#pragma unroll
                        for (int n = 0; n < 2; ++n)
#pragma unroll
                            for (int j = 0; j < 4; ++j) o[4 * n + j] = sigmoidf_(acc[ai][bj][m][n][j]);
                        v4u w; w.x = pk2(o[0], o[1]); w.y = pk2(o[2], o[3]); w.z = pk2(o[4], o[5]); w.w = pk2(o[6], o[7]);
                        *(GAS v4u*)(dst + (size_t)rc * DM + cb + 128 * bj + cw) = w; } }
        } else {
            if (wc == 0 && fq < 2) {
#pragma unroll
                for (int ai = 0; ai < 2; ++ai)
#pragma unroll
                    for (int m = 0; m < 4; ++m) { const int r = row0 + ai * 128 + m * 16; float o[8];
#pragma unroll
                        for (int n = 0; n < 2; ++n)
#pragma unroll
                            for (int j = 0; j < 4; ++j) { const int h = 4 * n + j; const float v = acc[ai][0][m][n][j];
                                if (fq == 0) o[h] = 1.f / (1.f + expf(-v));
                                else { const float xx = v + dt_bias[h]; const float sp = xx > 20.f ? xx : log1pf(expf(xx)); o[h] = -expf(a_log[h]) * sp; } }
                        GAS f32x4* p = (GAS f32x4*)(BETAG + (size_t)r * 16 + 8 * fq);
                        p[0] = (f32x4){o[0], o[1], o[2], o[3]}; p[1] = (f32x4){o[4], o[5], o[6], o[7]}; }
            }
        }
    }
};
template <int MODE> struct EpiGate {
    static constexpr bool PERM = true;
    bf16 *SG, *MA, *OUT;
    __device__ __forceinline__ void operator()(const A4 (&acc)[2][2][4][2], const pg8::Unit& u, int wr, int wc, int fr, int fq) const {
        const int row0 = u.pm * 256 + wr * 64 + fr, c0 = 256 * u.pn + 32 * wc + 8 * fq;
#pragma unroll
        for (int ai = 0; ai < 2; ++ai)
#pragma unroll
            for (int m = 0; m < 4; ++m) { const int rc = compact_row(row0 + ai * 128 + m * 16); if (rc < 0) continue;
#pragma unroll
                for (int bj = 0; bj < 2; ++bj) { const size_t off = (size_t)rc * DM + c0 + 128 * bj;
                    const v4u g = *(const GAS v4u*)(SG + off); float o[8];
                    const A4 a0 = acc[ai][bj][m][0], a1 = acc[ai][bj][m][1];
                    o[0] = bflo(g.x) * a0[0]; o[1] = bfhi(g.x) * a0[1]; o[2] = bflo(g.y) * a0[2]; o[3] = bfhi(g.y) * a0[3];
                    o[4] = bflo(g.z) * a1[0]; o[5] = bfhi(g.z) * a1[1]; o[6] = bflo(g.w) * a1[2]; o[7] = bfhi(g.w) * a1[3];
                    if (MODE == 1) { const v4u q = *(const GAS v4u*)(MA + off);
                        o[0] += bflo(q.x); o[1] += bfhi(q.x); o[2] += bflo(q.y); o[3] += bfhi(q.y); o[4] += bflo(q.z); o[5] += bfhi(q.z); o[6] += bflo(q.w); o[7] += bfhi(q.w); }
                    v4u w; w.x = pk2(o[0], o[1]); w.y = pk2(o[2], o[3]); w.z = pk2(o[4], o[5]); w.w = pk2(o[6], o[7]);
                    *(GAS v4u*)(OUT + off) = w; } }
    }
};
template <int MODE> struct EpiRes {
    static constexpr bool PERM = false;
    const float *xp, *xs; float* out;
    __device__ __forceinline__ void operator()(const A4 (&acc)[2][2][4][2], const pg8::Unit& u, int wr, int wc, int fr, int fq) const {
        const int row0 = u.pm * 256 + wr * 64 + fr, c0 = 256 * u.pn + 32 * wc + 4 * fq;
#pragma unroll
        for (int ai = 0; ai < 2; ++ai)
#pragma unroll
            for (int m = 0; m < 4; ++m) { const int r = row0 + ai * 128 + m * 16;
                const float* base = MODE == 0 ? (r < BP * SEQ ? xp + (size_t)r * DM : xs + (size_t)(r - BP * SEQ) * DM) : out + (size_t)r * DM;
                float* orow = out + (size_t)r * DM;
#pragma unroll
                for (int bj = 0; bj < 2; ++bj)
#pragma unroll
                    for (int n = 0; n < 2; ++n) { const int c = c0 + 128 * bj + 16 * n; const f32x4 b = *(const GAS f32x4*)(base + c); *(GAS f32x4*)(orow + c) = b + acc[ai][bj][m][n]; } }
    }
};
struct EpiUp {
    static constexpr bool PERM = true;
    bf16* HM;
    __device__ __forceinline__ void operator()(const A4 (&acc)[2][2][4][2], const pg8::Unit& u, int wr, int wc, int fr, int fq) const {
        const int row0 = u.pm * 256 + wr * 64 + fr, c0 = 256 * u.pn + 32 * wc + 8 * fq;
#pragma unroll
        for (int ai = 0; ai < 2; ++ai)
#pragma unroll
            for (int m = 0; m < 4; ++m) { const int r = row0 + ai * 128 + m * 16;
#pragma unroll
                for (int bj = 0; bj < 2; ++bj) { float o[8];
#pragma unroll
                    for (int n = 0; n < 2; ++n)
#pragma unroll
                        for (int j = 0; j < 4; ++j) { const float v = fmaxf(acc[ai][bj][m][n][j], 0.f); o[4 * n + j] = v * v; }
                    v4u w; w.x = pk2(o[0], o[1]); w.y = pk2(o[2], o[3]); w.z = pk2(o[4], o[5]); w.w = pk2(o[6], o[7]);
                    *(GAS v4u*)(HM + (size_t)r * DFF + c0 + 128 * bj) = w; } }
    }
};

__device__ __forceinline__ void conv_unit(const Args& a, LAS unsigned char* lds, int kind, int b, int run) {
    asm volatile("" ::: "memory");
    const int tid = threadIdx.x, lane = tid & 63, wave = tid >> 6; int ch = 2 * tid; asm volatile("" : "+v"(ch));
    const unsigned char* ws = a.ws;
    const bf16* GLU = (const bf16*)(ws + WS_GLU); bf16* C = (bf16*)(a.ws + WS_C);
    const float* w_dw = a.in[8];
    LAS float* red = (LAS float*)lds;
    f32x2 w[KC]; unsigned win[KC];
#pragma unroll
    for (int i = 0; i < KC; ++i) w[i] = *(const GAS f32x2*)(w_dw + (size_t)i * DM + ch);
    const f32x2 bdw = *(const GAS f32x2*)(a.in[9] + ch), lng = *(const GAS f32x2*)(a.in[10] + ch), lnb = *(const GAS f32x2*)(a.in[11] + ch);
    int row0, ntok; bool last_run;
    win[0] = 0u;
    if (kind == 0) { constexpr int RUN = TP / 8; row0 = b * TP + run * RUN; ntok = RUN; last_run = (run == 7);
#pragma unroll
        for (int i = 1; i < KC; ++i) { if (run == 0) win[i] = 0u; else win[i] = *(const GAS unsigned*)(GLU + (size_t)(row0 - KC + i) * DM + ch); }
    } else { row0 = RP + b * TS; ntok = TS; last_run = true;
        const float* st = a.in[2] + (size_t)b * (KC - 1) * DM;
#pragma unroll
        for (int i = 1; i < KC; ++i) { const f32x2 v = *(const GAS f32x2*)(st + (size_t)(i - 1) * DM + ch); win[i] = pk2(v.x, v.y); }
    }
    for (int t = 0; t < ntok; ++t) {
        const unsigned v = *(const GAS unsigned*)(GLU + (size_t)(row0 + t) * DM + ch);
#pragma unroll
        for (int i = 0; i < KC - 1; ++i) win[i] = win[i + 1];
        win[KC - 1] = v;
        float y0 = bdw.x, y1 = bdw.y;
#pragma unroll
        for (int i = 0; i < KC; ++i) { y0 += w[i].x * bflo(win[i]); y1 += w[i].y * bfhi(win[i]); }
        float s1 = wave_sum(y0 + y1), s2 = wave_sum(y0 * y0 + y1 * y1);
        LAS float* rb = red + (t & 1) * 16;
        if (lane == 0) { rb[wave * 2] = s1; rb[wave * 2 + 1] = s2; }
        __syncthreads();
        float t1 = 0.f, t2 = 0.f;
#pragma unroll
        for (int i = 0; i < 8; ++i) { t1 += rb[2 * i]; t2 += rb[2 * i + 1]; }
        const float mu = t1 * (1.f / DM), var = fmaxf(t2 * (1.f / DM) - mu * mu, 0.f), rstd = 1.f / sqrtf(var + EPS);
        const float z0 = (y0 - mu) * rstd * lng.x + lnb.x, z1 = (y1 - mu) * rstd * lng.y + lnb.y;
        *(GAS unsigned*)(C + (size_t)(row0 + t) * DM + ch) = pk2(siluf_(z0), siluf_(z1));
    }
    if (last_run) { float* o = a.out + (kind == 0 ? O_PC : O_SC) + (size_t)b * (KC - 1) * DM;
        if (kind == 0) {
#pragma unroll
            for (int i = 1; i < KC; ++i) *(GAS f32x2*)(o + (size_t)(i - 1) * DM + ch) = (f32x2){bflo(win[i]), bfhi(win[i])};
        } else {
            const float* st = a.in[2] + (size_t)b * (KC - 1) * DM;
#pragma unroll
            for (int i = 0; i < KC - 1 - TS; ++i) *(GAS f32x2*)(o + (size_t)i * DM + ch) = *(const GAS f32x2*)(st + (size_t)(i + TS) * DM + ch);
#pragma unroll
            for (int i = KC - TS; i < KC; ++i) *(GAS f32x2*)(o + (size_t)(i - 1) * DM + ch) = (f32x2){bflo(win[i]), bfhi(win[i])};
        }
    }
    __syncthreads();
}

__device__ __forceinline__ void delta_item(const Args& a, LAS unsigned char* lds, int item, bool sample) {
    asm volatile("" ::: "memory");
    const int tid = threadIdx.x, lane = tid & 63, sub = tid >> 7, wu = (tid >> 6) & 1; int j = tid & 127; asm volatile("" : "+v"(j));
    const int unit = item * 4 + sub, b = unit >> 3, h = unit & 7;
    const int T = sample ? TS : TP, row0 = sample ? RP + b * TS : b * TP;
    const bf16* QKV = (const bf16*)(a.ws + WS_QKV); bf16* ZS = (bf16*)(a.ws + WS_ZS); const float* BETAG = (const float*)(a.ws + WS_BETAG);
    LAS float* kq = (LAS float*)lds + sub * 256;
    LAS float* red = (LAS float*)lds + 1024 + sub * 4;
    LAS float* red2 = (LAS float*)lds + 1024 + 16 + sub * 2;
    float S[DH];
    if (sample) { const float* s0 = a.in[4] + ((size_t)(b * NH + h) * DH) * DH + j;
#pragma unroll
        for (int d = 0; d < DH; ++d) S[d] = s0[(size_t)d * DH];
    } else {
#pragma unroll
        for (int d = 0; d < DH; ++d) S[d] = 0.f;
    }
    const int cq = h * DH + j, ck = DM + cq, cv = 2 * DM + cq;
    float wq[KS], wk[KS], wv[KS];
#pragma unroll
    for (int i = 0; i < KS; ++i) { wq[i] = a.in[13][i * DQKV + cq]; wk[i] = a.in[13][i * DQKV + ck]; wv[i] = a.in[13][i * DQKV + cv]; }
    float hq[3], hk[3], hv[3];
#pragma unroll
    for (int i = 0; i < 3; ++i) { if (sample) { const float* st = a.in[3] + ((size_t)b * 3 + i) * DQKV; hq[i] = st[cq]; hk[i] = st[ck]; hv[i] = st[cv]; } else { hq[i] = 0.f; hk[i] = 0.f; hv[i] = 0.f; } }
    const float gh = a.in[16][j];
    for (int t = 0; t < T; ++t) {
        const size_t row = (size_t)(row0 + t);
        const float qp = bf1(QKV[row * DQKV + cq]), kp = bf1(QKV[row * DQKV + ck]), vp = bf1(QKV[row * DQKV + cv]);
        const float qc = siluf_(wq[0] * hq[0] + wq[1] * hq[1] + wq[2] * hq[2] + wq[3] * qp);
        const float kc = siluf_(wk[0] * hk[0] + wk[1] * hk[1] + wk[2] * hk[2] + wk[3] * kp);
        const float vc = siluf_(wv[0] * hv[0] + wv[1] * hv[1] + wv[2] * hv[2] + wv[3] * vp);
        hq[0] = hq[1]; hq[1] = hq[2]; hq[2] = qp; hk[0] = hk[1]; hk[1] = hk[2]; hk[2] = kp; hv[0] = hv[1]; hv[1] = hv[2]; hv[2] = vp;
        const float sq = wave_sum(qc * qc), sk = wave_sum(kc * kc);
        kq[j] = kc; kq[128 + j] = qc;
        if (lane == 0) { red[wu * 2] = sq; red[wu * 2 + 1] = sk; }
        const float beta = BETAG[row * 16 + h], gg = BETAG[row * 16 + 8 + h];
        const float zs = bf1(ZS[row * DM + cq]);
        __syncthreads();
        const float nq = (1.f / sqrtf(red[0] + red[2] + 1e-6f)) * 0.08838834764831845f, nk = 1.f / sqrtf(red[1] + red[3] + 1e-6f);
        const float alpha = expf(gg);
        float ks0 = 0.f, ks1 = 0.f, ks2 = 0.f, ks3 = 0.f;
#pragma unroll
        for (int d = 0; d < DH; d += 4) { const f32x4 kk = *(const LAS f32x4*)(kq + d); ks0 += kk.x * S[d]; ks1 += kk.y * S[d + 1]; ks2 += kk.z * S[d + 2]; ks3 += kk.w * S[d + 3];
            if ((d & 31) == 28) asm volatile("" ::: "memory"); }
        const float kS = (ks0 + ks1) + (ks2 + ks3);
        const float u = beta * (vc - alpha * nk * kS), un = nk * u;
        float o0 = 0.f, o1 = 0.f, o2 = 0.f, o3 = 0.f;
#pragma unroll
        for (int d = 0; d < DH; d += 4) { const f32x4 kk = *(const LAS f32x4*)(kq + d); const f32x4 qq = *(const LAS f32x4*)(kq + 128 + d);
            S[d] = alpha * S[d] + kk.x * un; S[d + 1] = alpha * S[d + 1] + kk.y * un; S[d + 2] = alpha * S[d + 2] + kk.z * un; S[d + 3] = alpha * S[d + 3] + kk.w * un;
            o0 += qq.x * S[d]; o1 += qq.y * S[d + 1]; o2 += qq.z * S[d + 2]; o3 += qq.w * S[d + 3];
            if ((d & 15) == 12) asm volatile("" ::: "memory"); }
        const float o = ((o0 + o1) + (o2 + o3)) * nq;
        const float so = wave_sum(o * o);
        if (lane == 0) red2[wu] = so;
        __syncthreads();
        const float rms = 1.f / sqrtf((red2[0] + red2[1]) * (1.f / DH) + EPS);
        ZS[row * DM + cq] = (bf16)f2bf(o * rms * gh * zs);
    }
    { float* so = a.out + (sample ? O_SD : O_PD) + ((size_t)(b * NH + h) * DH) * DH + j;
#pragma unroll
        for (int d = 0; d < DH; ++d) so[(size_t)d * DH] = S[d];
      float* qo = a.out + (sample ? O_SQ : O_PQ) + (size_t)b * 3 * DQKV;
#pragma unroll
        for (int i = 0; i < 3; ++i) { qo[i * DQKV + cq] = hq[i]; qo[i * DQKV + ck] = hk[i]; qo[i * DQKV + cv] = hv[i]; }
    }
    __syncthreads();
}

constexpr int NPHASES = 10;
__global__ void __launch_bounds__(NWAVES * 64, 2) fwd_kernel(Args args) {
    extern __shared__ __attribute__((aligned(16))) unsigned char lds_raw[];
    LAS unsigned char* lds = (LAS unsigned char*)lds_raw;
    volatile LAS unsigned* MISC = (volatile LAS unsigned*)(lds + MISC_OFF);
    const int tid = threadIdx.x, lane = tid & 63, wave = __builtin_amdgcn_readfirstlane(tid >> 6);
    const int G = gridDim.x, bx = blockIdx.x;
    const int vcu = (G % 8 == 0) ? (bx % 8) * (G / 8) + bx / 8 : bx;
    unsigned char* ws = args.ws;
    gu32* ctl = (gu32*)(ws + WS_CTL);
    for (int u = tid; u < (LDS_BYTES - LDSCTL_OFF) / 4; u += NWAVES * 64) ((LAS unsigned*)(lds + LDSCTL_OFF))[u] = 0u;
    __syncthreads();
    XcdBarrier bar; bar.bar = (unsigned*)(ctl + CW_BAR); bar.x = 0; bar.st = nullptr;
    const int lo = args.ph_lo, hi = args.ph_hi;
    if (hi - lo > 1) bar = xcd_barrier_post((unsigned*)(ctl + CW_BAR), MISC + 8);
#ifndef PH_MASK
#define PH_MASK 0x3ff
#endif
#define IN(k) (((PH_MASK >> (k)) & 1) && lo <= (k) && (k) < hi)
#define SEAM(k) do { if (IN(k) && IN((k) + 1)) xcd_barrier(bar); } while (0)
    bf16* WIN = (bf16*)(ws + WS_WIN); bf16* WC = (bf16*)(ws + WS_WC); bf16* WD = (bf16*)(ws + WS_WD); bf16* WO = (bf16*)(ws + WS_WO); bf16* WUP = (bf16*)(ws + WS_WUP); bf16* WDN = (bf16*)(ws + WS_WDN);
    bf16* H = (bf16*)(ws + WS_H); bf16* GLU = (bf16*)(ws + WS_GLU); bf16* QKV = (bf16*)(ws + WS_QKV); bf16* ZS = (bf16*)(ws + WS_ZS);
    bf16* SGC = (bf16*)args.out; bf16* SGD = (bf16*)args.out + (size_t)M2 * DM;
    bf16* MIX = (bf16*)(ws + WS_MIX); bf16* XG = (bf16*)(ws + WS_XG); bf16* HM = (bf16*)(ws + WS_HM); bf16* C = (bf16*)(ws + WS_C);
    float* BETAG = (float*)(ws + WS_BETAG);
    const int gw = vcu * NWAVES + wave, NGW = G * NWAVES;

    if (IN(0)) {
        LAS float* scr = (LAS float*)(lds + RING_OFF + wave * 16384);
        constexpr int I_IN = 16 * (NIN / 32), I_SQ = 16 * 32, I_UP = 16 * (DFF / 32), I_DN = (DFF / 64) * 32;
        constexpr int NITEMS = I_IN + 3 * I_SQ + I_UP + I_DN;
        for (int it = gw; it < NITEMS; it += NGW) {
            int r = it;
            if (r < I_IN) { const int nb = r >> 4, kb = r & 15; int src, nv; win_src(nb, src, nv); p0_transpose_item(args.in[7], DIN, DM, WIN, nb * 32, src, nv, scr, kb, lane); continue; } r -= I_IN;
            if (r < I_SQ) { p0_transpose_item(args.in[12], DM, DM, WC, (r >> 4) * 32, (r >> 4) * 32, 32, scr, r & 15, lane); continue; } r -= I_SQ;
            if (r < I_SQ) { p0_transpose_item(args.in[17], DM, DM, WD, (r >> 4) * 32, (r >> 4) * 32, 32, scr, r & 15, lane); continue; } r -= I_SQ;
            if (r < I_SQ) { p0_transpose_item(args.in[18], DM, DM, WO, (r >> 4) * 32, (r >> 4) * 32, 32, scr, r & 15, lane); continue; } r -= I_SQ;
            if (r < I_UP) { p0_transpose_item(args.in[20], DFF, DM, WUP, (r >> 4) * 32, (r >> 4) * 32, 32, scr, r & 15, lane); continue; } r -= I_UP;
            p0_transpose_item(args.in[21], DM, DFF, WDN, (r >> 6) * 32, (r >> 6) * 32, 32, scr, r & 63, lane);
        }
        for (int m = gw; m < MP; m += NGW) {
            if (m >= MR) { GAS unsigned long long* o8 = (GAS unsigned long long*)(H + (size_t)m * DM) + lane;
#pragma unroll
                for (int jj = 0; jj < 4; ++jj) o8[64 * jj] = 0ull; continue; }
            const float* src;
            if (m >= RP) src = args.in[1] + (size_t)(m - RP) * DM;
            else { const int b = m / TP, t = m - b * TP; src = t < NMETA ? args.in[5] + (size_t)t * DM : args.in[0] + ((size_t)b * SEQ + (t - NMETA)) * DM; }
            rms_row_to_bf16(src, args.in[6], H + (size_t)m * DM, lane);
        }
    }
    SEAM(0);
    if (IN(1)) {
        pg8::Gemm g{H, WIN, MP, NIN, DM}; pg8::StaticOrder S; S.init(MP, NIN, G, bx);
        EpiIn E{GLU, QKV, ZS, SGC, SGD, BETAG, args.in[14], args.in[15]};
        pg8::gemm_phase<EpiIn, pg8::StaticOrder, true, true>(lds + RING_OFF, g, S, E);
    }
    SEAM(1);
    if (IN(2)) {
        if (bx < 16) delta_item(args, lds, bx, false);
        else {
            for (int it = bx - 16; it < 64 + 128 + 256; it += G - 16) {
#ifndef NO_CONV
                if (it < 64) conv_unit(args, lds, 0, it >> 3, it & 7);
                else if (it < 192) conv_unit(args, lds, 1, it - 64, 0);
#else
                if (it < 192) {}
#endif
                else delta_item(args, lds, it - 192, true);
            }
        }
    }
    SEAM(2);
    if (IN(3)) {
        pg8::Gemm g{C, WC, MP, DM, DM}; pg8::StaticOrder S; S.init(MP, DM, G, bx);
        EpiGate<0> E{SGC, nullptr, SGC};
        pg8::gemm_phase<EpiGate<0>, pg8::StaticOrder, true, true>(lds + RING_OFF, g, S, E);
    }
    SEAM(3);
    if (IN(4)) {
        pg8::Gemm g{ZS, WD, MP, DM, DM}; pg8::StaticOrder S; S.init(MP, DM, G, bx);
        EpiGate<1> E{SGD, SGC, MIX};
        pg8::gemm_phase<EpiGate<1>, pg8::StaticOrder, true, true>(lds + RING_OFF, g, S, E);
    }
    SEAM(4);
    if (IN(5)) {
        pg8::Gemm g{MIX, WO, M2, DM, DM}; pg8::StaticOrder S; S.init(M2, DM, G, bx);
        EpiRes<0> E{args.in[0], args.in[1], args.out};
        pg8::gemm_phase<EpiRes<0>, pg8::StaticOrder, true, true>(lds + RING_OFF, g, S, E);
    }
    SEAM(5);
    if (IN(6)) {
        for (int m = gw; m < M2; m += NGW) rms_row_to_bf16(args.out + (size_t)m * DM, args.in[19], XG + (size_t)m * DM, lane);
    }
    SEAM(6);
    if (IN(7)) {
        pg8::Gemm g{XG, WUP, M2, DFF, DM}; pg8::StaticOrder S; S.init(M2, DFF, G, bx);
        EpiUp E{HM};
        pg8::gemm_phase<EpiUp, pg8::StaticOrder, true, true>(lds + RING_OFF, g, S, E);
    }
    SEAM(7);
    if (IN(8)) {
        pg8::Gemm g{HM, WDN, M2, DM, DFF}; pg8::StaticOrder S; S.init(M2, DM, G, bx);
        EpiRes<1> E{nullptr, nullptr, args.out};
        pg8::gemm_phase<EpiRes<1>, pg8::StaticOrder, true, true>(lds + RING_OFF, g, S, E);
    }
    SEAM(8);
    if (IN(9)) {
        for (int m = gw; m < M2; m += NGW) {
            float* xrow = args.out + (size_t)m * DM;
            GAS f32x4* xr = (GAS f32x4*)xrow + lane; const GAS f32x4* gr = (const GAS f32x4*)args.in[22] + lane;
            f32x4 v[4]; float s = 0.f;
#pragma unroll
            for (int jj = 0; jj < 4; ++jj) { v[jj] = xr[64 * jj]; s += (v[jj].x * v[jj].x + v[jj].y * v[jj].y) + (v[jj].z * v[jj].z + v[jj].w * v[jj].w); }
            const float rstd = 1.f / sqrtf(wave_sum(s) * (1.f / DM) + EPS);
#pragma unroll
            for (int jj = 0; jj < 4; ++jj) xr[64 * jj] = v[jj] * rstd * gr[64 * jj];
        }
    }
#undef IN
#undef SEAM
}

extern "C" void kernel_launch(void* const* d_in, const int* in_sizes, int n_in, void* d_out, int out_size, void* d_ws, size_t ws_size, hipStream_t stream) {
    static int grid = 0;
    if (grid == 0) {
        if (n_in != 23 || (size_t)out_size != O_END || ws_size < WS_END) { fprintf(stderr, "kernel_launch: unexpected shapes n_in %d out %d ws %zu\n", n_in, out_size, ws_size); grid = -1; return; }
        int dev = 0, cus = 0, per_cu = 0;
        if (hipGetDevice(&dev) != hipSuccess || hipDeviceGetAttribute(&cus, hipDeviceAttributeMultiprocessorCount, dev) != hipSuccess) { grid = -1; return; }
        if (hipFuncSetAttribute((const void*)fwd_kernel, hipFuncAttributeMaxDynamicSharedMemorySize, LDS_BYTES) != hipSuccess) { fprintf(stderr, "kernel_launch: hipFuncSetAttribute failed\n"); grid = -1; return; }
        if (hipOccupancyMaxActiveBlocksPerMultiprocessor(&per_cu, (const void*)fwd_kernel, NWAVES * 64, LDS_BYTES) != hipSuccess || per_cu < 1)
            fprintf(stderr, "kernel_launch: occupancy query reports %d\n", per_cu);
        (void)hipGetLastError();
        grid = cus;
    }
    if (grid < 0) return;
    if (hipMemsetAsync((char*)d_ws + WS_CTL, 0, CTL_ZERO_BYTES, stream) != hipSuccess) return;
    Args a{};
    for (int i = 0; i < 23; ++i) a.in[i] = (const float*)d_in[i];
    a.out = (float*)d_out; a.ws = (unsigned char*)d_ws;
#if MK_N_LAUNCHES == 1
    a.ph_lo = 0; a.ph_hi = NPHASES;
    hipLaunchKernelGGL(fwd_kernel, dim3(grid), dim3(NWAVES * 64), LDS_BYTES, stream, a);
#else
    for (int p = 0; p < NPHASES; ++p) { a.ph_lo = p; a.ph_hi = p + 1; hipLaunchKernelGGL(fwd_kernel, dim3(grid), dim3(NWAVES * 64), LDS_BYTES, stream, a); }
#endif
}
```

```cpp
#include <hip/hip_runtime.h>
#include <cstdio>
#include <cstdint>

#ifndef MK_N_LAUNCHES
#define MK_N_LAUNCHES 1
#endif

namespace pg8 {
#define PG8_LAS __attribute__((address_space(3)))
typedef unsigned short bf16_t;
typedef short bf16x8 __attribute__((ext_vector_type(8)));
typedef float f32x4 __attribute__((ext_vector_type(4)));
typedef unsigned u32x4 __attribute__((ext_vector_type(4)));
constexpr int BM = 256, BK = 64, HALF = 128, HTB = HALF * BK * 2, STAGE_BYTES = 8 * HTB, NXCD = 8, WGM = 8;

__host__ __device__ __forceinline__ int lds_byte(int r, int c) { const int st = (r >> 4) * 2 + (c >> 5), rr = r & 15, cc = c & 31, ob = rr * 64 + cc * 2; return st * 1024 + (ob ^ (((ob >> 9) & 1) << 5)); }
__host__ __device__ __forceinline__ void stage_rc(int b, int& R, int& C) { const int st = b / 1024, sb = b % 1024, swz = sb ^ (((sb >> 9) & 1) << 5); R = (st >> 1) * 16 + swz / 64; C = (st & 1) * 32 + (swz % 64) / 2; }
__host__ __device__ __forceinline__ int perm32(int rho) { const int n = rho >> 4, i = rho & 15; return 8 * (i >> 2) + 4 * n + (i & 3); }

struct Unit { int pm, pn; };
struct Gemm { const bf16_t* A; const bf16_t* Bt; int M, N, K; };

struct StaticOrder {
    int nM, nN, nwg, G, c;
    __host__ __device__ void init(int M, int N, int G_, int c_) { nM = M / BM; nN = N / BM; nwg = nM * nN; G = G_; c = c_; }
    __host__ __device__ bool next(int i, Unit& u) const {
        const long L = (long)i * G + c; if (L >= nwg) return false;
        int wgid = (int)L; { const int q = nwg / NXCD, r = nwg % NXCD, xcd = wgid % NXCD, off = wgid / NXCD; wgid = (xcd < r ? xcd * (q + 1) : r * (q + 1) + (xcd - r) * q) + off; }
        const int nig = WGM * nN, gid = wgid / nig, fm = gid * WGM, gsz = (nM - fm) < WGM ? (nM - fm) : WGM;
        u.pm = fm + ((wgid % nig) % gsz); u.pn = (wgid % nig) / gsz; return true;
    }
    __device__ __forceinline__ void a_ready(const Unit&) const {}
    __device__ __forceinline__ void done(const Unit&) const {}
};

__device__ __forceinline__ unsigned cvt_pk_bf16(float lo, float hi) { unsigned r; asm volatile("v_cvt_pk_bf16_f32 %0, %1, %2" : "=v"(r) : "v"(lo), "v"(hi)); return r; }

template <class Epi, class Sched, bool ALIGN_EPI = false, bool SP2 = false>
__device__ __forceinline__ void gemm_phase(PG8_LAS unsigned char* lds, const Gemm g, const Sched& S, const Epi& E) {
    const int tid = threadIdx.x, wid = __builtin_amdgcn_readfirstlane(tid >> 6), lane = tid & 63, wr = wid >> 2, wc = wid & 3, fr = lane & 15, fq = lane >> 4;
    const int K = g.K, nt = K / BK;
    unsigned voffA[2], voffB[2];
#pragma unroll
    for (int i = 0; i < 2; ++i) { int R, C; stage_rc(tid * 16 + i * 8192, R, C); const int Rb = Epi::PERM ? ((R & ~31) + perm32(R & 31)) : R;
        voffA[i] = (unsigned)(R * K + C) * 2u; voffB[i] = (unsigned)(Rb * K + C) * 2u; }
    const size_t kstep = (size_t)(BK * 2);
    const size_t hstep = (size_t)HALF * K * 2;
    const size_t tstep = 2 * hstep;
    const unsigned ldsw = (unsigned)wid * 1024u;
    const int aoff = lds_byte(wr * 64 + fr, fq * 8), boff = lds_byte(wc * 32 + fr, fq * 8);
#define PG8_SA(b, h) (((b) * 2 + (h)) * HTB)
#define PG8_SB(b, h) ((4 + (b) * 2 + (h)) * HTB)
#define PG8_STAGE(bufoff, gbase, voff) do { _Pragma("unroll") for (int _i = 0; _i < 2; ++_i) \
        __builtin_amdgcn_global_load_lds((const unsigned*)((const char*)(gbase) + (voff)[_i]), (PG8_LAS unsigned*)(lds + (bufoff) + ldsw + _i * 8192), 16, 0, 0); } while (0)
#define PG8_LDA(dst, b, h) do { _Pragma("unroll") for (int m = 0; m < 4; ++m) _Pragma("unroll") for (int k = 0; k < 2; ++k) dst[m][k] = *(const PG8_LAS bf16x8*)(lds + PG8_SA(b, h) + aoff + m * 2048 + k * 1024); } while (0)
#define PG8_LDB(dst, b, h) do { _Pragma("unroll") for (int n = 0; n < 2; ++n) _Pragma("unroll") for (int k = 0; k < 2; ++k) dst[n][k] = *(const PG8_LAS bf16x8*)(lds + PG8_SB(b, h) + boff + n * 2048 + k * 1024); } while (0)
#define PG8_MMA(ai, bj, At, Bt) do { __builtin_amdgcn_s_setprio(1); _Pragma("unroll") for (int m = 0; m < 4; ++m) _Pragma("unroll") for (int n = 0; n < 2; ++n) _Pragma("unroll") for (int k = 0; k < 2; ++k) \
        acc[ai][bj][m][n] = __builtin_amdgcn_mfma_f32_16x16x32_bf16(Bt[n][k], At[m][k], acc[ai][bj][m][n], 0, 0, 0); __builtin_amdgcn_s_setprio(0); } while (0)
#define PG8_WAIT_V(n) asm volatile("s_waitcnt vmcnt(" #n ")" ::: "memory")
#define PG8_WAIT_L(n) asm volatile("s_waitcnt lgkmcnt(" #n ")" ::: "memory")
#define PG8_BAR __builtin_amdgcn_s_barrier()
#define PG8_SCHED __builtin_amdgcn_sched_barrier(0)
    Unit cur, nxt; int ui = 0;
    if (!S.next(0, cur)) return;
    f32x4 acc[2][2][4][2];
#pragma unroll
    for (int a = 0; a < 2; ++a)
#pragma unroll
        for (int b = 0; b < 2; ++b)
#pragma unroll
            for (int m = 0; m < 4; ++m)
#pragma unroll
                for (int n = 0; n < 2; ++n) acc[a][b][m][n] = (f32x4){0.f, 0.f, 0.f, 0.f};
    bf16x8 At[4][2], B0[2][2], B1[2][2];
    const char* cA = (const char*)g.A + (size_t)cur.pm * tstep; const char* cB = (const char*)g.Bt + (size_t)cur.pn * tstep;
    S.a_ready(cur);
    if constexpr (SP2) {
        PG8_STAGE(PG8_SB(0, 0), cB, voffB); PG8_STAGE(PG8_SB(0, 1), cB + hstep, voffB); PG8_STAGE(PG8_SA(0, 0), cA, voffA); PG8_STAGE(PG8_SA(0, 1), cA + hstep, voffA);
        if (wr == 1) PG8_BAR;
        PG8_WAIT_V(2); PG8_BAR;
        PG8_STAGE(PG8_SB(1, 0), cB + kstep, voffB); PG8_STAGE(PG8_SA(1, 0), cA + kstep, voffA); PG8_STAGE(PG8_SB(1, 1), cB + hstep + kstep, voffB);
        PG8_WAIT_V(6); PG8_BAR;
    } else {
        PG8_STAGE(PG8_SB(0, 0), cB, voffB); PG8_STAGE(PG8_SA(0, 0), cA, voffA); PG8_STAGE(PG8_SB(0, 1), cB + hstep, voffB); PG8_STAGE(PG8_SA(0, 1), cA + hstep, voffA);
        if (wr == 1) PG8_BAR;
        PG8_WAIT_V(4); PG8_BAR;
        PG8_STAGE(PG8_SB(1, 0), cB + kstep, voffB); PG8_STAGE(PG8_SA(1, 0), cA + kstep, voffA); PG8_STAGE(PG8_SB(1, 1), cB + hstep + kstep, voffB);
        PG8_WAIT_V(6); PG8_BAR;
    }
    for (;;) {
        const bool has_next = S.next(ui + 1, nxt);
        const char* nA = has_next ? (const char*)g.A + (size_t)nxt.pm * tstep : cA; const char* nB = has_next ? (const char*)g.Bt + (size_t)nxt.pn * tstep : cB;
        for (int t = 0; t < nt; t += 2) {
            const bool last = (t == nt - 2);
            const char* a1 = cA + (size_t)(t + 1) * kstep;
            const char* a2 = last ? nA : cA + (size_t)(t + 2) * kstep; const char* b2 = last ? nB : cB + (size_t)(t + 2) * kstep;
            const char* a3 = a2 + kstep; const char* b3 = b2 + kstep;
            if (last && has_next) S.a_ready(nxt);
            if constexpr (SP2) {
            PG8_LDB(B0, 0, 0); PG8_LDB(B1, 0, 1); PG8_SCHED; PG8_LDA(At, 0, 0); PG8_STAGE(PG8_SA(1, 1), a1 + hstep, voffA);
            PG8_WAIT_V(8); PG8_WAIT_L(0); PG8_BAR; PG8_MMA(0, 0, At, B0); PG8_MMA(0, 1, At, B1); PG8_BAR; PG8_SCHED;
            PG8_LDA(At, 0, 1); PG8_STAGE(PG8_SB(0, 0), b2, voffB); PG8_STAGE(PG8_SB(0, 1), b2 + hstep, voffB); PG8_STAGE(PG8_SA(0, 0), a2, voffA);
            PG8_WAIT_V(8); PG8_WAIT_L(0); PG8_BAR; PG8_MMA(1, 0, At, B0); PG8_MMA(1, 1, At, B1); PG8_BAR; PG8_SCHED;
            PG8_LDB(B0, 1, 0); PG8_LDB(B1, 1, 1); PG8_SCHED; PG8_LDA(At, 1, 0); PG8_STAGE(PG8_SA(0, 1), a2 + hstep, voffA);
            PG8_WAIT_V(8); PG8_WAIT_L(0); PG8_BAR; PG8_MMA(0, 0, At, B0); PG8_MMA(0, 1, At, B1); PG8_BAR; PG8_SCHED;
            PG8_LDA(At, 1, 1); PG8_STAGE(PG8_SB(1, 0), b3, voffB); PG8_STAGE(PG8_SB(1, 1), b3 + hstep, voffB); PG8_STAGE(PG8_SA(1, 0), a3, voffA);
            PG8_WAIT_V(8); PG8_WAIT_L(0); PG8_BAR; PG8_MMA(1, 0, At, B0); PG8_MMA(1, 1, At, B1); PG8_BAR; PG8_SCHED;
            } else {
            PG8_LDB(B0, 0, 0); PG8_SCHED; PG8_LDA(At, 0, 0); PG8_STAGE(PG8_SA(1, 1), a1 + hstep, voffA);
            PG8_WAIT_L(8); PG8_BAR; PG8_WAIT_L(0); PG8_MMA(0, 0, At, B0); PG8_BAR; PG8_SCHED;
            PG8_LDB(B1, 0, 1); PG8_STAGE(PG8_SB(0, 0), b2, voffB);
            PG8_BAR; PG8_WAIT_L(0); PG8_MMA(0, 1, At, B1); PG8_BAR;
            PG8_LDA(At, 0, 1); PG8_STAGE(PG8_SA(0, 0), a2, voffA);
            PG8_BAR; PG8_WAIT_L(0); PG8_MMA(1, 0, At, B0); PG8_BAR; PG8_SCHED;
            PG8_STAGE(PG8_SB(0, 1), b2 + hstep, voffB);
            PG8_WAIT_V(6); PG8_BAR; PG8_MMA(1, 1, At, B1); PG8_BAR;
            PG8_LDB(B0, 1, 0); PG8_SCHED; PG8_LDA(At, 1, 0); PG8_STAGE(PG8_SA(0, 1), a2 + hstep, voffA);
            PG8_WAIT_L(8); PG8_BAR; PG8_WAIT_L(0); PG8_MMA(0, 0, At, B0); PG8_BAR; PG8_SCHED;
            PG8_LDB(B1, 1, 1); PG8_STAGE(PG8_SB(1, 0), b3, voffB);
            PG8_BAR; PG8_WAIT_L(0); PG8_MMA(0, 1, At, B1); PG8_BAR;
            PG8_LDA(At, 1, 1); PG8_STAGE(PG8_SA(1, 0), a3, voffA);
            PG8_BAR; PG8_WAIT_L(0); PG8_MMA(1, 0, At, B0); PG8_BAR; PG8_SCHED;
            PG8_STAGE(PG8_SB(1, 1), b3 + hstep, voffB);
            PG8_WAIT_V(6); PG8_BAR; PG8_MMA(1, 1, At, B1); PG8_BAR;
            }
        }
        if constexpr (ALIGN_EPI) { if (wr == 0) PG8_BAR; }
        E(acc, cur, wr, wc, fr, fq); S.done(cur);
        if (!has_next) break;
#pragma unroll
        for (int a = 0; a < 2; ++a)
#pragma unroll
            for (int b = 0; b < 2; ++b)
#pragma unroll
                for (int m = 0; m < 4; ++m)
#pragma unroll
                    for (int n = 0; n < 2; ++n) acc[a][b][m][n] = (f32x4){0.f, 0.f, 0.f, 0.f};
        cur = nxt; cA = nA; cB = nB; ++ui;
        if constexpr (ALIGN_EPI) { if (wr == 1) PG8_BAR; }
    }
    PG8_WAIT_V(0);
    if constexpr (!ALIGN_EPI) { if (wr == 0) PG8_BAR; }
    PG8_BAR;
#undef PG8_SA
#undef PG8_SB
#undef PG8_STAGE
#undef PG8_LDA
#undef PG8_LDB
#undef PG8_MMA
#undef PG8_WAIT_V
#undef PG8_WAIT_L
#undef PG8_BAR
#undef PG8_SCHED
}
}

constexpr int NWAVES = 8;
constexpr int DM = 1024, BP = 8, SEQ = 2048, NMETA = 16, TP = SEQ + NMETA, BS = 128, TS = 4;
constexpr int RP = BP * TP;
constexpr int RS = BS * TS;
constexpr int MR = RP + RS;
constexpr int MP = 17152;
constexpr int M2 = BP * SEQ + RS;
constexpr int NH = 8, DH = 128, DQKV = 3072, DFF = 4096, KC = 31, KS = 4;
constexpr int NIN = 8448;
constexpr int DIN = 8208;
constexpr float EPS = 1e-6f;

constexpr size_t O_YP = 0, O_YS = 16777216, O_PC = 17301504, O_PQ = 17547264, O_PD = 17620992, O_SC = 18669568, O_SQ = 22601728, O_SD = 23781376, O_END = 40558592;

constexpr size_t MiB = 1u << 20;
constexpr size_t WS_CTL = 0, CTL_ZERO_BYTES = 1 * MiB;
constexpr size_t WS_BETAG = 1 * MiB;
constexpr size_t WS_LASTV = 9 * MiB / 4;
constexpr size_t WS_HALOQ = 5 * MiB / 2;
constexpr size_t WS_WC = 29 * MiB / 4, WS_WD = WS_WC + 2 * MiB, WS_WO = WS_WD + 2 * MiB, WS_WUP = WS_WO + 2 * MiB, WS_WDN = WS_WUP + 8 * MiB;
constexpr size_t WS_GLU = 117 * MiB / 4;
constexpr size_t WS_QKVB = 63 * MiB;
constexpr size_t WS_QS = 162 * MiB;
constexpr size_t WS_ZS = 165 * MiB;
constexpr size_t WS_H = 397 * MiB / 2;
constexpr size_t WS_WIN = 232 * MiB;
constexpr size_t WS_HALOC = 497 * MiB / 2;
constexpr size_t WS_KDT = WS_H, WS_ATTN = 463 * MiB / 2;
constexpr size_t WS_MIX = WS_QKVB, WS_XG = WS_GLU, WS_HM = WS_QKVB, WS_C = WS_GLU;
constexpr size_t WS_END = 256 * MiB;
constexpr int NRUN = 16, RUNL = TP / NRUN;
static_assert(NRUN * RUNL == TP && WS_HALOC + (size_t)BP * NRUN * 30 * DM * 2 <= WS_END, "conv runs");
constexpr int NCH = 33, QBLK = 3 * 64 * 128;
static_assert(WS_WIN + (size_t)NIN * DM * 2 <= WS_HALOC && WS_WDN + 8 * MiB <= WS_GLU && WS_GLU + (size_t)MP * DM * 2 <= WS_QKVB && WS_HALOQ + (size_t)BP * 33 * 3 * 3072 * 2 <= WS_WC, "ws map");
static_assert(WS_ZS + (size_t)MP * DM * 2 <= WS_H && WS_H + (size_t)MP * DM * 2 <= WS_WIN, "ws map 2");
static_assert(WS_QKVB + (size_t)BP * NCH * NH * QBLK * 2 <= WS_QS, "ws map qkvb");
static_assert(WS_HM + (size_t)M2 * DFF * 2 <= WS_H, "ws map hm");
static_assert(WS_KDT + (size_t)BP * NCH * NH * 8192 * 2 <= WS_ATTN && WS_ATTN + (size_t)BP * NCH * NH * 4096 * 2 <= WS_HALOC, "ws map kdt");
constexpr int CW_TMO = 0, CW_CODE = 1, CW_BAR = 4096;

constexpr int RING_OFF = 0, RING_BYTES = 131072;
constexpr int LDSCTL_OFF = RING_BYTES, MISC_OFF = LDSCTL_OFF + 320;
constexpr int LDS_BYTES = 147456;

#define GAS __attribute__((address_space(1)))
#define LAS __attribute__((address_space(3)))
typedef unsigned short bf16;
typedef unsigned v4u __attribute__((ext_vector_type(4)));
typedef unsigned v2u __attribute__((ext_vector_type(2)));
typedef float f32x4 __attribute__((ext_vector_type(4)));
typedef float f32x2 __attribute__((ext_vector_type(2)));
typedef GAS unsigned gu32;
#define RLX_AGENT __ATOMIC_RELAXED, __HIP_MEMORY_SCOPE_AGENT
#define LDS_WAIT() asm volatile("s_waitcnt lgkmcnt(0)" ::: "memory")
#define VM_WAIT() asm volatile("s_waitcnt vmcnt(0)" ::: "memory")
__device__ __forceinline__ unsigned f2bf(float f) { unsigned u = __builtin_bit_cast(unsigned, f); return (u + 0x7fffu + ((u >> 16) & 1u)) >> 16; }
__device__ __forceinline__ unsigned pk2(float lo, float hi) { return f2bf(lo) | (f2bf(hi) << 16); }
__device__ __forceinline__ float bflo(unsigned w) { return __builtin_bit_cast(float, w << 16); }
__device__ __forceinline__ float bfhi(unsigned w) { return __builtin_bit_cast(float, w & 0xffff0000u); }
__device__ __forceinline__ float bf1(bf16 b) { return __builtin_bit_cast(float, ((unsigned)b) << 16); }
__device__ __forceinline__ float sigmoidf_(float x) { return __builtin_amdgcn_rcpf(1.f + __expf(-x)); }
__device__ __forceinline__ float siluf_(float x) { return x * sigmoidf_(x); }

#define XB_TMO      128
#define XB_XCNT(j)  (256  + 64 * (j))
#define XB_XSUB(j)  (1280 + 64 * (j))
#define XB_XGEN(j)  (2304 + 64 * (j))
#define XB_TOP      3328
#define XB_TOPGEN   3392
#define XCD_BAR_WORDS 3456
#define XB_SPIN_CAP (1u << 18)
__device__ __forceinline__ unsigned xb_ld(unsigned* p)              { return __hip_atomic_load(p, __ATOMIC_RELAXED, __HIP_MEMORY_SCOPE_AGENT); }
__device__ __forceinline__ unsigned xb_add(unsigned* p, unsigned v) { return __hip_atomic_fetch_add(p, v, __ATOMIC_RELAXED, __HIP_MEMORY_SCOPE_AGENT); }
__device__ __forceinline__ unsigned xb_xcc_id() { return (unsigned)__builtin_amdgcn_s_getreg((3 << 11) | 20) & 0xFu; }
#define XB_SPIN(cond, bar) do { unsigned _sp = 0; while (cond) { __builtin_amdgcn_s_sleep(1); \
    if ((++_sp & 255u) == 0u) { if (xb_ld(&(bar)[XB_TMO])) break; if (_sp > XB_SPIN_CAP) { atomicAdd(&(bar)[XB_TMO], 1u); break; } } } } while (0)
struct XcdBarrier { unsigned* bar; unsigned x; volatile LAS unsigned* st; };
__device__ __forceinline__ XcdBarrier xcd_barrier_post(unsigned* bar, volatile LAS unsigned* st) {
    XcdBarrier b; b.bar = bar; b.x = xb_xcc_id(); b.st = st;
    if (threadIdx.x == 0) (void)xb_add(&bar[XB_XCNT(b.x)], 1u);
    return b;
}
__device__ __forceinline__ void xcd_barrier_complete(unsigned* bar, unsigned x, unsigned& nloc, unsigned& nx) {
    const unsigned G = gridDim.x * gridDim.y * gridDim.z;
    unsigned sum, cnt, mine, sp = 0u;
    for (;;) {
        sum = 0u; cnt = 0u; mine = 0u;
#pragma unroll
        for (unsigned j = 0; j < 16; ++j) { const unsigned c = xb_ld(&bar[XB_XCNT(j)]); sum += c; cnt += (c > 0u) ? 1u : 0u; mine = (j == x) ? c : mine; }
        if (sum == G) break;
        __builtin_amdgcn_s_sleep(1);
        if ((++sp & 255u) == 0u) { if (xb_ld(&bar[XB_TMO])) break; if (sp > XB_SPIN_CAP) { atomicAdd(&bar[XB_TMO], 1u); break; } }
    }
    nloc = mine > 0u ? mine : 1u; nx = cnt > 0u ? cnt : 1u;
}
__device__ __forceinline__ void xcd_barrier(const XcdBarrier& b) {
    asm volatile("s_waitcnt vmcnt(0)" ::: "memory");
    __syncthreads();
    if (threadIdx.x == 0) {
        unsigned* bar = b.bar;
        __builtin_amdgcn_s_waitcnt(0);
        unsigned nloc = b.st[0], nx = b.st[1];
        if (nloc == 0u) { xcd_barrier_complete(bar, b.x, nloc, nx); b.st[0] = nloc; b.st[1] = nx; }
        const unsigned old = xb_add(&bar[XB_XSUB(b.x)], 1u);
        const unsigned gen = old / nloc;
        if (old + 1u == (gen + 1u) * nloc) {
            __builtin_amdgcn_fence(__ATOMIC_RELEASE, "agent");
            asm volatile("s_waitcnt vmcnt(0)" ::: "memory");
            const unsigned og = xb_add(&bar[XB_TOP], 1u);
            const unsigned tg = og / nx;
            if (og + 1u == (tg + 1u) * nx) xb_add(&bar[XB_TOPGEN], 1u);
            else XB_SPIN(xb_ld(&bar[XB_TOPGEN]) == tg, bar);
            __builtin_amdgcn_fence(__ATOMIC_ACQUIRE, "agent");
            xb_add(&bar[XB_XGEN(b.x)], 1u);
            asm volatile("s_waitcnt vmcnt(0)" ::: "memory");
        } else {
            XB_SPIN(xb_ld(&bar[XB_XGEN(b.x)]) == gen, bar);
            __builtin_amdgcn_fence(__ATOMIC_ACQUIRE, "agent");
            asm volatile("s_waitcnt vmcnt(0)" ::: "memory");
        }
    }
    __syncthreads();
}

struct Args { const float* in[23]; float* out; unsigned char* ws; int ph_lo, ph_hi; };

__device__ __forceinline__ float wave_sum(float v) {
#pragma unroll
    for (int o = 1; o < 64; o <<= 1) v += __shfl_xor(v, o);
    return v;
}
__device__ __forceinline__ int compact_row(int r) {
    if (r >= MR) return -1;
    if (r >= RP) return r - RP + BP * SEQ;
    const int b = r / TP, t = r - b * TP;
    return t < NMETA ? -1 : r - NMETA * (b + 1);
}

__device__ __forceinline__ void p0_transpose_item(const float* W, int Nsrc, int K, bf16* WT, int dst_row0, int src_col0, int nvalid, LAS float* scr, int kb, int lane) {
    const int k0 = 64 * kb, cidx = lane & 31;
#pragma unroll 8
    for (int i = 0; i < 32; ++i) { const int kk = 2 * i + (lane >> 5); float v = 0.f; if (cidx < nvalid) v = W[(size_t)(k0 + kk) * Nsrc + src_col0 + cidx]; scr[kk * 33 + cidx] = v; }
    LDS_WAIT(); asm volatile("" ::: "memory");
    const int c = lane & 7;
#pragma unroll
    for (int j = 0; j < 4; ++j) { const int n = (lane >> 3) + 8 * j; const LAS float* s = scr + (8 * c) * 33 + n;
        v4u o; o.x = pk2(s[0 * 33], s[1 * 33]); o.y = pk2(s[2 * 33], s[3 * 33]); o.z = pk2(s[4 * 33], s[5 * 33]); o.w = pk2(s[6 * 33], s[7 * 33]);
        *(GAS v4u*)(WT + (size_t)(dst_row0 + n) * K + k0 + 8 * c) = o; }
    LDS_WAIT(); asm volatile("" ::: "memory");
}
__device__ __forceinline__ void win_src(int nb, int& src, int& nvalid) {
    const int pn = nb >> 3, o = (nb & 7) * 32; nvalid = 32;
    if (pn < 8) src = (o < 128) ? 128 * pn + o : 1024 + 128 * pn + (o - 128);
    else if (pn < 20) src = 2048 + 256 * (pn - 8) + o;
    else if (pn < 24) src = 5120 + 256 * (pn - 20) + o;
    else if (pn < 28) src = 6160 + 256 * (pn - 24) + o;
    else if (pn < 32) src = 7184 + 256 * (pn - 28) + o;
    else { src = 6144; nvalid = (o == 0) ? 16 : 0; }
}
__device__ __forceinline__ void rms_row_to_bf16(const float* xrow, const float* gain, bf16* orow, int lane) {
    const GAS f32x4* xr = (const GAS f32x4*)xrow + lane; const GAS f32x4* gr = (const GAS f32x4*)gain + lane;
    f32x4 v[4]; float s = 0.f;
#pragma unroll
    for (int j = 0; j < 4; ++j) { v[j] = xr[64 * j]; s += (v[j].x * v[j].x + v[j].y * v[j].y) + (v[j].z * v[j].z + v[j].w * v[j].w); }
    const float rstd = 1.f / sqrtf(wave_sum(s) * (1.f / DM) + EPS);
    GAS unsigned long long* o8 = (GAS unsigned long long*)orow + lane;
#pragma unroll
    for (int j = 0; j < 4; ++j) { const f32x4 g = gr[64 * j]; o8[64 * j] = (unsigned long long)pk2(v[j].x * rstd * g.x, v[j].y * rstd * g.y) | ((unsigned long long)pk2(v[j].z * rstd * g.z, v[j].w * rstd * g.w) << 32); }
}

typedef pg8::f32x4 A4;
struct EpiIn {
    static constexpr bool PERM = true;
    bf16 *GLU, *QKVB, *QS, *HALOQ, *HALOC, *ZS, *SGC, *SGD; float* BETAG; const float *a_log, *dt_bias;
    __device__ __forceinline__ void operator()(const A4 (&acc)[2][2][4][2], const pg8::Unit& u, int wr, int wc, int fr, int fq) const {
        const int pn = u.pn, row0 = u.pm * 256 + wr * 64 + fr, cw = 32 * wc + 8 * fq;
        if (pn < 8) {
#pragma unroll
            for (int ai = 0; ai < 2; ++ai)
#pragma unroll
                for (int m = 0; m < 4; ++m) { const int r = row0 + ai * 128 + m * 16; float o[8];
#pragma unroll
                    for (int n = 0; n < 2; ++n)
#pragma unroll
                        for (int j = 0; j < 4; ++j) o[4 * n + j] = acc[ai][0][m][n][j] * sigmoidf_(acc[ai][1][m][n][j]);
                    v4u w; w.x = pk2(o[0], o[1]); w.y = pk2(o[2], o[3]); w.z = pk2(o[4], o[5]); w.w = pk2(o[6], o[7]);
                    *(GAS v4u*)(GLU + (size_t)r * DM + 128 * pn + cw) = w;
                    if (r < RP) { const int b = r / TP, t = r - b * TP, run = t / RUNL, pos = t - run * RUNL;
                        if (pos >= RUNL - 30 && run < NRUN - 1) *(GAS v4u*)(HALOC + ((size_t)(b * NRUN + run) * 30 + (pos - (RUNL - 30))) * DM + 128 * pn + cw) = w; } }
        } else if (pn < 20) {
            const int colb = 256 * (pn - 8);
#pragma unroll
            for (int ai = 0; ai < 2; ++ai)
#pragma unroll
                for (int m = 0; m < 4; ++m) { const int r = row0 + ai * 128 + m * 16; if (r >= MR) continue;
#pragma unroll
                    for (int bj = 0; bj < 2; ++bj) { const int col = colb + 128 * bj + cw;
                        const A4 a0 = acc[ai][bj][m][0], a1 = acc[ai][bj][m][1];
                        v4u w; w.x = pk2(a0[0], a0[1]); w.y = pk2(a0[2], a0[3]); w.z = pk2(a1[0], a1[1]); w.w = pk2(a1[2], a1[3]);
                        if (r >= RP) *(GAS v4u*)(QS + (size_t)(r - RP) * DQKV + col) = w;
                        else { const int b = r / TP, t = r - b * TP, c = t >> 6, i = t & 63, which = col >> 10, h = (col >> 7) & 7, d = col & 127;
                            *(GAS v4u*)(QKVB + ((size_t)((b * NCH + c) * NH + h) * 3 + which) * 8192 + i * 128 + d) = w;
                            if (i >= 61) *(GAS v4u*)(HALOQ + ((size_t)(b * NCH + c) * 3 + (i - 61)) * DQKV + col) = w; } } }
        } else if (pn < 24) {
            constexpr bool isz = true; bf16* dst = ZS; const int ld = DM, cb = 256 * (pn - 20);
#pragma unroll
            for (int ai = 0; ai < 2; ++ai)
#pragma unroll
                for (int m = 0; m < 4; ++m) { const int r = row0 + ai * 128 + m * 16;
#pragma unroll
                    for (int bj = 0; bj < 2; ++bj) { float o[8];
#pragma unroll
                        for (int n = 0; n < 2; ++n)
#pragma unroll
                            for (int j = 0; j < 4; ++j) { const float v = acc[ai][bj][m][n][j]; o[4 * n + j] = isz ? siluf_(v) : v; }
                        v4u w; w.x = pk2(o[0], o[1]); w.y = pk2(o[2], o[3]); w.z = pk2(o[4], o[5]); w.w = pk2(o[6], o[7]);
                        *(GAS v4u*)(dst + (size_t)r * ld + cb + 128 * bj + cw) = w; } }
        } else if (pn < 32) {
            bf16* dst = pn < 28 ? SGC : SGD; const int cb = 256 * ((pn - 24) & 3);
#pragma unroll
            for (int ai = 0; ai < 2; ++ai)
#pragma unroll
                for (int m = 0; m < 4; ++m) { const int rc = compact_row(row0 + ai * 128 + m * 16); if (rc < 0) continue;
#pragma unroll
                    for (int bj = 0; bj < 2; ++bj) { float o[8];
#pragma unroll
                        for (int n = 0; n < 2; ++n)
#pragma unroll
                            for (int j = 0; j < 4; ++j) o[4 * n + j] = sigmoidf_(acc[ai][bj][m][n][j]);
                        v4u w; w.x = pk2(o[0], o[1]); w.y = pk2(o[2], o[3]); w.z = pk2(o[4], o[5]); w.w = pk2(o[6], o[7]);
                        *(GAS v4u*)(dst + (size_t)rc * DM + cb + 128 * bj + cw) = w; } }
        } else {
            if (wc == 0 && fq < 2) {
#pragma unroll
                for (int ai = 0; ai < 2; ++ai)
#pragma unroll
                    for (int m = 0; m < 4; ++m) { const int r = row0 + ai * 128 + m * 16; float o[8];
#pragma unroll
                        for (int n = 0; n < 2; ++n)
#pragma unroll
                            for (int j = 0; j < 4; ++j) { const int h = 4 * n + j; const float v = acc[ai][0][m][n][j];
                                if (fq == 0) o[h] = 1.f / (1.f + expf(-v));
                                else { const float xx = v + dt_bias[h]; const float sp = xx > 20.f ? xx : log1pf(expf(xx)); o[h] = -expf(a_log[h]) * sp; } }
                        GAS f32x4* p = (GAS f32x4*)(BETAG + (size_t)r * 16 + 8 * fq);
                        p[0] = (f32x4){o[0], o[1], o[2], o[3]}; p[1] = (f32x4){o[4], o[5], o[6], o[7]}; }
            }
        }
    }
};
template <int MODE> struct EpiGate {
    static constexpr bool PERM = true;
    bf16 *SG, *MA, *OUT;
    __device__ __forceinline__ void operator()(const A4 (&acc)[2][2][4][2], const pg8::Unit& u, int wr, int wc, int fr, int fq) const {
        const int row0 = u.pm * 256 + wr * 64 + fr, c0 = 256 * u.pn + 32 * wc + 8 * fq;
#pragma unroll
        for (int ai = 0; ai < 2; ++ai)
#pragma unroll
            for (int m = 0; m < 4; ++m) { const int rc = compact_row(row0 + ai * 128 + m * 16); if (rc < 0) continue;
#pragma unroll
                for (int bj = 0; bj < 2; ++bj) { const size_t off = (size_t)rc * DM + c0 + 128 * bj;
                    const v4u g = *(const GAS v4u*)(SG + off); float o[8];
                    const A4 a0 = acc[ai][bj][m][0], a1 = acc[ai][bj][m][1];
                    o[0] = bflo(g.x) * a0[0]; o[1] = bfhi(g.x) * a0[1]; o[2] = bflo(g.y) * a0[2]; o[3] = bfhi(g.y) * a0[3];
                    o[4] = bflo(g.z) * a1[0]; o[5] = bfhi(g.z) * a1[1]; o[6] = bflo(g.w) * a1[2]; o[7] = bfhi(g.w) * a1[3];
                    if (MODE == 1) { const v4u q = *(const GAS v4u*)(MA + off);
                        o[0] += bflo(q.x); o[1] += bfhi(q.x); o[2] += bflo(q.y); o[3] += bfhi(q.y); o[4] += bflo(q.z); o[5] += bfhi(q.z); o[6] += bflo(q.w); o[7] += bfhi(q.w); }
                    v4u w; w.x = pk2(o[0], o[1]); w.y = pk2(o[2], o[3]); w.z = pk2(o[4], o[5]); w.w = pk2(o[6], o[7]);
                    *(GAS v4u*)(OUT + off) = w; } }
    }
};
template <int MODE> struct EpiRes {
    static constexpr bool PERM = false;
    const float *xp, *xs; float* out;
    __device__ __forceinline__ void operator()(const A4 (&acc)[2][2][4][2], const pg8::Unit& u, int wr, int wc, int fr, int fq) const {
        const int row0 = u.pm * 256 + wr * 64 + fr, c0 = 256 * u.pn + 32 * wc + 4 * fq;
#pragma unroll
        for (int ai = 0; ai < 2; ++ai)
#pragma unroll
            for (int m = 0; m < 4; ++m) { const int r = row0 + ai * 128 + m * 16;
                const float* base = MODE == 0 ? (r < BP * SEQ ? xp + (size_t)r * DM : xs + (size_t)(r - BP * SEQ) * DM) : out + (size_t)r * DM;
                float* orow = out + (size_t)r * DM;
#pragma unroll
                for (int bj = 0; bj < 2; ++bj)
#pragma unroll
                    for (int n = 0; n < 2; ++n) { const int c = c0 + 128 * bj + 16 * n; const f32x4 b = *(const GAS f32x4*)(base + c); *(GAS f32x4*)(orow + c) = b + acc[ai][bj][m][n]; } }
    }
};
struct EpiUp {
    static constexpr bool PERM = true;
    bf16* HM;
    __device__ __forceinline__ void operator()(const A4 (&acc)[2][2][4][2], const pg8::Unit& u, int wr, int wc, int fr, int fq) const {
        const int row0 = u.pm * 256 + wr * 64 + fr, c0 = 256 * u.pn + 32 * wc + 8 * fq;
#pragma unroll
        for (int ai = 0; ai < 2; ++ai)
#pragma unroll
            for (int m = 0; m < 4; ++m) { const int r = row0 + ai * 128 + m * 16;
#pragma unroll
                for (int bj = 0; bj < 2; ++bj) { float o[8];
#pragma unroll
                    for (int n = 0; n < 2; ++n)
#pragma unroll
                        for (int j = 0; j < 4; ++j) { const float v = fmaxf(acc[ai][bj][m][n][j], 0.f); o[4 * n + j] = v * v; }
                    v4u w; w.x = pk2(o[0], o[1]); w.y = pk2(o[2], o[3]); w.z = pk2(o[4], o[5]); w.w = pk2(o[6], o[7]);
                    *(GAS v4u*)(HM + (size_t)r * DFF + c0 + 128 * bj) = w; } }
    }
};

__device__ __forceinline__ void conv_unit(const Args& a, LAS unsigned char* lds, int kind, int b, int run) {
    asm volatile("" ::: "memory");
    const int tid = threadIdx.x, lane = tid & 63, wave = tid >> 6; int ch = 2 * tid; asm volatile("" : "+v"(ch));
    const unsigned char* ws = a.ws;
    const bf16* GLU = (const bf16*)(ws + WS_GLU); bf16* C = (bf16*)(a.ws + WS_C); const bf16* HALOC = (const bf16*)(ws + WS_HALOC);
    const float* w_dw = a.in[8];
    LAS float* red = (LAS float*)lds;
    f32x2 w[KC]; unsigned win[KC];
#pragma unroll
    for (int i = 0; i < KC; ++i) w[i] = *(const GAS f32x2*)(w_dw + (size_t)i * DM + ch);
    const f32x2 bdw = *(const GAS f32x2*)(a.in[9] + ch), lng = *(const GAS f32x2*)(a.in[10] + ch), lnb = *(const GAS f32x2*)(a.in[11] + ch);
    int row0, ntok; bool last_run;
    win[0] = 0u;
    if (kind == 0) { row0 = b * TP + run * RUNL; ntok = RUNL; last_run = (run == NRUN - 1);
#pragma unroll
        for (int i = 1; i < KC; ++i) { if (run == 0) win[i] = 0u; else win[i] = *(const GAS unsigned*)(HALOC + ((size_t)(b * NRUN + run - 1) * 30 + (i - 1)) * DM + ch); }
    } else { row0 = RP + b * TS; ntok = TS; last_run = true;
        const float* st = a.in[2] + (size_t)b * (KC - 1) * DM;
#pragma unroll
        for (int i = 1; i < KC; ++i) { const f32x2 v = *(const GAS f32x2*)(st + (size_t)(i - 1) * DM + ch); win[i] = pk2(v.x, v.y); }
    }
    for (int t = 0; t < ntok; ++t) {
        const unsigned v = *(const GAS unsigned*)(GLU + (size_t)(row0 + t) * DM + ch);
#pragma unroll
        for (int i = 0; i < KC - 1; ++i) win[i] = win[i + 1];
        win[KC - 1] = v;
        float y0 = bdw.x, y1 = bdw.y;
#pragma unroll
        for (int i = 0; i < KC; ++i) { y0 += w[i].x * bflo(win[i]); y1 += w[i].y * bfhi(win[i]); }
        float s1 = wave_sum(y0 + y1), s2 = wave_sum(y0 * y0 + y1 * y1);
        LAS float* rb = red + (t & 1) * 16;
        if (lane == 0) { rb[wave * 2] = s1; rb[wave * 2 + 1] = s2; }
        __syncthreads();
        float t1 = 0.f, t2 = 0.f;
#pragma unroll
        for (int i = 0; i < 8; ++i) { t1 += rb[2 * i]; t2 += rb[2 * i + 1]; }
        const float mu = t1 * (1.f / DM), var = fmaxf(t2 * (1.f / DM) - mu * mu, 0.f), rstd = 1.f / sqrtf(var + EPS);
        const float z0 = (y0 - mu) * rstd * lng.x + lnb.x, z1 = (y1 - mu) * rstd * lng.y + lnb.y;
        *(GAS unsigned*)(C + (size_t)(row0 + t) * DM + ch) = pk2(siluf_(z0), siluf_(z1));
    }
    if (last_run) { float* o = a.out + (kind == 0 ? O_PC : O_SC) + (size_t)b * (KC - 1) * DM;
        if (kind == 0) {
#pragma unroll
            for (int i = 1; i < KC; ++i) *(GAS f32x2*)(o + (size_t)(i - 1) * DM + ch) = (f32x2){bflo(win[i]), bfhi(win[i])};
        } else {
            const float* st = a.in[2] + (size_t)b * (KC - 1) * DM;
#pragma unroll
            for (int i = 0; i < KC - 1 - TS; ++i) *(GAS f32x2*)(o + (size_t)i * DM + ch) = *(const GAS f32x2*)(st + (size_t)(i + TS) * DM + ch);
#pragma unroll
            for (int i = KC - TS; i < KC; ++i) *(GAS f32x2*)(o + (size_t)(i - 1) * DM + ch) = (f32x2){bflo(win[i]), bfhi(win[i])};
        }
    }
    __syncthreads();
}

__device__ __forceinline__ void delta_item(const Args& a, LAS unsigned char* lds, int item) {
    asm volatile("" ::: "memory");
    const int tid = threadIdx.x, lane = tid & 63, sub = tid >> 7, wu = (tid >> 6) & 1; int j = tid & 127; asm volatile("" : "+v"(j));
    const int unit = item * 4 + sub, b = unit >> 3, h = unit & 7;
    const int row0 = RP + b * TS;
    const bf16* QS = (const bf16*)(a.ws + WS_QS); bf16* ZS = (bf16*)(a.ws + WS_ZS); const float* BETAG = (const float*)(a.ws + WS_BETAG);
    LAS float* kq = (LAS float*)lds + sub * 256;
    LAS float* red = (LAS float*)lds + 1024 + sub * 4;
    LAS float* red2 = (LAS float*)lds + 1024 + 16 + sub * 2;
    float S[DH];
    { const float* s0 = a.in[4] + ((size_t)(b * NH + h) * DH) * DH + j;
#pragma unroll
        for (int d = 0; d < DH; ++d) S[d] = s0[(size_t)d * DH]; }
    const int cq = h * DH + j, ck = DM + cq, cv = 2 * DM + cq;
    float wq[KS], wk[KS], wv[KS];
#pragma unroll
    for (int i = 0; i < KS; ++i) { wq[i] = a.in[13][i * DQKV + cq]; wk[i] = a.in[13][i * DQKV + ck]; wv[i] = a.in[13][i * DQKV + cv]; }
    float hq[3], hk[3], hv[3];
#pragma unroll
    for (int i = 0; i < 3; ++i) { const float* st = a.in[3] + ((size_t)b * 3 + i) * DQKV; hq[i] = st[cq]; hk[i] = st[ck]; hv[i] = st[cv]; }
    const float gh = a.in[16][j];
    for (int t = 0; t < TS; ++t) {
        const size_t row = (size_t)(row0 + t);
        const bf16* p = QS + (size_t)(b * TS + t) * DQKV; const float qp = bf1(p[cq]), kp = bf1(p[ck]), vp = bf1(p[cv]);
        const float qc = siluf_(wq[0] * hq[0] + wq[1] * hq[1] + wq[2] * hq[2] + wq[3] * qp);
        const float kc = siluf_(wk[0] * hk[0] + wk[1] * hk[1] + wk[2] * hk[2] + wk[3] * kp);
        const float vc = siluf_(wv[0] * hv[0] + wv[1] * hv[1] + wv[2] * hv[2] + wv[3] * vp);
        hq[0] = hq[1]; hq[1] = hq[2]; hq[2] = qp; hk[0] = hk[1]; hk[1] = hk[2]; hk[2] = kp; hv[0] = hv[1]; hv[1] = hv[2]; hv[2] = vp;
        const float sq = wave_sum(qc * qc), sk = wave_sum(kc * kc);
        kq[j] = kc; kq[128 + j] = qc;
        if (lane == 0) { red[wu * 2] = sq; red[wu * 2 + 1] = sk; }
        const float beta = BETAG[row * 16 + h], gg = BETAG[row * 16 + 8 + h];
        const float zs = bf1(ZS[row * DM + cq]);
        __syncthreads();
        const float nq = (1.f / sqrtf(red[0] + red[2] + 1e-6f)) * 0.08838834764831845f, nk = 1.f / sqrtf(red[1] + red[3] + 1e-6f);
        const float alpha = expf(gg);
        float ks0 = 0.f, ks1 = 0.f, ks2 = 0.f, ks3 = 0.f;
#pragma unroll
        for (int d = 0; d < DH; d += 4) { const f32x4 kk = *(const LAS f32x4*)(kq + d); ks0 += kk.x * S[d]; ks1 += kk.y * S[d + 1]; ks2 += kk.z * S[d + 2]; ks3 += kk.w * S[d + 3];
            if ((d & 31) == 28) asm volatile("" ::: "memory"); }
        const float kS = (ks0 + ks1) + (ks2 + ks3);
        const float u = beta * (vc - alpha * nk * kS), un = nk * u;
        float o0 = 0.f, o1 = 0.f, o2 = 0.f, o3 = 0.f;
#pragma unroll
        for (int d = 0; d < DH; d += 4) { const f32x4 kk = *(const LAS f32x4*)(kq + d); const f32x4 qq = *(const LAS f32x4*)(kq + 128 + d);
            S[d] = alpha * S[d] + kk.x * un; S[d + 1] = alpha * S[d + 1] + kk.y * un; S[d + 2] = alpha * S[d + 2] + kk.z * un; S[d + 3] = alpha * S[d + 3] + kk.w * un;
            o0 += qq.x * S[d]; o1 += qq.y * S[d + 1]; o2 += qq.z * S[d + 2]; o3 += qq.w * S[d + 3];
            if ((d & 15) == 12) asm volatile("" ::: "memory"); }
        const float o = ((o0 + o1) + (o2 + o3)) * nq;
        const float so = wave_sum(o * o);
        if (lane == 0) red2[wu] = so;
        __syncthreads();
        const float rms = 1.f / sqrtf((red2[0] + red2[1]) * (1.f / DH) + EPS);
        ZS[row * DM + cq] = (bf16)f2bf(o * rms * gh * zs);
    }
    { float* so = a.out + O_SD + ((size_t)(b * NH + h) * DH) * DH + j;
#pragma unroll
        for (int d = 0; d < DH; ++d) so[(size_t)d * DH] = S[d];
      float* qo = a.out + O_SQ + (size_t)b * 3 * DQKV;
#pragma unroll
        for (int i = 0; i < 3; ++i) { qo[i * DQKV + cq] = hq[i]; qo[i * DQKV + ck] = hk[i]; qo[i * DQKV + cv] = hv[i]; }
    }
    __syncthreads();
}

__host__ __device__ constexpr int perm_k(int x) { return (x & ~31) | (((x >> 2) & 3) << 3) | (((x >> 4) & 1) << 2) | (x & 3); }
typedef short bf16x8v __attribute__((ext_vector_type(8)));
constexpr int IH_KH = 0, IH_QH = 17408, IH_MF = 34816, IH_GV = 52224, IH_PS = 53248, IH_BYTES = 54272;
__device__ __forceinline__ void intra_pair(const Args& a, LAS unsigned char* lds_all, int pair) {
    asm volatile("" ::: "memory");
    const int tid = threadIdx.x, half = tid >> 8, lane = tid & 63, wq = (tid >> 6) & 3; int tu = tid & 255; asm volatile("" : "+v"(tu));
    const int uq = pair * 2 + half, h = uq & 7, bc = uq >> 3, b = bc / NCH, c = bc - b * NCH;
    const int nvalid = (c == NCH - 1) ? TP - 64 * (NCH - 1) : 64;
    LAS unsigned char* lds = lds_all + half * IH_BYTES;
    LAS bf16* KH = (LAS bf16*)(lds + IH_KH); LAS bf16* QH = (LAS bf16*)(lds + IH_QH); LAS float* MF = (LAS float*)(lds + IH_MF); LAS float* GV = (LAS float*)(lds + IH_GV); LAS float* PS = (LAS float*)(lds + IH_PS);
    unsigned char* ws = a.ws;
    bf16* blk = (bf16*)(ws + WS_QKVB) + (size_t)uq * QBLK; const bf16* HALOQ = (const bf16*)(ws + WS_HALOQ); const float* BETAG = (const float*)(ws + WS_BETAG);
    bf16* KDT = (bf16*)(ws + WS_KDT) + (size_t)uq * 8192; bf16* ATT = (bf16*)(ws + WS_ATTN) + (size_t)uq * 4096; float* LASTV = (float*)(ws + WS_LASTV);
    if (tu < 64) { const int i = tu; float g = 0.f, be = 0.f; if (i < nvalid) { const float* p = BETAG + (size_t)(b * TP + 64 * c + i) * 16; be = p[h]; g = p[8 + h]; }
        float G = g;
#pragma unroll
        for (int o = 1; o < 64; o <<= 1) { const float t = __shfl_up(G, o); if (lane >= o) G += t; }
        const float GL = __shfl(G, 63);
        GV[i] = G; GV[64 + i] = be; GV[128 + i] = expf(G); GV[192 + i] = expf(GL - G);
        if (i == 63) LASTV[uq] = expf(GL); }
    const int which = tu >> 7, d = tu & 127, colw = which * DM + h * DH + d;
    float x[64];
    {   float w0 = a.in[13][colw], w1 = a.in[13][DQKV + colw], w2 = a.in[13][2 * DQKV + colw], w3 = a.in[13][3 * DQKV + colw];
        float h0 = 0.f, h1 = 0.f, h2 = 0.f;
        if (c > 0) { const bf16* hp = HALOQ + (size_t)(b * NCH + c - 1) * 3 * DQKV + colw; h0 = bf1(hp[0]); h1 = bf1(hp[DQKV]); h2 = bf1(hp[2 * DQKV]); }
        const bf16* src = blk + which * 8192 + d;
#pragma unroll
        for (int i = 0; i < 64; ++i) { float xp = 0.f; if (i < nvalid) xp = bf1(src[i * 128]);
            const float y = siluf_(w0 * h0 + w1 * h1 + w2 * h2 + w3 * xp); x[i] = (i < nvalid) ? y : 0.f; h0 = h1; h1 = h2; h2 = xp; }
    }
    if (c == NCH - 1) { const bf16* src = blk + which * 8192 + d; float* qo = a.out + O_PQ + (size_t)b * 3 * DQKV + colw;
#pragma unroll
        for (int i = 0; i < 3; ++i) qo[i * DQKV] = bf1(src[(nvalid - 3 + i) * 128]); }
#pragma unroll
    for (int i = 0; i < 64; ++i) { const float sq = wave_sum(x[i] * x[i]); if (lane == 0) PS[wq * 64 + i] = sq; }
    __syncthreads();
    {   const float sc = which == 0 ? 0.08838834764831845f : 1.f; LAS bf16* dst = (which == 0 ? QH : KH) + d;
#pragma unroll
        for (int i = 0; i < 64; ++i) { const float ss = PS[(2 * which) * 64 + i] + PS[(2 * which + 1) * 64 + i]; x[i] *= sc / sqrtf(ss + 1e-6f); dst[i * 136] = (bf16)f2bf(x[i]); } }
    if (which == 0) {
        const int pd = perm_k(d);
#pragma unroll
        for (int i = 0; i < 64; ++i) blk[i * 128 + pd] = (bf16)f2bf(x[i] * GV[128 + i]);
        const int colv = 2 * DM + h * DH + d;
        float w0 = a.in[13][colv], w1 = a.in[13][DQKV + colv], w2 = a.in[13][2 * DQKV + colv], w3 = a.in[13][3 * DQKV + colv];
        float h0 = 0.f, h1 = 0.f, h2 = 0.f;
        if (c > 0) { const bf16* hp = HALOQ + (size_t)(b * NCH + c - 1) * 3 * DQKV + colv; h0 = bf1(hp[0]); h1 = bf1(hp[DQKV]); h2 = bf1(hp[2 * DQKV]); }
        const bf16* src = blk + 2 * 8192 + d;
        if (c == NCH - 1) { float* qo = a.out + O_PQ + (size_t)b * 3 * DQKV + colv;
#pragma unroll
            for (int i = 0; i < 3; ++i) qo[i * DQKV] = bf1(src[(nvalid - 3 + i) * 128]); }
#pragma unroll
        for (int i = 0; i < 64; ++i) { float xp = 0.f; if (i < nvalid) xp = bf1(src[i * 128]);
            const float y = siluf_(w0 * h0 + w1 * h1 + w2 * h2 + w3 * xp); x[i] = (i < nvalid) ? y * GV[64 + i] : 0.f; h0 = h1; h1 = h2; h2 = xp; }
    } else {
        bf16* kd = KDT + d * 64;
#pragma unroll
        for (int g8 = 0; g8 < 8; ++g8) { float o[8];
#pragma unroll
            for (int pp = 0; pp < 8; ++pp) { const int i = 32 * (g8 >> 2) + 16 * (pp >> 2) + 4 * (g8 & 3) + (pp & 3); o[pp] = x[i] * GV[192 + i]; }
            v4u w; w.x = pk2(o[0], o[1]); w.y = pk2(o[2], o[3]); w.z = pk2(o[4], o[5]); w.w = pk2(o[6], o[7]);
            *(GAS v4u*)(kd + 8 * g8) = w; }
#pragma unroll
        for (int i = 0; i < 64; ++i) x[i] *= GV[64 + i] * GV[128 + i];
    }
    __syncthreads();
    {   const int fr = lane & 15, fq = lane >> 4;
        bf16x8v ak[4], aq[4];
#pragma unroll
        for (int sI = 0; sI < 4; ++sI) { ak[sI] = *(const LAS bf16x8v*)(KH + (16 * wq + fr) * 136 + 32 * sI + 8 * fq); aq[sI] = *(const LAS bf16x8v*)(QH + (16 * wq + fr) * 136 + 32 * sI + 8 * fq); }
        float Gi[4], Bi[4];
#pragma unroll
        for (int r = 0; r < 4; ++r) { Gi[r] = GV[16 * wq + 4 * fq + r]; Bi[r] = GV[64 + 16 * wq + 4 * fq + r]; }
#pragma unroll
        for (int nt = 0; nt < 4; ++nt) {
            const int j = 16 * nt + fr, pj = 32 * (nt >> 1) + 8 * (fr >> 2) + 4 * (nt & 1) + (fr & 3);
            if (nt <= wq) {
                f32x4 kk = {0.f, 0.f, 0.f, 0.f}, qk = {0.f, 0.f, 0.f, 0.f};
#pragma unroll
                for (int sI = 0; sI < 4; ++sI) { const bf16x8v bk = *(const LAS bf16x8v*)(KH + (16 * nt + fr) * 136 + 32 * sI + 8 * fq);
                    kk = __builtin_amdgcn_mfma_f32_16x16x32_bf16(ak[sI], bk, kk, 0, 0, 0); qk = __builtin_amdgcn_mfma_f32_16x16x32_bf16(aq[sI], bk, qk, 0, 0, 0); }
                const float Gj = GV[j];
#pragma unroll
                for (int r = 0; r < 4; ++r) { const int i = 16 * wq + 4 * fq + r; const float dec = (i >= j) ? __expf(Gi[r] - Gj) : 0.f;
                    MF[i * 68 + j] = (i > j) ? Bi[r] * kk[r] * dec : 0.f;
                    ATT[i * 64 + pj] = (bf16)f2bf(qk[r] * dec); }
            } else {
#pragma unroll
                for (int r = 0; r < 4; ++r) { const int i = 16 * wq + 4 * fq + r; ATT[i * 64 + pj] = (bf16)0; }
            }
        }
    }
    __syncthreads();
#pragma unroll
    for (int i = 1; i < 64; ++i) {
        float a0 = x[i], a1 = 0.f, a2 = 0.f, a3 = 0.f;
#pragma unroll
        for (int j4 = 0; j4 < i; j4 += 4) { const f32x4 mm = *(const LAS f32x4*)(MF + i * 68 + j4);
            a0 -= mm.x * x[j4]; if (j4 + 1 < i) a1 -= mm.y * x[j4 + 1]; if (j4 + 2 < i) a2 -= mm.z * x[j4 + 2]; if (j4 + 3 < i) a3 -= mm.w * x[j4 + 3]; }
        x[i] = (a0 + a1) + (a2 + a3);
    }
    if (which == 0) {
        bf16* u0 = blk + 2 * 8192 + (size_t)(d >> 4) * 1024 + (d & 15) * 4;
#pragma unroll
        for (int m = 0; m < 4; ++m)
#pragma unroll
            for (int q = 0; q < 4; ++q) { const int i = 16 * m + 4 * q; v2u w; w.x = pk2(x[i], x[i + 1]); w.y = pk2(x[i + 2], x[i + 3]); *(GAS v2u*)(u0 + m * 256 + q * 64) = w; }
    } else {
        const int pd = perm_k(d);
#pragma unroll
        for (int i = 0; i < 64; ++i) blk[8192 + i * 128 + pd] = (bf16)f2bf(x[i]);
    }
    __syncthreads();
}

constexpr int SC_W = 0, SC_QD = 17408, SC_KDT = 34816, SC_AT = 53248, SC_BUF = 62464, SC_RMS = 2 * SC_BUF;
__device__ __forceinline__ void scan_chain(const Args& a, LAS unsigned char* lds, int chain) {
    const int tid = threadIdx.x, lane = tid & 63, wave = __builtin_amdgcn_readfirstlane(tid >> 6), fr = lane & 15, fq = lane >> 4;
    const int b = chain >> 3, h = chain & 7;
    unsigned char* ws = a.ws;
    const bf16* QKVB = (const bf16*)(ws + WS_QKVB); const bf16* KDTg = (const bf16*)(ws + WS_KDT); const bf16* ATTg = (const bf16*)(ws + WS_ATTN); const float* LASTV = (const float*)(ws + WS_LASTV);
    bf16* ZS = (bf16*)(ws + WS_ZS);
    LAS float* RMS = (LAS float*)(lds + SC_RMS);
    const float gh = a.in[16][16 * wave + fr];
    f32x4 Sacc[8];
#pragma unroll
    for (int mt = 0; mt < 8; ++mt) Sacc[mt] = (f32x4){0.f, 0.f, 0.f, 0.f};
    v4u st[7];
    auto stage_load = [&](int c) {
        const size_t uq = (size_t)(b * NCH + c) * NH + h; const bf16* blk = QKVB + uq * QBLK;
#pragma unroll
        for (int k = 0; k < 2; ++k) { const int e = (tid + 512 * k) * 8; st[k] = *(const GAS v4u*)(blk + 8192 + e); st[2 + k] = *(const GAS v4u*)(blk + e); st[4 + k] = *(const GAS v4u*)(KDTg + uq * 8192 + e); }
        st[6] = *(const GAS v4u*)(ATTg + uq * 4096 + tid * 8);
    };
    auto stage_store = [&](int buf) {
        LAS unsigned char* base = lds + buf * SC_BUF;
#pragma unroll
        for (int k = 0; k < 2; ++k) { const int e = (tid + 512 * k) * 8; const int r = e >> 7, cc = e & 127;
            *(LAS v4u*)(base + SC_W + r * 272 + cc * 2) = st[k]; *(LAS v4u*)(base + SC_QD + r * 272 + cc * 2) = st[2 + k];
            const int r2 = e >> 6, c2 = e & 63; *(LAS v4u*)(base + SC_KDT + r2 * 144 + c2 * 2) = st[4 + k]; }
        { const int e = tid * 8, r2 = e >> 6, c2 = e & 63; *(LAS v4u*)(base + SC_AT + r2 * 144 + c2 * 2) = st[6]; }
    };
    stage_load(0); stage_store(0);
    __syncthreads();
    for (int c = 0; c < NCH; ++c) {
        const int buf = c & 1; LAS unsigned char* base = lds + buf * SC_BUF;
        const size_t uq = (size_t)(b * NCH + c) * NH + h;
        const int nvalid = (c == NCH - 1) ? TP - 64 * (NCH - 1) : 64;
        if (c + 1 < NCH) stage_load(c + 1);
        v2u u0p[4];
        { const bf16* u0 = QKVB + uq * QBLK + 2 * 8192 + wave * 1024 + lane * 4;
#pragma unroll
          for (int m = 0; m < 4; ++m) u0p[m] = *(const GAS v2u*)(u0 + m * 256); }
        const float last = LASTV[uq];
        const size_t zrow0 = (size_t)(b * TP + 64 * c) * DM + h * DH + 16 * wave + fr;
        float zs[4][4];
#pragma unroll
        for (int m = 0; m < 4; ++m)
#pragma unroll
            for (int r = 0; r < 4; ++r) { const int i = 16 * m + 4 * fq + r; zs[m][r] = (i < nvalid) ? bf1(ZS[zrow0 + (size_t)i * DM]) : 0.f; }
        bf16x8v Sb[4];
#pragma unroll
        for (int sI = 0; sI < 4; ++sI) { v4u w; w.x = pk2(Sacc[2 * sI][0], Sacc[2 * sI][1]); w.y = pk2(Sacc[2 * sI][2], Sacc[2 * sI][3]); w.z = pk2(Sacc[2 * sI + 1][0], Sacc[2 * sI + 1][1]); w.w = pk2(Sacc[2 * sI + 1][2], Sacc[2 * sI + 1][3]);
            Sb[sI] = __builtin_bit_cast(bf16x8v, w); }
        f32x4 u[4], o[4];
#pragma unroll
        for (int m = 0; m < 4; ++m) { f32x4 p = {0.f, 0.f, 0.f, 0.f}, oo = {0.f, 0.f, 0.f, 0.f};
#pragma unroll
            for (int sI = 0; sI < 4; ++sI) { const bf16x8v aw = *(const LAS bf16x8v*)(base + SC_W + (16 * m + fr) * 272 + (32 * sI + 8 * fq) * 2);
                const bf16x8v aqd = *(const LAS bf16x8v*)(base + SC_QD + (16 * m + fr) * 272 + (32 * sI + 8 * fq) * 2);
                p = __builtin_amdgcn_mfma_f32_16x16x32_bf16(aw, Sb[sI], p, 0, 0, 0); oo = __builtin_amdgcn_mfma_f32_16x16x32_bf16(aqd, Sb[sI], oo, 0, 0, 0); }
            u[m] = (f32x4){bflo(u0p[m].x), bfhi(u0p[m].x), bflo(u0p[m].y), bfhi(u0p[m].y)} - p; o[m] = oo; }
        bf16x8v Ub[2];
#pragma unroll
        for (int s2 = 0; s2 < 2; ++s2) { v4u w; w.x = pk2(u[2 * s2][0], u[2 * s2][1]); w.y = pk2(u[2 * s2][2], u[2 * s2][3]); w.z = pk2(u[2 * s2 + 1][0], u[2 * s2 + 1][1]); w.w = pk2(u[2 * s2 + 1][2], u[2 * s2 + 1][3]);
            Ub[s2] = __builtin_bit_cast(bf16x8v, w); }
#pragma unroll
        for (int m = 0; m < 4; ++m)
#pragma unroll
            for (int s2 = 0; s2 < 2; ++s2) { const bf16x8v aa = *(const LAS bf16x8v*)(base + SC_AT + (16 * m + fr) * 144 + (32 * s2 + 8 * fq) * 2);
                o[m] = __builtin_amdgcn_mfma_f32_16x16x32_bf16(aa, Ub[s2], o[m], 0, 0, 0); }
#pragma unroll
        for (int mt = 0; mt < 8; ++mt) { f32x4 sacc = Sacc[mt] * last;
#pragma unroll
            for (int s2 = 0; s2 < 2; ++s2) { const bf16x8v ak = *(const LAS bf16x8v*)(base + SC_KDT + (16 * mt + fr) * 144 + (32 * s2 + 8 * fq) * 2);
                sacc = __builtin_amdgcn_mfma_f32_16x16x32_bf16(ak, Ub[s2], sacc, 0, 0, 0); }
            Sacc[mt] = sacc; }
        LAS float* rm = RMS + (c & 1) * 512;
#pragma unroll
        for (int m = 0; m < 4; ++m)
#pragma unroll
            for (int r = 0; r < 4; ++r) { float v = o[m][r] * o[m][r]; v += __shfl_xor(v, 1); v += __shfl_xor(v, 2); v += __shfl_xor(v, 4); v += __shfl_xor(v, 8);
                if (fr == 0) rm[(16 * m + 4 * fq + r) * 8 + wave] = v; }
        if (c + 1 < NCH) stage_store(buf ^ 1);
        __syncthreads();
#pragma unroll
        for (int m = 0; m < 4; ++m)
#pragma unroll
            for (int r = 0; r < 4; ++r) { const int i = 16 * m + 4 * fq + r; const f32x4 p0 = *(const LAS f32x4*)(rm + i * 8), p1 = *(const LAS f32x4*)(rm + i * 8 + 4);
                const float ss = ((p0.x + p0.y) + (p0.z + p0.w)) + ((p1.x + p1.y) + (p1.z + p1.w));
                const float on = o[m][r] * (1.f / sqrtf(ss * (1.f / DH) + EPS)) * gh * zs[m][r];
                if (i < nvalid) ZS[zrow0 + (size_t)i * DM] = (bf16)f2bf(on); }
    }
    { float* so = a.out + O_PD + ((size_t)(b * NH + h) * DH) * DH + 16 * wave + fr;
#pragma unroll
      for (int mt = 0; mt < 8; ++mt)
#pragma unroll
          for (int r = 0; r < 4; ++r) so[(size_t)(16 * mt + 4 * fq + r) * DH] = Sacc[mt][r]; }
    __syncthreads();
}

constexpr int NPHASES = 10;
__global__ void __launch_bounds__(NWAVES * 64, 2) fwd_kernel(Args args) {
    extern __shared__ __attribute__((aligned(16))) unsigned char lds_raw[];
    LAS unsigned char* lds = (LAS unsigned char*)lds_raw;
    volatile LAS unsigned* MISC = (volatile LAS unsigned*)(lds + MISC_OFF);
    const int tid = threadIdx.x, lane = tid & 63, wave = __builtin_amdgcn_readfirstlane(tid >> 6);
    const int G = gridDim.x, bx = blockIdx.x;
    const int vcu = (G % 8 == 0) ? (bx % 8) * (G / 8) + bx / 8 : bx;
    unsigned char* ws = args.ws;
    gu32* ctl = (gu32*)(ws + WS_CTL);
    for (int u = tid; u < (LDS_BYTES - LDSCTL_OFF) / 4; u += NWAVES * 64) ((LAS unsigned*)(lds + LDSCTL_OFF))[u] = 0u;
    __syncthreads();
    XcdBarrier bar; bar.bar = (unsigned*)(ctl + CW_BAR); bar.x = 0; bar.st = nullptr;
    const int lo = args.ph_lo, hi = args.ph_hi;
    if (hi - lo > 1) bar = xcd_barrier_post((unsigned*)(ctl + CW_BAR), MISC + 8);
#ifndef PH_MASK
#define PH_MASK 0x3ff
#endif
#define IN(k) (((PH_MASK >> (k)) & 1) && lo <= (k) && (k) < hi)
#define SEAM(k) do { if (IN(k) && IN((k) + 1)) xcd_barrier(bar); } while (0)
    bf16* WIN = (bf16*)(ws + WS_WIN); bf16* WC = (bf16*)(ws + WS_WC); bf16* WD = (bf16*)(ws + WS_WD); bf16* WO = (bf16*)(ws + WS_WO); bf16* WUP = (bf16*)(ws + WS_WUP); bf16* WDN = (bf16*)(ws + WS_WDN);
    bf16* H = (bf16*)(ws + WS_H); bf16* GLU = (bf16*)(ws + WS_GLU); bf16* QKVB = (bf16*)(ws + WS_QKVB); bf16* QS = (bf16*)(ws + WS_QS); bf16* ZS = (bf16*)(ws + WS_ZS);
    bf16* HALOQ = (bf16*)(ws + WS_HALOQ); bf16* HALOC = (bf16*)(ws + WS_HALOC);
    bf16* SGC = (bf16*)args.out; bf16* SGD = (bf16*)args.out + (size_t)M2 * DM;
    bf16* MIX = (bf16*)(ws + WS_MIX); bf16* XG = (bf16*)(ws + WS_XG); bf16* HM = (bf16*)(ws + WS_HM); bf16* C = (bf16*)(ws + WS_C);
    float* BETAG = (float*)(ws + WS_BETAG);
    const int gw = vcu * NWAVES + wave, NGW = G * NWAVES;

    if (IN(0)) {
        LAS float* scr = (LAS float*)(lds + RING_OFF + wave * 16384);
        constexpr int I_IN = 16 * (NIN / 32), I_SQ = 16 * 32, I_UP = 16 * (DFF / 32), I_DN = (DFF / 64) * 32;
        constexpr int NITEMS = I_IN + 3 * I_SQ + I_UP + I_DN;
        for (int it = gw; it < NITEMS; it += NGW) {
            int r = it;
            if (r < I_IN) { const int nb = r >> 4, kb = r & 15; int src, nv; win_src(nb, src, nv); p0_transpose_item(args.in[7], DIN, DM, WIN, nb * 32, src, nv, scr, kb, lane); continue; } r -= I_IN;
            if (r < I_SQ) { p0_transpose_item(args.in[12], DM, DM, WC, (r >> 4) * 32, (r >> 4) * 32, 32, scr, r & 15, lane); continue; } r -= I_SQ;
            if (r < I_SQ) { p0_transpose_item(args.in[17], DM, DM, WD, (r >> 4) * 32, (r >> 4) * 32, 32, scr, r & 15, lane); continue; } r -= I_SQ;
            if (r < I_SQ) { p0_transpose_item(args.in[18], DM, DM, WO, (r >> 4) * 32, (r >> 4) * 32, 32, scr, r & 15, lane); continue; } r -= I_SQ;
            if (r < I_UP) { p0_transpose_item(args.in[20], DFF, DM, WUP, (r >> 4) * 32, (r >> 4) * 32, 32, scr, r & 15, lane); continue; } r -= I_UP;
            p0_transpose_item(args.in[21], DM, DFF, WDN, (r >> 6) * 32, (r >> 6) * 32, 32, scr, r & 63, lane);
        }
        for (int m = gw; m < MP; m += NGW) {
            if (m >= MR) { GAS unsigned long long* o8 = (GAS unsigned long long*)(H + (size_t)m * DM) + lane;
#pragma unroll
                for (int jj = 0; jj < 4; ++jj) o8[64 * jj] = 0ull; continue; }
            const float* src;
            if (m >= RP) src = args.in[1] + (size_t)(m - RP) * DM;
            else { const int b = m / TP, t = m - b * TP; src = t < NMETA ? args.in[5] + (size_t)t * DM : args.in[0] + ((size_t)b * SEQ + (t - NMETA)) * DM; }
            rms_row_to_bf16(src, args.in[6], H + (size_t)m * DM, lane);
        }
    }
    SEAM(0);
    if (IN(1)) {
        pg8::Gemm g{H, WIN, MP, NIN, DM}; pg8::StaticOrder S; S.init(MP, NIN, G, bx);
        EpiIn E{GLU, QKVB, QS, HALOQ, HALOC, ZS, SGC, SGD, BETAG, args.in[14], args.in[15]};
        pg8::gemm_phase<EpiIn, pg8::StaticOrder, true, true>(lds + RING_OFF, g, S, E);
    }
    SEAM(1);
    if (IN(2)) {
        constexpr int N_CP = BP * NRUN, N_IP = BP * NCH * NH / 2, N_SD = BS * NH / 4, N_CS = BS, N_ITEMS = N_CP + N_IP + N_SD + N_CS;
        volatile LAS int* qslot = (volatile LAS int*)(lds + MISC_OFF + 64);
        for (;;) {
            if (tid == 0) *qslot = (int)__hip_atomic_fetch_add((unsigned*)(ctl + 2048), 1u, __ATOMIC_RELAXED, __HIP_MEMORY_SCOPE_AGENT);
            __syncthreads();
            int it = *qslot;
            __syncthreads();
            if (it >= N_ITEMS) break;
            if (it < N_CP) { conv_unit(args, lds, 0, it / NRUN, it % NRUN); continue; } it -= N_CP;
            if (it < N_IP) { intra_pair(args, lds, it); continue; } it -= N_IP;
            if (it < N_SD) { delta_item(args, lds, it); continue; } it -= N_SD;
            conv_unit(args, lds, 1, it, 0);
        }
    }
    SEAM(2);
    if (IN(3)) {
        if (bx < BP * NH) scan_chain(args, lds, bx);
        else {
            pg8::Gemm g{C, WC, MP, DM, DM}; pg8::StaticOrder S; S.init(MP, DM, G - BP * NH, bx - BP * NH);
            EpiGate<0> E{SGC, nullptr, SGC};
            pg8::gemm_phase<EpiGate<0>, pg8::StaticOrder, true, true>(lds + RING_OFF, g, S, E);
        }
    }
    SEAM(3);
    if (IN(4)) {
        pg8::Gemm g{ZS, WD, MP, DM, DM}; pg8::StaticOrder S; S.init(MP, DM, G, bx);
        EpiGate<1> E{SGD, SGC, MIX};
        pg8::gemm_phase<EpiGate<1>, pg8::StaticOrder, true, true>(lds + RING_OFF, g, S, E);
    }
    SEAM(4);
    if (IN(5)) {
        pg8::Gemm g{MIX, WO, M2, DM, DM}; pg8::StaticOrder S; S.init(M2, DM, G, bx);
        EpiRes<0> E{args.in[0], args.in[1], args.out};
        pg8::gemm_phase<EpiRes<0>, pg8::StaticOrder, true, true>(lds + RING_OFF, g, S, E);
    }
    SEAM(5);
    if (IN(6)) {
        for (int m = gw; m < M2; m += NGW) rms_row_to_bf16(args.out + (size_t)m * DM, args.in[19], XG + (size_t)m * DM, lane);
    }
    SEAM(6);
    if (IN(7)) {
        pg8::Gemm g{XG, WUP, M2, DFF, DM}; pg8::StaticOrder S; S.init(M2, DFF, G, bx);
        EpiUp E{HM};
        pg8::gemm_phase<EpiUp, pg8::StaticOrder, true, true>(lds + RING_OFF, g, S, E);
    }
    SEAM(7);
    if (IN(8)) {
        pg8::Gemm g{HM, WDN, M2, DM, DFF}; pg8::StaticOrder S; S.init(M2, DM, G, bx);
        EpiRes<1> E{nullptr, nullptr, args.out};
        pg8::gemm_phase<EpiRes<1>, pg8::StaticOrder, true, true>(lds + RING_OFF, g, S, E);
    }
    SEAM(8);
    if (IN(9)) {
        for (int m = gw; m < M2; m += NGW) {
            float* xrow = args.out + (size_t)m * DM;
            GAS f32x4* xr = (GAS f32x4*)xrow + lane; const GAS f32x4* gr = (const GAS f32x4*)args.in[22] + lane;
            f32x4 v[4]; float s = 0.f;
#pragma unroll
            for (int jj = 0; jj < 4; ++jj) { v[jj] = xr[64 * jj]; s += (v[jj].x * v[jj].x + v[jj].y * v[jj].y) + (v[jj].z * v[jj].z + v[jj].w * v[jj].w); }
            const float rstd = 1.f / sqrtf(wave_sum(s) * (1.f / DM) + EPS);
#pragma unroll
            for (int jj = 0; jj < 4; ++jj) xr[64 * jj] = v[jj] * rstd * gr[64 * jj];
        }
    }
#undef IN
#undef SEAM
}

extern "C" void kernel_launch(void* const* d_in, const int* in_sizes, int n_in, void* d_out, int out_size, void* d_ws, size_t ws_size, hipStream_t stream) {
    static int grid = 0;
    if (grid == 0) {
        if (n_in != 23 || (size_t)out_size != O_END || ws_size < WS_END) { fprintf(stderr, "kernel_launch: unexpected shapes n_in %d out %d ws %zu\n", n_in, out_size, ws_size); grid = -1; return; }
        int dev = 0, cus = 0, per_cu = 0;
        if (hipGetDevice(&dev) != hipSuccess || hipDeviceGetAttribute(&cus, hipDeviceAttributeMultiprocessorCount, dev) != hipSuccess) { grid = -1; return; }
        if (hipFuncSetAttribute((const void*)fwd_kernel, hipFuncAttributeMaxDynamicSharedMemorySize, LDS_BYTES) != hipSuccess) { fprintf(stderr, "kernel_launch: hipFuncSetAttribute failed\n"); grid = -1; return; }
        if (hipOccupancyMaxActiveBlocksPerMultiprocessor(&per_cu, (const void*)fwd_kernel, NWAVES * 64, LDS_BYTES) != hipSuccess || per_cu < 1)
            fprintf(stderr, "kernel_launch: occupancy query reports %d\n", per_cu);
        (void)hipGetLastError();
        grid = cus;
    }
    if (grid < 0) return;
    if (hipMemsetAsync((char*)d_ws + WS_CTL, 0, CTL_ZERO_BYTES, stream) != hipSuccess) return;
    Args a{};
    for (int i = 0; i < 23; ++i) a.in[i] = (const float*)d_in[i];
    a.out = (float*)d_out; a.ws = (unsigned char*)d_ws;
#if MK_N_LAUNCHES == 1
    a.ph_lo = 0; a.ph_hi = NPHASES;
    hipLaunchKernelGGL(fwd_kernel, dim3(grid), dim3(NWAVES * 64), LDS_BYTES, stream, a);
#else
    for (int p = 0; p < NPHASES; ++p) { a.ph_lo = p; a.ph_hi = p + 1; hipLaunchKernelGGL(fwd_kernel, dim3(grid), dim3(NWAVES * 64), LDS_BYTES, stream, a); }
#endif
}
```

```cpp
#include <hip/hip_runtime.h>
#include <cstdio>
#include <cstdint>

#ifndef MK_N_LAUNCHES
#define MK_N_LAUNCHES 1
#endif

namespace pg8 {
#define PG8_LAS __attribute__((address_space(3)))
typedef unsigned short bf16_t;
typedef short bf16x8 __attribute__((ext_vector_type(8)));
typedef float f32x4 __attribute__((ext_vector_type(4)));
typedef unsigned u32x4 __attribute__((ext_vector_type(4)));
constexpr int BM = 256, BK = 64, HALF = 128, HTB = HALF * BK * 2, STAGE_BYTES = 8 * HTB, NXCD = 8, WGM = 8;

__host__ __device__ __forceinline__ int lds_byte(int r, int c) { const int st = (r >> 4) * 2 + (c >> 5), rr = r & 15, cc = c & 31, ob = rr * 64 + cc * 2; return st * 1024 + (ob ^ (((ob >> 9) & 1) << 5)); }
__host__ __device__ __forceinline__ void stage_rc(int b, int& R, int& C) { const int st = b / 1024, sb = b % 1024, swz = sb ^ (((sb >> 9) & 1) << 5); R = (st >> 1) * 16 + swz / 64; C = (st & 1) * 32 + (swz % 64) / 2; }
__host__ __device__ __forceinline__ int perm32(int rho) { const int n = rho >> 4, i = rho & 15; return 8 * (i >> 2) + 4 * n + (i & 3); }

struct Unit { int pm, pn; };
struct Gemm { const bf16_t* A; const bf16_t* Bt; int M, N, K; };

struct StaticOrder {
    int nM, nN, nwg, G, c;
    __host__ __device__ void init(int M, int N, int G_, int c_) { nM = M / BM; nN = N / BM; nwg = nM * nN; G = G_; c = c_; }
    __host__ __device__ bool next(int i, Unit& u) const {
        const long L = (long)i * G + c; if (L >= nwg) return false;
        int wgid = (int)L; { const int q = nwg / NXCD, r = nwg % NXCD, xcd = wgid % NXCD, off = wgid / NXCD; wgid = (xcd < r ? xcd * (q + 1) : r * (q + 1) + (xcd - r) * q) + off; }
        const int nig = WGM * nN, gid = wgid / nig, fm = gid * WGM, gsz = (nM - fm) < WGM ? (nM - fm) : WGM;
        u.pm = fm + ((wgid % nig) % gsz); u.pn = (wgid % nig) / gsz; return true;
    }
    __device__ __forceinline__ void a_ready(const Unit&) const {}
    __device__ __forceinline__ void done(const Unit&) const {}
};

__device__ __forceinline__ unsigned cvt_pk_bf16(float lo, float hi) { unsigned r; asm volatile("v_cvt_pk_bf16_f32 %0, %1, %2" : "=v"(r) : "v"(lo), "v"(hi)); return r; }

template <class Epi, class Sched, bool ALIGN_EPI = false, bool SP2 = false>
__device__ __forceinline__ void gemm_phase(PG8_LAS unsigned char* lds, const Gemm g, const Sched& S, const Epi& E) {
    const int tid = threadIdx.x, wid = __builtin_amdgcn_readfirstlane(tid >> 6), lane = tid & 63, wr = wid >> 2, wc = wid & 3, fr = lane & 15, fq = lane >> 4;
    const int K = g.K, nt = K / BK;
    unsigned voffA[2], voffB[2];
#pragma unroll
    for (int i = 0; i < 2; ++i) { int R, C; stage_rc(tid * 16 + i * 8192, R, C); const int Rb = Epi::PERM ? ((R & ~31) + perm32(R & 31)) : R;
        voffA[i] = (unsigned)(R * K + C) * 2u; voffB[i] = (unsigned)(Rb * K + C) * 2u; }
    const size_t kstep = (size_t)(BK * 2);
    const size_t hstep = (size_t)HALF * K * 2;
    const size_t tstep = 2 * hstep;
    const unsigned ldsw = (unsigned)wid * 1024u;
    const int aoff = lds_byte(wr * 64 + fr, fq * 8), boff = lds_byte(wc * 32 + fr, fq * 8);
#define PG8_SA(b, h) (((b) * 2 + (h)) * HTB)
#define PG8_SB(b, h) ((4 + (b) * 2 + (h)) * HTB)
#define PG8_STAGE(bufoff, gbase, voff) do { _Pragma("unroll") for (int _i = 0; _i < 2; ++_i) \
        __builtin_amdgcn_global_load_lds((const unsigned*)((const char*)(gbase) + (voff)[_i]), (PG8_LAS unsigned*)(lds + (bufoff) + ldsw + _i * 8192), 16, 0, 0); } while (0)
#define PG8_LDA(dst, b, h) do { _Pragma("unroll") for (int m = 0; m < 4; ++m) _Pragma("unroll") for (int k = 0; k < 2; ++k) dst[m][k] = *(const PG8_LAS bf16x8*)(lds + PG8_SA(b, h) + aoff + m * 2048 + k * 1024); } while (0)
#define PG8_LDB(dst, b, h) do { _Pragma("unroll") for (int n = 0; n < 2; ++n) _Pragma("unroll") for (int k = 0; k < 2; ++k) dst[n][k] = *(const PG8_LAS bf16x8*)(lds + PG8_SB(b, h) + boff + n * 2048 + k * 1024); } while (0)
#define PG8_MMA(ai, bj, At, Bt) do { __builtin_amdgcn_s_setprio(1); _Pragma("unroll") for (int m = 0; m < 4; ++m) _Pragma("unroll") for (int n = 0; n < 2; ++n) _Pragma("unroll") for (int k = 0; k < 2; ++k) \
        acc[ai][bj][m][n] = __builtin_amdgcn_mfma_f32_16x16x32_bf16(Bt[n][k], At[m][k], acc[ai][bj][m][n], 0, 0, 0); __builtin_amdgcn_s_setprio(0); } while (0)
#define PG8_WAIT_V(n) asm volatile("s_waitcnt vmcnt(" #n ")" ::: "memory")
#define PG8_WAIT_L(n) asm volatile("s_waitcnt lgkmcnt(" #n ")" ::: "memory")
#define PG8_BAR __builtin_amdgcn_s_barrier()
#define PG8_SCHED __builtin_amdgcn_sched_barrier(0)
    Unit cur, nxt; int ui = 0;
    if (!S.next(0, cur)) return;
    f32x4 acc[2][2][4][2];
#pragma unroll
    for (int a = 0; a < 2; ++a)
#pragma unroll
        for (int b = 0; b < 2; ++b)
#pragma unroll
            for (int m = 0; m < 4; ++m)
#pragma unroll
                for (int n = 0; n < 2; ++n) acc[a][b][m][n] = (f32x4){0.f, 0.f, 0.f, 0.f};
    bf16x8 At[4][2], B0[2][2], B1[2][2];
    const char* cA = (const char*)g.A + (size_t)cur.pm * tstep; const char* cB = (const char*)g.Bt + (size_t)cur.pn * tstep;
    S.a_ready(cur);
    if constexpr (SP2) {
        PG8_STAGE(PG8_SB(0, 0), cB, voffB); PG8_STAGE(PG8_SB(0, 1), cB + hstep, voffB); PG8_STAGE(PG8_SA(0, 0), cA, voffA); PG8_STAGE(PG8_SA(0, 1), cA + hstep, voffA);
        if (wr == 1) PG8_BAR;
        PG8_WAIT_V(2); PG8_BAR;
        PG8_STAGE(PG8_SB(1, 0), cB + kstep, voffB); PG8_STAGE(PG8_SA(1, 0), cA + kstep, voffA); PG8_STAGE(PG8_SB(1, 1), cB + hstep + kstep, voffB);
        PG8_WAIT_V(6); PG8_BAR;
    } else {
        PG8_STAGE(PG8_SB(0, 0), cB, voffB); PG8_STAGE(PG8_SA(0, 0), cA, voffA); PG8_STAGE(PG8_SB(0, 1), cB + hstep, voffB); PG8_STAGE(PG8_SA(0, 1), cA + hstep, voffA);
        if (wr == 1) PG8_BAR;
        PG8_WAIT_V(4); PG8_BAR;
        PG8_STAGE(PG8_SB(1, 0), cB + kstep, voffB); PG8_STAGE(PG8_SA(1, 0), cA + kstep, voffA); PG8_STAGE(PG8_SB(1, 1), cB + hstep + kstep, voffB);
        PG8_WAIT_V(6); PG8_BAR;
    }
    for (;;) {
        const bool has_next = S.next(ui + 1, nxt);
        const char* nA = has_next ? (const char*)g.A + (size_t)nxt.pm * tstep : cA; const char* nB = has_next ? (const char*)g.Bt + (size_t)nxt.pn * tstep : cB;
        for (int t = 0; t < nt; t += 2) {
            const bool last = (t == nt - 2);
            const char* a1 = cA + (size_t)(t + 1) * kstep;
            const char* a2 = last ? nA : cA + (size_t)(t + 2) * kstep; const char* b2 = last ? nB : cB + (size_t)(t + 2) * kstep;
            const char* a3 = a2 + kstep; const char* b3 = b2 + kstep;
            if (last && has_next) S.a_ready(nxt);
            if constexpr (SP2) {
            PG8_LDB(B0, 0, 0); PG8_LDB(B1, 0, 1); PG8_SCHED; PG8_LDA(At, 0, 0); PG8_STAGE(PG8_SA(1, 1), a1 + hstep, voffA);
            PG8_WAIT_V(8); PG8_WAIT_L(0); PG8_BAR; PG8_MMA(0, 0, At, B0); PG8_MMA(0, 1, At, B1); PG8_BAR; PG8_SCHED;
            PG8_LDA(At, 0, 1); PG8_STAGE(PG8_SB(0, 0), b2, voffB); PG8_STAGE(PG8_SB(0, 1), b2 + hstep, voffB); PG8_STAGE(PG8_SA(0, 0), a2, voffA);
            PG8_WAIT_V(8); PG8_WAIT_L(0); PG8_BAR; PG8_MMA(1, 0, At, B0); PG8_MMA(1, 1, At, B1); PG8_BAR; PG8_SCHED;
            PG8_LDB(B0, 1, 0); PG8_LDB(B1, 1, 1); PG8_SCHED; PG8_LDA(At, 1, 0); PG8_STAGE(PG8_SA(0, 1), a2 + hstep, voffA);
            PG8_WAIT_V(8); PG8_WAIT_L(0); PG8_BAR; PG8_MMA(0, 0, At, B0); PG8_MMA(0, 1, At, B1); PG8_BAR; PG8_SCHED;
            PG8_LDA(At, 1, 1); PG8_STAGE(PG8_SB(1, 0), b3, voffB); PG8_STAGE(PG8_SB(1, 1), b3 + hstep, voffB); PG8_STAGE(PG8_SA(1, 0), a3, voffA);
            PG8_WAIT_V(8); PG8_WAIT_L(0); PG8_BAR; PG8_MMA(1, 0, At, B0); PG8_MMA(1, 1, At, B1); PG8_BAR; PG8_SCHED;
            } else {
            PG8_LDB(B0, 0, 0); PG8_SCHED; PG8_LDA(At, 0, 0); PG8_STAGE(PG8_SA(1, 1), a1 + hstep, voffA);
            PG8_WAIT_L(8); PG8_BAR; PG8_WAIT_L(0); PG8_MMA(0, 0, At, B0); PG8_BAR; PG8_SCHED;
            PG8_LDB(B1, 0, 1); PG8_STAGE(PG8_SB(0, 0), b2, voffB);
            PG8_BAR; PG8_WAIT_L(0); PG8_MMA(0, 1, At, B1); PG8_BAR;
            PG8_LDA(At, 0, 1); PG8_STAGE(PG8_SA(0, 0), a2, voffA);
            PG8_BAR; PG8_WAIT_L(0); PG8_MMA(1, 0, At, B0); PG8_BAR; PG8_SCHED;
            PG8_STAGE(PG8_SB(0, 1), b2 + hstep, voffB);
            PG8_WAIT_V(6); PG8_BAR; PG8_MMA(1, 1, At, B1); PG8_BAR;
            PG8_LDB(B0, 1, 0); PG8_SCHED; PG8_LDA(At, 1, 0); PG8_STAGE(PG8_SA(0, 1), a2 + hstep, voffA);
            PG8_WAIT_L(8); PG8_BAR; PG8_WAIT_L(0); PG8_MMA(0, 0, At, B0); PG8_BAR; PG8_SCHED;
            PG8_LDB(B1, 1, 1); PG8_STAGE(PG8_SB(1, 0), b3, voffB);
            PG8_BAR; PG8_WAIT_L(0); PG8_MMA(0, 1, At, B1); PG8_BAR;
            PG8_LDA(At, 1, 1); PG8_STAGE(PG8_SA(1, 0), a3, voffA);
            PG8_BAR; PG8_WAIT_L(0); PG8_MMA(1, 0, At, B0); PG8_BAR; PG8_SCHED;
            PG8_STAGE(PG8_SB(1, 1), b3 + hstep, voffB);
            PG8_WAIT_V(6); PG8_BAR; PG8_MMA(1, 1, At, B1); PG8_BAR;
            }
        }
        if constexpr (ALIGN_EPI) { if (wr == 0) PG8_BAR; }
        E(acc, cur, wr, wc, fr, fq); S.done(cur);
        if (!has_next) break;
#pragma unroll
        for (int a = 0; a < 2; ++a)
#pragma unroll
            for (int b = 0; b < 2; ++b)
#pragma unroll
                for (int m = 0; m < 4; ++m)
#pragma unroll
                    for (int n = 0; n < 2; ++n) acc[a][b][m][n] = (f32x4){0.f, 0.f, 0.f, 0.f};
        cur = nxt; cA = nA; cB = nB; ++ui;
        if constexpr (ALIGN_EPI) { if (wr == 1) PG8_BAR; }
    }
    PG8_WAIT_V(0);
    if constexpr (!ALIGN_EPI) { if (wr == 0) PG8_BAR; }
    PG8_BAR;
#undef PG8_SA
#undef PG8_SB
#undef PG8_STAGE
#undef PG8_LDA
#undef PG8_LDB
#undef PG8_MMA
#undef PG8_WAIT_V
#undef PG8_WAIT_L
#undef PG8_BAR
#undef PG8_SCHED
}
}

constexpr int NWAVES = 8;
constexpr int DM = 1024, BP = 8, SEQ = 2048, NMETA = 16, TP = SEQ + NMETA, BS = 128, TS = 4;
constexpr int RP = BP * TP;
constexpr int RS = BS * TS;
constexpr int MR = RP + RS;
constexpr int MP = 17152;
constexpr int M2 = BP * SEQ + RS;
constexpr int NH = 8, DH = 128, DQKV = 3072, DFF = 4096, KC = 31, KS = 4;
constexpr int NIN = 8448;
constexpr int DIN = 8208;
constexpr float EPS = 1e-6f;

constexpr size_t O_YP = 0, O_YS = 16777216, O_PC = 17301504, O_PQ = 17547264, O_PD = 17620992, O_SC = 18669568, O_SQ = 22601728, O_SD = 23781376, O_END = 40558592;

constexpr size_t MiB = 1u << 20;
constexpr size_t WS_CTL = 0, CTL_ZERO_BYTES = 1 * MiB;
constexpr size_t WS_BETAG = 1 * MiB;
constexpr size_t WS_LASTV = 9 * MiB / 4;
constexpr size_t WS_HALOQ = 5 * MiB / 2;
constexpr size_t WS_WC = 29 * MiB / 4, WS_WD = WS_WC + 2 * MiB, WS_WO = WS_WD + 2 * MiB, WS_WUP = WS_WO + 2 * MiB, WS_WDN = WS_WUP + 8 * MiB;
constexpr size_t WS_GLU = 117 * MiB / 4;
constexpr size_t WS_QKVB = 63 * MiB;
constexpr size_t WS_QS = 162 * MiB;
constexpr size_t WS_ZS = 165 * MiB;
constexpr size_t WS_H = 397 * MiB / 2;
constexpr size_t WS_WIN = 232 * MiB;
constexpr size_t WS_HALOC = 497 * MiB / 2;
constexpr size_t WS_KDT = WS_H, WS_ATTN = 463 * MiB / 2;
constexpr size_t WS_MIX = WS_QKVB, WS_XG = WS_GLU, WS_HM = WS_QKVB, WS_C = WS_GLU;
constexpr size_t WS_END = 256 * MiB;
constexpr int NRUN = 16, RUNL = TP / NRUN;
static_assert(TP - 64 * 32 == 16 && NRUN * RUNL == TP && WS_HALOC + (size_t)BP * NRUN * 30 * DM * 2 <= WS_END, "conv runs");
constexpr int NCH = 33, QBLK = 3 * 64 * 128;
static_assert(WS_WIN + (size_t)NIN * DM * 2 <= WS_HALOC && WS_WDN + 8 * MiB <= WS_GLU && WS_GLU + (size_t)MP * DM * 2 <= WS_QKVB && WS_HALOQ + (size_t)BP * 33 * 3 * 3072 * 2 <= WS_WC, "ws map");
static_assert(WS_ZS + (size_t)MP * DM * 2 <= WS_H && WS_H + (size_t)MP * DM * 2 <= WS_WIN, "ws map 2");
static_assert(WS_QKVB + (size_t)BP * NCH * NH * QBLK * 2 <= WS_QS, "ws map qkvb");
static_assert(WS_HM + (size_t)M2 * DFF * 2 <= WS_H, "ws map hm");
static_assert(WS_KDT + (size_t)BP * NCH * NH * 8192 * 2 <= WS_ATTN && WS_ATTN + (size_t)BP * NCH * NH * 4096 * 2 <= WS_HALOC, "ws map kdt");
constexpr int CW_TMO = 0, CW_CODE = 1, CW_BAR = 4096;

constexpr int RING_OFF = 0, RING_BYTES = 131072;
constexpr int LDSCTL_OFF = RING_BYTES, MISC_OFF = LDSCTL_OFF + 320;
constexpr int LDS_BYTES = 147456;

#define GAS __attribute__((address_space(1)))
#define LAS __attribute__((address_space(3)))
typedef unsigned short bf16;
typedef unsigned v4u __attribute__((ext_vector_type(4)));
typedef unsigned v2u __attribute__((ext_vector_type(2)));
typedef float f32x4 __attribute__((ext_vector_type(4)));
typedef float f32x2 __attribute__((ext_vector_type(2)));
typedef GAS unsigned gu32;
#define RLX_AGENT __ATOMIC_RELAXED, __HIP_MEMORY_SCOPE_AGENT
#define LDS_WAIT() asm volatile("s_waitcnt lgkmcnt(0)" ::: "memory")
#define VM_WAIT() asm volatile("s_waitcnt vmcnt(0)" ::: "memory")
__device__ __forceinline__ unsigned f2bf(float f) { unsigned u = __builtin_bit_cast(unsigned, f); return (u + 0x7fffu + ((u >> 16) & 1u)) >> 16; }
__device__ __forceinline__ unsigned pk2(float lo, float hi) { return f2bf(lo) | (f2bf(hi) << 16); }
__device__ __forceinline__ float bflo(unsigned w) { return __builtin_bit_cast(float, w << 16); }
__device__ __forceinline__ float bfhi(unsigned w) { return __builtin_bit_cast(float, w & 0xffff0000u); }
__device__ __forceinline__ float bf1(bf16 b) { return __builtin_bit_cast(float, ((unsigned)b) << 16); }
__device__ __forceinline__ float sigmoidf_(float x) { return __builtin_amdgcn_rcpf(1.f + __expf(-x)); }
__device__ __forceinline__ float siluf_(float x) { return x * sigmoidf_(x); }

#define XB_TMO      128
#define XB_XCNT(j)  (256  + 64 * (j))
#define XB_XSUB(j)  (1280 + 64 * (j))
#define XB_XGEN(j)  (2304 + 64 * (j))
#define XB_TOP      3328
#define XB_TOPGEN   3392
#define XCD_BAR_WORDS 3456
#define XB_SPIN_CAP (1u << 18)
__device__ __forceinline__ unsigned xb_ld(unsigned* p)              { return __hip_atomic_load(p, __ATOMIC_RELAXED, __HIP_MEMORY_SCOPE_AGENT); }
__device__ __forceinline__ unsigned xb_add(unsigned* p, unsigned v) { return __hip_atomic_fetch_add(p, v, __ATOMIC_RELAXED, __HIP_MEMORY_SCOPE_AGENT); }
__device__ __forceinline__ unsigned xb_xcc_id() { return (unsigned)__builtin_amdgcn_s_getreg((3 << 11) | 20) & 0xFu; }
#define XB_SPIN(cond, bar) do { unsigned _sp = 0; while (cond) { __builtin_amdgcn_s_sleep(1); \
    if ((++_sp & 255u) == 0u) { if (xb_ld(&(bar)[XB_TMO])) break; if (_sp > XB_SPIN_CAP) { atomicAdd(&(bar)[XB_TMO], 1u); break; } } } } while (0)
struct XcdBarrier { unsigned* bar; unsigned x; volatile LAS unsigned* st; };
__device__ __forceinline__ XcdBarrier xcd_barrier_post(unsigned* bar, volatile LAS unsigned* st) {
    XcdBarrier b; b.bar = bar; b.x = xb_xcc_id(); b.st = st;
    if (threadIdx.x == 0) (void)xb_add(&bar[XB_XCNT(b.x)], 1u);
    return b;
}
__device__ __forceinline__ void xcd_barrier_complete(unsigned* bar, unsigned x, unsigned& nloc, unsigned& nx) {
    const unsigned G = gridDim.x * gridDim.y * gridDim.z;
    unsigned sum, cnt, mine, sp = 0u;
    for (;;) {
        sum = 0u; cnt = 0u; mine = 0u;
#pragma unroll
        for (unsigned j = 0; j < 16; ++j) { const unsigned c = xb_ld(&bar[XB_XCNT(j)]); sum += c; cnt += (c > 0u) ? 1u : 0u; mine = (j == x) ? c : mine; }
        if (sum == G) break;
        __builtin_amdgcn_s_sleep(1);
        if ((++sp & 255u) == 0u) { if (xb_ld(&bar[XB_TMO])) break; if (sp > XB_SPIN_CAP) { atomicAdd(&bar[XB_TMO], 1u); break; } }
    }
    nloc = mine > 0u ? mine : 1u; nx = cnt > 0u ? cnt : 1u;
}
__device__ __forceinline__ void xcd_barrier(const XcdBarrier& b) {
    asm volatile("s_waitcnt vmcnt(0)" ::: "memory");
    __syncthreads();
    if (threadIdx.x == 0) {
        unsigned* bar = b.bar;
        __builtin_amdgcn_s_waitcnt(0);
        unsigned nloc = b.st[0], nx = b.st[1];
        if (nloc == 0u) { xcd_barrier_complete(bar, b.x, nloc, nx); b.st[0] = nloc; b.st[1] = nx; }
        const unsigned old = xb_add(&bar[XB_XSUB(b.x)], 1u);
        const unsigned gen = old / nloc;
        if (old + 1u == (gen + 1u) * nloc) {
            __builtin_amdgcn_fence(__ATOMIC_RELEASE, "agent");
            asm volatile("s_waitcnt vmcnt(0)" ::: "memory");
            const unsigned og = xb_add(&bar[XB_TOP], 1u);
            const unsigned tg = og / nx;
            if (og + 1u == (tg + 1u) * nx) xb_add(&bar[XB_TOPGEN], 1u);
            else XB_SPIN(xb_ld(&bar[XB_TOPGEN]) == tg, bar);
            __builtin_amdgcn_fence(__ATOMIC_ACQUIRE, "agent");
            xb_add(&bar[XB_XGEN(b.x)], 1u);
            asm volatile("s_waitcnt vmcnt(0)" ::: "memory");
        } else {
            XB_SPIN(xb_ld(&bar[XB_XGEN(b.x)]) == gen, bar);
            __builtin_amdgcn_fence(__ATOMIC_ACQUIRE, "agent");
            asm volatile("s_waitcnt vmcnt(0)" ::: "memory");
        }
    }
    __syncthreads();
}

struct Args { const float* in[23]; float* out; unsigned char* ws; int ph_lo, ph_hi; };

__device__ __forceinline__ float wave_sum(float v) {
#pragma unroll
    for (int o = 1; o < 64; o <<= 1) v += __shfl_xor(v, o);
    return v;
}
__device__ __forceinline__ int compact_row(int r) {
    if (r >= MR) return -1;
    if (r >= RP) return r - RP + BP * SEQ;
    const int b = r / TP, t = r - b * TP;
    return t < NMETA ? -1 : r - NMETA * (b + 1);
}

__device__ __forceinline__ void p0_transpose_item(const float* W, int Nsrc, int K, bf16* WT, int dst_row0, int src_col0, int nvalid, LAS float* scr, int kb, int lane) {
    const int k0 = 64 * kb, cidx = lane & 31;
#pragma unroll 8
    for (int i = 0; i < 32; ++i) { const int kk = 2 * i + (lane >> 5); float v = 0.f; if (cidx < nvalid) v = W[(size_t)(k0 + kk) * Nsrc + src_col0 + cidx]; scr[kk * 33 + cidx] = v; }
    LDS_WAIT(); asm volatile("" ::: "memory");
    const int c = lane & 7;
#pragma unroll
    for (int j = 0; j < 4; ++j) { const int n = (lane >> 3) + 8 * j; const LAS float* s = scr + (8 * c) * 33 + n;
        v4u o; o.x = pk2(s[0 * 33], s[1 * 33]); o.y = pk2(s[2 * 33], s[3 * 33]); o.z = pk2(s[4 * 33], s[5 * 33]); o.w = pk2(s[6 * 33], s[7 * 33]);
        *(GAS v4u*)(WT + (size_t)(dst_row0 + n) * K + k0 + 8 * c) = o; }
    LDS_WAIT(); asm volatile("" ::: "memory");
}
__device__ __forceinline__ void win_src(int nb, int& src, int& nvalid) {
    const int pn = nb >> 3, o = (nb & 7) * 32; nvalid = 32;
    if (pn < 8) src = (o < 128) ? 128 * pn + o : 1024 + 128 * pn + (o - 128);
    else if (pn < 20) src = 2048 + 256 * (pn - 8) + o;
    else if (pn < 24) src = 5120 + 256 * (pn - 20) + o;
    else if (pn < 28) src = 6160 + 256 * (pn - 24) + o;
    else if (pn < 32) src = 7184 + 256 * (pn - 28) + o;
    else { src = 6144; nvalid = (o == 0) ? 16 : 0; }
}
__device__ __forceinline__ void rms_row_to_bf16(const float* xrow, const float* gain, bf16* orow, int lane) {
    const GAS f32x4* xr = (const GAS f32x4*)xrow + lane; const GAS f32x4* gr = (const GAS f32x4*)gain + lane;
    f32x4 v[4]; float s = 0.f;
#pragma unroll
    for (int j = 0; j < 4; ++j) { v[j] = xr[64 * j]; s += (v[j].x * v[j].x + v[j].y * v[j].y) + (v[j].z * v[j].z + v[j].w * v[j].w); }
    const float rstd = 1.f / sqrtf(wave_sum(s) * (1.f / DM) + EPS);
    GAS unsigned long long* o8 = (GAS unsigned long long*)orow + lane;
#pragma unroll
    for (int j = 0; j < 4; ++j) { const f32x4 g = gr[64 * j]; o8[64 * j] = (unsigned long long)pk2(v[j].x * rstd * g.x, v[j].y * rstd * g.y) | ((unsigned long long)pk2(v[j].z * rstd * g.z, v[j].w * rstd * g.w) << 32); }
}

typedef pg8::f32x4 A4;
struct EpiIn {
    static constexpr bool PERM = true;
    bf16 *GLU, *QKVB, *QS, *HALOQ, *HALOC, *ZS, *SGC, *SGD; float* BETAG; const float *a_log, *dt_bias;
    __device__ __forceinline__ void operator()(const A4 (&acc)[2][2][4][2], const pg8::Unit& u, int wr, int wc, int fr, int fq) const {
        const int pn = u.pn, row0 = u.pm * 256 + wr * 64 + fr, cw = 32 * wc + 8 * fq;
        if (pn < 8) {
#pragma unroll
            for (int ai = 0; ai < 2; ++ai)
#pragma unroll
                for (int m = 0; m < 4; ++m) { const int r = row0 + ai * 128 + m * 16; float o[8];
#pragma unroll
                    for (int n = 0; n < 2; ++n)
#pragma unroll
                        for (int j = 0; j < 4; ++j) o[4 * n + j] = acc[ai][0][m][n][j] * sigmoidf_(acc[ai][1][m][n][j]);
                    v4u w; w.x = pk2(o[0], o[1]); w.y = pk2(o[2], o[3]); w.z = pk2(o[4], o[5]); w.w = pk2(o[6], o[7]);
                    *(GAS v4u*)(GLU + (size_t)r * DM + 128 * pn + cw) = w;
                    if (r < RP) { const int b = r / TP, t = r - b * TP, run = t / RUNL, pos = t - run * RUNL;
                        if (pos >= RUNL - 30 && run < NRUN - 1) *(GAS v4u*)(HALOC + ((size_t)(b * NRUN + run) * 30 + (pos - (RUNL - 30))) * DM + 128 * pn + cw) = w; } }
        } else if (pn < 20) {
            const int colb = 256 * (pn - 8);
#pragma unroll
            for (int ai = 0; ai < 2; ++ai)
#pragma unroll
                for (int m = 0; m < 4; ++m) { const int r = row0 + ai * 128 + m * 16; if (r >= MR) continue;
#pragma unroll
                    for (int bj = 0; bj < 2; ++bj) { const int col = colb + 128 * bj + cw;
                        const A4 a0 = acc[ai][bj][m][0], a1 = acc[ai][bj][m][1];
                        v4u w; w.x = pk2(a0[0], a0[1]); w.y = pk2(a0[2], a0[3]); w.z = pk2(a1[0], a1[1]); w.w = pk2(a1[2], a1[3]);
                        if (r >= RP) *(GAS v4u*)(QS + (size_t)(r - RP) * DQKV + col) = w;
                        else { const int b = r / TP, t = r - b * TP, c = t >> 6, i = t & 63, which = col >> 10, h = (col >> 7) & 7, d = col & 127;
                            *(GAS v4u*)(QKVB + ((size_t)((b * NCH + c) * NH + h) * 3 + which) * 8192 + i * 128 + d) = w;
                            if (i >= 61) *(GAS v4u*)(HALOQ + ((size_t)(b * NCH + c) * 3 + (i - 61)) * DQKV + col) = w; } } }
        } else if (pn < 24) {
            constexpr bool isz = true; bf16* dst = ZS; const int ld = DM, cb = 256 * (pn - 20);
#pragma unroll
            for (int ai = 0; ai < 2; ++ai)
#pragma unroll
                for (int m = 0; m < 4; ++m) { const int r = row0 + ai * 128 + m * 16;
#pragma unroll
                    for (int bj = 0; bj < 2; ++bj) { float o[8];
#pragma unroll
                        for (int n = 0; n < 2; ++n)
#pragma unroll
                            for (int j = 0; j < 4; ++j) { const float v = acc[ai][bj][m][n][j]; o[4 * n + j] = isz ? siluf_(v) : v; }
                        v4u w; w.x = pk2(o[0], o[1]); w.y = pk2(o[2], o[3]); w.z = pk2(o[4], o[5]); w.w = pk2(o[6], o[7]);
                        *(GAS v4u*)(dst + (size_t)r * ld + cb + 128 * bj + cw) = w; } }
        } else if (pn < 32) {
            bf16* dst = pn < 28 ? SGC : SGD; const int cb = 256 * ((pn - 24) & 3);
#pragma unroll
            for (int ai = 0; ai < 2; ++ai)
#pragma unroll
                for (int m = 0; m < 4; ++m) { const int rc = compact_row(row0 + ai * 128 + m * 16); if (rc < 0) continue;
#pragma unroll
                    for (int bj = 0; bj < 2; ++bj) { float o[8];
#pragma unroll
                        for (int n = 0; n < 2; ++n)
#pragma unroll
                            for (int j = 0; j < 4; ++j) o[4 * n + j] = sigmoidf_(acc[ai][bj][m][n][j]);
                        v4u w; w.x = pk2(o[0], o[1]); w.y = pk2(o[2], o[3]); w.z = pk2(o[4], o[5]); w.w = pk2(o[6], o[7]);
                        *(GAS v4u*)(dst + (size_t)rc * DM + cb + 128 * bj + cw) = w; } }
        } else {
            if (wc == 0 && fq < 2) {
#pragma unroll
                for (int ai = 0; ai < 2; ++ai)
#pragma unroll
                    for (int m = 0; m < 4; ++m) { const int r = row0 + ai * 128 + m * 16; float o[8];
#pragma unroll
                        for (int n = 0; n < 2; ++n)
#pragma unroll
                            for (int j = 0; j < 4; ++j) { const int h = 4 * n + j; const float v = acc[ai][0][m][n][j];
                                if (fq == 0) o[h] = 1.f / (1.f + expf(-v));
                                else { const float xx = v + dt_bias[h]; const float sp = xx > 20.f ? xx : log1pf(expf(xx)); o[h] = -expf(a_log[h]) * sp; } }
                        GAS f32x4* p = (GAS f32x4*)(BETAG + (size_t)r * 16 + 8 * fq);
                        p[0] = (f32x4){o[0], o[1], o[2], o[3]}; p[1] = (f32x4){o[4], o[5], o[6], o[7]}; }
            }
        }
    }
};
template <int MODE> struct EpiGate {
    static constexpr bool PERM = true;
    bf16 *SG, *MA, *OUT;
    __device__ __forceinline__ void operator()(const A4 (&acc)[2][2][4][2], const pg8::Unit& u, int wr, int wc, int fr, int fq) const {
        const int row0 = u.pm * 256 + wr * 64 + fr, c0 = 256 * u.pn + 32 * wc + 8 * fq;
#pragma unroll
        for (int ai = 0; ai < 2; ++ai)
#pragma unroll
            for (int m = 0; m < 4; ++m) { const int rc = compact_row(row0 + ai * 128 + m * 16); if (rc < 0) continue;
#pragma unroll
                for (int bj = 0; bj < 2; ++bj) { const size_t off = (size_t)rc * DM + c0 + 128 * bj;
                    const v4u g = *(const GAS v4u*)(SG + off); float o[8];
                    const A4 a0 = acc[ai][bj][m][0], a1 = acc[ai][bj][m][1];
                    o[0] = bflo(g.x) * a0[0]; o[1] = bfhi(g.x) * a0[1]; o[2] = bflo(g.y) * a0[2]; o[3] = bfhi(g.y) * a0[3];
                    o[4] = bflo(g.z) * a1[0]; o[5] = bfhi(g.z) * a1[1]; o[6] = bflo(g.w) * a1[2]; o[7] = bfhi(g.w) * a1[3];
                    if (MODE == 1) { const v4u q = *(const GAS v4u*)(MA + off);
                        o[0] += bflo(q.x); o[1] += bfhi(q.x); o[2] += bflo(q.y); o[3] += bfhi(q.y); o[4] += bflo(q.z); o[5] += bfhi(q.z); o[6] += bflo(q.w); o[7] += bfhi(q.w); }
                    v4u w; w.x = pk2(o[0], o[1]); w.y = pk2(o[2], o[3]); w.z = pk2(o[4], o[5]); w.w = pk2(o[6], o[7]);
                    *(GAS v4u*)(OUT + off) = w; } }
    }
};
template <int MODE> struct EpiRes {
    static constexpr bool PERM = false;
    const float *xp, *xs; float* out;
    __device__ __forceinline__ void operator()(const A4 (&acc)[2][2][4][2], const pg8::Unit& u, int wr, int wc, int fr, int fq) const {
        const int row0 = u.pm * 256 + wr * 64 + fr, c0 = 256 * u.pn + 32 * wc + 4 * fq;
#pragma unroll
        for (int ai = 0; ai < 2; ++ai)
#pragma unroll
            for (int m = 0; m < 4; ++m) { const int r = row0 + ai * 128 + m * 16;
                const float* base = MODE == 0 ? (r < BP * SEQ ? xp + (size_t)r * DM : xs + (size_t)(r - BP * SEQ) * DM) : out + (size_t)r * DM;
                float* orow = out + (size_t)r * DM;
#pragma unroll
                for (int bj = 0; bj < 2; ++bj)
#pragma unroll
                    for (int n = 0; n < 2; ++n) { const int c = c0 + 128 * bj + 16 * n; const f32x4 b = *(const GAS f32x4*)(base + c); *(GAS f32x4*)(orow + c) = b + acc[ai][bj][m][n]; } }
    }
};
struct EpiUp {
    static constexpr bool PERM = true;
    bf16* HM;
    __device__ __forceinline__ void operator()(const A4 (&acc)[2][2][4][2], const pg8::Unit& u, int wr, int wc, int fr, int fq) const {
        const int row0 = u.pm * 256 + wr * 64 + fr, c0 = 256 * u.pn + 32 * wc + 8 * fq;
#pragma unroll
        for (int ai = 0; ai < 2; ++ai)
#pragma unroll
            for (int m = 0; m < 4; ++m) { const int r = row0 + ai * 128 + m * 16;
#pragma unroll
                for (int bj = 0; bj < 2; ++bj) { float o[8];
#pragma unroll
                    for (int n = 0; n < 2; ++n)
#pragma unroll
                        for (int j = 0; j < 4; ++j) { const float v = fmaxf(acc[ai][bj][m][n][j], 0.f); o[4 * n + j] = v * v; }
                    v4u w; w.x = pk2(o[0], o[1]); w.y = pk2(o[2], o[3]); w.z = pk2(o[4], o[5]); w.w = pk2(o[6], o[7]);
                    *(GAS v4u*)(HM + (size_t)r * DFF + c0 + 128 * bj) = w; } }
    }
};

__device__ __forceinline__ void conv_unit(const Args& a, LAS unsigned char* lds, int kind, int b, int run) {
    asm volatile("" ::: "memory");
    const int tid = threadIdx.x, lane = tid & 63, wave = tid >> 6; int ch = 2 * tid; asm volatile("" : "+v"(ch));
    const unsigned char* ws = a.ws;
    const bf16* GLU = (const bf16*)(ws + WS_GLU); bf16* C = (bf16*)(a.ws + WS_C); const bf16* HALOC = (const bf16*)(ws + WS_HALOC);
    const float* w_dw = a.in[8];
    LAS float* red = (LAS float*)lds;
    f32x2 w[KC]; unsigned win[KC];
#pragma unroll
    for (int i = 0; i < KC; ++i) w[i] = *(const GAS f32x2*)(w_dw + (size_t)i * DM + ch);
    const f32x2 bdw = *(const GAS f32x2*)(a.in[9] + ch), lng = *(const GAS f32x2*)(a.in[10] + ch), lnb = *(const GAS f32x2*)(a.in[11] + ch);
    int row0, ntok; bool last_run;
    win[0] = 0u;
    if (kind == 0) { row0 = b * TP + run * RUNL; ntok = RUNL; last_run = (run == NRUN - 1);
#pragma unroll
        for (int i = 1; i < KC; ++i) { if (run == 0) win[i] = 0u; else win[i] = *(const GAS unsigned*)(HALOC + ((size_t)(b * NRUN + run - 1) * 30 + (i - 1)) * DM + ch); }
    } else { row0 = RP + b * TS; ntok = TS; last_run = true;
        const float* st = a.in[2] + (size_t)b * (KC - 1) * DM;
#pragma unroll
        for (int i = 1; i < KC; ++i) { const f32x2 v = *(const GAS f32x2*)(st + (size_t)(i - 1) * DM + ch); win[i] = pk2(v.x, v.y); }
    }
    for (int t = 0; t < ntok; ++t) {
        const unsigned v = *(const GAS unsigned*)(GLU + (size_t)(row0 + t) * DM + ch);
#pragma unroll
        for (int i = 0; i < KC - 1; ++i) win[i] = win[i + 1];
        win[KC - 1] = v;
        float y0 = bdw.x, y1 = bdw.y;
#pragma unroll
        for (int i = 0; i < KC; ++i) { y0 += w[i].x * bflo(win[i]); y1 += w[i].y * bfhi(win[i]); }
        float s1 = wave_sum(y0 + y1), s2 = wave_sum(y0 * y0 + y1 * y1);
        LAS float* rb = red + (t & 1) * 16;
        if (lane == 0) { rb[wave * 2] = s1; rb[wave * 2 + 1] = s2; }
        __syncthreads();
        float t1 = 0.f, t2 = 0.f;
#pragma unroll
        for (int i = 0; i < 8; ++i) { t1 += rb[2 * i]; t2 += rb[2 * i + 1]; }
        const float mu = t1 * (1.f / DM), var = fmaxf(t2 * (1.f / DM) - mu * mu, 0.f), rstd = 1.f / sqrtf(var + EPS);
        const float z0 = (y0 - mu) * rstd * lng.x + lnb.x, z1 = (y1 - mu) * rstd * lng.y + lnb.y;
        *(GAS unsigned*)(C + (size_t)(row0 + t) * DM + ch) = pk2(siluf_(z0), siluf_(z1));
    }
    if (last_run) { float* o = a.out + (kind == 0 ? O_PC : O_SC) + (size_t)b * (KC - 1) * DM;
        if (kind == 0) {
#pragma unroll
            for (int i = 1; i < KC; ++i) *(GAS f32x2*)(o + (size_t)(i - 1) * DM + ch) = (f32x2){bflo(win[i]), bfhi(win[i])};
        } else {
            const float* st = a.in[2] + (size_t)b * (KC - 1) * DM;
#pragma unroll
            for (int i = 0; i < KC - 1 - TS; ++i) *(GAS f32x2*)(o + (size_t)i * DM + ch) = *(const GAS f32x2*)(st + (size_t)(i + TS) * DM + ch);
#pragma unroll
            for (int i = KC - TS; i < KC; ++i) *(GAS f32x2*)(o + (size_t)(i - 1) * DM + ch) = (f32x2){bflo(win[i]), bfhi(win[i])};
        }
    }
    __syncthreads();
}

__device__ __forceinline__ void delta_item(const Args& a, LAS unsigned char* lds, int item) {
    asm volatile("" ::: "memory");
    const int tid = threadIdx.x, lane = tid & 63, sub = tid >> 7, wu = (tid >> 6) & 1; int j = tid & 127; asm volatile("" : "+v"(j));
    const int unit = item * 4 + sub, b = unit >> 3, h = unit & 7;
    const int row0 = RP + b * TS;
    const bf16* QS = (const bf16*)(a.ws + WS_QS); bf16* ZS = (bf16*)(a.ws + WS_ZS); const float* BETAG = (const float*)(a.ws + WS_BETAG);
    LAS float* kq = (LAS float*)lds + sub * 256;
    LAS float* red = (LAS float*)lds + 1024 + sub * 4;
    LAS float* red2 = (LAS float*)lds + 1024 + 16 + sub * 2;
    float S[DH];
    { const float* s0 = a.in[4] + ((size_t)(b * NH + h) * DH) * DH + j;
#pragma unroll
        for (int d = 0; d < DH; ++d) S[d] = s0[(size_t)d * DH]; }
    const int cq = h * DH + j, ck = DM + cq, cv = 2 * DM + cq;
    float wq[KS], wk[KS], wv[KS];
#pragma unroll
    for (int i = 0; i < KS; ++i) { wq[i] = a.in[13][i * DQKV + cq]; wk[i] = a.in[13][i * DQKV + ck]; wv[i] = a.in[13][i * DQKV + cv]; }
    float hq[3], hk[3], hv[3];
#pragma unroll
    for (int i = 0; i < 3; ++i) { const float* st = a.in[3] + ((size_t)b * 3 + i) * DQKV; hq[i] = st[cq]; hk[i] = st[ck]; hv[i] = st[cv]; }
    const float gh = a.in[16][j];
    for (int t = 0; t < TS; ++t) {
        const size_t row = (size_t)(row0 + t);
        const bf16* p = QS + (size_t)(b * TS + t) * DQKV; const float qp = bf1(p[cq]), kp = bf1(p[ck]), vp = bf1(p[cv]);
        const float qc = siluf_(wq[0] * hq[0] + wq[1] * hq[1] + wq[2] * hq[2] + wq[3] * qp);
        const float kc = siluf_(wk[0] * hk[0] + wk[1] * hk[1] + wk[2] * hk[2] + wk[3] * kp);
        const float vc = siluf_(wv[0] * hv[0] + wv[1] * hv[1] + wv[2] * hv[2] + wv[3] * vp);
        hq[0] = hq[1]; hq[1] = hq[2]; hq[2] = qp; hk[0] = hk[1]; hk[1] = hk[2]; hk[2] = kp; hv[0] = hv[1]; hv[1] = hv[2]; hv[2] = vp;
        const float sq = wave_sum(qc * qc), sk = wave_sum(kc * kc);
        kq[j] = kc; kq[128 + j] = qc;
        if (lane == 0) { red[wu * 2] = sq; red[wu * 2 + 1] = sk; }
        const float beta = BETAG[row * 16 + h], gg = BETAG[row * 16 + 8 + h];
        const float zs = bf1(ZS[row * DM + cq]);
        __syncthreads();
        const float nq = (1.f / sqrtf(red[0] + red[2] + 1e-6f)) * 0.08838834764831845f, nk = 1.f / sqrtf(red[1] + red[3] + 1e-6f);
        const float alpha = expf(gg);
        float ks0 = 0.f, ks1 = 0.f, ks2 = 0.f, ks3 = 0.f;
#pragma unroll
        for (int d = 0; d < DH; d += 4) { const f32x4 kk = *(const LAS f32x4*)(kq + d); ks0 += kk.x * S[d]; ks1 += kk.y * S[d + 1]; ks2 += kk.z * S[d + 2]; ks3 += kk.w * S[d + 3];
            if ((d & 31) == 28) asm volatile("" ::: "memory"); }
        const float kS = (ks0 + ks1) + (ks2 + ks3);
        const float u = beta * (vc - alpha * nk * kS), un = nk * u;
        float o0 = 0.f, o1 = 0.f, o2 = 0.f, o3 = 0.f;
#pragma unroll
        for (int d = 0; d < DH; d += 4) { const f32x4 kk = *(const LAS f32x4*)(kq + d); const f32x4 qq = *(const LAS f32x4*)(kq + 128 + d);
            S[d] = alpha * S[d] + kk.x * un; S[d + 1] = alpha * S[d + 1] + kk.y * un; S[d + 2] = alpha * S[d + 2] + kk.z * un; S[d + 3] = alpha * S[d + 3] + kk.w * un;
            o0 += qq.x * S[d]; o1 += qq.y * S[d + 1]; o2 += qq.z * S[d + 2]; o3 += qq.w * S[d + 3];
            if ((d & 15) == 12) asm volatile("" ::: "memory"); }
        const float o = ((o0 + o1) + (o2 + o3)) * nq;
        const float so = wave_sum(o * o);
        if (lane == 0) red2[wu] = so;
        __syncthreads();
        const float rms = 1.f / sqrtf((red2[0] + red2[1]) * (1.f / DH) + EPS);
        ZS[row * DM + cq] = (bf16)f2bf(o * rms * gh * zs);
    }
    { float* so = a.out + O_SD + ((size_t)(b * NH + h) * DH) * DH + j;
#pragma unroll
        for (int d = 0; d < DH; ++d) so[(size_t)d * DH] = S[d];
      float* qo = a.out + O_SQ + (size_t)b * 3 * DQKV;
#pragma unroll
        for (int i = 0; i < 3; ++i) { qo[i * DQKV + cq] = hq[i]; qo[i * DQKV + ck] = hk[i]; qo[i * DQKV + cv] = hv[i]; }
    }
    __syncthreads();
}

__host__ __device__ constexpr int perm_k(int x) { return (x & ~31) | (((x >> 2) & 3) << 3) | (((x >> 4) & 1) << 2) | (x & 3); }
typedef short bf16x8v __attribute__((ext_vector_type(8)));
constexpr int IH_KH = 0, IH_QH = 17408, IH_MF = 34816, IH_GV = 52224, IH_PS = 53248, IH_BYTES = 54272;
__device__ __forceinline__ void intra_pair(const Args& a, LAS unsigned char* lds_all, int pair) {
    asm volatile("" ::: "memory");
    const int tid = threadIdx.x, half = tid >> 8, lane = tid & 63, wq = (tid >> 6) & 3; int tu = tid & 255; asm volatile("" : "+v"(tu));
    const int uq = pair * 2 + half, h = uq & 7, bc = uq >> 3, b = bc / NCH, c = bc - b * NCH;
    const int nvalid = (c == NCH - 1) ? TP - 64 * (NCH - 1) : 64;
    LAS unsigned char* lds = lds_all + half * IH_BYTES;
    LAS bf16* KH = (LAS bf16*)(lds + IH_KH); LAS bf16* QH = (LAS bf16*)(lds + IH_QH); LAS float* MF = (LAS float*)(lds + IH_MF); LAS float* GV = (LAS float*)(lds + IH_GV); LAS float* PS = (LAS float*)(lds + IH_PS);
    unsigned char* ws = a.ws;
    bf16* blk = (bf16*)(ws + WS_QKVB) + (size_t)uq * QBLK; const bf16* HALOQ = (const bf16*)(ws + WS_HALOQ); const float* BETAG = (const float*)(ws + WS_BETAG);
    bf16* KDT = (bf16*)(ws + WS_KDT) + (size_t)uq * 8192; bf16* ATT = (bf16*)(ws + WS_ATTN) + (size_t)uq * 4096; float* LASTV = (float*)(ws + WS_LASTV);
    if (tu < 64) { const int i = tu; float g = 0.f, be = 0.f; if (i < nvalid) { const float* p = BETAG + (size_t)(b * TP + 64 * c + i) * 16; be = p[h]; g = p[8 + h]; }
        float G = g;
#pragma unroll
        for (int o = 1; o < 64; o <<= 1) { const float t = __shfl_up(G, o); if (lane >= o) G += t; }
        const float GL = __shfl(G, 63);
        GV[i] = G; GV[64 + i] = be; GV[128 + i] = expf(G); GV[192 + i] = expf(GL - G);
        if (i == 63) LASTV[uq] = expf(GL); }
    const int which = tu >> 7, d = tu & 127, colw = which * DM + h * DH + d;
    float x[64];
    {   float w0 = a.in[13][colw], w1 = a.in[13][DQKV + colw], w2 = a.in[13][2 * DQKV + colw], w3 = a.in[13][3 * DQKV + colw];
        float h0 = 0.f, h1 = 0.f, h2 = 0.f;
        if (c > 0) { const bf16* hp = HALOQ + (size_t)(b * NCH + c - 1) * 3 * DQKV + colw; h0 = bf1(hp[0]); h1 = bf1(hp[DQKV]); h2 = bf1(hp[2 * DQKV]); }
        const bf16* src = blk + which * 8192 + d;
        bf16 raw[64];
#pragma unroll
        for (int i = 0; i < 64; ++i) raw[i] = src[i * 128];
#pragma unroll
        for (int i = 0; i < 64; ++i) { const float xp = (i < nvalid) ? bf1(raw[i]) : 0.f;
            const float y = siluf_(w0 * h0 + w1 * h1 + w2 * h2 + w3 * xp); x[i] = (i < nvalid) ? y : 0.f; h0 = h1; h1 = h2; h2 = xp; }
    }
    if (c == NCH - 1) { const bf16* src = blk + which * 8192 + d; float* qo = a.out + O_PQ + (size_t)b * 3 * DQKV + colw;
#pragma unroll
        for (int i = 0; i < 3; ++i) qo[i * DQKV] = bf1(src[(nvalid - 3 + i) * 128]); }
#pragma unroll
    for (int i = 0; i < 64; ++i) { const float sq = wave_sum(x[i] * x[i]); if (lane == 0) PS[wq * 64 + i] = sq; }
    __syncthreads();
    {   const float sc = which == 0 ? 0.08838834764831845f : 1.f; LAS bf16* dst = (which == 0 ? QH : KH) + d;
#pragma unroll
        for (int i = 0; i < 64; ++i) { const float ss = PS[(2 * which) * 64 + i] + PS[(2 * which + 1) * 64 + i]; x[i] *= sc / sqrtf(ss + 1e-6f); dst[i * 136] = (bf16)f2bf(x[i]); } }
    if (which == 0) {
        const int pd = perm_k(d);
#pragma unroll
        for (int i = 0; i < 64; ++i) blk[i * 128 + pd] = (bf16)f2bf(x[i] * GV[128 + i]);
        const int colv = 2 * DM + h * DH + d;
        float w0 = a.in[13][colv], w1 = a.in[13][DQKV + colv], w2 = a.in[13][2 * DQKV + colv], w3 = a.in[13][3 * DQKV + colv];
        float h0 = 0.f, h1 = 0.f, h2 = 0.f;
        if (c > 0) { const bf16* hp = HALOQ + (size_t)(b * NCH + c - 1) * 3 * DQKV + colv; h0 = bf1(hp[0]); h1 = bf1(hp[DQKV]); h2 = bf1(hp[2 * DQKV]); }
        const bf16* src = blk + 2 * 8192 + d;
        if (c == NCH - 1) { float* qo = a.out + O_PQ + (size_t)b * 3 * DQKV + colv;
#pragma unroll
            for (int i = 0; i < 3; ++i) qo[i * DQKV] = bf1(src[(nvalid - 3 + i) * 128]); }
#pragma unroll
        for (int i = 0; i < 64; ++i) x[i] = bf1(src[i * 128]);
#pragma unroll
        for (int i = 0; i < 64; ++i) { const float xp = (i < nvalid) ? x[i] : 0.f;
            const float y = siluf_(w0 * h0 + w1 * h1 + w2 * h2 + w3 * xp); x[i] = (i < nvalid) ? y * GV[64 + i] : 0.f; h0 = h1; h1 = h2; h2 = xp; }
    } else {
        bf16* kd = KDT + d * 64;
#pragma unroll
        for (int g8 = 0; g8 < 8; ++g8) { float o[8];
#pragma unroll
            for (int pp = 0; pp < 8; ++pp) { const int i = 32 * (g8 >> 2) + 16 * (pp >> 2) + 4 * (g8 & 3) + (pp & 3); o[pp] = x[i] * GV[192 + i]; }
            v4u w; w.x = pk2(o[0], o[1]); w.y = pk2(o[2], o[3]); w.z = pk2(o[4], o[5]); w.w = pk2(o[6], o[7]);
            *(GAS v4u*)(kd + 8 * g8) = w; }
#pragma unroll
        for (int i = 0; i < 64; ++i) x[i] *= GV[64 + i] * GV[128 + i];
    }
    __syncthreads();
    {   const int fr = lane & 15, fq = lane >> 4;
        bf16x8v ak[4], aq[4];
#pragma unroll
        for (int sI = 0; sI < 4; ++sI) { ak[sI] = *(const LAS bf16x8v*)(KH + (16 * wq + fr) * 136 + 32 * sI + 8 * fq); aq[sI] = *(const LAS bf16x8v*)(QH + (16 * wq + fr) * 136 + 32 * sI + 8 * fq); }
        float Gi[4], Bi[4];
#pragma unroll
        for (int r = 0; r < 4; ++r) { Gi[r] = GV[16 * wq + 4 * fq + r]; Bi[r] = GV[64 + 16 * wq + 4 * fq + r]; }
#pragma unroll
        for (int nt = 0; nt < 4; ++nt) {
            const int j = 16 * nt + fr, pj = 32 * (nt >> 1) + 8 * (fr >> 2) + 4 * (nt & 1) + (fr & 3);
            if (nt <= wq) {
                f32x4 kk = {0.f, 0.f, 0.f, 0.f}, qk = {0.f, 0.f, 0.f, 0.f};
#pragma unroll
                for (int sI = 0; sI < 4; ++sI) { const bf16x8v bk = *(const LAS bf16x8v*)(KH + (16 * nt + fr) * 136 + 32 * sI + 8 * fq);
                    kk = __builtin_amdgcn_mfma_f32_16x16x32_bf16(ak[sI], bk, kk, 0, 0, 0); qk = __builtin_amdgcn_mfma_f32_16x16x32_bf16(aq[sI], bk, qk, 0, 0, 0); }
                const float Gj = GV[j];
#pragma unroll
                for (int r = 0; r < 4; ++r) { const int i = 16 * wq + 4 * fq + r; const float dec = (i >= j) ? __expf(Gi[r] - Gj) : 0.f;
                    MF[i * 68 + j] = (i > j) ? Bi[r] * kk[r] * dec : 0.f;
                    ATT[i * 64 + pj] = (bf16)f2bf(qk[r] * dec); }
            } else {
#pragma unroll
                for (int r = 0; r < 4; ++r) { const int i = 16 * wq + 4 * fq + r; ATT[i * 64 + pj] = (bf16)0; }
            }
        }
    }
    __syncthreads();
#pragma unroll
    for (int i = 1; i < 64; ++i) {
        float a0 = x[i], a1 = 0.f, a2 = 0.f, a3 = 0.f;
#pragma unroll
        for (int j4 = 0; j4 < i; j4 += 4) { const f32x4 mm = *(const LAS f32x4*)(MF + i * 68 + j4);
            a0 -= mm.x * x[j4]; if (j4 + 1 < i) a1 -= mm.y * x[j4 + 1]; if (j4 + 2 < i) a2 -= mm.z * x[j4 + 2]; if (j4 + 3 < i) a3 -= mm.w * x[j4 + 3]; }
        x[i] = (a0 + a1) + (a2 + a3);
    }
    if (which == 0) {
        bf16* u0 = blk + 2 * 8192 + (size_t)(d >> 4) * 1024 + (d & 15) * 4;
#pragma unroll
        for (int m = 0; m < 4; ++m)
#pragma unroll
            for (int q = 0; q < 4; ++q) { const int i = 16 * m + 4 * q; v2u w; w.x = pk2(x[i], x[i + 1]); w.y = pk2(x[i + 2], x[i + 3]); *(GAS v2u*)(u0 + m * 256 + q * 64) = w; }
    } else {
        const int pd = perm_k(d);
#pragma unroll
        for (int i = 0; i < 64; ++i) blk[8192 + i * 128 + pd] = (bf16)f2bf(x[i]);
    }
    __syncthreads();
}

constexpr int SC_W = 0, SC_QD = 17408, SC_KDT = 34816, SC_AT = 53248, SC_BUF = 62464, SC_RMS = 2 * SC_BUF;
__device__ __forceinline__ void scan_chain(const Args& a, LAS unsigned char* lds, int chain) {
    const int tid = threadIdx.x, lane = tid & 63, wave = __builtin_amdgcn_readfirstlane(tid >> 6), fr = lane & 15, fq = lane >> 4;
    const int b = chain >> 3, h = chain & 7;
    unsigned char* ws = a.ws;
    const bf16* QKVB = (const bf16*)(ws + WS_QKVB); const bf16* KDTg = (const bf16*)(ws + WS_KDT); const bf16* ATTg = (const bf16*)(ws + WS_ATTN); const float* LASTV = (const float*)(ws + WS_LASTV);
    bf16* ZS = (bf16*)(ws + WS_ZS);
    LAS float* RMS = (LAS float*)(lds + SC_RMS);
    const float gh = a.in[16][16 * wave + fr];
    f32x4 Sacc[8];
#pragma unroll
    for (int mt = 0; mt < 8; ++mt) Sacc[mt] = (f32x4){0.f, 0.f, 0.f, 0.f};
    v4u st[7];
    auto stage_load = [&](int c) {
        const size_t uq = (size_t)(b * NCH + c) * NH + h; const bf16* blk = QKVB + uq * QBLK;
#pragma unroll
        for (int k = 0; k < 2; ++k) { const int e = (tid + 512 * k) * 8; st[k] = *(const GAS v4u*)(blk + 8192 + e); st[2 + k] = *(const GAS v4u*)(blk + e); st[4 + k] = *(const GAS v4u*)(KDTg + uq * 8192 + e); }
        st[6] = *(const GAS v4u*)(ATTg + uq * 4096 + tid * 8);
    };
    auto stage_store = [&](int buf) {
        LAS unsigned char* base = lds + buf * SC_BUF;
#pragma unroll
        for (int k = 0; k < 2; ++k) { const int e = (tid + 512 * k) * 8; const int r = e >> 7, cc = e & 127;
            *(LAS v4u*)(base + SC_W + r * 272 + cc * 2) = st[k]; *(LAS v4u*)(base + SC_QD + r * 272 + cc * 2) = st[2 + k];
            const int r2 = e >> 6, c2 = e & 63; *(LAS v4u*)(base + SC_KDT + r2 * 144 + c2 * 2) = st[4 + k]; }
        { const int e = tid * 8, r2 = e >> 6, c2 = e & 63; *(LAS v4u*)(base + SC_AT + r2 * 144 + c2 * 2) = st[6]; }
    };
    stage_load(0); stage_store(0);
    __syncthreads();
    for (int c = 0; c < NCH; ++c) {
        const int buf = c & 1; LAS unsigned char* base = lds + buf * SC_BUF;
        const size_t uq = (size_t)(b * NCH + c) * NH + h;
        const int nvalid = (c == NCH - 1) ? TP - 64 * (NCH - 1) : 64;
        if (c + 1 < NCH) stage_load(c + 1);
        v2u u0p[4];
        { const bf16* u0 = QKVB + uq * QBLK + 2 * 8192 + wave * 1024 + lane * 4;
#pragma unroll
          for (int m = 0; m < 4; ++m) u0p[m] = *(const GAS v2u*)(u0 + m * 256); }
        const float last = LASTV[uq];
        const size_t zrow0 = (size_t)(b * TP + 64 * c) * DM + h * DH + 16 * wave + fr;
        float zs[4][4];
#pragma unroll
        for (int m = 0; m < 4; ++m)
#pragma unroll
            for (int r = 0; r < 4; ++r) { const int i = 16 * m + 4 * fq + r; zs[m][r] = bf1(ZS[zrow0 + (size_t)i * DM]); }
        bf16x8v Sb[4];
#pragma unroll
        for (int sI = 0; sI < 4; ++sI) { v4u w; w.x = pk2(Sacc[2 * sI][0], Sacc[2 * sI][1]); w.y = pk2(Sacc[2 * sI][2], Sacc[2 * sI][3]); w.z = pk2(Sacc[2 * sI + 1][0], Sacc[2 * sI + 1][1]); w.w = pk2(Sacc[2 * sI + 1][2], Sacc[2 * sI + 1][3]);
            Sb[sI] = __builtin_bit_cast(bf16x8v, w); }
        f32x4 u[4], o[4];
#pragma unroll
        for (int m = 0; m < 4; ++m) { f32x4 p = {0.f, 0.f, 0.f, 0.f}, oo = {0.f, 0.f, 0.f, 0.f};
#pragma unroll
            for (int sI = 0; sI < 4; ++sI) { const bf16x8v aw = *(const LAS bf16x8v*)(base + SC_W + (16 * m + fr) * 272 + (32 * sI + 8 * fq) * 2);
                const bf16x8v aqd = *(const LAS bf16x8v*)(base + SC_QD + (16 * m + fr) * 272 + (32 * sI + 8 * fq) * 2);
                p = __builtin_amdgcn_mfma_f32_16x16x32_bf16(aw, Sb[sI], p, 0, 0, 0); oo = __builtin_amdgcn_mfma_f32_16x16x32_bf16(aqd, Sb[sI], oo, 0, 0, 0); }
            u[m] = (f32x4){bflo(u0p[m].x), bfhi(u0p[m].x), bflo(u0p[m].y), bfhi(u0p[m].y)} - p; o[m] = oo; }
        bf16x8v Ub[2];
#pragma unroll
        for (int s2 = 0; s2 < 2; ++s2) { v4u w; w.x = pk2(u[2 * s2][0], u[2 * s2][1]); w.y = pk2(u[2 * s2][2], u[2 * s2][3]); w.z = pk2(u[2 * s2 + 1][0], u[2 * s2 + 1][1]); w.w = pk2(u[2 * s2 + 1][2], u[2 * s2 + 1][3]);
            Ub[s2] = __builtin_bit_cast(bf16x8v, w); }
#pragma unroll
        for (int m = 0; m < 4; ++m)
#pragma unroll
            for (int s2 = 0; s2 < 2; ++s2) { const bf16x8v aa = *(const LAS bf16x8v*)(base + SC_AT + (16 * m + fr) * 144 + (32 * s2 + 8 * fq) * 2);
                o[m] = __builtin_amdgcn_mfma_f32_16x16x32_bf16(aa, Ub[s2], o[m], 0, 0, 0); }
#pragma unroll
        for (int mt = 0; mt < 8; ++mt) { f32x4 sacc = Sacc[mt] * last;
#pragma unroll
            for (int s2 = 0; s2 < 2; ++s2) { const bf16x8v ak = *(const LAS bf16x8v*)(base + SC_KDT + (16 * mt + fr) * 144 + (32 * s2 + 8 * fq) * 2);
                sacc = __builtin_amdgcn_mfma_f32_16x16x32_bf16(ak, Ub[s2], sacc, 0, 0, 0); }
            Sacc[mt] = sacc; }
        LAS float* rm = RMS + (c & 1) * 512;
#pragma unroll
        for (int m = 0; m < 4; ++m)
#pragma unroll
            for (int r = 0; r < 4; ++r) { float v = o[m][r] * o[m][r]; v += __shfl_xor(v, 1); v += __shfl_xor(v, 2); v += __shfl_xor(v, 4); v += __shfl_xor(v, 8);
                if (fr == 0) rm[(16 * m + 4 * fq + r) * 8 + wave] = v; }
        if (c + 1 < NCH) stage_store(buf ^ 1);
        __syncthreads();
#pragma unroll
        for (int m = 0; m < 4; ++m) { if (16 * m >= nvalid) continue;
#pragma unroll
            for (int r = 0; r < 4; ++r) { const int i = 16 * m + 4 * fq + r; const f32x4 p0 = *(const LAS f32x4*)(rm + i * 8), p1 = *(const LAS f32x4*)(rm + i * 8 + 4);
                const float ss = ((p0.x + p0.y) + (p0.z + p0.w)) + ((p1.x + p1.y) + (p1.z + p1.w));
                const float on = o[m][r] * (1.f / sqrtf(ss * (1.f / DH) + EPS)) * gh * zs[m][r];
                ZS[zrow0 + (size_t)i * DM] = (bf16)f2bf(on); } }
    }
    { float* so = a.out + O_PD + ((size_t)(b * NH + h) * DH) * DH + 16 * wave + fr;
#pragma unroll
      for (int mt = 0; mt < 8; ++mt)
#pragma unroll
          for (int r = 0; r < 4; ++r) so[(size_t)(16 * mt + 4 * fq + r) * DH] = Sacc[mt][r]; }
    __syncthreads();
}

constexpr int NPHASES = 10;
__global__ void __launch_bounds__(NWAVES * 64, 2) fwd_kernel(Args args) {
    extern __shared__ __attribute__((aligned(16))) unsigned char lds_raw[];
    LAS unsigned char* lds = (LAS unsigned char*)lds_raw;
    volatile LAS unsigned* MISC = (volatile LAS unsigned*)(lds + MISC_OFF);
    const int tid = threadIdx.x, lane = tid & 63, wave = __builtin_amdgcn_readfirstlane(tid >> 6);
    const int G = gridDim.x, bx = blockIdx.x;
    const int vcu = (G % 8 == 0) ? (bx % 8) * (G / 8) + bx / 8 : bx;
    unsigned char* ws = args.ws;
    gu32* ctl = (gu32*)(ws + WS_CTL);
    for (int u = tid; u < (LDS_BYTES - LDSCTL_OFF) / 4; u += NWAVES * 64) ((LAS unsigned*)(lds + LDSCTL_OFF))[u] = 0u;
    __syncthreads();
    XcdBarrier bar; bar.bar = (unsigned*)(ctl + CW_BAR); bar.x = 0; bar.st = nullptr;
    const int lo = args.ph_lo, hi = args.ph_hi;
    if (hi - lo > 1) bar = xcd_barrier_post((unsigned*)(ctl + CW_BAR), MISC + 8);
#ifndef PH_MASK
#define PH_MASK 0x3ff
#endif
#define IN(k) (((PH_MASK >> (k)) & 1) && lo <= (k) && (k) < hi)
#ifndef PROBE_K
#define PROBE_K -1
#endif
#if PROBE_K >= 0
    volatile LAS unsigned long long* stamps = (volatile LAS unsigned long long*)(lds + MISC_OFF + 128);
    if (tid == 0) stamps[0] = __builtin_amdgcn_s_memrealtime();
#define SEAM(k) do { if (IN(k) && IN((k) + 1)) xcd_barrier(bar); if (tid == 0) stamps[(k) + 1] = __builtin_amdgcn_s_memrealtime(); } while (0)
#else
#define SEAM(k) do { if (IN(k) && IN((k) + 1)) xcd_barrier(bar); } while (0)
#endif
    bf16* WIN = (bf16*)(ws + WS_WIN); bf16* WC = (bf16*)(ws + WS_WC); bf16* WD = (bf16*)(ws + WS_WD); bf16* WO = (bf16*)(ws + WS_WO); bf16* WUP = (bf16*)(ws + WS_WUP); bf16* WDN = (bf16*)(ws + WS_WDN);
    bf16* H = (bf16*)(ws + WS_H); bf16* GLU = (bf16*)(ws + WS_GLU); bf16* QKVB = (bf16*)(ws + WS_QKVB); bf16* QS = (bf16*)(ws + WS_QS); bf16* ZS = (bf16*)(ws + WS_ZS);
    bf16* HALOQ = (bf16*)(ws + WS_HALOQ); bf16* HALOC = (bf16*)(ws + WS_HALOC);
    bf16* SGC = (bf16*)args.out; bf16* SGD = (bf16*)args.out + (size_t)M2 * DM;
    bf16* MIX = (bf16*)(ws + WS_MIX); bf16* XG = (bf16*)(ws + WS_XG); bf16* HM = (bf16*)(ws + WS_HM); bf16* C = (bf16*)(ws + WS_C);
    float* BETAG = (float*)(ws + WS_BETAG);
    const int gw = vcu * NWAVES + wave, NGW = G * NWAVES;

    if (IN(0)) {
        LAS float* scr = (LAS float*)(lds + RING_OFF + wave * 16384);
        constexpr int I_IN = 16 * (NIN / 32), I_SQ = 16 * 32, I_UP = 16 * (DFF / 32), I_DN = (DFF / 64) * 32;
        constexpr int NITEMS = I_IN + 3 * I_SQ + I_UP + I_DN;
        for (int it = gw; it < NITEMS; it += NGW) {
            int r = it;
            if (r < I_IN) { const int nb = r >> 4, kb = r & 15; int src, nv; win_src(nb, src, nv); p0_transpose_item(args.in[7], DIN, DM, WIN, nb * 32, src, nv, scr, kb, lane); continue; } r -= I_IN;
            if (r < I_SQ) { p0_transpose_item(args.in[12], DM, DM, WC, (r >> 4) * 32, (r >> 4) * 32, 32, scr, r & 15, lane); continue; } r -= I_SQ;
            if (r < I_SQ) { p0_transpose_item(args.in[17], DM, DM, WD, (r >> 4) * 32, (r >> 4) * 32, 32, scr, r & 15, lane); continue; } r -= I_SQ;
            if (r < I_SQ) { p0_transpose_item(args.in[18], DM, DM, WO, (r >> 4) * 32, (r >> 4) * 32, 32, scr, r & 15, lane); continue; } r -= I_SQ;
            if (r < I_UP) { p0_transpose_item(args.in[20], DFF, DM, WUP, (r >> 4) * 32, (r >> 4) * 32, 32, scr, r & 15, lane); continue; } r -= I_UP;
            p0_transpose_item(args.in[21], DM, DFF, WDN, (r >> 6) * 32, (r >> 6) * 32, 32, scr, r & 63, lane);
        }
        for (int m = gw; m < MP; m += NGW) {
            if (m >= MR) { GAS unsigned long long* o8 = (GAS unsigned long long*)(H + (size_t)m * DM) + lane;
#pragma unroll
                for (int jj = 0; jj < 4; ++jj) o8[64 * jj] = 0ull; continue; }
            const float* src;
            if (m >= RP) src = args.in[1] + (size_t)(m - RP) * DM;
            else { const int b = m / TP, t = m - b * TP; src = t < NMETA ? args.in[5] + (size_t)t * DM : args.in[0] + ((size_t)b * SEQ + (t - NMETA)) * DM; }
            rms_row_to_bf16(src, args.in[6], H + (size_t)m * DM, lane);
        }
    }
    SEAM(0);
    if (IN(1)) {
        pg8::Gemm g{H, WIN, MP, NIN, DM}; pg8::StaticOrder S; S.init(MP, NIN, G, bx);
        EpiIn E{GLU, QKVB, QS, HALOQ, HALOC, ZS, SGC, SGD, BETAG, args.in[14], args.in[15]};
        pg8::gemm_phase<EpiIn, pg8::StaticOrder, true, true>(lds + RING_OFF, g, S, E);
    }
    SEAM(1);
    if (IN(2)) {
        constexpr int N_CP = BP * NRUN, N_IP = BP * NCH * NH / 2, N_SD = BS * NH / 4, N_CS = BS, N_ITEMS = N_CP + N_IP + N_SD + N_CS;
        volatile LAS int* qslot = (volatile LAS int*)(lds + MISC_OFF + 64);
        for (;;) {
            if (tid == 0) *qslot = (int)__hip_atomic_fetch_add((unsigned*)(ctl + 2048), 1u, __ATOMIC_RELAXED, __HIP_MEMORY_SCOPE_AGENT);
            __syncthreads();
            int it = *qslot;
            __syncthreads();
            if (it >= N_ITEMS) break;
            if (it < N_CP) { conv_unit(args, lds, 0, it / NRUN, it % NRUN); continue; } it -= N_CP;
            if (it < N_IP) { intra_pair(args, lds, it); continue; } it -= N_IP;
            if (it < N_SD) { delta_item(args, lds, it); continue; } it -= N_SD;
            conv_unit(args, lds, 1, it, 0);
        }
    }
    SEAM(2);
    if (IN(3)) {
        if (bx < BP * NH) scan_chain(args, lds, bx);
        else {
            pg8::Gemm g{C, WC, MP, DM, DM}; pg8::StaticOrder S; S.init(MP, DM, G - BP * NH, bx - BP * NH);
            EpiGate<0> E{SGC, nullptr, SGC};
            pg8::gemm_phase<EpiGate<0>, pg8::StaticOrder, true, true>(lds + RING_OFF, g, S, E);
        }
    }
    SEAM(3);
    if (IN(4)) {
        pg8::Gemm g{ZS, WD, MP, DM, DM}; pg8::StaticOrder S; S.init(MP, DM, G, bx);
        EpiGate<1> E{SGD, SGC, MIX};
        pg8::gemm_phase<EpiGate<1>, pg8::StaticOrder, true, true>(lds + RING_OFF, g, S, E);
    }
    SEAM(4);
    if (IN(5)) {
        pg8::Gemm g{MIX, WO, M2, DM, DM}; pg8::StaticOrder S; S.init(M2, DM, G, bx);
        EpiRes<0> E{args.in[0], args.in[1], args.out};
        pg8::gemm_phase<EpiRes<0>, pg8::StaticOrder, true, true>(lds + RING_OFF, g, S, E);
    }
    SEAM(5);
    if (IN(6)) {
        for (int m = gw; m < M2; m += NGW) rms_row_to_bf16(args.out + (size_t)m * DM, args.in[19], XG + (size_t)m * DM, lane);
    }
    SEAM(6);
    if (IN(7)) {
        pg8::Gemm g{XG, WUP, M2, DFF, DM}; pg8::StaticOrder S; S.init(M2, DFF, G, bx);
        EpiUp E{HM};
        pg8::gemm_phase<EpiUp, pg8::StaticOrder, true, true>(lds + RING_OFF, g, S, E);
    }
    SEAM(7);
    if (IN(8)) {
        pg8::Gemm g{HM, WDN, M2, DM, DFF}; pg8::StaticOrder S; S.init(M2, DM, G, bx);
        EpiRes<1> E{nullptr, nullptr, args.out};
        pg8::gemm_phase<EpiRes<1>, pg8::StaticOrder, true, true>(lds + RING_OFF, g, S, E);
    }
    SEAM(8);
    if (IN(9)) {
        for (int m = gw; m < M2; m += NGW) {
            float* xrow = args.out + (size_t)m * DM;
            GAS f32x4* xr = (GAS f32x4*)xrow + lane; const GAS f32x4* gr = (const GAS f32x4*)args.in[22] + lane;
            f32x4 v[4]; float s = 0.f;
#pragma unroll
            for (int jj = 0; jj < 4; ++jj) { v[jj] = xr[64 * jj]; s += (v[jj].x * v[jj].x + v[jj].y * v[jj].y) + (v[jj].z * v[jj].z + v[jj].w * v[jj].w); }
            const float rstd = 1.f / sqrtf(wave_sum(s) * (1.f / DM) + EPS);
#pragma unroll
            for (int jj = 0; jj < 4; ++jj) xr[64 * jj] = v[jj] * rstd * gr[64 * jj];
        }
    }
#if PROBE_K >= 0
    __syncthreads();
    if (bx == 0) { if (tid == 0) stamps[NPHASES] = __builtin_amdgcn_s_memrealtime(); __syncthreads();
        const float dt_us = (float)(stamps[PROBE_B] - stamps[PROBE_K]) * 0.01f; const float f = 1.f + dt_us * (1.f / (float)(PROBE_DIV));
        for (int i = tid; i < BP * 3 * DQKV; i += NWAVES * 64) args.out[O_PQ + i] *= f; }
#endif
#undef IN
#undef SEAM
}

extern "C" void kernel_launch(void* const* d_in, const int* in_sizes, int n_in, void* d_out, int out_size, void* d_ws, size_t ws_size, hipStream_t stream) {
    static int grid = 0;
    if (grid == 0) {
        if (n_in != 23 || (size_t)out_size != O_END || ws_size < WS_END) { fprintf(stderr, "kernel_launch: unexpected shapes n_in %d out %d ws %zu\n", n_in, out_size, ws_size); grid = -1; return; }
        int dev = 0, cus = 0, per_cu = 0;
        if (hipGetDevice(&dev) != hipSuccess || hipDeviceGetAttribute(&cus, hipDeviceAttributeMultiprocessorCount, dev) != hipSuccess) { grid = -1; return; }
        if (hipFuncSetAttribute((const void*)fwd_kernel, hipFuncAttributeMaxDynamicSharedMemorySize, LDS_BYTES) != hipSuccess) { fprintf(stderr, "kernel_launch: hipFuncSetAttribute failed\n"); grid = -1; return; }
        if (hipOccupancyMaxActiveBlocksPerMultiprocessor(&per_cu, (const void*)fwd_kernel, NWAVES * 64, LDS_BYTES) != hipSuccess || per_cu < 1)
            fprintf(stderr, "kernel_launch: occupancy query reports %d\n", per_cu);
        (void)hipGetLastError();
        grid = cus;
    }
    if (grid < 0) return;
    if (hipMemsetAsync((char*)d_ws + WS_CTL, 0, CTL_ZERO_BYTES, stream) != hipSuccess) return;
    Args a{};
    for (int i = 0; i < 23; ++i) a.in[i] = (const float*)d_in[i];
    a.out = (float*)d_out; a.ws = (unsigned char*)d_ws;
#if MK_N_LAUNCHES == 1
    a.ph_lo = 0; a.ph_hi = NPHASES;
    hipLaunchKernelGGL(fwd_kernel, dim3(grid), dim3(NWAVES * 64), LDS_BYTES, stream, a);
#else
    for (int p = 0; p < NPHASES; ++p) { a.ph_lo = p; a.ph_hi = p + 1; hipLaunchKernelGGL(fwd_kernel, dim3(grid), dim3(NWAVES * 64), LDS_BYTES, stream, a); }
#endif
}
```

```cpp
#include <hip/hip_runtime.h>
#include <cstdio>
#include <cstdint>

#ifndef MK_N_LAUNCHES
#define MK_N_LAUNCHES 1
#endif

namespace pg8 {
#define PG8_LAS __attribute__((address_space(3)))
typedef unsigned short bf16_t;
typedef short bf16x8 __attribute__((ext_vector_type(8)));
typedef float f32x4 __attribute__((ext_vector_type(4)));
typedef unsigned u32x4 __attribute__((ext_vector_type(4)));
constexpr int BM = 256, BK = 64, HALF = 128, HTB = HALF * BK * 2, STAGE_BYTES = 8 * HTB, NXCD = 8, WGM = 8;

__host__ __device__ __forceinline__ int lds_byte(int r, int c) { const int st = (r >> 4) * 2 + (c >> 5), rr = r & 15, cc = c & 31, ob = rr * 64 + cc * 2; return st * 1024 + (ob ^ (((ob >> 9) & 1) << 5)); }
__host__ __device__ __forceinline__ void stage_rc(int b, int& R, int& C) { const int st = b / 1024, sb = b % 1024, swz = sb ^ (((sb >> 9) & 1) << 5); R = (st >> 1) * 16 + swz / 64; C = (st & 1) * 32 + (swz % 64) / 2; }
__host__ __device__ __forceinline__ int perm32(int rho) { const int n = rho >> 4, i = rho & 15; return 8 * (i >> 2) + 4 * n + (i & 3); }

struct Unit { int pm, pn; };
struct Gemm { const bf16_t* A; const bf16_t* Bt; int M, N, K; };

struct StaticOrder {
    int nM, nN, nwg, G, c;
    __host__ __device__ void init(int M, int N, int G_, int c_) { nM = M / BM; nN = N / BM; nwg = nM * nN; G = G_; c = c_; }
    __host__ __device__ bool next(int i, Unit& u) const {
        const long L = (long)i * G + c; if (L >= nwg) return false;
        int wgid = (int)L; { const int q = nwg / NXCD, r = nwg % NXCD, xcd = wgid % NXCD, off = wgid / NXCD; wgid = (xcd < r ? xcd * (q + 1) : r * (q + 1) + (xcd - r) * q) + off; }
        const int nig = WGM * nN, gid = wgid / nig, fm = gid * WGM, gsz = (nM - fm) < WGM ? (nM - fm) : WGM;
        u.pm = fm + ((wgid % nig) % gsz); u.pn = (wgid % nig) / gsz; return true;
    }
    __device__ __forceinline__ void a_ready(const Unit&) const {}
    __device__ __forceinline__ void done(const Unit&) const {}
};

__device__ __forceinline__ unsigned cvt_pk_bf16(float lo, float hi) { unsigned r; asm volatile("v_cvt_pk_bf16_f32 %0, %1, %2" : "=v"(r) : "v"(lo), "v"(hi)); return r; }

template <class Epi, class Sched, bool ALIGN_EPI = false, bool SP2 = false>
__device__ __forceinline__ void gemm_phase(PG8_LAS unsigned char* lds, const Gemm g, const Sched& S, const Epi& E) {
    const int tid = threadIdx.x, wid = __builtin_amdgcn_readfirstlane(tid >> 6), lane = tid & 63, wr = wid >> 2, wc = wid & 3, fr = lane & 15, fq = lane >> 4;
    const int K = g.K, nt = K / BK;
    unsigned voffA[2], voffB[2];
#pragma unroll
    for (int i = 0; i < 2; ++i) { int R, C; stage_rc(tid * 16 + i * 8192, R, C); const int Rb = Epi::PERM ? ((R & ~31) + perm32(R & 31)) : R;
        voffA[i] = (unsigned)(R * K + C) * 2u; voffB[i] = (unsigned)(Rb * K + C) * 2u; }
    const size_t kstep = (size_t)(BK * 2);
    const size_t hstep = (size_t)HALF * K * 2;
    const size_t tstep = 2 * hstep;
    const unsigned ldsw = (unsigned)wid * 1024u;
    const int aoff = lds_byte(wr * 64 + fr, fq * 8), boff = lds_byte(wc * 32 + fr, fq * 8);
#define PG8_SA(b, h) (((b) * 2 + (h)) * HTB)
#define PG8_SB(b, h) ((4 + (b) * 2 + (h)) * HTB)
#define PG8_STAGE(bufoff, gbase, voff) do { _Pragma("unroll") for (int _i = 0; _i < 2; ++_i) \
        __builtin_amdgcn_global_load_lds((const unsigned*)((const char*)(gbase) + (voff)[_i]), (PG8_LAS unsigned*)(lds + (bufoff) + ldsw + _i * 8192), 16, 0, 0); } while (0)
#define PG8_LDA(dst, b, h) do { _Pragma("unroll") for (int m = 0; m < 4; ++m) _Pragma("unroll") for (int k = 0; k < 2; ++k) dst[m][k] = *(const PG8_LAS bf16x8*)(lds + PG8_SA(b, h) + aoff + m * 2048 + k * 1024); } while (0)
#define PG8_LDB(dst, b, h) do { _Pragma("unroll") for (int n = 0; n < 2; ++n) _Pragma("unroll") for (int k = 0; k < 2; ++k) dst[n][k] = *(const PG8_LAS bf16x8*)(lds + PG8_SB(b, h) + boff + n * 2048 + k * 1024); } while (0)
#define PG8_MMA(ai, bj, At, Bt) do { __builtin_amdgcn_s_setprio(1); _Pragma("unroll") for (int m = 0; m < 4; ++m) _Pragma("unroll") for (int n = 0; n < 2; ++n) _Pragma("unroll") for (int k = 0; k < 2; ++k) \
        acc[ai][bj][m][n] = __builtin_amdgcn_mfma_f32_16x16x32_bf16(Bt[n][k], At[m][k], acc[ai][bj][m][n], 0, 0, 0); __builtin_amdgcn_s_setprio(0); } while (0)
#define PG8_WAIT_V(n) asm volatile("s_waitcnt vmcnt(" #n ")" ::: "memory")
#define PG8_WAIT_L(n) asm volatile("s_waitcnt lgkmcnt(" #n ")" ::: "memory")
#define PG8_BAR __builtin_amdgcn_s_barrier()
#define PG8_SCHED __builtin_amdgcn_sched_barrier(0)
    Unit cur, nxt; int ui = 0;
    if (!S.next(0, cur)) return;
    f32x4 acc[2][2][4][2];
#pragma unroll
    for (int a = 0; a < 2; ++a)
#pragma unroll
        for (int b = 0; b < 2; ++b)
#pragma unroll
            for (int m = 0; m < 4; ++m)
#pragma unroll
                for (int n = 0; n < 2; ++n) acc[a][b][m][n] = (f32x4){0.f, 0.f, 0.f, 0.f};
    bf16x8 At[4][2], B0[2][2], B1[2][2];
    const char* cA = (const char*)g.A + (size_t)cur.pm * tstep; const char* cB = (const char*)g.Bt + (size_t)cur.pn * tstep;
    S.a_ready(cur);
    if constexpr (SP2) {
        PG8_STAGE(PG8_SB(0, 0), cB, voffB); PG8_STAGE(PG8_SB(0, 1), cB + hstep, voffB); PG8_STAGE(PG8_SA(0, 0), cA, voffA); PG8_STAGE(PG8_SA(0, 1), cA + hstep, voffA);
        if (wr == 1) PG8_BAR;
        PG8_WAIT_V(2); PG8_BAR;
        PG8_STAGE(PG8_SB(1, 0), cB + kstep, voffB); PG8_STAGE(PG8_SA(1, 0), cA + kstep, voffA); PG8_STAGE(PG8_SB(1, 1), cB + hstep + kstep, voffB);
        PG8_WAIT_V(6); PG8_BAR;
    } else {
        PG8_STAGE(PG8_SB(0, 0), cB, voffB); PG8_STAGE(PG8_SA(0, 0), cA, voffA); PG8_STAGE(PG8_SB(0, 1), cB + hstep, voffB); PG8_STAGE(PG8_SA(0, 1), cA + hstep, voffA);
        if (wr == 1) PG8_BAR;
        PG8_WAIT_V(4); PG8_BAR;
        PG8_STAGE(PG8_SB(1, 0), cB + kstep, voffB); PG8_STAGE(PG8_SA(1, 0), cA + kstep, voffA); PG8_STAGE(PG8_SB(1, 1), cB + hstep + kstep, voffB);
        PG8_WAIT_V(6); PG8_BAR;
    }
    for (;;) {
        const bool has_next = S.next(ui + 1, nxt);
        const char* nA = has_next ? (const char*)g.A + (size_t)nxt.pm * tstep : cA; const char* nB = has_next ? (const char*)g.Bt + (size_t)nxt.pn * tstep : cB;
        for (int t = 0; t < nt; t += 2) {
            const bool last = (t == nt - 2);
            const char* a1 = cA + (size_t)(t + 1) * kstep;
            const char* a2 = last ? nA : cA + (size_t)(t + 2) * kstep; const char* b2 = last ? nB : cB + (size_t)(t + 2) * kstep;
            const char* a3 = a2 + kstep; const char* b3 = b2 + kstep;
            if (last && has_next) S.a_ready(nxt);
            if constexpr (SP2) {
            PG8_LDB(B0, 0, 0); PG8_LDB(B1, 0, 1); PG8_SCHED; PG8_LDA(At, 0, 0); PG8_STAGE(PG8_SA(1, 1), a1 + hstep, voffA);
            PG8_WAIT_V(8); PG8_WAIT_L(0); PG8_BAR; PG8_MMA(0, 0, At, B0); PG8_MMA(0, 1, At, B1); PG8_BAR; PG8_SCHED;
            PG8_LDA(At, 0, 1); PG8_STAGE(PG8_SB(0, 0), b2, voffB); PG8_STAGE(PG8_SB(0, 1), b2 + hstep, voffB); PG8_STAGE(PG8_SA(0, 0), a2, voffA);
            PG8_WAIT_V(8); PG8_WAIT_L(0); PG8_BAR; PG8_MMA(1, 0, At, B0); PG8_MMA(1, 1, At, B1); PG8_BAR; PG8_SCHED;
            PG8_LDB(B0, 1, 0); PG8_LDB(B1, 1, 1); PG8_SCHED; PG8_LDA(At, 1, 0); PG8_STAGE(PG8_SA(0, 1), a2 + hstep, voffA);
            PG8_WAIT_V(8); PG8_WAIT_L(0); PG8_BAR; PG8_MMA(0, 0, At, B0); PG8_MMA(0, 1, At, B1); PG8_BAR; PG8_SCHED;
            PG8_LDA(At, 1, 1); PG8_STAGE(PG8_SB(1, 0), b3, voffB); PG8_STAGE(PG8_SB(1, 1), b3 + hstep, voffB); PG8_STAGE(PG8_SA(1, 0), a3, voffA);
            PG8_WAIT_V(8); PG8_WAIT_L(0); PG8_BAR; PG8_MMA(1, 0, At, B0); PG8_MMA(1, 1, At, B1); PG8_BAR; PG8_SCHED;
            } else {
            PG8_LDB(B0, 0, 0); PG8_SCHED; PG8_LDA(At, 0, 0); PG8_STAGE(PG8_SA(1, 1), a1 + hstep, voffA);
            PG8_WAIT_L(8); PG8_BAR; PG8_WAIT_L(0); PG8_MMA(0, 0, At, B0); PG8_BAR; PG8_SCHED;
            PG8_LDB(B1, 0, 1); PG8_STAGE(PG8_SB(0, 0), b2, voffB);
            PG8_BAR; PG8_WAIT_L(0); PG8_MMA(0, 1, At, B1); PG8_BAR;
            PG8_LDA(At, 0, 1); PG8_STAGE(PG8_SA(0, 0), a2, voffA);
            PG8_BAR; PG8_WAIT_L(0); PG8_MMA(1, 0, At, B0); PG8_BAR; PG8_SCHED;
            PG8_STAGE(PG8_SB(0, 1), b2 + hstep, voffB);
            PG8_WAIT_V(6); PG8_BAR; PG8_MMA(1, 1, At, B1); PG8_BAR;
            PG8_LDB(B0, 1, 0); PG8_SCHED; PG8_LDA(At, 1, 0); PG8_STAGE(PG8_SA(0, 1), a2 + hstep, voffA);
            PG8_WAIT_L(8); PG8_BAR; PG8_WAIT_L(0); PG8_MMA(0, 0, At, B0); PG8_BAR; PG8_SCHED;
            PG8_LDB(B1, 1, 1); PG8_STAGE(PG8_SB(1, 0), b3, voffB);
            PG8_BAR; PG8_WAIT_L(0); PG8_MMA(0, 1, At, B1); PG8_BAR;
            PG8_LDA(At, 1, 1); PG8_STAGE(PG8_SA(1, 0), a3, voffA);
            PG8_BAR; PG8_WAIT_L(0); PG8_MMA(1, 0, At, B0); PG8_BAR; PG8_SCHED;
            PG8_STAGE(PG8_SB(1, 1), b3 + hstep, voffB);
            PG8_WAIT_V(6); PG8_BAR; PG8_MMA(1, 1, At, B1); PG8_BAR;
            }
        }
        if constexpr (ALIGN_EPI) { if (wr == 0) PG8_BAR; }
        E(acc, cur, wr, wc, fr, fq); S.done(cur);
        if (!has_next) break;
#pragma unroll
        for (int a = 0; a < 2; ++a)
#pragma unroll
            for (int b = 0; b < 2; ++b)
#pragma unroll
                for (int m = 0; m < 4; ++m)
#pragma unroll
                    for (int n = 0; n < 2; ++n) acc[a][b][m][n] = (f32x4){0.f, 0.f, 0.f, 0.f};
        cur = nxt; cA = nA; cB = nB; ++ui;
        if constexpr (ALIGN_EPI) { if (wr == 1) PG8_BAR; }
    }
    PG8_WAIT_V(0);
    if constexpr (!ALIGN_EPI) { if (wr == 0) PG8_BAR; }
    PG8_BAR;
#undef PG8_SA
#undef PG8_SB
#undef PG8_STAGE
#undef PG8_LDA
#undef PG8_LDB
#undef PG8_MMA
#undef PG8_WAIT_V
#undef PG8_WAIT_L
#undef PG8_BAR
#undef PG8_SCHED
}
}

constexpr int NWAVES = 8;
constexpr int DM = 1024, BP = 8, SEQ = 2048, NMETA = 16, TP = SEQ + NMETA, BS = 128, TS = 4;
constexpr int RP = BP * TP;
constexpr int RS = BS * TS;
constexpr int MR = RP + RS;
constexpr int MP = 17152;
constexpr int M2 = BP * SEQ + RS;
constexpr int NH = 8, DH = 128, DQKV = 3072, DFF = 4096, KC = 31, KS = 4;
constexpr int NIN = 8448;
constexpr int DIN = 8208;
constexpr float EPS = 1e-6f;

constexpr size_t O_YP = 0, O_YS = 16777216, O_PC = 17301504, O_PQ = 17547264, O_PD = 17620992, O_SC = 18669568, O_SQ = 22601728, O_SD = 23781376, O_END = 40558592;

constexpr size_t MiB = 1u << 20;
constexpr size_t WS_CTL = 0, CTL_ZERO_BYTES = 1 * MiB;
constexpr size_t WS_BETAG = 1 * MiB;
constexpr size_t WS_LASTV = 9 * MiB / 4;
constexpr size_t WS_HALOQ = 5 * MiB / 2;
constexpr size_t WS_WC = 29 * MiB / 4, WS_WD = WS_WC + 2 * MiB, WS_WO = WS_WD + 2 * MiB, WS_WUP = WS_WO + 2 * MiB, WS_WDN = WS_WUP + 8 * MiB;
constexpr size_t WS_GLU = 117 * MiB / 4;
constexpr size_t WS_QKVB = 63 * MiB;
constexpr size_t WS_QS = 162 * MiB;
constexpr size_t WS_ZS = 165 * MiB;
constexpr size_t WS_H = 397 * MiB / 2;
constexpr size_t WS_WIN = 232 * MiB;
constexpr size_t WS_HALOC = 497 * MiB / 2;
constexpr size_t WS_KDT = WS_H, WS_ATTN = 463 * MiB / 2;
constexpr size_t WS_MIX = WS_QKVB, WS_XG = WS_GLU, WS_HM = WS_QKVB, WS_C = WS_GLU;
constexpr size_t WS_END = 256 * MiB;
constexpr int NRUN = 16, RUNL = TP / NRUN;
static_assert(TP - 64 * 32 == 16 && NRUN * RUNL == TP && WS_HALOC + (size_t)BP * NRUN * 30 * DM * 2 <= WS_END, "conv runs");
constexpr int NCH = 33, QBLK = 3 * 64 * 128;
static_assert(WS_WIN + (size_t)NIN * DM * 2 <= WS_HALOC && WS_WDN + 8 * MiB <= WS_GLU && WS_GLU + (size_t)MP * DM * 2 <= WS_QKVB && WS_HALOQ + (size_t)BP * 33 * 3 * 3072 * 2 <= WS_WC, "ws map");
static_assert(WS_ZS + (size_t)MP * DM * 2 <= WS_H && WS_H + (size_t)MP * DM * 2 <= WS_WIN, "ws map 2");
static_assert(WS_QKVB + (size_t)BP * NCH * NH * QBLK * 2 <= WS_QS, "ws map qkvb");
static_assert(WS_HM + (size_t)M2 * DFF * 2 <= WS_H, "ws map hm");
static_assert(WS_KDT + (size_t)BP * NCH * NH * 8192 * 2 <= WS_ATTN && WS_ATTN + (size_t)BP * NCH * NH * 4096 * 2 <= WS_HALOC, "ws map kdt");
constexpr int CW_TMO = 0, CW_CODE = 1, CW_BAR = 4096;

constexpr int RING_OFF = 0, RING_BYTES = 131072;
constexpr int LDSCTL_OFF = RING_BYTES, MISC_OFF = LDSCTL_OFF + 320;
constexpr int LDS_BYTES = 147456;

#define GAS __attribute__((address_space(1)))
#define LAS __attribute__((address_space(3)))
typedef unsigned short bf16;
typedef unsigned v4u __attribute__((ext_vector_type(4)));
typedef unsigned v2u __attribute__((ext_vector_type(2)));
typedef float f32x4 __attribute__((ext_vector_type(4)));
typedef float f32x2 __attribute__((ext_vector_type(2)));
typedef GAS unsigned gu32;
#define RLX_AGENT __ATOMIC_RELAXED, __HIP_MEMORY_SCOPE_AGENT
#define LDS_WAIT() asm volatile("s_waitcnt lgkmcnt(0)" ::: "memory")
#define VM_WAIT() asm volatile("s_waitcnt vmcnt(0)" ::: "memory")
__device__ __forceinline__ unsigned f2bf(float f) { unsigned u = __builtin_bit_cast(unsigned, f); return (u + 0x7fffu + ((u >> 16) & 1u)) >> 16; }
__device__ __forceinline__ unsigned pk2(float lo, float hi) { return f2bf(lo) | (f2bf(hi) << 16); }
__device__ __forceinline__ float bflo(unsigned w) { return __builtin_bit_cast(float, w << 16); }
__device__ __forceinline__ float bfhi(unsigned w) { return __builtin_bit_cast(float, w & 0xffff0000u); }
__device__ __forceinline__ float bf1(bf16 b) { return __builtin_bit_cast(float, ((unsigned)b) << 16); }
__device__ __forceinline__ float sigmoidf_(float x) { return __builtin_amdgcn_rcpf(1.f + __expf(-x)); }
__device__ __forceinline__ float siluf_(float x) { return x * sigmoidf_(x); }

#define XB_TMO      128
#define XB_XCNT(j)  (256  + 64 * (j))
#define XB_XSUB(j)  (1280 + 64 * (j))
#define XB_XGEN(j)  (2304 + 64 * (j))
#define XB_TOP      3328
#define XB_TOPGEN   3392
#define XCD_BAR_WORDS 3456
#define XB_SPIN_CAP (1u << 18)
__device__ __forceinline__ unsigned xb_ld(unsigned* p)              { return __hip_atomic_load(p, __ATOMIC_RELAXED, __HIP_MEMORY_SCOPE_AGENT); }
__device__ __forceinline__ unsigned xb_add(unsigned* p, unsigned v) { return __hip_atomic_fetch_add(p, v, __ATOMIC_RELAXED, __HIP_MEMORY_SCOPE_AGENT); }
__device__ __forceinline__ unsigned xb_xcc_id() { return (unsigned)__builtin_amdgcn_s_getreg((3 << 11) | 20) & 0xFu; }
#define XB_SPIN(cond, bar) do { unsigned _sp = 0; while (cond) { __builtin_amdgcn_s_sleep(1); \
    if ((++_sp & 255u) == 0u) { if (xb_ld(&(bar)[XB_TMO])) break; if (_sp > XB_SPIN_CAP) { atomicAdd(&(bar)[XB_TMO], 1u); break; } } } } while (0)
struct XcdBarrier { unsigned* bar; unsigned x; volatile LAS unsigned* st; };
__device__ __forceinline__ XcdBarrier xcd_barrier_post(unsigned* bar, volatile LAS unsigned* st) {
    XcdBarrier b; b.bar = bar; b.x = xb_xcc_id(); b.st = st;
    if (threadIdx.x == 0) (void)xb_add(&bar[XB_XCNT(b.x)], 1u);
    return b;
}
__device__ __forceinline__ void xcd_barrier_complete(unsigned* bar, unsigned x, unsigned& nloc, unsigned& nx) {
    const unsigned G = gridDim.x * gridDim.y * gridDim.z;
    unsigned sum, cnt, mine, sp = 0u;
    for (;;) {
        sum = 0u; cnt = 0u; mine = 0u;
#pragma unroll
        for (unsigned j = 0; j < 16; ++j) { const unsigned c = xb_ld(&bar[XB_XCNT(j)]); sum += c; cnt += (c > 0u) ? 1u : 0u; mine = (j == x) ? c : mine; }
        if (sum == G) break;
        __builtin_amdgcn_s_sleep(1);
        if ((++sp & 255u) == 0u) { if (xb_ld(&bar[XB_TMO])) break; if (sp > XB_SPIN_CAP) { atomicAdd(&bar[XB_TMO], 1u); break; } }
    }
    nloc = mine > 0u ? mine : 1u; nx = cnt > 0u ? cnt : 1u;
}
__device__ __forceinline__ void xcd_barrier(const XcdBarrier& b) {
    asm volatile("s_waitcnt vmcnt(0)" ::: "memory");
    __syncthreads();
    if (threadIdx.x == 0) {
        unsigned* bar = b.bar;
        __builtin_amdgcn_s_waitcnt(0);
        unsigned nloc = b.st[0], nx = b.st[1];
        if (nloc == 0u) { xcd_barrier_complete(bar, b.x, nloc, nx); b.st[0] = nloc; b.st[1] = nx; }
        const unsigned old = xb_add(&bar[XB_XSUB(b.x)], 1u);
        const unsigned gen = old / nloc;
        if (old + 1u == (gen + 1u) * nloc) {
            __builtin_amdgcn_fence(__ATOMIC_RELEASE, "agent");
            asm volatile("s_waitcnt vmcnt(0)" ::: "memory");
            const unsigned og = xb_add(&bar[XB_TOP], 1u);
            const unsigned tg = og / nx;
            if (og + 1u == (tg + 1u) * nx) xb_add(&bar[XB_TOPGEN], 1u);
            else XB_SPIN(xb_ld(&bar[XB_TOPGEN]) == tg, bar);
            __builtin_amdgcn_fence(__ATOMIC_ACQUIRE, "agent");
            xb_add(&bar[XB_XGEN(b.x)], 1u);
            asm volatile("s_waitcnt vmcnt(0)" ::: "memory");
        } else {
            XB_SPIN(xb_ld(&bar[XB_XGEN(b.x)]) == gen, bar);
            __builtin_amdgcn_fence(__ATOMIC_ACQUIRE, "agent");
            asm volatile("s_waitcnt vmcnt(0)" ::: "memory");
        }
    }
    __syncthreads();
}

struct Args { const float* in[23]; float* out; unsigned char* ws; int ph_lo, ph_hi; };

#define DPP_ADD(v, ctrl, rmask, bc) v += __builtin_bit_cast(float, __builtin_amdgcn_update_dpp(0, __builtin_bit_cast(int, v), ctrl, rmask, 0xF, bc))
__device__ __forceinline__ float sum16(float v) {
    DPP_ADD(v, 0xB1, 0xF, true); DPP_ADD(v, 0x4E, 0xF, true); DPP_ADD(v, 0x141, 0xF, true); DPP_ADD(v, 0x140, 0xF, true); return v; }
__device__ __forceinline__ float wave_sum(float v) {
    v = sum16(v); DPP_ADD(v, 0x142, 0xA, false); DPP_ADD(v, 0x143, 0xC, false);
    return __builtin_bit_cast(float, __builtin_amdgcn_readlane(__builtin_bit_cast(int, v), 63)); }
__device__ __forceinline__ float rsqf(float x) { return __builtin_amdgcn_rsqf(x); }
__device__ __forceinline__ unsigned cvtpk(float lo, float hi) { unsigned r; asm("v_cvt_pk_bf16_f32 %0, %1, %2" : "=v"(r) : "v"(lo), "v"(hi)); return r; }
__device__ __forceinline__ int compact_row(int r) {
    if (r >= MR) return -1;
    if (r >= RP) return r - RP + BP * SEQ;
    const int b = r / TP, t = r - b * TP;
    return t < NMETA ? -1 : r - NMETA * (b + 1);
}

__device__ __forceinline__ void p0_transpose_item(const float* W, int Nsrc, int K, bf16* WT, int dst_row0, int src_col0, int nvalid, LAS float* scr, int kb, int lane) {
    const int k0 = 64 * kb, cidx = lane & 31;
#pragma unroll 8
    for (int i = 0; i < 32; ++i) { const int kk = 2 * i + (lane >> 5); float v = 0.f; if (cidx < nvalid) v = W[(size_t)(k0 + kk) * Nsrc + src_col0 + cidx]; scr[kk * 33 + cidx] = v; }
    LDS_WAIT(); asm volatile("" ::: "memory");
    const int c = lane & 7;
#pragma unroll
    for (int j = 0; j < 4; ++j) { const int n = (lane >> 3) + 8 * j; const LAS float* s = scr + (8 * c) * 33 + n;
        v4u o; o.x = pk2(s[0 * 33], s[1 * 33]); o.y = pk2(s[2 * 33], s[3 * 33]); o.z = pk2(s[4 * 33], s[5 * 33]); o.w = pk2(s[6 * 33], s[7 * 33]);
        *(GAS v4u*)(WT + (size_t)(dst_row0 + n) * K + k0 + 8 * c) = o; }
    LDS_WAIT(); asm volatile("" ::: "memory");
}
__device__ __forceinline__ void win_src(int nb, int& src, int& nvalid) {
    const int pn = nb >> 3, o = (nb & 7) * 32; nvalid = 32;
    if (pn < 8) src = (o < 128) ? 128 * pn + o : 1024 + 128 * pn + (o - 128);
    else if (pn < 20) src = 2048 + 256 * (pn - 8) + o;
    else if (pn < 24) src = 5120 + 256 * (pn - 20) + o;
    else if (pn < 28) src = 6160 + 256 * (pn - 24) + o;
    else if (pn < 32) src = 7184 + 256 * (pn - 28) + o;
    else { src = 6144; nvalid = (o == 0) ? 16 : 0; }
}
__device__ __forceinline__ void rms_row_to_bf16(const float* xrow, const float* gain, bf16* orow, int lane) {
    const GAS f32x4* xr = (const GAS f32x4*)xrow + lane; const GAS f32x4* gr = (const GAS f32x4*)gain + lane;
    f32x4 v[4]; float s = 0.f;
#pragma unroll
    for (int j = 0; j < 4; ++j) { v[j] = xr[64 * j]; s += (v[j].x * v[j].x + v[j].y * v[j].y) + (v[j].z * v[j].z + v[j].w * v[j].w); }
    const float rstd = 1.f / sqrtf(wave_sum(s) * (1.f / DM) + EPS);
    GAS unsigned long long* o8 = (GAS unsigned long long*)orow + lane;
#pragma unroll
    for (int j = 0; j < 4; ++j) { const f32x4 g = gr[64 * j]; o8[64 * j] = (unsigned long long)pk2(v[j].x * rstd * g.x, v[j].y * rstd * g.y) | ((unsigned long long)pk2(v[j].z * rstd * g.z, v[j].w * rstd * g.w) << 32); }
}

typedef pg8::f32x4 A4;
struct EpiIn {
    static constexpr bool PERM = true;
    bf16 *GLU, *QKVB, *QS, *HALOQ, *HALOC, *ZS, *SGC, *SGD; float* BETAG; const float *a_log, *dt_bias;
    __device__ __forceinline__ void operator()(const A4 (&acc)[2][2][4][2], const pg8::Unit& u, int wr, int wc, int fr, int fq) const {
        const int pn = u.pn, row0 = u.pm * 256 + wr * 64 + fr, cw = 32 * wc + 8 * fq;
        if (pn < 8) {
#pragma unroll
            for (int ai = 0; ai < 2; ++ai)
#pragma unroll
                for (int m = 0; m < 4; ++m) { const int r = row0 + ai * 128 + m * 16; float o[8];
#pragma unroll
                    for (int n = 0; n < 2; ++n)
#pragma unroll
                        for (int j = 0; j < 4; ++j) o[4 * n + j] = acc[ai][0][m][n][j] * sigmoidf_(acc[ai][1][m][n][j]);
                    v4u w; w.x = pk2(o[0], o[1]); w.y = pk2(o[2], o[3]); w.z = pk2(o[4], o[5]); w.w = pk2(o[6], o[7]);
                    *(GAS v4u*)(GLU + (size_t)r * DM + 128 * pn + cw) = w;
                    if (r < RP) { const int b = r / TP, t = r - b * TP, run = t / RUNL, pos = t - run * RUNL;
                        if (pos >= RUNL - 30 && run < NRUN - 1) *(GAS v4u*)(HALOC + ((size_t)(b * NRUN + run) * 30 + (pos - (RUNL - 30))) * DM + 128 * pn + cw) = w; } }
        } else if (pn < 20) {
            const int colb = 256 * (pn - 8);
#pragma unroll
            for (int ai = 0; ai < 2; ++ai)
#pragma unroll
                for (int m = 0; m < 4; ++m) { const int r = row0 + ai * 128 + m * 16; if (r >= MR) continue;
#pragma unroll
                    for (int bj = 0; bj < 2; ++bj) { const int col = colb + 128 * bj + cw;
                        const A4 a0 = acc[ai][bj][m][0], a1 = acc[ai][bj][m][1];
                        v4u w; w.x = pk2(a0[0], a0[1]); w.y = pk2(a0[2], a0[3]); w.z = pk2(a1[0], a1[1]); w.w = pk2(a1[2], a1[3]);
                        if (r >= RP) *(GAS v4u*)(QS + (size_t)(r - RP) * DQKV + col) = w;
                        else { const int b = r / TP, t = r - b * TP, c = t >> 6, i = t & 63, which = col >> 10, h = (col >> 7) & 7, d = col & 127;
                            *(GAS v4u*)(QKVB + ((size_t)((b * NCH + c) * NH + h) * 3 + which) * 8192 + i * 128 + d) = w;
                            if (i >= 61) *(GAS v4u*)(HALOQ + ((size_t)(b * NCH + c) * 3 + (i - 61)) * DQKV + col) = w; } } }
        } else if (pn < 24) {
            constexpr bool isz = true; bf16* dst = ZS; const int ld = DM, cb = 256 * (pn - 20);
#pragma unroll
            for (int ai = 0; ai < 2; ++ai)
#pragma unroll
                for (int m = 0; m < 4; ++m) { const int r = row0 + ai * 128 + m * 16;
#pragma unroll
                    for (int bj = 0; bj < 2; ++bj) { float o[8];
#pragma unroll
                        for (int n = 0; n < 2; ++n)
#pragma unroll
                            for (int j = 0; j < 4; ++j) { const float v = acc[ai][bj][m][n][j]; o[4 * n + j] = isz ? siluf_(v) : v; }
                        v4u w; w.x = pk2(o[0], o[1]); w.y = pk2(o[2], o[3]); w.z = pk2(o[4], o[5]); w.w = pk2(o[6], o[7]);
                        *(GAS v4u*)(dst + (size_t)r * ld + cb + 128 * bj + cw) = w; } }
        } else if (pn < 32) {
            bf16* dst = pn < 28 ? SGC : SGD; const int cb = 256 * ((pn - 24) & 3);
#pragma unroll
            for (int ai = 0; ai < 2; ++ai)
#pragma unroll
                for (int m = 0; m < 4; ++m) { const int rc = compact_row(row0 + ai * 128 + m * 16); if (rc < 0) continue;
#pragma unroll
                    for (int bj = 0; bj < 2; ++bj) { float o[8];
#pragma unroll
                        for (int n = 0; n < 2; ++n)
#pragma unroll
                            for (int j = 0; j < 4; ++j) o[4 * n + j] = sigmoidf_(acc[ai][bj][m][n][j]);
                        v4u w; w.x = pk2(o[0], o[1]); w.y = pk2(o[2], o[3]); w.z = pk2(o[4], o[5]); w.w = pk2(o[6], o[7]);
                        *(GAS v4u*)(dst + (size_t)rc * DM + cb + 128 * bj + cw) = w; } }
        } else {
            if (wc == 0 && fq < 2) {
#pragma unroll
                for (int ai = 0; ai < 2; ++ai)
#pragma unroll
                    for (int m = 0; m < 4; ++m) { const int r = row0 + ai * 128 + m * 16; float o[8];
#pragma unroll
                        for (int n = 0; n < 2; ++n)
#pragma unroll
                            for (int j = 0; j < 4; ++j) { const int h = 4 * n + j; const float v = acc[ai][0][m][n][j];
                                if (fq == 0) o[h] = 1.f / (1.f + expf(-v));
                                else { const float xx = v + dt_bias[h]; const float sp = xx > 20.f ? xx : log1pf(expf(xx)); o[h] = -expf(a_log[h]) * sp; } }
                        GAS f32x4* p = (GAS f32x4*)(BETAG + (size_t)r * 16 + 8 * fq);
                        p[0] = (f32x4){o[0], o[1], o[2], o[3]}; p[1] = (f32x4){o[4], o[5], o[6], o[7]}; }
            }
        }
    }
};
template <int MODE> struct EpiGate {
    static constexpr bool PERM = true;
    bf16 *SG, *MA, *OUT;
    __device__ __forceinline__ void operator()(const A4 (&acc)[2][2][4][2], const pg8::Unit& u, int wr, int wc, int fr, int fq) const {
        const int row0 = u.pm * 256 + wr * 64 + fr, c0 = 256 * u.pn + 32 * wc + 8 * fq;
#pragma unroll
        for (int ai = 0; ai < 2; ++ai)
#pragma unroll
            for (int m = 0; m < 4; ++m) { const int rc = compact_row(row0 + ai * 128 + m * 16); if (rc < 0) continue;
#pragma unroll
                for (int bj = 0; bj < 2; ++bj) { const size_t off = (size_t)rc * DM + c0 + 128 * bj;
                    const v4u g = *(const GAS v4u*)(SG + off); float o[8];
                    const A4 a0 = acc[ai][bj][m][0], a1 = acc[ai][bj][m][1];
                    o[0] = bflo(g.x) * a0[0]; o[1] = bfhi(g.x) * a0[1]; o[2] = bflo(g.y) * a0[2]; o[3] = bfhi(g.y) * a0[3];
                    o[4] = bflo(g.z) * a1[0]; o[5] = bfhi(g.z) * a1[1]; o[6] = bflo(g.w) * a1[2]; o[7] = bfhi(g.w) * a1[3];
                    if (MODE == 1) { const v4u q = *(const GAS v4u*)(MA + off);
                        o[0] += bflo(q.x); o[1] += bfhi(q.x); o[2] += bflo(q.y); o[3] += bfhi(q.y); o[4] += bflo(q.z); o[5] += bfhi(q.z); o[6] += bflo(q.w); o[7] += bfhi(q.w); }
                    v4u w; w.x = pk2(o[0], o[1]); w.y = pk2(o[2], o[3]); w.z = pk2(o[4], o[5]); w.w = pk2(o[6], o[7]);
                    *(GAS v4u*)(OUT + off) = w; } }
    }
};
template <int MODE> struct EpiRes {
    static constexpr bool PERM = false;
    const float *xp, *xs; float* out;
    __device__ __forceinline__ void operator()(const A4 (&acc)[2][2][4][2], const pg8::Unit& u, int wr, int wc, int fr, int fq) const {
        const int row0 = u.pm * 256 + wr * 64 + fr, c0 = 256 * u.pn + 32 * wc + 4 * fq;
#pragma unroll
        for (int ai = 0; ai < 2; ++ai)
#pragma unroll
            for (int m = 0; m < 4; ++m) { const int r = row0 + ai * 128 + m * 16;
                const float* base = MODE == 0 ? (r < BP * SEQ ? xp + (size_t)r * DM : xs + (size_t)(r - BP * SEQ) * DM) : out + (size_t)r * DM;
                float* orow = out + (size_t)r * DM;
#pragma unroll
                for (int bj = 0; bj < 2; ++bj)
#pragma unroll
                    for (int n = 0; n < 2; ++n) { const int c = c0 + 128 * bj + 16 * n; const f32x4 b = *(const GAS f32x4*)(base + c); *(GAS f32x4*)(orow + c) = b + acc[ai][bj][m][n]; } }
    }
};
struct EpiUp {
    static constexpr bool PERM = true;
    bf16* HM;
    __device__ __forceinline__ void operator()(const A4 (&acc)[2][2][4][2], const pg8::Unit& u, int wr, int wc, int fr, int fq) const {
        const int row0 = u.pm * 256 + wr * 64 + fr, c0 = 256 * u.pn + 32 * wc + 8 * fq;
#pragma unroll
        for (int ai = 0; ai < 2; ++ai)
#pragma unroll
            for (int m = 0; m < 4; ++m) { const int r = row0 + ai * 128 + m * 16;
#pragma unroll
                for (int bj = 0; bj < 2; ++bj) { float o[8];
#pragma unroll
                    for (int n = 0; n < 2; ++n)
#pragma unroll
                        for (int j = 0; j < 4; ++j) { const float v = fmaxf(acc[ai][bj][m][n][j], 0.f); o[4 * n + j] = v * v; }
                    v4u w; w.x = pk2(o[0], o[1]); w.y = pk2(o[2], o[3]); w.z = pk2(o[4], o[5]); w.w = pk2(o[6], o[7]);
                    *(GAS v4u*)(HM + (size_t)r * DFF + c0 + 128 * bj) = w; } }
    }
};

template <int KIND>
__device__ __forceinline__ void conv_unit(const Args& a, LAS unsigned char* lds, int b, int run) {
    asm volatile("" ::: "memory");
    const int tid = threadIdx.x, lane = tid & 63, wave = tid >> 6; int ch = 2 * tid; asm volatile("" : "+v"(ch));
    unsigned char* ws = a.ws;
    bf16* GC = (bf16*)(ws + WS_GLU); const bf16* HALOC = (const bf16*)(ws + WS_HALOC);
    const float* w_dw = a.in[8];
    LAS float* red = (LAS float*)lds;
    constexpr int NTOK = KIND == 0 ? RUNL : TS, NSTEP = (NTOK + 3) / 4, REM = NTOK - 4 * (NSTEP - 1);
    f32x2 w[KC]; unsigned E[KC + 3];
#pragma unroll
    for (int i = 0; i < KC; ++i) w[i] = *(const GAS f32x2*)(w_dw + (size_t)i * DM + ch);
    const f32x2 bdw = *(const GAS f32x2*)(a.in[9] + ch), lng = *(const GAS f32x2*)(a.in[10] + ch), lnb = *(const GAS f32x2*)(a.in[11] + ch);
    const int row0 = KIND == 0 ? b * TP + run * RUNL : RP + b * TS;
    if (KIND == 0) {
#pragma unroll
        for (int i = 0; i < KC - 1; ++i) { unsigned v = *(const GAS unsigned*)(HALOC + ((size_t)(b * NRUN + (run > 0 ? run - 1 : 0)) * 30 + i) * DM + ch); E[i] = run > 0 ? v : 0u; }
    } else { const float* st = a.in[2] + (size_t)b * (KC - 1) * DM;
#pragma unroll
        for (int i = 0; i < KC - 1; ++i) { const f32x2 v = *(const GAS f32x2*)(st + (size_t)i * DM + ch); E[i] = pk2(v.x, v.y); }
    }
    unsigned nx[4];
#pragma unroll
    for (int k = 0; k < 4; ++k) nx[k] = *(const GAS unsigned*)(GC + (size_t)(row0 + (k < NTOK ? k : NTOK - 1)) * DM + ch);
    for (int st4 = 0; st4 < NSTEP; ++st4) {
        const int t0 = 4 * st4;
#pragma unroll
        for (int k = 0; k < 4; ++k) E[KC - 1 + k] = nx[k];
        if (st4 + 1 < NSTEP) {
#pragma unroll
            for (int k = 0; k < 4; ++k) { const int t = t0 + 4 + k; nx[k] = *(const GAS unsigned*)(GC + (size_t)(row0 + (t < NTOK ? t : NTOK - 1)) * DM + ch); }
        }
        f32x2 y[4] = {bdw, bdw, bdw, bdw};
#pragma unroll
        for (int j = 0; j < KC + 3; ++j) { const f32x2 e = {bflo(E[j]), bfhi(E[j])};
#pragma unroll
            for (int k = 0; k < 4; ++k) { const int i = j - k; if (i >= 0 && i < KC) y[k] += w[i] * e; } }
        float sv[8];
#pragma unroll
        for (int k = 0; k < 4; ++k) { sv[2 * k] = wave_sum(y[k].x + y[k].y); sv[2 * k + 1] = wave_sum(y[k].x * y[k].x + y[k].y * y[k].y); }
        LAS float* rb = red + (st4 & 1) * 64;
        if (lane == 0) { *(LAS f32x4*)(rb + wave * 8) = (f32x4){sv[0], sv[1], sv[2], sv[3]}; *(LAS f32x4*)(rb + wave * 8 + 4) = (f32x4){sv[4], sv[5], sv[6], sv[7]}; }
        __syncthreads();
        f32x4 ta = {0.f, 0.f, 0.f, 0.f}, tb = {0.f, 0.f, 0.f, 0.f};
#pragma unroll
        for (int i = 0; i < 8; ++i) { ta += *(const LAS f32x4*)(rb + i * 8); tb += *(const LAS f32x4*)(rb + i * 8 + 4); }
        const float tt[8] = {ta.x, ta.y, ta.z, ta.w, tb.x, tb.y, tb.z, tb.w};
#pragma unroll
        for (int k = 0; k < 4; ++k) { if (t0 + k < NTOK) {
            const float mu = tt[2 * k] * (1.f / DM), var = fmaxf(tt[2 * k + 1] * (1.f / DM) - mu * mu, 0.f), rstd = rsqf(var + EPS);
            const float z0 = (y[k].x - mu) * rstd * lng.x + lnb.x, z1 = (y[k].y - mu) * rstd * lng.y + lnb.y;
            *(GAS unsigned*)(GC + (size_t)(row0 + t0 + k) * DM + ch) = pk2(siluf_(z0), siluf_(z1)); } }
        if (st4 + 1 < NSTEP) {
#pragma unroll
            for (int i = 0; i < KC - 1; ++i) E[i] = E[i + 4];
        }
    }
    if (KIND == 1 || run == NRUN - 1) { float* o = a.out + (KIND == 0 ? O_PC : O_SC) + (size_t)b * (KC - 1) * DM;
        if (KIND == 0) {
#pragma unroll
            for (int i = 0; i < KC - 1; ++i) *(GAS f32x2*)(o + (size_t)i * DM + ch) = (f32x2){bflo(E[REM + i]), bfhi(E[REM + i])};
        } else {
            const float* st = a.in[2] + (size_t)b * (KC - 1) * DM;
#pragma unroll
            for (int i = 0; i < KC - 1 - TS; ++i) *(GAS f32x2*)(o + (size_t)i * DM + ch) = *(const GAS f32x2*)(st + (size_t)(i + TS) * DM + ch);
#pragma unroll
            for (int i = KC - 1 - TS; i < KC - 1; ++i) *(GAS f32x2*)(o + (size_t)i * DM + ch) = (f32x2){bflo(E[REM + i]), bfhi(E[REM + i])};
        }
    }
    __syncthreads();
}

__device__ __forceinline__ void delta_item(const Args& a, LAS unsigned char* lds, int item) {
    asm volatile("" ::: "memory");
    const int tid = threadIdx.x, lane = tid & 63, sub = tid >> 7, wu = (tid >> 6) & 1; int j = tid & 127; asm volatile("" : "+v"(j));
    const int unit = item * 4 + sub, b = unit >> 3, h = unit & 7;
    const int row0 = RP + b * TS;
    const bf16* QS = (const bf16*)(a.ws + WS_QS); bf16* ZS = (bf16*)(a.ws + WS_ZS); const float* BETAG = (const float*)(a.ws + WS_BETAG);
    LAS float* kq = (LAS float*)lds + sub * 256;
    LAS float* red = (LAS float*)lds + 1024 + sub * 4;
    LAS float* red2 = (LAS float*)lds + 1024 + 16 + sub * 2;
    float S[DH];
    { const float* s0 = a.in[4] + ((size_t)(b * NH + h) * DH) * DH + j;
#pragma unroll
        for (int d = 0; d < DH; ++d) S[d] = s0[(size_t)d * DH]; }
    const int cq = h * DH + j, ck = DM + cq, cv = 2 * DM + cq;
    float wq[KS], wk[KS], wv[KS];
#pragma unroll
    for (int i = 0; i < KS; ++i) { wq[i] = a.in[13][i * DQKV + cq]; wk[i] = a.in[13][i * DQKV + ck]; wv[i] = a.in[13][i * DQKV + cv]; }
    float hq[3], hk[3], hv[3];
#pragma unroll
    for (int i = 0; i < 3; ++i) { const float* st = a.in[3] + ((size_t)b * 3 + i) * DQKV; hq[i] = st[cq]; hk[i] = st[ck]; hv[i] = st[cv]; }
    const float gh = a.in[16][j];
    for (int t = 0; t < TS; ++t) {
        const size_t row = (size_t)(row0 + t);
        const bf16* p = QS + (size_t)(b * TS + t) * DQKV; const float qp = bf1(p[cq]), kp = bf1(p[ck]), vp = bf1(p[cv]);
        const float qc = siluf_(wq[0] * hq[0] + wq[1] * hq[1] + wq[2] * hq[2] + wq[3] * qp);
        const float kc = siluf_(wk[0] * hk[0] + wk[1] * hk[1] + wk[2] * hk[2] + wk[3] * kp);
        const float vc = siluf_(wv[0] * hv[0] + wv[1] * hv[1] + wv[2] * hv[2] + wv[3] * vp);
        hq[0] = hq[1]; hq[1] = hq[2]; hq[2] = qp; hk[0] = hk[1]; hk[1] = hk[2]; hk[2] = kp; hv[0] = hv[1]; hv[1] = hv[2]; hv[2] = vp;
        const float sq = wave_sum(qc * qc), sk = wave_sum(kc * kc);
        kq[j] = kc; kq[128 + j] = qc;
        if (lane == 0) { red[wu * 2] = sq; red[wu * 2 + 1] = sk; }
        const float beta = BETAG[row * 16 + h], gg = BETAG[row * 16 + 8 + h];
        const float zs = bf1(ZS[row * DM + cq]);
        __syncthreads();
        const float nq = (1.f / sqrtf(red[0] + red[2] + 1e-6f)) * 0.08838834764831845f, nk = 1.f / sqrtf(red[1] + red[3] + 1e-6f);
        const float alpha = expf(gg);
        float ks0 = 0.f, ks1 = 0.f, ks2 = 0.f, ks3 = 0.f;
#pragma unroll
        for (int d = 0; d < DH; d += 4) { const f32x4 kk = *(const LAS f32x4*)(kq + d); ks0 += kk.x * S[d]; ks1 += kk.y * S[d + 1]; ks2 += kk.z * S[d + 2]; ks3 += kk.w * S[d + 3];
            if ((d & 31) == 28) asm volatile("" ::: "memory"); }
        const float kS = (ks0 + ks1) + (ks2 + ks3);
        const float u = beta * (vc - alpha * nk * kS), un = nk * u;
        float o0 = 0.f, o1 = 0.f, o2 = 0.f, o3 = 0.f;
#pragma unroll
        for (int d = 0; d < DH; d += 4) { const f32x4 kk = *(const LAS f32x4*)(kq + d); const f32x4 qq = *(const LAS f32x4*)(kq + 128 + d);
            S[d] = alpha * S[d] + kk.x * un; S[d + 1] = alpha * S[d + 1] + kk.y * un; S[d + 2] = alpha * S[d + 2] + kk.z * un; S[d + 3] = alpha * S[d + 3] + kk.w * un;
            o0 += qq.x * S[d]; o1 += qq.y * S[d + 1]; o2 += qq.z * S[d + 2]; o3 += qq.w * S[d + 3];
            if ((d & 15) == 12) asm volatile("" ::: "memory"); }
        const float o = ((o0 + o1) + (o2 + o3)) * nq;
        const float so = wave_sum(o * o);
        if (lane == 0) red2[wu] = so;
        __syncthreads();
        const float rms = 1.f / sqrtf((red2[0] + red2[1]) * (1.f / DH) + EPS);
        ZS[row * DM + cq] = (bf16)f2bf(o * rms * gh * zs);
    }
    { float* so = a.out + O_SD + ((size_t)(b * NH + h) * DH) * DH + j;
#pragma unroll
        for (int d = 0; d < DH; ++d) so[(size_t)d * DH] = S[d];
      float* qo = a.out + O_SQ + (size_t)b * 3 * DQKV;
#pragma unroll
        for (int i = 0; i < 3; ++i) { qo[i * DQKV + cq] = hq[i]; qo[i * DQKV + ck] = hk[i]; qo[i * DQKV + cv] = hv[i]; }
    }
    __syncthreads();
}

__host__ __device__ constexpr int perm_k(int x) { return (x & ~31) | (((x >> 2) & 3) << 3) | (((x >> 4) & 1) << 2) | (x & 3); }
typedef short bf16x8v __attribute__((ext_vector_type(8)));
constexpr int IH_QH = 0, IH_KH = 17408, IH_VH = 34816, IH_GV = 52224, IH_BYTES = 54272;
__device__ __forceinline__ void intra_pair(const Args& a, LAS unsigned char* lds_all, int pair) {
    asm volatile("" ::: "memory");
    const int tid = threadIdx.x, half = tid >> 8, lane = tid & 63, wq = (tid >> 6) & 3; int tu = tid & 255; asm volatile("" : "+v"(tu));
    const int uq = pair * 2 + half, h = uq & 7, bc = uq >> 3, b = bc / NCH, c = bc - b * NCH;
    const int nvalid = (c == NCH - 1) ? TP - 64 * (NCH - 1) : 64;
    LAS unsigned char* lds = lds_all + half * IH_BYTES;
    LAS bf16* QH = (LAS bf16*)(lds + IH_QH); LAS bf16* KH = (LAS bf16*)(lds + IH_KH); LAS bf16* VH = (LAS bf16*)(lds + IH_VH);
    LAS float* MF = (LAS float*)(lds + IH_KH); LAS bf16* ATL = (LAS bf16*)(lds + IH_VH); LAS float* GV = (LAS float*)(lds + IH_GV);
    unsigned char* ws = a.ws;
    bf16* blk = (bf16*)(ws + WS_QKVB) + (size_t)uq * QBLK; const bf16* HALOQ = (const bf16*)(ws + WS_HALOQ); const float* BETAG = (const float*)(ws + WS_BETAG);
    bf16* KDT = (bf16*)(ws + WS_KDT) + (size_t)uq * 8192; bf16* ATT = (bf16*)(ws + WS_ATTN) + (size_t)uq * 4096; float* LASTV = (float*)(ws + WS_LASTV);
    if (tu < 64) { const int i = tu; float g = 0.f, be = 0.f; { const float* p = BETAG + (size_t)(b * TP + 64 * c + (i < nvalid ? i : 0)) * 16; be = p[h]; g = p[8 + h]; } if (i >= nvalid) { g = 0.f; be = 0.f; }
        float G = g;
#pragma unroll
        for (int o = 1; o < 64; o <<= 1) { const float t = __shfl_up(G, o); if (lane >= o) G += t; }
        const float GL = __shfl(G, 63);
        GV[i] = G; GV[64 + i] = be; GV[128 + i] = expf(G); GV[192 + i] = expf(GL - G);
        if (i == 63) LASTV[uq] = expf(GL); }
    {   const int cp = tu & 15, rg = tu >> 4;
        v4u raw[3][7];
#pragma unroll
        for (int wh = 0; wh < 3; ++wh)
#pragma unroll
            for (int k = 0; k < 7; ++k) { const int rr = 4 * rg - 3 + k;
                const bf16* p = (rr >= 0) ? blk + wh * 8192 + rr * 128 + 8 * cp : HALOQ + ((size_t)(b * NCH + (c > 0 ? c - 1 : 0)) * 3 + (3 + rr)) * DQKV + wh * DM + h * DH + 8 * cp;
                raw[wh][k] = *(const GAS v4u*)p; }
#pragma unroll
        for (int wh = 0; wh < 3; ++wh) {
            const int col = wh * DM + h * DH + 8 * cp;
            f32x4 wl[4], wh4[4];
#pragma unroll
            for (int i = 0; i < 4; ++i) { wl[i] = *(const GAS f32x4*)(a.in[13] + i * DQKV + col); wh4[i] = *(const GAS f32x4*)(a.in[13] + i * DQKV + col + 4); }
            float xr[7][8];
#pragma unroll
            for (int k = 0; k < 7; ++k) { const int rr = 4 * rg - 3 + k; const bool ok = (rr >= 0) ? (rr < nvalid) : (c > 0); const v4u v = raw[wh][k];
                xr[k][0] = ok ? bflo(v.x) : 0.f; xr[k][1] = ok ? bfhi(v.x) : 0.f; xr[k][2] = ok ? bflo(v.y) : 0.f; xr[k][3] = ok ? bfhi(v.y) : 0.f;
                xr[k][4] = ok ? bflo(v.z) : 0.f; xr[k][5] = ok ? bfhi(v.z) : 0.f; xr[k][6] = ok ? bflo(v.w) : 0.f; xr[k][7] = ok ? bfhi(v.w) : 0.f; }
            if (c == NCH - 1 && rg == (nvalid - 1) / 4) {
                float* qo = a.out + O_PQ + (size_t)b * 3 * DQKV + col;
#pragma unroll
                for (int i = 0; i < 3; ++i) { *(GAS f32x4*)(qo + i * DQKV) = (f32x4){xr[4 + i][0], xr[4 + i][1], xr[4 + i][2], xr[4 + i][3]}; *(GAS f32x4*)(qo + i * DQKV + 4) = (f32x4){xr[4 + i][4], xr[4 + i][5], xr[4 + i][6], xr[4 + i][7]}; } }
            LAS bf16* tile = wh == 0 ? QH : (wh == 1 ? KH : VH);
#pragma unroll
            for (int r = 0; r < 4; ++r) { const bool ok = (4 * rg + r) < nvalid; float y[8];
#pragma unroll
                for (int e = 0; e < 8; ++e) { const float w0 = e < 4 ? wl[0][e & 3] : wh4[0][e & 3], w1 = e < 4 ? wl[1][e & 3] : wh4[1][e & 3], w2 = e < 4 ? wl[2][e & 3] : wh4[2][e & 3], w3 = e < 4 ? wl[3][e & 3] : wh4[3][e & 3];
                    const float t = w0 * xr[r][e] + w1 * xr[r + 1][e] + w2 * xr[r + 2][e] + w3 * xr[r + 3][e]; y[e] = ok ? siluf_(t) : 0.f; }
                v4u o; o.x = cvtpk(y[0], y[1]); o.y = cvtpk(y[2], y[3]); o.z = cvtpk(y[4], y[5]); o.w = cvtpk(y[6], y[7]);
                *(LAS v4u*)(tile + (4 * rg + r) * 136 + 8 * cp) = o; }
        }
    }
    __syncthreads();
    const int which = tu >> 7, d = tu & 127;
    float x[64];
    { const LAS bf16* colp = (which == 0 ? VH : KH) + d;
#pragma unroll
      for (int i = 0; i < 64; ++i) x[i] = bf1(colp[i * 136]); }
    const int fr = lane & 15, fq = lane >> 4;
    f32x4 kk[4], qk[4];
    {   bf16x8v ak[4], aq[4];
#pragma unroll
        for (int sI = 0; sI < 4; ++sI) { ak[sI] = *(const LAS bf16x8v*)(KH + (16 * wq + fr) * 136 + 32 * sI + 8 * fq); aq[sI] = *(const LAS bf16x8v*)(QH + (16 * wq + fr) * 136 + 32 * sI + 8 * fq); }
        f32x4 kkd = {0.f, 0.f, 0.f, 0.f}, qqd = {0.f, 0.f, 0.f, 0.f};
#pragma unroll
        for (int sI = 0; sI < 4; ++sI) { kkd = __builtin_amdgcn_mfma_f32_16x16x32_bf16(ak[sI], ak[sI], kkd, 0, 0, 0); qqd = __builtin_amdgcn_mfma_f32_16x16x32_bf16(aq[sI], aq[sI], qqd, 0, 0, 0); }
#pragma unroll
        for (int nt = 0; nt < 4; ++nt) { kk[nt] = (f32x4){0.f, 0.f, 0.f, 0.f}; qk[nt] = (f32x4){0.f, 0.f, 0.f, 0.f};
            if (nt <= wq) {
#pragma unroll
                for (int sI = 0; sI < 4; ++sI) { const bf16x8v bk = *(const LAS bf16x8v*)(KH + (16 * nt + fr) * 136 + 32 * sI + 8 * fq);
                    kk[nt] = __builtin_amdgcn_mfma_f32_16x16x32_bf16(ak[sI], bk, kk[nt], 0, 0, 0); qk[nt] = __builtin_amdgcn_mfma_f32_16x16x32_bf16(aq[sI], bk, qk[nt], 0, 0, 0); } } }
#pragma unroll
        for (int r = 0; r < 4; ++r) if (fr == 4 * fq + r) { GV[320 + 16 * wq + fr] = rsqf(kkd[r] + 1e-6f); GV[256 + 16 * wq + fr] = rsqf(qqd[r] + 1e-6f) * 0.08838834764831845f; }
    }
    __syncthreads();
    {
#pragma unroll
        for (int nt = 0; nt < 4; ++nt) { const int j = 16 * nt + fr;
            if (nt <= wq) { const float Gj = GV[j], nkj = GV[320 + j];
#pragma unroll
                for (int r = 0; r < 4; ++r) { const int i = 16 * wq + 4 * fq + r; const float dec = (i >= j) ? __expf(GV[i] - Gj) : 0.f;
                    MF[i * 68 + j] = (i > j) ? GV[64 + i] * GV[320 + i] * nkj * kk[nt][r] * dec : 0.f;
                    ATL[i * 72 + j] = (bf16)f2bf(GV[256 + i] * nkj * qk[nt][r] * dec); }
            } else {
#pragma unroll
                for (int r = 0; r < 4; ++r) ATL[(16 * wq + 4 * fq + r) * 72 + j] = (bf16)0; }
        }
#pragma unroll
        for (int k = 0; k < 4; ++k) { const int pc = tu + 256 * k, i = pc >> 4, p16 = pc & 15, c0 = 32 * (p16 >> 2) + 4 * (p16 & 3);
            const v2u lo = *(const LAS v2u*)(QH + i * 136 + c0), hi = *(const LAS v2u*)(QH + i * 136 + c0 + 16); const float f = GV[256 + i] * GV[128 + i];
            v4u o; o.x = cvtpk(bflo(lo.x) * f, bfhi(lo.x) * f); o.y = cvtpk(bflo(lo.y) * f, bfhi(lo.y) * f); o.z = cvtpk(bflo(hi.x) * f, bfhi(hi.x) * f); o.w = cvtpk(bflo(hi.y) * f, bfhi(hi.y) * f);
            *(GAS v4u*)(blk + i * 128 + 8 * p16) = o; }
        if (which == 0) {
#pragma unroll
            for (int i = 0; i < 64; ++i) x[i] *= GV[64 + i];
        } else {
            bf16* kd = KDT + d * 64;
#pragma unroll
            for (int g8 = 0; g8 < 8; ++g8) { float o[8];
#pragma unroll
                for (int pp = 0; pp < 8; ++pp) { const int i = 32 * (g8 >> 2) + 16 * (pp >> 2) + 4 * (g8 & 3) + (pp & 3); o[pp] = x[i] * GV[320 + i] * GV[192 + i]; }
                v4u w; w.x = cvtpk(o[0], o[1]); w.y = cvtpk(o[2], o[3]); w.z = cvtpk(o[4], o[5]); w.w = cvtpk(o[6], o[7]);
                *(GAS v4u*)(kd + 8 * g8) = w; }
#pragma unroll
            for (int i = 0; i < 64; ++i) x[i] *= GV[320 + i] * GV[64 + i] * GV[128 + i];
        }
    }
    __syncthreads();
#pragma unroll
    for (int i = 1; i < 64; ++i) {
        f32x2 a01 = {x[i], 0.f}, a23 = {0.f, 0.f};
#pragma unroll
        for (int j4 = 0; j4 < i; j4 += 4) { const f32x4 mm = *(const LAS f32x4*)(MF + i * 68 + j4);
            a01 -= (f32x2){mm.x, mm.y} * (f32x2){x[j4], x[j4 + 1]}; a23 -= (f32x2){mm.z, mm.w} * (f32x2){x[j4 + 2], x[j4 + 3]}; }
        x[i] = (a01.x + a01.y) + (a23.x + a23.y);
    }
    if (which == 0) {
        bf16* u0 = blk + 2 * 8192 + (size_t)(d >> 4) * 1024 + (d & 15) * 4;
#pragma unroll
        for (int m = 0; m < 4; ++m)
#pragma unroll
            for (int q = 0; q < 4; ++q) { const int i = 16 * m + 4 * q; v2u w; w.x = cvtpk(x[i], x[i + 1]); w.y = cvtpk(x[i + 2], x[i + 3]); *(GAS v2u*)(u0 + m * 256 + q * 64) = w; }
    } else {
#pragma unroll
        for (int i = 0; i < 64; ++i) QH[i * 136 + d] = (bf16)f2bf(x[i]);
    }
    __syncthreads();
#pragma unroll
    for (int k = 0; k < 4; ++k) { const int pc = tu + 256 * k, i = pc >> 4, p16 = pc & 15, c0 = 32 * (p16 >> 2) + 4 * (p16 & 3);
        const v2u lo = *(const LAS v2u*)(QH + i * 136 + c0), hi = *(const LAS v2u*)(QH + i * 136 + c0 + 16);
        *(GAS v4u*)(blk + 8192 + i * 128 + 8 * p16) = (v4u){lo.x, lo.y, hi.x, hi.y}; }
#pragma unroll
    for (int k = 0; k < 2; ++k) { const int pc = tu + 256 * k, i = pc >> 3, p8 = pc & 7, c0 = 32 * (p8 >> 2) + 4 * (p8 & 3);
        const v2u lo = *(const LAS v2u*)(ATL + i * 72 + c0), hi = *(const LAS v2u*)(ATL + i * 72 + c0 + 16);
        *(GAS v4u*)(ATT + i * 64 + 8 * p8) = (v4u){lo.x, lo.y, hi.x, hi.y}; }
    __syncthreads();
}

constexpr int SC_W = 0, SC_QD = 17408, SC_KDT = 34816, SC_AT = 53248, SC_BUF = 62464, SC_RMS = 2 * SC_BUF;
__device__ __forceinline__ void scan_chain(const Args& a, LAS unsigned char* lds, int chain) {
    const int tid = threadIdx.x, lane = tid & 63, wave = __builtin_amdgcn_readfirstlane(tid >> 6), fr = lane & 15, fq = lane >> 4;
    const int b = chain >> 3, h = chain & 7;
    unsigned char* ws = a.ws;
    const bf16* QKVB = (const bf16*)(ws + WS_QKVB); const bf16* KDTg = (const bf16*)(ws + WS_KDT); const bf16* ATTg = (const bf16*)(ws + WS_ATTN); const float* LASTV = (const float*)(ws + WS_LASTV);
    bf16* ZS = (bf16*)(ws + WS_ZS);
    LAS float* RMS = (LAS float*)(lds + SC_RMS);
    const float gh = a.in[16][16 * wave + fr];
    f32x4 Sacc[8];
#pragma unroll
    for (int mt = 0; mt < 8; ++mt) Sacc[mt] = (f32x4){0.f, 0.f, 0.f, 0.f};
    v4u st[7];
    auto stage_load = [&](int c) {
        const size_t uq = (size_t)(b * NCH + c) * NH + h; const bf16* blk = QKVB + uq * QBLK;
#pragma unroll
        for (int k = 0; k < 2; ++k) { const int e = (tid + 512 * k) * 8; st[k] = *(const GAS v4u*)(blk + 8192 + e); st[2 + k] = *(const GAS v4u*)(blk + e); st[4 + k] = *(const GAS v4u*)(KDTg + uq * 8192 + e); }
        st[6] = *(const GAS v4u*)(ATTg + uq * 4096 + tid * 8);
    };
    auto stage_store = [&](int buf) {
        LAS unsigned char* base = lds + buf * SC_BUF;
#pragma unroll
        for (int k = 0; k < 2; ++k) { const int e = (tid + 512 * k) * 8; const int r = e >> 7, cc = e & 127;
            *(LAS v4u*)(base + SC_W + r * 272 + cc * 2) = st[k]; *(LAS v4u*)(base + SC_QD + r * 272 + cc * 2) = st[2 + k];
            const int r2 = e >> 6, c2 = e & 63; *(LAS v4u*)(base + SC_KDT + r2 * 144 + c2 * 2) = st[4 + k]; }
        { const int e = tid * 8, r2 = e >> 6, c2 = e & 63; *(LAS v4u*)(base + SC_AT + r2 * 144 + c2 * 2) = st[6]; }
    };
    v2u u0n[4]; float lastn;
    auto side_load = [&](int c) {
        const size_t uq = (size_t)(b * NCH + c) * NH + h;
        const bf16* u0 = QKVB + uq * QBLK + 2 * 8192 + wave * 1024 + lane * 4;
#pragma unroll
        for (int m = 0; m < 4; ++m) u0n[m] = *(const GAS v2u*)(u0 + m * 256);
        lastn = LASTV[uq];
    };
    stage_load(0); side_load(0); stage_store(0);
    __syncthreads();
    for (int c = 0; c < NCH; ++c) {
        const int buf = c & 1; LAS unsigned char* base = lds + buf * SC_BUF;
        const int nvalid = (c == NCH - 1) ? TP - 64 * (NCH - 1) : 64;
        v2u u0p[4]; bf16 zs[16];
#pragma unroll
        for (int m = 0; m < 4; ++m) u0p[m] = u0n[m];
        const float last = lastn;
        const size_t zrow0 = (size_t)(b * TP + 64 * c) * DM + h * DH + 16 * wave + fr;
        if (c + 1 < NCH) { stage_load(c + 1); side_load(c + 1); }
#pragma unroll
        for (int m = 0; m < 4; ++m)
#pragma unroll
            for (int r = 0; r < 4; ++r) zs[4 * m + r] = ZS[zrow0 + (size_t)(16 * m + 4 * fq + r) * DM];
        bf16x8v Sb[4];
#pragma unroll
        for (int sI = 0; sI < 4; ++sI) { v4u w; w.x = cvtpk(Sacc[2 * sI][0], Sacc[2 * sI][1]); w.y = cvtpk(Sacc[2 * sI][2], Sacc[2 * sI][3]); w.z = cvtpk(Sacc[2 * sI + 1][0], Sacc[2 * sI + 1][1]); w.w = cvtpk(Sacc[2 * sI + 1][2], Sacc[2 * sI + 1][3]);
            Sb[sI] = __builtin_bit_cast(bf16x8v, w); }
        f32x4 u[4], o[4];
#pragma unroll
        for (int m = 0; m < 4; ++m) { f32x4 p = {0.f, 0.f, 0.f, 0.f}, oo = {0.f, 0.f, 0.f, 0.f};
#pragma unroll
            for (int sI = 0; sI < 4; ++sI) { const bf16x8v aw = *(const LAS bf16x8v*)(base + SC_W + (16 * m + fr) * 272 + (32 * sI + 8 * fq) * 2);
                const bf16x8v aqd = *(const LAS bf16x8v*)(base + SC_QD + (16 * m + fr) * 272 + (32 * sI + 8 * fq) * 2);
                p = __builtin_amdgcn_mfma_f32_16x16x32_bf16(aw, Sb[sI], p, 0, 0, 0); oo = __builtin_amdgcn_mfma_f32_16x16x32_bf16(aqd, Sb[sI], oo, 0, 0, 0); }
            u[m] = (f32x4){bflo(u0p[m].x), bfhi(u0p[m].x), bflo(u0p[m].y), bfhi(u0p[m].y)} - p; o[m] = oo; }
        bf16x8v Ub[2];
#pragma unroll
        for (int s2 = 0; s2 < 2; ++s2) { v4u w; w.x = cvtpk(u[2 * s2][0], u[2 * s2][1]); w.y = cvtpk(u[2 * s2][2], u[2 * s2][3]); w.z = cvtpk(u[2 * s2 + 1][0], u[2 * s2 + 1][1]); w.w = cvtpk(u[2 * s2 + 1][2], u[2 * s2 + 1][3]);
            Ub[s2] = __builtin_bit_cast(bf16x8v, w); }
#pragma unroll
        for (int m = 0; m < 4; ++m)
#pragma unroll
            for (int s2 = 0; s2 < 2; ++s2) { const bf16x8v aa = *(const LAS bf16x8v*)(base + SC_AT + (16 * m + fr) * 144 + (32 * s2 + 8 * fq) * 2);
                o[m] = __builtin_amdgcn_mfma_f32_16x16x32_bf16(aa, Ub[s2], o[m], 0, 0, 0); }
#pragma unroll
        for (int mt = 0; mt < 8; ++mt) { f32x4 sacc = Sacc[mt] * last;
#pragma unroll
            for (int s2 = 0; s2 < 2; ++s2) { const bf16x8v ak = *(const LAS bf16x8v*)(base + SC_KDT + (16 * mt + fr) * 144 + (32 * s2 + 8 * fq) * 2);
                sacc = __builtin_amdgcn_mfma_f32_16x16x32_bf16(ak, Ub[s2], sacc, 0, 0, 0); }
            Sacc[mt] = sacc; }
        LAS float* rm = RMS + (c & 1) * 512;
#pragma unroll
        for (int m = 0; m < 4; ++m)
#pragma unroll
            for (int r = 0; r < 4; ++r) { const float v = sum16(o[m][r] * o[m][r]); if (fr == 0) rm[(16 * m + 4 * fq + r) * 8 + wave] = v; }
        if (c + 1 < NCH) stage_store(buf ^ 1);
        __syncthreads();
#pragma unroll
        for (int m = 0; m < 4; ++m) { if (16 * m >= nvalid) continue;
#pragma unroll
            for (int r = 0; r < 4; ++r) { const int i = 16 * m + 4 * fq + r; const f32x4 p0 = *(const LAS f32x4*)(rm + i * 8), p1 = *(const LAS f32x4*)(rm + i * 8 + 4);
                const float ss = ((p0.x + p0.y) + (p0.z + p0.w)) + ((p1.x + p1.y) + (p1.z + p1.w));
                const float on = o[m][r] * rsqf(ss * (1.f / DH) + EPS) * gh * bf1(zs[4 * m + r]);
                ZS[zrow0 + (size_t)i * DM] = (bf16)f2bf(on); } }
    }
    { float* so = a.out + O_PD + ((size_t)(b * NH + h) * DH) * DH + 16 * wave + fr;
#pragma unroll
      for (int mt = 0; mt < 8; ++mt)
#pragma unroll
          for (int r = 0; r < 4; ++r) so[(size_t)(16 * mt + 4 * fq + r) * DH] = Sacc[mt][r]; }
    __syncthreads();
}

constexpr int NPHASES = 10;
__global__ void __launch_bounds__(NWAVES * 64, 2) fwd_kernel(Args args) {
    extern __shared__ __attribute__((aligned(16))) unsigned char lds_raw[];
    LAS unsigned char* lds = (LAS unsigned char*)lds_raw;
    volatile LAS unsigned* MISC = (volatile LAS unsigned*)(lds + MISC_OFF);
    const int tid = threadIdx.x, lane = tid & 63, wave = __builtin_amdgcn_readfirstlane(tid >> 6);
    const int G = gridDim.x, bx = blockIdx.x;
    const int vcu = (G % 8 == 0) ? (bx % 8) * (G / 8) + bx / 8 : bx;
    unsigned char* ws = args.ws;
    gu32* ctl = (gu32*)(ws + WS_CTL);
    for (int u = tid; u < (LDS_BYTES - LDSCTL_OFF) / 4; u += NWAVES * 64) ((LAS unsigned*)(lds + LDSCTL_OFF))[u] = 0u;
    __syncthreads();
    XcdBarrier bar; bar.bar = (unsigned*)(ctl + CW_BAR); bar.x = 0; bar.st = nullptr;
    const int lo = args.ph_lo, hi = args.ph_hi;
    if (hi - lo > 1) bar = xcd_barrier_post((unsigned*)(ctl + CW_BAR), MISC + 8);
#ifndef PH_MASK
#define PH_MASK 0x3ff
#endif
#define IN(k) (((PH_MASK >> (k)) & 1) && lo <= (k) && (k) < hi)
#ifndef PROBE_K
#define PROBE_K -1
#endif
#if PROBE_K >= 0
    volatile LAS unsigned long long* stamps = (volatile LAS unsigned long long*)(lds + MISC_OFF + 128);
    if (tid == 0) stamps[0] = __builtin_amdgcn_s_memrealtime();
#define SEAM(k) do { if (IN(k) && IN((k) + 1)) xcd_barrier(bar); if (tid == 0) stamps[(k) + 1] = __builtin_amdgcn_s_memrealtime(); } while (0)
#else
#define SEAM(k) do { if (IN(k) && IN((k) + 1)) xcd_barrier(bar); } while (0)
#endif
    bf16* WIN = (bf16*)(ws + WS_WIN); bf16* WC = (bf16*)(ws + WS_WC); bf16* WD = (bf16*)(ws + WS_WD); bf16* WO = (bf16*)(ws + WS_WO); bf16* WUP = (bf16*)(ws + WS_WUP); bf16* WDN = (bf16*)(ws + WS_WDN);
    bf16* H = (bf16*)(ws + WS_H); bf16* GLU = (bf16*)(ws + WS_GLU); bf16* QKVB = (bf16*)(ws + WS_QKVB); bf16* QS = (bf16*)(ws + WS_QS); bf16* ZS = (bf16*)(ws + WS_ZS);
    bf16* HALOQ = (bf16*)(ws + WS_HALOQ); bf16* HALOC = (bf16*)(ws + WS_HALOC);
    bf16* SGC = (bf16*)args.out; bf16* SGD = (bf16*)args.out + (size_t)M2 * DM;
    bf16* MIX = (bf16*)(ws + WS_MIX); bf16* XG = (bf16*)(ws + WS_XG); bf16* HM = (bf16*)(ws + WS_HM); bf16* C = (bf16*)(ws + WS_C);
    float* BETAG = (float*)(ws + WS_BETAG);
    const int gw = vcu * NWAVES + wave, NGW = G * NWAVES;

    if (IN(0)) {
        LAS float* scr = (LAS float*)(lds + RING_OFF + wave * 16384);
        constexpr int I_IN = 16 * (NIN / 32), I_SQ = 16 * 32, I_UP = 16 * (DFF / 32), I_DN = (DFF / 64) * 32;
        constexpr int NITEMS = I_IN + 3 * I_SQ + I_UP + I_DN;
        for (int it = gw; it < NITEMS; it += NGW) {
            int r = it;
            if (r < I_IN) { const int nb = r >> 4, kb = r & 15; int src, nv; win_src(nb, src, nv); p0_transpose_item(args.in[7], DIN, DM, WIN, nb * 32, src, nv, scr, kb, lane); continue; } r -= I_IN;
            if (r < I_SQ) { p0_transpose_item(args.in[12], DM, DM, WC, (r >> 4) * 32, (r >> 4) * 32, 32, scr, r & 15, lane); continue; } r -= I_SQ;
            if (r < I_SQ) { p0_transpose_item(args.in[17], DM, DM, WD, (r >> 4) * 32, (r >> 4) * 32, 32, scr, r & 15, lane); continue; } r -= I_SQ;
            if (r < I_SQ) { p0_transpose_item(args.in[18], DM, DM, WO, (r >> 4) * 32, (r >> 4) * 32, 32, scr, r & 15, lane); continue; } r -= I_SQ;
            if (r < I_UP) { p0_transpose_item(args.in[20], DFF, DM, WUP, (r >> 4) * 32, (r >> 4) * 32, 32, scr, r & 15, lane); continue; } r -= I_UP;
            p0_transpose_item(args.in[21], DM, DFF, WDN, (r >> 6) * 32, (r >> 6) * 32, 32, scr, r & 63, lane);
        }
        for (int m = gw; m < MP; m += NGW) {
            if (m >= MR) { GAS unsigned long long* o8 = (GAS unsigned long long*)(H + (size_t)m * DM) + lane;
#pragma unroll
                for (int jj = 0; jj < 4; ++jj) o8[64 * jj] = 0ull; continue; }
            const float* src;
            if (m >= RP) src = args.in[1] + (size_t)(m - RP) * DM;
            else { const int b = m / TP, t = m - b * TP; src = t < NMETA ? args.in[5] + (size_t)t * DM : args.in[0] + ((size_t)b * SEQ + (t - NMETA)) * DM; }
            rms_row_to_bf16(src, args.in[6], H + (size_t)m * DM, lane);
        }
    }
    SEAM(0);
    if (IN(1)) {
        pg8::Gemm g{H, WIN, MP, NIN, DM}; pg8::StaticOrder S; S.init(MP, NIN, G, bx);
        EpiIn E{GLU, QKVB, QS, HALOQ, HALOC, ZS, SGC, SGD, BETAG, args.in[14], args.in[15]};
        pg8::gemm_phase<EpiIn, pg8::StaticOrder, true, true>(lds + RING_OFF, g, S, E);
    }
    SEAM(1);
    if (IN(2)) {
        constexpr int N_CP = BP * NRUN, N_IP = BP * NCH * NH / 2, N_SD = BS * NH / 4, N_CS = BS, N_ITEMS = N_CP + N_IP + N_SD + N_CS;
        volatile LAS int* qslot = (volatile LAS int*)(lds + MISC_OFF + 64);
#if PROBE_K >= 0
        for (int sub = 0; sub < 3; ++sub) {
            const int lo_i = sub == 0 ? 0 : (sub == 1 ? N_CP : N_CP + N_IP), hi_i = sub == 0 ? N_CP : (sub == 1 ? N_CP + N_IP : N_CP + N_IP + N_SD);
            for (;;) {
                if (tid == 0) *qslot = (int)__hip_atomic_fetch_add((unsigned*)(ctl + 2048 + 64 * sub), 1u, __ATOMIC_RELAXED, __HIP_MEMORY_SCOPE_AGENT);
                __syncthreads();
                int it = *qslot + lo_i;
                __syncthreads();
                if (sub == 0 && it >= N_CP) { it += N_IP + N_SD; if (it >= N_ITEMS) break; conv_unit<1>(args, lds, it - (N_CP + N_IP + N_SD), 0); continue; }
                if (it >= hi_i) break;
                if (it < N_CP) { conv_unit<0>(args, lds, it / NRUN, it % NRUN); continue; } it -= N_CP;
                if (it < N_IP) { intra_pair(args, lds, it); continue; } it -= N_IP;
                delta_item(args, lds, it);
            }
            if (sub < 2) { xcd_barrier(bar); if (tid == 0) stamps[12 + sub] = __builtin_amdgcn_s_memrealtime(); }
        }
#else
        for (;;) {
            if (tid == 0) *qslot = (int)__hip_atomic_fetch_add((unsigned*)(ctl + 2048), 1u, __ATOMIC_RELAXED, __HIP_MEMORY_SCOPE_AGENT);
            __syncthreads();
            int it = *qslot;
            __syncthreads();
            if (it >= N_ITEMS) break;
            if (it < N_CP) { conv_unit<0>(args, lds, it / NRUN, it % NRUN); continue; } it -= N_CP;
            if (it < N_IP) { intra_pair(args, lds, it); continue; } it -= N_IP;
            if (it < N_SD) { delta_item(args, lds, it); continue; } it -= N_SD;
            conv_unit<1>(args, lds, it, 0);
        }
#endif
    }
    SEAM(2);
    if (IN(3)) {
        if (bx < BP * NH) scan_chain(args, lds, bx);
        else {
            pg8::Gemm g{C, WC, MP, DM, DM}; pg8::StaticOrder S; S.init(MP, DM, G - BP * NH, bx - BP * NH);
            EpiGate<0> E{SGC, nullptr, SGC};
            pg8::gemm_phase<EpiGate<0>, pg8::StaticOrder, true, true>(lds + RING_OFF, g, S, E);
        }
    }
    SEAM(3);
    if (IN(4)) {
        pg8::Gemm g{ZS, WD, MP, DM, DM}; pg8::StaticOrder S; S.init(MP, DM, G, bx);
        EpiGate<1> E{SGD, SGC, MIX};
        pg8::gemm_phase<EpiGate<1>, pg8::StaticOrder, true, true>(lds + RING_OFF, g, S, E);
    }
    SEAM(4);
    if (IN(5)) {
        pg8::Gemm g{MIX, WO, M2, DM, DM}; pg8::StaticOrder S; S.init(M2, DM, G, bx);
        EpiRes<0> E{args.in[0], args.in[1], args.out};
        pg8::gemm_phase<EpiRes<0>, pg8::StaticOrder, true, true>(lds + RING_OFF, g, S, E);
    }
    SEAM(5);
    if (IN(6)) {
        for (int m = gw; m < M2; m += NGW) rms_row_to_bf16(args.out + (size_t)m * DM, args.in[19], XG + (size_t)m * DM, lane);
    }
    SEAM(6);
    if (IN(7)) {
        pg8::Gemm g{XG, WUP, M2, DFF, DM}; pg8::StaticOrder S; S.init(M2, DFF, G, bx);
        EpiUp E{HM};
        pg8::gemm_phase<EpiUp, pg8::StaticOrder, true, true>(lds + RING_OFF, g, S, E);
    }
    SEAM(7);
    if (IN(8)) {
        pg8::Gemm g{HM, WDN, M2, DM, DFF}; pg8::StaticOrder S; S.init(M2, DM, G, bx);
        EpiRes<1> E{nullptr, nullptr, args.out};
        pg8::gemm_phase<EpiRes<1>, pg8::StaticOrder, true, true>(lds + RING_OFF, g, S, E);
    }
    SEAM(8);
    if (IN(9)) {
        for (int m = gw; m < M2; m += NGW) {
            float* xrow = args.out + (size_t)m * DM;
            GAS f32x4* xr = (GAS f32x4*)xrow + lane; const GAS f32x4* gr = (const GAS f32x4*)args.in[22] + lane;
            f32x4 v[4]; float s = 0.f;
#pragma unroll
            for (int jj = 0; jj < 4; ++jj) { v[jj] = xr[64 * jj]; s += (v[jj].x * v[jj].x + v[jj].y * v[jj].y) + (v[jj].z * v[jj].z + v[jj].w * v[jj].w); }
            const float rstd = 1.f / sqrtf(wave_sum(s) * (1.f / DM) + EPS);
#pragma unroll
            for (int jj = 0; jj < 4; ++jj) xr[64 * jj] = v[jj] * rstd * gr[64 * jj];
        }
    }
#if PROBE_K >= 0
    __syncthreads();
    if (bx == 0) { if (tid == 0) stamps[NPHASES] = __builtin_amdgcn_s_memrealtime(); __syncthreads();
        const float dt_us = (float)(stamps[PROBE_B] - stamps[PROBE_K]) * 0.01f; const float f = 1.f + dt_us * (1.f / (float)(PROBE_DIV));
        for (int i = tid; i < BP * 3 * DQKV; i += NWAVES * 64) args.out[O_PQ + i] *= f; }
#endif
#undef IN
#undef SEAM
}

extern "C" void kernel_launch(void* const* d_in, const int* in_sizes, int n_in, void* d_out, int out_size, void* d_ws, size_t ws_size, hipStream_t stream) {
    static int grid = 0;
    if (grid == 0) {
        if (n_in != 23 || (size_t)out_size != O_END || ws_size < WS_END) { fprintf(stderr, "kernel_launch: unexpected shapes n_in %d out %d ws %zu\n", n_in, out_size, ws_size); grid = -1; return; }
        int dev = 0, cus = 0, per_cu = 0;
        if (hipGetDevice(&dev) != hipSuccess || hipDeviceGetAttribute(&cus, hipDeviceAttributeMultiprocessorCount, dev) != hipSuccess) { grid = -1; return; }
        if (hipFuncSetAttribute((const void*)fwd_kernel, hipFuncAttributeMaxDynamicSharedMemorySize, LDS_BYTES) != hipSuccess) { fprintf(stderr, "kernel_launch: hipFuncSetAttribute failed\n"); grid = -1; return; }
        if (hipOccupancyMaxActiveBlocksPerMultiprocessor(&per_cu, (const void*)fwd_kernel, NWAVES * 64, LDS_BYTES) != hipSuccess || per_cu < 1)
            fprintf(stderr, "kernel_launch: occupancy query reports %d\n", per_cu);
        (void)hipGetLastError();
        grid = cus;
    }
    if (grid < 0) return;
    if (hipMemsetAsync((char*)d_ws + WS_CTL, 0, CTL_ZERO_BYTES, stream) != hipSuccess) return;
    Args a{};
    for (int i = 0; i < 23; ++i) a.in[i] = (const float*)d_in[i];
    a.out = (float*)d_out; a.ws = (unsigned char*)d_ws;
#if MK_N_LAUNCHES == 1
    a.ph_lo = 0; a.ph_hi = NPHASES;
    hipLaunchKernelGGL(fwd_kernel, dim3(grid), dim3(NWAVES * 64), LDS_BYTES, stream, a);
#else
    for (int p = 0; p < NPHASES; ++p) { a.ph_lo = p; a.ph_hi = p + 1; hipLaunchKernelGGL(fwd_kernel, dim3(grid), dim3(NWAVES * 64), LDS_BYTES, stream, a); }
#endif
}
```

```cpp
#include <hip/hip_runtime.h>
#include <cstdio>
#include <cstdint>

#ifndef MK_N_LAUNCHES
#define MK_N_LAUNCHES 1
#endif

namespace pg8 {
#define PG8_LAS __attribute__((address_space(3)))
typedef unsigned short bf16_t;
typedef short bf16x8 __attribute__((ext_vector_type(8)));
typedef float f32x4 __attribute__((ext_vector_type(4)));
typedef unsigned u32x4 __attribute__((ext_vector_type(4)));
constexpr int BM = 256, BK = 64, HALF = 128, HTB = HALF * BK * 2, STAGE_BYTES = 8 * HTB, NXCD = 8, WGM = 8;

__host__ __device__ __forceinline__ int lds_byte(int r, int c) { const int st = (r >> 4) * 2 + (c >> 5), rr = r & 15, cc = c & 31, ob = rr * 64 + cc * 2; return st * 1024 + (ob ^ (((ob >> 9) & 1) << 5)); }
__host__ __device__ __forceinline__ void stage_rc(int b, int& R, int& C) { const int st = b / 1024, sb = b % 1024, swz = sb ^ (((sb >> 9) & 1) << 5); R = (st >> 1) * 16 + swz / 64; C = (st & 1) * 32 + (swz % 64) / 2; }
__host__ __device__ __forceinline__ int perm32(int rho) { const int n = rho >> 4, i = rho & 15; return 8 * (i >> 2) + 4 * n + (i & 3); }

struct Unit { int pm, pn; };
struct Gemm { const bf16_t* A; const bf16_t* Bt; int M, N, K; };

struct StaticOrder {
    int nM, nN, nwg, G, c;
    __host__ __device__ void init(int M, int N, int G_, int c_) { nM = M / BM; nN = N / BM; nwg = nM * nN; G = G_; c = c_; }
    __host__ __device__ bool next(int i, Unit& u) const {
        const long L = (long)i * G + c; if (L >= nwg) return false;
        int wgid = (int)L; { const int q = nwg / NXCD, r = nwg % NXCD, xcd = wgid % NXCD, off = wgid / NXCD; wgid = (xcd < r ? xcd * (q + 1) : r * (q + 1) + (xcd - r) * q) + off; }
        const int nig = WGM * nN, gid = wgid / nig, fm = gid * WGM, gsz = (nM - fm) < WGM ? (nM - fm) : WGM;
        u.pm = fm + ((wgid % nig) % gsz); u.pn = (wgid % nig) / gsz; return true;
    }
    __device__ __forceinline__ void a_ready(const Unit&) const {}
    __device__ __forceinline__ void done(const Unit&) const {}
};

__device__ __forceinline__ unsigned cvt_pk_bf16(float lo, float hi) { unsigned r; asm volatile("v_cvt_pk_bf16_f32 %0, %1, %2" : "=v"(r) : "v"(lo), "v"(hi)); return r; }

template <class Epi, class Sched, bool ALIGN_EPI = false, bool SP2 = false>
__device__ __forceinline__ void gemm_phase(PG8_LAS unsigned char* lds, const Gemm g, const Sched& S, const Epi& E) {
    const int tid = threadIdx.x, wid = __builtin_amdgcn_readfirstlane(tid >> 6), lane = tid & 63, wr = wid >> 2, wc = wid & 3, fr = lane & 15, fq = lane >> 4;
    const int K = g.K, nt = K / BK;
    unsigned voffA[2], voffB[2];
#pragma unroll
    for (int i = 0; i < 2; ++i) { int R, C; stage_rc(tid * 16 + i * 8192, R, C); const int Rb = Epi::PERM ? ((R & ~31) + perm32(R & 31)) : R;
        voffA[i] = (unsigned)(R * K + C) * 2u; voffB[i] = (unsigned)(Rb * K + C) * 2u; }
    const size_t kstep = (size_t)(BK * 2);
    const size_t hstep = (size_t)HALF * K * 2;
    const size_t tstep = 2 * hstep;
    const unsigned ldsw = (unsigned)wid * 1024u;
    const int aoff = lds_byte(wr * 64 + fr, fq * 8), boff = lds_byte(wc * 32 + fr, fq * 8);
#define PG8_SA(b, h) (((b) * 2 + (h)) * HTB)
#define PG8_SB(b, h) ((4 + (b) * 2 + (h)) * HTB)
#define PG8_STAGE(bufoff, gbase, voff) do { _Pragma("unroll") for (int _i = 0; _i < 2; ++_i) \
        __builtin_amdgcn_global_load_lds((const unsigned*)((const char*)(gbase) + (voff)[_i]), (PG8_LAS unsigned*)(lds + (bufoff) + ldsw + _i * 8192), 16, 0, 0); } while (0)
#define PG8_LDA(dst, b, h) do { _Pragma("unroll") for (int m = 0; m < 4; ++m) _Pragma("unroll") for (int k = 0; k < 2; ++k) dst[m][k] = *(const PG8_LAS bf16x8*)(lds + PG8_SA(b, h) + aoff + m * 2048 + k * 1024); } while (0)
#define PG8_LDB(dst, b, h) do { _Pragma("unroll") for (int n = 0; n < 2; ++n) _Pragma("unroll") for (int k = 0; k < 2; ++k) dst[n][k] = *(const PG8_LAS bf16x8*)(lds + PG8_SB(b, h) + boff + n * 2048 + k * 1024); } while (0)
#define PG8_MMA(ai, bj, At, Bt) do { __builtin_amdgcn_s_setprio(1); _Pragma("unroll") for (int m = 0; m < 4; ++m) _Pragma("unroll") for (int n = 0; n < 2; ++n) _Pragma("unroll") for (int k = 0; k < 2; ++k) \
        acc[ai][bj][m][n] = __builtin_amdgcn_mfma_f32_16x16x32_bf16(Bt[n][k], At[m][k], acc[ai][bj][m][n], 0, 0, 0); __builtin_amdgcn_s_setprio(0); } while (0)
#define PG8_WAIT_V(n) asm volatile("s_waitcnt vmcnt(" #n ")" ::: "memory")
#define PG8_WAIT_L(n) asm volatile("s_waitcnt lgkmcnt(" #n ")" ::: "memory")
#define PG8_BAR __builtin_amdgcn_s_barrier()
#define PG8_SCHED __builtin_amdgcn_sched_barrier(0)
    Unit cur, nxt; int ui = 0;
    if (!S.next(0, cur)) return;
    f32x4 acc[2][2][4][2];
#pragma unroll
    for (int a = 0; a < 2; ++a)
#pragma unroll
        for (int b = 0; b < 2; ++b)
#pragma unroll
            for (int m = 0; m < 4; ++m)
#pragma unroll
                for (int n = 0; n < 2; ++n) acc[a][b][m][n] = (f32x4){0.f, 0.f, 0.f, 0.f};
    bf16x8 At[4][2], B0[2][2], B1[2][2];
    const char* cA = (const char*)g.A + (size_t)cur.pm * tstep; const char* cB = (const char*)g.Bt + (size_t)cur.pn * tstep;
    S.a_ready(cur);
    if constexpr (SP2) {
        PG8_STAGE(PG8_SB(0, 0), cB, voffB); PG8_STAGE(PG8_SB(0, 1), cB + hstep, voffB); PG8_STAGE(PG8_SA(0, 0), cA, voffA); PG8_STAGE(PG8_SA(0, 1), cA + hstep, voffA);
        if (wr == 1) PG8_BAR;
        PG8_WAIT_V(2); PG8_BAR;
        PG8_STAGE(PG8_SB(1, 0), cB + kstep, voffB); PG8_STAGE(PG8_SA(1, 0), cA + kstep, voffA); PG8_STAGE(PG8_SB(1, 1), cB + hstep + kstep, voffB);
        PG8_WAIT_V(6); PG8_BAR;
    } else {
        PG8_STAGE(PG8_SB(0, 0), cB, voffB); PG8_STAGE(PG8_SA(0, 0), cA, voffA); PG8_STAGE(PG8_SB(0, 1), cB + hstep, voffB); PG8_STAGE(PG8_SA(0, 1), cA + hstep, voffA);
        if (wr == 1) PG8_BAR;
        PG8_WAIT_V(4); PG8_BAR;
        PG8_STAGE(PG8_SB(1, 0), cB + kstep, voffB); PG8_STAGE(PG8_SA(1, 0), cA + kstep, voffA); PG8_STAGE(PG8_SB(1, 1), cB + hstep + kstep, voffB);
        PG8_WAIT_V(6); PG8_BAR;
    }
    for (;;) {
        const bool has_next = S.next(ui + 1, nxt);
        const char* nA = has_next ? (const char*)g.A + (size_t)nxt.pm * tstep : cA; const char* nB = has_next ? (const char*)g.Bt + (size_t)nxt.pn * tstep : cB;
        for (int t = 0; t < nt; t += 2) {
            const bool last = (t == nt - 2);
            const char* a1 = cA + (size_t)(t + 1) * kstep;
            const char* a2 = last ? nA : cA + (size_t)(t + 2) * kstep; const char* b2 = last ? nB : cB + (size_t)(t + 2) * kstep;
            const char* a3 = a2 + kstep; const char* b3 = b2 + kstep;
            if (last && has_next) S.a_ready(nxt);
            if constexpr (SP2) {
            PG8_LDB(B0, 0, 0); PG8_LDB(B1, 0, 1); PG8_SCHED; PG8_LDA(At, 0, 0); PG8_STAGE(PG8_SA(1, 1), a1 + hstep, voffA);
            PG8_WAIT_V(8); PG8_WAIT_L(0); PG8_BAR; PG8_MMA(0, 0, At, B0); PG8_MMA(0, 1, At, B1); PG8_BAR; PG8_SCHED;
            PG8_LDA(At, 0, 1); PG8_STAGE(PG8_SB(0, 0), b2, voffB); PG8_STAGE(PG8_SB(0, 1), b2 + hstep, voffB); PG8_STAGE(PG8_SA(0, 0), a2, voffA);
            PG8_WAIT_V(8); PG8_WAIT_L(0); PG8_BAR; PG8_MMA(1, 0, At, B0); PG8_MMA(1, 1, At, B1); PG8_BAR; PG8_SCHED;
            PG8_LDB(B0, 1, 0); PG8_LDB(B1, 1, 1); PG8_SCHED; PG8_LDA(At, 1, 0); PG8_STAGE(PG8_SA(0, 1), a2 + hstep, voffA);
            PG8_WAIT_V(8); PG8_WAIT_L(0); PG8_BAR; PG8_MMA(0, 0, At, B0); PG8_MMA(0, 1, At, B1); PG8_BAR; PG8_SCHED;
            PG8_LDA(At, 1, 1); PG8_STAGE(PG8_SB(1, 0), b3, voffB); PG8_STAGE(PG8_SB(1, 1), b3 + hstep, voffB); PG8_STAGE(PG8_SA(1, 0), a3, voffA);
            PG8_WAIT_V(8); PG8_WAIT_L(0); PG8_BAR; PG8_MMA(1, 0, At, B0); PG8_MMA(1, 1, At, B1); PG8_BAR; PG8_SCHED;
            } else {
            PG8_LDB(B0, 0, 0); PG8_SCHED; PG8_LDA(At, 0, 0); PG8_STAGE(PG8_SA(1, 1), a1 + hstep, voffA);
            PG8_WAIT_L(8); PG8_BAR; PG8_WAIT_L(0); PG8_MMA(0, 0, At, B0); PG8_BAR; PG8_SCHED;
            PG8_LDB(B1, 0, 1); PG8_STAGE(PG8_SB(0, 0), b2, voffB);
            PG8_BAR; PG8_WAIT_L(0); PG8_MMA(0, 1, At, B1); PG8_BAR;
            PG8_LDA(At, 0, 1); PG8_STAGE(PG8_SA(0, 0), a2, voffA);
            PG8_BAR; PG8_WAIT_L(0); PG8_MMA(1, 0, At, B0); PG8_BAR; PG8_SCHED;
            PG8_STAGE(PG8_SB(0, 1), b2 + hstep, voffB);
            PG8_WAIT_V(6); PG8_BAR; PG8_MMA(1, 1, At, B1); PG8_BAR;
            PG8_LDB(B0, 1, 0); PG8_SCHED; PG8_LDA(At, 1, 0); PG8_STAGE(PG8_SA(0, 1), a2 + hstep, voffA);
            PG8_WAIT_L(8); PG8_BAR; PG8_WAIT_L(0); PG8_MMA(0, 0, At, B0); PG8_BAR; PG8_SCHED;
            PG8_LDB(B1, 1, 1); PG8_STAGE(PG8_SB(1, 0), b3, voffB);
            PG8_BAR; PG8_WAIT_L(0); PG8_MMA(0, 1, At, B1); PG8_BAR;
            PG8_LDA(At, 1, 1); PG8_STAGE(PG8_SA(1, 0), a3, voffA);
            PG8_BAR; PG8_WAIT_L(0); PG8_MMA(1, 0, At, B0); PG8_BAR; PG8_SCHED;
            PG8_STAGE(PG8_SB(1, 1), b3 + hstep, voffB);
            PG8_WAIT_V(6); PG8_BAR; PG8_MMA(1, 1, At, B1); PG8_BAR;
            }
        }
        if constexpr (ALIGN_EPI) { if (wr == 0) PG8_BAR; }
        E(acc, cur, wr, wc, fr, fq); S.done(cur);
        if (!has_next) break;
#pragma unroll
        for (int a = 0; a < 2; ++a)
#pragma unroll
            for (int b = 0; b < 2; ++b)
#pragma unroll
                for (int m = 0; m < 4; ++m)
#pragma unroll
                    for (int n = 0; n < 2; ++n) acc[a][b][m][n] = (f32x4){0.f, 0.f, 0.f, 0.f};
        cur = nxt; cA = nA; cB = nB; ++ui;
        if constexpr (ALIGN_EPI) { if (wr == 1) PG8_BAR; }
    }
    PG8_WAIT_V(0);
    if constexpr (!ALIGN_EPI) { if (wr == 0) PG8_BAR; }
    PG8_BAR;
#undef PG8_SA
#undef PG8_SB
#undef PG8_STAGE
#undef PG8_LDA
#undef PG8_LDB
#undef PG8_MMA
#undef PG8_WAIT_V
#undef PG8_WAIT_L
#undef PG8_BAR
#undef PG8_SCHED
}
}

constexpr int NWAVES = 8;
constexpr int DM = 1024, BP = 8, SEQ = 2048, NMETA = 16, TP = SEQ + NMETA, BS = 128, TS = 4;
constexpr int RP = BP * TP;
constexpr int RS = BS * TS;
constexpr int MR = RP + RS;
constexpr int MP = 17152;
constexpr int M2 = BP * SEQ + RS;
constexpr int NH = 8, DH = 128, DQKV = 3072, DFF = 4096, KC = 31, KS = 4;
constexpr int NIN = 8448;
constexpr int DIN = 8208;
constexpr float EPS = 1e-6f;

constexpr size_t O_YP = 0, O_YS = 16777216, O_PC = 17301504, O_PQ = 17547264, O_PD = 17620992, O_SC = 18669568, O_SQ = 22601728, O_SD = 23781376, O_END = 40558592;

constexpr size_t MiB = 1u << 20;
constexpr size_t WS_CTL = 0, CTL_ZERO_BYTES = 1 * MiB;
constexpr size_t WS_BETAG = 1 * MiB;
constexpr size_t WS_LASTV = 9 * MiB / 4;
constexpr size_t WS_HALOQ = 5 * MiB / 2;
constexpr size_t WS_WC = 29 * MiB / 4, WS_WD = WS_WC + 2 * MiB, WS_WO = WS_WD + 2 * MiB, WS_WUP = WS_WO + 2 * MiB, WS_WDN = WS_WUP + 8 * MiB;
constexpr size_t WS_GLU = 117 * MiB / 4;
constexpr size_t WS_QKVB = 63 * MiB;
constexpr size_t WS_QS = 162 * MiB;
constexpr size_t WS_ZS = 165 * MiB;
constexpr size_t WS_H = 397 * MiB / 2;
constexpr size_t WS_WIN = 232 * MiB;
constexpr size_t WS_HALOC = 497 * MiB / 2;
constexpr size_t WS_KDT = WS_H, WS_ATTN = 463 * MiB / 2;
constexpr size_t WS_MIX = WS_QKVB, WS_XG = WS_GLU, WS_HM = WS_QKVB, WS_C = WS_GLU;
constexpr size_t WS_END = 256 * MiB;
constexpr int NRUN = 16, RUNL = TP / NRUN;
static_assert(TP - 64 * 32 == 16 && NRUN * RUNL == TP && WS_HALOC + (size_t)BP * NRUN * 30 * DM * 2 <= WS_END, "conv runs");
constexpr int NCH = 33, QBLK = 3 * 64 * 128;
static_assert(WS_WIN + (size_t)NIN * DM * 2 <= WS_HALOC && WS_WDN + 8 * MiB <= WS_GLU && WS_GLU + (size_t)MP * DM * 2 <= WS_QKVB && WS_HALOQ + (size_t)BP * 33 * 3 * 3072 * 2 <= WS_WC, "ws map");
static_assert(WS_ZS + (size_t)MP * DM * 2 <= WS_H && WS_H + (size_t)MP * DM * 2 <= WS_WIN, "ws map 2");
static_assert(WS_QKVB + (size_t)BP * NCH * NH * QBLK * 2 <= WS_QS, "ws map qkvb");
static_assert(WS_HM + (size_t)M2 * DFF * 2 <= WS_H, "ws map hm");
static_assert(WS_KDT + (size_t)BP * NCH * NH * 8192 * 2 <= WS_ATTN && WS_ATTN + (size_t)BP * NCH * NH * 4096 * 2 <= WS_HALOC, "ws map kdt");
constexpr int CW_TMO = 0, CW_CODE = 1, CW_BAR = 4096;

constexpr int RING_OFF = 0, RING_BYTES = 131072;
constexpr int LDSCTL_OFF = RING_BYTES, MISC_OFF = LDSCTL_OFF + 320;
constexpr int LDS_BYTES = 147456;

#define GAS __attribute__((address_space(1)))
#define LAS __attribute__((address_space(3)))
typedef unsigned short bf16;
typedef unsigned v4u __attribute__((ext_vector_type(4)));
typedef unsigned v2u __attribute__((ext_vector_type(2)));
typedef float f32x4 __attribute__((ext_vector_type(4)));
typedef float f32x2 __attribute__((ext_vector_type(2)));
typedef GAS unsigned gu32;
#define RLX_AGENT __ATOMIC_RELAXED, __HIP_MEMORY_SCOPE_AGENT
#define LDS_WAIT() asm volatile("s_waitcnt lgkmcnt(0)" ::: "memory")
#define VM_WAIT() asm volatile("s_waitcnt vmcnt(0)" ::: "memory")
__device__ __forceinline__ unsigned f2bf(float f) { unsigned u = __builtin_bit_cast(unsigned, f); return (u + 0x7fffu + ((u >> 16) & 1u)) >> 16; }
__device__ __forceinline__ unsigned pk2(float lo, float hi) { return f2bf(lo) | (f2bf(hi) << 16); }
__device__ __forceinline__ float bflo(unsigned w) { return __builtin_bit_cast(float, w << 16); }
__device__ __forceinline__ float bfhi(unsigned w) { return __builtin_bit_cast(float, w & 0xffff0000u); }
__device__ __forceinline__ float bf1(bf16 b) { return __builtin_bit_cast(float, ((unsigned)b) << 16); }
__device__ __forceinline__ float sigmoidf_(float x) { return __builtin_amdgcn_rcpf(1.f + __expf(-x)); }
__device__ __forceinline__ float siluf_(float x) { return x * sigmoidf_(x); }

#define XB_TMO      128
#define XB_XCNT(j)  (256  + 64 * (j))
#define XB_XSUB(j)  (1280 + 64 * (j))
#define XB_XGEN(j)  (2304 + 64 * (j))
#define XB_TOP      3328
#define XB_TOPGEN   3392
#define XCD_BAR_WORDS 3456
#define XB_SPIN_CAP (1u << 18)
__device__ __forceinline__ unsigned xb_ld(unsigned* p)              { return __hip_atomic_load(p, __ATOMIC_RELAXED, __HIP_MEMORY_SCOPE_AGENT); }
__device__ __forceinline__ unsigned xb_add(unsigned* p, unsigned v) { return __hip_atomic_fetch_add(p, v, __ATOMIC_RELAXED, __HIP_MEMORY_SCOPE_AGENT); }
__device__ __forceinline__ unsigned xb_xcc_id() { return (unsigned)__builtin_amdgcn_s_getreg((3 << 11) | 20) & 0xFu; }
#define XB_SPIN(cond, bar) do { unsigned _sp = 0; while (cond) { __builtin_amdgcn_s_sleep(1); \
    if ((++_sp & 255u) == 0u) { if (xb_ld(&(bar)[XB_TMO])) break; if (_sp > XB_SPIN_CAP) { atomicAdd(&(bar)[XB_TMO], 1u); break; } } } } while (0)
struct XcdBarrier { unsigned* bar; unsigned x; volatile LAS unsigned* st; };
__device__ __forceinline__ XcdBarrier xcd_barrier_post(unsigned* bar, volatile LAS unsigned* st) {
    XcdBarrier b; b.bar = bar; b.x = xb_xcc_id(); b.st = st;
    if (threadIdx.x == 0) (void)xb_add(&bar[XB_XCNT(b.x)], 1u);
    return b;
}
__device__ __forceinline__ void xcd_barrier_complete(unsigned* bar, unsigned x, unsigned& nloc, unsigned& nx) {
    const unsigned G = gridDim.x * gridDim.y * gridDim.z;
    unsigned sum, cnt, mine, sp = 0u;
    for (;;) {
        sum = 0u; cnt = 0u; mine = 0u;
#pragma unroll
        for (unsigned j = 0; j < 16; ++j) { const unsigned c = xb_ld(&bar[XB_XCNT(j)]); sum += c; cnt += (c > 0u) ? 1u : 0u; mine = (j == x) ? c : mine; }
        if (sum == G) break;
        __builtin_amdgcn_s_sleep(1);
        if ((++sp & 255u) == 0u) { if (xb_ld(&bar[XB_TMO])) break; if (sp > XB_SPIN_CAP) { atomicAdd(&bar[XB_TMO], 1u); break; } }
    }
    nloc = mine > 0u ? mine : 1u; nx = cnt > 0u ? cnt : 1u;
}
__device__ __forceinline__ void xcd_barrier(const XcdBarrier& b) {
    asm volatile("s_waitcnt vmcnt(0)" ::: "memory");
    __syncthreads();
    if (threadIdx.x == 0) {
        unsigned* bar = b.bar;
        __builtin_amdgcn_s_waitcnt(0);
        unsigned nloc = b.st[0], nx = b.st[1];
        if (nloc == 0u) { xcd_barrier_complete(bar, b.x, nloc, nx); b.st[0] = nloc; b.st[1] = nx; }
        const unsigned old = xb_add(&bar[XB_XSUB(b.x)], 1u);
        const unsigned gen = old / nloc;
        if (old + 1u == (gen + 1u) * nloc) {
            __builtin_amdgcn_fence(__ATOMIC_RELEASE, "agent");
            asm volatile("s_waitcnt vmcnt(0)" ::: "memory");
            const unsigned og = xb_add(&bar[XB_TOP], 1u);
            const unsigned tg = og / nx;
            if (og + 1u == (tg + 1u) * nx) xb_add(&bar[XB_TOPGEN], 1u);
            else XB_SPIN(xb_ld(&bar[XB_TOPGEN]) == tg, bar);
            __builtin_amdgcn_fence(__ATOMIC_ACQUIRE, "agent");
            xb_add(&bar[XB_XGEN(b.x)], 1u);
            asm volatile("s_waitcnt vmcnt(0)" ::: "memory");
        } else {
            XB_SPIN(xb_ld(&bar[XB_XGEN(b.x)]) == gen, bar);
            __builtin_amdgcn_fence(__ATOMIC_ACQUIRE, "agent");
            asm volatile("s_waitcnt vmcnt(0)" ::: "memory");
        }
    }
    __syncthreads();
}

struct Args { const float* in[23]; float* out; unsigned char* ws; int ph_lo, ph_hi; };

#define DPP_ADD(v, ctrl, rmask, bc) v += __builtin_bit_cast(float, __builtin_amdgcn_update_dpp(0, __builtin_bit_cast(int, v), ctrl, rmask, 0xF, bc))
__device__ __forceinline__ float sum16(float v) {
    DPP_ADD(v, 0xB1, 0xF, true); DPP_ADD(v, 0x4E, 0xF, true); DPP_ADD(v, 0x141, 0xF, true); DPP_ADD(v, 0x140, 0xF, true); return v; }
__device__ __forceinline__ float wave_sum(float v) {
    v = sum16(v); DPP_ADD(v, 0x142, 0xA, false); DPP_ADD(v, 0x143, 0xC, false);
    return __builtin_bit_cast(float, __builtin_amdgcn_readlane(__builtin_bit_cast(int, v), 63)); }
__device__ __forceinline__ float rsqf(float x) { return __builtin_amdgcn_rsqf(x); }
__device__ __forceinline__ unsigned cvtpk(float lo, float hi) { unsigned r; asm("v_cvt_pk_bf16_f32 %0, %1, %2" : "=v"(r) : "v"(lo), "v"(hi)); return r; }
__device__ __forceinline__ int compact_row(int r) {
    if (r >= MR) return -1;
    if (r >= RP) return r - RP + BP * SEQ;
    const int b = r / TP, t = r - b * TP;
    return t < NMETA ? -1 : r - NMETA * (b + 1);
}

__device__ __forceinline__ void p0_transpose_item(const float* W, int Nsrc, int K, bf16* WT, int dst_row0, int src_col0, int nvalid, LAS float* scr, int kb, int lane) {
    const int k0 = 64 * kb, cidx = lane & 31;
#pragma unroll 8
    for (int i = 0; i < 32; ++i) { const int kk = 2 * i + (lane >> 5); float v = 0.f; if (cidx < nvalid) v = W[(size_t)(k0 + kk) * Nsrc + src_col0 + cidx]; scr[kk * 33 + cidx] = v; }
    LDS_WAIT(); asm volatile("" ::: "memory");
    const int c = lane & 7;
#pragma unroll
    for (int j = 0; j < 4; ++j) { const int n = (lane >> 3) + 8 * j; const LAS float* s = scr + (8 * c) * 33 + n;
        v4u o; o.x = pk2(s[0 * 33], s[1 * 33]); o.y = pk2(s[2 * 33], s[3 * 33]); o.z = pk2(s[4 * 33], s[5 * 33]); o.w = pk2(s[6 * 33], s[7 * 33]);
        *(GAS v4u*)(WT + (size_t)(dst_row0 + n) * K + k0 + 8 * c) = o; }
    LDS_WAIT(); asm volatile("" ::: "memory");
}
__device__ __forceinline__ void win_src(int nb, int& src, int& nvalid) {
    const int pn = nb >> 3, o = (nb & 7) * 32; nvalid = 32;
    if (pn < 8) src = (o < 128) ? 128 * pn + o : 1024 + 128 * pn + (o - 128);
    else if (pn < 20) src = 2048 + 256 * (pn - 8) + o;
    else if (pn < 24) src = 5120 + 256 * (pn - 20) + o;
    else if (pn < 28) src = 6160 + 256 * (pn - 24) + o;
    else if (pn < 32) src = 7184 + 256 * (pn - 28) + o;
    else { src = 6144; nvalid = (o == 0) ? 16 : 0; }
}
__device__ __forceinline__ void rms_row_to_bf16(const float* xrow, const float* gain, bf16* orow, int lane) {
    const GAS f32x4* xr = (const GAS f32x4*)xrow + lane; const GAS f32x4* gr = (const GAS f32x4*)gain + lane;
    f32x4 v[4]; float s = 0.f;
#pragma unroll
    for (int j = 0; j < 4; ++j) { v[j] = xr[64 * j]; s += (v[j].x * v[j].x + v[j].y * v[j].y) + (v[j].z * v[j].z + v[j].w * v[j].w); }
    const float rstd = 1.f / sqrtf(wave_sum(s) * (1.f / DM) + EPS);
    GAS unsigned long long* o8 = (GAS unsigned long long*)orow + lane;
#pragma unroll
    for (int j = 0; j < 4; ++j) { const f32x4 g = gr[64 * j]; o8[64 * j] = (unsigned long long)pk2(v[j].x * rstd * g.x, v[j].y * rstd * g.y) | ((unsigned long long)pk2(v[j].z * rstd * g.z, v[j].w * rstd * g.w) << 32); }
}

typedef pg8::f32x4 A4;
struct EpiIn {
    static constexpr bool PERM = true;
    bf16 *GLU, *QKVB, *QS, *HALOQ, *HALOC, *ZS, *SGC, *SGD; float* BETAG; const float *a_log, *dt_bias;
    __device__ __forceinline__ void operator()(const A4 (&acc)[2][2][4][2], const pg8::Unit& u, int wr, int wc, int fr, int fq) const {
        const int pn = u.pn, row0 = u.pm * 256 + wr * 64 + fr, cw = 32 * wc + 8 * fq;
        if (pn < 8) {
#pragma unroll
            for (int ai = 0; ai < 2; ++ai)
#pragma unroll
                for (int m = 0; m < 4; ++m) { const int r = row0 + ai * 128 + m * 16; float o[8];
#pragma unroll
                    for (int n = 0; n < 2; ++n)
#pragma unroll
                        for (int j = 0; j < 4; ++j) o[4 * n + j] = acc[ai][0][m][n][j] * sigmoidf_(acc[ai][1][m][n][j]);
                    v4u w; w.x = pk2(o[0], o[1]); w.y = pk2(o[2], o[3]); w.z = pk2(o[4], o[5]); w.w = pk2(o[6], o[7]);
                    *(GAS v4u*)(GLU + (size_t)r * DM + 128 * pn + cw) = w;
                    if (r < RP) { const int b = r / TP, t = r - b * TP, run = t / RUNL, pos = t - run * RUNL;
                        if (pos >= RUNL - 30 && run < NRUN - 1) *(GAS v4u*)(HALOC + ((size_t)(b * NRUN + run) * 30 + (pos - (RUNL - 30))) * DM + 128 * pn + cw) = w; } }
        } else if (pn < 20) {
            const int colb = 256 * (pn - 8);
#pragma unroll
            for (int ai = 0; ai < 2; ++ai)
#pragma unroll
                for (int m = 0; m < 4; ++m) { const int r = row0 + ai * 128 + m * 16; if (r >= MR) continue;
#pragma unroll
                    for (int bj = 0; bj < 2; ++bj) { const int col = colb + 128 * bj + cw;
                        const A4 a0 = acc[ai][bj][m][0], a1 = acc[ai][bj][m][1];
                        v4u w; w.x = pk2(a0[0], a0[1]); w.y = pk2(a0[2], a0[3]); w.z = pk2(a1[0], a1[1]); w.w = pk2(a1[2], a1[3]);
                        if (r >= RP) *(GAS v4u*)(QS + (size_t)(r - RP) * DQKV + col) = w;
                        else { const int b = r / TP, t = r - b * TP, c = t >> 6, i = t & 63, which = col >> 10, h = (col >> 7) & 7, d = col & 127;
                            *(GAS v4u*)(QKVB + ((size_t)((b * NCH + c) * NH + h) * 3 + which) * 8192 + i * 128 + d) = w;
                            if (i >= 61) *(GAS v4u*)(HALOQ + ((size_t)(b * NCH + c) * 3 + (i - 61)) * DQKV + col) = w; } } }
        } else if (pn < 24) {
            constexpr bool isz = true; bf16* dst = ZS; const int ld = DM, cb = 256 * (pn - 20);
#pragma unroll
            for (int ai = 0; ai < 2; ++ai)
#pragma unroll
                for (int m = 0; m < 4; ++m) { const int r = row0 + ai * 128 + m * 16;
#pragma unroll
                    for (int bj = 0; bj < 2; ++bj) { float o[8];
#pragma unroll
                        for (int n = 0; n < 2; ++n)
#pragma unroll
                            for (int j = 0; j < 4; ++j) { const float v = acc[ai][bj][m][n][j]; o[4 * n + j] = isz ? siluf_(v) : v; }
                        v4u w; w.x = pk2(o[0], o[1]); w.y = pk2(o[2], o[3]); w.z = pk2(o[4], o[5]); w.w = pk2(o[6], o[7]);
                        *(GAS v4u*)(dst + (size_t)r * ld + cb + 128 * bj + cw) = w; } }
        } else if (pn < 32) {
            bf16* dst = pn < 28 ? SGC : SGD; const int cb = 256 * ((pn - 24) & 3);
#pragma unroll
            for (int ai = 0; ai < 2; ++ai)
#pragma unroll
                for (int m = 0; m < 4; ++m) { const int rc = compact_row(row0 + ai * 128 + m * 16); if (rc < 0) continue;
#pragma unroll
                    for (int bj = 0; bj < 2; ++bj) { float o[8];
#pragma unroll
                        for (int n = 0; n < 2; ++n)
#pragma unroll
                            for (int j = 0; j < 4; ++j) o[4 * n + j] = sigmoidf_(acc[ai][bj][m][n][j]);
                        v4u w; w.x = pk2(o[0], o[1]); w.y = pk2(o[2], o[3]); w.z = pk2(o[4], o[5]); w.w = pk2(o[6], o[7]);
                        *(GAS v4u*)(dst + (size_t)rc * DM + cb + 128 * bj + cw) = w; } }
        } else {
            if (wc == 0 && fq < 2) {
#pragma unroll
                for (int ai = 0; ai < 2; ++ai)
#pragma unroll
                    for (int m = 0; m < 4; ++m) { const int r = row0 + ai * 128 + m * 16; float o[8];
#pragma unroll
                        for (int n = 0; n < 2; ++n)
#pragma unroll
                            for (int j = 0; j < 4; ++j) { const int h = 4 * n + j; const float v = acc[ai][0][m][n][j];
                                if (fq == 0) o[h] = 1.f / (1.f + expf(-v));
                                else { const float xx = v + dt_bias[h]; const float sp = xx > 20.f ? xx : log1pf(expf(xx)); o[h] = -expf(a_log[h]) * sp; } }
                        GAS f32x4* p = (GAS f32x4*)(BETAG + (size_t)r * 16 + 8 * fq);
                        p[0] = (f32x4){o[0], o[1], o[2], o[3]}; p[1] = (f32x4){o[4], o[5], o[6], o[7]}; }
            }
        }
    }
};
template <int MODE> struct EpiGate {
    static constexpr bool PERM = true;
    bf16 *SG, *MA, *OUT;
    __device__ __forceinline__ void operator()(const A4 (&acc)[2][2][4][2], const pg8::Unit& u, int wr, int wc, int fr, int fq) const {
        const int row0 = u.pm * 256 + wr * 64 + fr, c0 = 256 * u.pn + 32 * wc + 8 * fq;
#pragma unroll
        for (int ai = 0; ai < 2; ++ai)
#pragma unroll
            for (int m = 0; m < 4; ++m) { const int rc = compact_row(row0 + ai * 128 + m * 16); if (rc < 0) continue;
#pragma unroll
                for (int bj = 0; bj < 2; ++bj) { const size_t off = (size_t)rc * DM + c0 + 128 * bj;
                    const v4u g = *(const GAS v4u*)(SG + off); float o[8];
                    const A4 a0 = acc[ai][bj][m][0], a1 = acc[ai][bj][m][1];
                    o[0] = bflo(g.x) * a0[0]; o[1] = bfhi(g.x) * a0[1]; o[2] = bflo(g.y) * a0[2]; o[3] = bfhi(g.y) * a0[3];
                    o[4] = bflo(g.z) * a1[0]; o[5] = bfhi(g.z) * a1[1]; o[6] = bflo(g.w) * a1[2]; o[7] = bfhi(g.w) * a1[3];
                    if (MODE == 1) { const v4u q = *(const GAS v4u*)(MA + off);
                        o[0] += bflo(q.x); o[1] += bfhi(q.x); o[2] += bflo(q.y); o[3] += bfhi(q.y); o[4] += bflo(q.z); o[5] += bfhi(q.z); o[6] += bflo(q.w); o[7] += bfhi(q.w); }
                    v4u w; w.x = pk2(o[0], o[1]); w.y = pk2(o[2], o[3]); w.z = pk2(o[4], o[5]); w.w = pk2(o[6], o[7]);
                    *(GAS v4u*)(OUT + off) = w; } }
    }
};
template <int MODE> struct EpiRes {
    static constexpr bool PERM = false;
    const float *xp, *xs; float* out;
    __device__ __forceinline__ void operator()(const A4 (&acc)[2][2][4][2], const pg8::Unit& u, int wr, int wc, int fr, int fq) const {
        const int row0 = u.pm * 256 + wr * 64 + fr, c0 = 256 * u.pn + 32 * wc + 4 * fq;
#pragma unroll
        for (int ai = 0; ai < 2; ++ai)
#pragma unroll
            for (int m = 0; m < 4; ++m) { const int r = row0 + ai * 128 + m * 16;
                const float* base = MODE == 0 ? (r < BP * SEQ ? xp + (size_t)r * DM : xs + (size_t)(r - BP * SEQ) * DM) : out + (size_t)r * DM;
                float* orow = out + (size_t)r * DM;
#pragma unroll
                for (int bj = 0; bj < 2; ++bj)
#pragma unroll
                    for (int n = 0; n < 2; ++n) { const int c = c0 + 128 * bj + 16 * n; const f32x4 b = *(const GAS f32x4*)(base + c); *(GAS f32x4*)(orow + c) = b + acc[ai][bj][m][n]; } }
    }
};
struct EpiUp {
    static constexpr bool PERM = true;
    bf16* HM;
    __device__ __forceinline__ void operator()(const A4 (&acc)[2][2][4][2], const pg8::Unit& u, int wr, int wc, int fr, int fq) const {
        const int row0 = u.pm * 256 + wr * 64 + fr, c0 = 256 * u.pn + 32 * wc + 8 * fq;
#pragma unroll
        for (int ai = 0; ai < 2; ++ai)
#pragma unroll
            for (int m = 0; m < 4; ++m) { const int r = row0 + ai * 128 + m * 16;
#pragma unroll
                for (int bj = 0; bj < 2; ++bj) { float o[8];
#pragma unroll
                    for (int n = 0; n < 2; ++n)
#pragma unroll
                        for (int j = 0; j < 4; ++j) { const float v = fmaxf(acc[ai][bj][m][n][j], 0.f); o[4 * n + j] = v * v; }
                    v4u w; w.x = pk2(o[0], o[1]); w.y = pk2(o[2], o[3]); w.z = pk2(o[4], o[5]); w.w = pk2(o[6], o[7]);
                    *(GAS v4u*)(HM + (size_t)r * DFF + c0 + 128 * bj) = w; } }
    }
};

template <int KIND>
__device__ __forceinline__ void conv_unit(const Args& a, LAS unsigned char* lds, int b, int run) {
    asm volatile("" ::: "memory");
    const int tid = threadIdx.x, lane = tid & 63, wave = tid >> 6; int ch = 2 * tid; asm volatile("" : "+v"(ch));
    unsigned char* ws = a.ws;
    bf16* GC = (bf16*)(ws + WS_GLU); const bf16* HALOC = (const bf16*)(ws + WS_HALOC);
    const float* w_dw = a.in[8];
    LAS float* red = (LAS float*)lds;
    constexpr int NTOK = KIND == 0 ? RUNL : TS, NSTEP = (NTOK + 3) / 4, REM = NTOK - 4 * (NSTEP - 1);
    f32x2 w[KC]; unsigned E[KC + 3];
#pragma unroll
    for (int i = 0; i < KC; ++i) w[i] = *(const GAS f32x2*)(w_dw + (size_t)i * DM + ch);
    const f32x2 bdw = *(const GAS f32x2*)(a.in[9] + ch), lng = *(const GAS f32x2*)(a.in[10] + ch), lnb = *(const GAS f32x2*)(a.in[11] + ch);
    const int row0 = KIND == 0 ? b * TP + run * RUNL : RP + b * TS;
    if (KIND == 0) {
#pragma unroll
        for (int i = 0; i < KC - 1; ++i) { unsigned v = *(const GAS unsigned*)(HALOC + ((size_t)(b * NRUN + (run > 0 ? run - 1 : 0)) * 30 + i) * DM + ch); E[i] = run > 0 ? v : 0u; }
    } else { const float* st = a.in[2] + (size_t)b * (KC - 1) * DM;
#pragma unroll
        for (int i = 0; i < KC - 1; ++i) { const f32x2 v = *(const GAS f32x2*)(st + (size_t)i * DM + ch); E[i] = pk2(v.x, v.y); }
    }
    unsigned nx[4];
#pragma unroll
    for (int k = 0; k < 4; ++k) nx[k] = *(const GAS unsigned*)(GC + (size_t)(row0 + (k < NTOK ? k : NTOK - 1)) * DM + ch);
    for (int st4 = 0; st4 < NSTEP; ++st4) {
        const int t0 = 4 * st4;
#pragma unroll
        for (int k = 0; k < 4; ++k) E[KC - 1 + k] = nx[k];
        if (st4 + 1 < NSTEP) {
#pragma unroll
            for (int k = 0; k < 4; ++k) { const int t = t0 + 4 + k; nx[k] = *(const GAS unsigned*)(GC + (size_t)(row0 + (t < NTOK ? t : NTOK - 1)) * DM + ch); }
        }
        f32x2 y[4] = {bdw, bdw, bdw, bdw};
#pragma unroll
        for (int j = 0; j < KC + 3; ++j) { const f32x2 e = {bflo(E[j]), bfhi(E[j])};
#pragma unroll
            for (int k = 0; k < 4; ++k) { const int i = j - k; if (i >= 0 && i < KC) y[k] += w[i] * e; } }
        float sv[8];
#pragma unroll
        for (int k = 0; k < 4; ++k) { sv[2 * k] = wave_sum(y[k].x + y[k].y); sv[2 * k + 1] = wave_sum(y[k].x * y[k].x + y[k].y * y[k].y); }
        LAS float* rb = red + (st4 & 1) * 64;
        if (lane == 0) { *(LAS f32x4*)(rb + wave * 8) = (f32x4){sv[0], sv[1], sv[2], sv[3]}; *(LAS f32x4*)(rb + wave * 8 + 4) = (f32x4){sv[4], sv[5], sv[6], sv[7]}; }
        __syncthreads();
        f32x4 ta = {0.f, 0.f, 0.f, 0.f}, tb = {0.f, 0.f, 0.f, 0.f};
#pragma unroll
        for (int i = 0; i < 8; ++i) { ta += *(const LAS f32x4*)(rb + i * 8); tb += *(const LAS f32x4*)(rb + i * 8 + 4); }
        const float tt[8] = {ta.x, ta.y, ta.z, ta.w, tb.x, tb.y, tb.z, tb.w};
#pragma unroll
        for (int k = 0; k < 4; ++k) { if (t0 + k < NTOK) {
            const float mu = tt[2 * k] * (1.f / DM), var = fmaxf(tt[2 * k + 1] * (1.f / DM) - mu * mu, 0.f), rstd = rsqf(var + EPS);
            const float z0 = (y[k].x - mu) * rstd * lng.x + lnb.x, z1 = (y[k].y - mu) * rstd * lng.y + lnb.y;
            *(GAS unsigned*)(GC + (size_t)(row0 + t0 + k) * DM + ch) = pk2(siluf_(z0), siluf_(z1)); } }
        if (st4 + 1 < NSTEP) {
#pragma unroll
            for (int i = 0; i < KC - 1; ++i) E[i] = E[i + 4];
        }
    }
    if (KIND == 1 || run == NRUN - 1) { float* o = a.out + (KIND == 0 ? O_PC : O_SC) + (size_t)b * (KC - 1) * DM;
        if (KIND == 0) {
#pragma unroll
            for (int i = 0; i < KC - 1; ++i) *(GAS f32x2*)(o + (size_t)i * DM + ch) = (f32x2){bflo(E[REM + i]), bfhi(E[REM + i])};
        } else {
            const float* st = a.in[2] + (size_t)b * (KC - 1) * DM;
#pragma unroll
            for (int i = 0; i < KC - 1 - TS; ++i) *(GAS f32x2*)(o + (size_t)i * DM + ch) = *(const GAS f32x2*)(st + (size_t)(i + TS) * DM + ch);
#pragma unroll
            for (int i = KC - 1 - TS; i < KC - 1; ++i) *(GAS f32x2*)(o + (size_t)i * DM + ch) = (f32x2){bflo(E[REM + i]), bfhi(E[REM + i])};
        }
    }
    __syncthreads();
}

__device__ __forceinline__ void delta_item(const Args& a, LAS unsigned char* lds, int item) {
    asm volatile("" ::: "memory");
    const int tid = threadIdx.x, lane = tid & 63, sub = tid >> 7, wu = (tid >> 6) & 1; int j = tid & 127; asm volatile("" : "+v"(j));
    const int unit = item * 4 + sub, b = unit >> 3, h = unit & 7;
    const int row0 = RP + b * TS;
    const bf16* QS = (const bf16*)(a.ws + WS_QS); bf16* ZS = (bf16*)(a.ws + WS_ZS); const float* BETAG = (const float*)(a.ws + WS_BETAG);
    LAS float* kq = (LAS float*)lds + sub * 256;
    LAS float* red = (LAS float*)lds + 1024 + sub * 4;
    LAS float* red2 = (LAS float*)lds + 1024 + 16 + sub * 2;
    float S[DH];
    { const float* s0 = a.in[4] + ((size_t)(b * NH + h) * DH) * DH + j;
#pragma unroll
        for (int d = 0; d < DH; ++d) S[d] = s0[(size_t)d * DH]; }
    const int cq = h * DH + j, ck = DM + cq, cv = 2 * DM + cq;
    float wq[KS], wk[KS], wv[KS];
#pragma unroll
    for (int i = 0; i < KS; ++i) { wq[i] = a.in[13][i * DQKV + cq]; wk[i] = a.in[13][i * DQKV + ck]; wv[i] = a.in[13][i * DQKV + cv]; }
    float hq[3], hk[3], hv[3];
#pragma unroll
    for (int i = 0; i < 3; ++i) { const float* st = a.in[3] + ((size_t)b * 3 + i) * DQKV; hq[i] = st[cq]; hk[i] = st[ck]; hv[i] = st[cv]; }
    const float gh = a.in[16][j];
    float pq[TS], pk[TS], pv[TS], pbe[TS], pgg[TS], pzs[TS];
#pragma unroll
    for (int t = 0; t < TS; ++t) { const bf16* p = QS + (size_t)(b * TS + t) * DQKV; pq[t] = bf1(p[cq]); pk[t] = bf1(p[ck]); pv[t] = bf1(p[cv]);
        pbe[t] = BETAG[(size_t)(row0 + t) * 16 + h]; pgg[t] = BETAG[(size_t)(row0 + t) * 16 + 8 + h]; pzs[t] = bf1(ZS[(size_t)(row0 + t) * DM + cq]); }
#pragma unroll
    for (int t = 0; t < TS; ++t) {
        const size_t row = (size_t)(row0 + t);
        const float qp = pq[t], kp = pk[t], vp = pv[t];
        const float qc = siluf_(wq[0] * hq[0] + wq[1] * hq[1] + wq[2] * hq[2] + wq[3] * qp);
        const float kc = siluf_(wk[0] * hk[0] + wk[1] * hk[1] + wk[2] * hk[2] + wk[3] * kp);
        const float vc = siluf_(wv[0] * hv[0] + wv[1] * hv[1] + wv[2] * hv[2] + wv[3] * vp);
        hq[0] = hq[1]; hq[1] = hq[2]; hq[2] = qp; hk[0] = hk[1]; hk[1] = hk[2]; hk[2] = kp; hv[0] = hv[1]; hv[1] = hv[2]; hv[2] = vp;
        const float sq = wave_sum(qc * qc), sk = wave_sum(kc * kc);
        kq[j] = kc; kq[128 + j] = qc;
        if (lane == 0) { red[wu * 2] = sq; red[wu * 2 + 1] = sk; }
        const float beta = pbe[t], gg = pgg[t], zs = pzs[t];
        __syncthreads();
        const float nq = rsqf(red[0] + red[2] + 1e-6f) * 0.08838834764831845f, nk = rsqf(red[1] + red[3] + 1e-6f);
        const float alpha = __expf(gg);
        float ks0 = 0.f, ks1 = 0.f, ks2 = 0.f, ks3 = 0.f;
#pragma unroll
        for (int d = 0; d < DH; d += 4) { const f32x4 kk = *(const LAS f32x4*)(kq + d); ks0 += kk.x * S[d]; ks1 += kk.y * S[d + 1]; ks2 += kk.z * S[d + 2]; ks3 += kk.w * S[d + 3];
            if ((d & 31) == 28) asm volatile("" ::: "memory"); }
        const float kS = (ks0 + ks1) + (ks2 + ks3);
        const float u = beta * (vc - alpha * nk * kS), un = nk * u;
        float o0 = 0.f, o1 = 0.f, o2 = 0.f, o3 = 0.f;
#pragma unroll
        for (int d = 0; d < DH; d += 4) { const f32x4 kk = *(const LAS f32x4*)(kq + d); const f32x4 qq = *(const LAS f32x4*)(kq + 128 + d);
            S[d] = alpha * S[d] + kk.x * un; S[d + 1] = alpha * S[d + 1] + kk.y * un; S[d + 2] = alpha * S[d + 2] + kk.z * un; S[d + 3] = alpha * S[d + 3] + kk.w * un;
            o0 += qq.x * S[d]; o1 += qq.y * S[d + 1]; o2 += qq.z * S[d + 2]; o3 += qq.w * S[d + 3];
            if ((d & 15) == 12) asm volatile("" ::: "memory"); }
        const float o = ((o0 + o1) + (o2 + o3)) * nq;
        const float so = wave_sum(o * o);
        if (lane == 0) red2[wu] = so;
        __syncthreads();
        const float rms = rsqf((red2[0] + red2[1]) * (1.f / DH) + EPS);
        ZS[row * DM + cq] = (bf16)f2bf(o * rms * gh * zs);
    }
    { float* so = a.out + O_SD + ((size_t)(b * NH + h) * DH) * DH + j;
#pragma unroll
        for (int d = 0; d < DH; ++d) so[(size_t)d * DH] = S[d];
      float* qo = a.out + O_SQ + (size_t)b * 3 * DQKV;
#pragma unroll
        for (int i = 0; i < 3; ++i) { qo[i * DQKV + cq] = hq[i]; qo[i * DQKV + ck] = hk[i]; qo[i * DQKV + cv] = hv[i]; }
    }
    __syncthreads();
}

__host__ __device__ constexpr int perm_k(int x) { return (x & ~31) | (((x >> 2) & 3) << 3) | (((x >> 4) & 1) << 2) | (x & 3); }
typedef short bf16x8v __attribute__((ext_vector_type(8)));
constexpr int IH_QH = 0, IH_KH = 17408, IH_VH = 34816, IH_GV = 52224, IH_BYTES = 54272;
__device__ __forceinline__ void intra_pair(const Args& a, LAS unsigned char* lds_all, int pair) {
    asm volatile("" ::: "memory");
    const int tid = threadIdx.x, half = tid >> 8, lane = tid & 63, wq = (tid >> 6) & 3; int tu = tid & 255; asm volatile("" : "+v"(tu));
    const int uq = pair * 2 + half, h = uq & 7, bc = uq >> 3, b = bc / NCH, c = bc - b * NCH;
    const int nvalid = (c == NCH - 1) ? TP - 64 * (NCH - 1) : 64;
    LAS unsigned char* lds = lds_all + half * IH_BYTES;
    LAS bf16* QH = (LAS bf16*)(lds + IH_QH); LAS bf16* KH = (LAS bf16*)(lds + IH_KH); LAS bf16* VH = (LAS bf16*)(lds + IH_VH);
    LAS float* MF = (LAS float*)(lds + IH_KH); LAS bf16* ATL = (LAS bf16*)(lds + IH_VH); LAS float* GV = (LAS float*)(lds + IH_GV);
    unsigned char* ws = a.ws;
    bf16* blk = (bf16*)(ws + WS_QKVB) + (size_t)uq * QBLK; const bf16* HALOQ = (const bf16*)(ws + WS_HALOQ); const float* BETAG = (const float*)(ws + WS_BETAG);
    bf16* KDT = (bf16*)(ws + WS_KDT) + (size_t)uq * 8192; bf16* ATT = (bf16*)(ws + WS_ATTN) + (size_t)uq * 4096; float* LASTV = (float*)(ws + WS_LASTV);
    if (tu < 64) { const int i = tu; float g = 0.f, be = 0.f; { const float* p = BETAG + (size_t)(b * TP + 64 * c + (i < nvalid ? i : 0)) * 16; be = p[h]; g = p[8 + h]; } if (i >= nvalid) { g = 0.f; be = 0.f; }
        float G = g;
#pragma unroll
        for (int o = 1; o < 64; o <<= 1) { const float t = __shfl_up(G, o); if (lane >= o) G += t; }
        const float GL = __shfl(G, 63);
        GV[i] = G; GV[64 + i] = be; GV[128 + i] = expf(G); GV[192 + i] = expf(GL - G);
        if (i == 63) LASTV[uq] = expf(GL); }
    {   const int cp = tu & 15, rg = tu >> 4;
        v4u raw[3][7];
#pragma unroll
        for (int wh = 0; wh < 3; ++wh)
#pragma unroll
            for (int k = 0; k < 7; ++k) { const int rr = 4 * rg - 3 + k;
                const bf16* p = (rr >= 0) ? blk + wh * 8192 + rr * 128 + 8 * cp : HALOQ + ((size_t)(b * NCH + (c > 0 ? c - 1 : 0)) * 3 + (3 + rr)) * DQKV + wh * DM + h * DH + 8 * cp;
                raw[wh][k] = *(const GAS v4u*)p; }
#pragma unroll
        for (int wh = 0; wh < 3; ++wh) {
            const int col = wh * DM + h * DH + 8 * cp;
            f32x4 wl[4], wh4[4];
#pragma unroll
            for (int i = 0; i < 4; ++i) { wl[i] = *(const GAS f32x4*)(a.in[13] + i * DQKV + col); wh4[i] = *(const GAS f32x4*)(a.in[13] + i * DQKV + col + 4); }
            float xr[7][8];
#pragma unroll
            for (int k = 0; k < 7; ++k) { const int rr = 4 * rg - 3 + k; const bool ok = (rr >= 0) ? (rr < nvalid) : (c > 0); const v4u v = raw[wh][k];
                xr[k][0] = ok ? bflo(v.x) : 0.f; xr[k][1] = ok ? bfhi(v.x) : 0.f; xr[k][2] = ok ? bflo(v.y) : 0.f; xr[k][3] = ok ? bfhi(v.y) : 0.f;
                xr[k][4] = ok ? bflo(v.z) : 0.f; xr[k][5] = ok ? bfhi(v.z) : 0.f; xr[k][6] = ok ? bflo(v.w) : 0.f; xr[k][7] = ok ? bfhi(v.w) : 0.f; }
            if (c == NCH - 1 && rg == (nvalid - 1) / 4) {
                float* qo = a.out + O_PQ + (size_t)b * 3 * DQKV + col;
#pragma unroll
                for (int i = 0; i < 3; ++i) { *(GAS f32x4*)(qo + i * DQKV) = (f32x4){xr[4 + i][0], xr[4 + i][1], xr[4 + i][2], xr[4 + i][3]}; *(GAS f32x4*)(qo + i * DQKV + 4) = (f32x4){xr[4 + i][4], xr[4 + i][5], xr[4 + i][6], xr[4 + i][7]}; } }
            LAS bf16* tile = wh == 0 ? QH : (wh == 1 ? KH : VH);
#pragma unroll
            for (int r = 0; r < 4; ++r) { const bool ok = (4 * rg + r) < nvalid; float y[8];
#pragma unroll
                for (int e = 0; e < 8; ++e) { const float w0 = e < 4 ? wl[0][e & 3] : wh4[0][e & 3], w1 = e < 4 ? wl[1][e & 3] : wh4[1][e & 3], w2 = e < 4 ? wl[2][e & 3] : wh4[2][e & 3], w3 = e < 4 ? wl[3][e & 3] : wh4[3][e & 3];
                    const float t = w0 * xr[r][e] + w1 * xr[r + 1][e] + w2 * xr[r + 2][e] + w3 * xr[r + 3][e]; y[e] = ok ? siluf_(t) : 0.f; }
                v4u o; o.x = cvtpk(y[0], y[1]); o.y = cvtpk(y[2], y[3]); o.z = cvtpk(y[4], y[5]); o.w = cvtpk(y[6], y[7]);
                *(LAS v4u*)(tile + (4 * rg + r) * 136 + 8 * cp) = o; }
        }
    }
    __syncthreads();
    const int which = tu >> 7, d = tu & 127;
    float x[64];
    { const LAS bf16* colp = (which == 0 ? VH : KH) + d;
#pragma unroll
      for (int i = 0; i < 64; ++i) x[i] = bf1(colp[i * 136]); }
    const int fr = lane & 15, fq = lane >> 4;
    f32x4 kk[4], qk[4];
    {   bf16x8v ak[4], aq[4];
#pragma unroll
        for (int sI = 0; sI < 4; ++sI) { ak[sI] = *(const LAS bf16x8v*)(KH + (16 * wq + fr) * 136 + 32 * sI + 8 * fq); aq[sI] = *(const LAS bf16x8v*)(QH + (16 * wq + fr) * 136 + 32 * sI + 8 * fq); }
        f32x4 kkd = {0.f, 0.f, 0.f, 0.f}, qqd = {0.f, 0.f, 0.f, 0.f};
#pragma unroll
        for (int sI = 0; sI < 4; ++sI) { kkd = __builtin_amdgcn_mfma_f32_16x16x32_bf16(ak[sI], ak[sI], kkd, 0, 0, 0); qqd = __builtin_amdgcn_mfma_f32_16x16x32_bf16(aq[sI], aq[sI], qqd, 0, 0, 0); }
#pragma unroll
        for (int nt = 0; nt < 4; ++nt) { kk[nt] = (f32x4){0.f, 0.f, 0.f, 0.f}; qk[nt] = (f32x4){0.f, 0.f, 0.f, 0.f};
            if (nt <= wq) {
#pragma unroll
                for (int sI = 0; sI < 4; ++sI) { const bf16x8v bk = *(const LAS bf16x8v*)(KH + (16 * nt + fr) * 136 + 32 * sI + 8 * fq);
                    kk[nt] = __builtin_amdgcn_mfma_f32_16x16x32_bf16(ak[sI], bk, kk[nt], 0, 0, 0); qk[nt] = __builtin_amdgcn_mfma_f32_16x16x32_bf16(aq[sI], bk, qk[nt], 0, 0, 0); } } }
#pragma unroll
        for (int r = 0; r < 4; ++r) if (fr == 4 * fq + r) { GV[320 + 16 * wq + fr] = rsqf(kkd[r] + 1e-6f); GV[256 + 16 * wq + fr] = rsqf(qqd[r] + 1e-6f) * 0.08838834764831845f; }
    }
    __syncthreads();
    {
#pragma unroll
        for (int nt = 0; nt < 4; ++nt) { const int j = 16 * nt + fr;
            if (nt <= wq) { const float Gj = GV[j], nkj = GV[320 + j];
#pragma unroll
                for (int r = 0; r < 4; ++r) { const int i = 16 * wq + 4 * fq + r; const float dec = (i >= j) ? __expf(GV[i] - Gj) : 0.f;
                    MF[i * 68 + j] = (i > j) ? GV[64 + i] * GV[320 + i] * nkj * kk[nt][r] * dec : 0.f;
                    ATL[i * 72 + j] = (bf16)f2bf(GV[256 + i] * nkj * qk[nt][r] * dec); }
            } else {
#pragma unroll
                for (int r = 0; r < 4; ++r) ATL[(16 * wq + 4 * fq + r) * 72 + j] = (bf16)0; }
        }
#pragma unroll
        for (int k = 0; k < 4; ++k) { const int pc = tu + 256 * k, i = pc >> 4, p16 = pc & 15, c0 = 32 * (p16 >> 2) + 4 * (p16 & 3);
            const v2u lo = *(const LAS v2u*)(QH + i * 136 + c0), hi = *(const LAS v2u*)(QH + i * 136 + c0 + 16); const float f = GV[256 + i] * GV[128 + i];
            v4u o; o.x = cvtpk(bflo(lo.x) * f, bfhi(lo.x) * f); o.y = cvtpk(bflo(lo.y) * f, bfhi(lo.y) * f); o.z = cvtpk(bflo(hi.x) * f, bfhi(hi.x) * f); o.w = cvtpk(bflo(hi.y) * f, bfhi(hi.y) * f);
            *(GAS v4u*)(blk + i * 128 + 8 * p16) = o; }
        if (which == 0) {
#pragma unroll
            for (int i = 0; i < 64; i += 4) { const f32x4 be = *(const LAS f32x4*)(GV + 64 + i); x[i] *= be.x; x[i + 1] *= be.y; x[i + 2] *= be.z; x[i + 3] *= be.w; }
        } else {
            bf16* kd = KDT + d * 64;
#pragma unroll
            for (int i = 0; i < 64; i += 4) { const f32x4 nk = *(const LAS f32x4*)(GV + 320 + i); x[i] *= nk.x; x[i + 1] *= nk.y; x[i + 2] *= nk.z; x[i + 3] *= nk.w; }
#pragma unroll
            for (int g8 = 0; g8 < 8; ++g8) { const int i0 = 32 * (g8 >> 2) + 4 * (g8 & 3);
                const f32x4 e0 = *(const LAS f32x4*)(GV + 192 + i0), e1 = *(const LAS f32x4*)(GV + 192 + i0 + 16);
                v4u w; w.x = cvtpk(x[i0] * e0.x, x[i0 + 1] * e0.y); w.y = cvtpk(x[i0 + 2] * e0.z, x[i0 + 3] * e0.w); w.z = cvtpk(x[i0 + 16] * e1.x, x[i0 + 17] * e1.y); w.w = cvtpk(x[i0 + 18] * e1.z, x[i0 + 19] * e1.w);
                *(GAS v4u*)(kd + 8 * g8) = w; }
#pragma unroll
            for (int i = 0; i < 64; i += 4) { const f32x4 be = *(const LAS f32x4*)(GV + 64 + i), eg = *(const LAS f32x4*)(GV + 128 + i);
                x[i] *= be.x * eg.x; x[i + 1] *= be.y * eg.y; x[i + 2] *= be.z * eg.z; x[i + 3] *= be.w * eg.w; }
        }
    }
    __syncthreads();
    {   f32x4 mb[16];
#pragma unroll
        for (int i = 1; i < 64; ++i) {
#pragma unroll
            for (int g = 0; g < (i + 3) / 4; ++g) mb[g] = *(const LAS f32x4*)(MF + i * 68 + 4 * g);
            __builtin_amdgcn_sched_barrier(0);
            f32x2 a01 = {x[i], 0.f}, a23 = {0.f, 0.f};
#pragma unroll
            for (int g = 0; g < (i + 3) / 4; ++g) { const f32x4 mm = mb[g];
                a01 -= (f32x2){mm.x, mm.y} * (f32x2){x[4 * g], x[4 * g + 1]}; a23 -= (f32x2){mm.z, mm.w} * (f32x2){x[4 * g + 2], x[4 * g + 3]}; }
            x[i] = (a01.x + a01.y) + (a23.x + a23.y);
            __builtin_amdgcn_sched_barrier(0);
        }
    }
    if (which == 0) {
        bf16* u0 = blk + 2 * 8192 + (size_t)(d >> 4) * 1024 + (d & 15) * 4;
#pragma unroll
        for (int m = 0; m < 4; ++m)
#pragma unroll
            for (int q = 0; q < 4; ++q) { const int i = 16 * m + 4 * q; v2u w; w.x = cvtpk(x[i], x[i + 1]); w.y = cvtpk(x[i + 2], x[i + 3]); *(GAS v2u*)(u0 + m * 256 + q * 64) = w; }
    } else {
#pragma unroll
        for (int i = 0; i < 64; ++i) QH[i * 136 + d] = (bf16)f2bf(x[i]);
    }
    __syncthreads();
#pragma unroll
    for (int k = 0; k < 4; ++k) { const int pc = tu + 256 * k, i = pc >> 4, p16 = pc & 15, c0 = 32 * (p16 >> 2) + 4 * (p16 & 3);
        const v2u lo = *(const LAS v2u*)(QH + i * 136 + c0), hi = *(const LAS v2u*)(QH + i * 136 + c0 + 16);
        *(GAS v4u*)(blk + 8192 + i * 128 + 8 * p16) = (v4u){lo.x, lo.y, hi.x, hi.y}; }
#pragma unroll
    for (int k = 0; k < 2; ++k) { const int pc = tu + 256 * k, i = pc >> 3, p8 = pc & 7, c0 = 32 * (p8 >> 2) + 4 * (p8 & 3);
        const v2u lo = *(const LAS v2u*)(ATL + i * 72 + c0), hi = *(const LAS v2u*)(ATL + i * 72 + c0 + 16);
        *(GAS v4u*)(ATT + i * 64 + 8 * p8) = (v4u){lo.x, lo.y, hi.x, hi.y}; }
    __syncthreads();
}

constexpr int SC_W = 0, SC_QD = 17408, SC_KDT = 34816, SC_AT = 53248, SC_BUF = 62464, SC_RMS = 2 * SC_BUF;
__device__ __forceinline__ void scan_chain(const Args& a, LAS unsigned char* lds, int chain) {
    const int tid = threadIdx.x, lane = tid & 63, wave = __builtin_amdgcn_readfirstlane(tid >> 6), fr = lane & 15, fq = lane >> 4;
    const int b = chain >> 3, h = chain & 7;
    unsigned char* ws = a.ws;
    const bf16* QKVB = (const bf16*)(ws + WS_QKVB); const bf16* KDTg = (const bf16*)(ws + WS_KDT); const bf16* ATTg = (const bf16*)(ws + WS_ATTN); const float* LASTV = (const float*)(ws + WS_LASTV);
    bf16* ZS = (bf16*)(ws + WS_ZS);
    LAS float* RMS = (LAS float*)(lds + SC_RMS);
    const float gh = a.in[16][16 * wave + fr];
    f32x4 Sacc[8];
#pragma unroll
    for (int mt = 0; mt < 8; ++mt) Sacc[mt] = (f32x4){0.f, 0.f, 0.f, 0.f};
    v4u st[7];
    auto stage_load = [&](int c) {
        const size_t uq = (size_t)(b * NCH + c) * NH + h; const bf16* blk = QKVB + uq * QBLK;
#pragma unroll
        for (int k = 0; k < 2; ++k) { const int e = (tid + 512 * k) * 8; st[k] = *(const GAS v4u*)(blk + 8192 + e); st[2 + k] = *(const GAS v4u*)(blk + e); st[4 + k] = *(const GAS v4u*)(KDTg + uq * 8192 + e); }
        st[6] = *(const GAS v4u*)(ATTg + uq * 4096 + tid * 8);
    };
    auto stage_store = [&](int buf) {
        LAS unsigned char* base = lds + buf * SC_BUF;
#pragma unroll
        for (int k = 0; k < 2; ++k) { const int e = (tid + 512 * k) * 8; const int r = e >> 7, cc = e & 127;
            *(LAS v4u*)(base + SC_W + r * 272 + cc * 2) = st[k]; *(LAS v4u*)(base + SC_QD + r * 272 + cc * 2) = st[2 + k];
            const int r2 = e >> 6, c2 = e & 63; *(LAS v4u*)(base + SC_KDT + r2 * 144 + c2 * 2) = st[4 + k]; }
        { const int e = tid * 8, r2 = e >> 6, c2 = e & 63; *(LAS v4u*)(base + SC_AT + r2 * 144 + c2 * 2) = st[6]; }
    };
    v2u u0n[4]; float lastn;
    auto side_load = [&](int c) {
        const size_t uq = (size_t)(b * NCH + c) * NH + h;
        const bf16* u0 = QKVB + uq * QBLK + 2 * 8192 + wave * 1024 + lane * 4;
#pragma unroll
        for (int m = 0; m < 4; ++m) u0n[m] = *(const GAS v2u*)(u0 + m * 256);
        lastn = LASTV[uq];
    };
    stage_load(0); side_load(0); stage_store(0);
    __syncthreads();
    for (int c = 0; c < NCH; ++c) {
        const int buf = c & 1; LAS unsigned char* base = lds + buf * SC_BUF;
        const int nvalid = (c == NCH - 1) ? TP - 64 * (NCH - 1) : 64;
        v2u u0p[4]; bf16 zs[16];
#pragma unroll
        for (int m = 0; m < 4; ++m) u0p[m] = u0n[m];
        const float last = lastn;
        const size_t zrow0 = (size_t)(b * TP + 64 * c) * DM + h * DH + 16 * wave + fr;
        if (c + 1 < NCH) { stage_load(c + 1); side_load(c + 1); }
#pragma unroll
        for (int m = 0; m < 4; ++m)
#pragma unroll
            for (int r = 0; r < 4; ++r) zs[4 * m + r] = ZS[zrow0 + (size_t)(16 * m + 4 * fq + r) * DM];
        bf16x8v Sb[4];
#pragma unroll
        for (int sI = 0; sI < 4; ++sI) { v4u w; w.x = cvtpk(Sacc[2 * sI][0], Sacc[2 * sI][1]); w.y = cvtpk(Sacc[2 * sI][2], Sacc[2 * sI][3]); w.z = cvtpk(Sacc[2 * sI + 1][0], Sacc[2 * sI + 1][1]); w.w = cvtpk(Sacc[2 * sI + 1][2], Sacc[2 * sI + 1][3]);
            Sb[sI] = __builtin_bit_cast(bf16x8v, w); }
        f32x4 u[4], o[4];
#pragma unroll
        for (int m = 0; m < 4; ++m) { f32x4 p = {0.f, 0.f, 0.f, 0.f}, oo = {0.f, 0.f, 0.f, 0.f};
#pragma unroll
            for (int sI = 0; sI < 4; ++sI) { const bf16x8v aw = *(const LAS bf16x8v*)(base + SC_W + (16 * m + fr) * 272 + (32 * sI + 8 * fq) * 2);
                const bf16x8v aqd = *(const LAS bf16x8v*)(base + SC_QD + (16 * m + fr) * 272 + (32 * sI + 8 * fq) * 2);
                p = __builtin_amdgcn_mfma_f32_16x16x32_bf16(aw, Sb[sI], p, 0, 0, 0); oo = __builtin_amdgcn_mfma_f32_16x16x32_bf16(aqd, Sb[sI], oo, 0, 0, 0); }
            u[m] = (f32x4){bflo(u0p[m].x), bfhi(u0p[m].x), bflo(u0p[m].y), bfhi(u0p[m].y)} - p; o[m] = oo; }
        bf16x8v Ub[2];
#pragma unroll
        for (int s2 = 0; s2 < 2; ++s2) { v4u w; w.x = cvtpk(u[2 * s2][0], u[2 * s2][1]); w.y = cvtpk(u[2 * s2][2], u[2 * s2][3]); w.z = cvtpk(u[2 * s2 + 1][0], u[2 * s2 + 1][1]); w.w = cvtpk(u[2 * s2 + 1][2], u[2 * s2 + 1][3]);
            Ub[s2] = __builtin_bit_cast(bf16x8v, w); }
#pragma unroll
        for (int m = 0; m < 4; ++m)
#pragma unroll
            for (int s2 = 0; s2 < 2; ++s2) { const bf16x8v aa = *(const LAS bf16x8v*)(base + SC_AT + (16 * m + fr) * 144 + (32 * s2 + 8 * fq) * 2);
                o[m] = __builtin_amdgcn_mfma_f32_16x16x32_bf16(aa, Ub[s2], o[m], 0, 0, 0); }
#pragma unroll
        for (int mt = 0; mt < 8; ++mt) { f32x4 sacc = Sacc[mt] * last;
#pragma unroll
            for (int s2 = 0; s2 < 2; ++s2) { const bf16x8v ak = *(const LAS bf16x8v*)(base + SC_KDT + (16 * mt + fr) * 144 + (32 * s2 + 8 * fq) * 2);
                sacc = __builtin_amdgcn_mfma_f32_16x16x32_bf16(ak, Ub[s2], sacc, 0, 0, 0); }
            Sacc[mt] = sacc; }
        LAS float* rm = RMS + (c & 1) * 512;
#pragma unroll
        for (int m = 0; m < 4; ++m)
#pragma unroll
            for (int r = 0; r < 4; ++r) { const float v = sum16(o[m][r] * o[m][r]); if (fr == 0) rm[(16 * m + 4 * fq + r) * 8 + wave] = v; }
        if (c + 1 < NCH) stage_store(buf ^ 1);
        __syncthreads();
#pragma unroll
        for (int m = 0; m < 4; ++m) { if (16 * m >= nvalid) continue;
#pragma unroll
            for (int r = 0; r < 4; ++r) { const int i = 16 * m + 4 * fq + r; const f32x4 p0 = *(const LAS f32x4*)(rm + i * 8), p1 = *(const LAS f32x4*)(rm + i * 8 + 4);
                const float ss = ((p0.x + p0.y) + (p0.z + p0.w)) + ((p1.x + p1.y) + (p1.z + p1.w));
                const float on = o[m][r] * rsqf(ss * (1.f / DH) + EPS) * gh * bf1(zs[4 * m + r]);
                ZS[zrow0 + (size_t)i * DM] = (bf16)f2bf(on); } }
    }
    { float* so = a.out + O_PD + ((size_t)(b * NH + h) * DH) * DH + 16 * wave + fr;
#pragma unroll
      for (int mt = 0; mt < 8; ++mt)
#pragma unroll
          for (int r = 0; r < 4; ++r) so[(size_t)(16 * mt + 4 * fq + r) * DH] = Sacc[mt][r]; }
    __syncthreads();
}

constexpr int NPHASES = 10;
__global__ void __launch_bounds__(NWAVES * 64, 2) fwd_kernel(Args args) {
    extern __shared__ __attribute__((aligned(16))) unsigned char lds_raw[];
    LAS unsigned char* lds = (LAS unsigned char*)lds_raw;
    volatile LAS unsigned* MISC = (volatile LAS unsigned*)(lds + MISC_OFF);
    const int tid = threadIdx.x, lane = tid & 63, wave = __builtin_amdgcn_readfirstlane(tid >> 6);
    const int G = gridDim.x, bx = blockIdx.x;
    const int vcu = (G % 8 == 0) ? (bx % 8) * (G / 8) + bx / 8 : bx;
    unsigned char* ws = args.ws;
    gu32* ctl = (gu32*)(ws + WS_CTL);
    for (int u = tid; u < (LDS_BYTES - LDSCTL_OFF) / 4; u += NWAVES * 64) ((LAS unsigned*)(lds + LDSCTL_OFF))[u] = 0u;
    __syncthreads();
    XcdBarrier bar; bar.bar = (unsigned*)(ctl + CW_BAR); bar.x = 0; bar.st = nullptr;
    const int lo = args.ph_lo, hi = args.ph_hi;
    if (hi - lo > 1) bar = xcd_barrier_post((unsigned*)(ctl + CW_BAR), MISC + 8);
#ifndef PH_MASK
#define PH_MASK 0x3ff
#endif
#define IN(k) (((PH_MASK >> (k)) & 1) && lo <= (k) && (k) < hi)
#ifndef PROBE_K
#define PROBE_K -1
#endif
#if PROBE_K >= 0
    volatile LAS unsigned long long* stamps = (volatile LAS unsigned long long*)(lds + MISC_OFF + 128);
    if (tid == 0) stamps[0] = __builtin_amdgcn_s_memrealtime();
#define SEAM(k) do { if (IN(k) && IN((k) + 1)) xcd_barrier(bar); if (tid == 0) stamps[(k) + 1] = __builtin_amdgcn_s_memrealtime(); } while (0)
#else
#define SEAM(k) do { if (IN(k) && IN((k) + 1)) xcd_barrier(bar); } while (0)
#endif
    bf16* WIN = (bf16*)(ws + WS_WIN); bf16* WC = (bf16*)(ws + WS_WC); bf16* WD = (bf16*)(ws + WS_WD); bf16* WO = (bf16*)(ws + WS_WO); bf16* WUP = (bf16*)(ws + WS_WUP); bf16* WDN = (bf16*)(ws + WS_WDN);
    bf16* H = (bf16*)(ws + WS_H); bf16* GLU = (bf16*)(ws + WS_GLU); bf16* QKVB = (bf16*)(ws + WS_QKVB); bf16* QS = (bf16*)(ws + WS_QS); bf16* ZS = (bf16*)(ws + WS_ZS);
    bf16* HALOQ = (bf16*)(ws + WS_HALOQ); bf16* HALOC = (bf16*)(ws + WS_HALOC);
    bf16* SGC = (bf16*)args.out; bf16* SGD = (bf16*)args.out + (size_t)M2 * DM;
    bf16* MIX = (bf16*)(ws + WS_MIX); bf16* XG = (bf16*)(ws + WS_XG); bf16* HM = (bf16*)(ws + WS_HM); bf16* C = (bf16*)(ws + WS_C);
    float* BETAG = (float*)(ws + WS_BETAG);
    const int gw = vcu * NWAVES + wave, NGW = G * NWAVES;

    if (IN(0)) {
        LAS float* scr = (LAS float*)(lds + RING_OFF + wave * 16384);
        constexpr int I_IN = 16 * (NIN / 32), I_SQ = 16 * 32, I_UP = 16 * (DFF / 32), I_DN = (DFF / 64) * 32;
        constexpr int NITEMS = I_IN + 3 * I_SQ + I_UP + I_DN;
        for (int it = gw; it < NITEMS; it += NGW) {
            int r = it;
            if (r < I_IN) { const int nb = r >> 4, kb = r & 15; int src, nv; win_src(nb, src, nv); p0_transpose_item(args.in[7], DIN, DM, WIN, nb * 32, src, nv, scr, kb, lane); continue; } r -= I_IN;
            if (r < I_SQ) { p0_transpose_item(args.in[12], DM, DM, WC, (r >> 4) * 32, (r >> 4) * 32, 32, scr, r & 15, lane); continue; } r -= I_SQ;
            if (r < I_SQ) { p0_transpose_item(args.in[17], DM, DM, WD, (r >> 4) * 32, (r >> 4) * 32, 32, scr, r & 15, lane); continue; } r -= I_SQ;
            if (r < I_SQ) { p0_transpose_item(args.in[18], DM, DM, WO, (r >> 4) * 32, (r >> 4) * 32, 32, scr, r & 15, lane); continue; } r -= I_SQ;
            if (r < I_UP) { p0_transpose_item(args.in[20], DFF, DM, WUP, (r >> 4) * 32, (r >> 4) * 32, 32, scr, r & 15, lane); continue; } r -= I_UP;
            p0_transpose_item(args.in[21], DM, DFF, WDN, (r >> 6) * 32, (r >> 6) * 32, 32, scr, r & 63, lane);
        }
        for (int m = gw; m < MP; m += NGW) {
            if (m >= MR) { GAS unsigned long long* o8 = (GAS unsigned long long*)(H + (size_t)m * DM) + lane;
#pragma unroll
                for (int jj = 0; jj < 4; ++jj) o8[64 * jj] = 0ull; continue; }
            const float* src;
            if (m >= RP) src = args.in[1] + (size_t)(m - RP) * DM;
            else { const int b = m / TP, t = m - b * TP; src = t < NMETA ? args.in[5] + (size_t)t * DM : args.in[0] + ((size_t)b * SEQ + (t - NMETA)) * DM; }
            rms_row_to_bf16(src, args.in[6], H + (size_t)m * DM, lane);
        }
    }
    SEAM(0);
    if (IN(1)) {
        pg8::Gemm g{H, WIN, MP, NIN, DM}; pg8::StaticOrder S; S.init(MP, NIN, G, bx);
        EpiIn E{GLU, QKVB, QS, HALOQ, HALOC, ZS, SGC, SGD, BETAG, args.in[14], args.in[15]};
        pg8::gemm_phase<EpiIn, pg8::StaticOrder, true, true>(lds + RING_OFF, g, S, E);
    }
    SEAM(1);
    if (IN(2)) {
        constexpr int N_CP = BP * NRUN, N_IP = BP * NCH * NH / 2, N_SD = BS * NH / 4, N_CS = BS, N_ITEMS = N_CP + N_IP + N_SD + N_CS;
        volatile LAS int* qslot = (volatile LAS int*)(lds + MISC_OFF + 64);
#if PROBE_K >= 0
        for (int sub = 0; sub < 3; ++sub) {
            const int lo_i = sub == 0 ? 0 : (sub == 1 ? N_CP : N_CP + N_IP), hi_i = sub == 0 ? N_CP : (sub == 1 ? N_CP + N_IP : N_CP + N_IP + N_SD);
            for (;;) {
                if (tid == 0) *qslot = (int)__hip_atomic_fetch_add((unsigned*)(ctl + 2048 + 64 * sub), 1u, __ATOMIC_RELAXED, __HIP_MEMORY_SCOPE_AGENT);
                __syncthreads();
                int it = *qslot + lo_i;
                __syncthreads();
                if (sub == 0 && it >= N_CP) { it += N_IP + N_SD; if (it >= N_ITEMS) break; conv_unit<1>(args, lds, it - (N_CP + N_IP + N_SD), 0); continue; }
                if (it >= hi_i) break;
                if (it < N_CP) { conv_unit<0>(args, lds, it / NRUN, it % NRUN); continue; } it -= N_CP;
                if (it < N_IP) { intra_pair(args, lds, it); continue; } it -= N_IP;
                (void)it;
            }
            if (sub < 2) { xcd_barrier(bar); if (tid == 0) stamps[12 + sub] = __builtin_amdgcn_s_memrealtime(); }
        }
#else
        for (;;) {
            if (tid == 0) *qslot = (int)__hip_atomic_fetch_add((unsigned*)(ctl + 2048), 1u, __ATOMIC_RELAXED, __HIP_MEMORY_SCOPE_AGENT);
            __syncthreads();
            int it = *qslot;
            __syncthreads();
            if (it >= N_CP + N_IP) it += N_SD;
            if (it >= N_ITEMS) break;
            if (it < N_CP) { conv_unit<0>(args, lds, it / NRUN, it % NRUN); continue; } it -= N_CP;
            if (it < N_IP) { intra_pair(args, lds, it); continue; } it -= N_IP;
            it -= N_SD; if (it < 0) continue;
            conv_unit<1>(args, lds, it, 0);
        }
#endif
    }
    SEAM(2);
    if (IN(3)) {
        if (bx < BP * NH) scan_chain(args, lds, bx);
        else {
            pg8::Gemm g{C, WC, MP, DM, DM}; pg8::StaticOrder S; S.init(MP, DM, G - BP * NH, bx - BP * NH);
            EpiGate<0> E{SGC, nullptr, SGC};
            pg8::gemm_phase<EpiGate<0>, pg8::StaticOrder, true, true>(lds + RING_OFF, g, S, E);
            volatile LAS int* qslot = (volatile LAS int*)(lds + MISC_OFF + 64);
            for (;;) {
                if (tid == 0) *qslot = (int)__hip_atomic_fetch_add((unsigned*)(ctl + 2048 + 256), 1u, __ATOMIC_RELAXED, __HIP_MEMORY_SCOPE_AGENT);
                __syncthreads();
                const int it = *qslot;
                __syncthreads();
                if (it >= BS * NH / 4) break;
                delta_item(args, lds, it);
            }
        }
    }
    SEAM(3);
    if (IN(4)) {
        pg8::Gemm g{ZS, WD, MP, DM, DM}; pg8::StaticOrder S; S.init(MP, DM, G, bx);
        EpiGate<1> E{SGD, SGC, MIX};
        pg8::gemm_phase<EpiGate<1>, pg8::StaticOrder, true, true>(lds + RING_OFF, g, S, E);
    }
    SEAM(4);
    if (IN(5)) {
        pg8::Gemm g{MIX, WO, M2, DM, DM}; pg8::StaticOrder S; S.init(M2, DM, G, bx);
        EpiRes<0> E{args.in[0], args.in[1], args.out};
        pg8::gemm_phase<EpiRes<0>, pg8::StaticOrder, true, true>(lds + RING_OFF, g, S, E);
    }
    SEAM(5);
    if (IN(6)) {
        for (int m = gw; m < M2; m += NGW) rms_row_to_bf16(args.out + (size_t)m * DM, args.in[19], XG + (size_t)m * DM, lane);
    }
    SEAM(6);
    if (IN(7)) {
        pg8::Gemm g{XG, WUP, M2, DFF, DM}; pg8::StaticOrder S; S.init(M2, DFF, G, bx);
        EpiUp E{HM};
        pg8::gemm_phase<EpiUp, pg8::StaticOrder, true, true>(lds + RING_OFF, g, S, E);
    }
    SEAM(7);
    if (IN(8)) {
        pg8::Gemm g{HM, WDN, M2, DM, DFF}; pg8::StaticOrder S; S.init(M2, DM, G, bx);
        EpiRes<1> E{nullptr, nullptr, args.out};
        pg8::gemm_phase<EpiRes<1>, pg8::StaticOrder, true, true>(lds + RING_OFF, g, S, E);
    }
    SEAM(8);
    if (IN(9)) {
        for (int m = gw; m < M2; m += NGW) {
            float* xrow = args.out + (size_t)m * DM;
            GAS f32x4* xr = (GAS f32x4*)xrow + lane; const GAS f32x4* gr = (const GAS f32x4*)args.in[22] + lane;
            f32x4 v[4]; float s = 0.f;
#pragma unroll
            for (int jj = 0; jj < 4; ++jj) { v[jj] = xr[64 * jj]; s += (v[jj].x * v[jj].x + v[jj].y * v[jj].y) + (v[jj].z * v[jj].z + v[jj].w * v[jj].w); }
            const float rstd = 1.f / sqrtf(wave_sum(s) * (1.f / DM) + EPS);
#pragma unroll
            for (int jj = 0; jj < 4; ++jj) xr[64 * jj] = v[jj] * rstd * gr[64 * jj];
        }
    }
#if PROBE_K >= 0
    __syncthreads();
    if (bx == 0) { if (tid == 0) stamps[NPHASES] = __builtin_amdgcn_s_memrealtime(); __syncthreads();
        const float dt_us = (float)(stamps[PROBE_B] - stamps[PROBE_K]) * 0.01f; const float f = 1.f + dt_us * (1.f / (float)(PROBE_DIV));
        for (int i = tid; i < BP * 3 * DQKV; i += NWAVES * 64) args.out[O_PQ + i] *= f; }
#endif
#undef IN
#undef SEAM
}

extern "C" void kernel_launch(void* const* d_in, const int* in_sizes, int n_in, void* d_out, int out_size, void* d_ws, size_t ws_size, hipStream_t stream) {
    static int grid = 0;
    if (grid == 0) {
        if (n_in != 23 || (size_t)out_size != O_END || ws_size < WS_END) { fprintf(stderr, "kernel_launch: unexpected shapes n_in %d out %d ws %zu\n", n_in, out_size, ws_size); grid = -1; return; }
        int dev = 0, cus = 0, per_cu = 0;
        if (hipGetDevice(&dev) != hipSuccess || hipDeviceGetAttribute(&cus, hipDeviceAttributeMultiprocessorCount, dev) != hipSuccess) { grid = -1; return; }
        if (hipFuncSetAttribute((const void*)fwd_kernel, hipFuncAttributeMaxDynamicSharedMemorySize, LDS_BYTES) != hipSuccess) { fprintf(stderr, "kernel_launch: hipFuncSetAttribute failed\n"); grid = -1; return; }
        if (hipOccupancyMaxActiveBlocksPerMultiprocessor(&per_cu, (const void*)fwd_kernel, NWAVES * 64, LDS_BYTES) != hipSuccess || per_cu < 1)
            fprintf(stderr, "kernel_launch: occupancy query reports %d\n", per_cu);
        (void)hipGetLastError();
        grid = cus;
    }
    if (grid < 0) return;
    if (hipMemsetAsync((char*)d_ws + WS_CTL, 0, CTL_ZERO_BYTES, stream) != hipSuccess) return;
    Args a{};
    for (int i = 0; i < 23; ++i) a.in[i] = (const float*)d_in[i];
    a.out = (float*)d_out; a.ws = (unsigned char*)d_ws;
#if MK_N_LAUNCHES == 1
    a.ph_lo = 0; a.ph_hi = NPHASES;
    hipLaunchKernelGGL(fwd_kernel, dim3(grid), dim3(NWAVES * 64), LDS_BYTES, stream, a);
#else
    for (int p = 0; p < NPHASES; ++p) { a.ph_lo = p; a.ph_hi = p + 1; hipLaunchKernelGGL(fwd_kernel, dim3(grid), dim3(NWAVES * 64), LDS_BYTES, stream, a); }
#endif
}
```

```cpp
#include <hip/hip_runtime.h>
#include <cstdio>
#include <cstdint>

#ifndef MK_N_LAUNCHES
#define MK_N_LAUNCHES 1
#endif

namespace pg8 {
#define PG8_LAS __attribute__((address_space(3)))
typedef unsigned short bf16_t;
typedef short bf16x8 __attribute__((ext_vector_type(8)));
typedef float f32x4 __attribute__((ext_vector_type(4)));
typedef unsigned u32x4 __attribute__((ext_vector_type(4)));
constexpr int BM = 256, BK = 64, HALF = 128, HTB = HALF * BK * 2, STAGE_BYTES = 8 * HTB, NXCD = 8, WGM = 8;

__host__ __device__ __forceinline__ int lds_byte(int r, int c) { const int st = (r >> 4) * 2 + (c >> 5), rr = r & 15, cc = c & 31, ob = rr * 64 + cc * 2; return st * 1024 + (ob ^ (((ob >> 9) & 1) << 5)); }
__host__ __device__ __forceinline__ void stage_rc(int b, int& R, int& C) { const int st = b / 1024, sb = b % 1024, swz = sb ^ (((sb >> 9) & 1) << 5); R = (st >> 1) * 16 + swz / 64; C = (st & 1) * 32 + (swz % 64) / 2; }
__host__ __device__ __forceinline__ int perm32(int rho) { const int n = rho >> 4, i = rho & 15; return 8 * (i >> 2) + 4 * n + (i & 3); }

struct Unit { int pm, pn; };
struct Gemm { const bf16_t* A; const bf16_t* Bt; int M, N, K; };

struct StaticOrder {
    int nM, nN, nwg, G, c;
    __host__ __device__ void init(int M, int N, int G_, int c_) { nM = M / BM; nN = N / BM; nwg = nM * nN; G = G_; c = c_; }
    __host__ __device__ bool next(int i, Unit& u) const {
        const long L = (long)i * G + c; if (L >= nwg) return false;
        int wgid = (int)L; { const int q = nwg / NXCD, r = nwg % NXCD, xcd = wgid % NXCD, off = wgid / NXCD; wgid = (xcd < r ? xcd * (q + 1) : r * (q + 1) + (xcd - r) * q) + off; }
        const int nig = WGM * nN, gid = wgid / nig, fm = gid * WGM, gsz = (nM - fm) < WGM ? (nM - fm) : WGM;
        u.pm = fm + ((wgid % nig) % gsz); u.pn = (wgid % nig) / gsz; return true;
    }
    __device__ __forceinline__ void a_ready(const Unit&) const {}
    __device__ __forceinline__ void done(const Unit&) const {}
};

__device__ __forceinline__ unsigned cvt_pk_bf16(float lo, float hi) { unsigned r; asm volatile("v_cvt_pk_bf16_f32 %0, %1, %2" : "=v"(r) : "v"(lo), "v"(hi)); return r; }

template <class Epi, class Sched, bool ALIGN_EPI = false, bool SP2 = false>
__device__ __forceinline__ void gemm_phase(PG8_LAS unsigned char* lds, const Gemm g, const Sched& S, const Epi& E) {
    const int tid = threadIdx.x, wid = __builtin_amdgcn_readfirstlane(tid >> 6), lane = tid & 63, wr = wid >> 2, wc = wid & 3, fr = lane & 15, fq = lane >> 4;
    const int K = g.K, nt = K / BK;
    unsigned voffA[2], voffB[2];
#pragma unroll
    for (int i = 0; i < 2; ++i) { int R, C; stage_rc(tid * 16 + i * 8192, R, C); const int Rb = Epi::PERM ? ((R & ~31) + perm32(R & 31)) : R;
        voffA[i] = (unsigned)(R * K + C) * 2u; voffB[i] = (unsigned)(Rb * K + C) * 2u; }
    const size_t kstep = (size_t)(BK * 2);
    const size_t hstep = (size_t)HALF * K * 2;
    const size_t tstep = 2 * hstep;
    const unsigned ldsw = (unsigned)wid * 1024u;
    const int aoff = lds_byte(wr * 64 + fr, fq * 8), boff = lds_byte(wc * 32 + fr, fq * 8);
#define PG8_SA(b, h) (((b) * 2 + (h)) * HTB)
#define PG8_SB(b, h) ((4 + (b) * 2 + (h)) * HTB)
#define PG8_STAGE(bufoff, gbase, voff) do { _Pragma("unroll") for (int _i = 0; _i < 2; ++_i) \
        __builtin_amdgcn_global_load_lds((const unsigned*)((const char*)(gbase) + (voff)[_i]), (PG8_LAS unsigned*)(lds + (bufoff) + ldsw + _i * 8192), 16, 0, 0); } while (0)
#define PG8_LDA(dst, b, h) do { _Pragma("unroll") for (int m = 0; m < 4; ++m) _Pragma("unroll") for (int k = 0; k < 2; ++k) dst[m][k] = *(const PG8_LAS bf16x8*)(lds + PG8_SA(b, h) + aoff + m * 2048 + k * 1024); } while (0)
#define PG8_LDB(dst, b, h) do { _Pragma("unroll") for (int n = 0; n < 2; ++n) _Pragma("unroll") for (int k = 0; k < 2; ++k) dst[n][k] = *(const PG8_LAS bf16x8*)(lds + PG8_SB(b, h) + boff + n * 2048 + k * 1024); } while (0)
#define PG8_MMA(ai, bj, At, Bt) do { __builtin_amdgcn_s_setprio(1); _Pragma("unroll") for (int m = 0; m < 4; ++m) _Pragma("unroll") for (int n = 0; n < 2; ++n) _Pragma("unroll") for (int k = 0; k < 2; ++k) \
        acc[ai][bj][m][n] = __builtin_amdgcn_mfma_f32_16x16x32_bf16(Bt[n][k], At[m][k], acc[ai][bj][m][n], 0, 0, 0); __builtin_amdgcn_s_setprio(0); } while (0)
#define PG8_WAIT_V(n) asm volatile("s_waitcnt vmcnt(" #n ")" ::: "memory")
#define PG8_WAIT_L(n) asm volatile("s_waitcnt lgkmcnt(" #n ")" ::: "memory")
#define PG8_BAR __builtin_amdgcn_s_barrier()
#define PG8_SCHED __builtin_amdgcn_sched_barrier(0)
    Unit cur, nxt; int ui = 0;
    if (!S.next(0, cur)) return;
    f32x4 acc[2][2][4][2];
#pragma unroll
    for (int a = 0; a < 2; ++a)
#pragma unroll
        for (int b = 0; b < 2; ++b)
#pragma unroll
            for (int m = 0; m < 4; ++m)
#pragma unroll
                for (int n = 0; n < 2; ++n) acc[a][b][m][n] = (f32x4){0.f, 0.f, 0.f, 0.f};
    bf16x8 At[4][2], B0[2][2], B1[2][2];
    const char* cA = (const char*)g.A + (size_t)cur.pm * tstep; const char* cB = (const char*)g.Bt + (size_t)cur.pn * tstep;
    S.a_ready(cur);
    if constexpr (SP2) {
        PG8_STAGE(PG8_SB(0, 0), cB, voffB); PG8_STAGE(PG8_SB(0, 1), cB + hstep, voffB); PG8_STAGE(PG8_SA(0, 0), cA, voffA); PG8_STAGE(PG8_SA(0, 1), cA + hstep, voffA);
        if (wr == 1) PG8_BAR;
        PG8_WAIT_V(2); PG8_BAR;
        PG8_STAGE(PG8_SB(1, 0), cB + kstep, voffB); PG8_STAGE(PG8_SA(1, 0), cA + kstep, voffA); PG8_STAGE(PG8_SB(1, 1), cB + hstep + kstep, voffB);
        PG8_WAIT_V(6); PG8_BAR;
    } else {
        PG8_STAGE(PG8_SB(0, 0), cB, voffB); PG8_STAGE(PG8_SA(0, 0), cA, voffA); PG8_STAGE(PG8_SB(0, 1), cB + hstep, voffB); PG8_STAGE(PG8_SA(0, 1), cA + hstep, voffA);
        if (wr == 1) PG8_BAR;
        PG8_WAIT_V(4); PG8_BAR;
        PG8_STAGE(PG8_SB(1, 0), cB + kstep, voffB); PG8_STAGE(PG8_SA(1, 0), cA + kstep, voffA); PG8_STAGE(PG8_SB(1, 1), cB + hstep + kstep, voffB);
        PG8_WAIT_V(6); PG8_BAR;
    }
    for (;;) {
        const bool has_next = S.next(ui + 1, nxt);
        const char* nA = has_next ? (const char*)g.A + (size_t)nxt.pm * tstep : cA; const char* nB = has_next ? (const char*)g.Bt + (size_t)nxt.pn * tstep : cB;
        for (int t = 0; t < nt; t += 2) {
            const bool last = (t == nt - 2);
            const char* a1 = cA + (size_t)(t + 1) * kstep;
            const char* a2 = last ? nA : cA + (size_t)(t + 2) * kstep; const char* b2 = last ? nB : cB + (size_t)(t + 2) * kstep;
            const char* a3 = a2 + kstep; const char* b3 = b2 + kstep;
            if (last && has_next) S.a_ready(nxt);
            if constexpr (SP2) {
            PG8_LDB(B0, 0, 0); PG8_LDB(B1, 0, 1); PG8_SCHED; PG8_LDA(At, 0, 0); PG8_STAGE(PG8_SA(1, 1), a1 + hstep, voffA);
            PG8_WAIT_V(8); PG8_WAIT_L(0); PG8_BAR; PG8_MMA(0, 0, At, B0); PG8_MMA(0, 1, At, B1); PG8_BAR; PG8_SCHED;
            PG8_LDA(At, 0, 1); PG8_STAGE(PG8_SB(0, 0), b2, voffB); PG8_STAGE(PG8_SB(0, 1), b2 + hstep, voffB); PG8_STAGE(PG8_SA(0, 0), a2, voffA);
            PG8_WAIT_V(8); PG8_WAIT_L(0); PG8_BAR; PG8_MMA(1, 0, At, B0); PG8_MMA(1, 1, At, B1); PG8_BAR; PG8_SCHED;
            PG8_LDB(B0, 1, 0); PG8_LDB(B1, 1, 1); PG8_SCHED; PG8_LDA(At, 1, 0); PG8_STAGE(PG8_SA(0, 1), a2 + hstep, voffA);
            PG8_WAIT_V(8); PG8_WAIT_L(0); PG8_BAR; PG8_MMA(0, 0, At, B0); PG8_MMA(0, 1, At, B1); PG8_BAR; PG8_SCHED;
            PG8_LDA(At, 1, 1); PG8_STAGE(PG8_SB(1, 0), b3, voffB); PG8_STAGE(PG8_SB(1, 1), b3 + hstep, voffB); PG8_STAGE(PG8_SA(1, 0), a3, voffA);
            PG8_WAIT_V(8); PG8_WAIT_L(0); PG8_BAR; PG8_MMA(1, 0, At, B0); PG8_MMA(1, 1, At, B1); PG8_BAR; PG8_SCHED;
            } else {
            PG8_LDB(B0, 0, 0); PG8_SCHED; PG8_LDA(At, 0, 0); PG8_STAGE(PG8_SA(1, 1), a1 + hstep, voffA);
            PG8_WAIT_L(8); PG8_BAR; PG8_WAIT_L(0); PG8_MMA(0, 0, At, B0); PG8_BAR; PG8_SCHED;
            PG8_LDB(B1, 0, 1); PG8_STAGE(PG8_SB(0, 0), b2, voffB);
            PG8_BAR; PG8_WAIT_L(0); PG8_MMA(0, 1, At, B1); PG8_BAR;
            PG8_LDA(At, 0, 1); PG8_STAGE(PG8_SA(0, 0), a2, voffA);
            PG8_BAR; PG8_WAIT_L(0); PG8_MMA(1, 0, At, B0); PG8_BAR; PG8_SCHED;
            PG8_STAGE(PG8_SB(0, 1), b2 + hstep, voffB);
            PG8_WAIT_V(6); PG8_BAR; PG8_MMA(1, 1, At, B1); PG8_BAR;
            PG8_LDB(B0, 1, 0); PG8_SCHED; PG8_LDA(At, 1, 0); PG8_STAGE(PG8_SA(0, 1), a2 + hstep, voffA);
            PG8_WAIT_L(8); PG8_BAR; PG8_WAIT_L(0); PG8_MMA(0, 0, At, B0); PG8_BAR; PG8_SCHED;
            PG8_LDB(B1, 1, 1); PG8_STAGE(PG8_SB(1, 0), b3, voffB);
            PG8_BAR; PG8_WAIT_L(0); PG8_MMA(0, 1, At, B1); PG8_BAR;
            PG8_LDA(At, 1, 1); PG8_STAGE(PG8_SA(1, 0), a3, voffA);
            PG8_BAR; PG8_WAIT_L(0); PG8_MMA(1, 0, At, B0); PG8_BAR; PG8_SCHED;
            PG8_STAGE(PG8_SB(1, 1), b3 + hstep, voffB);
            PG8_WAIT_V(6); PG8_BAR; PG8_MMA(1, 1, At, B1); PG8_BAR;
            }
        }
        if constexpr (ALIGN_EPI) { if (wr == 0) PG8_BAR; }
        E(acc, cur, wr, wc, fr, fq); S.done(cur);
        if (!has_next) break;
#pragma unroll
        for (int a = 0; a < 2; ++a)
#pragma unroll
            for (int b = 0; b < 2; ++b)
#pragma unroll
                for (int m = 0; m < 4; ++m)
#pragma unroll
                    for (int n = 0; n < 2; ++n) acc[a][b][m][n] = (f32x4){0.f, 0.f, 0.f, 0.f};
        cur = nxt; cA = nA; cB = nB; ++ui;
        if constexpr (ALIGN_EPI) { if (wr == 1) PG8_BAR; }
    }
    PG8_WAIT_V(0);
    if constexpr (!ALIGN_EPI) { if (wr == 0) PG8_BAR; }
    PG8_BAR;
#undef PG8_SA
#undef PG8_SB
#undef PG8_STAGE
#undef PG8_LDA
#undef PG8_LDB
#undef PG8_MMA
#undef PG8_WAIT_V
#undef PG8_WAIT_L
#undef PG8_BAR
#undef PG8_SCHED
}
}

constexpr int NWAVES = 8;
constexpr int DM = 1024, BP = 8, SEQ = 2048, NMETA = 16, TP = SEQ + NMETA, BS = 128, TS = 4;
constexpr int RP = BP * TP;
constexpr int RS = BS * TS;
constexpr int MR = RP + RS;
constexpr int MP = 17152;
constexpr int M2 = BP * SEQ + RS;
constexpr int NH = 8, DH = 128, DQKV = 3072, DFF = 4096, KC = 31, KS = 4;
constexpr int NIN = 8448;
constexpr int DIN = 8208;
constexpr float EPS = 1e-6f;

constexpr size_t O_YP = 0, O_YS = 16777216, O_PC = 17301504, O_PQ = 17547264, O_PD = 17620992, O_SC = 18669568, O_SQ = 22601728, O_SD = 23781376, O_END = 40558592;

constexpr size_t MiB = 1u << 20;
constexpr size_t WS_CTL = 0, CTL_ZERO_BYTES = 1 * MiB;
constexpr size_t WS_BETAG = 1 * MiB;
constexpr size_t WS_LASTV = 9 * MiB / 4;
constexpr size_t WS_HALOQ = 5 * MiB / 2;
constexpr size_t WS_WC = 29 * MiB / 4, WS_WD = WS_WC + 2 * MiB, WS_WO = WS_WD + 2 * MiB, WS_WUP = WS_WO + 2 * MiB, WS_WDN = WS_WUP + 8 * MiB;
constexpr size_t WS_GLU = 117 * MiB / 4;
constexpr size_t WS_QKVB = 63 * MiB;
constexpr size_t WS_QS = 162 * MiB;
constexpr size_t WS_ZS = 165 * MiB;
constexpr size_t WS_H = 397 * MiB / 2;
constexpr size_t WS_WIN = 232 * MiB;
constexpr size_t WS_HALOC = 497 * MiB / 2;
constexpr size_t WS_KDT = WS_H, WS_ATTN = 463 * MiB / 2;
constexpr size_t WS_MIX = WS_QKVB, WS_XG = WS_GLU, WS_HM = WS_QKVB, WS_C = WS_GLU;
constexpr size_t WS_END = 256 * MiB;
constexpr int NRUN = 16, RUNL = TP / NRUN;
static_assert(TP - 64 * 32 == 16 && NRUN * RUNL == TP && WS_HALOC + (size_t)BP * NRUN * 30 * DM * 2 <= WS_END, "conv runs");
constexpr int NCH = 33, QBLK = 3 * 64 * 128;
static_assert(WS_WIN + (size_t)NIN * DM * 2 <= WS_HALOC && WS_WDN + 8 * MiB <= WS_GLU && WS_GLU + (size_t)MP * DM * 2 <= WS_QKVB && WS_HALOQ + (size_t)BP * 33 * 3 * 3072 * 2 <= WS_WC, "ws map");
static_assert(WS_ZS + (size_t)MP * DM * 2 <= WS_H && WS_H + (size_t)MP * DM * 2 <= WS_WIN, "ws map 2");
static_assert(WS_QKVB + (size_t)BP * NCH * NH * QBLK * 2 <= WS_QS, "ws map qkvb");
static_assert(WS_HM + (size_t)M2 * DFF * 2 <= WS_H, "ws map hm");
static_assert(WS_KDT + (size_t)BP * NCH * NH * 8192 * 2 <= WS_ATTN && WS_ATTN + (size_t)BP * NCH * NH * 4096 * 2 <= WS_HALOC, "ws map kdt");
constexpr int CW_TMO = 0, CW_CODE = 1, CW_BAR = 4096;

constexpr int RING_OFF = 0, RING_BYTES = 131072;
constexpr int LDSCTL_OFF = 151552, MISC_OFF = LDSCTL_OFF + 320;
constexpr int LDS_BYTES = LDSCTL_OFF + 1024;

#define GAS __attribute__((address_space(1)))
#define LAS __attribute__((address_space(3)))
typedef unsigned short bf16;
typedef unsigned v4u __attribute__((ext_vector_type(4)));
typedef unsigned v2u __attribute__((ext_vector_type(2)));
typedef float f32x4 __attribute__((ext_vector_type(4)));
typedef float f32x2 __attribute__((ext_vector_type(2)));
typedef GAS unsigned gu32;
#define RLX_AGENT __ATOMIC_RELAXED, __HIP_MEMORY_SCOPE_AGENT
#define LDS_WAIT() asm volatile("s_waitcnt lgkmcnt(0)" ::: "memory")
#define VM_WAIT() asm volatile("s_waitcnt vmcnt(0)" ::: "memory")
__device__ __forceinline__ unsigned f2bf(float f) { unsigned u = __builtin_bit_cast(unsigned, f); return (u + 0x7fffu + ((u >> 16) & 1u)) >> 16; }
__device__ __forceinline__ unsigned pk2(float lo, float hi) { return f2bf(lo) | (f2bf(hi) << 16); }
__device__ __forceinline__ float bflo(unsigned w) { return __builtin_bit_cast(float, w << 16); }
__device__ __forceinline__ float bfhi(unsigned w) { return __builtin_bit_cast(float, w & 0xffff0000u); }
__device__ __forceinline__ float bf1(bf16 b) { return __builtin_bit_cast(float, ((unsigned)b) << 16); }
__device__ __forceinline__ float sigmoidf_(float x) { return __builtin_amdgcn_rcpf(1.f + __expf(-x)); }
__device__ __forceinline__ float siluf_(float x) { return x * sigmoidf_(x); }

#define XB_TMO      128
#define XB_XCNT(j)  (256  + 64 * (j))
#define XB_XSUB(j)  (1280 + 64 * (j))
#define XB_XGEN(j)  (2304 + 64 * (j))
#define XB_TOP      3328
#define XB_TOPGEN   3392
#define XCD_BAR_WORDS 3456
#define XB_SPIN_CAP (1u << 18)
__device__ __forceinline__ unsigned xb_ld(unsigned* p)              { return __hip_atomic_load(p, __ATOMIC_RELAXED, __HIP_MEMORY_SCOPE_AGENT); }
__device__ __forceinline__ unsigned xb_add(unsigned* p, unsigned v) { return __hip_atomic_fetch_add(p, v, __ATOMIC_RELAXED, __HIP_MEMORY_SCOPE_AGENT); }
__device__ __forceinline__ unsigned xb_xcc_id() { return (unsigned)__builtin_amdgcn_s_getreg((3 << 11) | 20) & 0xFu; }
#define XB_SPIN(cond, bar) do { unsigned _sp = 0; while (cond) { __builtin_amdgcn_s_sleep(1); \
    if ((++_sp & 255u) == 0u) { if (xb_ld(&(bar)[XB_TMO])) break; if (_sp > XB_SPIN_CAP) { atomicAdd(&(bar)[XB_TMO], 1u); break; } } } } while (0)
struct XcdBarrier { unsigned* bar; unsigned x; volatile LAS unsigned* st; };
__device__ __forceinline__ XcdBarrier xcd_barrier_post(unsigned* bar, volatile LAS unsigned* st) {
    XcdBarrier b; b.bar = bar; b.x = xb_xcc_id(); b.st = st;
    if (threadIdx.x == 0) (void)xb_add(&bar[XB_XCNT(b.x)], 1u);
    return b;
}
__device__ __forceinline__ void xcd_barrier_complete(unsigned* bar, unsigned x, unsigned& nloc, unsigned& nx) {
    const unsigned G = gridDim.x * gridDim.y * gridDim.z;
    unsigned sum, cnt, mine, sp = 0u;
    for (;;) {
        sum = 0u; cnt = 0u; mine = 0u;
#pragma unroll
        for (unsigned j = 0; j < 16; ++j) { const unsigned c = xb_ld(&bar[XB_XCNT(j)]); sum += c; cnt += (c > 0u) ? 1u : 0u; mine = (j == x) ? c : mine; }
        if (sum == G) break;
        __builtin_amdgcn_s_sleep(1);
        if ((++sp & 255u) == 0u) { if (xb_ld(&bar[XB_TMO])) break; if (sp > XB_SPIN_CAP) { atomicAdd(&bar[XB_TMO], 1u); break; } }
    }
    nloc = mine > 0u ? mine : 1u; nx = cnt > 0u ? cnt : 1u;
}
__device__ __forceinline__ void xcd_barrier(const XcdBarrier& b) {
    asm volatile("s_waitcnt vmcnt(0)" ::: "memory");
    __syncthreads();
    if (threadIdx.x == 0) {
        unsigned* bar = b.bar;
        __builtin_amdgcn_s_waitcnt(0);
        unsigned nloc = b.st[0], nx = b.st[1];
        if (nloc == 0u) { xcd_barrier_complete(bar, b.x, nloc, nx); b.st[0] = nloc; b.st[1] = nx; }
        const unsigned old = xb_add(&bar[XB_XSUB(b.x)], 1u);
        const unsigned gen = old / nloc;
        if (old + 1u == (gen + 1u) * nloc) {
            __builtin_amdgcn_fence(__ATOMIC_RELEASE, "agent");
            asm volatile("s_waitcnt vmcnt(0)" ::: "memory");
            const unsigned og = xb_add(&bar[XB_TOP], 1u);
            const unsigned tg = og / nx;
            if (og + 1u == (tg + 1u) * nx) xb_add(&bar[XB_TOPGEN], 1u);
            else XB_SPIN(xb_ld(&bar[XB_TOPGEN]) == tg, bar);
            __builtin_amdgcn_fence(__ATOMIC_ACQUIRE, "agent");
            xb_add(&bar[XB_XGEN(b.x)], 1u);
            asm volatile("s_waitcnt vmcnt(0)" ::: "memory");
        } else {
            XB_SPIN(xb_ld(&bar[XB_XGEN(b.x)]) == gen, bar);
            __builtin_amdgcn_fence(__ATOMIC_ACQUIRE, "agent");
            asm volatile("s_waitcnt vmcnt(0)" ::: "memory");
        }
    }
    __syncthreads();
}

struct Args { const float* in[23]; float* out; unsigned char* ws; int ph_lo, ph_hi; };

#define DPP_ADD(v, ctrl, rmask, bc) v += __builtin_bit_cast(float, __builtin_amdgcn_update_dpp(0, __builtin_bit_cast(int, v), ctrl, rmask, 0xF, bc))
__device__ __forceinline__ float sum16(float v) {
    DPP_ADD(v, 0xB1, 0xF, true); DPP_ADD(v, 0x4E, 0xF, true); DPP_ADD(v, 0x141, 0xF, true); DPP_ADD(v, 0x140, 0xF, true); return v; }
__device__ __forceinline__ float wave_sum(float v) {
    v = sum16(v); DPP_ADD(v, 0x142, 0xA, false); DPP_ADD(v, 0x143, 0xC, false);
    return __builtin_bit_cast(float, __builtin_amdgcn_readlane(__builtin_bit_cast(int, v), 63)); }
__device__ __forceinline__ float rsqf(float x) { return __builtin_amdgcn_rsqf(x); }
__device__ __forceinline__ unsigned cvtpk(float lo, float hi) { unsigned r; asm("v_cvt_pk_bf16_f32 %0, %1, %2" : "=v"(r) : "v"(lo), "v"(hi)); return r; }
__device__ __forceinline__ int compact_row(int r) {
    if (r >= MR) return -1;
    if (r >= RP) return r - RP + BP * SEQ;
    const int b = r / TP, t = r - b * TP;
    return t < NMETA ? -1 : r - NMETA * (b + 1);
}

__device__ __forceinline__ void p0_transpose_item(const float* W, int Nsrc, int K, bf16* WT, int dst_row0, int src_col0, int nvalid, int k0, int lane) {
    const float* src = W + (size_t)k0 * Nsrc + src_col0 + (lane < nvalid ? lane : 0);
    float v[32];
#pragma unroll
    for (int j = 0; j < 32; ++j) v[j] = src[(size_t)j * Nsrc];
    if (lane >= nvalid) {
#pragma unroll
        for (int j = 0; j < 32; ++j) v[j] = 0.f; }
    GAS v4u* dst = (GAS v4u*)(WT + (size_t)(dst_row0 + lane) * K + k0);
#pragma unroll
    for (int q = 0; q < 4; ++q) { v4u o; o.x = cvtpk(v[8 * q], v[8 * q + 1]); o.y = cvtpk(v[8 * q + 2], v[8 * q + 3]); o.z = cvtpk(v[8 * q + 4], v[8 * q + 5]); o.w = cvtpk(v[8 * q + 6], v[8 * q + 7]); dst[q] = o; }
}
__device__ __forceinline__ void win_src(int nb, int& src, int& nvalid) {
    const int pn = nb >> 2, o = (nb & 3) * 64; nvalid = 64;
    if (pn < 8) src = (o < 128) ? 128 * pn + o : 1024 + 128 * pn + (o - 128);
    else if (pn < 20) src = 2048 + 256 * (pn - 8) + o;
    else if (pn < 24) src = 5120 + 256 * (pn - 20) + o;
    else if (pn < 28) src = 6160 + 256 * (pn - 24) + o;
    else if (pn < 32) src = 7184 + 256 * (pn - 28) + o;
    else { src = 6144; nvalid = (o == 0) ? 16 : 0; }
}
__device__ __forceinline__ void rms_row_to_bf16(const float* xrow, const float* gain, bf16* orow, int lane) {
    const GAS f32x4* xr = (const GAS f32x4*)xrow + lane; const GAS f32x4* gr = (const GAS f32x4*)gain + lane;
    f32x4 v[4]; float s = 0.f;
#pragma unroll
    for (int j = 0; j < 4; ++j) { v[j] = xr[64 * j]; s += (v[j].x * v[j].x + v[j].y * v[j].y) + (v[j].z * v[j].z + v[j].w * v[j].w); }
    const float rstd = 1.f / sqrtf(wave_sum(s) * (1.f / DM) + EPS);
    GAS unsigned long long* o8 = (GAS unsigned long long*)orow + lane;
#pragma unroll
    for (int j = 0; j < 4; ++j) { const f32x4 g = gr[64 * j]; o8[64 * j] = (unsigned long long)pk2(v[j].x * rstd * g.x, v[j].y * rstd * g.y) | ((unsigned long long)pk2(v[j].z * rstd * g.z, v[j].w * rstd * g.w) << 32); }
}

typedef pg8::f32x4 A4;
struct EpiIn {
    static constexpr bool PERM = true;
    bf16 *GLU, *QKVB, *QS, *HALOQ, *HALOC, *ZS, *SGC, *SGD; float* BETAG; const float *a_log, *dt_bias;
    __device__ __forceinline__ void operator()(const A4 (&acc)[2][2][4][2], const pg8::Unit& u, int wr, int wc, int fr, int fq) const {
        const int pn = u.pn, row0 = u.pm * 256 + wr * 64 + fr, cw = 32 * wc + 8 * fq;
        if (pn < 8) {
#pragma unroll
            for (int ai = 0; ai < 2; ++ai)
#pragma unroll
                for (int m = 0; m < 4; ++m) { const int r = row0 + ai * 128 + m * 16; float o[8];
#pragma unroll
                    for (int n = 0; n < 2; ++n)
#pragma unroll
                        for (int j = 0; j < 4; ++j) o[4 * n + j] = acc[ai][0][m][n][j] * sigmoidf_(acc[ai][1][m][n][j]);
                    v4u w; w.x = pk2(o[0], o[1]); w.y = pk2(o[2], o[3]); w.z = pk2(o[4], o[5]); w.w = pk2(o[6], o[7]);
                    *(GAS v4u*)(GLU + (size_t)r * DM + 128 * pn + cw) = w;
                    if (r < RP) { const int b = r / TP, t = r - b * TP, run = t / RUNL, pos = t - run * RUNL;
                        if (pos >= RUNL - 30 && run < NRUN - 1) *(GAS v4u*)(HALOC + ((size_t)(b * NRUN + run) * 30 + (pos - (RUNL - 30))) * DM + 128 * pn + cw) = w; } }
        } else if (pn < 20) {
            const int colb = 256 * (pn - 8);
#pragma unroll
            for (int ai = 0; ai < 2; ++ai)
#pragma unroll
                for (int m = 0; m < 4; ++m) { const int r = row0 + ai * 128 + m * 16; if (r >= MR) continue;
#pragma unroll
                    for (int bj = 0; bj < 2; ++bj) { const int col = colb + 128 * bj + cw;
                        const A4 a0 = acc[ai][bj][m][0], a1 = acc[ai][bj][m][1];
                        v4u w; w.x = pk2(a0[0], a0[1]); w.y = pk2(a0[2], a0[3]); w.z = pk2(a1[0], a1[1]); w.w = pk2(a1[2], a1[3]);
                        if (r >= RP) *(GAS v4u*)(QS + (size_t)(r - RP) * DQKV + col) = w;
                        else { const int b = r / TP, t = r - b * TP, c = t >> 6, i = t & 63, which = col >> 10, h = (col >> 7) & 7, d = col & 127;
                            *(GAS v4u*)(QKVB + ((size_t)((b * NCH + c) * NH + h) * 3 + which) * 8192 + i * 128 + d) = w;
                            if (i >= 61) *(GAS v4u*)(HALOQ + ((size_t)(b * NCH + c) * 3 + (i - 61)) * DQKV + col) = w; } } }
        } else if (pn < 24) {
            constexpr bool isz = true; bf16* dst = ZS; const int ld = DM, cb = 256 * (pn - 20);
#pragma unroll
            for (int ai = 0; ai < 2; ++ai)
#pragma unroll
                for (int m = 0; m < 4; ++m) { const int r = row0 + ai * 128 + m * 16;
#pragma unroll
                    for (int bj = 0; bj < 2; ++bj) { float o[8];
#pragma unroll
                        for (int n = 0; n < 2; ++n)
#pragma unroll
                            for (int j = 0; j < 4; ++j) { const float v = acc[ai][bj][m][n][j]; o[4 * n + j] = isz ? siluf_(v) : v; }
                        v4u w; w.x = pk2(o[0], o[1]); w.y = pk2(o[2], o[3]); w.z = pk2(o[4], o[5]); w.w = pk2(o[6], o[7]);
                        *(GAS v4u*)(dst + (size_t)r * ld + cb + 128 * bj + cw) = w; } }
        } else if (pn < 32) {
            bf16* dst = pn < 28 ? SGC : SGD; const int cb = 256 * ((pn - 24) & 3);
#pragma unroll
            for (int ai = 0; ai < 2; ++ai)
#pragma unroll
                for (int m = 0; m < 4; ++m) { const int rc = compact_row(row0 + ai * 128 + m * 16); if (rc < 0) continue;
#pragma unroll
                    for (int bj = 0; bj < 2; ++bj) { float o[8];
#pragma unroll
                        for (int n = 0; n < 2; ++n)
#pragma unroll
                            for (int j = 0; j < 4; ++j) o[4 * n + j] = sigmoidf_(acc[ai][bj][m][n][j]);
                        v4u w; w.x = pk2(o[0], o[1]); w.y = pk2(o[2], o[3]); w.z = pk2(o[4], o[5]); w.w = pk2(o[6], o[7]);
                        *(GAS v4u*)(dst + (size_t)rc * DM + cb + 128 * bj + cw) = w; } }
        } else {
            if (wc == 0 && fq < 2) {
#pragma unroll
                for (int ai = 0; ai < 2; ++ai)
#pragma unroll
                    for (int m = 0; m < 4; ++m) { const int r = row0 + ai * 128 + m * 16; float o[8];
#pragma unroll
                        for (int n = 0; n < 2; ++n)
#pragma unroll
                            for (int j = 0; j < 4; ++j) { const int h = 4 * n + j; const float v = acc[ai][0][m][n][j];
                                if (fq == 0) o[h] = 1.f / (1.f + expf(-v));
                                else { const float xx = v + dt_bias[h]; const float sp = xx > 20.f ? xx : log1pf(expf(xx)); o[h] = -expf(a_log[h]) * sp; } }
                        GAS f32x4* p = (GAS f32x4*)(BETAG + (size_t)r * 16 + 8 * fq);
                        p[0] = (f32x4){o[0], o[1], o[2], o[3]}; p[1] = (f32x4){o[4], o[5], o[6], o[7]}; }
            }
        }
    }
};
template <int MODE> struct EpiGate {
    static constexpr bool PERM = true;
    bf16 *SG, *MA, *OUT;
    __device__ __forceinline__ void operator()(const A4 (&acc)[2][2][4][2], const pg8::Unit& u, int wr, int wc, int fr, int fq) const {
        const int row0 = u.pm * 256 + wr * 64 + fr, c0 = 256 * u.pn + 32 * wc + 8 * fq;
#pragma unroll
        for (int ai = 0; ai < 2; ++ai)
#pragma unroll
            for (int m = 0; m < 4; ++m) { const int rc = compact_row(row0 + ai * 128 + m * 16); if (rc < 0) continue;
#pragma unroll
                for (int bj = 0; bj < 2; ++bj) { const size_t off = (size_t)rc * DM + c0 + 128 * bj;
                    const v4u g = *(const GAS v4u*)(SG + off); float o[8];
                    const A4 a0 = acc[ai][bj][m][0], a1 = acc[ai][bj][m][1];
                    o[0] = bflo(g.x) * a0[0]; o[1] = bfhi(g.x) * a0[1]; o[2] = bflo(g.y) * a0[2]; o[3] = bfhi(g.y) * a0[3];
                    o[4] = bflo(g.z) * a1[0]; o[5] = bfhi(g.z) * a1[1]; o[6] = bflo(g.w) * a1[2]; o[7] = bfhi(g.w) * a1[3];
                    if (MODE == 1) { const v4u q = *(const GAS v4u*)(MA + off);
                        o[0] += bflo(q.x); o[1] += bfhi(q.x); o[2] += bflo(q.y); o[3] += bfhi(q.y); o[4] += bflo(q.z); o[5] += bfhi(q.z); o[6] += bflo(q.w); o[7] += bfhi(q.w); }
                    v4u w; w.x = pk2(o[0], o[1]); w.y = pk2(o[2], o[3]); w.z = pk2(o[4], o[5]); w.w = pk2(o[6], o[7]);
                    *(GAS v4u*)(OUT + off) = w; } }
    }
};
template <int MODE> struct EpiRes {
    static constexpr bool PERM = false;
    const float *xp, *xs; float* out;
    __device__ __forceinline__ void operator()(const A4 (&acc)[2][2][4][2], const pg8::Unit& u, int wr, int wc, int fr, int fq) const {
        const int row0 = u.pm * 256 + wr * 64 + fr, c0 = 256 * u.pn + 32 * wc + 4 * fq;
#pragma unroll
        for (int ai = 0; ai < 2; ++ai)
#pragma unroll
            for (int m = 0; m < 4; ++m) { const int r = row0 + ai * 128 + m * 16;
                const float* base = MODE == 0 ? (r < BP * SEQ ? xp + (size_t)r * DM : xs + (size_t)(r - BP * SEQ) * DM) : out + (size_t)r * DM;
                float* orow = out + (size_t)r * DM;
#pragma unroll
                for (int bj = 0; bj < 2; ++bj)
#pragma unroll
                    for (int n = 0; n < 2; ++n) { const int c = c0 + 128 * bj + 16 * n; const f32x4 b = *(const GAS f32x4*)(base + c); *(GAS f32x4*)(orow + c) = b + acc[ai][bj][m][n]; } }
    }
};
struct EpiUp {
    static constexpr bool PERM = true;
    bf16* HM;
    __device__ __forceinline__ void operator()(const A4 (&acc)[2][2][4][2], const pg8::Unit& u, int wr, int wc, int fr, int fq) const {
        const int row0 = u.pm * 256 + wr * 64 + fr, c0 = 256 * u.pn + 32 * wc + 8 * fq;
#pragma unroll
        for (int ai = 0; ai < 2; ++ai)
#pragma unroll
            for (int m = 0; m < 4; ++m) { const int r = row0 + ai * 128 + m * 16;
#pragma unroll
                for (int bj = 0; bj < 2; ++bj) { float o[8];
#pragma unroll
                    for (int n = 0; n < 2; ++n)
#pragma unroll
                        for (int j = 0; j < 4; ++j) { const float v = fmaxf(acc[ai][bj][m][n][j], 0.f); o[4 * n + j] = v * v; }
                    v4u w; w.x = pk2(o[0], o[1]); w.y = pk2(o[2], o[3]); w.z = pk2(o[4], o[5]); w.w = pk2(o[6], o[7]);
                    *(GAS v4u*)(HM + (size_t)r * DFF + c0 + 128 * bj) = w; } }
    }
};

template <int KIND>
__device__ __forceinline__ void conv_unit(const Args& a, LAS unsigned char* lds, int b, int run) {
    asm volatile("" ::: "memory");
    const int tid = threadIdx.x, lane = tid & 63, wave = tid >> 6; int ch = 2 * tid; asm volatile("" : "+v"(ch));
    unsigned char* ws = a.ws;
    bf16* GC = (bf16*)(ws + WS_GLU); const bf16* HALOC = (const bf16*)(ws + WS_HALOC);
    const float* w_dw = a.in[8];
    LAS float* red = (LAS float*)lds;
    constexpr int NTOK = KIND == 0 ? RUNL : TS, NSTEP = (NTOK + 3) / 4, REM = NTOK - 4 * (NSTEP - 1);
    f32x2 w[KC]; unsigned E[KC + 3];
#pragma unroll
    for (int i = 0; i < KC; ++i) w[i] = *(const GAS f32x2*)(w_dw + (size_t)i * DM + ch);
    const f32x2 bdw = *(const GAS f32x2*)(a.in[9] + ch), lng = *(const GAS f32x2*)(a.in[10] + ch), lnb = *(const GAS f32x2*)(a.in[11] + ch);
    const int row0 = KIND == 0 ? b * TP + run * RUNL : RP + b * TS;
    if (KIND == 0) {
#pragma unroll
        for (int i = 0; i < KC - 1; ++i) { unsigned v = *(const GAS unsigned*)(HALOC + ((size_t)(b * NRUN + (run > 0 ? run - 1 : 0)) * 30 + i) * DM + ch); E[i] = run > 0 ? v : 0u; }
    } else { const float* st = a.in[2] + (size_t)b * (KC - 1) * DM;
#pragma unroll
        for (int i = 0; i < KC - 1; ++i) { const f32x2 v = *(const GAS f32x2*)(st + (size_t)i * DM + ch); E[i] = pk2(v.x, v.y); }
    }
    unsigned nx[4];
#pragma unroll
    for (int k = 0; k < 4; ++k) nx[k] = *(const GAS unsigned*)(GC + (size_t)(row0 + (k < NTOK ? k : NTOK - 1)) * DM + ch);
    for (int st4 = 0; st4 < NSTEP; ++st4) {
        const int t0 = 4 * st4;
#pragma unroll
        for (int k = 0; k < 4; ++k) E[KC - 1 + k] = nx[k];
        if (st4 + 1 < NSTEP) {
#pragma unroll
            for (int k = 0; k < 4; ++k) { const int t = t0 + 4 + k; nx[k] = *(const GAS unsigned*)(GC + (size_t)(row0 + (t < NTOK ? t : NTOK - 1)) * DM + ch); }
        }
        f32x2 y[4] = {bdw, bdw, bdw, bdw};
#pragma unroll
        for (int j = 0; j < KC + 3; ++j) { const f32x2 e = {bflo(E[j]), bfhi(E[j])};
#pragma unroll
            for (int k = 0; k < 4; ++k) { const int i = j - k; if (i >= 0 && i < KC) y[k] += w[i] * e; } }
        float sv[8];
#pragma unroll
        for (int k = 0; k < 4; ++k) { sv[2 * k] = wave_sum(y[k].x + y[k].y); sv[2 * k + 1] = wave_sum(y[k].x * y[k].x + y[k].y * y[k].y); }
        LAS float* rb = red + (st4 & 1) * 64;
        if (lane == 0) { *(LAS f32x4*)(rb + wave * 8) = (f32x4){sv[0], sv[1], sv[2], sv[3]}; *(LAS f32x4*)(rb + wave * 8 + 4) = (f32x4){sv[4], sv[5], sv[6], sv[7]}; }
        __syncthreads();
        f32x4 ta = {0.f, 0.f, 0.f, 0.f}, tb = {0.f, 0.f, 0.f, 0.f};
#pragma unroll
        for (int i = 0; i < 8; ++i) { ta += *(const LAS f32x4*)(rb + i * 8); tb += *(const LAS f32x4*)(rb + i * 8 + 4); }
        const float tt[8] = {ta.x, ta.y, ta.z, ta.w, tb.x, tb.y, tb.z, tb.w};
#pragma unroll
        for (int k = 0; k < 4; ++k) { if (t0 + k < NTOK) {
            const float mu = tt[2 * k] * (1.f / DM), var = fmaxf(tt[2 * k + 1] * (1.f / DM) - mu * mu, 0.f), rstd = rsqf(var + EPS);
            const float z0 = (y[k].x - mu) * rstd * lng.x + lnb.x, z1 = (y[k].y - mu) * rstd * lng.y + lnb.y;
            *(GAS unsigned*)(GC + (size_t)(row0 + t0 + k) * DM + ch) = pk2(siluf_(z0), siluf_(z1)); } }
        if (st4 + 1 < NSTEP) {
#pragma unroll
            for (int i = 0; i < KC - 1; ++i) E[i] = E[i + 4];
        }
    }
    if (KIND == 1 || run == NRUN - 1) { float* o = a.out + (KIND == 0 ? O_PC : O_SC) + (size_t)b * (KC - 1) * DM;
        if (KIND == 0) {
#pragma unroll
            for (int i = 0; i < KC - 1; ++i) *(GAS f32x2*)(o + (size_t)i * DM + ch) = (f32x2){bflo(E[REM + i]), bfhi(E[REM + i])};
        } else {
            const float* st = a.in[2] + (size_t)b * (KC - 1) * DM;
#pragma unroll
            for (int i = 0; i < KC - 1 - TS; ++i) *(GAS f32x2*)(o + (size_t)i * DM + ch) = *(const GAS f32x2*)(st + (size_t)(i + TS) * DM + ch);
#pragma unroll
            for (int i = KC - 1 - TS; i < KC - 1; ++i) *(GAS f32x2*)(o + (size_t)i * DM + ch) = (f32x2){bflo(E[REM + i]), bfhi(E[REM + i])};
        }
    }
    __syncthreads();
}

__device__ __forceinline__ void delta_item(const Args& a, LAS unsigned char* lds, int item) {
    asm volatile("" ::: "memory");
    const int tid = threadIdx.x, lane = tid & 63, sub = tid >> 7, wu = (tid >> 6) & 1; int j = tid & 127; asm volatile("" : "+v"(j));
    const int unit = item * 4 + sub, b = unit >> 3, h = unit & 7;
    const int row0 = RP + b * TS;
    const bf16* QS = (const bf16*)(a.ws + WS_QS); bf16* ZS = (bf16*)(a.ws + WS_ZS); const float* BETAG = (const float*)(a.ws + WS_BETAG);
    LAS float* kq = (LAS float*)lds + sub * 256;
    LAS float* red = (LAS float*)lds + 1024 + sub * 4;
    LAS float* red2 = (LAS float*)lds + 1024 + 16 + sub * 2;
    float S[DH];
    { const float* s0 = a.in[4] + ((size_t)(b * NH + h) * DH) * DH + j;
#pragma unroll
        for (int d = 0; d < DH; ++d) S[d] = s0[(size_t)d * DH]; }
    const int cq = h * DH + j, ck = DM + cq, cv = 2 * DM + cq;
    float wq[KS], wk[KS], wv[KS];
#pragma unroll
    for (int i = 0; i < KS; ++i) { wq[i] = a.in[13][i * DQKV + cq]; wk[i] = a.in[13][i * DQKV + ck]; wv[i] = a.in[13][i * DQKV + cv]; }
    float hq[3], hk[3], hv[3];
#pragma unroll
    for (int i = 0; i < 3; ++i) { const float* st = a.in[3] + ((size_t)b * 3 + i) * DQKV; hq[i] = st[cq]; hk[i] = st[ck]; hv[i] = st[cv]; }
    const float gh = a.in[16][j];
    float pq[TS], pk[TS], pv[TS], pbe[TS], pgg[TS], pzs[TS];
#pragma unroll
    for (int t = 0; t < TS; ++t) { const bf16* p = QS + (size_t)(b * TS + t) * DQKV; pq[t] = bf1(p[cq]); pk[t] = bf1(p[ck]); pv[t] = bf1(p[cv]);
        pbe[t] = BETAG[(size_t)(row0 + t) * 16 + h]; pgg[t] = BETAG[(size_t)(row0 + t) * 16 + 8 + h]; pzs[t] = bf1(ZS[(size_t)(row0 + t) * DM + cq]); }
#pragma unroll
    for (int t = 0; t < TS; ++t) {
        const size_t row = (size_t)(row0 + t);
        const float qp = pq[t], kp = pk[t], vp = pv[t];
        const float qc = siluf_(wq[0] * hq[0] + wq[1] * hq[1] + wq[2] * hq[2] + wq[3] * qp);
        const float kc = siluf_(wk[0] * hk[0] + wk[1] * hk[1] + wk[2] * hk[2] + wk[3] * kp);
        const float vc = siluf_(wv[0] * hv[0] + wv[1] * hv[1] + wv[2] * hv[2] + wv[3] * vp);
        hq[0] = hq[1]; hq[1] = hq[2]; hq[2] = qp; hk[0] = hk[1]; hk[1] = hk[2]; hk[2] = kp; hv[0] = hv[1]; hv[1] = hv[2]; hv[2] = vp;
        const float sq = wave_sum(qc * qc), sk = wave_sum(kc * kc);
        kq[j] = kc; kq[128 + j] = qc;
        if (lane == 0) { red[wu * 2] = sq; red[wu * 2 + 1] = sk; }
        const float beta = pbe[t], gg = pgg[t], zs = pzs[t];
        __syncthreads();
        const float nq = rsqf(red[0] + red[2] + 1e-6f) * 0.08838834764831845f, nk = rsqf(red[1] + red[3] + 1e-6f);
        const float alpha = __expf(gg);
        float ks0 = 0.f, ks1 = 0.f, ks2 = 0.f, ks3 = 0.f;
#pragma unroll
        for (int d = 0; d < DH; d += 4) { const f32x4 kk = *(const LAS f32x4*)(kq + d); ks0 += kk.x * S[d]; ks1 += kk.y * S[d + 1]; ks2 += kk.z * S[d + 2]; ks3 += kk.w * S[d + 3];
            if ((d & 31) == 28) asm volatile("" ::: "memory"); }
        const float kS = (ks0 + ks1) + (ks2 + ks3);
        const float u = beta * (vc - alpha * nk * kS), un = nk * u;
        float o0 = 0.f, o1 = 0.f, o2 = 0.f, o3 = 0.f;
#pragma unroll
        for (int d = 0; d < DH; d += 4) { const f32x4 kk = *(const LAS f32x4*)(kq + d); const f32x4 qq = *(const LAS f32x4*)(kq + 128 + d);
            S[d] = alpha * S[d] + kk.x * un; S[d + 1] = alpha * S[d + 1] + kk.y * un; S[d + 2] = alpha * S[d + 2] + kk.z * un; S[d + 3] = alpha * S[d + 3] + kk.w * un;
            o0 += qq.x * S[d]; o1 += qq.y * S[d + 1]; o2 += qq.z * S[d + 2]; o3 += qq.w * S[d + 3];
            if ((d & 15) == 12) asm volatile("" ::: "memory"); }
        const float o = ((o0 + o1) + (o2 + o3)) * nq;
        const float so = wave_sum(o * o);
        if (lane == 0) red2[wu] = so;
        __syncthreads();
        const float rms = rsqf((red2[0] + red2[1]) * (1.f / DH) + EPS);
        ZS[row * DM + cq] = (bf16)f2bf(o * rms * gh * zs);
    }
    { float* so = a.out + O_SD + ((size_t)(b * NH + h) * DH) * DH + j;
#pragma unroll
        for (int d = 0; d < DH; ++d) so[(size_t)d * DH] = S[d];
      float* qo = a.out + O_SQ + (size_t)b * 3 * DQKV;
#pragma unroll
        for (int i = 0; i < 3; ++i) { qo[i * DQKV + cq] = hq[i]; qo[i * DQKV + ck] = hk[i]; qo[i * DQKV + cv] = hv[i]; }
    }
    __syncthreads();
}

__host__ __device__ constexpr int perm_k(int x) { return (x & ~31) | (((x >> 2) & 3) << 3) | (((x >> 4) & 1) << 2) | (x & 3); }
typedef short bf16x8v __attribute__((ext_vector_type(8)));
constexpr int IH_QH = 0, IH_KH = 17408, IH_VH = 34816, IH_GV = 52224, IH_BYTES = 54272;
__device__ __forceinline__ void intra_pair(const Args& a, LAS unsigned char* lds_all, int pair) {
    asm volatile("" ::: "memory");
    const int tid = threadIdx.x, half = tid >> 8, lane = tid & 63, wq = (tid >> 6) & 3; int tu = tid & 255; asm volatile("" : "+v"(tu));
    const int uq = pair * 2 + half, h = uq & 7, bc = uq >> 3, b = bc / NCH, c = bc - b * NCH;
    const int nvalid = (c == NCH - 1) ? TP - 64 * (NCH - 1) : 64;
    LAS unsigned char* lds = lds_all + half * IH_BYTES;
    LAS bf16* QH = (LAS bf16*)(lds + IH_QH); LAS bf16* KH = (LAS bf16*)(lds + IH_KH); LAS bf16* VH = (LAS bf16*)(lds + IH_VH);
    LAS float* MF = (LAS float*)(lds + IH_KH); LAS bf16* ATL = (LAS bf16*)(lds + IH_VH); LAS float* GV = (LAS float*)(lds + IH_GV);
    unsigned char* ws = a.ws;
    bf16* blk = (bf16*)(ws + WS_QKVB) + (size_t)uq * QBLK; const bf16* HALOQ = (const bf16*)(ws + WS_HALOQ); const float* BETAG = (const float*)(ws + WS_BETAG);
    bf16* KDT = (bf16*)(ws + WS_KDT) + (size_t)uq * 8192; bf16* ATT = (bf16*)(ws + WS_ATTN) + (size_t)uq * 4096; float* LASTV = (float*)(ws + WS_LASTV);
    if (tu < 64) { const int i = tu; float g = 0.f, be = 0.f; { const float* p = BETAG + (size_t)(b * TP + 64 * c + (i < nvalid ? i : 0)) * 16; be = p[h]; g = p[8 + h]; } if (i >= nvalid) { g = 0.f; be = 0.f; }
        float G = g;
#pragma unroll
        for (int o = 1; o < 64; o <<= 1) { const float t = __shfl_up(G, o); if (lane >= o) G += t; }
        const float GL = __shfl(G, 63);
        GV[i] = G; GV[64 + i] = be; GV[128 + i] = expf(G); GV[192 + i] = expf(GL - G);
        if (i == 63) LASTV[uq] = expf(GL); }
    {   const int cp = tu & 15, rg = tu >> 4;
        v4u raw[3][7];
#pragma unroll
        for (int wh = 0; wh < 3; ++wh)
#pragma unroll
            for (int k = 0; k < 7; ++k) { const int rr = 4 * rg - 3 + k;
                const bf16* p = (rr >= 0) ? blk + wh * 8192 + rr * 128 + 8 * cp : HALOQ + ((size_t)(b * NCH + (c > 0 ? c - 1 : 0)) * 3 + (3 + rr)) * DQKV + wh * DM + h * DH + 8 * cp;
                raw[wh][k] = *(const GAS v4u*)p; }
#pragma unroll
        for (int wh = 0; wh < 3; ++wh) {
            const int col = wh * DM + h * DH + 8 * cp;
            f32x4 wl[4], wh4[4];
#pragma unroll
            for (int i = 0; i < 4; ++i) { wl[i] = *(const GAS f32x4*)(a.in[13] + i * DQKV + col); wh4[i] = *(const GAS f32x4*)(a.in[13] + i * DQKV + col + 4); }
            float xr[7][8];
#pragma unroll
            for (int k = 0; k < 7; ++k) { const int rr = 4 * rg - 3 + k; const bool ok = (rr >= 0) ? (rr < nvalid) : (c > 0); const v4u v = raw[wh][k];
                xr[k][0] = ok ? bflo(v.x) : 0.f; xr[k][1] = ok ? bfhi(v.x) : 0.f; xr[k][2] = ok ? bflo(v.y) : 0.f; xr[k][3] = ok ? bfhi(v.y) : 0.f;
                xr[k][4] = ok ? bflo(v.z) : 0.f; xr[k][5] = ok ? bfhi(v.z) : 0.f; xr[k][6] = ok ? bflo(v.w) : 0.f; xr[k][7] = ok ? bfhi(v.w) : 0.f; }
            if (c == NCH - 1 && rg == (nvalid - 1) / 4) {
                float* qo = a.out + O_PQ + (size_t)b * 3 * DQKV + col;
#pragma unroll
                for (int i = 0; i < 3; ++i) { *(GAS f32x4*)(qo + i * DQKV) = (f32x4){xr[4 + i][0], xr[4 + i][1], xr[4 + i][2], xr[4 + i][3]}; *(GAS f32x4*)(qo + i * DQKV + 4) = (f32x4){xr[4 + i][4], xr[4 + i][5], xr[4 + i][6], xr[4 + i][7]}; } }
            LAS bf16* tile = wh == 0 ? QH : (wh == 1 ? KH : VH);
#pragma unroll
            for (int r = 0; r < 4; ++r) { const bool ok = (4 * rg + r) < nvalid; float y[8];
#pragma unroll
                for (int e = 0; e < 8; ++e) { const float w0 = e < 4 ? wl[0][e & 3] : wh4[0][e & 3], w1 = e < 4 ? wl[1][e & 3] : wh4[1][e & 3], w2 = e < 4 ? wl[2][e & 3] : wh4[2][e & 3], w3 = e < 4 ? wl[3][e & 3] : wh4[3][e & 3];
                    const float t = w0 * xr[r][e] + w1 * xr[r + 1][e] + w2 * xr[r + 2][e] + w3 * xr[r + 3][e]; y[e] = ok ? siluf_(t) : 0.f; }
                v4u o; o.x = cvtpk(y[0], y[1]); o.y = cvtpk(y[2], y[3]); o.z = cvtpk(y[4], y[5]); o.w = cvtpk(y[6], y[7]);
                *(LAS v4u*)(tile + (4 * rg + r) * 136 + 8 * cp) = o; }
        }
    }
    __syncthreads();
    const int which = tu >> 7, d = tu & 127;
    float x[64];
    { const LAS bf16* colp = (which == 0 ? VH : KH) + d;
#pragma unroll
      for (int i = 0; i < 64; ++i) x[i] = bf1(colp[i * 136]); }
    const int fr = lane & 15, fq = lane >> 4;
    f32x4 kk[4], qk[4];
    {   bf16x8v ak[4], aq[4];
#pragma unroll
        for (int sI = 0; sI < 4; ++sI) { ak[sI] = *(const LAS bf16x8v*)(KH + (16 * wq + fr) * 136 + 32 * sI + 8 * fq); aq[sI] = *(const LAS bf16x8v*)(QH + (16 * wq + fr) * 136 + 32 * sI + 8 * fq); }
        f32x4 kkd = {0.f, 0.f, 0.f, 0.f}, qqd = {0.f, 0.f, 0.f, 0.f};
#pragma unroll
        for (int sI = 0; sI < 4; ++sI) { kkd = __builtin_amdgcn_mfma_f32_16x16x32_bf16(ak[sI], ak[sI], kkd, 0, 0, 0); qqd = __builtin_amdgcn_mfma_f32_16x16x32_bf16(aq[sI], aq[sI], qqd, 0, 0, 0); }
#pragma unroll
        for (int nt = 0; nt < 4; ++nt) { kk[nt] = (f32x4){0.f, 0.f, 0.f, 0.f}; qk[nt] = (f32x4){0.f, 0.f, 0.f, 0.f};
            if (nt <= wq) {
#pragma unroll
                for (int sI = 0; sI < 4; ++sI) { const bf16x8v bk = *(const LAS bf16x8v*)(KH + (16 * nt + fr) * 136 + 32 * sI + 8 * fq);
                    kk[nt] = __builtin_amdgcn_mfma_f32_16x16x32_bf16(ak[sI], bk, kk[nt], 0, 0, 0); qk[nt] = __builtin_amdgcn_mfma_f32_16x16x32_bf16(aq[sI], bk, qk[nt], 0, 0, 0); } } }
#pragma unroll
        for (int r = 0; r < 4; ++r) if (fr == 4 * fq + r) { GV[320 + 16 * wq + fr] = rsqf(kkd[r] + 1e-6f); GV[256 + 16 * wq + fr] = rsqf(qqd[r] + 1e-6f) * 0.08838834764831845f; }
    }
    __syncthreads();
    {
#pragma unroll
        for (int nt = 0; nt < 4; ++nt) { const int j = 16 * nt + fr;
            if (nt <= wq) { const float Gj = GV[j], nkj = GV[320 + j];
#pragma unroll
                for (int r = 0; r < 4; ++r) { const int i = 16 * wq + 4 * fq + r; const float dec = (i >= j) ? __expf(GV[i] - Gj) : 0.f;
                    MF[i * 68 + j] = (i > j) ? GV[64 + i] * GV[320 + i] * nkj * kk[nt][r] * dec : 0.f;
                    ATL[i * 72 + j] = (bf16)f2bf(GV[256 + i] * nkj * qk[nt][r] * dec); }
            } else {
#pragma unroll
                for (int r = 0; r < 4; ++r) ATL[(16 * wq + 4 * fq + r) * 72 + j] = (bf16)0; }
        }
#pragma unroll
        for (int k = 0; k < 4; ++k) { const int pc = tu + 256 * k, i = pc >> 4, p16 = pc & 15, c0 = 32 * (p16 >> 2) + 4 * (p16 & 3);
            const v2u lo = *(const LAS v2u*)(QH + i * 136 + c0), hi = *(const LAS v2u*)(QH + i * 136 + c0 + 16); const float f = GV[256 + i] * GV[128 + i];
            v4u o; o.x = cvtpk(bflo(lo.x) * f, bfhi(lo.x) * f); o.y = cvtpk(bflo(lo.y) * f, bfhi(lo.y) * f); o.z = cvtpk(bflo(hi.x) * f, bfhi(hi.x) * f); o.w = cvtpk(bflo(hi.y) * f, bfhi(hi.y) * f);
            *(GAS v4u*)(blk + i * 128 + 8 * p16) = o; }
        if (which == 0) {
#pragma unroll
            for (int i = 0; i < 64; i += 4) { const f32x4 be = *(const LAS f32x4*)(GV + 64 + i); x[i] *= be.x; x[i + 1] *= be.y; x[i + 2] *= be.z; x[i + 3] *= be.w; }
        } else {
            bf16* kd = KDT + d * 64;
#pragma unroll
            for (int i = 0; i < 64; i += 4) { const f32x4 nk = *(const LAS f32x4*)(GV + 320 + i); x[i] *= nk.x; x[i + 1] *= nk.y; x[i + 2] *= nk.z; x[i + 3] *= nk.w; }
#pragma unroll
            for (int g8 = 0; g8 < 8; ++g8) { const int i0 = 32 * (g8 >> 2) + 4 * (g8 & 3);
                const f32x4 e0 = *(const LAS f32x4*)(GV + 192 + i0), e1 = *(const LAS f32x4*)(GV + 192 + i0 + 16);
                v4u w; w.x = cvtpk(x[i0] * e0.x, x[i0 + 1] * e0.y); w.y = cvtpk(x[i0 + 2] * e0.z, x[i0 + 3] * e0.w); w.z = cvtpk(x[i0 + 16] * e1.x, x[i0 + 17] * e1.y); w.w = cvtpk(x[i0 + 18] * e1.z, x[i0 + 19] * e1.w);
                *(GAS v4u*)(kd + 8 * g8) = w; }
#pragma unroll
            for (int i = 0; i < 64; i += 4) { const f32x4 be = *(const LAS f32x4*)(GV + 64 + i), eg = *(const LAS f32x4*)(GV + 128 + i);
                x[i] *= be.x * eg.x; x[i + 1] *= be.y * eg.y; x[i + 2] *= be.z * eg.z; x[i + 3] *= be.w * eg.w; }
        }
    }
    __syncthreads();
    {   f32x4 mb[16];
#pragma unroll
        for (int i = 1; i < 64; ++i) {
#pragma unroll
            for (int g = 0; g < (i + 3) / 4; ++g) mb[g] = *(const LAS f32x4*)(MF + i * 68 + 4 * g);
            __builtin_amdgcn_sched_barrier(0);
            f32x2 a01 = {x[i], 0.f}, a23 = {0.f, 0.f};
#pragma unroll
            for (int g = 0; g < (i + 3) / 4; ++g) { const f32x4 mm = mb[g];
                a01 -= (f32x2){mm.x, mm.y} * (f32x2){x[4 * g], x[4 * g + 1]}; a23 -= (f32x2){mm.z, mm.w} * (f32x2){x[4 * g + 2], x[4 * g + 3]}; }
            x[i] = (a01.x + a01.y) + (a23.x + a23.y);
            __builtin_amdgcn_sched_barrier(0);
        }
    }
    if (which == 0) {
        bf16* u0 = blk + 2 * 8192 + (size_t)(d >> 4) * 1024 + (d & 15) * 4;
#pragma unroll
        for (int m = 0; m < 4; ++m)
#pragma unroll
            for (int q = 0; q < 4; ++q) { const int i = 16 * m + 4 * q; v2u w; w.x = cvtpk(x[i], x[i + 1]); w.y = cvtpk(x[i + 2], x[i + 3]); *(GAS v2u*)(u0 + m * 256 + q * 64) = w; }
    } else {
#pragma unroll
        for (int i = 0; i < 64; ++i) QH[i * 136 + d] = (bf16)f2bf(x[i]);
    }
    __syncthreads();
#pragma unroll
    for (int k = 0; k < 4; ++k) { const int pc = tu + 256 * k, i = pc >> 4, p16 = pc & 15, c0 = 32 * (p16 >> 2) + 4 * (p16 & 3);
        const v2u lo = *(const LAS v2u*)(QH + i * 136 + c0), hi = *(const LAS v2u*)(QH + i * 136 + c0 + 16);
        *(GAS v4u*)(blk + 8192 + i * 128 + 8 * p16) = (v4u){lo.x, lo.y, hi.x, hi.y}; }
#pragma unroll
    for (int k = 0; k < 2; ++k) { const int pc = tu + 256 * k, i = pc >> 3, p8 = pc & 7, c0 = 32 * (p8 >> 2) + 4 * (p8 & 3);
        const v2u lo = *(const LAS v2u*)(ATL + i * 72 + c0), hi = *(const LAS v2u*)(ATL + i * 72 + c0 + 16);
        *(GAS v4u*)(ATT + i * 64 + 8 * p8) = (v4u){lo.x, lo.y, hi.x, hi.y}; }
    __syncthreads();
}

constexpr int SC_W = 0, SC_QD = 16384, SC_KDT = 32768, SC_AT = 49152, SC_BUF = 57344, SC_RMS = 2 * SC_BUF, SC_ZT = SC_RMS + 4096, SC_END = SC_ZT + 2 * 16384;
__device__ __forceinline__ int swz256(int row, int chunk) { return row * 256 + ((chunk ^ (row & 15)) << 4); }
__device__ __forceinline__ int swz128(int row, int ch) { return (row >> 1) * 256 + (((8 * (row & 1) + ch) ^ ((row >> 1) & 7)) << 4); }
__device__ __forceinline__ void scan_chain(const Args& a, LAS unsigned char* lds, int chain) {
    const int tid = threadIdx.x, lane = tid & 63, wave = __builtin_amdgcn_readfirstlane(tid >> 6), fr = lane & 15, fq = lane >> 4;
    const int b = chain >> 3, h = chain & 7;
    unsigned char* ws = a.ws;
    const bf16* QKVB = (const bf16*)(ws + WS_QKVB); const bf16* KDTg = (const bf16*)(ws + WS_KDT); const bf16* ATTg = (const bf16*)(ws + WS_ATTN); const float* LASTV = (const float*)(ws + WS_LASTV);
    bf16* ZS = (bf16*)(ws + WS_ZS);
    LAS float* RMS = (LAS float*)(lds + SC_RMS);
    const float gh = a.in[16][16 * wave + fr];
    f32x4 Sacc[8];
#pragma unroll
    for (int mt = 0; mt < 8; ++mt) Sacc[mt] = (f32x4){0.f, 0.f, 0.f, 0.f};
    v4u ztn[2]; v2u u0n[4]; float lastn;
    auto chunk_dma = [&](int c) {
        const size_t uq = (size_t)(b * NCH + c) * NH + h; const bf16* blk = QKVB + uq * QBLK; LAS unsigned char* base = lds + (c & 1) * SC_BUF;
#pragma unroll
        for (int k = 0; k < 2; ++k) { const int P = (wave + 8 * k) * 64 + lane, row = P >> 4, ch = (P & 15) ^ (row & 15);
            __builtin_amdgcn_global_load_lds((const unsigned*)(blk + 8192 + row * 128 + 8 * ch), (LAS unsigned*)(base + SC_W + (wave + 8 * k) * 1024), 16, 0, 0);
            __builtin_amdgcn_global_load_lds((const unsigned*)(blk + row * 128 + 8 * ch), (LAS unsigned*)(base + SC_QD + (wave + 8 * k) * 1024), 16, 0, 0);
            const int line = P >> 4, t = (P & 15) ^ (line & 7), r2 = 2 * line + (t >> 3);
            __builtin_amdgcn_global_load_lds((const unsigned*)(KDTg + uq * 8192 + r2 * 64 + 8 * (t & 7)), (LAS unsigned*)(base + SC_KDT + (wave + 8 * k) * 1024), 16, 0, 0); }
        { const int P = wave * 64 + lane, line = P >> 4, t = (P & 15) ^ (line & 7), r2 = 2 * line + (t >> 3);
            __builtin_amdgcn_global_load_lds((const unsigned*)(ATTg + uq * 4096 + r2 * 64 + 8 * (t & 7)), (LAS unsigned*)(base + SC_AT + wave * 1024), 16, 0, 0); }
    };
    auto side_load = [&](int c) {
        const size_t uq = (size_t)(b * NCH + c) * NH + h;
#pragma unroll
        for (int k = 0; k < 2; ++k) { const int p = tid + 512 * k; ztn[k] = *(const GAS v4u*)(ZS + (size_t)(b * TP + 64 * c + (p >> 4)) * DM + h * DH + 8 * (p & 15)); }
        const bf16* u0 = QKVB + uq * QBLK + 2 * 8192 + wave * 1024 + lane * 4;
#pragma unroll
        for (int m = 0; m < 4; ++m) u0n[m] = *(const GAS v2u*)(u0 + m * 256);
        lastn = LASTV[uq];
    };
    auto side_store = [&](int buf) {
#pragma unroll
        for (int k = 0; k < 2; ++k) { const int p = tid + 512 * k; *(LAS v4u*)(lds + SC_ZT + buf * 16384 + swz256(p >> 4, p & 15)) = ztn[k]; }
    };
    chunk_dma(0); side_load(0); side_store(0);
    v2u u0p[4]; float last;
#pragma unroll
    for (int m = 0; m < 4; ++m) u0p[m] = u0n[m];
    last = lastn;
    chunk_dma(1); side_load(1);
    __syncthreads();
    for (int c = 0; c < NCH; ++c) {
        const int buf = c & 1; LAS unsigned char* base = lds + buf * SC_BUF; LAS unsigned char* zt = lds + SC_ZT + buf * 16384;
        const int nvalid = (c == NCH - 1) ? TP - 64 * (NCH - 1) : 64;
        bf16x8v F[2][8];
#define SC_LD_A(m, f) do { _Pragma("unroll") for (int sI = 0; sI < 4; ++sI) { const int off = swz256(16 * (m) + fr, 4 * sI + fq); \
            f[2 * sI] = *(const LAS bf16x8v*)(base + SC_W + off); f[2 * sI + 1] = *(const LAS bf16x8v*)(base + SC_QD + off); } } while (0)
#define SC_LD_D(f) do { _Pragma("unroll") for (int m = 0; m < 4; ++m) _Pragma("unroll") for (int s2 = 0; s2 < 2; ++s2) f[2 * m + s2] = *(const LAS bf16x8v*)(base + SC_AT + swz128(16 * m + fr, 4 * s2 + fq)); } while (0)
#define SC_LD_C(g, f) do { _Pragma("unroll") for (int mm = 0; mm < 4; ++mm) _Pragma("unroll") for (int s2 = 0; s2 < 2; ++s2) f[2 * mm + s2] = *(const LAS bf16x8v*)(base + SC_KDT + swz128(16 * (4 * (g) + mm) + fr, 4 * s2 + fq)); } while (0)
        SC_LD_A(0, F[0]);
        bf16x8v Sb[4];
#pragma unroll
        for (int sI = 0; sI < 4; ++sI) { v4u w; w.x = cvtpk(Sacc[2 * sI][0], Sacc[2 * sI][1]); w.y = cvtpk(Sacc[2 * sI][2], Sacc[2 * sI][3]); w.z = cvtpk(Sacc[2 * sI + 1][0], Sacc[2 * sI + 1][1]); w.w = cvtpk(Sacc[2 * sI + 1][2], Sacc[2 * sI + 1][3]);
            Sb[sI] = __builtin_bit_cast(bf16x8v, w); }
        f32x4 u[4], o[4];
#pragma unroll
        for (int m = 0; m < 4; ++m) {
            if (m == 0) SC_LD_A(1, F[1]); else if (m == 1) SC_LD_A(2, F[0]); else if (m == 2) SC_LD_A(3, F[1]); else SC_LD_D(F[0]);
            __builtin_amdgcn_sched_barrier(0);
            f32x4 p = {0.f, 0.f, 0.f, 0.f}, oo = {0.f, 0.f, 0.f, 0.f};
#pragma unroll
            for (int sI = 0; sI < 4; ++sI) { p = __builtin_amdgcn_mfma_f32_16x16x32_bf16(F[m & 1][2 * sI], Sb[sI], p, 0, 0, 0); oo = __builtin_amdgcn_mfma_f32_16x16x32_bf16(F[m & 1][2 * sI + 1], Sb[sI], oo, 0, 0, 0); }
            u[m] = (f32x4){bflo(u0p[m].x), bfhi(u0p[m].x), bflo(u0p[m].y), bfhi(u0p[m].y)} - p; o[m] = oo;
            __builtin_amdgcn_sched_barrier(0);
        }
        bf16x8v Ub[2];
#pragma unroll
        for (int s2 = 0; s2 < 2; ++s2) { v4u w; w.x = cvtpk(u[2 * s2][0], u[2 * s2][1]); w.y = cvtpk(u[2 * s2][2], u[2 * s2][3]); w.z = cvtpk(u[2 * s2 + 1][0], u[2 * s2 + 1][1]); w.w = cvtpk(u[2 * s2 + 1][2], u[2 * s2 + 1][3]);
            Ub[s2] = __builtin_bit_cast(bf16x8v, w); }
        SC_LD_C(0, F[1]);
        __builtin_amdgcn_sched_barrier(0);
#pragma unroll
        for (int m = 0; m < 4; ++m)
#pragma unroll
            for (int s2 = 0; s2 < 2; ++s2) o[m] = __builtin_amdgcn_mfma_f32_16x16x32_bf16(F[0][2 * m + s2], Ub[s2], o[m], 0, 0, 0);
        __builtin_amdgcn_sched_barrier(0);
        SC_LD_C(1, F[0]);
        __builtin_amdgcn_sched_barrier(0);
#pragma unroll
        for (int mt = 0; mt < 4; ++mt) { f32x4 sacc = Sacc[mt] * last;
#pragma unroll
            for (int s2 = 0; s2 < 2; ++s2) sacc = __builtin_amdgcn_mfma_f32_16x16x32_bf16(F[1][2 * mt + s2], Ub[s2], sacc, 0, 0, 0);
            Sacc[mt] = sacc; }
        __builtin_amdgcn_sched_barrier(0);
#pragma unroll
        for (int mt = 4; mt < 8; ++mt) { f32x4 sacc = Sacc[mt] * last;
#pragma unroll
            for (int s2 = 0; s2 < 2; ++s2) sacc = __builtin_amdgcn_mfma_f32_16x16x32_bf16(F[0][2 * (mt - 4) + s2], Ub[s2], sacc, 0, 0, 0);
            Sacc[mt] = sacc; }
#undef SC_LD_A
#undef SC_LD_D
#undef SC_LD_C
        LAS float* rm = RMS + (c & 1) * 512;
#pragma unroll
        for (int m = 0; m < 4; ++m)
#pragma unroll
            for (int r = 0; r < 4; ++r) { const float v = sum16(o[m][r] * o[m][r]); if (fr == 0) rm[(16 * m + 4 * fq + r) * 8 + wave] = v; }
        if (c + 1 < NCH) { side_store(buf ^ 1);
#pragma unroll
            for (int m = 0; m < 4; ++m) u0p[m] = u0n[m];
            last = lastn; }
        __syncthreads();
        if (c + 2 < NCH) side_load(c + 2);
        {   LAS float* rsw = RMS + ((c + 1) & 1) * 512 + wave * 64;
            const f32x4 p0 = *(const LAS f32x4*)(rm + lane * 8), p1 = *(const LAS f32x4*)(rm + lane * 8 + 4);
            LAS bf16* zp[16]; bf16 zv[16];
#pragma unroll
            for (int m = 0; m < 4; ++m)
#pragma unroll
                for (int r = 0; r < 4; ++r) { zp[4 * m + r] = (LAS bf16*)(zt + swz256(16 * m + 4 * fq + r, 2 * wave + (fr >> 3))) + (fr & 7); zv[4 * m + r] = *zp[4 * m + r]; }
            rsw[lane] = rsqf((((p0.x + p0.y) + (p0.z + p0.w)) + ((p1.x + p1.y) + (p1.z + p1.w))) * (1.f / DH) + EPS);
            f32x4 rs[4];
#pragma unroll
            for (int m = 0; m < 4; ++m) rs[m] = *(const LAS f32x4*)(rsw + 16 * m + 4 * fq);
            __builtin_amdgcn_sched_barrier(0);
#pragma unroll
            for (int m = 0; m < 4; ++m)
#pragma unroll
                for (int r = 0; r < 4; ++r) *zp[4 * m + r] = (bf16)f2bf(o[m][r] * rs[m][r] * gh * bf1(zv[4 * m + r]));
        }
        __syncthreads();
        if (c + 2 < NCH) chunk_dma(c + 2);
#pragma unroll
        for (int k = 0; k < 2; ++k) { const int p = tid + 512 * k, i = p >> 4;
            if (i < nvalid) *(GAS v4u*)(ZS + (size_t)(b * TP + 64 * c + i) * DM + h * DH + 8 * (p & 15)) = *(const LAS v4u*)(zt + swz256(i, p & 15)); }
    }
    { float* so = a.out + O_PD + ((size_t)(b * NH + h) * DH) * DH + 16 * wave + fr;
#pragma unroll
      for (int mt = 0; mt < 8; ++mt)
#pragma unroll
          for (int r = 0; r < 4; ++r) so[(size_t)(16 * mt + 4 * fq + r) * DH] = Sacc[mt][r]; }
    __syncthreads();
}

static_assert(SC_END <= LDSCTL_OFF && 2 * IH_BYTES <= LDSCTL_OFF && RING_BYTES <= LDSCTL_OFF, "LDS map");
constexpr int NPHASES = 10;
__global__ void __launch_bounds__(NWAVES * 64, 2) fwd_kernel(Args args) {
    extern __shared__ __attribute__((aligned(16))) unsigned char lds_raw[];
    LAS unsigned char* lds = (LAS unsigned char*)lds_raw;
    volatile LAS unsigned* MISC = (volatile LAS unsigned*)(lds + MISC_OFF);
    const int tid = threadIdx.x, lane = tid & 63, wave = __builtin_amdgcn_readfirstlane(tid >> 6);
    const int G = gridDim.x, bx = blockIdx.x;
    const int vcu = (G % 8 == 0) ? (bx % 8) * (G / 8) + bx / 8 : bx;
    unsigned char* ws = args.ws;
    gu32* ctl = (gu32*)(ws + WS_CTL);
    for (int u = tid; u < (LDS_BYTES - LDSCTL_OFF) / 4; u += NWAVES * 64) ((LAS unsigned*)(lds + LDSCTL_OFF))[u] = 0u;
    __syncthreads();
    XcdBarrier bar; bar.bar = (unsigned*)(ctl + CW_BAR); bar.x = 0; bar.st = nullptr;
    const int lo = args.ph_lo, hi = args.ph_hi;
    if (hi - lo > 1) bar = xcd_barrier_post((unsigned*)(ctl + CW_BAR), MISC + 8);
#ifndef PH_MASK
#define PH_MASK 0x3ff
#endif
#define IN(k) (((PH_MASK >> (k)) & 1) && lo <= (k) && (k) < hi)
#ifndef PROBE_K
#define PROBE_K -1
#endif
#if PROBE_K >= 0
    volatile LAS unsigned long long* stamps = (volatile LAS unsigned long long*)(lds + MISC_OFF + 128);
    if (tid == 0) stamps[0] = __builtin_amdgcn_s_memrealtime();
#define SEAM(k) do { if (IN(k) && IN((k) + 1)) xcd_barrier(bar); if (tid == 0) stamps[(k) + 1] = __builtin_amdgcn_s_memrealtime(); } while (0)
#else
#define SEAM(k) do { if (IN(k) && IN((k) + 1)) xcd_barrier(bar); } while (0)
#endif
    bf16* WIN = (bf16*)(ws + WS_WIN); bf16* WC = (bf16*)(ws + WS_WC); bf16* WD = (bf16*)(ws + WS_WD); bf16* WO = (bf16*)(ws + WS_WO); bf16* WUP = (bf16*)(ws + WS_WUP); bf16* WDN = (bf16*)(ws + WS_WDN);
    bf16* H = (bf16*)(ws + WS_H); bf16* GLU = (bf16*)(ws + WS_GLU); bf16* QKVB = (bf16*)(ws + WS_QKVB); bf16* QS = (bf16*)(ws + WS_QS); bf16* ZS = (bf16*)(ws + WS_ZS);
    bf16* HALOQ = (bf16*)(ws + WS_HALOQ); bf16* HALOC = (bf16*)(ws + WS_HALOC);
    bf16* SGC = (bf16*)args.out; bf16* SGD = (bf16*)args.out + (size_t)M2 * DM;
    bf16* MIX = (bf16*)(ws + WS_MIX); bf16* XG = (bf16*)(ws + WS_XG); bf16* HM = (bf16*)(ws + WS_HM); bf16* C = (bf16*)(ws + WS_C);
    float* BETAG = (float*)(ws + WS_BETAG);
    const int gw = vcu * NWAVES + wave, NGW = G * NWAVES;

    if (IN(0)) {
        constexpr int KB1 = DM / 32, KB4 = DFF / 32;
        constexpr int I_IN = KB1 * (NIN / 64), I_SQ = KB1 * (DM / 64), I_UP = KB1 * (DFF / 64), I_DN = KB4 * (DM / 64);
        constexpr int NITEMS = I_IN + 3 * I_SQ + I_UP + I_DN;
        for (int it = gw; it < NITEMS; it += NGW) {
            int r = it;
            if (r < I_IN) { const int nb = r / KB1, kb = r % KB1; int src, nv; win_src(nb, src, nv); p0_transpose_item(args.in[7], DIN, DM, WIN, nb * 64, src, nv, kb * 32, lane); continue; } r -= I_IN;
            if (r < I_SQ) { p0_transpose_item(args.in[12], DM, DM, WC, (r / KB1) * 64, (r / KB1) * 64, 64, (r % KB1) * 32, lane); continue; } r -= I_SQ;
            if (r < I_SQ) { p0_transpose_item(args.in[17], DM, DM, WD, (r / KB1) * 64, (r / KB1) * 64, 64, (r % KB1) * 32, lane); continue; } r -= I_SQ;
            if (r < I_SQ) { p0_transpose_item(args.in[18], DM, DM, WO, (r / KB1) * 64, (r / KB1) * 64, 64, (r % KB1) * 32, lane); continue; } r -= I_SQ;
            if (r < I_UP) { p0_transpose_item(args.in[20], DFF, DM, WUP, (r / KB1) * 64, (r / KB1) * 64, 64, (r % KB1) * 32, lane); continue; } r -= I_UP;
            p0_transpose_item(args.in[21], DM, DFF, WDN, (r / KB4) * 64, (r / KB4) * 64, 64, (r % KB4) * 32, lane);
        }
        for (int m0 = gw; m0 < MP; m0 += 2 * NGW) {
            const float* src[2]; bool ok[2]; f32x4 v[2][4];
#pragma unroll
            for (int q = 0; q < 2; ++q) { const int m = m0 + q * NGW; ok[q] = m < MR; const int mm = ok[q] ? m : 0;
                if (mm >= RP) src[q] = args.in[1] + (size_t)(mm - RP) * DM;
                else { const int b = mm / TP, t = mm - b * TP; src[q] = t < NMETA ? args.in[5] + (size_t)t * DM : args.in[0] + ((size_t)b * SEQ + (t - NMETA)) * DM; }
#pragma unroll
                for (int j = 0; j < 4; ++j) v[q][j] = ((const GAS f32x4*)src[q])[lane + 64 * j]; }
#pragma unroll
            for (int q = 0; q < 2; ++q) { const int m = m0 + q * NGW; if (m >= MP) continue;
                float ss = 0.f;
#pragma unroll
                for (int j = 0; j < 4; ++j) ss += (v[q][j].x * v[q][j].x + v[q][j].y * v[q][j].y) + (v[q][j].z * v[q][j].z + v[q][j].w * v[q][j].w);
                const float rstd = ok[q] ? rsqf(wave_sum(ss) * (1.f / DM) + EPS) : 0.f;
                GAS v2u* o8 = (GAS v2u*)(H + (size_t)m * DM) + lane;
#pragma unroll
                for (int j = 0; j < 4; ++j) { const f32x4 g = ((const GAS f32x4*)args.in[6])[lane + 64 * j]; v2u o; o.x = cvtpk(v[q][j].x * rstd * g.x, v[q][j].y * rstd * g.y); o.y = cvtpk(v[q][j].z * rstd * g.z, v[q][j].w * rstd * g.w); o8[64 * j] = o; } }
        }
    }
    SEAM(0);
    if (IN(1)) {
        pg8::Gemm g{H, WIN, MP, NIN, DM}; pg8::StaticOrder S; S.init(MP, NIN, G, bx);
        EpiIn E{GLU, QKVB, QS, HALOQ, HALOC, ZS, SGC, SGD, BETAG, args.in[14], args.in[15]};
        pg8::gemm_phase<EpiIn, pg8::StaticOrder, true, true>(lds + RING_OFF, g, S, E);
    }
    SEAM(1);
    if (IN(2)) {
        constexpr int N_CP = BP * NRUN, N_IP = BP * NCH * NH / 2, N_SD = BS * NH / 4, N_CS = BS, N_ITEMS = N_CP + N_IP + N_SD + N_CS;
        volatile LAS int* qslot = (volatile LAS int*)(lds + MISC_OFF + 64);
#if PROBE_K >= 0
        for (int sub = 0; sub < 3; ++sub) {
            const int lo_i = sub == 0 ? 0 : (sub == 1 ? N_CP : N_CP + N_IP), hi_i = sub == 0 ? N_CP : (sub == 1 ? N_CP + N_IP : N_CP + N_IP + N_SD);
            for (;;) {
                if (tid == 0) *qslot = (int)__hip_atomic_fetch_add((unsigned*)(ctl + 2048 + 64 * sub), 1u, __ATOMIC_RELAXED, __HIP_MEMORY_SCOPE_AGENT);
                __syncthreads();
                int it = *qslot + lo_i;
                __syncthreads();
                if (sub == 0 && it >= N_CP) { it += N_IP + N_SD; if (it >= N_ITEMS) break; conv_unit<1>(args, lds, it - (N_CP + N_IP + N_SD), 0); continue; }
                if (it >= hi_i) break;
                if (it < N_CP) { conv_unit<0>(args, lds, it / NRUN, it % NRUN); continue; } it -= N_CP;
                if (it < N_IP) { intra_pair(args, lds, it); continue; } it -= N_IP;
                (void)it;
            }
            if (sub < 2) { xcd_barrier(bar); if (tid == 0) stamps[12 + sub] = __builtin_amdgcn_s_memrealtime(); }
        }
#else
        for (;;) {
            if (tid == 0) *qslot = (int)__hip_atomic_fetch_add((unsigned*)(ctl + 2048), 1u, __ATOMIC_RELAXED, __HIP_MEMORY_SCOPE_AGENT);
            __syncthreads();
            int it = *qslot;
            __syncthreads();
            if (it >= N_CP + N_IP) it += N_SD;
            if (it >= N_ITEMS) break;
            if (it < N_CP) { conv_unit<0>(args, lds, it / NRUN, it % NRUN); continue; } it -= N_CP;
            if (it < N_IP) { intra_pair(args, lds, it); continue; } it -= N_IP;
            it -= N_SD; if (it < 0) continue;
            conv_unit<1>(args, lds, it, 0);
        }
#endif
    }
    SEAM(2);
    if (IN(3)) {
        if (bx < BP * NH) { scan_chain(args, lds, bx);
#if PROBE_K >= 0
            if (tid == 0) stamps[14] = __builtin_amdgcn_s_memrealtime();
#endif
        }
#if defined(PROBE_SCAN_ALONE)
        xcd_barrier(bar);
        if (bx < BP * NH) {}
#endif
        else {
            pg8::Gemm g{C, WC, MP, DM, DM}; pg8::StaticOrder S; S.init(MP, DM, G - BP * NH, bx - BP * NH);
            EpiGate<0> E{SGC, nullptr, SGC};
            pg8::gemm_phase<EpiGate<0>, pg8::StaticOrder, true, true>(lds + RING_OFF, g, S, E);
            volatile LAS int* qslot = (volatile LAS int*)(lds + MISC_OFF + 64);
            for (;;) {
                if (tid == 0) *qslot = (int)__hip_atomic_fetch_add((unsigned*)(ctl + 2048 + 256), 1u, __ATOMIC_RELAXED, __HIP_MEMORY_SCOPE_AGENT);
                __syncthreads();
                const int it = *qslot;
                __syncthreads();
                if (it >= BS * NH / 4) break;
                delta_item(args, lds, it);
            }
        }
    }
    SEAM(3);
    if (IN(4)) {
        pg8::Gemm g{ZS, WD, MP, DM, DM}; pg8::StaticOrder S; S.init(MP, DM, G, bx);
        EpiGate<1> E{SGD, SGC, MIX};
        pg8::gemm_phase<EpiGate<1>, pg8::StaticOrder, true, true>(lds + RING_OFF, g, S, E);
    }
    SEAM(4);
    if (IN(5)) {
        pg8::Gemm g{MIX, WO, M2, DM, DM}; pg8::StaticOrder S; S.init(M2, DM, G, bx);
        EpiRes<0> E{args.in[0], args.in[1], args.out};
        pg8::gemm_phase<EpiRes<0>, pg8::StaticOrder, true, true>(lds + RING_OFF, g, S, E);
    }
    SEAM(5);
    if (IN(6)) {
        for (int m = gw; m < M2; m += NGW) rms_row_to_bf16(args.out + (size_t)m * DM, args.in[19], XG + (size_t)m * DM, lane);
    }
    SEAM(6);
    if (IN(7)) {
        pg8::Gemm g{XG, WUP, M2, DFF, DM}; pg8::StaticOrder S; S.init(M2, DFF, G, bx);
        EpiUp E{HM};
        pg8::gemm_phase<EpiUp, pg8::StaticOrder, true, true>(lds + RING_OFF, g, S, E);
    }
    SEAM(7);
    if (IN(8)) {
        pg8::Gemm g{HM, WDN, M2, DM, DFF}; pg8::StaticOrder S; S.init(M2, DM, G, bx);
        EpiRes<1> E{nullptr, nullptr, args.out};
        pg8::gemm_phase<EpiRes<1>, pg8::StaticOrder, true, true>(lds + RING_OFF, g, S, E);
    }
    SEAM(8);
    if (IN(9)) {
        for (int m = gw; m < M2; m += NGW) {
            float* xrow = args.out + (size_t)m * DM;
            GAS f32x4* xr = (GAS f32x4*)xrow + lane; const GAS f32x4* gr = (const GAS f32x4*)args.in[22] + lane;
            f32x4 v[4]; float s = 0.f;
#pragma unroll
            for (int jj = 0; jj < 4; ++jj) { v[jj] = xr[64 * jj]; s += (v[jj].x * v[jj].x + v[jj].y * v[jj].y) + (v[jj].z * v[jj].z + v[jj].w * v[jj].w); }
            const float rstd = 1.f / sqrtf(wave_sum(s) * (1.f / DM) + EPS);
#pragma unroll
            for (int jj = 0; jj < 4; ++jj) xr[64 * jj] = v[jj] * rstd * gr[64 * jj];
        }
    }
#if PROBE_K >= 0
    __syncthreads();
    if (bx == 0) { if (tid == 0) stamps[NPHASES] = __builtin_amdgcn_s_memrealtime(); __syncthreads();
        const float dt_us = (float)(stamps[PROBE_B] - stamps[PROBE_K]) * 0.01f; const float f = 1.f + dt_us * (1.f / (float)(PROBE_DIV));
        for (int i = tid; i < BP * 3 * DQKV; i += NWAVES * 64) args.out[O_PQ + i] *= f; }
#endif
#undef IN
#undef SEAM
}

extern "C" void kernel_launch(void* const* d_in, const int* in_sizes, int n_in, void* d_out, int out_size, void* d_ws, size_t ws_size, hipStream_t stream) {
    static int grid = 0;
    if (grid == 0) {
        if (n_in != 23 || (size_t)out_size != O_END || ws_size < WS_END) { fprintf(stderr, "kernel_launch: unexpected shapes n_in %d out %d ws %zu\n", n_in, out_size, ws_size); grid = -1; return; }
        int dev = 0, cus = 0, per_cu = 0;
        if (hipGetDevice(&dev) != hipSuccess || hipDeviceGetAttribute(&cus, hipDeviceAttributeMultiprocessorCount, dev) != hipSuccess) { grid = -1; return; }
        if (hipFuncSetAttribute((const void*)fwd_kernel, hipFuncAttributeMaxDynamicSharedMemorySize, LDS_BYTES) != hipSuccess) { fprintf(stderr, "kernel_launch: hipFuncSetAttribute failed\n"); grid = -1; return; }
        if (hipOccupancyMaxActiveBlocksPerMultiprocessor(&per_cu, (const void*)fwd_kernel, NWAVES * 64, LDS_BYTES) != hipSuccess || per_cu < 1)
            fprintf(stderr, "kernel_launch: occupancy query reports %d\n", per_cu);
        (void)hipGetLastError();
        grid = cus;
    }
    if (grid < 0) return;
    if (hipMemsetAsync((char*)d_ws + WS_CTL, 0, CTL_ZERO_BYTES, stream) != hipSuccess) return;
    Args a{};
    for (int i = 0; i < 23; ++i) a.in[i] = (const float*)d_in[i];
    a.out = (float*)d_out; a.ws = (unsigned char*)d_ws;
#if MK_N_LAUNCHES == 1
    a.ph_lo = 0; a.ph_hi = NPHASES;
    hipLaunchKernelGGL(fwd_kernel, dim3(grid), dim3(NWAVES * 64), LDS_BYTES, stream, a);
#else
    for (int p = 0; p < NPHASES; ++p) { a.ph_lo = p; a.ph_hi = p + 1; hipLaunchKernelGGL(fwd_kernel, dim3(grid), dim3(NWAVES * 64), LDS_BYTES, stream, a); }
#endif
}
```

```cpp
#include <hip/hip_runtime.h>
#include <cstdio>
#include <cstdint>

#ifndef MK_N_LAUNCHES
#define MK_N_LAUNCHES 1
#endif

namespace pg8 {
#define PG8_LAS __attribute__((address_space(3)))
typedef unsigned short bf16_t;
typedef short bf16x8 __attribute__((ext_vector_type(8)));
typedef float f32x4 __attribute__((ext_vector_type(4)));
typedef unsigned u32x4 __attribute__((ext_vector_type(4)));
constexpr int BM = 256, BK = 64, HALF = 128, HTB = HALF * BK * 2, STAGE_BYTES = 8 * HTB, NXCD = 8, WGM = 8;

__host__ __device__ __forceinline__ int lds_byte(int r, int c) { const int st = (r >> 4) * 2 + (c >> 5), rr = r & 15, cc = c & 31, ob = rr * 64 + cc * 2; return st * 1024 + (ob ^ (((ob >> 9) & 1) << 5)); }
__host__ __device__ __forceinline__ void stage_rc(int b, int& R, int& C) { const int st = b / 1024, sb = b % 1024, swz = sb ^ (((sb >> 9) & 1) << 5); R = (st >> 1) * 16 + swz / 64; C = (st & 1) * 32 + (swz % 64) / 2; }
__host__ __device__ __forceinline__ int perm32(int rho) { const int n = rho >> 4, i = rho & 15; return 8 * (i >> 2) + 4 * n + (i & 3); }

struct Unit { int pm, pn, k0, nt; };
struct Gemm { const bf16_t* A; const bf16_t* Bt; int M, N, K; };

struct StaticOrder {
    int nM, nN, nwg, G, c, nt;
    __host__ __device__ void init(int M, int N, int G_, int c_, int K) { nM = M / BM; nN = N / BM; nwg = nM * nN; G = G_; c = c_; nt = K / BK; }
    __host__ __device__ __forceinline__ bool next(int i, Unit& u) const {
        const long L = (long)i * G + c; if (L >= nwg) return false;
        u.k0 = 0; u.nt = nt;
        int wgid = (int)L; { const int q = nwg / NXCD, r = nwg % NXCD, xcd = wgid % NXCD, off = wgid / NXCD; wgid = (xcd < r ? xcd * (q + 1) : r * (q + 1) + (xcd - r) * q) + off; }
        const int nig = WGM * nN, gid = wgid / nig, fm = gid * WGM, gsz = (nM - fm) < WGM ? (nM - fm) : WGM;
        u.pm = fm + ((wgid % nig) % gsz); u.pn = (wgid % nig) / gsz; return true;
    }
    __device__ __forceinline__ void a_ready(const Unit&) const {}
    __device__ __forceinline__ void done(const Unit&) const {}
};

struct SplitOrder {
    int nM, nN, nwg, G, c, ntfull, nsub, KS, ntsub;
    __host__ __device__ void init(int Mmain, int Mall, int N, int G_, int c_, int K, int KS_) { nM = Mmain / BM; nN = N / BM; nwg = nM * nN; G = G_; c = c_; ntfull = K / BK; KS = KS_; ntsub = K / BK / KS_; nsub = (Mall / BM - nM) * nN * KS_; }
    __host__ __device__ __forceinline__ bool next(int i, Unit& u) const {
        const long L = (long)i * G + c; if (L >= nwg + nsub) return false;
        int pm, pn, k0, ntu;
        if (L < nwg) {
            int wgid = (int)L; { const int q = nwg / NXCD, r = nwg % NXCD, xcd = wgid % NXCD, off = wgid / NXCD; wgid = (xcd < r ? xcd * (q + 1) : r * (q + 1) + (xcd - r) * q) + off; }
            const int nig = WGM * nN, gid = wgid / nig, fm = gid * WGM, gsz = (nM - fm) < WGM ? (nM - fm) : WGM;
            pm = fm + ((wgid % nig) % gsz); pn = (wgid % nig) / gsz; k0 = 0; ntu = ntfull;
        } else { const int j = (int)L - nwg, tile = j / KS, ks = j % KS; pm = nM + tile / nN; pn = tile % nN; k0 = ks * ntsub; ntu = ntsub; }
        u.pm = pm; u.pn = pn; u.k0 = k0; u.nt = ntu; return true;
    }
    __device__ __forceinline__ void a_ready(const Unit&) const {}
    __device__ __forceinline__ void done(const Unit&) const {}
};

__device__ __forceinline__ unsigned cvt_pk_bf16(float lo, float hi) { unsigned r; asm volatile("v_cvt_pk_bf16_f32 %0, %1, %2" : "=v"(r) : "v"(lo), "v"(hi)); return r; }

template <class Epi, class Sched, bool ALIGN_EPI = false, bool SP2 = false>
__device__ __forceinline__ void gemm_phase(PG8_LAS unsigned char* lds, const Gemm g, const Sched& S, const Epi& E) {
    const int tid = threadIdx.x, wid = __builtin_amdgcn_readfirstlane(tid >> 6), lane = tid & 63, wr = wid >> 2, wc = wid & 3, fr = lane & 15, fq = lane >> 4;
    const int K = g.K;
    unsigned voffA[2], voffB[2];
#pragma unroll
    for (int i = 0; i < 2; ++i) { int R, C; stage_rc(tid * 16 + i * 8192, R, C); const int Rb = Epi::PERM ? ((R & ~31) + perm32(R & 31)) : R;
        voffA[i] = (unsigned)(R * K + C) * 2u; voffB[i] = (unsigned)(Rb * K + C) * 2u; }
    const size_t kstep = (size_t)(BK * 2);
    const size_t hstep = (size_t)HALF * K * 2;
    const size_t tstep = 2 * hstep;
    const unsigned ldsw = (unsigned)wid * 1024u;
    const int aoff = lds_byte(wr * 64 + fr, fq * 8), boff = lds_byte(wc * 32 + fr, fq * 8);
#define PG8_SA(b, h) (((b) * 2 + (h)) * HTB)
#define PG8_SB(b, h) ((4 + (b) * 2 + (h)) * HTB)
#define PG8_STAGE(bufoff, gbase, voff) do { _Pragma("unroll") for (int _i = 0; _i < 2; ++_i) \
        __builtin_amdgcn_global_load_lds((const unsigned*)((const char*)(gbase) + (voff)[_i]), (PG8_LAS unsigned*)(lds + (bufoff) + ldsw + _i * 8192), 16, 0, 0); } while (0)
#define PG8_LDA(dst, b, h) do { _Pragma("unroll") for (int m = 0; m < 4; ++m) _Pragma("unroll") for (int k = 0; k < 2; ++k) dst[m][k] = *(const PG8_LAS bf16x8*)(lds + PG8_SA(b, h) + aoff + m * 2048 + k * 1024); } while (0)
#define PG8_LDB(dst, b, h) do { _Pragma("unroll") for (int n = 0; n < 2; ++n) _Pragma("unroll") for (int k = 0; k < 2; ++k) dst[n][k] = *(const PG8_LAS bf16x8*)(lds + PG8_SB(b, h) + boff + n * 2048 + k * 1024); } while (0)
#define PG8_MMA(ai, bj, At, Bt) do { __builtin_amdgcn_s_setprio(1); _Pragma("unroll") for (int m = 0; m < 4; ++m) _Pragma("unroll") for (int n = 0; n < 2; ++n) _Pragma("unroll") for (int k = 0; k < 2; ++k) \
        acc[ai][bj][m][n] = __builtin_amdgcn_mfma_f32_16x16x32_bf16(Bt[n][k], At[m][k], acc[ai][bj][m][n], 0, 0, 0); __builtin_amdgcn_s_setprio(0); } while (0)
#define PG8_WAIT_V(n) asm volatile("s_waitcnt vmcnt(" #n ")" ::: "memory")
#define PG8_WAIT_L(n) asm volatile("s_waitcnt lgkmcnt(" #n ")" ::: "memory")
#define PG8_BAR __builtin_amdgcn_s_barrier()
#define PG8_SCHED __builtin_amdgcn_sched_barrier(0)
    Unit cur, nxt; int ui = 0;
    if (!S.next(0, cur)) return;
    f32x4 acc[2][2][4][2];
#pragma unroll
    for (int a = 0; a < 2; ++a)
#pragma unroll
        for (int b = 0; b < 2; ++b)
#pragma unroll
            for (int m = 0; m < 4; ++m)
#pragma unroll
                for (int n = 0; n < 2; ++n) acc[a][b][m][n] = (f32x4){0.f, 0.f, 0.f, 0.f};
    bf16x8 At[4][2], B0[2][2], B1[2][2];
    const char* cA = (const char*)g.A + (size_t)cur.pm * tstep + (size_t)cur.k0 * kstep; const char* cB = (const char*)g.Bt + (size_t)cur.pn * tstep + (size_t)cur.k0 * kstep;
    S.a_ready(cur);
    if constexpr (SP2) {
        PG8_STAGE(PG8_SB(0, 0), cB, voffB); PG8_STAGE(PG8_SB(0, 1), cB + hstep, voffB); PG8_STAGE(PG8_SA(0, 0), cA, voffA); PG8_STAGE(PG8_SA(0, 1), cA + hstep, voffA);
        if (wr == 1) PG8_BAR;
        PG8_WAIT_V(2); PG8_BAR;
        PG8_STAGE(PG8_SB(1, 0), cB + kstep, voffB); PG8_STAGE(PG8_SA(1, 0), cA + kstep, voffA); PG8_STAGE(PG8_SB(1, 1), cB + hstep + kstep, voffB);
        PG8_WAIT_V(6); PG8_BAR;
    } else {
        PG8_STAGE(PG8_SB(0, 0), cB, voffB); PG8_STAGE(PG8_SA(0, 0), cA, voffA); PG8_STAGE(PG8_SB(0, 1), cB + hstep, voffB); PG8_STAGE(PG8_SA(0, 1), cA + hstep, voffA);
        if (wr == 1) PG8_BAR;
        PG8_WAIT_V(4); PG8_BAR;
        PG8_STAGE(PG8_SB(1, 0), cB + kstep, voffB); PG8_STAGE(PG8_SA(1, 0), cA + kstep, voffA); PG8_STAGE(PG8_SB(1, 1), cB + hstep + kstep, voffB);
        PG8_WAIT_V(6); PG8_BAR;
    }
    for (;;) {
        const bool has_next = S.next(ui + 1, nxt);
        const char* nA = has_next ? (const char*)g.A + (size_t)nxt.pm * tstep + (size_t)nxt.k0 * kstep : cA; const char* nB = has_next ? (const char*)g.Bt + (size_t)nxt.pn * tstep + (size_t)nxt.k0 * kstep : cB;
        const int nt = cur.nt;
        for (int t = 0; t < nt; t += 2) {
            const bool last = (t == nt - 2);
            const char* a1 = cA + (size_t)(t + 1) * kstep;
            const char* a2 = last ? nA : cA + (size_t)(t + 2) * kstep; const char* b2 = last ? nB : cB + (size_t)(t + 2) * kstep;
            const char* a3 = a2 + kstep; const char* b3 = b2 + kstep;
            if (last && has_next) S.a_ready(nxt);
            if constexpr (SP2) {
            PG8_LDB(B0, 0, 0); PG8_LDB(B1, 0, 1); PG8_SCHED; PG8_LDA(At, 0, 0); PG8_STAGE(PG8_SA(1, 1), a1 + hstep, voffA);
            PG8_WAIT_V(8); PG8_WAIT_L(0); PG8_BAR; PG8_MMA(0, 0, At, B0); PG8_MMA(0, 1, At, B1); PG8_BAR; PG8_SCHED;
            PG8_LDA(At, 0, 1); PG8_STAGE(PG8_SB(0, 0), b2, voffB); PG8_STAGE(PG8_SB(0, 1), b2 + hstep, voffB); PG8_STAGE(PG8_SA(0, 0), a2, voffA);
            PG8_WAIT_V(8); PG8_WAIT_L(0); PG8_BAR; PG8_MMA(1, 0, At, B0); PG8_MMA(1, 1, At, B1); PG8_BAR; PG8_SCHED;
            PG8_LDB(B0, 1, 0); PG8_LDB(B1, 1, 1); PG8_SCHED; PG8_LDA(At, 1, 0); PG8_STAGE(PG8_SA(0, 1), a2 + hstep, voffA);
            PG8_WAIT_V(8); PG8_WAIT_L(0); PG8_BAR; PG8_MMA(0, 0, At, B0); PG8_MMA(0, 1, At, B1); PG8_BAR; PG8_SCHED;
            PG8_LDA(At, 1, 1); PG8_STAGE(PG8_SB(1, 0), b3, voffB); PG8_STAGE(PG8_SB(1, 1), b3 + hstep, voffB); PG8_STAGE(PG8_SA(1, 0), a3, voffA);
            PG8_WAIT_V(8); PG8_WAIT_L(0); PG8_BAR; PG8_MMA(1, 0, At, B0); PG8_MMA(1, 1, At, B1); PG8_BAR; PG8_SCHED;
            } else {
            PG8_LDB(B0, 0, 0); PG8_SCHED; PG8_LDA(At, 0, 0); PG8_STAGE(PG8_SA(1, 1), a1 + hstep, voffA);
            PG8_WAIT_L(8); PG8_BAR; PG8_WAIT_L(0); PG8_MMA(0, 0, At, B0); PG8_BAR; PG8_SCHED;
            PG8_LDB(B1, 0, 1); PG8_STAGE(PG8_SB(0, 0), b2, voffB);
            PG8_BAR; PG8_WAIT_L(0); PG8_MMA(0, 1, At, B1); PG8_BAR;
            PG8_LDA(At, 0, 1); PG8_STAGE(PG8_SA(0, 0), a2, voffA);
            PG8_BAR; PG8_WAIT_L(0); PG8_MMA(1, 0, At, B0); PG8_BAR; PG8_SCHED;
            PG8_STAGE(PG8_SB(0, 1), b2 + hstep, voffB);
            PG8_WAIT_V(6); PG8_BAR; PG8_MMA(1, 1, At, B1); PG8_BAR;
            PG8_LDB(B0, 1, 0); PG8_SCHED; PG8_LDA(At, 1, 0); PG8_STAGE(PG8_SA(0, 1), a2 + hstep, voffA);
            PG8_WAIT_L(8); PG8_BAR; PG8_WAIT_L(0); PG8_MMA(0, 0, At, B0); PG8_BAR; PG8_SCHED;
            PG8_LDB(B1, 1, 1); PG8_STAGE(PG8_SB(1, 0), b3, voffB);
            PG8_BAR; PG8_WAIT_L(0); PG8_MMA(0, 1, At, B1); PG8_BAR;
            PG8_LDA(At, 1, 1); PG8_STAGE(PG8_SA(1, 0), a3, voffA);
            PG8_BAR; PG8_WAIT_L(0); PG8_MMA(1, 0, At, B0); PG8_BAR; PG8_SCHED;
            PG8_STAGE(PG8_SB(1, 1), b3 + hstep, voffB);
            PG8_WAIT_V(6); PG8_BAR; PG8_MMA(1, 1, At, B1); PG8_BAR;
            }
        }
        if constexpr (ALIGN_EPI) { if (wr == 0) PG8_BAR; }
        E(acc, cur, wr, wc, fr, fq); S.done(cur);
        if (!has_next) break;
#pragma unroll
        for (int a = 0; a < 2; ++a)
#pragma unroll
            for (int b = 0; b < 2; ++b)
#pragma unroll
                for (int m = 0; m < 4; ++m)
#pragma unroll
                    for (int n = 0; n < 2; ++n) acc[a][b][m][n] = (f32x4){0.f, 0.f, 0.f, 0.f};
        cur = nxt; cA = nA; cB = nB; ++ui;
        if constexpr (ALIGN_EPI) { if (wr == 1) PG8_BAR; }
    }
    PG8_WAIT_V(0);
    if constexpr (!ALIGN_EPI) { if (wr == 0) PG8_BAR; }
    PG8_BAR;
#undef PG8_SA
#undef PG8_SB
#undef PG8_STAGE
#undef PG8_LDA
#undef PG8_LDB
#undef PG8_MMA
#undef PG8_WAIT_V
#undef PG8_WAIT_L
#undef PG8_BAR
#undef PG8_SCHED
}
}

constexpr int NWAVES = 8;
constexpr int DM = 1024, BP = 8, SEQ = 2048, NMETA = 16, TP = SEQ + NMETA, BS = 128, TS = 4;
constexpr int RP = BP * TP;
constexpr int RS = BS * TS;
constexpr int MR = RP + RS;
constexpr int MP = 17152;
constexpr int M2 = BP * SEQ + RS;
constexpr int NH = 8, DH = 128, DQKV = 3072, DFF = 4096, KC = 31, KS = 4;
constexpr int NIN = 8448;
constexpr int DIN = 8208;
constexpr float EPS = 1e-6f;

constexpr size_t O_YP = 0, O_YS = 16777216, O_PC = 17301504, O_PQ = 17547264, O_PD = 17620992, O_SC = 18669568, O_SQ = 22601728, O_SD = 23781376, O_END = 40558592;

constexpr size_t MiB = 1u << 20;
constexpr size_t WS_CTL = 0, CTL_ZERO_BYTES = 1 * MiB;
constexpr size_t WS_BETAG = 1 * MiB;
constexpr size_t WS_LASTV = 9 * MiB / 4;
constexpr size_t WS_HALOQ = 5 * MiB / 2;
constexpr size_t WS_WC = 29 * MiB / 4, WS_WD = WS_WC + 2 * MiB, WS_WO = WS_WD + 2 * MiB, WS_WUP = WS_WO + 2 * MiB, WS_WDN = WS_WUP + 8 * MiB;
constexpr size_t WS_GLU = 117 * MiB / 4;
constexpr size_t WS_QKVB = 63 * MiB;
constexpr size_t WS_QS = 162 * MiB;
constexpr size_t WS_ZS = 165 * MiB;
constexpr size_t WS_H = 397 * MiB / 2;
constexpr size_t WS_WIN = 232 * MiB;
constexpr size_t WS_HALOC = 497 * MiB / 2;
constexpr size_t WS_KDT = WS_H, WS_ATTN = 463 * MiB / 2;
constexpr size_t WS_MIX = WS_QKVB, WS_XG = WS_GLU, WS_HM = WS_QKVB, WS_C = WS_GLU;
constexpr int KSPLIT5 = 4; constexpr size_t WS_PART5 = WS_H;
constexpr int KSPLIT = 16;
constexpr size_t WS_PART = WS_XG;
static_assert(WS_PART + (size_t)KSPLIT * RS * DM * 4 <= WS_QKVB, "ws map part");
constexpr size_t WS_END = 256 * MiB;
constexpr int NRUN = 16, RUNL = TP / NRUN;
static_assert(TP - 64 * 32 == 16 && NRUN * RUNL == TP && WS_HALOC + (size_t)BP * NRUN * 30 * DM * 2 <= WS_END, "conv runs");
constexpr int NCH = 33, QBLK = 3 * 64 * 128;
static_assert(WS_WIN + (size_t)NIN * DM * 2 <= WS_HALOC && WS_WDN + 8 * MiB <= WS_GLU && WS_GLU + (size_t)MP * DM * 2 <= WS_QKVB && WS_HALOQ + (size_t)BP * 33 * 3 * 3072 * 2 <= WS_WC, "ws map");
static_assert(WS_ZS + (size_t)MP * DM * 2 <= WS_H && WS_H + (size_t)MP * DM * 2 <= WS_WIN, "ws map 2");
static_assert(WS_QKVB + (size_t)BP * NCH * NH * QBLK * 2 <= WS_QS, "ws map qkvb");
static_assert(WS_HM + (size_t)M2 * DFF * 2 <= WS_H, "ws map hm");
static_assert(WS_KDT + (size_t)BP * NCH * NH * 8192 * 2 <= WS_ATTN && WS_ATTN + (size_t)BP * NCH * NH * 4096 * 2 <= WS_HALOC, "ws map kdt");
constexpr int CW_TMO = 0, CW_CODE = 1, CW_BAR = 4096;

constexpr int RING_OFF = 0, RING_BYTES = 131072;
constexpr int LDSCTL_OFF = 151552, MISC_OFF = LDSCTL_OFF + 320;
constexpr int LDS_BYTES = LDSCTL_OFF + 1024;

#define GAS __attribute__((address_space(1)))
#define LAS __attribute__((address_space(3)))
typedef unsigned short bf16;
typedef unsigned v4u __attribute__((ext_vector_type(4)));
typedef unsigned v2u __attribute__((ext_vector_type(2)));
typedef float f32x4 __attribute__((ext_vector_type(4)));
typedef float f32x2 __attribute__((ext_vector_type(2)));
typedef GAS unsigned gu32;
#define RLX_AGENT __ATOMIC_RELAXED, __HIP_MEMORY_SCOPE_AGENT
#define LDS_WAIT() asm volatile("s_waitcnt lgkmcnt(0)" ::: "memory")
#define VM_WAIT() asm volatile("s_waitcnt vmcnt(0)" ::: "memory")
__device__ __forceinline__ unsigned f2bf(float f) { unsigned u = __builtin_bit_cast(unsigned, f); return (u + 0x7fffu + ((u >> 16) & 1u)) >> 16; }
__device__ __forceinline__ unsigned pk2(float lo, float hi) { return f2bf(lo) | (f2bf(hi) << 16); }
__device__ __forceinline__ float bflo(unsigned w) { return __builtin_bit_cast(float, w << 16); }
__device__ __forceinline__ float bfhi(unsigned w) { return __builtin_bit_cast(float, w & 0xffff0000u); }
__device__ __forceinline__ float bf1(bf16 b) { return __builtin_bit_cast(float, ((unsigned)b) << 16); }
__device__ __forceinline__ float sigmoidf_(float x) { return __builtin_amdgcn_rcpf(1.f + __expf(-x)); }
__device__ __forceinline__ float siluf_(float x) { return x * sigmoidf_(x); }

#define XB_TMO      128
#define XB_XCNT(j)  (256  + 64 * (j))
#define XB_XSUB(j)  (1280 + 64 * (j))
#define XB_XGEN(j)  (2304 + 64 * (j))
#define XB_TOP      3328
#define XB_TOPGEN   3392
#define XCD_BAR_WORDS 3456
#define XB_SPIN_CAP (1u << 18)
__device__ __forceinline__ unsigned xb_ld(unsigned* p)              { return __hip_atomic_load(p, __ATOMIC_RELAXED, __HIP_MEMORY_SCOPE_AGENT); }
__device__ __forceinline__ unsigned xb_add(unsigned* p, unsigned v) { return __hip_atomic_fetch_add(p, v, __ATOMIC_RELAXED, __HIP_MEMORY_SCOPE_AGENT); }
__device__ __forceinline__ unsigned xb_xcc_id() { return (unsigned)__builtin_amdgcn_s_getreg((3 << 11) | 20) & 0xFu; }
#define XB_SPIN(cond, bar) do { unsigned _sp = 0; while (cond) { __builtin_amdgcn_s_sleep(1); \
    if ((++_sp & 255u) == 0u) { if (xb_ld(&(bar)[XB_TMO])) break; if (_sp > XB_SPIN_CAP) { atomicAdd(&(bar)[XB_TMO], 1u); break; } } } } while (0)
struct XcdBarrier { unsigned* bar; unsigned x; volatile LAS unsigned* st; };
__device__ __forceinline__ XcdBarrier xcd_barrier_post(unsigned* bar, volatile LAS unsigned* st) {
    XcdBarrier b; b.bar = bar; b.x = xb_xcc_id(); b.st = st;
    if (threadIdx.x == 0) (void)xb_add(&bar[XB_XCNT(b.x)], 1u);
    return b;
}
__device__ __forceinline__ void xcd_barrier_complete(unsigned* bar, unsigned x, unsigned& nloc, unsigned& nx) {
    const unsigned G = gridDim.x * gridDim.y * gridDim.z;
    unsigned sum, cnt, mine, sp = 0u;
    for (;;) {
        sum = 0u; cnt = 0u; mine = 0u;
#pragma unroll
        for (unsigned j = 0; j < 16; ++j) { const unsigned c = xb_ld(&bar[XB_XCNT(j)]); sum += c; cnt += (c > 0u) ? 1u : 0u; mine = (j == x) ? c : mine; }
        if (sum == G) break;
        __builtin_amdgcn_s_sleep(1);
        if ((++sp & 255u) == 0u) { if (xb_ld(&bar[XB_TMO])) break; if (sp > XB_SPIN_CAP) { atomicAdd(&bar[XB_TMO], 1u); break; } }
    }
    nloc = mine > 0u ? mine : 1u; nx = cnt > 0u ? cnt : 1u;
}
__device__ __forceinline__ void xcd_barrier(const XcdBarrier& b) {
    asm volatile("s_waitcnt vmcnt(0)" ::: "memory");
    __syncthreads();
    if (threadIdx.x == 0) {
        unsigned* bar = b.bar;
        __builtin_amdgcn_s_waitcnt(0);
        unsigned nloc = b.st[0], nx = b.st[1];
        if (nloc == 0u) { xcd_barrier_complete(bar, b.x, nloc, nx); b.st[0] = nloc; b.st[1] = nx; }
        const unsigned old = xb_add(&bar[XB_XSUB(b.x)], 1u);
        const unsigned gen = old / nloc;
        if (old + 1u == (gen + 1u) * nloc) {
            __builtin_amdgcn_fence(__ATOMIC_RELEASE, "agent");
            asm volatile("s_waitcnt vmcnt(0)" ::: "memory");
            const unsigned og = xb_add(&bar[XB_TOP], 1u);
            const unsigned tg = og / nx;
            if (og + 1u == (tg + 1u) * nx) xb_add(&bar[XB_TOPGEN], 1u);
            else XB_SPIN(xb_ld(&bar[XB_TOPGEN]) == tg, bar);
            __builtin_amdgcn_fence(__ATOMIC_ACQUIRE, "agent");
            xb_add(&bar[XB_XGEN(b.x)], 1u);
            asm volatile("s_waitcnt vmcnt(0)" ::: "memory");
        } else {
            XB_SPIN(xb_ld(&bar[XB_XGEN(b.x)]) == gen, bar);
            __builtin_amdgcn_fence(__ATOMIC_ACQUIRE, "agent");
            asm volatile("s_waitcnt vmcnt(0)" ::: "memory");
        }
    }
    __syncthreads();
}

struct Args { const float* in[23]; float* out; unsigned char* ws; int ph_lo, ph_hi; };

#define DPP_ADD(v, ctrl, rmask, bc) v += __builtin_bit_cast(float, __builtin_amdgcn_update_dpp(0, __builtin_bit_cast(int, v), ctrl, rmask, 0xF, bc))
__device__ __forceinline__ float sum16(float v) {
    DPP_ADD(v, 0xB1, 0xF, true); DPP_ADD(v, 0x4E, 0xF, true); DPP_ADD(v, 0x141, 0xF, true); DPP_ADD(v, 0x140, 0xF, true); return v; }
__device__ __forceinline__ float wave_sum(float v) {
    v = sum16(v); DPP_ADD(v, 0x142, 0xA, false); DPP_ADD(v, 0x143, 0xC, false);
    return __builtin_bit_cast(float, __builtin_amdgcn_readlane(__builtin_bit_cast(int, v), 63)); }
__device__ __forceinline__ float rsqf(float x) { return __builtin_amdgcn_rsqf(x); }
__device__ __forceinline__ unsigned cvtpk(float lo, float hi) { unsigned r; asm("v_cvt_pk_bf16_f32 %0, %1, %2" : "=v"(r) : "v"(lo), "v"(hi)); return r; }
__device__ __forceinline__ int compact_row(int r) {
    if (r >= MR) return -1;
    if (r >= RP) return r - RP + BP * SEQ;
    const int b = r / TP, t = r - b * TP;
    return t < NMETA ? -1 : r - NMETA * (b + 1);
}

__device__ __forceinline__ void p0_transpose_item(const float* W, int Nsrc, int K, bf16* WT, int dst_row0, int src_col0, int nvalid, int k0, int lane) {
    const float* src = W + (size_t)k0 * Nsrc + src_col0 + (lane < nvalid ? lane : 0);
    float v[32];
#pragma unroll
    for (int j = 0; j < 32; ++j) v[j] = src[(size_t)j * Nsrc];
    if (lane >= nvalid) {
#pragma unroll
        for (int j = 0; j < 32; ++j) v[j] = 0.f; }
    GAS v4u* dst = (GAS v4u*)(WT + (size_t)(dst_row0 + lane) * K + k0);
#pragma unroll
    for (int q = 0; q < 4; ++q) { v4u o; o.x = cvtpk(v[8 * q], v[8 * q + 1]); o.y = cvtpk(v[8 * q + 2], v[8 * q + 3]); o.z = cvtpk(v[8 * q + 4], v[8 * q + 5]); o.w = cvtpk(v[8 * q + 6], v[8 * q + 7]); dst[q] = o; }
}
__device__ __forceinline__ void win_src(int nb, int& src, int& nvalid) {
    const int pn = nb >> 2, o = (nb & 3) * 64; nvalid = 64;
    if (pn < 8) src = (o < 128) ? 128 * pn + o : 1024 + 128 * pn + (o - 128);
    else if (pn < 20) src = 2048 + 256 * (pn - 8) + o;
    else if (pn < 24) src = 5120 + 256 * (pn - 20) + o;
    else if (pn < 28) src = 6160 + 256 * (pn - 24) + o;
    else if (pn < 32) src = 7184 + 256 * (pn - 28) + o;
    else { src = 6144; nvalid = (o == 0) ? 16 : 0; }
}
__device__ __forceinline__ void rms_row_to_bf16(const float* xrow, const float* gain, bf16* orow, int lane) {
    const GAS f32x4* xr = (const GAS f32x4*)xrow + lane; const GAS f32x4* gr = (const GAS f32x4*)gain + lane;
    f32x4 v[4]; float s = 0.f;
#pragma unroll
    for (int j = 0; j < 4; ++j) { v[j] = xr[64 * j]; s += (v[j].x * v[j].x + v[j].y * v[j].y) + (v[j].z * v[j].z + v[j].w * v[j].w); }
    const float rstd = 1.f / sqrtf(wave_sum(s) * (1.f / DM) + EPS);
    GAS unsigned long long* o8 = (GAS unsigned long long*)orow + lane;
#pragma unroll
    for (int j = 0; j < 4; ++j) { const f32x4 g = gr[64 * j]; o8[64 * j] = (unsigned long long)pk2(v[j].x * rstd * g.x, v[j].y * rstd * g.y) | ((unsigned long long)pk2(v[j].z * rstd * g.z, v[j].w * rstd * g.w) << 32); }
}

typedef pg8::f32x4 A4;
struct EpiIn {
    static constexpr bool PERM = true;
    bf16 *GLU, *QKVB, *QS, *HALOQ, *HALOC, *ZS, *SGC, *SGD; float* BETAG; const float *a_log, *dt_bias;
    __device__ __forceinline__ void operator()(const A4 (&acc)[2][2][4][2], const pg8::Unit& u, int wr, int wc, int fr, int fq) const {
        const int pn = u.pn, row0 = u.pm * 256 + wr * 64 + fr, cw = 32 * wc + 8 * fq;
        if (pn < 8) {
#pragma unroll
            for (int ai = 0; ai < 2; ++ai)
#pragma unroll
                for (int m = 0; m < 4; ++m) { const int r = row0 + ai * 128 + m * 16; float o[8];
#pragma unroll
                    for (int n = 0; n < 2; ++n)
#pragma unroll
                        for (int j = 0; j < 4; ++j) o[4 * n + j] = acc[ai][0][m][n][j] * sigmoidf_(acc[ai][1][m][n][j]);
                    v4u w; w.x = pk2(o[0], o[1]); w.y = pk2(o[2], o[3]); w.z = pk2(o[4], o[5]); w.w = pk2(o[6], o[7]);
                    *(GAS v4u*)(GLU + (size_t)r * DM + 128 * pn + cw) = w;
                    if (r < RP) { const int b = r / TP, t = r - b * TP, run = t / RUNL, pos = t - run * RUNL;
                        if (pos >= RUNL - 30 && run < NRUN - 1) *(GAS v4u*)(HALOC + ((size_t)(b * NRUN + run) * 30 + (pos - (RUNL - 30))) * DM + 128 * pn + cw) = w; } }
        } else if (pn < 20) {
            const int colb = 256 * (pn - 8);
#pragma unroll
            for (int ai = 0; ai < 2; ++ai)
#pragma unroll
                for (int m = 0; m < 4; ++m) { const int r = row0 + ai * 128 + m * 16; if (r >= MR) continue;
#pragma unroll
                    for (int bj = 0; bj < 2; ++bj) { const int col = colb + 128 * bj + cw;
                        const A4 a0 = acc[ai][bj][m][0], a1 = acc[ai][bj][m][1];
                        v4u w; w.x = pk2(a0[0], a0[1]); w.y = pk2(a0[2], a0[3]); w.z = pk2(a1[0], a1[1]); w.w = pk2(a1[2], a1[3]);
                        if (r >= RP) *(GAS v4u*)(QS + (size_t)(r - RP) * DQKV + col) = w;
                        else { const int b = r / TP, t = r - b * TP, c = t >> 6, i = t & 63, which = col >> 10, h = (col >> 7) & 7, d = col & 127;
                            *(GAS v4u*)(QKVB + ((size_t)((b * NCH + c) * NH + h) * 3 + which) * 8192 + i * 128 + d) = w;
                            if (i >= 61) *(GAS v4u*)(HALOQ + ((size_t)(b * NCH + c) * 3 + (i - 61)) * DQKV + col) = w; } } }
        } else if (pn < 24) {
            constexpr bool isz = true; bf16* dst = ZS; const int ld = DM, cb = 256 * (pn - 20);
#pragma unroll
            for (int ai = 0; ai < 2; ++ai)
#pragma unroll
                for (int m = 0; m < 4; ++m) { const int r = row0 + ai * 128 + m * 16;
#pragma unroll
                    for (int bj = 0; bj < 2; ++bj) { float o[8];
#pragma unroll
                        for (int n = 0; n < 2; ++n)
#pragma unroll
                            for (int j = 0; j < 4; ++j) { const float v = acc[ai][bj][m][n][j]; o[4 * n + j] = isz ? siluf_(v) : v; }
                        v4u w; w.x = pk2(o[0], o[1]); w.y = pk2(o[2], o[3]); w.z = pk2(o[4], o[5]); w.w = pk2(o[6], o[7]);
                        *(GAS v4u*)(dst + (size_t)r * ld + cb + 128 * bj + cw) = w; } }
        } else if (pn < 32) {
            bf16* dst = pn < 28 ? SGC : SGD; const int cb = 256 * ((pn - 24) & 3);
#pragma unroll
            for (int ai = 0; ai < 2; ++ai)
#pragma unroll
                for (int m = 0; m < 4; ++m) { const int rc = compact_row(row0 + ai * 128 + m * 16); if (rc < 0) continue;
#pragma unroll
                    for (int bj = 0; bj < 2; ++bj) { float o[8];
#pragma unroll
                        for (int n = 0; n < 2; ++n)
#pragma unroll
                            for (int j = 0; j < 4; ++j) o[4 * n + j] = sigmoidf_(acc[ai][bj][m][n][j]);
                        v4u w; w.x = pk2(o[0], o[1]); w.y = pk2(o[2], o[3]); w.z = pk2(o[4], o[5]); w.w = pk2(o[6], o[7]);
                        *(GAS v4u*)(dst + (size_t)rc * DM + cb + 128 * bj + cw) = w; } }
        } else {
            if (wc == 0 && fq < 2) {
#pragma unroll
                for (int ai = 0; ai < 2; ++ai)
#pragma unroll
                    for (int m = 0; m < 4; ++m) { const int r = row0 + ai * 128 + m * 16; float o[8];
#pragma unroll
                        for (int n = 0; n < 2; ++n)
#pragma unroll
                            for (int j = 0; j < 4; ++j) { const int h = 4 * n + j; const float v = acc[ai][0][m][n][j];
                                if (fq == 0) o[h] = 1.f / (1.f + expf(-v));
                                else { const float xx = v + dt_bias[h]; const float sp = xx > 20.f ? xx : log1pf(expf(xx)); o[h] = -expf(a_log[h]) * sp; } }
                        GAS f32x4* p = (GAS f32x4*)(BETAG + (size_t)r * 16 + 8 * fq);
                        p[0] = (f32x4){o[0], o[1], o[2], o[3]}; p[1] = (f32x4){o[4], o[5], o[6], o[7]}; }
            }
        }
    }
};
template <int MODE> struct EpiGate {
    static constexpr bool PERM = true;
    bf16 *SG, *MA, *OUT;
    __device__ __forceinline__ void operator()(const A4 (&acc)[2][2][4][2], const pg8::Unit& u, int wr, int wc, int fr, int fq) const {
        const int row0 = u.pm * 256 + wr * 64 + fr, c0 = 256 * u.pn + 32 * wc + 8 * fq;
#pragma unroll
        for (int ai = 0; ai < 2; ++ai)
#pragma unroll
            for (int m = 0; m < 4; ++m) { const int rc = compact_row(row0 + ai * 128 + m * 16); if (rc < 0) continue;
#pragma unroll
                for (int bj = 0; bj < 2; ++bj) { const size_t off = (size_t)rc * DM + c0 + 128 * bj;
                    const v4u g = *(const GAS v4u*)(SG + off); float o[8];
                    const A4 a0 = acc[ai][bj][m][0], a1 = acc[ai][bj][m][1];
                    o[0] = bflo(g.x) * a0[0]; o[1] = bfhi(g.x) * a0[1]; o[2] = bflo(g.y) * a0[2]; o[3] = bfhi(g.y) * a0[3];
                    o[4] = bflo(g.z) * a1[0]; o[5] = bfhi(g.z) * a1[1]; o[6] = bflo(g.w) * a1[2]; o[7] = bfhi(g.w) * a1[3];
                    if (MODE == 1) { const v4u q = *(const GAS v4u*)(MA + off);
                        o[0] += bflo(q.x); o[1] += bfhi(q.x); o[2] += bflo(q.y); o[3] += bfhi(q.y); o[4] += bflo(q.z); o[5] += bfhi(q.z); o[6] += bflo(q.w); o[7] += bfhi(q.w); }
                    v4u w; w.x = pk2(o[0], o[1]); w.y = pk2(o[2], o[3]); w.z = pk2(o[4], o[5]); w.w = pk2(o[6], o[7]);
                    *(GAS v4u*)(OUT + off) = w; } }
    }
};
template <int MODE> struct EpiRes {
    static constexpr bool PERM = false;
    const float *xp, *xs; float* out; float* parts;
    __device__ __forceinline__ void operator()(const A4 (&acc)[2][2][4][2], const pg8::Unit& u, int wr, int wc, int fr, int fq) const {
        const int row0 = u.pm * 256 + wr * 64 + fr, c0 = 256 * u.pn + 32 * wc + 4 * fq;
        if (u.pm >= BP * SEQ / 256) {
            float* part = parts + (size_t)(u.k0 / u.nt) * RS * DM;
#pragma unroll
            for (int ai = 0; ai < 2; ++ai)
#pragma unroll
                for (int m = 0; m < 4; ++m) { float* orow = part + (size_t)(row0 + ai * 128 + m * 16 - BP * SEQ) * DM;
#pragma unroll
                    for (int bj = 0; bj < 2; ++bj)
#pragma unroll
                        for (int n = 0; n < 2; ++n) *(GAS f32x4*)(orow + c0 + 128 * bj + 16 * n) = acc[ai][bj][m][n]; }
            return; }
#pragma unroll
        for (int ai = 0; ai < 2; ++ai)
#pragma unroll
            for (int m = 0; m < 4; ++m) { const int r = row0 + ai * 128 + m * 16;
                const float* base = MODE == 0 ? (r < BP * SEQ ? xp + (size_t)r * DM : xs + (size_t)(r - BP * SEQ) * DM) : out + (size_t)r * DM;
                float* orow = out + (size_t)r * DM;
#pragma unroll
                for (int bj = 0; bj < 2; ++bj)
#pragma unroll
                    for (int n = 0; n < 2; ++n) { const int c = c0 + 128 * bj + 16 * n; const f32x4 b = *(const GAS f32x4*)(base + c); *(GAS f32x4*)(orow + c) = b + acc[ai][bj][m][n]; } }
    }
};
struct EpiUp {
    static constexpr bool PERM = true;
    bf16* HM;
    __device__ __forceinline__ void operator()(const A4 (&acc)[2][2][4][2], const pg8::Unit& u, int wr, int wc, int fr, int fq) const {
        const int row0 = u.pm * 256 + wr * 64 + fr, c0 = 256 * u.pn + 32 * wc + 8 * fq;
#pragma unroll
        for (int ai = 0; ai < 2; ++ai)
#pragma unroll
            for (int m = 0; m < 4; ++m) { const int r = row0 + ai * 128 + m * 16;
#pragma unroll
                for (int bj = 0; bj < 2; ++bj) { float o[8];
#pragma unroll
                    for (int n = 0; n < 2; ++n)
#pragma unroll
                        for (int j = 0; j < 4; ++j) { const float v = fmaxf(acc[ai][bj][m][n][j], 0.f); o[4 * n + j] = v * v; }
                    v4u w; w.x = pk2(o[0], o[1]); w.y = pk2(o[2], o[3]); w.z = pk2(o[4], o[5]); w.w = pk2(o[6], o[7]);
                    *(GAS v4u*)(HM + (size_t)r * DFF + c0 + 128 * bj) = w; } }
    }
};

template <int KIND>
__device__ __forceinline__ void conv_unit(const Args& a, LAS unsigned char* lds, int b, int run) {
    asm volatile("" ::: "memory");
    const int tid = threadIdx.x, lane = tid & 63, wave = tid >> 6; int ch = 2 * tid; asm volatile("" : "+v"(ch));
    unsigned char* ws = a.ws;
    bf16* GC = (bf16*)(ws + WS_GLU); const bf16* HALOC = (const bf16*)(ws + WS_HALOC);
    const float* w_dw = a.in[8];
    LAS float* red = (LAS float*)lds;
    constexpr int NTOK = KIND == 0 ? RUNL : TS, NSTEP = (NTOK + 3) / 4, REM = NTOK - 4 * (NSTEP - 1);
    f32x2 w[KC]; unsigned E[KC + 3];
#pragma unroll
    for (int i = 0; i < KC; ++i) w[i] = *(const GAS f32x2*)(w_dw + (size_t)i * DM + ch);
    const f32x2 bdw = *(const GAS f32x2*)(a.in[9] + ch), lng = *(const GAS f32x2*)(a.in[10] + ch), lnb = *(const GAS f32x2*)(a.in[11] + ch);
    const int row0 = KIND == 0 ? b * TP + run * RUNL : RP + b * TS;
    if (KIND == 0) {
#pragma unroll
        for (int i = 0; i < KC - 1; ++i) { unsigned v = *(const GAS unsigned*)(HALOC + ((size_t)(b * NRUN + (run > 0 ? run - 1 : 0)) * 30 + i) * DM + ch); E[i] = run > 0 ? v : 0u; }
    } else { const float* st = a.in[2] + (size_t)b * (KC - 1) * DM;
#pragma unroll
        for (int i = 0; i < KC - 1; ++i) { const f32x2 v = *(const GAS f32x2*)(st + (size_t)i * DM + ch); E[i] = pk2(v.x, v.y); }
    }
    unsigned nx[4];
#pragma unroll
    for (int k = 0; k < 4; ++k) nx[k] = *(const GAS unsigned*)(GC + (size_t)(row0 + (k < NTOK ? k : NTOK - 1)) * DM + ch);
    for (int st4 = 0; st4 < NSTEP; ++st4) {
        const int t0 = 4 * st4;
#pragma unroll
        for (int k = 0; k < 4; ++k) E[KC - 1 + k] = nx[k];
        if (st4 + 1 < NSTEP) {
#pragma unroll
            for (int k = 0; k < 4; ++k) { const int t = t0 + 4 + k; nx[k] = *(const GAS unsigned*)(GC + (size_t)(row0 + (t < NTOK ? t : NTOK - 1)) * DM + ch); }
        }
        f32x2 y[4] = {bdw, bdw, bdw, bdw};
#pragma unroll
        for (int j = 0; j < KC + 3; ++j) { const f32x2 e = {bflo(E[j]), bfhi(E[j])};
#pragma unroll
            for (int k = 0; k < 4; ++k) { const int i = j - k; if (i >= 0 && i < KC) y[k] += w[i] * e; } }
        float sv[8];
#pragma unroll
        for (int k = 0; k < 4; ++k) { sv[2 * k] = wave_sum(y[k].x + y[k].y); sv[2 * k + 1] = wave_sum(y[k].x * y[k].x + y[k].y * y[k].y); }
        LAS float* rb = red + (st4 & 1) * 64;
        if (lane == 0) { *(LAS f32x4*)(rb + wave * 8) = (f32x4){sv[0], sv[1], sv[2], sv[3]}; *(LAS f32x4*)(rb + wave * 8 + 4) = (f32x4){sv[4], sv[5], sv[6], sv[7]}; }
        __syncthreads();
        f32x4 ta = {0.f, 0.f, 0.f, 0.f}, tb = {0.f, 0.f, 0.f, 0.f};
#pragma unroll
        for (int i = 0; i < 8; ++i) { ta += *(const LAS f32x4*)(rb + i * 8); tb += *(const LAS f32x4*)(rb + i * 8 + 4); }
        const float tt[8] = {ta.x, ta.y, ta.z, ta.w, tb.x, tb.y, tb.z, tb.w};
#pragma unroll
        for (int k = 0; k < 4; ++k) { if (t0 + k < NTOK) {
            const float mu = tt[2 * k] * (1.f / DM), var = fmaxf(tt[2 * k + 1] * (1.f / DM) - mu * mu, 0.f), rstd = rsqf(var + EPS);
            const float z0 = (y[k].x - mu) * rstd * lng.x + lnb.x, z1 = (y[k].y - mu) * rstd * lng.y + lnb.y;
            *(GAS unsigned*)(GC + (size_t)(row0 + t0 + k) * DM + ch) = pk2(siluf_(z0), siluf_(z1)); } }
        if (st4 + 1 < NSTEP) {
#pragma unroll
            for (int i = 0; i < KC - 1; ++i) E[i] = E[i + 4];
        }
    }
    if (KIND == 1 || run == NRUN - 1) { float* o = a.out + (KIND == 0 ? O_PC : O_SC) + (size_t)b * (KC - 1) * DM;
        if (KIND == 0) {
#pragma unroll
            for (int i = 0; i < KC - 1; ++i) *(GAS f32x2*)(o + (size_t)i * DM + ch) = (f32x2){bflo(E[REM + i]), bfhi(E[REM + i])};
        } else {
            const float* st = a.in[2] + (size_t)b * (KC - 1) * DM;
#pragma unroll
            for (int i = 0; i < KC - 1 - TS; ++i) *(GAS f32x2*)(o + (size_t)i * DM + ch) = *(const GAS f32x2*)(st + (size_t)(i + TS) * DM + ch);
#pragma unroll
            for (int i = KC - 1 - TS; i < KC - 1; ++i) *(GAS f32x2*)(o + (size_t)i * DM + ch) = (f32x2){bflo(E[REM + i]), bfhi(E[REM + i])};
        }
    }
    __syncthreads();
}

__device__ __forceinline__ void delta_item(const Args& a, LAS unsigned char* lds, int item) {
    asm volatile("" ::: "memory");
    const int tid = threadIdx.x, lane = tid & 63, sub = tid >> 7, wu = (tid >> 6) & 1; int j = tid & 127; asm volatile("" : "+v"(j));
    const int unit = item * 4 + sub, b = unit >> 3, h = unit & 7;
    const int row0 = RP + b * TS;
    const bf16* QS = (const bf16*)(a.ws + WS_QS); bf16* ZS = (bf16*)(a.ws + WS_ZS); const float* BETAG = (const float*)(a.ws + WS_BETAG);
    LAS float* kq = (LAS float*)lds + sub * 256;
    LAS float* red = (LAS float*)lds + 1024 + sub * 4;
    LAS float* red2 = (LAS float*)lds + 1024 + 16 + sub * 2;
    float S[DH];
    { const float* s0 = a.in[4] + ((size_t)(b * NH + h) * DH) * DH + j;
#pragma unroll
        for (int d = 0; d < DH; ++d) S[d] = s0[(size_t)d * DH]; }
    const int cq = h * DH + j, ck = DM + cq, cv = 2 * DM + cq;
    float wq[KS], wk[KS], wv[KS];
#pragma unroll
    for (int i = 0; i < KS; ++i) { wq[i] = a.in[13][i * DQKV + cq]; wk[i] = a.in[13][i * DQKV + ck]; wv[i] = a.in[13][i * DQKV + cv]; }
    float hq[3], hk[3], hv[3];
#pragma unroll
    for (int i = 0; i < 3; ++i) { const float* st = a.in[3] + ((size_t)b * 3 + i) * DQKV; hq[i] = st[cq]; hk[i] = st[ck]; hv[i] = st[cv]; }
    const float gh = a.in[16][j];
    float pq[TS], pk[TS], pv[TS], pbe[TS], pgg[TS], pzs[TS];
#pragma unroll
    for (int t = 0; t < TS; ++t) { const bf16* p = QS + (size_t)(b * TS + t) * DQKV; pq[t] = bf1(p[cq]); pk[t] = bf1(p[ck]); pv[t] = bf1(p[cv]);
        pbe[t] = BETAG[(size_t)(row0 + t) * 16 + h]; pgg[t] = BETAG[(size_t)(row0 + t) * 16 + 8 + h]; pzs[t] = bf1(ZS[(size_t)(row0 + t) * DM + cq]); }
#pragma unroll
    for (int t = 0; t < TS; ++t) {
        const size_t row = (size_t)(row0 + t);
        const float qp = pq[t], kp = pk[t], vp = pv[t];
        const float qc = siluf_(wq[0] * hq[0] + wq[1] * hq[1] + wq[2] * hq[2] + wq[3] * qp);
        const float kc = siluf_(wk[0] * hk[0] + wk[1] * hk[1] + wk[2] * hk[2] + wk[3] * kp);
        const float vc = siluf_(wv[0] * hv[0] + wv[1] * hv[1] + wv[2] * hv[2] + wv[3] * vp);
        hq[0] = hq[1]; hq[1] = hq[2]; hq[2] = qp; hk[0] = hk[1]; hk[1] = hk[2]; hk[2] = kp; hv[0] = hv[1]; hv[1] = hv[2]; hv[2] = vp;
        const float sq = wave_sum(qc * qc), sk = wave_sum(kc * kc);
        kq[j] = kc; kq[128 + j] = qc;
        if (lane == 0) { red[wu * 2] = sq; red[wu * 2 + 1] = sk; }
        const float beta = pbe[t], gg = pgg[t], zs = pzs[t];
        __syncthreads();
        const float nq = rsqf(red[0] + red[2] + 1e-6f) * 0.08838834764831845f, nk = rsqf(red[1] + red[3] + 1e-6f);
        const float alpha = __expf(gg);
        float ks0 = 0.f, ks1 = 0.f, ks2 = 0.f, ks3 = 0.f;
#pragma unroll
        for (int d = 0; d < DH; d += 4) { const f32x4 kk = *(const LAS f32x4*)(kq + d); ks0 += kk.x * S[d]; ks1 += kk.y * S[d + 1]; ks2 += kk.z * S[d + 2]; ks3 += kk.w * S[d + 3];
            if ((d & 31) == 28) asm volatile("" ::: "memory"); }
        const float kS = (ks0 + ks1) + (ks2 + ks3);
        const float u = beta * (vc - alpha * nk * kS), un = nk * u;
        float o0 = 0.f, o1 = 0.f, o2 = 0.f, o3 = 0.f;
#pragma unroll
        for (int d = 0; d < DH; d += 4) { const f32x4 kk = *(const LAS f32x4*)(kq + d); const f32x4 qq = *(const LAS f32x4*)(kq + 128 + d);
            S[d] = alpha * S[d] + kk.x * un; S[d + 1] = alpha * S[d + 1] + kk.y * un; S[d + 2] = alpha * S[d + 2] + kk.z * un; S[d + 3] = alpha * S[d + 3] + kk.w * un;
            o0 += qq.x * S[d]; o1 += qq.y * S[d + 1]; o2 += qq.z * S[d + 2]; o3 += qq.w * S[d + 3];
            if ((d & 15) == 12) asm volatile("" ::: "memory"); }
        const float o = ((o0 + o1) + (o2 + o3)) * nq;
        const float so = wave_sum(o * o);
        if (lane == 0) red2[wu] = so;
        __syncthreads();
        const float rms = rsqf((red2[0] + red2[1]) * (1.f / DH) + EPS);
        ZS[row * DM + cq] = (bf16)f2bf(o * rms * gh * zs);
    }
    { float* so = a.out + O_SD + ((size_t)(b * NH + h) * DH) * DH + j;
#pragma unroll
        for (int d = 0; d < DH; ++d) so[(size_t)d * DH] = S[d];
      float* qo = a.out + O_SQ + (size_t)b * 3 * DQKV;
#pragma unroll
        for (int i = 0; i < 3; ++i) { qo[i * DQKV + cq] = hq[i]; qo[i * DQKV + ck] = hk[i]; qo[i * DQKV + cv] = hv[i]; }
    }
    __syncthreads();
}

__host__ __device__ constexpr int perm_k(int x) { return (x & ~31) | (((x >> 2) & 3) << 3) | (((x >> 4) & 1) << 2) | (x & 3); }
typedef short bf16x8v __attribute__((ext_vector_type(8)));
constexpr int IH_QH = 0, IH_KH = 17408, IH_VH = 34816, IH_GV = 52224, IH_BYTES = 54272;
__device__ __forceinline__ void intra_pair(const Args& a, LAS unsigned char* lds_all, int pair) {
    asm volatile("" ::: "memory");
    const int tid = threadIdx.x, half = tid >> 8, lane = tid & 63, wq = (tid >> 6) & 3; int tu = tid & 255; asm volatile("" : "+v"(tu));
    const int uq = pair * 2 + half, h = uq & 7, bc = uq >> 3, b = bc / NCH, c = bc - b * NCH;
    const int nvalid = (c == NCH - 1) ? TP - 64 * (NCH - 1) : 64;
    LAS unsigned char* lds = lds_all + half * IH_BYTES;
    LAS bf16* QH = (LAS bf16*)(lds + IH_QH); LAS bf16* KH = (LAS bf16*)(lds + IH_KH); LAS bf16* VH = (LAS bf16*)(lds + IH_VH);
    LAS float* MF = (LAS float*)(lds + IH_KH); LAS bf16* ATL = (LAS bf16*)(lds + IH_VH); LAS float* GV = (LAS float*)(lds + IH_GV);
    unsigned char* ws = a.ws;
    bf16* blk = (bf16*)(ws + WS_QKVB) + (size_t)uq * QBLK; const bf16* HALOQ = (const bf16*)(ws + WS_HALOQ); const float* BETAG = (const float*)(ws + WS_BETAG);
    bf16* KDT = (bf16*)(ws + WS_KDT) + (size_t)uq * 8192; bf16* ATT = (bf16*)(ws + WS_ATTN) + (size_t)uq * 4096; float* LASTV = (float*)(ws + WS_LASTV);
    if (tu < 64) { const int i = tu; float g = 0.f, be = 0.f; { const float* p = BETAG + (size_t)(b * TP + 64 * c + (i < nvalid ? i : 0)) * 16; be = p[h]; g = p[8 + h]; } if (i >= nvalid) { g = 0.f; be = 0.f; }
        float G = g;
#pragma unroll
        for (int o = 1; o < 64; o <<= 1) { const float t = __shfl_up(G, o); if (lane >= o) G += t; }
        const float GL = __shfl(G, 63);
        GV[i] = G; GV[64 + i] = be; GV[128 + i] = expf(G); GV[192 + i] = expf(GL - G);
        if (i == 63) LASTV[uq] = expf(GL); }
    {   const int cp = tu & 15, rg = tu >> 4;
        v4u raw[3][7];
#pragma unroll
        for (int wh = 0; wh < 3; ++wh)
#pragma unroll
            for (int k = 0; k < 7; ++k) { const int rr = 4 * rg - 3 + k;
                const bf16* p = (rr >= 0) ? blk + wh * 8192 + rr * 128 + 8 * cp : HALOQ + ((size_t)(b * NCH + (c > 0 ? c - 1 : 0)) * 3 + (3 + rr)) * DQKV + wh * DM + h * DH + 8 * cp;
                raw[wh][k] = *(const GAS v4u*)p; }
#pragma unroll
        for (int wh = 0; wh < 3; ++wh) {
            const int col = wh * DM + h * DH + 8 * cp;
            f32x4 wl[4], wh4[4];
#pragma unroll
            for (int i = 0; i < 4; ++i) { wl[i] = *(const GAS f32x4*)(a.in[13] + i * DQKV + col); wh4[i] = *(const GAS f32x4*)(a.in[13] + i * DQKV + col + 4); }
            float xr[7][8];
#pragma unroll
            for (int k = 0; k < 7; ++k) { const int rr = 4 * rg - 3 + k; const bool ok = (rr >= 0) ? (rr < nvalid) : (c > 0); const v4u v = raw[wh][k];
                xr[k][0] = ok ? bflo(v.x) : 0.f; xr[k][1] = ok ? bfhi(v.x) : 0.f; xr[k][2] = ok ? bflo(v.y) : 0.f; xr[k][3] = ok ? bfhi(v.y) : 0.f;
                xr[k][4] = ok ? bflo(v.z) : 0.f; xr[k][5] = ok ? bfhi(v.z) : 0.f; xr[k][6] = ok ? bflo(v.w) : 0.f; xr[k][7] = ok ? bfhi(v.w) : 0.f; }
            if (c == NCH - 1 && rg == (nvalid - 1) / 4) {
                float* qo = a.out + O_PQ + (size_t)b * 3 * DQKV + col;
#pragma unroll
                for (int i = 0; i < 3; ++i) { *(GAS f32x4*)(qo + i * DQKV) = (f32x4){xr[4 + i][0], xr[4 + i][1], xr[4 + i][2], xr[4 + i][3]}; *(GAS f32x4*)(qo + i * DQKV + 4) = (f32x4){xr[4 + i][4], xr[4 + i][5], xr[4 + i][6], xr[4 + i][7]}; } }
            LAS bf16* tile = wh == 0 ? QH : (wh == 1 ? KH : VH);
#pragma unroll
            for (int r = 0; r < 4; ++r) { const bool ok = (4 * rg + r) < nvalid; float y[8];
#pragma unroll
                for (int e = 0; e < 8; ++e) { const float w0 = e < 4 ? wl[0][e & 3] : wh4[0][e & 3], w1 = e < 4 ? wl[1][e & 3] : wh4[1][e & 3], w2 = e < 4 ? wl[2][e & 3] : wh4[2][e & 3], w3 = e < 4 ? wl[3][e & 3] : wh4[3][e & 3];
                    const float t = w0 * xr[r][e] + w1 * xr[r + 1][e] + w2 * xr[r + 2][e] + w3 * xr[r + 3][e]; y[e] = ok ? siluf_(t) : 0.f; }
                v4u o; o.x = cvtpk(y[0], y[1]); o.y = cvtpk(y[2], y[3]); o.z = cvtpk(y[4], y[5]); o.w = cvtpk(y[6], y[7]);
                *(LAS v4u*)(tile + (4 * rg + r) * 136 + 8 * cp) = o; }
        }
    }
    __syncthreads();
    const int which = tu >> 7, d = tu & 127;
    float x[64];
    { const LAS bf16* colp = (which == 0 ? VH : KH) + d;
#pragma unroll
      for (int i = 0; i < 64; ++i) x[i] = bf1(colp[i * 136]); }
    const int fr = lane & 15, fq = lane >> 4;
    f32x4 kk[4], qk[4];
    {   bf16x8v ak[4], aq[4];
#pragma unroll
        for (int sI = 0; sI < 4; ++sI) { ak[sI] = *(const LAS bf16x8v*)(KH + (16 * wq + fr) * 136 + 32 * sI + 8 * fq); aq[sI] = *(const LAS bf16x8v*)(QH + (16 * wq + fr) * 136 + 32 * sI + 8 * fq); }
        f32x4 kkd = {0.f, 0.f, 0.f, 0.f}, qqd = {0.f, 0.f, 0.f, 0.f};
#pragma unroll
        for (int sI = 0; sI < 4; ++sI) { kkd = __builtin_amdgcn_mfma_f32_16x16x32_bf16(ak[sI], ak[sI], kkd, 0, 0, 0); qqd = __builtin_amdgcn_mfma_f32_16x16x32_bf16(aq[sI], aq[sI], qqd, 0, 0, 0); }
#pragma unroll
        for (int nt = 0; nt < 4; ++nt) { kk[nt] = (f32x4){0.f, 0.f, 0.f, 0.f}; qk[nt] = (f32x4){0.f, 0.f, 0.f, 0.f};
            if (nt <= wq) {
#pragma unroll
                for (int sI = 0; sI < 4; ++sI) { const bf16x8v bk = *(const LAS bf16x8v*)(KH + (16 * nt + fr) * 136 + 32 * sI + 8 * fq);
                    kk[nt] = __builtin_amdgcn_mfma_f32_16x16x32_bf16(ak[sI], bk, kk[nt], 0, 0, 0); qk[nt] = __builtin_amdgcn_mfma_f32_16x16x32_bf16(aq[sI], bk, qk[nt], 0, 0, 0); } } }
#pragma unroll
        for (int r = 0; r < 4; ++r) if (fr == 4 * fq + r) { GV[320 + 16 * wq + fr] = rsqf(kkd[r] + 1e-6f); GV[256 + 16 * wq + fr] = rsqf(qqd[r] + 1e-6f) * 0.08838834764831845f; }
    }
    __syncthreads();
    {
#pragma unroll
        for (int nt = 0; nt < 4; ++nt) { const int j = 16 * nt + fr;
            if (nt <= wq) { const float Gj = GV[j], nkj = GV[320 + j];
#pragma unroll
                for (int r = 0; r < 4; ++r) { const int i = 16 * wq + 4 * fq + r; const float dec = (i >= j) ? __expf(GV[i] - Gj) : 0.f;
                    MF[i * 68 + j] = (i > j) ? GV[64 + i] * GV[320 + i] * nkj * kk[nt][r] * dec : 0.f;
                    ATL[i * 72 + j] = (bf16)f2bf(GV[256 + i] * nkj * qk[nt][r] * dec); }
            } else {
#pragma unroll
                for (int r = 0; r < 4; ++r) ATL[(16 * wq + 4 * fq + r) * 72 + j] = (bf16)0; }
        }
#pragma unroll
        for (int k = 0; k < 4; ++k) { const int pc = tu + 256 * k, i = pc >> 4, p16 = pc & 15, c0 = 32 * (p16 >> 2) + 4 * (p16 & 3);
            const v2u lo = *(const LAS v2u*)(QH + i * 136 + c0), hi = *(const LAS v2u*)(QH + i * 136 + c0 + 16); const float f = GV[256 + i] * GV[128 + i];
            v4u o; o.x = cvtpk(bflo(lo.x) * f, bfhi(lo.x) * f); o.y = cvtpk(bflo(lo.y) * f, bfhi(lo.y) * f); o.z = cvtpk(bflo(hi.x) * f, bfhi(hi.x) * f); o.w = cvtpk(bflo(hi.y) * f, bfhi(hi.y) * f);
            *(GAS v4u*)(blk + i * 128 + 8 * p16) = o; }
        if (which == 0) {
#pragma unroll
            for (int i = 0; i < 64; i += 4) { const f32x4 be = *(const LAS f32x4*)(GV + 64 + i); x[i] *= be.x; x[i + 1] *= be.y; x[i + 2] *= be.z; x[i + 3] *= be.w; }
        } else {
            bf16* kd = KDT + d * 64;
#pragma unroll
            for (int i = 0; i < 64; i += 4) { const f32x4 nk = *(const LAS f32x4*)(GV + 320 + i); x[i] *= nk.x; x[i + 1] *= nk.y; x[i + 2] *= nk.z; x[i + 3] *= nk.w; }
#pragma unroll
            for (int g8 = 0; g8 < 8; ++g8) { const int i0 = 32 * (g8 >> 2) + 4 * (g8 & 3);
                const f32x4 e0 = *(const LAS f32x4*)(GV + 192 + i0), e1 = *(const LAS f32x4*)(GV + 192 + i0 + 16);
                v4u w; w.x = cvtpk(x[i0] * e0.x, x[i0 + 1] * e0.y); w.y = cvtpk(x[i0 + 2] * e0.z, x[i0 + 3] * e0.w); w.z = cvtpk(x[i0 + 16] * e1.x, x[i0 + 17] * e1.y); w.w = cvtpk(x[i0 + 18] * e1.z, x[i0 + 19] * e1.w);
                *(GAS v4u*)(kd + 8 * g8) = w; }
#pragma unroll
            for (int i = 0; i < 64; i += 4) { const f32x4 be = *(const LAS f32x4*)(GV + 64 + i), eg = *(const LAS f32x4*)(GV + 128 + i);
                x[i] *= be.x * eg.x; x[i + 1] *= be.y * eg.y; x[i + 2] *= be.z * eg.z; x[i + 3] *= be.w * eg.w; }
        }
    }
    __syncthreads();
    {   f32x4 mb[16];
#pragma unroll
        for (int i = 1; i < 64; ++i) {
#pragma unroll
            for (int g = 0; g < (i + 3) / 4; ++g) mb[g] = *(const LAS f32x4*)(MF + i * 68 + 4 * g);
            __builtin_amdgcn_sched_barrier(0);
            f32x2 a01 = {x[i], 0.f}, a23 = {0.f, 0.f};
#pragma unroll
            for (int g = 0; g < (i + 3) / 4; ++g) { const f32x4 mm = mb[g];
                a01 -= (f32x2){mm.x, mm.y} * (f32x2){x[4 * g], x[4 * g + 1]}; a23 -= (f32x2){mm.z, mm.w} * (f32x2){x[4 * g + 2], x[4 * g + 3]}; }
            x[i] = (a01.x + a01.y) + (a23.x + a23.y);
            __builtin_amdgcn_sched_barrier(0);
        }
    }
    if (which == 0) {
        bf16* u0 = blk + 2 * 8192 + (size_t)(d >> 4) * 1024 + (d & 15) * 4;
#pragma unroll
        for (int m = 0; m < 4; ++m)
#pragma unroll
            for (int q = 0; q < 4; ++q) { const int i = 16 * m + 4 * q; v2u w; w.x = cvtpk(x[i], x[i + 1]); w.y = cvtpk(x[i + 2], x[i + 3]); *(GAS v2u*)(u0 + m * 256 + q * 64) = w; }
    } else {
#pragma unroll
        for (int i = 0; i < 64; ++i) QH[i * 136 + d] = (bf16)f2bf(x[i]);
    }
    __syncthreads();
#pragma unroll
    for (int k = 0; k < 4; ++k) { const int pc = tu + 256 * k, i = pc >> 4, p16 = pc & 15, c0 = 32 * (p16 >> 2) + 4 * (p16 & 3);
        const v2u lo = *(const LAS v2u*)(QH + i * 136 + c0), hi = *(const LAS v2u*)(QH + i * 136 + c0 + 16);
        *(GAS v4u*)(blk + 8192 + i * 128 + 8 * p16) = (v4u){lo.x, lo.y, hi.x, hi.y}; }
#pragma unroll
    for (int k = 0; k < 2; ++k) { const int pc = tu + 256 * k, i = pc >> 3, p8 = pc & 7, c0 = 32 * (p8 >> 2) + 4 * (p8 & 3);
        const v2u lo = *(const LAS v2u*)(ATL + i * 72 + c0), hi = *(const LAS v2u*)(ATL + i * 72 + c0 + 16);
        *(GAS v4u*)(ATT + i * 64 + 8 * p8) = (v4u){lo.x, lo.y, hi.x, hi.y}; }
    __syncthreads();
}

constexpr int SC_W = 0, SC_QD = 16384, SC_KDT = 32768, SC_AT = 49152, SC_BUF = 57344, SC_RMS = 2 * SC_BUF, SC_ZT = SC_RMS + 4096, SC_END = SC_ZT + 2 * 16384;
__device__ __forceinline__ int swz256(int row, int chunk) { return row * 256 + ((chunk ^ (row & 15)) << 4); }
__device__ __forceinline__ int swz128(int row, int ch) { return (row >> 1) * 256 + (((8 * (row & 1) + ch) ^ ((row >> 1) & 7)) << 4); }
__device__ __forceinline__ void scan_chain(const Args& a, LAS unsigned char* lds, int chain) {
    const int tid = threadIdx.x, lane = tid & 63, wave = __builtin_amdgcn_readfirstlane(tid >> 6), fr = lane & 15, fq = lane >> 4;
    const int b = chain >> 3, h = chain & 7;
    unsigned char* ws = a.ws;
    const bf16* QKVB = (const bf16*)(ws + WS_QKVB); const bf16* KDTg = (const bf16*)(ws + WS_KDT); const bf16* ATTg = (const bf16*)(ws + WS_ATTN); const float* LASTV = (const float*)(ws + WS_LASTV);
    bf16* ZS = (bf16*)(ws + WS_ZS);
    LAS float* RMS = (LAS float*)(lds + SC_RMS);
    const float gh = a.in[16][16 * wave + fr];
    f32x4 Sacc[8];
#pragma unroll
    for (int mt = 0; mt < 8; ++mt) Sacc[mt] = (f32x4){0.f, 0.f, 0.f, 0.f};
    v4u ztn[2]; v2u u0n[4]; float lastn;
    auto chunk_dma = [&](int c) {
        const size_t uq = (size_t)(b * NCH + c) * NH + h; const bf16* blk = QKVB + uq * QBLK; LAS unsigned char* base = lds + (c & 1) * SC_BUF;
#pragma unroll
        for (int k = 0; k < 2; ++k) { const int P = (wave + 8 * k) * 64 + lane, row = P >> 4, ch = (P & 15) ^ (row & 15);
            __builtin_amdgcn_global_load_lds((const unsigned*)(blk + 8192 + row * 128 + 8 * ch), (LAS unsigned*)(base + SC_W + (wave + 8 * k) * 1024), 16, 0, 0);
            __builtin_amdgcn_global_load_lds((const unsigned*)(blk + row * 128 + 8 * ch), (LAS unsigned*)(base + SC_QD + (wave + 8 * k) * 1024), 16, 0, 0);
            const int line = P >> 4, t = (P & 15) ^ (line & 7), r2 = 2 * line + (t >> 3);
            __builtin_amdgcn_global_load_lds((const unsigned*)(KDTg + uq * 8192 + r2 * 64 + 8 * (t & 7)), (LAS unsigned*)(base + SC_KDT + (wave + 8 * k) * 1024), 16, 0, 0); }
        { const int P = wave * 64 + lane, line = P >> 4, t = (P & 15) ^ (line & 7), r2 = 2 * line + (t >> 3);
            __builtin_amdgcn_global_load_lds((const unsigned*)(ATTg + uq * 4096 + r2 * 64 + 8 * (t & 7)), (LAS unsigned*)(base + SC_AT + wave * 1024), 16, 0, 0); }
    };
    auto side_load = [&](int c) {
        const size_t uq = (size_t)(b * NCH + c) * NH + h;
#pragma unroll
        for (int k = 0; k < 2; ++k) { const int p = tid + 512 * k; ztn[k] = *(const GAS v4u*)(ZS + (size_t)(b * TP + 64 * c + (p >> 4)) * DM + h * DH + 8 * (p & 15)); }
        const bf16* u0 = QKVB + uq * QBLK + 2 * 8192 + wave * 1024 + lane * 4;
#pragma unroll
        for (int m = 0; m < 4; ++m) u0n[m] = *(const GAS v2u*)(u0 + m * 256);
        lastn = LASTV[uq];
    };
    auto side_store = [&](int buf) {
#pragma unroll
        for (int k = 0; k < 2; ++k) { const int p = tid + 512 * k; *(LAS v4u*)(lds + SC_ZT + buf * 16384 + swz256(p >> 4, p & 15)) = ztn[k]; }
    };
    chunk_dma(0); side_load(0); side_store(0);
    v2u u0p[4]; float last;
#pragma unroll
    for (int m = 0; m < 4; ++m) u0p[m] = u0n[m];
    last = lastn;
    chunk_dma(1); side_load(1);
    __syncthreads();
    for (int c = 0; c < NCH; ++c) {
        const int buf = c & 1; LAS unsigned char* base = lds + buf * SC_BUF; LAS unsigned char* zt = lds + SC_ZT + buf * 16384;
        const int nvalid = (c == NCH - 1) ? TP - 64 * (NCH - 1) : 64;
        bf16x8v F[2][8];
#define SC_LD_A(m, f) do { _Pragma("unroll") for (int sI = 0; sI < 4; ++sI) { const int off = swz256(16 * (m) + fr, 4 * sI + fq); \
            f[2 * sI] = *(const LAS bf16x8v*)(base + SC_W + off); f[2 * sI + 1] = *(const LAS bf16x8v*)(base + SC_QD + off); } } while (0)
#define SC_LD_D(f) do { _Pragma("unroll") for (int m = 0; m < 4; ++m) _Pragma("unroll") for (int s2 = 0; s2 < 2; ++s2) f[2 * m + s2] = *(const LAS bf16x8v*)(base + SC_AT + swz128(16 * m + fr, 4 * s2 + fq)); } while (0)
#define SC_LD_C(g, f) do { _Pragma("unroll") for (int mm = 0; mm < 4; ++mm) _Pragma("unroll") for (int s2 = 0; s2 < 2; ++s2) f[2 * mm + s2] = *(const LAS bf16x8v*)(base + SC_KDT + swz128(16 * (4 * (g) + mm) + fr, 4 * s2 + fq)); } while (0)
        SC_LD_A(0, F[0]);
        bf16x8v Sb[4];
#pragma unroll
        for (int sI = 0; sI < 4; ++sI) { v4u w; w.x = cvtpk(Sacc[2 * sI][0], Sacc[2 * sI][1]); w.y = cvtpk(Sacc[2 * sI][2], Sacc[2 * sI][3]); w.z = cvtpk(Sacc[2 * sI + 1][0], Sacc[2 * sI + 1][1]); w.w = cvtpk(Sacc[2 * sI + 1][2], Sacc[2 * sI + 1][3]);
            Sb[sI] = __builtin_bit_cast(bf16x8v, w); }
        f32x4 u[4], o[4];
#pragma unroll
        for (int m = 0; m < 4; ++m) {
            if (m == 0) SC_LD_A(1, F[1]); else if (m == 1) SC_LD_A(2, F[0]); else if (m == 2) SC_LD_A(3, F[1]); else SC_LD_D(F[0]);
            __builtin_amdgcn_sched_barrier(0);
            f32x4 p = {0.f, 0.f, 0.f, 0.f}, oo = {0.f, 0.f, 0.f, 0.f};
#pragma unroll
            for (int sI = 0; sI < 4; ++sI) { p = __builtin_amdgcn_mfma_f32_16x16x32_bf16(F[m & 1][2 * sI], Sb[sI], p, 0, 0, 0); oo = __builtin_amdgcn_mfma_f32_16x16x32_bf16(F[m & 1][2 * sI + 1], Sb[sI], oo, 0, 0, 0); }
            u[m] = (f32x4){bflo(u0p[m].x), bfhi(u0p[m].x), bflo(u0p[m].y), bfhi(u0p[m].y)} - p; o[m] = oo;
            __builtin_amdgcn_sched_barrier(0);
        }
        bf16x8v Ub[2];
#pragma unroll
        for (int s2 = 0; s2 < 2; ++s2) { v4u w; w.x = cvtpk(u[2 * s2][0], u[2 * s2][1]); w.y = cvtpk(u[2 * s2][2], u[2 * s2][3]); w.z = cvtpk(u[2 * s2 + 1][0], u[2 * s2 + 1][1]); w.w = cvtpk(u[2 * s2 + 1][2], u[2 * s2 + 1][3]);
            Ub[s2] = __builtin_bit_cast(bf16x8v, w); }
        SC_LD_C(0, F[1]);
        __builtin_amdgcn_sched_barrier(0);
#pragma unroll
        for (int m = 0; m < 4; ++m)
#pragma unroll
            for (int s2 = 0; s2 < 2; ++s2) o[m] = __builtin_amdgcn_mfma_f32_16x16x32_bf16(F[0][2 * m + s2], Ub[s2], o[m], 0, 0, 0);
        __builtin_amdgcn_sched_barrier(0);
        SC_LD_C(1, F[0]);
        __builtin_amdgcn_sched_barrier(0);
#pragma unroll
        for (int mt = 0; mt < 4; ++mt) { f32x4 sacc = Sacc[mt] * last;
#pragma unroll
            for (int s2 = 0; s2 < 2; ++s2) sacc = __builtin_amdgcn_mfma_f32_16x16x32_bf16(F[1][2 * mt + s2], Ub[s2], sacc, 0, 0, 0);
            Sacc[mt] = sacc; }
        __builtin_amdgcn_sched_barrier(0);
#pragma unroll
        for (int mt = 4; mt < 8; ++mt) { f32x4 sacc = Sacc[mt] * last;
#pragma unroll
            for (int s2 = 0; s2 < 2; ++s2) sacc = __builtin_amdgcn_mfma_f32_16x16x32_bf16(F[0][2 * (mt - 4) + s2], Ub[s2], sacc, 0, 0, 0);
            Sacc[mt] = sacc; }
#undef SC_LD_A
#undef SC_LD_D
#undef SC_LD_C
        LAS float* rm = RMS + (c & 1) * 512;
#pragma unroll
        for (int m = 0; m < 4; ++m)
#pragma unroll
            for (int r = 0; r < 4; ++r) { const float v = sum16(o[m][r] * o[m][r]); if (fr == 0) rm[(16 * m + 4 * fq + r) * 8 + wave] = v; }
        if (c + 1 < NCH) { side_store(buf ^ 1);
#pragma unroll
            for (int m = 0; m < 4; ++m) u0p[m] = u0n[m];
            last = lastn; }
        __syncthreads();
        if (c + 2 < NCH) side_load(c + 2);
        {   LAS float* rsw = RMS + ((c + 1) & 1) * 512 + wave * 64;
            const f32x4 p0 = *(const LAS f32x4*)(rm + lane * 8), p1 = *(const LAS f32x4*)(rm + lane * 8 + 4);
            LAS bf16* zp[16]; bf16 zv[16];
#pragma unroll
            for (int m = 0; m < 4; ++m)
#pragma unroll
                for (int r = 0; r < 4; ++r) { zp[4 * m + r] = (LAS bf16*)(zt + swz256(16 * m + 4 * fq + r, 2 * wave + (fr >> 3))) + (fr & 7); zv[4 * m + r] = *zp[4 * m + r]; }
            rsw[lane] = rsqf((((p0.x + p0.y) + (p0.z + p0.w)) + ((p1.x + p1.y) + (p1.z + p1.w))) * (1.f / DH) + EPS);
            f32x4 rs[4];
#pragma unroll
            for (int m = 0; m < 4; ++m) rs[m] = *(const LAS f32x4*)(rsw + 16 * m + 4 * fq);
            __builtin_amdgcn_sched_barrier(0);
#pragma unroll
            for (int m = 0; m < 4; ++m)
#pragma unroll
                for (int r = 0; r < 4; ++r) *zp[4 * m + r] = (bf16)f2bf(o[m][r] * rs[m][r] * gh * bf1(zv[4 * m + r]));
        }
        __syncthreads();
        if (c + 2 < NCH) chunk_dma(c + 2);
#pragma unroll
        for (int k = 0; k < 2; ++k) { const int p = tid + 512 * k, i = p >> 4;
            if (i < nvalid) *(GAS v4u*)(ZS + (size_t)(b * TP + 64 * c + i) * DM + h * DH + 8 * (p & 15)) = *(const LAS v4u*)(zt + swz256(i, p & 15)); }
    }
    { float* so = a.out + O_PD + ((size_t)(b * NH + h) * DH) * DH + 16 * wave + fr;
#pragma unroll
      for (int mt = 0; mt < 8; ++mt)
#pragma unroll
          for (int r = 0; r < 4; ++r) so[(size_t)(16 * mt + 4 * fq + r) * DH] = Sacc[mt][r]; }
    __syncthreads();
}

static_assert(SC_END <= LDSCTL_OFF && 2 * IH_BYTES <= LDSCTL_OFF && RING_BYTES <= LDSCTL_OFF, "LDS map");
constexpr int NPHASES = 10;
__global__ void __launch_bounds__(NWAVES * 64, 2) fwd_kernel(Args args) {
    extern __shared__ __attribute__((aligned(16))) unsigned char lds_raw[];
    LAS unsigned char* lds = (LAS unsigned char*)lds_raw;
    volatile LAS unsigned* MISC = (volatile LAS unsigned*)(lds + MISC_OFF);
    const int tid = threadIdx.x, lane = tid & 63, wave = __builtin_amdgcn_readfirstlane(tid >> 6);
    const int G = gridDim.x, bx = blockIdx.x;
    const int vcu = (G % 8 == 0) ? (bx % 8) * (G / 8) + bx / 8 : bx;
    unsigned char* ws = args.ws;
    gu32* ctl = (gu32*)(ws + WS_CTL);
    for (int u = tid; u < (LDS_BYTES - LDSCTL_OFF) / 4; u += NWAVES * 64) ((LAS unsigned*)(lds + LDSCTL_OFF))[u] = 0u;
    __syncthreads();
    XcdBarrier bar; bar.bar = (unsigned*)(ctl + CW_BAR); bar.x = 0; bar.st = nullptr;
    const int lo = args.ph_lo, hi = args.ph_hi;
    if (hi - lo > 1) bar = xcd_barrier_post((unsigned*)(ctl + CW_BAR), MISC + 8);
#ifndef PH_MASK
#define PH_MASK 0x3ff
#endif
#define IN(k) (((PH_MASK >> (k)) & 1) && lo <= (k) && (k) < hi)
#ifndef PROBE_K
#define PROBE_K -1
#endif
#if PROBE_K >= 0
    volatile LAS unsigned long long* stamps = (volatile LAS unsigned long long*)(lds + MISC_OFF + 128);
    if (tid == 0) stamps[0] = __builtin_amdgcn_s_memrealtime();
#define SEAM(k) do { if (IN(k) && IN((k) + 1)) xcd_barrier(bar); if (tid == 0) stamps[(k) + 1] = __builtin_amdgcn_s_memrealtime(); } while (0)
#else
#define SEAM(k) do { if (IN(k) && IN((k) + 1)) xcd_barrier(bar); } while (0)
#endif
    bf16* WIN = (bf16*)(ws + WS_WIN); bf16* WC = (bf16*)(ws + WS_WC); bf16* WD = (bf16*)(ws + WS_WD); bf16* WO = (bf16*)(ws + WS_WO); bf16* WUP = (bf16*)(ws + WS_WUP); bf16* WDN = (bf16*)(ws + WS_WDN);
    bf16* H = (bf16*)(ws + WS_H); bf16* GLU = (bf16*)(ws + WS_GLU); bf16* QKVB = (bf16*)(ws + WS_QKVB); bf16* QS = (bf16*)(ws + WS_QS); bf16* ZS = (bf16*)(ws + WS_ZS);
    bf16* HALOQ = (bf16*)(ws + WS_HALOQ); bf16* HALOC = (bf16*)(ws + WS_HALOC);
    bf16* SGC = (bf16*)args.out; bf16* SGD = (bf16*)args.out + (size_t)M2 * DM;
    bf16* MIX = (bf16*)(ws + WS_MIX); bf16* XG = (bf16*)(ws + WS_XG); bf16* HM = (bf16*)(ws + WS_HM); bf16* C = (bf16*)(ws + WS_C);
    float* BETAG = (float*)(ws + WS_BETAG);
    const int gw = vcu * NWAVES + wave, NGW = G * NWAVES;

    if (IN(0)) {
        constexpr int KB1 = DM / 32;
        constexpr int I_IN = KB1 * (NIN / 64);
        for (int it = gw; it < I_IN; it += NGW) { const int nb = it / KB1, kb = it % KB1; int src, nv; win_src(nb, src, nv); p0_transpose_item(args.in[7], DIN, DM, WIN, nb * 64, src, nv, kb * 32, lane); }
        for (int m0 = gw; m0 < MP; m0 += 2 * NGW) {
            const float* src[2]; bool ok[2]; f32x4 v[2][4];
#pragma unroll
            for (int q = 0; q < 2; ++q) { const int m = m0 + q * NGW; ok[q] = m < MR; const int mm = ok[q] ? m : 0;
                if (mm >= RP) src[q] = args.in[1] + (size_t)(mm - RP) * DM;
                else { const int b = mm / TP, t = mm - b * TP; src[q] = t < NMETA ? args.in[5] + (size_t)t * DM : args.in[0] + ((size_t)b * SEQ + (t - NMETA)) * DM; }
#pragma unroll
                for (int j = 0; j < 4; ++j) v[q][j] = ((const GAS f32x4*)src[q])[lane + 64 * j]; }
#pragma unroll
            for (int q = 0; q < 2; ++q) { const int m = m0 + q * NGW; if (m >= MP) continue;
                float ss = 0.f;
#pragma unroll
                for (int j = 0; j < 4; ++j) ss += (v[q][j].x * v[q][j].x + v[q][j].y * v[q][j].y) + (v[q][j].z * v[q][j].z + v[q][j].w * v[q][j].w);
                const float rstd = ok[q] ? rsqf(wave_sum(ss) * (1.f / DM) + EPS) : 0.f;
                GAS v2u* o8 = (GAS v2u*)(H + (size_t)m * DM) + lane;
#pragma unroll
                for (int j = 0; j < 4; ++j) { const f32x4 g = ((const GAS f32x4*)args.in[6])[lane + 64 * j]; v2u o; o.x = cvtpk(v[q][j].x * rstd * g.x, v[q][j].y * rstd * g.y); o.y = cvtpk(v[q][j].z * rstd * g.z, v[q][j].w * rstd * g.w); o8[64 * j] = o; } }
        }
    }
    SEAM(0);
    if (IN(1)) {
        pg8::Gemm g{H, WIN, MP, NIN, DM}; pg8::StaticOrder S; S.init(MP, NIN, G, bx, DM);
        EpiIn E{GLU, QKVB, QS, HALOQ, HALOC, ZS, SGC, SGD, BETAG, args.in[14], args.in[15]};
        pg8::gemm_phase<EpiIn, pg8::StaticOrder, true, true>(lds + RING_OFF, g, S, E);
        constexpr int NU = (MP / 256) * (NIN / 256), NFREE = 256 - NU % 256;
        if (G == 256 && bx >= NU % 256) {
            constexpr int KB1 = DM / 32, KB4 = DFF / 32;
            constexpr int I_SQ = KB1 * (DM / 64), I_UP = KB1 * (DFF / 64), I_DN = KB4 * (DM / 64), NITEMS = 3 * I_SQ + I_UP + I_DN;
            for (int it = (bx - NU % 256) * NWAVES + wave; it < NITEMS; it += NFREE * NWAVES) {
                int r = it;
                if (r < I_SQ) { p0_transpose_item(args.in[12], DM, DM, WC, (r / KB1) * 64, (r / KB1) * 64, 64, (r % KB1) * 32, lane); continue; } r -= I_SQ;
                if (r < I_SQ) { p0_transpose_item(args.in[17], DM, DM, WD, (r / KB1) * 64, (r / KB1) * 64, 64, (r % KB1) * 32, lane); continue; } r -= I_SQ;
                if (r < I_SQ) { p0_transpose_item(args.in[18], DM, DM, WO, (r / KB1) * 64, (r / KB1) * 64, 64, (r % KB1) * 32, lane); continue; } r -= I_SQ;
                if (r < I_UP) { p0_transpose_item(args.in[20], DFF, DM, WUP, (r / KB1) * 64, (r / KB1) * 64, 64, (r % KB1) * 32, lane); continue; } r -= I_UP;
                p0_transpose_item(args.in[21], DM, DFF, WDN, (r / KB4) * 64, (r / KB4) * 64, 64, (r % KB4) * 32, lane);
            }
        } else if (G != 256) {
            constexpr int KB1 = DM / 32, KB4 = DFF / 32;
            constexpr int I_SQ = KB1 * (DM / 64), I_UP = KB1 * (DFF / 64), I_DN = KB4 * (DM / 64), NITEMS = 3 * I_SQ + I_UP + I_DN;
            for (int it = gw; it < NITEMS; it += NGW) {
                int r = it;
                if (r < I_SQ) { p0_transpose_item(args.in[12], DM, DM, WC, (r / KB1) * 64, (r / KB1) * 64, 64, (r % KB1) * 32, lane); continue; } r -= I_SQ;
                if (r < I_SQ) { p0_transpose_item(args.in[17], DM, DM, WD, (r / KB1) * 64, (r / KB1) * 64, 64, (r % KB1) * 32, lane); continue; } r -= I_SQ;
                if (r < I_SQ) { p0_transpose_item(args.in[18], DM, DM, WO, (r / KB1) * 64, (r / KB1) * 64, 64, (r % KB1) * 32, lane); continue; } r -= I_SQ;
                if (r < I_UP) { p0_transpose_item(args.in[20], DFF, DM, WUP, (r / KB1) * 64, (r / KB1) * 64, 64, (r % KB1) * 32, lane); continue; } r -= I_UP;
                p0_transpose_item(args.in[21], DM, DFF, WDN, (r / KB4) * 64, (r / KB4) * 64, 64, (r % KB4) * 32, lane);
            }
        }
    }
    SEAM(1);
    if (IN(2)) {
        constexpr int N_CP = BP * NRUN, N_IP = BP * NCH * NH / 2, N_SD = BS * NH / 4, N_CS = BS, N_ITEMS = N_CP + N_IP + N_SD + N_CS;
        volatile LAS int* qslot = (volatile LAS int*)(lds + MISC_OFF + 64);
#if PROBE_K >= 0
        for (int sub = 0; sub < 3; ++sub) {
            const int lo_i = sub == 0 ? 0 : (sub == 1 ? N_CP : N_CP + N_IP), hi_i = sub == 0 ? N_CP : (sub == 1 ? N_CP + N_IP : N_CP + N_IP + N_SD);
            for (;;) {
                if (tid == 0) *qslot = (int)__hip_atomic_fetch_add((unsigned*)(ctl + 2048 + 64 * sub), 1u, __ATOMIC_RELAXED, __HIP_MEMORY_SCOPE_AGENT);
                __syncthreads();
                int it = *qslot + lo_i;
                __syncthreads();
                if (sub == 0 && it >= N_CP) { it += N_IP + N_SD; if (it >= N_ITEMS) break; conv_unit<1>(args, lds, it - (N_CP + N_IP + N_SD), 0); continue; }
                if (it >= hi_i) break;
                if (it < N_CP) { conv_unit<0>(args, lds, it / NRUN, it % NRUN); continue; } it -= N_CP;
                if (it < N_IP) { intra_pair(args, lds, it); continue; } it -= N_IP;
                (void)it;
            }
            if (sub < 2) { xcd_barrier(bar); if (tid == 0) stamps[12 + sub] = __builtin_amdgcn_s_memrealtime(); }
        }
#else
        for (;;) {
            if (tid == 0) *qslot = (int)__hip_atomic_fetch_add((unsigned*)(ctl + 2048), 1u, __ATOMIC_RELAXED, __HIP_MEMORY_SCOPE_AGENT);
            __syncthreads();
            int it = *qslot;
            __syncthreads();
            if (it >= N_CP + N_IP) it += N_SD;
            if (it >= N_ITEMS) break;
            if (it < N_CP) { conv_unit<0>(args, lds, it / NRUN, it % NRUN); continue; } it -= N_CP;
            if (it < N_IP) { intra_pair(args, lds, it); continue; } it -= N_IP;
            it -= N_SD; if (it < 0) continue;
            conv_unit<1>(args, lds, it, 0);
        }
#endif
    }
    SEAM(2);
    if (IN(3)) {
        if (bx < BP * NH) { scan_chain(args, lds, bx);
#if PROBE_K >= 0
            if (tid == 0) stamps[14] = __builtin_amdgcn_s_memrealtime();
#endif
        }
#if defined(PROBE_SCAN_ALONE)
        xcd_barrier(bar);
        if (bx < BP * NH) {}
#endif
        else {
            pg8::Gemm g{C, WC, MP, DM, DM}; pg8::StaticOrder S; S.init(MP, DM, G - BP * NH, bx - BP * NH, DM);
            EpiGate<0> E{SGC, nullptr, SGC};
            pg8::gemm_phase<EpiGate<0>, pg8::StaticOrder, true, true>(lds + RING_OFF, g, S, E);
            volatile LAS int* qslot = (volatile LAS int*)(lds + MISC_OFF + 64);
            for (;;) {
                if (tid == 0) *qslot = (int)__hip_atomic_fetch_add((unsigned*)(ctl + 2048 + 256), 1u, __ATOMIC_RELAXED, __HIP_MEMORY_SCOPE_AGENT);
                __syncthreads();
                const int it = *qslot;
                __syncthreads();
                if (it >= BS * NH / 4) break;
                delta_item(args, lds, it);
            }
        }
    }
    SEAM(3);
    if (IN(4)) {
        pg8::Gemm g{ZS, WD, MP, DM, DM}; pg8::StaticOrder S; S.init(MP, DM, G, bx, DM);
        EpiGate<1> E{SGD, SGC, MIX};
        pg8::gemm_phase<EpiGate<1>, pg8::StaticOrder, true, true>(lds + RING_OFF, g, S, E);
    }
    SEAM(4);
    if (IN(5)) {
        pg8::Gemm g{MIX, WO, M2, DM, DM}; pg8::SplitOrder S; S.init(BP * SEQ, M2, DM, G, bx, DM, KSPLIT5);
        EpiRes<0> E{args.in[0], args.in[1], args.out, (float*)(ws + WS_PART5)};
        pg8::gemm_phase<EpiRes<0>, pg8::SplitOrder, true, true>(lds + RING_OFF, g, S, E);
    }
    SEAM(5);
    if (IN(6)) {
        for (int m = gw; m < M2; m += NGW) {
            if (m >= BP * SEQ) {
                GAS f32x4* xr = (GAS f32x4*)(args.out + (size_t)m * DM) + lane; const GAS f32x4* x0 = (const GAS f32x4*)(args.in[1] + (size_t)(m - BP * SEQ) * DM) + lane;
                const GAS f32x4* pr = (const GAS f32x4*)((const float*)(ws + WS_PART5) + (size_t)(m - BP * SEQ) * DM) + lane; const GAS f32x4* gr = (const GAS f32x4*)args.in[19] + lane;
                f32x4 v[4]; float ss = 0.f;
#pragma unroll
                for (int jj = 0; jj < 4; ++jj) { v[jj] = x0[64 * jj];
#pragma unroll
                    for (int ks = 0; ks < KSPLIT5; ++ks) v[jj] += pr[(size_t)ks * RS * DM / 4 + 64 * jj];
                    xr[64 * jj] = v[jj]; ss += (v[jj].x * v[jj].x + v[jj].y * v[jj].y) + (v[jj].z * v[jj].z + v[jj].w * v[jj].w); }
                const float rstd = rsqf(wave_sum(ss) * (1.f / DM) + EPS);
                GAS v2u* o8 = (GAS v2u*)(XG + (size_t)m * DM) + lane;
#pragma unroll
                for (int jj = 0; jj < 4; ++jj) { const f32x4 g = gr[64 * jj]; v2u o; o.x = cvtpk(v[jj].x * rstd * g.x, v[jj].y * rstd * g.y); o.y = cvtpk(v[jj].z * rstd * g.z, v[jj].w * rstd * g.w); o8[64 * jj] = o; }
                continue;
            }
            rms_row_to_bf16(args.out + (size_t)m * DM, args.in[19], XG + (size_t)m * DM, lane);
        }
    }
    SEAM(6);
    if (IN(7)) {
        pg8::Gemm g{XG, WUP, M2, DFF, DM}; pg8::StaticOrder S; S.init(M2, DFF, G, bx, DM);
        EpiUp E{HM};
        pg8::gemm_phase<EpiUp, pg8::StaticOrder, true, true>(lds + RING_OFF, g, S, E);
    }
    SEAM(7);
    if (IN(8)) {
        pg8::Gemm g{HM, WDN, M2, DM, DFF}; pg8::SplitOrder S; S.init(BP * SEQ, M2, DM, G, bx, DFF, KSPLIT);
        EpiRes<1> E{nullptr, nullptr, args.out, (float*)(ws + WS_PART)};
        pg8::gemm_phase<EpiRes<1>, pg8::SplitOrder, true, true>(lds + RING_OFF, g, S, E);
    }
    SEAM(8);
    if (IN(9)) {
        for (int m = gw; m < M2; m += NGW) {
            float* xrow = args.out + (size_t)m * DM;
            GAS f32x4* xr = (GAS f32x4*)xrow + lane; const GAS f32x4* gr = (const GAS f32x4*)args.in[22] + lane;
            f32x4 v[4]; float s = 0.f;
#pragma unroll
            for (int jj = 0; jj < 4; ++jj) v[jj] = xr[64 * jj];
            if (m >= BP * SEQ) { const GAS f32x4* pr = (const GAS f32x4*)((const float*)(ws + WS_PART) + (size_t)(m - BP * SEQ) * DM) + lane;
#pragma unroll 4
                for (int ks = 0; ks < KSPLIT; ++ks)
#pragma unroll
                    for (int jj = 0; jj < 4; ++jj) v[jj] += pr[(size_t)ks * RS * DM / 4 + 64 * jj]; }
#pragma unroll
            for (int jj = 0; jj < 4; ++jj) s += (v[jj].x * v[jj].x + v[jj].y * v[jj].y) + (v[jj].z * v[jj].z + v[jj].w * v[jj].w);
            const float rstd = 1.f / sqrtf(wave_sum(s) * (1.f / DM) + EPS);
#pragma unroll
            for (int jj = 0; jj < 4; ++jj) xr[64 * jj] = v[jj] * rstd * gr[64 * jj];
        }
    }
#if PROBE_K >= 0
    __syncthreads();
    if (bx == 0) { if (tid == 0) stamps[NPHASES] = __builtin_amdgcn_s_memrealtime(); __syncthreads();
        const float dt_us = (float)(stamps[PROBE_B] - stamps[PROBE_K]) * 0.01f; const float f = 1.f + dt_us * (1.f / (float)(PROBE_DIV));
        for (int i = tid; i < BP * 3 * DQKV; i += NWAVES * 64) args.out[O_PQ + i] *= f; }
#endif
#undef IN
#undef SEAM
}

extern "C" void kernel_launch(void* const* d_in, const int* in_sizes, int n_in, void* d_out, int out_size, void* d_ws, size_t ws_size, hipStream_t stream) {
    static int grid = 0;
    if (grid == 0) {
        if (n_in != 23 || (size_t)out_size != O_END || ws_size < WS_END) { fprintf(stderr, "kernel_launch: unexpected shapes n_in %d out %d ws %zu\n", n_in, out_size, ws_size); grid = -1; return; }
        int dev = 0, cus = 0, per_cu = 0;
        if (hipGetDevice(&dev) != hipSuccess || hipDeviceGetAttribute(&cus, hipDeviceAttributeMultiprocessorCount, dev) != hipSuccess) { grid = -1; return; }
        if (hipFuncSetAttribute((const void*)fwd_kernel, hipFuncAttributeMaxDynamicSharedMemorySize, LDS_BYTES) != hipSuccess) { fprintf(stderr, "kernel_launch: hipFuncSetAttribute failed\n"); grid = -1; return; }
        if (hipOccupancyMaxActiveBlocksPerMultiprocessor(&per_cu, (const void*)fwd_kernel, NWAVES * 64, LDS_BYTES) != hipSuccess || per_cu < 1)
            fprintf(stderr, "kernel_launch: occupancy query reports %d\n", per_cu);
        (void)hipGetLastError();
        grid = cus;
    }
    if (grid < 0) return;
    if (hipMemsetAsync((char*)d_ws + WS_CTL, 0, CTL_ZERO_BYTES, stream) != hipSuccess) return;
    Args a{};
    for (int i = 0; i < 23; ++i) a.in[i] = (const float*)d_in[i];
    a.out = (float*)d_out; a.ws = (unsigned char*)d_ws;
#if MK_N_LAUNCHES == 1
    a.ph_lo = 0; a.ph_hi = NPHASES;
    hipLaunchKernelGGL(fwd_kernel, dim3(grid), dim3(NWAVES * 64), LDS_BYTES, stream, a);
#else
    for (int p = 0; p < NPHASES; ++p) { a.ph_lo = p; a.ph_hi = p + 1; hipLaunchKernelGGL(fwd_kernel, dim3(grid), dim3(NWAVES * 64), LDS_BYTES, stream, a); }
#endif
}
```

```cpp
#include <hip/hip_runtime.h>
#include <cstdio>
#include <cstdint>

#ifndef MK_N_LAUNCHES
#define MK_N_LAUNCHES 1
#endif

namespace pg8 {
#define PG8_LAS __attribute__((address_space(3)))
typedef unsigned short bf16_t;
typedef short bf16x8 __attribute__((ext_vector_type(8)));
typedef float f32x4 __attribute__((ext_vector_type(4)));
typedef unsigned u32x4 __attribute__((ext_vector_type(4)));
constexpr int BM = 256, BK = 64, HALF = 128, HTB = HALF * BK * 2, STAGE_BYTES = 8 * HTB, NXCD = 8, WGM = 8;

__host__ __device__ __forceinline__ int lds_byte(int r, int c) { const int st = (r >> 4) * 2 + (c >> 5), rr = r & 15, cc = c & 31, ob = rr * 64 + cc * 2; return st * 1024 + (ob ^ (((ob >> 9) & 1) << 5)); }
__host__ __device__ __forceinline__ void stage_rc(int b, int& R, int& C) { const int st = b / 1024, sb = b % 1024, swz = sb ^ (((sb >> 9) & 1) << 5); R = (st >> 1) * 16 + swz / 64; C = (st & 1) * 32 + (swz % 64) / 2; }
__host__ __device__ __forceinline__ int perm32(int rho) { const int n = rho >> 4, i = rho & 15; return 8 * (i >> 2) + 4 * n + (i & 3); }

struct Unit { int pm, pn, k0, nt, typ; };
struct Gemm { const bf16_t* A; const bf16_t* Bt; int M, N, K;
    __device__ __forceinline__ const char* a(const Unit&) const { return (const char*)A; } __device__ __forceinline__ const char* b(const Unit&) const { return (const char*)Bt; } };
struct Gemm2 { const bf16_t *A0, *B0, *A1, *B1; int K;
    __device__ __forceinline__ const char* a(const Unit& u) const { return (const char*)(u.typ ? A1 : A0); } __device__ __forceinline__ const char* b(const Unit& u) const { return (const char*)(u.typ ? B1 : B0); } };

struct StaticOrder {
    int nM, nN, nwg, G, c, nt;
    __host__ __device__ void init(int M, int N, int G_, int c_, int K) { nM = M / BM; nN = N / BM; nwg = nM * nN; G = G_; c = c_; nt = K / BK; }
    __host__ __device__ __forceinline__ bool next(int i, Unit& u) const {
        const long L = (long)i * G + c; if (L >= nwg) return false;
        u.k0 = 0; u.nt = nt; u.typ = 0;
        int wgid = (int)L; { const int q = nwg / NXCD, r = nwg % NXCD, xcd = wgid % NXCD, off = wgid / NXCD; wgid = (xcd < r ? xcd * (q + 1) : r * (q + 1) + (xcd - r) * q) + off; }
        const int nig = WGM * nN, gid = wgid / nig, fm = gid * WGM, gsz = (nM - fm) < WGM ? (nM - fm) : WGM;
        u.pm = fm + ((wgid % nig) % gsz); u.pn = (wgid % nig) / gsz; return true;
    }
    __device__ __forceinline__ void a_ready(const Unit&) const {}
    __device__ __forceinline__ void done(const Unit&) const {}
};

struct SplitOrder {
    int nM, nN, nwg, G, c, ntfull, nsub, KS, ntsub;
    __host__ __device__ void init(int Mmain, int Mall, int N, int G_, int c_, int K, int KS_) { nM = Mmain / BM; nN = N / BM; nwg = nM * nN; G = G_; c = c_; ntfull = K / BK; KS = KS_; ntsub = K / BK / KS_; nsub = (Mall / BM - nM) * nN * KS_; }
    __host__ __device__ __forceinline__ bool next(int i, Unit& u) const {
        const long L = (long)i * G + c; if (L >= nwg + nsub) return false;
        int pm, pn, k0, ntu;
        if (L < nwg) {
            int wgid = (int)L; { const int q = nwg / NXCD, r = nwg % NXCD, xcd = wgid % NXCD, off = wgid / NXCD; wgid = (xcd < r ? xcd * (q + 1) : r * (q + 1) + (xcd - r) * q) + off; }
            const int nig = WGM * nN, gid = wgid / nig, fm = gid * WGM, gsz = (nM - fm) < WGM ? (nM - fm) : WGM;
            pm = fm + ((wgid % nig) % gsz); pn = (wgid % nig) / gsz; k0 = 0; ntu = ntfull;
        } else { const int j = (int)L - nwg, tile = j / KS, ks = j % KS; pm = nM + tile / nN; pn = tile % nN; k0 = ks * ntsub; ntu = ntsub; }
        u.pm = pm; u.pn = pn; u.k0 = k0; u.nt = ntu; u.typ = 0; return true;
    }
    __device__ __forceinline__ void a_ready(const Unit&) const {}
    __device__ __forceinline__ void done(const Unit&) const {}
};

__device__ __forceinline__ unsigned cvt_pk_bf16(float lo, float hi) { unsigned r; asm volatile("v_cvt_pk_bf16_f32 %0, %1, %2" : "=v"(r) : "v"(lo), "v"(hi)); return r; }

template <class Epi, class Sched, bool ALIGN_EPI = false, bool SP2 = false, class GemmT = Gemm>
__device__ __forceinline__ void gemm_phase(PG8_LAS unsigned char* lds, const GemmT g, const Sched& S, const Epi& E) {
    const int tid = threadIdx.x, wid = __builtin_amdgcn_readfirstlane(tid >> 6), lane = tid & 63, wr = wid >> 2, wc = wid & 3, fr = lane & 15, fq = lane >> 4;
    const int K = g.K;
    unsigned voffA[2], voffB[2];
#pragma unroll
    for (int i = 0; i < 2; ++i) { int R, C; stage_rc(tid * 16 + i * 8192, R, C); const int Rb = Epi::PERM ? ((R & ~31) + perm32(R & 31)) : R;
        voffA[i] = (unsigned)(R * K + C) * 2u; voffB[i] = (unsigned)(Rb * K + C) * 2u; }
    const size_t kstep = (size_t)(BK * 2);
    const size_t hstep = (size_t)HALF * K * 2;
    const size_t tstep = 2 * hstep;
    const unsigned ldsw = (unsigned)wid * 1024u;
    const int aoff = lds_byte(wr * 64 + fr, fq * 8), boff = lds_byte(wc * 32 + fr, fq * 8);
#define PG8_SA(b, h) (((b) * 2 + (h)) * HTB)
#define PG8_SB(b, h) ((4 + (b) * 2 + (h)) * HTB)
#define PG8_STAGE(bufoff, gbase, voff) do { _Pragma("unroll") for (int _i = 0; _i < 2; ++_i) \
        __builtin_amdgcn_global_load_lds((const unsigned*)((const char*)(gbase) + (voff)[_i]), (PG8_LAS unsigned*)(lds + (bufoff) + ldsw + _i * 8192), 16, 0, 0); } while (0)
#define PG8_LDA(dst, b, h) do { _Pragma("unroll") for (int m = 0; m < 4; ++m) _Pragma("unroll") for (int k = 0; k < 2; ++k) dst[m][k] = *(const PG8_LAS bf16x8*)(lds + PG8_SA(b, h) + aoff + m * 2048 + k * 1024); } while (0)
#define PG8_LDB(dst, b, h) do { _Pragma("unroll") for (int n = 0; n < 2; ++n) _Pragma("unroll") for (int k = 0; k < 2; ++k) dst[n][k] = *(const PG8_LAS bf16x8*)(lds + PG8_SB(b, h) + boff + n * 2048 + k * 1024); } while (0)
#define PG8_MMA(ai, bj, At, Bt) do { __builtin_amdgcn_s_setprio(1); _Pragma("unroll") for (int m = 0; m < 4; ++m) _Pragma("unroll") for (int n = 0; n < 2; ++n) _Pragma("unroll") for (int k = 0; k < 2; ++k) \
        acc[ai][bj][m][n] = __builtin_amdgcn_mfma_f32_16x16x32_bf16(Bt[n][k], At[m][k], acc[ai][bj][m][n], 0, 0, 0); __builtin_amdgcn_s_setprio(0); } while (0)
#define PG8_WAIT_V(n) asm volatile("s_waitcnt vmcnt(" #n ")" ::: "memory")
#define PG8_WAIT_L(n) asm volatile("s_waitcnt lgkmcnt(" #n ")" ::: "memory")
#define PG8_BAR __builtin_amdgcn_s_barrier()
#define PG8_SCHED __builtin_amdgcn_sched_barrier(0)
    Unit cur, nxt; int ui = 0;
    if (!S.next(0, cur)) return;
    f32x4 acc[2][2][4][2];
#pragma unroll
    for (int a = 0; a < 2; ++a)
#pragma unroll
        for (int b = 0; b < 2; ++b)
#pragma unroll
            for (int m = 0; m < 4; ++m)
#pragma unroll
                for (int n = 0; n < 2; ++n) acc[a][b][m][n] = (f32x4){0.f, 0.f, 0.f, 0.f};
    bf16x8 At[4][2], B0[2][2], B1[2][2];
    const char* cA = g.a(cur) + (size_t)cur.pm * tstep + (size_t)cur.k0 * kstep; const char* cB = g.b(cur) + (size_t)cur.pn * tstep + (size_t)cur.k0 * kstep;
    S.a_ready(cur);
    if constexpr (SP2) {
        PG8_STAGE(PG8_SB(0, 0), cB, voffB); PG8_STAGE(PG8_SB(0, 1), cB + hstep, voffB); PG8_STAGE(PG8_SA(0, 0), cA, voffA); PG8_STAGE(PG8_SA(0, 1), cA + hstep, voffA);
        if (wr == 1) PG8_BAR;
        PG8_WAIT_V(2); PG8_BAR;
        PG8_STAGE(PG8_SB(1, 0), cB + kstep, voffB); PG8_STAGE(PG8_SA(1, 0), cA + kstep, voffA); PG8_STAGE(PG8_SB(1, 1), cB + hstep + kstep, voffB);
        PG8_WAIT_V(6); PG8_BAR;
    } else {
        PG8_STAGE(PG8_SB(0, 0), cB, voffB); PG8_STAGE(PG8_SA(0, 0), cA, voffA); PG8_STAGE(PG8_SB(0, 1), cB + hstep, voffB); PG8_STAGE(PG8_SA(0, 1), cA + hstep, voffA);
        if (wr == 1) PG8_BAR;
        PG8_WAIT_V(4); PG8_BAR;
        PG8_STAGE(PG8_SB(1, 0), cB + kstep, voffB); PG8_STAGE(PG8_SA(1, 0), cA + kstep, voffA); PG8_STAGE(PG8_SB(1, 1), cB + hstep + kstep, voffB);
        PG8_WAIT_V(6); PG8_BAR;
    }
    for (;;) {
        const bool has_next = S.next(ui + 1, nxt);
        const char* nA = has_next ? g.a(nxt) + (size_t)nxt.pm * tstep + (size_t)nxt.k0 * kstep : cA; const char* nB = has_next ? g.b(nxt) + (size_t)nxt.pn * tstep + (size_t)nxt.k0 * kstep : cB;
        const int nt = cur.nt;
        for (int t = 0; t < nt; t += 2) {
            const bool last = (t == nt - 2);
            const char* a1 = cA + (size_t)(t + 1) * kstep;
            const char* a2 = last ? nA : cA + (size_t)(t + 2) * kstep; const char* b2 = last ? nB : cB + (size_t)(t + 2) * kstep;
            const char* a3 = a2 + kstep; const char* b3 = b2 + kstep;
            if (last && has_next) S.a_ready(nxt);
            if constexpr (SP2) {
            PG8_LDB(B0, 0, 0); PG8_LDB(B1, 0, 1); PG8_SCHED; PG8_LDA(At, 0, 0); PG8_STAGE(PG8_SA(1, 1), a1 + hstep, voffA);
            PG8_WAIT_V(8); PG8_WAIT_L(0); PG8_BAR; PG8_MMA(0, 0, At, B0); PG8_MMA(0, 1, At, B1); PG8_BAR; PG8_SCHED;
            PG8_LDA(At, 0, 1); PG8_STAGE(PG8_SB(0, 0), b2, voffB); PG8_STAGE(PG8_SB(0, 1), b2 + hstep, voffB); PG8_STAGE(PG8_SA(0, 0), a2, voffA);
            PG8_WAIT_V(8); PG8_WAIT_L(0); PG8_BAR; PG8_MMA(1, 0, At, B0); PG8_MMA(1, 1, At, B1); PG8_BAR; PG8_SCHED;
            PG8_LDB(B0, 1, 0); PG8_LDB(B1, 1, 1); PG8_SCHED; PG8_LDA(At, 1, 0); PG8_STAGE(PG8_SA(0, 1), a2 + hstep, voffA);
            PG8_WAIT_V(8); PG8_WAIT_L(0); PG8_BAR; PG8_MMA(0, 0, At, B0); PG8_MMA(0, 1, At, B1); PG8_BAR; PG8_SCHED;
            PG8_LDA(At, 1, 1); PG8_STAGE(PG8_SB(1, 0), b3, voffB); PG8_STAGE(PG8_SB(1, 1), b3 + hstep, voffB); PG8_STAGE(PG8_SA(1, 0), a3, voffA);
            PG8_WAIT_V(8); PG8_WAIT_L(0); PG8_BAR; PG8_MMA(1, 0, At, B0); PG8_MMA(1, 1, At, B1); PG8_BAR; PG8_SCHED;
            } else {
            PG8_LDB(B0, 0, 0); PG8_SCHED; PG8_LDA(At, 0, 0); PG8_STAGE(PG8_SA(1, 1), a1 + hstep, voffA);
            PG8_WAIT_L(8); PG8_BAR; PG8_WAIT_L(0); PG8_MMA(0, 0, At, B0); PG8_BAR; PG8_SCHED;
            PG8_LDB(B1, 0, 1); PG8_STAGE(PG8_SB(0, 0), b2, voffB);
            PG8_BAR; PG8_WAIT_L(0); PG8_MMA(0, 1, At, B1); PG8_BAR;
            PG8_LDA(At, 0, 1); PG8_STAGE(PG8_SA(0, 0), a2, voffA);
            PG8_BAR; PG8_WAIT_L(0); PG8_MMA(1, 0, At, B0); PG8_BAR; PG8_SCHED;
            PG8_STAGE(PG8_SB(0, 1), b2 + hstep, voffB);
            PG8_WAIT_V(6); PG8_BAR; PG8_MMA(1, 1, At, B1); PG8_BAR;
            PG8_LDB(B0, 1, 0); PG8_SCHED; PG8_LDA(At, 1, 0); PG8_STAGE(PG8_SA(0, 1), a2 + hstep, voffA);
            PG8_WAIT_L(8); PG8_BAR; PG8_WAIT_L(0); PG8_MMA(0, 0, At, B0); PG8_BAR; PG8_SCHED;
            PG8_LDB(B1, 1, 1); PG8_STAGE(PG8_SB(1, 0), b3, voffB);
            PG8_BAR; PG8_WAIT_L(0); PG8_MMA(0, 1, At, B1); PG8_BAR;
            PG8_LDA(At, 1, 1); PG8_STAGE(PG8_SA(1, 0), a3, voffA);
            PG8_BAR; PG8_WAIT_L(0); PG8_MMA(1, 0, At, B0); PG8_BAR; PG8_SCHED;
            PG8_STAGE(PG8_SB(1, 1), b3 + hstep, voffB);
            PG8_WAIT_V(6); PG8_BAR; PG8_MMA(1, 1, At, B1); PG8_BAR;
            }
        }
        if constexpr (ALIGN_EPI) { if (wr == 0) PG8_BAR; }
        E(acc, cur, wr, wc, fr, fq); S.done(cur);
        if (!has_next) break;
#pragma unroll
        for (int a = 0; a < 2; ++a)
#pragma unroll
            for (int b = 0; b < 2; ++b)
#pragma unroll
                for (int m = 0; m < 4; ++m)
#pragma unroll
                    for (int n = 0; n < 2; ++n) acc[a][b][m][n] = (f32x4){0.f, 0.f, 0.f, 0.f};
        cur = nxt; cA = nA; cB = nB; ++ui;
        if constexpr (ALIGN_EPI) { if (wr == 1) PG8_BAR; }
    }
    PG8_WAIT_V(0);
    if constexpr (!ALIGN_EPI) { if (wr == 0) PG8_BAR; }
    PG8_BAR;
#undef PG8_SA
#undef PG8_SB
#undef PG8_STAGE
#undef PG8_LDA
#undef PG8_LDB
#undef PG8_MMA
#undef PG8_WAIT_V
#undef PG8_WAIT_L
#undef PG8_BAR
#undef PG8_SCHED
}
}

constexpr int NWAVES = 8;
constexpr int DM = 1024, BP = 8, SEQ = 2048, NMETA = 16, TP = SEQ + NMETA, BS = 128, TS = 4;
constexpr int RP = BP * TP;
constexpr int RS = BS * TS;
constexpr int MR = RP + RS;
constexpr int MP = 17152;
constexpr int M2 = BP * SEQ + RS;
constexpr int NH = 8, DH = 128, DQKV = 3072, DFF = 4096, KC = 31, KS = 4;
constexpr int NIN = 8448;
constexpr int DIN = 8208;
constexpr float EPS = 1e-6f;

constexpr size_t O_YP = 0, O_YS = 16777216, O_PC = 17301504, O_PQ = 17547264, O_PD = 17620992, O_SC = 18669568, O_SQ = 22601728, O_SD = 23781376, O_END = 40558592;

constexpr size_t MiB = 1u << 20;
constexpr size_t WS_CTL = 0, CTL_ZERO_BYTES = 1 * MiB;
constexpr size_t WS_BETAG = 1 * MiB;
constexpr size_t WS_LASTV = 9 * MiB / 4;
constexpr size_t WS_HALOQ = 5 * MiB / 2;
constexpr size_t WS_WC = 29 * MiB / 4, WS_WD = WS_WC + 2 * MiB, WS_WO = WS_WD + 2 * MiB, WS_WUP = WS_WO + 2 * MiB, WS_WDN = WS_WUP + 8 * MiB;
constexpr size_t WS_GLU = 117 * MiB / 4;
constexpr size_t WS_QKVB = 63 * MiB;
constexpr size_t WS_QS = 162 * MiB;
constexpr size_t WS_ZS = 165 * MiB;
constexpr size_t WS_H = 397 * MiB / 2;
constexpr size_t WS_WIN = 232 * MiB;
constexpr size_t WS_HALOC = 497 * MiB / 2;
constexpr size_t WS_KDT = WS_H, WS_ATTN = 463 * MiB / 2;
constexpr size_t WS_MIX = WS_QKVB, WS_XG = WS_GLU, WS_HM = WS_QKVB, WS_C = WS_GLU;
constexpr int KSPLIT5 = 4; constexpr size_t WS_PART5 = 232 * MiB;
constexpr size_t WS_X1B = WS_H;
constexpr int CW_READY = 8192;
constexpr int KSPLIT = 16;
constexpr size_t WS_PART = WS_XG;
static_assert(WS_PART + (size_t)KSPLIT * RS * DM * 4 <= WS_QKVB, "ws map part");
constexpr size_t WS_END = 256 * MiB;
constexpr int NRUN = 16, RUNL = TP / NRUN;
static_assert(TP - 64 * 32 == 16 && NRUN * RUNL == TP && WS_HALOC + (size_t)BP * NRUN * 30 * DM * 2 <= WS_END, "conv runs");
constexpr int NCH = 33, QBLK = 3 * 64 * 128;
static_assert(WS_WIN + (size_t)NIN * DM * 2 <= WS_HALOC && WS_WDN + 8 * MiB <= WS_GLU && WS_GLU + (size_t)MP * DM * 2 <= WS_QKVB && WS_HALOQ + (size_t)BP * 33 * 3 * 3072 * 2 <= WS_WC, "ws map");
static_assert(WS_ZS + (size_t)MP * DM * 2 <= WS_H && WS_H + (size_t)MP * DM * 2 <= WS_WIN, "ws map 2");
static_assert(WS_QKVB + (size_t)BP * NCH * NH * QBLK * 2 <= WS_QS, "ws map qkvb");
static_assert(WS_HM + (size_t)M2 * DFF * 2 <= WS_H, "ws map hm");
static_assert(WS_KDT + (size_t)BP * NCH * NH * 8192 * 2 <= WS_ATTN && WS_ATTN + (size_t)BP * NCH * NH * 4096 * 2 <= WS_HALOC, "ws map kdt");
constexpr int CW_TMO = 0, CW_CODE = 1, CW_BAR = 4096;

constexpr int RING_OFF = 0, RING_BYTES = 131072;
constexpr int LDSCTL_OFF = 151552, MISC_OFF = LDSCTL_OFF + 320;
constexpr int LDS_BYTES = LDSCTL_OFF + 1024;

#define GAS __attribute__((address_space(1)))
#define LAS __attribute__((address_space(3)))
typedef unsigned short bf16;
typedef unsigned v4u __attribute__((ext_vector_type(4)));
typedef unsigned v2u __attribute__((ext_vector_type(2)));
typedef float f32x4 __attribute__((ext_vector_type(4)));
typedef float f32x2 __attribute__((ext_vector_type(2)));
typedef GAS unsigned gu32;
#define RLX_AGENT __ATOMIC_RELAXED, __HIP_MEMORY_SCOPE_AGENT
#define LDS_WAIT() asm volatile("s_waitcnt lgkmcnt(0)" ::: "memory")
#define VM_WAIT() asm volatile("s_waitcnt vmcnt(0)" ::: "memory")
__device__ __forceinline__ unsigned f2bf(float f) { unsigned u = __builtin_bit_cast(unsigned, f); return (u + 0x7fffu + ((u >> 16) & 1u)) >> 16; }
__device__ __forceinline__ unsigned pk2(float lo, float hi) { return f2bf(lo) | (f2bf(hi) << 16); }
__device__ __forceinline__ float bflo(unsigned w) { return __builtin_bit_cast(float, w << 16); }
__device__ __forceinline__ float bfhi(unsigned w) { return __builtin_bit_cast(float, w & 0xffff0000u); }
__device__ __forceinline__ float bf1(bf16 b) { return __builtin_bit_cast(float, ((unsigned)b) << 16); }
__device__ __forceinline__ float sigmoidf_(float x) { return __builtin_amdgcn_rcpf(1.f + __expf(-x)); }
__device__ __forceinline__ float siluf_(float x) { return x * sigmoidf_(x); }

#define XB_TMO      128
#define XB_XCNT(j)  (256  + 64 * (j))
#define XB_XSUB(j)  (1280 + 64 * (j))
#define XB_XGEN(j)  (2304 + 64 * (j))
#define XB_TOP      3328
#define XB_TOPGEN   3392
#define XCD_BAR_WORDS 3456
#define XB_SPIN_CAP (1u << 18)
__device__ __forceinline__ unsigned xb_ld(unsigned* p)              { return __hip_atomic_load(p, __ATOMIC_RELAXED, __HIP_MEMORY_SCOPE_AGENT); }
__device__ __forceinline__ unsigned xb_add(unsigned* p, unsigned v) { return __hip_atomic_fetch_add(p, v, __ATOMIC_RELAXED, __HIP_MEMORY_SCOPE_AGENT); }
__device__ __forceinline__ unsigned xb_xcc_id() { return (unsigned)__builtin_amdgcn_s_getreg((3 << 11) | 20) & 0xFu; }
#define XB_SPIN(cond, bar) do { unsigned _sp = 0; while (cond) { __builtin_amdgcn_s_sleep(1); \
    if ((++_sp & 255u) == 0u) { if (xb_ld(&(bar)[XB_TMO])) break; if (_sp > XB_SPIN_CAP) { atomicAdd(&(bar)[XB_TMO], 1u); break; } } } } while (0)
struct XcdBarrier { unsigned* bar; unsigned x; volatile LAS unsigned* st; };
__device__ __forceinline__ XcdBarrier xcd_barrier_post(unsigned* bar, volatile LAS unsigned* st) {
    XcdBarrier b; b.bar = bar; b.x = xb_xcc_id(); b.st = st;
    if (threadIdx.x == 0) (void)xb_add(&bar[XB_XCNT(b.x)], 1u);
    return b;
}
__device__ __forceinline__ void xcd_barrier_complete(unsigned* bar, unsigned x, unsigned& nloc, unsigned& nx) {
    const unsigned G = gridDim.x * gridDim.y * gridDim.z;
    unsigned sum, cnt, mine, sp = 0u;
    for (;;) {
        sum = 0u; cnt = 0u; mine = 0u;
#pragma unroll
        for (unsigned j = 0; j < 16; ++j) { const unsigned c = xb_ld(&bar[XB_XCNT(j)]); sum += c; cnt += (c > 0u) ? 1u : 0u; mine = (j == x) ? c : mine; }
        if (sum == G) break;
        __builtin_amdgcn_s_sleep(1);
        if ((++sp & 255u) == 0u) { if (xb_ld(&bar[XB_TMO])) break; if (sp > XB_SPIN_CAP) { atomicAdd(&bar[XB_TMO], 1u); break; } }
    }
    nloc = mine > 0u ? mine : 1u; nx = cnt > 0u ? cnt : 1u;
}
__device__ __forceinline__ void xcd_barrier(const XcdBarrier& b) {
    asm volatile("s_waitcnt vmcnt(0)" ::: "memory");
    __syncthreads();
    if (threadIdx.x == 0) {
        unsigned* bar = b.bar;
        __builtin_amdgcn_s_waitcnt(0);
        unsigned nloc = b.st[0], nx = b.st[1];
        if (nloc == 0u) { xcd_barrier_complete(bar, b.x, nloc, nx); b.st[0] = nloc; b.st[1] = nx; }
        const unsigned old = xb_add(&bar[XB_XSUB(b.x)], 1u);
        const unsigned gen = old / nloc;
        if (old + 1u == (gen + 1u) * nloc) {
            __builtin_amdgcn_fence(__ATOMIC_RELEASE, "agent");
            asm volatile("s_waitcnt vmcnt(0)" ::: "memory");
            const unsigned og = xb_add(&bar[XB_TOP], 1u);
            const unsigned tg = og / nx;
            if (og + 1u == (tg + 1u) * nx) xb_add(&bar[XB_TOPGEN], 1u);
            else XB_SPIN(xb_ld(&bar[XB_TOPGEN]) == tg, bar);
            __builtin_amdgcn_fence(__ATOMIC_ACQUIRE, "agent");
            xb_add(&bar[XB_XGEN(b.x)], 1u);
            asm volatile("s_waitcnt vmcnt(0)" ::: "memory");
        } else {
            XB_SPIN(xb_ld(&bar[XB_XGEN(b.x)]) == gen, bar);
            __builtin_amdgcn_fence(__ATOMIC_ACQUIRE, "agent");
            asm volatile("s_waitcnt vmcnt(0)" ::: "memory");
        }
    }
    __syncthreads();
}

struct Args { const float* in[23]; float* out; unsigned char* ws; int ph_lo, ph_hi; };

#define DPP_ADD(v, ctrl, rmask, bc) v += __builtin_bit_cast(float, __builtin_amdgcn_update_dpp(0, __builtin_bit_cast(int, v), ctrl, rmask, 0xF, bc))
__device__ __forceinline__ float sum16(float v) {
    DPP_ADD(v, 0xB1, 0xF, true); DPP_ADD(v, 0x4E, 0xF, true); DPP_ADD(v, 0x141, 0xF, true); DPP_ADD(v, 0x140, 0xF, true); return v; }
__device__ __forceinline__ float wave_sum(float v) {
    v = sum16(v); DPP_ADD(v, 0x142, 0xA, false); DPP_ADD(v, 0x143, 0xC, false);
    return __builtin_bit_cast(float, __builtin_amdgcn_readlane(__builtin_bit_cast(int, v), 63)); }
__device__ __forceinline__ float rsqf(float x) { return __builtin_amdgcn_rsqf(x); }
__device__ __forceinline__ unsigned cvtpk(float lo, float hi) { unsigned r; asm("v_cvt_pk_bf16_f32 %0, %1, %2" : "=v"(r) : "v"(lo), "v"(hi)); return r; }
__device__ __forceinline__ int compact_row(int r) {
    if (r >= MR) return -1;
    if (r >= RP) return r - RP + BP * SEQ;
    const int b = r / TP, t = r - b * TP;
    return t < NMETA ? -1 : r - NMETA * (b + 1);
}

__device__ __forceinline__ void p0_transpose_item(const float* W, int Nsrc, int K, bf16* WT, int dst_row0, int src_col0, int nvalid, int k0, int lane) {
    const float* src = W + (size_t)k0 * Nsrc + src_col0 + (lane < nvalid ? lane : 0);
    float v[32];
#pragma unroll
    for (int j = 0; j < 32; ++j) v[j] = src[(size_t)j * Nsrc];
    if (lane >= nvalid) {
#pragma unroll
        for (int j = 0; j < 32; ++j) v[j] = 0.f; }
    GAS v4u* dst = (GAS v4u*)(WT + (size_t)(dst_row0 + lane) * K + k0);
#pragma unroll
    for (int q = 0; q < 4; ++q) { v4u o; o.x = cvtpk(v[8 * q], v[8 * q + 1]); o.y = cvtpk(v[8 * q + 2], v[8 * q + 3]); o.z = cvtpk(v[8 * q + 4], v[8 * q + 5]); o.w = cvtpk(v[8 * q + 6], v[8 * q + 7]); dst[q] = o; }
}
__device__ __forceinline__ void win_src(int nb, int& src, int& nvalid) {
    const int pn = nb >> 2, o = (nb & 3) * 64; nvalid = 64;
    if (pn < 8) src = (o < 128) ? 128 * pn + o : 1024 + 128 * pn + (o - 128);
    else if (pn < 20) src = 2048 + 256 * (pn - 8) + o;
    else if (pn < 24) src = 5120 + 256 * (pn - 20) + o;
    else if (pn < 28) src = 6160 + 256 * (pn - 24) + o;
    else if (pn < 32) src = 7184 + 256 * (pn - 28) + o;
    else { src = 6144; nvalid = (o == 0) ? 16 : 0; }
}
__device__ __forceinline__ void rms_row_to_bf16(const float* xrow, const float* gain, bf16* orow, int lane) {
    const GAS f32x4* xr = (const GAS f32x4*)xrow + lane; const GAS f32x4* gr = (const GAS f32x4*)gain + lane;
    f32x4 v[4]; float s = 0.f;
#pragma unroll
    for (int j = 0; j < 4; ++j) { v[j] = xr[64 * j]; s += (v[j].x * v[j].x + v[j].y * v[j].y) + (v[j].z * v[j].z + v[j].w * v[j].w); }
    const float rstd = 1.f / sqrtf(wave_sum(s) * (1.f / DM) + EPS);
    GAS unsigned long long* o8 = (GAS unsigned long long*)orow + lane;
#pragma unroll
    for (int j = 0; j < 4; ++j) { const f32x4 g = gr[64 * j]; o8[64 * j] = (unsigned long long)pk2(v[j].x * rstd * g.x, v[j].y * rstd * g.y) | ((unsigned long long)pk2(v[j].z * rstd * g.z, v[j].w * rstd * g.w) << 32); }
}

typedef pg8::f32x4 A4;
struct EpiIn {
    static constexpr bool PERM = true;
    bf16 *GLU, *QKVB, *QS, *HALOQ, *HALOC, *ZS, *SGC, *SGD; float* BETAG; const float *a_log, *dt_bias;
    __device__ __forceinline__ void operator()(const A4 (&acc)[2][2][4][2], const pg8::Unit& u, int wr, int wc, int fr, int fq) const {
        const int pn = u.pn, row0 = u.pm * 256 + wr * 64 + fr, cw = 32 * wc + 8 * fq;
        if (pn < 8) {
#pragma unroll
            for (int ai = 0; ai < 2; ++ai)
#pragma unroll
                for (int m = 0; m < 4; ++m) { const int r = row0 + ai * 128 + m * 16; float o[8];
#pragma unroll
                    for (int n = 0; n < 2; ++n)
#pragma unroll
                        for (int j = 0; j < 4; ++j) o[4 * n + j] = acc[ai][0][m][n][j] * sigmoidf_(acc[ai][1][m][n][j]);
                    v4u w; w.x = pk2(o[0], o[1]); w.y = pk2(o[2], o[3]); w.z = pk2(o[4], o[5]); w.w = pk2(o[6], o[7]);
                    *(GAS v4u*)(GLU + (size_t)r * DM + 128 * pn + cw) = w;
                    if (r < RP) { const int b = r / TP, t = r - b * TP, run = t / RUNL, pos = t - run * RUNL;
                        if (pos >= RUNL - 30 && run < NRUN - 1) *(GAS v4u*)(HALOC + ((size_t)(b * NRUN + run) * 30 + (pos - (RUNL - 30))) * DM + 128 * pn + cw) = w; } }
        } else if (pn < 20) {
            const int colb = 256 * (pn - 8);
#pragma unroll
            for (int ai = 0; ai < 2; ++ai)
#pragma unroll
                for (int m = 0; m < 4; ++m) { const int r = row0 + ai * 128 + m * 16; if (r >= MR) continue;
#pragma unroll
                    for (int bj = 0; bj < 2; ++bj) { const int col = colb + 128 * bj + cw;
                        const A4 a0 = acc[ai][bj][m][0], a1 = acc[ai][bj][m][1];
                        v4u w; w.x = pk2(a0[0], a0[1]); w.y = pk2(a0[2], a0[3]); w.z = pk2(a1[0], a1[1]); w.w = pk2(a1[2], a1[3]);
                        if (r >= RP) *(GAS v4u*)(QS + (size_t)(r - RP) * DQKV + col) = w;
                        else { const int b = r / TP, t = r - b * TP, c = t >> 6, i = t & 63, which = col >> 10, h = (col >> 7) & 7, d = col & 127;
                            *(GAS v4u*)(QKVB + ((size_t)((b * NCH + c) * NH + h) * 3 + which) * 8192 + i * 128 + d) = w;
                            if (i >= 61) *(GAS v4u*)(HALOQ + ((size_t)(b * NCH + c) * 3 + (i - 61)) * DQKV + col) = w; } } }
        } else if (pn < 24) {
            constexpr bool isz = true; bf16* dst = ZS; const int ld = DM, cb = 256 * (pn - 20);
#pragma unroll
            for (int ai = 0; ai < 2; ++ai)
#pragma unroll
                for (int m = 0; m < 4; ++m) { const int r = row0 + ai * 128 + m * 16;
#pragma unroll
                    for (int bj = 0; bj < 2; ++bj) { float o[8];
#pragma unroll
                        for (int n = 0; n < 2; ++n)
#pragma unroll
                            for (int j = 0; j < 4; ++j) { const float v = acc[ai][bj][m][n][j]; o[4 * n + j] = isz ? siluf_(v) : v; }
                        v4u w; w.x = pk2(o[0], o[1]); w.y = pk2(o[2], o[3]); w.z = pk2(o[4], o[5]); w.w = pk2(o[6], o[7]);
                        *(GAS v4u*)(dst + (size_t)r * ld + cb + 128 * bj + cw) = w; } }
        } else if (pn < 32) {
            bf16* dst = pn < 28 ? SGC : SGD; const int cb = 256 * ((pn - 24) & 3);
#pragma unroll
            for (int ai = 0; ai < 2; ++ai)
#pragma unroll
                for (int m = 0; m < 4; ++m) { const int rc = compact_row(row0 + ai * 128 + m * 16); if (rc < 0) continue;
#pragma unroll
                    for (int bj = 0; bj < 2; ++bj) { float o[8];
#pragma unroll
                        for (int n = 0; n < 2; ++n)
#pragma unroll
                            for (int j = 0; j < 4; ++j) o[4 * n + j] = sigmoidf_(acc[ai][bj][m][n][j]);
                        v4u w; w.x = pk2(o[0], o[1]); w.y = pk2(o[2], o[3]); w.z = pk2(o[4], o[5]); w.w = pk2(o[6], o[7]);
                        *(GAS v4u*)(dst + (size_t)rc * DM + cb + 128 * bj + cw) = w; } }
        } else {
            if (wc == 0 && fq < 2) {
#pragma unroll
                for (int ai = 0; ai < 2; ++ai)
#pragma unroll
                    for (int m = 0; m < 4; ++m) { const int r = row0 + ai * 128 + m * 16; float o[8];
#pragma unroll
                        for (int n = 0; n < 2; ++n)
#pragma unroll
                            for (int j = 0; j < 4; ++j) { const int h = 4 * n + j; const float v = acc[ai][0][m][n][j];
                                if (fq == 0) o[h] = 1.f / (1.f + expf(-v));
                                else { const float xx = v + dt_bias[h]; const float sp = xx > 20.f ? xx : log1pf(expf(xx)); o[h] = -expf(a_log[h]) * sp; } }
                        GAS f32x4* p = (GAS f32x4*)(BETAG + (size_t)r * 16 + 8 * fq);
                        p[0] = (f32x4){o[0], o[1], o[2], o[3]}; p[1] = (f32x4){o[4], o[5], o[6], o[7]}; }
            }
        }
    }
};
template <int MODE> struct EpiGate {
    static constexpr bool PERM = true;
    bf16 *SG, *MA, *OUT;
    __device__ __forceinline__ void operator()(const A4 (&acc)[2][2][4][2], const pg8::Unit& u, int wr, int wc, int fr, int fq) const {
        const int row0 = u.pm * 256 + wr * 64 + fr, c0 = 256 * u.pn + 32 * wc + 8 * fq;
#pragma unroll
        for (int ai = 0; ai < 2; ++ai)
#pragma unroll
            for (int m = 0; m < 4; ++m) { const int rc = compact_row(row0 + ai * 128 + m * 16); if (rc < 0) continue;
#pragma unroll
                for (int bj = 0; bj < 2; ++bj) { const size_t off = (size_t)rc * DM + c0 + 128 * bj;
                    const v4u g = *(const GAS v4u*)(SG + off); float o[8];
                    const A4 a0 = acc[ai][bj][m][0], a1 = acc[ai][bj][m][1];
                    o[0] = bflo(g.x) * a0[0]; o[1] = bfhi(g.x) * a0[1]; o[2] = bflo(g.y) * a0[2]; o[3] = bfhi(g.y) * a0[3];
                    o[4] = bflo(g.z) * a1[0]; o[5] = bfhi(g.z) * a1[1]; o[6] = bflo(g.w) * a1[2]; o[7] = bfhi(g.w) * a1[3];
                    if (MODE == 1) { const v4u q = *(const GAS v4u*)(MA + off);
                        o[0] += bflo(q.x); o[1] += bfhi(q.x); o[2] += bflo(q.y); o[3] += bfhi(q.y); o[4] += bflo(q.z); o[5] += bfhi(q.z); o[6] += bflo(q.w); o[7] += bfhi(q.w); }
                    v4u w; w.x = pk2(o[0], o[1]); w.y = pk2(o[2], o[3]); w.z = pk2(o[4], o[5]); w.w = pk2(o[6], o[7]);
                    *(GAS v4u*)(OUT + off) = w; } }
    }
};
template <int MODE> struct EpiRes {
    static constexpr bool PERM = false;
    const float *xp, *xs; float* out; float* parts; const bf16* X1B;
    __device__ __forceinline__ void operator()(const A4 (&acc)[2][2][4][2], const pg8::Unit& u, int wr, int wc, int fr, int fq) const {
        const int row0 = u.pm * 256 + wr * 64 + fr, c0 = 256 * u.pn + 32 * wc + 4 * fq;
        if (u.pm >= BP * SEQ / 256) {
            float* part = parts + (size_t)(u.k0 / u.nt) * RS * DM;
#pragma unroll
            for (int ai = 0; ai < 2; ++ai)
#pragma unroll
                for (int m = 0; m < 4; ++m) { float* orow = part + (size_t)(row0 + ai * 128 + m * 16 - BP * SEQ) * DM;
#pragma unroll
                    for (int bj = 0; bj < 2; ++bj)
#pragma unroll
                        for (int n = 0; n < 2; ++n) *(GAS f32x4*)(orow + c0 + 128 * bj + 16 * n) = acc[ai][bj][m][n]; }
            return; }
#pragma unroll
        for (int ai = 0; ai < 2; ++ai)
#pragma unroll
            for (int m = 0; m < 4; ++m) { const int r = row0 + ai * 128 + m * 16;
                float* orow = out + (size_t)r * DM;
                if (MODE == 0) { const float* base = r < BP * SEQ ? xp + (size_t)r * DM : xs + (size_t)(r - BP * SEQ) * DM;
#pragma unroll
                    for (int bj = 0; bj < 2; ++bj)
#pragma unroll
                        for (int n = 0; n < 2; ++n) { const int c = c0 + 128 * bj + 16 * n; const f32x4 b = *(const GAS f32x4*)(base + c); *(GAS f32x4*)(orow + c) = b + acc[ai][bj][m][n]; }
                } else {
#pragma unroll
                    for (int bj = 0; bj < 2; ++bj)
#pragma unroll
                        for (int n = 0; n < 2; ++n) { const int c = c0 + 128 * bj + 16 * n; const v2u b = *(const GAS v2u*)(X1B + (size_t)r * DM + c);
                            *(GAS f32x4*)(orow + c) = (f32x4){bflo(b.x), bfhi(b.x), bflo(b.y), bfhi(b.y)} + acc[ai][bj][m][n]; } } }
    }
};
struct EpiWo {
    const float *xp; bf16* X1B; float* parts;
    __device__ __forceinline__ void operator()(const A4 (&acc)[2][2][4][2], const pg8::Unit& u, int wr, int wc, int fr, int fq) const {
        const int row0 = u.pm * 256 + wr * 64 + fr, c0 = 256 * u.pn + 32 * wc + 8 * fq;
        if (u.pm >= BP * SEQ / 256) {
            float* part = parts + (size_t)(u.k0 / u.nt) * RS * DM;
#pragma unroll
            for (int ai = 0; ai < 2; ++ai)
#pragma unroll
                for (int m = 0; m < 4; ++m) { float* orow = part + (size_t)(row0 + ai * 128 + m * 16 - BP * SEQ) * DM + c0;
#pragma unroll
                    for (int bj = 0; bj < 2; ++bj) { *(GAS f32x4*)(orow + 128 * bj) = acc[ai][bj][m][0]; *(GAS f32x4*)(orow + 128 * bj + 4) = acc[ai][bj][m][1]; } }
            return; }
#pragma unroll
        for (int ai = 0; ai < 2; ++ai)
#pragma unroll
            for (int m = 0; m < 4; ++m) { const int r = row0 + ai * 128 + m * 16; const float* xrow = xp + (size_t)r * DM + c0;
#pragma unroll
                for (int bj = 0; bj < 2; ++bj) { const f32x4 x0 = *(const GAS f32x4*)(xrow + 128 * bj) + acc[ai][bj][m][0], x1 = *(const GAS f32x4*)(xrow + 128 * bj + 4) + acc[ai][bj][m][1];
                    v4u w; w.x = cvtpk(x0[0], x0[1]); w.y = cvtpk(x0[2], x0[3]); w.z = cvtpk(x1[0], x1[1]); w.w = cvtpk(x1[2], x1[3]);
                    *(GAS v4u*)(X1B + (size_t)r * DM + c0 + 128 * bj) = w; } }
    }
};
struct EpiWoP : EpiWo { static constexpr bool PERM = true; };
struct EpiUp {
    static constexpr bool PERM = true;
    bf16* HM;
    __device__ __forceinline__ void operator()(const A4 (&acc)[2][2][4][2], const pg8::Unit& u, int wr, int wc, int fr, int fq) const {
        const int row0 = u.pm * 256 + wr * 64 + fr, c0 = 256 * u.pn + 32 * wc + 8 * fq;
#pragma unroll
        for (int ai = 0; ai < 2; ++ai)
#pragma unroll
            for (int m = 0; m < 4; ++m) { const int r = row0 + ai * 128 + m * 16;
#pragma unroll
                for (int bj = 0; bj < 2; ++bj) { float o[8];
#pragma unroll
                    for (int n = 0; n < 2; ++n)
#pragma unroll
                        for (int j = 0; j < 4; ++j) { const float v = fmaxf(acc[ai][bj][m][n][j], 0.f); o[4 * n + j] = v * v; }
                    v4u w; w.x = pk2(o[0], o[1]); w.y = pk2(o[2], o[3]); w.z = pk2(o[4], o[5]); w.w = pk2(o[6], o[7]);
                    *(GAS v4u*)(HM + (size_t)r * DFF + c0 + 128 * bj) = w; } }
    }
};

template <int KIND>
__device__ __forceinline__ void conv_unit(const Args& a, LAS unsigned char* lds, int b, int run) {
    asm volatile("" ::: "memory");
    const int tid = threadIdx.x, lane = tid & 63, wave = tid >> 6; int ch = 2 * tid; asm volatile("" : "+v"(ch));
    unsigned char* ws = a.ws;
    bf16* GC = (bf16*)(ws + WS_GLU); const bf16* HALOC = (const bf16*)(ws + WS_HALOC);
    const float* w_dw = a.in[8];
    LAS float* red = (LAS float*)lds;
    constexpr int NTOK = KIND == 0 ? RUNL : TS, NSTEP = (NTOK + 3) / 4, REM = NTOK - 4 * (NSTEP - 1);
    f32x2 w[KC]; unsigned E[KC + 3];
#pragma unroll
    for (int i = 0; i < KC; ++i) w[i] = *(const GAS f32x2*)(w_dw + (size_t)i * DM + ch);
    const f32x2 bdw = *(const GAS f32x2*)(a.in[9] + ch), lng = *(const GAS f32x2*)(a.in[10] + ch), lnb = *(const GAS f32x2*)(a.in[11] + ch);
    const int row0 = KIND == 0 ? b * TP + run * RUNL : RP + b * TS;
    if (KIND == 0) {
#pragma unroll
        for (int i = 0; i < KC - 1; ++i) { unsigned v = *(const GAS unsigned*)(HALOC + ((size_t)(b * NRUN + (run > 0 ? run - 1 : 0)) * 30 + i) * DM + ch); E[i] = run > 0 ? v : 0u; }
    } else { const float* st = a.in[2] + (size_t)b * (KC - 1) * DM;
#pragma unroll
        for (int i = 0; i < KC - 1; ++i) { const f32x2 v = *(const GAS f32x2*)(st + (size_t)i * DM + ch); E[i] = pk2(v.x, v.y); }
    }
    unsigned nx[4];
#pragma unroll
    for (int k = 0; k < 4; ++k) nx[k] = *(const GAS unsigned*)(GC + (size_t)(row0 + (k < NTOK ? k : NTOK - 1)) * DM + ch);
    for (int st4 = 0; st4 < NSTEP; ++st4) {
        const int t0 = 4 * st4;
#pragma unroll
        for (int k = 0; k < 4; ++k) E[KC - 1 + k] = nx[k];
        if (st4 + 1 < NSTEP) {
#pragma unroll
            for (int k = 0; k < 4; ++k) { const int t = t0 + 4 + k; nx[k] = *(const GAS unsigned*)(GC + (size_t)(row0 + (t < NTOK ? t : NTOK - 1)) * DM + ch); }
        }
        f32x2 y[4] = {bdw, bdw, bdw, bdw};
#pragma unroll
        for (int j = 0; j < KC + 3; ++j) { const f32x2 e = {bflo(E[j]), bfhi(E[j])};
#pragma unroll
            for (int k = 0; k < 4; ++k) { const int i = j - k; if (i >= 0 && i < KC) y[k] += w[i] * e; } }
        float sv[8];
#pragma unroll
        for (int k = 0; k < 4; ++k) { sv[2 * k] = wave_sum(y[k].x + y[k].y); sv[2 * k + 1] = wave_sum(y[k].x * y[k].x + y[k].y * y[k].y); }
        LAS float* rb = red + (st4 & 1) * 64;
        if (lane == 0) { *(LAS f32x4*)(rb + wave * 8) = (f32x4){sv[0], sv[1], sv[2], sv[3]}; *(LAS f32x4*)(rb + wave * 8 + 4) = (f32x4){sv[4], sv[5], sv[6], sv[7]}; }
        __syncthreads();
        f32x4 ta = {0.f, 0.f, 0.f, 0.f}, tb = {0.f, 0.f, 0.f, 0.f};
#pragma unroll
        for (int i = 0; i < 8; ++i) { ta += *(const LAS f32x4*)(rb + i * 8); tb += *(const LAS f32x4*)(rb + i * 8 + 4); }
        const float tt[8] = {ta.x, ta.y, ta.z, ta.w, tb.x, tb.y, tb.z, tb.w};
#pragma unroll
        for (int k = 0; k < 4; ++k) { if (t0 + k < NTOK) {
            const float mu = tt[2 * k] * (1.f / DM), var = fmaxf(tt[2 * k + 1] * (1.f / DM) - mu * mu, 0.f), rstd = rsqf(var + EPS);
            const float z0 = (y[k].x - mu) * rstd * lng.x + lnb.x, z1 = (y[k].y - mu) * rstd * lng.y + lnb.y;
            *(GAS unsigned*)(GC + (size_t)(row0 + t0 + k) * DM + ch) = pk2(siluf_(z0), siluf_(z1)); } }
        if (st4 + 1 < NSTEP) {
#pragma unroll
            for (int i = 0; i < KC - 1; ++i) E[i] = E[i + 4];
        }
    }
    if (KIND == 1 || run == NRUN - 1) { float* o = a.out + (KIND == 0 ? O_PC : O_SC) + (size_t)b * (KC - 1) * DM;
        if (KIND == 0) {
#pragma unroll
            for (int i = 0; i < KC - 1; ++i) *(GAS f32x2*)(o + (size_t)i * DM + ch) = (f32x2){bflo(E[REM + i]), bfhi(E[REM + i])};
        } else {
            const float* st = a.in[2] + (size_t)b * (KC - 1) * DM;
#pragma unroll
            for (int i = 0; i < KC - 1 - TS; ++i) *(GAS f32x2*)(o + (size_t)i * DM + ch) = *(const GAS f32x2*)(st + (size_t)(i + TS) * DM + ch);
#pragma unroll
            for (int i = KC - 1 - TS; i < KC - 1; ++i) *(GAS f32x2*)(o + (size_t)i * DM + ch) = (f32x2){bflo(E[REM + i]), bfhi(E[REM + i])};
        }
    }
    __syncthreads();
}

__device__ __forceinline__ void delta_item(const Args& a, LAS unsigned char* lds, int item) {
    asm volatile("" ::: "memory");
    const int tid = threadIdx.x, lane = tid & 63, sub = tid >> 7, wu = (tid >> 6) & 1; int j = tid & 127; asm volatile("" : "+v"(j));
    const int unit = item * 4 + sub, b = unit >> 3, h = unit & 7;
    const int row0 = RP + b * TS;
    const bf16* QS = (const bf16*)(a.ws + WS_QS); bf16* ZS = (bf16*)(a.ws + WS_ZS); const float* BETAG = (const float*)(a.ws + WS_BETAG);
    LAS float* kq = (LAS float*)lds + sub * 256;
    LAS float* red = (LAS float*)lds + 1024 + sub * 4;
    LAS float* red2 = (LAS float*)lds + 1024 + 16 + sub * 2;
    float S[DH];
    { const float* s0 = a.in[4] + ((size_t)(b * NH + h) * DH) * DH + j;
#pragma unroll
        for (int d = 0; d < DH; ++d) S[d] = s0[(size_t)d * DH]; }
    const int cq = h * DH + j, ck = DM + cq, cv = 2 * DM + cq;
    float wq[KS], wk[KS], wv[KS];
#pragma unroll
    for (int i = 0; i < KS; ++i) { wq[i] = a.in[13][i * DQKV + cq]; wk[i] = a.in[13][i * DQKV + ck]; wv[i] = a.in[13][i * DQKV + cv]; }
    float hq[3], hk[3], hv[3];
#pragma unroll
    for (int i = 0; i < 3; ++i) { const float* st = a.in[3] + ((size_t)b * 3 + i) * DQKV; hq[i] = st[cq]; hk[i] = st[ck]; hv[i] = st[cv]; }
    const float gh = a.in[16][j];
    float pq[TS], pk[TS], pv[TS], pbe[TS], pgg[TS], pzs[TS];
#pragma unroll
    for (int t = 0; t < TS; ++t) { const bf16* p = QS + (size_t)(b * TS + t) * DQKV; pq[t] = bf1(p[cq]); pk[t] = bf1(p[ck]); pv[t] = bf1(p[cv]);
        pbe[t] = BETAG[(size_t)(row0 + t) * 16 + h]; pgg[t] = BETAG[(size_t)(row0 + t) * 16 + 8 + h]; pzs[t] = bf1(ZS[(size_t)(row0 + t) * DM + cq]); }
#pragma unroll
    for (int t = 0; t < TS; ++t) {
        const size_t row = (size_t)(row0 + t);
        const float qp = pq[t], kp = pk[t], vp = pv[t];
        const float qc = siluf_(wq[0] * hq[0] + wq[1] * hq[1] + wq[2] * hq[2] + wq[3] * qp);
        const float kc = siluf_(wk[0] * hk[0] + wk[1] * hk[1] + wk[2] * hk[2] + wk[3] * kp);
        const float vc = siluf_(wv[0] * hv[0] + wv[1] * hv[1] + wv[2] * hv[2] + wv[3] * vp);
        hq[0] = hq[1]; hq[1] = hq[2]; hq[2] = qp; hk[0] = hk[1]; hk[1] = hk[2]; hk[2] = kp; hv[0] = hv[1]; hv[1] = hv[2]; hv[2] = vp;
        const float sq = wave_sum(qc * qc), sk = wave_sum(kc * kc);
        kq[j] = kc; kq[128 + j] = qc;
        if (lane == 0) { red[wu * 2] = sq; red[wu * 2 + 1] = sk; }
        const float beta = pbe[t], gg = pgg[t], zs = pzs[t];
        __syncthreads();
        const float nq = rsqf(red[0] + red[2] + 1e-6f) * 0.08838834764831845f, nk = rsqf(red[1] + red[3] + 1e-6f);
        const float alpha = __expf(gg);
        float ks0 = 0.f, ks1 = 0.f, ks2 = 0.f, ks3 = 0.f;
#pragma unroll
        for (int d = 0; d < DH; d += 4) { const f32x4 kk = *(const LAS f32x4*)(kq + d); ks0 += kk.x * S[d]; ks1 += kk.y * S[d + 1]; ks2 += kk.z * S[d + 2]; ks3 += kk.w * S[d + 3];
            if ((d & 31) == 28) asm volatile("" ::: "memory"); }
        const float kS = (ks0 + ks1) + (ks2 + ks3);
        const float u = beta * (vc - alpha * nk * kS), un = nk * u;
        float o0 = 0.f, o1 = 0.f, o2 = 0.f, o3 = 0.f;
#pragma unroll
        for (int d = 0; d < DH; d += 4) { const f32x4 kk = *(const LAS f32x4*)(kq + d); const f32x4 qq = *(const LAS f32x4*)(kq + 128 + d);
            S[d] = alpha * S[d] + kk.x * un; S[d + 1] = alpha * S[d + 1] + kk.y * un; S[d + 2] = alpha * S[d + 2] + kk.z * un; S[d + 3] = alpha * S[d + 3] + kk.w * un;
            o0 += qq.x * S[d]; o1 += qq.y * S[d + 1]; o2 += qq.z * S[d + 2]; o3 += qq.w * S[d + 3];
            if ((d & 15) == 12) asm volatile("" ::: "memory"); }
        const float o = ((o0 + o1) + (o2 + o3)) * nq;
        const float so = wave_sum(o * o);
        if (lane == 0) red2[wu] = so;
        __syncthreads();
        const float rms = rsqf((red2[0] + red2[1]) * (1.f / DH) + EPS);
        ZS[row * DM + cq] = (bf16)f2bf(o * rms * gh * zs);
    }
    { float* so = a.out + O_SD + ((size_t)(b * NH + h) * DH) * DH + j;
#pragma unroll
        for (int d = 0; d < DH; ++d) so[(size_t)d * DH] = S[d];
      float* qo = a.out + O_SQ + (size_t)b * 3 * DQKV;
#pragma unroll
        for (int i = 0; i < 3; ++i) { qo[i * DQKV + cq] = hq[i]; qo[i * DQKV + ck] = hk[i]; qo[i * DQKV + cv] = hv[i]; }
    }
    __syncthreads();
}

__host__ __device__ constexpr int perm_k(int x) { return (x & ~31) | (((x >> 2) & 3) << 3) | (((x >> 4) & 1) << 2) | (x & 3); }
typedef short bf16x8v __attribute__((ext_vector_type(8)));
constexpr int IH_QH = 0, IH_KH = 17408, IH_VH = 34816, IH_GV = 52224, IH_BYTES = 54272;
__device__ __forceinline__ void intra_pair(const Args& a, LAS unsigned char* lds_all, int pair) {
    asm volatile("" ::: "memory");
    const int tid = threadIdx.x, half = tid >> 8, lane = tid & 63, wq = (tid >> 6) & 3; int tu = tid & 255; asm volatile("" : "+v"(tu));
    const int uq = pair * 2 + half, h = uq & 7, bc = uq >> 3, b = bc / NCH, c = bc - b * NCH;
    const int nvalid = (c == NCH - 1) ? TP - 64 * (NCH - 1) : 64;
    LAS unsigned char* lds = lds_all + half * IH_BYTES;
    LAS bf16* QH = (LAS bf16*)(lds + IH_QH); LAS bf16* KH = (LAS bf16*)(lds + IH_KH); LAS bf16* VH = (LAS bf16*)(lds + IH_VH);
    LAS float* MF = (LAS float*)(lds + IH_KH); LAS bf16* ATL = (LAS bf16*)(lds + IH_VH); LAS float* GV = (LAS float*)(lds + IH_GV);
    unsigned char* ws = a.ws;
    bf16* blk = (bf16*)(ws + WS_QKVB) + (size_t)uq * QBLK; const bf16* HALOQ = (const bf16*)(ws + WS_HALOQ); const float* BETAG = (const float*)(ws + WS_BETAG);
    bf16* KDT = (bf16*)(ws + WS_KDT) + (size_t)uq * 8192; bf16* ATT = (bf16*)(ws + WS_ATTN) + (size_t)uq * 4096; float* LASTV = (float*)(ws + WS_LASTV);
    if (tu < 64) { const int i = tu; float g = 0.f, be = 0.f; { const float* p = BETAG + (size_t)(b * TP + 64 * c + (i < nvalid ? i : 0)) * 16; be = p[h]; g = p[8 + h]; } if (i >= nvalid) { g = 0.f; be = 0.f; }
        float G = g;
#pragma unroll
        for (int o = 1; o < 64; o <<= 1) { const float t = __shfl_up(G, o); if (lane >= o) G += t; }
        const float GL = __shfl(G, 63);
        GV[i] = G; GV[64 + i] = be; GV[128 + i] = expf(G); GV[192 + i] = expf(GL - G);
        if (i == 63) LASTV[uq] = expf(GL); }
    {   const int cp = tu & 15, rg = tu >> 4;
        v4u raw[3][7];
#pragma unroll
        for (int wh = 0; wh < 3; ++wh)
#pragma unroll
            for (int k = 0; k < 7; ++k) { const int rr = 4 * rg - 3 + k;
                const bf16* p = (rr >= 0) ? blk + wh * 8192 + rr * 128 + 8 * cp : HALOQ + ((size_t)(b * NCH + (c > 0 ? c - 1 : 0)) * 3 + (3 + rr)) * DQKV + wh * DM + h * DH + 8 * cp;
                raw[wh][k] = *(const GAS v4u*)p; }
#pragma unroll
        for (int wh = 0; wh < 3; ++wh) {
            const int col = wh * DM + h * DH + 8 * cp;
            f32x4 wl[4], wh4[4];
#pragma unroll
            for (int i = 0; i < 4; ++i) { wl[i] = *(const GAS f32x4*)(a.in[13] + i * DQKV + col); wh4[i] = *(const GAS f32x4*)(a.in[13] + i * DQKV + col + 4); }
            float xr[7][8];
#pragma unroll
            for (int k = 0; k < 7; ++k) { const int rr = 4 * rg - 3 + k; const bool ok = (rr >= 0) ? (rr < nvalid) : (c > 0); const v4u v = raw[wh][k];
                xr[k][0] = ok ? bflo(v.x) : 0.f; xr[k][1] = ok ? bfhi(v.x) : 0.f; xr[k][2] = ok ? bflo(v.y) : 0.f; xr[k][3] = ok ? bfhi(v.y) : 0.f;
                xr[k][4] = ok ? bflo(v.z) : 0.f; xr[k][5] = ok ? bfhi(v.z) : 0.f; xr[k][6] = ok ? bflo(v.w) : 0.f; xr[k][7] = ok ? bfhi(v.w) : 0.f; }
            if (c == NCH - 1 && rg == (nvalid - 1) / 4) {
                float* qo = a.out + O_PQ + (size_t)b * 3 * DQKV + col;
#pragma unroll
                for (int i = 0; i < 3; ++i) { *(GAS f32x4*)(qo + i * DQKV) = (f32x4){xr[4 + i][0], xr[4 + i][1], xr[4 + i][2], xr[4 + i][3]}; *(GAS f32x4*)(qo + i * DQKV + 4) = (f32x4){xr[4 + i][4], xr[4 + i][5], xr[4 + i][6], xr[4 + i][7]}; } }
            LAS bf16* tile = wh == 0 ? QH : (wh == 1 ? KH : VH);
#pragma unroll
            for (int r = 0; r < 4; ++r) { const bool ok = (4 * rg + r) < nvalid; float y[8];
#pragma unroll
                for (int e = 0; e < 8; ++e) { const float w0 = e < 4 ? wl[0][e & 3] : wh4[0][e & 3], w1 = e < 4 ? wl[1][e & 3] : wh4[1][e & 3], w2 = e < 4 ? wl[2][e & 3] : wh4[2][e & 3], w3 = e < 4 ? wl[3][e & 3] : wh4[3][e & 3];
                    const float t = w0 * xr[r][e] + w1 * xr[r + 1][e] + w2 * xr[r + 2][e] + w3 * xr[r + 3][e]; y[e] = ok ? siluf_(t) : 0.f; }
                v4u o; o.x = cvtpk(y[0], y[1]); o.y = cvtpk(y[2], y[3]); o.z = cvtpk(y[4], y[5]); o.w = cvtpk(y[6], y[7]);
                *(LAS v4u*)(tile + (4 * rg + r) * 136 + 8 * cp) = o; }
        }
    }
    __syncthreads();
    const int which = tu >> 7, d = tu & 127;
    float x[64];
    { const LAS bf16* colp = (which == 0 ? VH : KH) + d;
#pragma unroll
      for (int i = 0; i < 64; ++i) x[i] = bf1(colp[i * 136]); }
    const int fr = lane & 15, fq = lane >> 4;
    f32x4 kk[4], qk[4];
    {   bf16x8v ak[4], aq[4];
#pragma unroll
        for (int sI = 0; sI < 4; ++sI) { ak[sI] = *(const LAS bf16x8v*)(KH + (16 * wq + fr) * 136 + 32 * sI + 8 * fq); aq[sI] = *(const LAS bf16x8v*)(QH + (16 * wq + fr) * 136 + 32 * sI + 8 * fq); }
        f32x4 kkd = {0.f, 0.f, 0.f, 0.f}, qqd = {0.f, 0.f, 0.f, 0.f};
#pragma unroll
        for (int sI = 0; sI < 4; ++sI) { kkd = __builtin_amdgcn_mfma_f32_16x16x32_bf16(ak[sI], ak[sI], kkd, 0, 0, 0); qqd = __builtin_amdgcn_mfma_f32_16x16x32_bf16(aq[sI], aq[sI], qqd, 0, 0, 0); }
#pragma unroll
        for (int nt = 0; nt < 4; ++nt) { kk[nt] = (f32x4){0.f, 0.f, 0.f, 0.f}; qk[nt] = (f32x4){0.f, 0.f, 0.f, 0.f};
            if (nt <= wq) {
#pragma unroll
                for (int sI = 0; sI < 4; ++sI) { const bf16x8v bk = *(const LAS bf16x8v*)(KH + (16 * nt + fr) * 136 + 32 * sI + 8 * fq);
                    kk[nt] = __builtin_amdgcn_mfma_f32_16x16x32_bf16(ak[sI], bk, kk[nt], 0, 0, 0); qk[nt] = __builtin_amdgcn_mfma_f32_16x16x32_bf16(aq[sI], bk, qk[nt], 0, 0, 0); } } }
#pragma unroll
        for (int r = 0; r < 4; ++r) if (fr == 4 * fq + r) { GV[320 + 16 * wq + fr] = rsqf(kkd[r] + 1e-6f); GV[256 + 16 * wq + fr] = rsqf(qqd[r] + 1e-6f) * 0.08838834764831845f; }
    }
    __syncthreads();
    {
#pragma unroll
        for (int nt = 0; nt < 4; ++nt) { const int j = 16 * nt + fr;
            if (nt <= wq) { const float Gj = GV[j], nkj = GV[320 + j];
#pragma unroll
                for (int r = 0; r < 4; ++r) { const int i = 16 * wq + 4 * fq + r; const float dec = (i >= j) ? __expf(GV[i] - Gj) : 0.f;
                    MF[i * 68 + j] = (i > j) ? GV[64 + i] * GV[320 + i] * nkj * kk[nt][r] * dec : 0.f;
                    ATL[i * 72 + j] = (bf16)f2bf(GV[256 + i] * nkj * qk[nt][r] * dec); }
            } else {
#pragma unroll
                for (int r = 0; r < 4; ++r) ATL[(16 * wq + 4 * fq + r) * 72 + j] = (bf16)0; }
        }
#pragma unroll
        for (int k = 0; k < 4; ++k) { const int pc = tu + 256 * k, i = pc >> 4, p16 = pc & 15, c0 = 32 * (p16 >> 2) + 4 * (p16 & 3);
            const v2u lo = *(const LAS v2u*)(QH + i * 136 + c0), hi = *(const LAS v2u*)(QH + i * 136 + c0 + 16); const float f = GV[256 + i] * GV[128 + i];
            v4u o; o.x = cvtpk(bflo(lo.x) * f, bfhi(lo.x) * f); o.y = cvtpk(bflo(lo.y) * f, bfhi(lo.y) * f); o.z = cvtpk(bflo(hi.x) * f, bfhi(hi.x) * f); o.w = cvtpk(bflo(hi.y) * f, bfhi(hi.y) * f);
            *(GAS v4u*)(blk + i * 128 + 8 * p16) = o; }
        if (which == 0) {
#pragma unroll
            for (int i = 0; i < 64; i += 4) { const f32x4 be = *(const LAS f32x4*)(GV + 64 + i); x[i] *= be.x; x[i + 1] *= be.y; x[i + 2] *= be.z; x[i + 3] *= be.w; }
        } else {
            bf16* kd = KDT + d * 64;
#pragma unroll
            for (int i = 0; i < 64; i += 4) { const f32x4 nk = *(const LAS f32x4*)(GV + 320 + i); x[i] *= nk.x; x[i + 1] *= nk.y; x[i + 2] *= nk.z; x[i + 3] *= nk.w; }
#pragma unroll
            for (int g8 = 0; g8 < 8; ++g8) { const int i0 = 32 * (g8 >> 2) + 4 * (g8 & 3);
                const f32x4 e0 = *(const LAS f32x4*)(GV + 192 + i0), e1 = *(const LAS f32x4*)(GV + 192 + i0 + 16);
                v4u w; w.x = cvtpk(x[i0] * e0.x, x[i0 + 1] * e0.y); w.y = cvtpk(x[i0 + 2] * e0.z, x[i0 + 3] * e0.w); w.z = cvtpk(x[i0 + 16] * e1.x, x[i0 + 17] * e1.y); w.w = cvtpk(x[i0 + 18] * e1.z, x[i0 + 19] * e1.w);
                *(GAS v4u*)(kd + 8 * g8) = w; }
#pragma unroll
            for (int i = 0; i < 64; i += 4) { const f32x4 be = *(const LAS f32x4*)(GV + 64 + i), eg = *(const LAS f32x4*)(GV + 128 + i);
                x[i] *= be.x * eg.x; x[i + 1] *= be.y * eg.y; x[i + 2] *= be.z * eg.z; x[i + 3] *= be.w * eg.w; }
        }
    }
    __syncthreads();
    {   f32x4 mb[16];
#pragma unroll
        for (int i = 1; i < 64; ++i) {
#pragma unroll
            for (int g = 0; g < (i + 3) / 4; ++g) mb[g] = *(const LAS f32x4*)(MF + i * 68 + 4 * g);
            __builtin_amdgcn_sched_barrier(0);
            f32x2 a01 = {x[i], 0.f}, a23 = {0.f, 0.f};
#pragma unroll
            for (int g = 0; g < (i + 3) / 4; ++g) { const f32x4 mm = mb[g];
                a01 -= (f32x2){mm.x, mm.y} * (f32x2){x[4 * g], x[4 * g + 1]}; a23 -= (f32x2){mm.z, mm.w} * (f32x2){x[4 * g + 2], x[4 * g + 3]}; }
            x[i] = (a01.x + a01.y) + (a23.x + a23.y);
            __builtin_amdgcn_sched_barrier(0);
        }
    }
    if (which == 0) {
        bf16* u0 = blk + 2 * 8192 + (size_t)(d >> 4) * 1024 + (d & 15) * 4;
#pragma unroll
        for (int m = 0; m < 4; ++m)
#pragma unroll
            for (int q = 0; q < 4; ++q) { const int i = 16 * m + 4 * q; v2u w; w.x = cvtpk(x[i], x[i + 1]); w.y = cvtpk(x[i + 2], x[i + 3]); *(GAS v2u*)(u0 + m * 256 + q * 64) = w; }
    } else {
#pragma unroll
        for (int i = 0; i < 64; ++i) QH[i * 136 + d] = (bf16)f2bf(x[i]);
    }
    __syncthreads();
#pragma unroll
    for (int k = 0; k < 4; ++k) { const int pc = tu + 256 * k, i = pc >> 4, p16 = pc & 15, c0 = 32 * (p16 >> 2) + 4 * (p16 & 3);
        const v2u lo = *(const LAS v2u*)(QH + i * 136 + c0), hi = *(const LAS v2u*)(QH + i * 136 + c0 + 16);
        *(GAS v4u*)(blk + 8192 + i * 128 + 8 * p16) = (v4u){lo.x, lo.y, hi.x, hi.y}; }
#pragma unroll
    for (int k = 0; k < 2; ++k) { const int pc = tu + 256 * k, i = pc >> 3, p8 = pc & 7, c0 = 32 * (p8 >> 2) + 4 * (p8 & 3);
        const v2u lo = *(const LAS v2u*)(ATL + i * 72 + c0), hi = *(const LAS v2u*)(ATL + i * 72 + c0 + 16);
        *(GAS v4u*)(ATT + i * 64 + 8 * p8) = (v4u){lo.x, lo.y, hi.x, hi.y}; }
    __syncthreads();
}

constexpr int SC_W = 0, SC_QD = 16384, SC_KDT = 32768, SC_AT = 49152, SC_BUF = 57344, SC_RMS = 2 * SC_BUF, SC_ZT = SC_RMS + 4096, SC_END = SC_ZT + 2 * 16384;
__device__ __forceinline__ int swz256(int row, int chunk) { return row * 256 + ((chunk ^ (row & 15)) << 4); }
__device__ __forceinline__ int swz128(int row, int ch) { return (row >> 1) * 256 + (((8 * (row & 1) + ch) ^ ((row >> 1) & 7)) << 4); }
__device__ __forceinline__ void scan_chain(const Args& a, LAS unsigned char* lds, int chain) {
    const int tid = threadIdx.x, lane = tid & 63, wave = __builtin_amdgcn_readfirstlane(tid >> 6), fr = lane & 15, fq = lane >> 4;
    const int b = chain >> 3, h = chain & 7;
    unsigned char* ws = a.ws;
    const bf16* QKVB = (const bf16*)(ws + WS_QKVB); const bf16* KDTg = (const bf16*)(ws + WS_KDT); const bf16* ATTg = (const bf16*)(ws + WS_ATTN); const float* LASTV = (const float*)(ws + WS_LASTV);
    bf16* ZS = (bf16*)(ws + WS_ZS);
    LAS float* RMS = (LAS float*)(lds + SC_RMS);
    const float gh = a.in[16][16 * wave + fr];
    f32x4 Sacc[8];
#pragma unroll
    for (int mt = 0; mt < 8; ++mt) Sacc[mt] = (f32x4){0.f, 0.f, 0.f, 0.f};
    v4u ztn[2]; v2u u0n[4]; float lastn;
    auto chunk_dma = [&](int c) {
        const size_t uq = (size_t)(b * NCH + c) * NH + h; const bf16* blk = QKVB + uq * QBLK; LAS unsigned char* base = lds + (c & 1) * SC_BUF;
#pragma unroll
        for (int k = 0; k < 2; ++k) { const int P = (wave + 8 * k) * 64 + lane, row = P >> 4, ch = (P & 15) ^ (row & 15);
            __builtin_amdgcn_global_load_lds((const unsigned*)(blk + 8192 + row * 128 + 8 * ch), (LAS unsigned*)(base + SC_W + (wave + 8 * k) * 1024), 16, 0, 0);
            __builtin_amdgcn_global_load_lds((const unsigned*)(blk + row * 128 + 8 * ch), (LAS unsigned*)(base + SC_QD + (wave + 8 * k) * 1024), 16, 0, 0);
            const int line = P >> 4, t = (P & 15) ^ (line & 7), r2 = 2 * line + (t >> 3);
            __builtin_amdgcn_global_load_lds((const unsigned*)(KDTg + uq * 8192 + r2 * 64 + 8 * (t & 7)), (LAS unsigned*)(base + SC_KDT + (wave + 8 * k) * 1024), 16, 0, 0); }
        { const int P = wave * 64 + lane, line = P >> 4, t = (P & 15) ^ (line & 7), r2 = 2 * line + (t >> 3);
            __builtin_amdgcn_global_load_lds((const unsigned*)(ATTg + uq * 4096 + r2 * 64 + 8 * (t & 7)), (LAS unsigned*)(base + SC_AT + wave * 1024), 16, 0, 0); }
    };
    auto side_load = [&](int c) {
        const size_t uq = (size_t)(b * NCH + c) * NH + h;
#pragma unroll
        for (int k = 0; k < 2; ++k) { const int p = tid + 512 * k; ztn[k] = *(const GAS v4u*)(ZS + (size_t)(b * TP + 64 * c + (p >> 4)) * DM + h * DH + 8 * (p & 15)); }
        const bf16* u0 = QKVB + uq * QBLK + 2 * 8192 + wave * 1024 + lane * 4;
#pragma unroll
        for (int m = 0; m < 4; ++m) u0n[m] = *(const GAS v2u*)(u0 + m * 256);
        lastn = LASTV[uq];
    };
    auto side_store = [&](int buf) {
#pragma unroll
        for (int k = 0; k < 2; ++k) { const int p = tid + 512 * k; *(LAS v4u*)(lds + SC_ZT + buf * 16384 + swz256(p >> 4, p & 15)) = ztn[k]; }
    };
    chunk_dma(0); side_load(0); side_store(0);
    v2u u0p[4]; float last;
#pragma unroll
    for (int m = 0; m < 4; ++m) u0p[m] = u0n[m];
    last = lastn;
    chunk_dma(1); side_load(1);
    __syncthreads();
    for (int c = 0; c < NCH; ++c) {
        const int buf = c & 1; LAS unsigned char* base = lds + buf * SC_BUF; LAS unsigned char* zt = lds + SC_ZT + buf * 16384;
        const int nvalid = (c == NCH - 1) ? TP - 64 * (NCH - 1) : 64;
        bf16x8v F[2][8];
#define SC_LD_A(m, f) do { _Pragma("unroll") for (int sI = 0; sI < 4; ++sI) { const int off = swz256(16 * (m) + fr, 4 * sI + fq); \
            f[2 * sI] = *(const LAS bf16x8v*)(base + SC_W + off); f[2 * sI + 1] = *(const LAS bf16x8v*)(base + SC_QD + off); } } while (0)
#define SC_LD_D(f) do { _Pragma("unroll") for (int m = 0; m < 4; ++m) _Pragma("unroll") for (int s2 = 0; s2 < 2; ++s2) f[2 * m + s2] = *(const LAS bf16x8v*)(base + SC_AT + swz128(16 * m + fr, 4 * s2 + fq)); } while (0)
#define SC_LD_C(g, f) do { _Pragma("unroll") for (int mm = 0; mm < 4; ++mm) _Pragma("unroll") for (int s2 = 0; s2 < 2; ++s2) f[2 * mm + s2] = *(const LAS bf16x8v*)(base + SC_KDT + swz128(16 * (4 * (g) + mm) + fr, 4 * s2 + fq)); } while (0)
        SC_LD_A(0, F[0]);
        bf16x8v Sb[4];
#pragma unroll
        for (int sI = 0; sI < 4; ++sI) { v4u w; w.x = cvtpk(Sacc[2 * sI][0], Sacc[2 * sI][1]); w.y = cvtpk(Sacc[2 * sI][2], Sacc[2 * sI][3]); w.z = cvtpk(Sacc[2 * sI + 1][0], Sacc[2 * sI + 1][1]); w.w = cvtpk(Sacc[2 * sI + 1][2], Sacc[2 * sI + 1][3]);
            Sb[sI] = __builtin_bit_cast(bf16x8v, w); }
        f32x4 u[4], o[4];
#pragma unroll
        for (int m = 0; m < 4; ++m) {
            if (m == 0) SC_LD_A(1, F[1]); else if (m == 1) SC_LD_A(2, F[0]); else if (m == 2) SC_LD_A(3, F[1]); else SC_LD_D(F[0]);
            __builtin_amdgcn_sched_barrier(0);
            f32x4 p = {0.f, 0.f, 0.f, 0.f}, oo = {0.f, 0.f, 0.f, 0.f};
#pragma unroll
            for (int sI = 0; sI < 4; ++sI) { p = __builtin_amdgcn_mfma_f32_16x16x32_bf16(F[m & 1][2 * sI], Sb[sI], p, 0, 0, 0); oo = __builtin_amdgcn_mfma_f32_16x16x32_bf16(F[m & 1][2 * sI + 1], Sb[sI], oo, 0, 0, 0); }
            u[m] = (f32x4){bflo(u0p[m].x), bfhi(u0p[m].x), bflo(u0p[m].y), bfhi(u0p[m].y)} - p; o[m] = oo;
            __builtin_amdgcn_sched_barrier(0);
        }
        bf16x8v Ub[2];
#pragma unroll
        for (int s2 = 0; s2 < 2; ++s2) { v4u w; w.x = cvtpk(u[2 * s2][0], u[2 * s2][1]); w.y = cvtpk(u[2 * s2][2], u[2 * s2][3]); w.z = cvtpk(u[2 * s2 + 1][0], u[2 * s2 + 1][1]); w.w = cvtpk(u[2 * s2 + 1][2], u[2 * s2 + 1][3]);
            Ub[s2] = __builtin_bit_cast(bf16x8v, w); }
        SC_LD_C(0, F[1]);
        __builtin_amdgcn_sched_barrier(0);
#pragma unroll
        for (int m = 0; m < 4; ++m)
#pragma unroll
            for (int s2 = 0; s2 < 2; ++s2) o[m] = __builtin_amdgcn_mfma_f32_16x16x32_bf16(F[0][2 * m + s2], Ub[s2], o[m], 0, 0, 0);
        __builtin_amdgcn_sched_barrier(0);
        SC_LD_C(1, F[0]);
        __builtin_amdgcn_sched_barrier(0);
#pragma unroll
        for (int mt = 0; mt < 4; ++mt) { f32x4 sacc = Sacc[mt] * last;
#pragma unroll
            for (int s2 = 0; s2 < 2; ++s2) sacc = __builtin_amdgcn_mfma_f32_16x16x32_bf16(F[1][2 * mt + s2], Ub[s2], sacc, 0, 0, 0);
            Sacc[mt] = sacc; }
        __builtin_amdgcn_sched_barrier(0);
#pragma unroll
        for (int mt = 4; mt < 8; ++mt) { f32x4 sacc = Sacc[mt] * last;
#pragma unroll
            for (int s2 = 0; s2 < 2; ++s2) sacc = __builtin_amdgcn_mfma_f32_16x16x32_bf16(F[0][2 * (mt - 4) + s2], Ub[s2], sacc, 0, 0, 0);
            Sacc[mt] = sacc; }
#undef SC_LD_A
#undef SC_LD_D
#undef SC_LD_C
        LAS float* rm = RMS + (c & 1) * 512;
#pragma unroll
        for (int m = 0; m < 4; ++m)
#pragma unroll
            for (int r = 0; r < 4; ++r) { const float v = sum16(o[m][r] * o[m][r]); if (fr == 0) rm[(16 * m + 4 * fq + r) * 8 + wave] = v; }
        if (c + 1 < NCH) { side_store(buf ^ 1);
#pragma unroll
            for (int m = 0; m < 4; ++m) u0p[m] = u0n[m];
            last = lastn; }
        __syncthreads();
        if (c + 2 < NCH) side_load(c + 2);
        {   LAS float* rsw = RMS + ((c + 1) & 1) * 512 + wave * 64;
            const f32x4 p0 = *(const LAS f32x4*)(rm + lane * 8), p1 = *(const LAS f32x4*)(rm + lane * 8 + 4);
            LAS bf16* zp[16]; bf16 zv[16];
#pragma unroll
            for (int m = 0; m < 4; ++m)
#pragma unroll
                for (int r = 0; r < 4; ++r) { zp[4 * m + r] = (LAS bf16*)(zt + swz256(16 * m + 4 * fq + r, 2 * wave + (fr >> 3))) + (fr & 7); zv[4 * m + r] = *zp[4 * m + r]; }
            rsw[lane] = rsqf((((p0.x + p0.y) + (p0.z + p0.w)) + ((p1.x + p1.y) + (p1.z + p1.w))) * (1.f / DH) + EPS);
            f32x4 rs[4];
#pragma unroll
            for (int m = 0; m < 4; ++m) rs[m] = *(const LAS f32x4*)(rsw + 16 * m + 4 * fq);
            __builtin_amdgcn_sched_barrier(0);
#pragma unroll
            for (int m = 0; m < 4; ++m)
#pragma unroll
                for (int r = 0; r < 4; ++r) *zp[4 * m + r] = (bf16)f2bf(o[m][r] * rs[m][r] * gh * bf1(zv[4 * m + r]));
        }
        __syncthreads();
        if (c + 2 < NCH) chunk_dma(c + 2);
#pragma unroll
        for (int k = 0; k < 2; ++k) { const int p = tid + 512 * k, i = p >> 4;
            if (i < nvalid) *(GAS v4u*)(ZS + (size_t)(b * TP + 64 * c + i) * DM + h * DH + 8 * (p & 15)) = *(const LAS v4u*)(zt + swz256(i, p & 15)); }
    }
    { float* so = a.out + O_PD + ((size_t)(b * NH + h) * DH) * DH + 16 * wave + fr;
#pragma unroll
      for (int mt = 0; mt < 8; ++mt)
#pragma unroll
          for (int r = 0; r < 4; ++r) so[(size_t)(16 * mt + 4 * fq + r) * DH] = Sacc[mt][r]; }
    __syncthreads();
}

static_assert(SC_END <= LDSCTL_OFF && 2 * IH_BYTES <= LDSCTL_OFF && RING_BYTES <= LDSCTL_OFF, "LDS map");
constexpr int NPHASES = 10;
__global__ void __launch_bounds__(NWAVES * 64, 2) fwd_kernel(Args args) {
    extern __shared__ __attribute__((aligned(16))) unsigned char lds_raw[];
    LAS unsigned char* lds = (LAS unsigned char*)lds_raw;
    volatile LAS unsigned* MISC = (volatile LAS unsigned*)(lds + MISC_OFF);
    const int tid = threadIdx.x, lane = tid & 63, wave = __builtin_amdgcn_readfirstlane(tid >> 6);
    const int G = gridDim.x, bx = blockIdx.x;
    const int vcu = (G % 8 == 0) ? (bx % 8) * (G / 8) + bx / 8 : bx;
    unsigned char* ws = args.ws;
    gu32* ctl = (gu32*)(ws + WS_CTL);
    for (int u = tid; u < (LDS_BYTES - LDSCTL_OFF) / 4; u += NWAVES * 64) ((LAS unsigned*)(lds + LDSCTL_OFF))[u] = 0u;
    __syncthreads();
    XcdBarrier bar; bar.bar = (unsigned*)(ctl + CW_BAR); bar.x = 0; bar.st = nullptr;
    const int lo = args.ph_lo, hi = args.ph_hi;
    if (hi - lo > 1) bar = xcd_barrier_post((unsigned*)(ctl + CW_BAR), MISC + 8);
#ifndef PH_MASK
#define PH_MASK 0x3ff
#endif
#define IN(k) (((PH_MASK >> (k)) & 1) && lo <= (k) && (k) < hi)
#ifndef PROBE_K
#define PROBE_K -1
#endif
#if PROBE_K >= 0
    volatile LAS unsigned long long* stamps = (volatile LAS unsigned long long*)(lds + MISC_OFF + 128);
    if (tid == 0) stamps[0] = __builtin_amdgcn_s_memrealtime();
#define SEAM(k) do { if (IN(k) && IN((k) + 1)) xcd_barrier(bar); if (tid == 0) stamps[(k) + 1] = __builtin_amdgcn_s_memrealtime(); } while (0)
#else
#define SEAM(k) do { if (IN(k) && IN((k) + 1)) xcd_barrier(bar); } while (0)
#endif
    bf16* WIN = (bf16*)(ws + WS_WIN); bf16* WC = (bf16*)(ws + WS_WC); bf16* WD = (bf16*)(ws + WS_WD); bf16* WO = (bf16*)(ws + WS_WO); bf16* WUP = (bf16*)(ws + WS_WUP); bf16* WDN = (bf16*)(ws + WS_WDN);
    bf16* H = (bf16*)(ws + WS_H); bf16* GLU = (bf16*)(ws + WS_GLU); bf16* QKVB = (bf16*)(ws + WS_QKVB); bf16* QS = (bf16*)(ws + WS_QS); bf16* ZS = (bf16*)(ws + WS_ZS);
    bf16* HALOQ = (bf16*)(ws + WS_HALOQ); bf16* HALOC = (bf16*)(ws + WS_HALOC);
    bf16* SGC = (bf16*)args.out; bf16* SGD = (bf16*)args.out + (size_t)M2 * DM;
    bf16* X1B = (bf16*)(ws + WS_X1B);
    bf16* MIX = (bf16*)(ws + WS_MIX); bf16* XG = (bf16*)(ws + WS_XG); bf16* HM = (bf16*)(ws + WS_HM); bf16* C = (bf16*)(ws + WS_C);
    float* BETAG = (float*)(ws + WS_BETAG);
    const int gw = vcu * NWAVES + wave, NGW = G * NWAVES;

    if (IN(0)) {
        constexpr int KB1 = DM / 32;
        constexpr int I_IN = KB1 * (NIN / 64);
        for (int it = gw; it < I_IN; it += NGW) { const int nb = it / KB1, kb = it % KB1; int src, nv; win_src(nb, src, nv); p0_transpose_item(args.in[7], DIN, DM, WIN, nb * 64, src, nv, kb * 32, lane); }
        for (int m0 = gw; m0 < MP; m0 += 2 * NGW) {
            const float* src[2]; bool ok[2]; f32x4 v[2][4];
#pragma unroll
            for (int q = 0; q < 2; ++q) { const int m = m0 + q * NGW; ok[q] = m < MR; const int mm = ok[q] ? m : 0;
                if (mm >= RP) src[q] = args.in[1] + (size_t)(mm - RP) * DM;
                else { const int b = mm / TP, t = mm - b * TP; src[q] = t < NMETA ? args.in[5] + (size_t)t * DM : args.in[0] + ((size_t)b * SEQ + (t - NMETA)) * DM; }
#pragma unroll
                for (int j = 0; j < 4; ++j) v[q][j] = ((const GAS f32x4*)src[q])[lane + 64 * j]; }
#pragma unroll
            for (int q = 0; q < 2; ++q) { const int m = m0 + q * NGW; if (m >= MP) continue;
                float ss = 0.f;
#pragma unroll
                for (int j = 0; j < 4; ++j) ss += (v[q][j].x * v[q][j].x + v[q][j].y * v[q][j].y) + (v[q][j].z * v[q][j].z + v[q][j].w * v[q][j].w);
                const float rstd = ok[q] ? rsqf(wave_sum(ss) * (1.f / DM) + EPS) : 0.f;
                GAS v2u* o8 = (GAS v2u*)(H + (size_t)m * DM) + lane;
#pragma unroll
                for (int j = 0; j < 4; ++j) { const f32x4 g = ((const GAS f32x4*)args.in[6])[lane + 64 * j]; v2u o; o.x = cvtpk(v[q][j].x * rstd * g.x, v[q][j].y * rstd * g.y); o.y = cvtpk(v[q][j].z * rstd * g.z, v[q][j].w * rstd * g.w); o8[64 * j] = o; } }
        }
    }
    SEAM(0);
    if (IN(1)) {
        pg8::Gemm g{H, WIN, MP, NIN, DM}; pg8::StaticOrder S; S.init(MP, NIN, G, bx, DM);
        EpiIn E{GLU, QKVB, QS, HALOQ, HALOC, ZS, SGC, SGD, BETAG, args.in[14], args.in[15]};
        pg8::gemm_phase<EpiIn, pg8::StaticOrder, true, true>(lds + RING_OFF, g, S, E);
        constexpr int NU = (MP / 256) * (NIN / 256), NFREE = 256 - NU % 256;
        if (G == 256 && bx >= NU % 256) {
            constexpr int KB1 = DM / 32, KB4 = DFF / 32;
            constexpr int I_SQ = KB1 * (DM / 64), I_UP = KB1 * (DFF / 64), I_DN = KB4 * (DM / 64), NITEMS = 3 * I_SQ + I_UP + I_DN;
            for (int it = (bx - NU % 256) * NWAVES + wave; it < NITEMS; it += NFREE * NWAVES) {
                int r = it;
                if (r < I_SQ) { p0_transpose_item(args.in[12], DM, DM, WC, (r / KB1) * 64, (r / KB1) * 64, 64, (r % KB1) * 32, lane); continue; } r -= I_SQ;
                if (r < I_SQ) { p0_transpose_item(args.in[17], DM, DM, WD, (r / KB1) * 64, (r / KB1) * 64, 64, (r % KB1) * 32, lane); continue; } r -= I_SQ;
                if (r < I_SQ) { p0_transpose_item(args.in[18], DM, DM, WO, (r / KB1) * 64, (r / KB1) * 64, 64, (r % KB1) * 32, lane); continue; } r -= I_SQ;
                if (r < I_UP) { p0_transpose_item(args.in[20], DFF, DM, WUP, (r / KB1) * 64, (r / KB1) * 64, 64, (r % KB1) * 32, lane); continue; } r -= I_UP;
                p0_transpose_item(args.in[21], DM, DFF, WDN, (r / KB4) * 64, (r / KB4) * 64, 64, (r % KB4) * 32, lane);
            }
        } else if (G != 256) {
            constexpr int KB1 = DM / 32, KB4 = DFF / 32;
            constexpr int I_SQ = KB1 * (DM / 64), I_UP = KB1 * (DFF / 64), I_DN = KB4 * (DM / 64), NITEMS = 3 * I_SQ + I_UP + I_DN;
            for (int it = gw; it < NITEMS; it += NGW) {
                int r = it;
                if (r < I_SQ) { p0_transpose_item(args.in[12], DM, DM, WC, (r / KB1) * 64, (r / KB1) * 64, 64, (r % KB1) * 32, lane); continue; } r -= I_SQ;
                if (r < I_SQ) { p0_transpose_item(args.in[17], DM, DM, WD, (r / KB1) * 64, (r / KB1) * 64, 64, (r % KB1) * 32, lane); continue; } r -= I_SQ;
                if (r < I_SQ) { p0_transpose_item(args.in[18], DM, DM, WO, (r / KB1) * 64, (r / KB1) * 64, 64, (r % KB1) * 32, lane); continue; } r -= I_SQ;
                if (r < I_UP) { p0_transpose_item(args.in[20], DFF, DM, WUP, (r / KB1) * 64, (r / KB1) * 64, 64, (r % KB1) * 32, lane); continue; } r -= I_UP;
                p0_transpose_item(args.in[21], DM, DFF, WDN, (r / KB4) * 64, (r / KB4) * 64, 64, (r % KB4) * 32, lane);
            }
        }
    }
    SEAM(1);
    if (IN(2)) {
        constexpr int N_CP = BP * NRUN, N_IP = BP * NCH * NH / 2, N_SD = BS * NH / 4, N_CS = BS, N_ITEMS = N_CP + N_IP + N_SD + N_CS;
        volatile LAS int* qslot = (volatile LAS int*)(lds + MISC_OFF + 64);
#if PROBE_K >= 0
        for (int sub = 0; sub < 3; ++sub) {
            const int lo_i = sub == 0 ? 0 : (sub == 1 ? N_CP : N_CP + N_IP), hi_i = sub == 0 ? N_CP : (sub == 1 ? N_CP + N_IP : N_CP + N_IP + N_SD);
            for (;;) {
                if (tid == 0) *qslot = (int)__hip_atomic_fetch_add((unsigned*)(ctl + 2048 + 64 * sub), 1u, __ATOMIC_RELAXED, __HIP_MEMORY_SCOPE_AGENT);
                __syncthreads();
                int it = *qslot + lo_i;
                __syncthreads();
                if (sub == 0 && it >= N_CP) { it += N_IP + N_SD; if (it >= N_ITEMS) break; conv_unit<1>(args, lds, it - (N_CP + N_IP + N_SD), 0); continue; }
                if (it >= hi_i) break;
                if (it < N_CP) { conv_unit<0>(args, lds, it / NRUN, it % NRUN); continue; } it -= N_CP;
                if (it < N_IP) { intra_pair(args, lds, it); continue; } it -= N_IP;
                (void)it;
            }
            if (sub < 2) { xcd_barrier(bar); if (tid == 0) stamps[12 + sub] = __builtin_amdgcn_s_memrealtime(); }
        }
#else
        for (;;) {
            if (tid == 0) *qslot = (int)__hip_atomic_fetch_add((unsigned*)(ctl + 2048), 1u, __ATOMIC_RELAXED, __HIP_MEMORY_SCOPE_AGENT);
            __syncthreads();
            int it = *qslot;
            __syncthreads();
            if (it >= N_CP + N_IP) it += N_SD;
            if (it >= N_ITEMS) break;
            if (it < N_CP) { conv_unit<0>(args, lds, it / NRUN, it % NRUN); continue; } it -= N_CP;
            if (it < N_IP) { intra_pair(args, lds, it); continue; } it -= N_IP;
            it -= N_SD; if (it < 0) continue;
            conv_unit<1>(args, lds, it, 0);
        }
#endif
    }
    SEAM(2);
    if (IN(3)) {
        if (bx < BP * NH) { scan_chain(args, lds, bx);
#if PROBE_K >= 0
            if (tid == 0) stamps[14] = __builtin_amdgcn_s_memrealtime();
#endif
        }
#if defined(PROBE_SCAN_ALONE)
        xcd_barrier(bar);
        if (bx < BP * NH) {}
#endif
        else {
            pg8::Gemm g{C, WC, MP, DM, DM}; pg8::StaticOrder S; S.init(MP, DM, G - BP * NH, bx - BP * NH, DM);
            EpiGate<0> E{SGC, nullptr, SGC};
            pg8::gemm_phase<EpiGate<0>, pg8::StaticOrder, true, true>(lds + RING_OFF, g, S, E);
            volatile LAS int* qslot = (volatile LAS int*)(lds + MISC_OFF + 64);
            for (;;) {
                if (tid == 0) *qslot = (int)__hip_atomic_fetch_add((unsigned*)(ctl + 2048 + 256), 1u, __ATOMIC_RELAXED, __HIP_MEMORY_SCOPE_AGENT);
                __syncthreads();
                const int it = *qslot;
                __syncthreads();
                if (it >= BS * NH / 4) break;
                delta_item(args, lds, it);
            }
        }
    }
    SEAM(3);
    if (IN(4)) {
        pg8::Gemm g{ZS, WD, MP, DM, DM}; pg8::StaticOrder S; S.init(MP, DM, G, bx, DM);
        EpiGate<1> E{SGD, SGC, MIX};
        pg8::gemm_phase<EpiGate<1>, pg8::StaticOrder, true, true>(lds + RING_OFF, g, S, E);
    }
    SEAM(4);
    if (IN(5)) {
        pg8::Gemm g{MIX, WO, M2, DM, DM}; pg8::SplitOrder S; S.init(BP * SEQ, M2, DM, G, bx, DM, KSPLIT5);
        EpiWoP E; E.xp = args.in[0]; E.X1B = X1B; E.parts = (float*)(ws + WS_PART5);
        pg8::gemm_phase<EpiWoP, pg8::SplitOrder, true, true>(lds + RING_OFF, g, S, E);
    }
    SEAM(5);
    if (IN(6)) {
        for (int m = gw; m < M2; m += NGW) {
            const GAS f32x4* gr = (const GAS f32x4*)args.in[19] + lane;
            f32x4 v[4]; float ss = 0.f;
            if (m >= BP * SEQ) {
                const GAS f32x4* x0 = (const GAS f32x4*)(args.in[1] + (size_t)(m - BP * SEQ) * DM) + lane;
                const GAS f32x4* pr = (const GAS f32x4*)((const float*)(ws + WS_PART5) + (size_t)(m - BP * SEQ) * DM) + lane;
                GAS v2u* xb = (GAS v2u*)(X1B + (size_t)m * DM) + lane;
#pragma unroll
                for (int jj = 0; jj < 4; ++jj) { v[jj] = x0[64 * jj];
#pragma unroll
                    for (int ks = 0; ks < KSPLIT5; ++ks) v[jj] += pr[(size_t)ks * RS * DM / 4 + 64 * jj];
                    v2u o; o.x = cvtpk(v[jj].x, v[jj].y); o.y = cvtpk(v[jj].z, v[jj].w); xb[64 * jj] = o;
                    v[jj] = (f32x4){bflo(o.x), bfhi(o.x), bflo(o.y), bfhi(o.y)}; }
            } else { const GAS v2u* xb = (const GAS v2u*)(X1B + (size_t)m * DM) + lane;
#pragma unroll
                for (int jj = 0; jj < 4; ++jj) { const v2u o = xb[64 * jj]; v[jj] = (f32x4){bflo(o.x), bfhi(o.x), bflo(o.y), bfhi(o.y)}; } }
#pragma unroll
            for (int jj = 0; jj < 4; ++jj) ss += (v[jj].x * v[jj].x + v[jj].y * v[jj].y) + (v[jj].z * v[jj].z + v[jj].w * v[jj].w);
            const float rstd = rsqf(wave_sum(ss) * (1.f / DM) + EPS);
            GAS v2u* o8 = (GAS v2u*)(XG + (size_t)m * DM) + lane;
#pragma unroll
            for (int jj = 0; jj < 4; ++jj) { const f32x4 g = gr[64 * jj]; v2u o; o.x = cvtpk(v[jj].x * rstd * g.x, v[jj].y * rstd * g.y); o.y = cvtpk(v[jj].z * rstd * g.z, v[jj].w * rstd * g.w); o8[64 * jj] = o; }
        }
    }
    SEAM(6);
    if (IN(7)) {
        pg8::Gemm g{XG, WUP, M2, DFF, DM}; pg8::StaticOrder S; S.init(M2, DFF, G, bx, DM);
        EpiUp E{HM};
        pg8::gemm_phase<EpiUp, pg8::StaticOrder, true, true>(lds + RING_OFF, g, S, E);
    }
    SEAM(7);
    if (IN(8)) {
        pg8::Gemm g{HM, WDN, M2, DM, DFF}; pg8::SplitOrder S; S.init(BP * SEQ, M2, DM, G, bx, DFF, KSPLIT);
        EpiRes<1> E{nullptr, nullptr, args.out, (float*)(ws + WS_PART), X1B};
        pg8::gemm_phase<EpiRes<1>, pg8::SplitOrder, true, true>(lds + RING_OFF, g, S, E);
    }
    SEAM(8);
    if (IN(9)) {
        for (int m = gw; m < M2; m += NGW) {
            float* xrow = args.out + (size_t)m * DM;
            GAS f32x4* xr = (GAS f32x4*)xrow + lane; const GAS f32x4* gr = (const GAS f32x4*)args.in[22] + lane;
            f32x4 v[4]; float s = 0.f;
#pragma unroll
            for (int jj = 0; jj < 4; ++jj) v[jj] = xr[64 * jj];
            if (m >= BP * SEQ) { const GAS v2u* xb = (const GAS v2u*)(X1B + (size_t)m * DM) + lane;
#pragma unroll
                for (int jj = 0; jj < 4; ++jj) { const v2u o = xb[64 * jj]; v[jj] = (f32x4){bflo(o.x), bfhi(o.x), bflo(o.y), bfhi(o.y)}; } }
            if (m >= BP * SEQ) { const GAS f32x4* pr = (const GAS f32x4*)((const float*)(ws + WS_PART) + (size_t)(m - BP * SEQ) * DM) + lane;
#pragma unroll 4
                for (int ks = 0; ks < KSPLIT; ++ks)
#pragma unroll
                    for (int jj = 0; jj < 4; ++jj) v[jj] += pr[(size_t)ks * RS * DM / 4 + 64 * jj]; }
#pragma unroll
            for (int jj = 0; jj < 4; ++jj) s += (v[jj].x * v[jj].x + v[jj].y * v[jj].y) + (v[jj].z * v[jj].z + v[jj].w * v[jj].w);
            const float rstd = 1.f / sqrtf(wave_sum(s) * (1.f / DM) + EPS);
#pragma unroll
            for (int jj = 0; jj < 4; ++jj) xr[64 * jj] = v[jj] * rstd * gr[64 * jj];
        }
    }
#if PROBE_K >= 0
    __syncthreads();
    if (bx == 0) { if (tid == 0) stamps[NPHASES] = __builtin_amdgcn_s_memrealtime(); __syncthreads();
        const float dt_us = (float)(stamps[PROBE_B] - stamps[PROBE_K]) * 0.01f; const float f = 1.f + dt_us * (1.f / (float)(PROBE_DIV));
        for (int i = tid; i < BP * 3 * DQKV; i += NWAVES * 64) args.out[O_PQ + i] *= f; }
#endif
#undef IN
#undef SEAM
}

extern "C" void kernel_launch(void* const* d_in, const int* in_sizes, int n_in, void* d_out, int out_size, void* d_ws, size_t ws_size, hipStream_t stream) {
    static int grid = 0;
    if (grid == 0) {
        if (n_in != 23 || (size_t)out_size != O_END || ws_size < WS_END) { fprintf(stderr, "kernel_launch: unexpected shapes n_in %d out %d ws %zu\n", n_in, out_size, ws_size); grid = -1; return; }
        int dev = 0, cus = 0, per_cu = 0;
        if (hipGetDevice(&dev) != hipSuccess || hipDeviceGetAttribute(&cus, hipDeviceAttributeMultiprocessorCount, dev) != hipSuccess) { grid = -1; return; }
        if (hipFuncSetAttribute((const void*)fwd_kernel, hipFuncAttributeMaxDynamicSharedMemorySize, LDS_BYTES) != hipSuccess) { fprintf(stderr, "kernel_launch: hipFuncSetAttribute failed\n"); grid = -1; return; }
        if (hipOccupancyMaxActiveBlocksPerMultiprocessor(&per_cu, (const void*)fwd_kernel, NWAVES * 64, LDS_BYTES) != hipSuccess || per_cu < 1)
            fprintf(stderr, "kernel_launch: occupancy query reports %d\n", per_cu);
        (void)hipGetLastError();
        grid = cus;
    }
    if (grid < 0) return;
    if (hipMemsetAsync((char*)d_ws + WS_CTL, 0, CTL_ZERO_BYTES, stream) != hipSuccess) return;
    Args a{};
    for (int i = 0; i < 23; ++i) a.in[i] = (const float*)d_in[i];
    a.out = (float*)d_out; a.ws = (unsigned char*)d_ws;
#if MK_N_LAUNCHES == 1
    a.ph_lo = 0; a.ph_hi = NPHASES;
    hipLaunchKernelGGL(fwd_kernel, dim3(grid), dim3(NWAVES * 64), LDS_BYTES, stream, a);
#else
    for (int p = 0; p < NPHASES; ++p) { a.ph_lo = p; a.ph_hi = p + 1; hipLaunchKernelGGL(fwd_kernel, dim3(grid), dim3(NWAVES * 64), LDS_BYTES, stream, a); }
#endif
}
```

```cpp
#include <hip/hip_runtime.h>
#include <cstdio>
#include <cstdint>

#ifndef MK_N_LAUNCHES
#define MK_N_LAUNCHES 1
#endif

namespace pg8 {
#define PG8_LAS __attribute__((address_space(3)))
typedef unsigned short bf16_t;
typedef short bf16x8 __attribute__((ext_vector_type(8)));
typedef float f32x4 __attribute__((ext_vector_type(4)));
typedef unsigned u32x4 __attribute__((ext_vector_type(4)));
constexpr int BM = 256, BK = 64, HALF = 128, HTB = HALF * BK * 2, STAGE_BYTES = 8 * HTB, NXCD = 8, WGM = 8;

__host__ __device__ __forceinline__ int lds_byte(int r, int c) { const int st = (r >> 4) * 2 + (c >> 5), rr = r & 15, cc = c & 31, ob = rr * 64 + cc * 2; return st * 1024 + (ob ^ (((ob >> 9) & 1) << 5)); }
__host__ __device__ __forceinline__ void stage_rc(int b, int& R, int& C) { const int st = b / 1024, sb = b % 1024, swz = sb ^ (((sb >> 9) & 1) << 5); R = (st >> 1) * 16 + swz / 64; C = (st & 1) * 32 + (swz % 64) / 2; }
__host__ __device__ __forceinline__ int perm32(int rho) { const int n = rho >> 4, i = rho & 15; return 8 * (i >> 2) + 4 * n + (i & 3); }

struct Unit { int pm, pn, k0, nt, typ; };
struct Gemm { const bf16_t* A; const bf16_t* Bt; int M, N, K;
    __device__ __forceinline__ const char* a(const Unit&) const { return (const char*)A; } __device__ __forceinline__ const char* b(const Unit&) const { return (const char*)Bt; } };
struct Gemm2 { const bf16_t *A0, *B0, *A1, *B1; int K;
    __device__ __forceinline__ const char* a(const Unit& u) const { return (const char*)(u.typ ? A1 : A0); } __device__ __forceinline__ const char* b(const Unit& u) const { return (const char*)(u.typ ? B1 : B0); } };

struct StaticOrder {
    int nM, nN, nwg, G, c, nt;
    __host__ __device__ void init(int M, int N, int G_, int c_, int K) { nM = M / BM; nN = N / BM; nwg = nM * nN; G = G_; c = c_; nt = K / BK; }
    __host__ __device__ __forceinline__ bool next(int i, Unit& u) const {
        const long L = (long)i * G + c; if (L >= nwg) return false;
        u.k0 = 0; u.nt = nt; u.typ = 0;
        int wgid = (int)L; { const int q = nwg / NXCD, r = nwg % NXCD, xcd = wgid % NXCD, off = wgid / NXCD; wgid = (xcd < r ? xcd * (q + 1) : r * (q + 1) + (xcd - r) * q) + off; }
        const int nig = WGM * nN, gid = wgid / nig, fm = gid * WGM, gsz = (nM - fm) < WGM ? (nM - fm) : WGM;
        u.pm = fm + ((wgid % nig) % gsz); u.pn = (wgid % nig) / gsz; return true;
    }
    __device__ __forceinline__ void a_ready(const Unit&) const {}
    __device__ __forceinline__ void done(const Unit&) const {}
};

struct SplitOrder {
    int nM, nN, nwg, G, c, ntfull, nsub, KS, ntsub;
    __host__ __device__ void init(int Mmain, int Mall, int N, int G_, int c_, int K, int KS_) { nM = Mmain / BM; nN = N / BM; nwg = nM * nN; G = G_; c = c_; ntfull = K / BK; KS = KS_; ntsub = K / BK / KS_; nsub = (Mall / BM - nM) * nN * KS_; }
    __host__ __device__ __forceinline__ bool next(int i, Unit& u) const {
        const long L = (long)i * G + c; if (L >= nwg + nsub) return false;
        int pm, pn, k0, ntu;
        if (L < nwg) {
            int wgid = (int)L; { const int q = nwg / NXCD, r = nwg % NXCD, xcd = wgid % NXCD, off = wgid / NXCD; wgid = (xcd < r ? xcd * (q + 1) : r * (q + 1) + (xcd - r) * q) + off; }
            const int nig = WGM * nN, gid = wgid / nig, fm = gid * WGM, gsz = (nM - fm) < WGM ? (nM - fm) : WGM;
            pm = fm + ((wgid % nig) % gsz); pn = (wgid % nig) / gsz; k0 = 0; ntu = ntfull;
        } else { const int j = (int)L - nwg, tile = j / KS, ks = j % KS; pm = nM + tile / nN; pn = tile % nN; k0 = ks * ntsub; ntu = ntsub; }
        u.pm = pm; u.pn = pn; u.k0 = k0; u.nt = ntu; u.typ = 0; return true;
    }
    __device__ __forceinline__ void a_ready(const Unit&) const {}
    __device__ __forceinline__ void done(const Unit&) const {}
};

__device__ __forceinline__ unsigned cvt_pk_bf16(float lo, float hi) { unsigned r; asm volatile("v_cvt_pk_bf16_f32 %0, %1, %2" : "=v"(r) : "v"(lo), "v"(hi)); return r; }

template <class Epi, class Sched, bool ALIGN_EPI = false, bool SP2 = false, class GemmT = Gemm>
__device__ __forceinline__ void gemm_phase(PG8_LAS unsigned char* lds, const GemmT g, const Sched& S, const Epi& E) {
    const int tid = threadIdx.x, wid = __builtin_amdgcn_readfirstlane(tid >> 6), lane = tid & 63, wr = wid >> 2, wc = wid & 3, fr = lane & 15, fq = lane >> 4;
    const int K = g.K;
    unsigned voffA[2], voffB[2];
#pragma unroll
    for (int i = 0; i < 2; ++i) { int R, C; stage_rc(tid * 16 + i * 8192, R, C); const int Rb = Epi::PERM ? ((R & ~31) + perm32(R & 31)) : R;
        voffA[i] = (unsigned)(R * K + C) * 2u; voffB[i] = (unsigned)(Rb * K + C) * 2u; }
    const size_t kstep = (size_t)(BK * 2);
    const size_t hstep = (size_t)HALF * K * 2;
    const size_t tstep = 2 * hstep;
    const unsigned ldsw = (unsigned)wid * 1024u;
    const int aoff = lds_byte(wr * 64 + fr, fq * 8), boff = lds_byte(wc * 32 + fr, fq * 8);
#define PG8_SA(b, h) (((b) * 2 + (h)) * HTB)
#define PG8_SB(b, h) ((4 + (b) * 2 + (h)) * HTB)
#define PG8_STAGE(bufoff, gbase, voff) do { _Pragma("unroll") for (int _i = 0; _i < 2; ++_i) \
        __builtin_amdgcn_global_load_lds((const unsigned*)((const char*)(gbase) + (voff)[_i]), (PG8_LAS unsigned*)(lds + (bufoff) + ldsw + _i * 8192), 16, 0, 0); } while (0)
#define PG8_LDA(dst, b, h) do { _Pragma("unroll") for (int m = 0; m < 4; ++m) _Pragma("unroll") for (int k = 0; k < 2; ++k) dst[m][k] = *(const PG8_LAS bf16x8*)(lds + PG8_SA(b, h) + aoff + m * 2048 + k * 1024); } while (0)
#define PG8_LDB(dst, b, h) do { _Pragma("unroll") for (int n = 0; n < 2; ++n) _Pragma("unroll") for (int k = 0; k < 2; ++k) dst[n][k] = *(const PG8_LAS bf16x8*)(lds + PG8_SB(b, h) + boff + n * 2048 + k * 1024); } while (0)
#define PG8_MMA(ai, bj, At, Bt) do { __builtin_amdgcn_s_setprio(1); _Pragma("unroll") for (int m = 0; m < 4; ++m) _Pragma("unroll") for (int n = 0; n < 2; ++n) _Pragma("unroll") for (int k = 0; k < 2; ++k) \
        acc[ai][bj][m][n] = __builtin_amdgcn_mfma_f32_16x16x32_bf16(Bt[n][k], At[m][k], acc[ai][bj][m][n], 0, 0, 0); __builtin_amdgcn_s_setprio(0); } while (0)
#define PG8_WAIT_V(n) asm volatile("s_waitcnt vmcnt(" #n ")" ::: "memory")
#define PG8_WAIT_L(n) asm volatile("s_waitcnt lgkmcnt(" #n ")" ::: "memory")
#define PG8_BAR __builtin_amdgcn_s_barrier()
#define PG8_SCHED __builtin_amdgcn_sched_barrier(0)
    Unit cur, nxt; int ui = 0;
    if (!S.next(0, cur)) return;
    f32x4 acc[2][2][4][2];
#pragma unroll
    for (int a = 0; a < 2; ++a)
#pragma unroll
        for (int b = 0; b < 2; ++b)
#pragma unroll
            for (int m = 0; m < 4; ++m)
#pragma unroll
                for (int n = 0; n < 2; ++n) acc[a][b][m][n] = (f32x4){0.f, 0.f, 0.f, 0.f};
    bf16x8 At[4][2], B0[2][2], B1[2][2];
    const char* cA = g.a(cur) + (size_t)cur.pm * tstep + (size_t)cur.k0 * kstep; const char* cB = g.b(cur) + (size_t)cur.pn * tstep + (size_t)cur.k0 * kstep;
    S.a_ready(cur);
    if constexpr (SP2) {
        PG8_STAGE(PG8_SB(0, 0), cB, voffB); PG8_STAGE(PG8_SB(0, 1), cB + hstep, voffB); PG8_STAGE(PG8_SA(0, 0), cA, voffA); PG8_STAGE(PG8_SA(0, 1), cA + hstep, voffA);
        if (wr == 1) PG8_BAR;
        PG8_WAIT_V(2); PG8_BAR;
        PG8_STAGE(PG8_SB(1, 0), cB + kstep, voffB); PG8_STAGE(PG8_SA(1, 0), cA + kstep, voffA); PG8_STAGE(PG8_SB(1, 1), cB + hstep + kstep, voffB);
        PG8_WAIT_V(6); PG8_BAR;
    } else {
        PG8_STAGE(PG8_SB(0, 0), cB, voffB); PG8_STAGE(PG8_SA(0, 0), cA, voffA); PG8_STAGE(PG8_SB(0, 1), cB + hstep, voffB); PG8_STAGE(PG8_SA(0, 1), cA + hstep, voffA);
        if (wr == 1) PG8_BAR;
        PG8_WAIT_V(4); PG8_BAR;
        PG8_STAGE(PG8_SB(1, 0), cB + kstep, voffB); PG8_STAGE(PG8_SA(1, 0), cA + kstep, voffA); PG8_STAGE(PG8_SB(1, 1), cB + hstep + kstep, voffB);
        PG8_WAIT_V(6); PG8_BAR;
    }
    for (;;) {
        const bool has_next = S.next(ui + 1, nxt);
        const char* nA = has_next ? g.a(nxt) + (size_t)nxt.pm * tstep + (size_t)nxt.k0 * kstep : cA; const char* nB = has_next ? g.b(nxt) + (size_t)nxt.pn * tstep + (size_t)nxt.k0 * kstep : cB;
        const int nt = cur.nt;
        for (int t = 0; t < nt; t += 2) {
            const bool last = (t == nt - 2);
            const char* a1 = cA + (size_t)(t + 1) * kstep;
            const char* a2 = last ? nA : cA + (size_t)(t + 2) * kstep; const char* b2 = last ? nB : cB + (size_t)(t + 2) * kstep;
            const char* a3 = a2 + kstep; const char* b3 = b2 + kstep;
            if (last && has_next) S.a_ready(nxt);
            if constexpr (SP2) {
            PG8_LDB(B0, 0, 0); PG8_LDB(B1, 0, 1); PG8_SCHED; PG8_LDA(At, 0, 0); PG8_STAGE(PG8_SA(1, 1), a1 + hstep, voffA);
            PG8_WAIT_V(8); PG8_WAIT_L(0); PG8_BAR; PG8_MMA(0, 0, At, B0); PG8_MMA(0, 1, At, B1); PG8_BAR; PG8_SCHED;
            PG8_LDA(At, 0, 1); PG8_STAGE(PG8_SB(0, 0), b2, voffB); PG8_STAGE(PG8_SB(0, 1), b2 + hstep, voffB); PG8_STAGE(PG8_SA(0, 0), a2, voffA);
            PG8_WAIT_V(8); PG8_WAIT_L(0); PG8_BAR; PG8_MMA(1, 0, At, B0); PG8_MMA(1, 1, At, B1); PG8_BAR; PG8_SCHED;
            PG8_LDB(B0, 1, 0); PG8_LDB(B1, 1, 1); PG8_SCHED; PG8_LDA(At, 1, 0); PG8_STAGE(PG8_SA(0, 1), a2 + hstep, voffA);
            PG8_WAIT_V(8); PG8_WAIT_L(0); PG8_BAR; PG8_MMA(0, 0, At, B0); PG8_MMA(0, 1, At, B1); PG8_BAR; PG8_SCHED;
            PG8_LDA(At, 1, 1); PG8_STAGE(PG8_SB(1, 0), b3, voffB); PG8_STAGE(PG8_SB(1, 1), b3 + hstep, voffB); PG8_STAGE(PG8_SA(1, 0), a3, voffA);
            PG8_WAIT_V(8); PG8_WAIT_L(0); PG8_BAR; PG8_MMA(1, 0, At, B0); PG8_MMA(1, 1, At, B1); PG8_BAR; PG8_SCHED;
            } else {
            PG8_LDB(B0, 0, 0); PG8_SCHED; PG8_LDA(At, 0, 0); PG8_STAGE(PG8_SA(1, 1), a1 + hstep, voffA);
            PG8_WAIT_L(8); PG8_BAR; PG8_WAIT_L(0); PG8_MMA(0, 0, At, B0); PG8_BAR; PG8_SCHED;
            PG8_LDB(B1, 0, 1); PG8_STAGE(PG8_SB(0, 0), b2, voffB);
            PG8_BAR; PG8_WAIT_L(0); PG8_MMA(0, 1, At, B1); PG8_BAR;
            PG8_LDA(At, 0, 1); PG8_STAGE(PG8_SA(0, 0), a2, voffA);
            PG8_BAR; PG8_WAIT_L(0); PG8_MMA(1, 0, At, B0); PG8_BAR; PG8_SCHED;
            PG8_STAGE(PG8_SB(0, 1), b2 + hstep, voffB);
            PG8_WAIT_V(6); PG8_BAR; PG8_MMA(1, 1, At, B1); PG8_BAR;
            PG8_LDB(B0, 1, 0); PG8_SCHED; PG8_LDA(At, 1, 0); PG8_STAGE(PG8_SA(0, 1), a2 + hstep, voffA);
            PG8_WAIT_L(8); PG8_BAR; PG8_WAIT_L(0); PG8_MMA(0, 0, At, B0); PG8_BAR; PG8_SCHED;
            PG8_LDB(B1, 1, 1); PG8_STAGE(PG8_SB(1, 0), b3, voffB);
            PG8_BAR; PG8_WAIT_L(0); PG8_MMA(0, 1, At, B1); PG8_BAR;
            PG8_LDA(At, 1, 1); PG8_STAGE(PG8_SA(1, 0), a3, voffA);
            PG8_BAR; PG8_WAIT_L(0); PG8_MMA(1, 0, At, B0); PG8_BAR; PG8_SCHED;
            PG8_STAGE(PG8_SB(1, 1), b3 + hstep, voffB);
            PG8_WAIT_V(6); PG8_BAR; PG8_MMA(1, 1, At, B1); PG8_BAR;
            }
        }
        if constexpr (ALIGN_EPI) { if (wr == 0) PG8_BAR; }
        E(acc, cur, wr, wc, fr, fq); S.done(cur);
        if (!has_next) break;
#pragma unroll
        for (int a = 0; a < 2; ++a)
#pragma unroll
            for (int b = 0; b < 2; ++b)
#pragma unroll
                for (int m = 0; m < 4; ++m)
#pragma unroll
                    for (int n = 0; n < 2; ++n) acc[a][b][m][n] = (f32x4){0.f, 0.f, 0.f, 0.f};
        cur = nxt; cA = nA; cB = nB; ++ui;
        if constexpr (ALIGN_EPI) { if (wr == 1) PG8_BAR; }
    }
    PG8_WAIT_V(0);
    if constexpr (!ALIGN_EPI) { if (wr == 0) PG8_BAR; }
    PG8_BAR;
#undef PG8_SA
#undef PG8_SB
#undef PG8_STAGE
#undef PG8_LDA
#undef PG8_LDB
#undef PG8_MMA
#undef PG8_WAIT_V
#undef PG8_WAIT_L
#undef PG8_BAR
#undef PG8_SCHED
}
}

constexpr int NWAVES = 8;
constexpr int DM = 1024, BP = 8, SEQ = 2048, NMETA = 16, TP = SEQ + NMETA, BS = 128, TS = 4;
constexpr int RP = BP * TP;
constexpr int RS = BS * TS;
constexpr int MR = RP + RS;
constexpr int MP = 17152;
constexpr int M2 = BP * SEQ + RS;
constexpr int NH = 8, DH = 128, DQKV = 3072, DFF = 4096, KC = 31, KS = 4;
constexpr int NIN = 8448;
constexpr int DIN = 8208;
constexpr float EPS = 1e-6f;

constexpr size_t O_YP = 0, O_YS = 16777216, O_PC = 17301504, O_PQ = 17547264, O_PD = 17620992, O_SC = 18669568, O_SQ = 22601728, O_SD = 23781376, O_END = 40558592;

constexpr size_t MiB = 1u << 20;
constexpr size_t WS_CTL = 0, CTL_ZERO_BYTES = 1 * MiB;
constexpr size_t WS_BETAG = 1 * MiB;
constexpr size_t WS_LASTV = 9 * MiB / 4;
constexpr size_t WS_HALOQ = 5 * MiB / 2;
constexpr size_t WS_WC = 29 * MiB / 4, WS_WD = WS_WC + 2 * MiB, WS_WO = WS_WD + 2 * MiB, WS_WUP = WS_WO + 2 * MiB, WS_WDN = WS_WUP + 8 * MiB;
constexpr size_t WS_GLU = 117 * MiB / 4;
constexpr size_t WS_QKVB = 63 * MiB;
constexpr size_t WS_QS = 162 * MiB;
constexpr size_t WS_ZS = 165 * MiB;
constexpr size_t WS_H = 397 * MiB / 2;
constexpr size_t WS_WIN = 232 * MiB;
constexpr size_t WS_HALOC = 497 * MiB / 2;
constexpr size_t WS_KDT = WS_H, WS_ATTN = 463 * MiB / 2;
constexpr size_t WS_MIX = WS_QKVB, WS_XG = WS_GLU, WS_HM = WS_QKVB, WS_C = WS_GLU;
constexpr int KSPLIT5 = 4; constexpr size_t WS_PART5 = 232 * MiB;
constexpr size_t WS_X1B = WS_H;
constexpr int CW_READY = 8192;
constexpr int KSPLIT = 16;
constexpr size_t WS_PART = WS_XG;
static_assert(WS_PART + (size_t)KSPLIT * RS * DM * 4 <= WS_QKVB, "ws map part");
constexpr size_t WS_END = 256 * MiB;
constexpr int NRUN = 16, RUNL = TP / NRUN;
static_assert(TP - 64 * 32 == 16 && NRUN * RUNL == TP && WS_HALOC + (size_t)BP * NRUN * 30 * DM * 2 <= WS_END, "conv runs");
constexpr int NCH = 33, QBLK = 3 * 64 * 128;
static_assert(WS_WIN + (size_t)NIN * DM * 2 <= WS_HALOC && WS_WDN + 8 * MiB <= WS_GLU && WS_GLU + (size_t)MP * DM * 2 <= WS_QKVB && WS_HALOQ + (size_t)BP * 33 * 3 * 3072 * 2 <= WS_WC, "ws map");
static_assert(WS_ZS + (size_t)MP * DM * 2 <= WS_H && WS_H + (size_t)MP * DM * 2 <= WS_WIN, "ws map 2");
static_assert(WS_QKVB + (size_t)BP * NCH * NH * QBLK * 2 <= WS_QS, "ws map qkvb");
static_assert(WS_HM + (size_t)M2 * DFF * 2 <= WS_H, "ws map hm");
static_assert(WS_KDT + (size_t)BP * NCH * NH * 8192 * 2 <= WS_ATTN && WS_ATTN + (size_t)BP * NCH * NH * 4096 * 2 <= WS_HALOC, "ws map kdt");
constexpr int CW_TMO = 0, CW_CODE = 1, CW_BAR = 4096;

constexpr int RING_OFF = 0, RING_BYTES = 131072;
constexpr int LDSCTL_OFF = 151552, MISC_OFF = LDSCTL_OFF + 320;
constexpr int LDS_BYTES = LDSCTL_OFF + 1024;

#define GAS __attribute__((address_space(1)))
#define LAS __attribute__((address_space(3)))
typedef unsigned short bf16;
typedef unsigned v4u __attribute__((ext_vector_type(4)));
typedef unsigned v2u __attribute__((ext_vector_type(2)));
typedef float f32x4 __attribute__((ext_vector_type(4)));
typedef float f32x2 __attribute__((ext_vector_type(2)));
typedef GAS unsigned gu32;
#define RLX_AGENT __ATOMIC_RELAXED, __HIP_MEMORY_SCOPE_AGENT
#define LDS_WAIT() asm volatile("s_waitcnt lgkmcnt(0)" ::: "memory")
#define VM_WAIT() asm volatile("s_waitcnt vmcnt(0)" ::: "memory")
__device__ __forceinline__ unsigned f2bf(float f) { unsigned u = __builtin_bit_cast(unsigned, f); return (u + 0x7fffu + ((u >> 16) & 1u)) >> 16; }
__device__ __forceinline__ unsigned pk2(float lo, float hi) { return f2bf(lo) | (f2bf(hi) << 16); }
__device__ __forceinline__ float bflo(unsigned w) { return __builtin_bit_cast(float, w << 16); }
__device__ __forceinline__ float bfhi(unsigned w) { return __builtin_bit_cast(float, w & 0xffff0000u); }
__device__ __forceinline__ float bf1(bf16 b) { return __builtin_bit_cast(float, ((unsigned)b) << 16); }
__device__ __forceinline__ float sigmoidf_(float x) { return __builtin_amdgcn_rcpf(1.f + __expf(-x)); }
__device__ __forceinline__ float siluf_(float x) { return x * sigmoidf_(x); }

#define XB_TMO      128
#define XB_XCNT(j)  (256  + 64 * (j))
#define XB_XSUB(j)  (1280 + 64 * (j))
#define XB_XGEN(j)  (2304 + 64 * (j))
#define XB_TOP      3328
#define XB_TOPGEN   3392
#define XCD_BAR_WORDS 3456
#define XB_SPIN_CAP (1u << 18)
__device__ __forceinline__ unsigned xb_ld(unsigned* p)              { return __hip_atomic_load(p, __ATOMIC_RELAXED, __HIP_MEMORY_SCOPE_AGENT); }
__device__ __forceinline__ unsigned xb_add(unsigned* p, unsigned v) { return __hip_atomic_fetch_add(p, v, __ATOMIC_RELAXED, __HIP_MEMORY_SCOPE_AGENT); }
__device__ __forceinline__ unsigned xb_xcc_id() { return (unsigned)__builtin_amdgcn_s_getreg((3 << 11) | 20) & 0xFu; }
#define XB_SPIN(cond, bar) do { unsigned _sp = 0; while (cond) { __builtin_amdgcn_s_sleep(1); \
    if ((++_sp & 255u) == 0u) { if (xb_ld(&(bar)[XB_TMO])) break; if (_sp > XB_SPIN_CAP) { atomicAdd(&(bar)[XB_TMO], 1u); break; } } } } while (0)
struct XcdBarrier { unsigned* bar; unsigned x; volatile LAS unsigned* st; };
__device__ __forceinline__ XcdBarrier xcd_barrier_post(unsigned* bar, volatile LAS unsigned* st) {
    XcdBarrier b; b.bar = bar; b.x = xb_xcc_id(); b.st = st;
    if (threadIdx.x == 0) (void)xb_add(&bar[XB_XCNT(b.x)], 1u);
    return b;
}
__device__ __forceinline__ void xcd_barrier_complete(unsigned* bar, unsigned x, unsigned& nloc, unsigned& nx) {
    const unsigned G = gridDim.x * gridDim.y * gridDim.z;
    unsigned sum, cnt, mine, sp = 0u;
    for (;;) {
        sum = 0u; cnt = 0u; mine = 0u;
#pragma unroll
        for (unsigned j = 0; j < 16; ++j) { const unsigned c = xb_ld(&bar[XB_XCNT(j)]); sum += c; cnt += (c > 0u) ? 1u : 0u; mine = (j == x) ? c : mine; }
        if (sum == G) break;
        __builtin_amdgcn_s_sleep(1);
        if ((++sp & 255u) == 0u) { if (xb_ld(&bar[XB_TMO])) break; if (sp > XB_SPIN_CAP) { atomicAdd(&bar[XB_TMO], 1u); break; } }
    }
    nloc = mine > 0u ? mine : 1u; nx = cnt > 0u ? cnt : 1u;
}
__device__ __forceinline__ void xcd_barrier(const XcdBarrier& b) {
    asm volatile("s_waitcnt vmcnt(0)" ::: "memory");
    __syncthreads();
    if (threadIdx.x == 0) {
        unsigned* bar = b.bar;
        __builtin_amdgcn_s_waitcnt(0);
        unsigned nloc = b.st[0], nx = b.st[1];
        if (nloc == 0u) { xcd_barrier_complete(bar, b.x, nloc, nx); b.st[0] = nloc; b.st[1] = nx; }
        const unsigned old = xb_add(&bar[XB_XSUB(b.x)], 1u);
        const unsigned gen = old / nloc;
        if (old + 1u == (gen + 1u) * nloc) {
            __builtin_amdgcn_fence(__ATOMIC_RELEASE, "agent");
            asm volatile("s_waitcnt vmcnt(0)" ::: "memory");
            const unsigned og = xb_add(&bar[XB_TOP], 1u);
            const unsigned tg = og / nx;
            if (og + 1u == (tg + 1u) * nx) xb_add(&bar[XB_TOPGEN], 1u);
            else XB_SPIN(xb_ld(&bar[XB_TOPGEN]) == tg, bar);
            __builtin_amdgcn_fence(__ATOMIC_ACQUIRE, "agent");
            xb_add(&bar[XB_XGEN(b.x)], 1u);
            asm volatile("s_waitcnt vmcnt(0)" ::: "memory");
        } else {
            XB_SPIN(xb_ld(&bar[XB_XGEN(b.x)]) == gen, bar);
            __builtin_amdgcn_fence(__ATOMIC_ACQUIRE, "agent");
            asm volatile("s_waitcnt vmcnt(0)" ::: "memory");
        }
    }
    __syncthreads();
}

struct Args { const float* in[23]; float* out; unsigned char* ws; int ph_lo, ph_hi; };

#define DPP_ADD(v, ctrl, rmask, bc) v += __builtin_bit_cast(float, __builtin_amdgcn_update_dpp(0, __builtin_bit_cast(int, v), ctrl, rmask, 0xF, bc))
__device__ __forceinline__ float sum16(float v) {
    DPP_ADD(v, 0xB1, 0xF, true); DPP_ADD(v, 0x4E, 0xF, true); DPP_ADD(v, 0x141, 0xF, true); DPP_ADD(v, 0x140, 0xF, true); return v; }
__device__ __forceinline__ float wave_sum(float v) {
    v = sum16(v); DPP_ADD(v, 0x142, 0xA, false); DPP_ADD(v, 0x143, 0xC, false);
    return __builtin_bit_cast(float, __builtin_amdgcn_readlane(__builtin_bit_cast(int, v), 63)); }
__device__ __forceinline__ float rsqf(float x) { return __builtin_amdgcn_rsqf(x); }
__device__ __forceinline__ unsigned cvtpk(float lo, float hi) { unsigned r; asm("v_cvt_pk_bf16_f32 %0, %1, %2" : "=v"(r) : "v"(lo), "v"(hi)); return r; }
__device__ __forceinline__ int compact_row(int r) {
    if (r >= MR) return -1;
    if (r >= RP) return r - RP + BP * SEQ;
    const int b = r / TP, t = r - b * TP;
    return t < NMETA ? -1 : r - NMETA * (b + 1);
}

__device__ __forceinline__ void p0_transpose_item(const float* W, int Nsrc, int K, bf16* WT, int dst_row0, int src_col0, int nvalid, int k0, int lane) {
    const float* src = W + (size_t)k0 * Nsrc + src_col0 + (lane < nvalid ? lane : 0);
    float v[32];
#pragma unroll
    for (int j = 0; j < 32; ++j) v[j] = src[(size_t)j * Nsrc];
    if (lane >= nvalid) {
#pragma unroll
        for (int j = 0; j < 32; ++j) v[j] = 0.f; }
    GAS v4u* dst = (GAS v4u*)(WT + (size_t)(dst_row0 + lane) * K + k0);
#pragma unroll
    for (int q = 0; q < 4; ++q) { v4u o; o.x = cvtpk(v[8 * q], v[8 * q + 1]); o.y = cvtpk(v[8 * q + 2], v[8 * q + 3]); o.z = cvtpk(v[8 * q + 4], v[8 * q + 5]); o.w = cvtpk(v[8 * q + 6], v[8 * q + 7]); dst[q] = o; }
}
__device__ __forceinline__ void win_src(int nb, int& src, int& nvalid) {
    const int pn = nb >> 2, o = (nb & 3) * 64; nvalid = 64;
    if (pn < 8) src = (o < 128) ? 128 * pn + o : 1024 + 128 * pn + (o - 128);
    else if (pn < 20) src = 2048 + 256 * (pn - 8) + o;
    else if (pn < 24) src = 5120 + 256 * (pn - 20) + o;
    else if (pn < 28) src = 6160 + 256 * (pn - 24) + o;
    else if (pn < 32) src = 7184 + 256 * (pn - 28) + o;
    else { src = 6144; nvalid = (o == 0) ? 16 : 0; }
}
__device__ __forceinline__ void rms_row_to_bf16(const float* xrow, const float* gain, bf16* orow, int lane) {
    const GAS f32x4* xr = (const GAS f32x4*)xrow + lane; const GAS f32x4* gr = (const GAS f32x4*)gain + lane;
    f32x4 v[4]; float s = 0.f;
#pragma unroll
    for (int j = 0; j < 4; ++j) { v[j] = xr[64 * j]; s += (v[j].x * v[j].x + v[j].y * v[j].y) + (v[j].z * v[j].z + v[j].w * v[j].w); }
    const float rstd = 1.f / sqrtf(wave_sum(s) * (1.f / DM) + EPS);
    GAS unsigned long long* o8 = (GAS unsigned long long*)orow + lane;
#pragma unroll
    for (int j = 0; j < 4; ++j) { const f32x4 g = gr[64 * j]; o8[64 * j] = (unsigned long long)pk2(v[j].x * rstd * g.x, v[j].y * rstd * g.y) | ((unsigned long long)pk2(v[j].z * rstd * g.z, v[j].w * rstd * g.w) << 32); }
}

typedef pg8::f32x4 A4;
struct EpiIn {
    static constexpr bool PERM = true;
    bf16 *GLU, *QKVB, *QS, *HALOQ, *HALOC, *ZS, *SGC, *SGD; float* BETAG; const float *a_log, *dt_bias;
    __device__ __forceinline__ void operator()(const A4 (&acc)[2][2][4][2], const pg8::Unit& u, int wr, int wc, int fr, int fq) const {
#if defined(PROBE_EPI2)
        for (int rep = 0; rep < 2; ++rep) { asm volatile("" ::: "memory"); body(acc, u, wr, wc, fr, fq); }
#else
        body(acc, u, wr, wc, fr, fq);
#endif
    }
    __device__ __forceinline__ void body(const A4 (&acc)[2][2][4][2], const pg8::Unit& u, int wr, int wc, int fr, int fq) const {
        const int pn = u.pn, row0 = u.pm * 256 + wr * 64 + fr, cw = 32 * wc + 8 * fq;
        if (pn < 8) {
#pragma unroll
            for (int ai = 0; ai < 2; ++ai)
#pragma unroll
                for (int m = 0; m < 4; ++m) { const int r = row0 + ai * 128 + m * 16; float o[8];
#pragma unroll
                    for (int n = 0; n < 2; ++n)
#pragma unroll
                        for (int j = 0; j < 4; ++j) o[4 * n + j] = acc[ai][0][m][n][j] * sigmoidf_(acc[ai][1][m][n][j]);
                    v4u w; w.x = pk2(o[0], o[1]); w.y = pk2(o[2], o[3]); w.z = pk2(o[4], o[5]); w.w = pk2(o[6], o[7]);
                    *(GAS v4u*)(GLU + (size_t)r * DM + 128 * pn + cw) = w;
                    if (r < RP) { const int b = r / TP, t = r - b * TP, run = t / RUNL, pos = t - run * RUNL;
                        if (pos >= RUNL - 30 && run < NRUN - 1) *(GAS v4u*)(HALOC + ((size_t)(b * NRUN + run) * 30 + (pos - (RUNL - 30))) * DM + 128 * pn + cw) = w; } }
        } else if (pn < 20) {
            const int colb = 256 * (pn - 8);
#pragma unroll
            for (int ai = 0; ai < 2; ++ai)
#pragma unroll
                for (int m = 0; m < 4; ++m) { const int r = row0 + ai * 128 + m * 16; if (r >= MR) continue;
#pragma unroll
                    for (int bj = 0; bj < 2; ++bj) { const int col = colb + 128 * bj + cw;
                        const A4 a0 = acc[ai][bj][m][0], a1 = acc[ai][bj][m][1];
                        v4u w; w.x = pk2(a0[0], a0[1]); w.y = pk2(a0[2], a0[3]); w.z = pk2(a1[0], a1[1]); w.w = pk2(a1[2], a1[3]);
                        if (r >= RP) *(GAS v4u*)(QS + (size_t)(r - RP) * DQKV + col) = w;
                        else { const int b = r / TP, t = r - b * TP, c = t >> 6, i = t & 63, which = col >> 10, h = (col >> 7) & 7, d = col & 127;
                            *(GAS v4u*)(QKVB + ((size_t)((b * NCH + c) * NH + h) * 3 + which) * 8192 + i * 128 + d) = w;
                            if (i >= 61) *(GAS v4u*)(HALOQ + ((size_t)(b * NCH + c) * 3 + (i - 61)) * DQKV + col) = w; } } }
        } else if (pn < 24) {
            constexpr bool isz = true; bf16* dst = ZS; const int ld = DM, cb = 256 * (pn - 20);
#pragma unroll
            for (int ai = 0; ai < 2; ++ai)
#pragma unroll
                for (int m = 0; m < 4; ++m) { const int r = row0 + ai * 128 + m * 16;
#pragma unroll
                    for (int bj = 0; bj < 2; ++bj) { float o[8];
#pragma unroll
                        for (int n = 0; n < 2; ++n)
#pragma unroll
                            for (int j = 0; j < 4; ++j) { const float v = acc[ai][bj][m][n][j]; o[4 * n + j] = isz ? siluf_(v) : v; }
                        v4u w; w.x = pk2(o[0], o[1]); w.y = pk2(o[2], o[3]); w.z = pk2(o[4], o[5]); w.w = pk2(o[6], o[7]);
                        *(GAS v4u*)(dst + (size_t)r * ld + cb + 128 * bj + cw) = w; } }
        } else if (pn < 32) {
            bf16* dst = pn < 28 ? SGC : SGD; const int cb = 256 * ((pn - 24) & 3);
#pragma unroll
            for (int ai = 0; ai < 2; ++ai)
#pragma unroll
                for (int m = 0; m < 4; ++m) { const int rc = compact_row(row0 + ai * 128 + m * 16); if (rc < 0) continue;
#pragma unroll
                    for (int bj = 0; bj < 2; ++bj) { float o[8];
#pragma unroll
                        for (int n = 0; n < 2; ++n)
#pragma unroll
                            for (int j = 0; j < 4; ++j) o[4 * n + j] = sigmoidf_(acc[ai][bj][m][n][j]);
                        v4u w; w.x = pk2(o[0], o[1]); w.y = pk2(o[2], o[3]); w.z = pk2(o[4], o[5]); w.w = pk2(o[6], o[7]);
                        *(GAS v4u*)(dst + (size_t)rc * DM + cb + 128 * bj + cw) = w; } }
        } else {
            if (wc == 0 && fq < 2) {
#pragma unroll
                for (int ai = 0; ai < 2; ++ai)
#pragma unroll
                    for (int m = 0; m < 4; ++m) { const int r = row0 + ai * 128 + m * 16; float o[8];
#pragma unroll
                        for (int n = 0; n < 2; ++n)
#pragma unroll
                            for (int j = 0; j < 4; ++j) { const int h = 4 * n + j; const float v = acc[ai][0][m][n][j];
                                if (fq == 0) o[h] = 1.f / (1.f + expf(-v));
                                else { const float xx = v + dt_bias[h]; const float sp = xx > 20.f ? xx : log1pf(expf(xx)); o[h] = -expf(a_log[h]) * sp; } }
                        GAS f32x4* p = (GAS f32x4*)(BETAG + (size_t)r * 16 + 8 * fq);
                        p[0] = (f32x4){o[0], o[1], o[2], o[3]}; p[1] = (f32x4){o[4], o[5], o[6], o[7]}; }
            }
        }
    }
};
template <int MODE> struct EpiGate {
    static constexpr bool PERM = true;
    bf16 *SG, *MA, *OUT;
    __device__ __forceinline__ void operator()(const A4 (&acc)[2][2][4][2], const pg8::Unit& u, int wr, int wc, int fr, int fq) const {
        const int row0 = u.pm * 256 + wr * 64 + fr, c0 = 256 * u.pn + 32 * wc + 8 * fq;
#pragma unroll
        for (int ai = 0; ai < 2; ++ai) {
            size_t off[4]; bool ok[4]; v4u g[4][2], q[4][2];
#pragma unroll
            for (int m = 0; m < 4; ++m) { const int rc = compact_row(row0 + ai * 128 + m * 16); ok[m] = rc >= 0; off[m] = (size_t)(ok[m] ? rc : 0) * DM + c0; }
#pragma unroll
            for (int m = 0; m < 4; ++m)
#pragma unroll
                for (int bj = 0; bj < 2; ++bj) { g[m][bj] = *(const GAS v4u*)(SG + off[m] + 128 * bj); if (MODE == 1) q[m][bj] = *(const GAS v4u*)(MA + off[m] + 128 * bj); }
#pragma unroll
            for (int m = 0; m < 4; ++m)
#pragma unroll
                for (int bj = 0; bj < 2; ++bj) { const v4u gg = g[m][bj]; float o[8];
                    const A4 a0 = acc[ai][bj][m][0], a1 = acc[ai][bj][m][1];
                    o[0] = bflo(gg.x) * a0[0]; o[1] = bfhi(gg.x) * a0[1]; o[2] = bflo(gg.y) * a0[2]; o[3] = bfhi(gg.y) * a0[3];
                    o[4] = bflo(gg.z) * a1[0]; o[5] = bfhi(gg.z) * a1[1]; o[6] = bflo(gg.w) * a1[2]; o[7] = bfhi(gg.w) * a1[3];
                    if (MODE == 1) { const v4u qq = q[m][bj];
                        o[0] += bflo(qq.x); o[1] += bfhi(qq.x); o[2] += bflo(qq.y); o[3] += bfhi(qq.y); o[4] += bflo(qq.z); o[5] += bfhi(qq.z); o[6] += bflo(qq.w); o[7] += bfhi(qq.w); }
                    v4u w; w.x = cvtpk(o[0], o[1]); w.y = cvtpk(o[2], o[3]); w.z = cvtpk(o[4], o[5]); w.w = cvtpk(o[6], o[7]);
                    if (ok[m]) *(GAS v4u*)(OUT + off[m] + 128 * bj) = w; }
        }
    }
};
template <int MODE> struct EpiRes {
    static constexpr bool PERM = false;
    const float *xp, *xs; float* out; float* parts; const bf16* X1B;
    __device__ __forceinline__ void operator()(const A4 (&acc)[2][2][4][2], const pg8::Unit& u, int wr, int wc, int fr, int fq) const {
        const int row0 = u.pm * 256 + wr * 64 + fr, c0 = 256 * u.pn + 32 * wc + 4 * fq;
        if (u.pm >= BP * SEQ / 256) {
            float* part = parts + (size_t)(u.k0 / u.nt) * RS * DM;
#pragma unroll
            for (int ai = 0; ai < 2; ++ai)
#pragma unroll
                for (int m = 0; m < 4; ++m) { float* orow = part + (size_t)(row0 + ai * 128 + m * 16 - BP * SEQ) * DM;
#pragma unroll
                    for (int bj = 0; bj < 2; ++bj)
#pragma unroll
                        for (int n = 0; n < 2; ++n) *(GAS f32x4*)(orow + c0 + 128 * bj + 16 * n) = acc[ai][bj][m][n]; }
            return; }
#pragma unroll
        for (int ai = 0; ai < 2; ++ai)
#pragma unroll
            for (int m = 0; m < 4; ++m) { const int r = row0 + ai * 128 + m * 16;
                float* orow = out + (size_t)r * DM;
                if (MODE == 0) { const float* base = r < BP * SEQ ? xp + (size_t)r * DM : xs + (size_t)(r - BP * SEQ) * DM;
#pragma unroll
                    for (int bj = 0; bj < 2; ++bj)
#pragma unroll
                        for (int n = 0; n < 2; ++n) { const int c = c0 + 128 * bj + 16 * n; const f32x4 b = *(const GAS f32x4*)(base + c); *(GAS f32x4*)(orow + c) = b + acc[ai][bj][m][n]; }
                } else {
                } }
        if (MODE == 1) {
#pragma unroll
            for (int ai = 0; ai < 2; ++ai) { v2u xb[4][2][2];
#pragma unroll
                for (int m = 0; m < 4; ++m)
#pragma unroll
                    for (int bj = 0; bj < 2; ++bj)
#pragma unroll
                        for (int n = 0; n < 2; ++n) xb[m][bj][n] = *(const GAS v2u*)(X1B + (size_t)(row0 + ai * 128 + m * 16) * DM + c0 + 128 * bj + 16 * n);
#pragma unroll
                for (int m = 0; m < 4; ++m)
#pragma unroll
                    for (int bj = 0; bj < 2; ++bj)
#pragma unroll
                        for (int n = 0; n < 2; ++n) { const v2u b = xb[m][bj][n];
                            *(GAS f32x4*)(out + (size_t)(row0 + ai * 128 + m * 16) * DM + c0 + 128 * bj + 16 * n) = (f32x4){bflo(b.x), bfhi(b.x), bflo(b.y), bfhi(b.y)} + acc[ai][bj][m][n]; } }
        }
    }
};
struct EpiWo {
    const float *xp; bf16* X1B; float* parts;
    __device__ __forceinline__ void operator()(const A4 (&acc)[2][2][4][2], const pg8::Unit& u, int wr, int wc, int fr, int fq) const {
        const int row0 = u.pm * 256 + wr * 64 + fr, c0 = 256 * u.pn + 32 * wc + 8 * fq;
        if (u.pm >= BP * SEQ / 256) {
            float* part = parts + (size_t)(u.k0 / u.nt) * RS * DM;
#pragma unroll
            for (int ai = 0; ai < 2; ++ai)
#pragma unroll
                for (int m = 0; m < 4; ++m) { float* orow = part + (size_t)(row0 + ai * 128 + m * 16 - BP * SEQ) * DM + c0;
#pragma unroll
                    for (int bj = 0; bj < 2; ++bj) { *(GAS f32x4*)(orow + 128 * bj) = acc[ai][bj][m][0]; *(GAS f32x4*)(orow + 128 * bj + 4) = acc[ai][bj][m][1]; } }
            return; }
#pragma unroll
        for (int ai = 0; ai < 2; ++ai) { f32x4 xv[4][2][2];
#pragma unroll
            for (int m = 0; m < 4; ++m)
#pragma unroll
                for (int bj = 0; bj < 2; ++bj) { const float* xrow = xp + (size_t)(row0 + ai * 128 + m * 16) * DM + c0 + 128 * bj; xv[m][bj][0] = *(const GAS f32x4*)xrow; xv[m][bj][1] = *(const GAS f32x4*)(xrow + 4); }
#pragma unroll
            for (int m = 0; m < 4; ++m)
#pragma unroll
                for (int bj = 0; bj < 2; ++bj) { const f32x4 x0 = xv[m][bj][0] + acc[ai][bj][m][0], x1 = xv[m][bj][1] + acc[ai][bj][m][1];
                    v4u w; w.x = cvtpk(x0[0], x0[1]); w.y = cvtpk(x0[2], x0[3]); w.z = cvtpk(x1[0], x1[1]); w.w = cvtpk(x1[2], x1[3]);
                    *(GAS v4u*)(X1B + (size_t)(row0 + ai * 128 + m * 16) * DM + c0 + 128 * bj) = w; } }
    }
};
struct EpiWoP : EpiWo { static constexpr bool PERM = true; };
struct EpiUp {
    static constexpr bool PERM = true;
    bf16* HM;
    __device__ __forceinline__ void operator()(const A4 (&acc)[2][2][4][2], const pg8::Unit& u, int wr, int wc, int fr, int fq) const {
        const int row0 = u.pm * 256 + wr * 64 + fr, c0 = 256 * u.pn + 32 * wc + 8 * fq;
#pragma unroll
        for (int ai = 0; ai < 2; ++ai)
#pragma unroll
            for (int m = 0; m < 4; ++m) { const int r = row0 + ai * 128 + m * 16;
#pragma unroll
                for (int bj = 0; bj < 2; ++bj) { float o[8];
#pragma unroll
                    for (int n = 0; n < 2; ++n)
#pragma unroll
                        for (int j = 0; j < 4; ++j) { const float v = fmaxf(acc[ai][bj][m][n][j], 0.f); o[4 * n + j] = v * v; }
                    v4u w; w.x = pk2(o[0], o[1]); w.y = pk2(o[2], o[3]); w.z = pk2(o[4], o[5]); w.w = pk2(o[6], o[7]);
                    *(GAS v4u*)(HM + (size_t)r * DFF + c0 + 128 * bj) = w; } }
    }
};

template <int KIND>
__device__ __forceinline__ void conv_unit(const Args& a, LAS unsigned char* lds, int b, int run) {
    asm volatile("" ::: "memory");
    const int tid = threadIdx.x, lane = tid & 63, wave = tid >> 6; int ch = 2 * tid; asm volatile("" : "+v"(ch));
    unsigned char* ws = a.ws;
    bf16* GC = (bf16*)(ws + WS_GLU); const bf16* HALOC = (const bf16*)(ws + WS_HALOC);
    const float* w_dw = a.in[8];
    LAS float* red = (LAS float*)lds;
    constexpr int NTOK = KIND == 0 ? RUNL : TS, NSTEP = (NTOK + 3) / 4, REM = NTOK - 4 * (NSTEP - 1);
    f32x2 w[KC]; unsigned E[KC + 3];
#pragma unroll
    for (int i = 0; i < KC; ++i) w[i] = *(const GAS f32x2*)(w_dw + (size_t)i * DM + ch);
    const f32x2 bdw = *(const GAS f32x2*)(a.in[9] + ch), lng = *(const GAS f32x2*)(a.in[10] + ch), lnb = *(const GAS f32x2*)(a.in[11] + ch);
    const int row0 = KIND == 0 ? b * TP + run * RUNL : RP + b * TS;
    if (KIND == 0) {
#pragma unroll
        for (int i = 0; i < KC - 1; ++i) { unsigned v = *(const GAS unsigned*)(HALOC + ((size_t)(b * NRUN + (run > 0 ? run - 1 : 0)) * 30 + i) * DM + ch); E[i] = run > 0 ? v : 0u; }
    } else { const float* st = a.in[2] + (size_t)b * (KC - 1) * DM;
#pragma unroll
        for (int i = 0; i < KC - 1; ++i) { const f32x2 v = *(const GAS f32x2*)(st + (size_t)i * DM + ch); E[i] = pk2(v.x, v.y); }
    }
    unsigned nx[4];
#pragma unroll
    for (int k = 0; k < 4; ++k) nx[k] = *(const GAS unsigned*)(GC + (size_t)(row0 + (k < NTOK ? k : NTOK - 1)) * DM + ch);
    for (int st4 = 0; st4 < NSTEP; ++st4) {
        const int t0 = 4 * st4;
#pragma unroll
        for (int k = 0; k < 4; ++k) E[KC - 1 + k] = nx[k];
        if (st4 + 1 < NSTEP) {
#pragma unroll
            for (int k = 0; k < 4; ++k) { const int t = t0 + 4 + k; nx[k] = *(const GAS unsigned*)(GC + (size_t)(row0 + (t < NTOK ? t : NTOK - 1)) * DM + ch); }
        }
        f32x2 y[4] = {bdw, bdw, bdw, bdw};
#pragma unroll
        for (int j = 0; j < KC + 3; ++j) { const f32x2 e = {bflo(E[j]), bfhi(E[j])};
#pragma unroll
            for (int k = 0; k < 4; ++k) { const int i = j - k; if (i >= 0 && i < KC) y[k] += w[i] * e; } }
        float sv[8];
#pragma unroll
        for (int k = 0; k < 4; ++k) { sv[2 * k] = wave_sum(y[k].x + y[k].y); sv[2 * k + 1] = wave_sum(y[k].x * y[k].x + y[k].y * y[k].y); }
        LAS float* rb = red + (st4 & 1) * 64;
        if (lane == 0) { *(LAS f32x4*)(rb + wave * 8) = (f32x4){sv[0], sv[1], sv[2], sv[3]}; *(LAS f32x4*)(rb + wave * 8 + 4) = (f32x4){sv[4], sv[5], sv[6], sv[7]}; }
        __syncthreads();
        f32x4 ta = {0.f, 0.f, 0.f, 0.f}, tb = {0.f, 0.f, 0.f, 0.f};
#pragma unroll
        for (int i = 0; i < 8; ++i) { ta += *(const LAS f32x4*)(rb + i * 8); tb += *(const LAS f32x4*)(rb + i * 8 + 4); }
        const float tt[8] = {ta.x, ta.y, ta.z, ta.w, tb.x, tb.y, tb.z, tb.w};
#pragma unroll
        for (int k = 0; k < 4; ++k) { if (t0 + k < NTOK) {
            const float mu = tt[2 * k] * (1.f / DM), var = fmaxf(tt[2 * k + 1] * (1.f / DM) - mu * mu, 0.f), rstd = rsqf(var + EPS);
            const float z0 = (y[k].x - mu) * rstd * lng.x + lnb.x, z1 = (y[k].y - mu) * rstd * lng.y + lnb.y;
            *(GAS unsigned*)(GC + (size_t)(row0 + t0 + k) * DM + ch) = pk2(siluf_(z0), siluf_(z1)); } }
        if (st4 + 1 < NSTEP) {
#pragma unroll
            for (int i = 0; i < KC - 1; ++i) E[i] = E[i + 4];
        }
    }
    if (KIND == 1 || run == NRUN - 1) { float* o = a.out + (KIND == 0 ? O_PC : O_SC) + (size_t)b * (KC - 1) * DM;
        if (KIND == 0) {
#pragma unroll
            for (int i = 0; i < KC - 1; ++i) *(GAS f32x2*)(o + (size_t)i * DM + ch) = (f32x2){bflo(E[REM + i]), bfhi(E[REM + i])};
        } else {
            const float* st = a.in[2] + (size_t)b * (KC - 1) * DM;
#pragma unroll
            for (int i = 0; i < KC - 1 - TS; ++i) *(GAS f32x2*)(o + (size_t)i * DM + ch) = *(const GAS f32x2*)(st + (size_t)(i + TS) * DM + ch);
#pragma unroll
            for (int i = KC - 1 - TS; i < KC - 1; ++i) *(GAS f32x2*)(o + (size_t)i * DM + ch) = (f32x2){bflo(E[REM + i]), bfhi(E[REM + i])};
        }
    }
    __syncthreads();
}

__device__ __forceinline__ void delta_item(const Args& a, LAS unsigned char* lds, int item) {
    asm volatile("" ::: "memory");
    const int tid = threadIdx.x, lane = tid & 63, sub = tid >> 7, wu = (tid >> 6) & 1; int j = tid & 127; asm volatile("" : "+v"(j));
    const int unit = item * 4 + sub, b = unit >> 3, h = unit & 7;
    const int row0 = RP + b * TS;
    const bf16* QS = (const bf16*)(a.ws + WS_QS); bf16* ZS = (bf16*)(a.ws + WS_ZS); const float* BETAG = (const float*)(a.ws + WS_BETAG);
    LAS float* kq = (LAS float*)lds + sub * 256;
    LAS float* red = (LAS float*)lds + 1024 + sub * 4;
    LAS float* red2 = (LAS float*)lds + 1024 + 16 + sub * 2;
    float S[DH];
    { const float* s0 = a.in[4] + ((size_t)(b * NH + h) * DH) * DH + j;
#pragma unroll
        for (int d = 0; d < DH; ++d) S[d] = s0[(size_t)d * DH]; }
    const int cq = h * DH + j, ck = DM + cq, cv = 2 * DM + cq;
    float wq[KS], wk[KS], wv[KS];
#pragma unroll
    for (int i = 0; i < KS; ++i) { wq[i] = a.in[13][i * DQKV + cq]; wk[i] = a.in[13][i * DQKV + ck]; wv[i] = a.in[13][i * DQKV + cv]; }
    float hq[3], hk[3], hv[3];
#pragma unroll
    for (int i = 0; i < 3; ++i) { const float* st = a.in[3] + ((size_t)b * 3 + i) * DQKV; hq[i] = st[cq]; hk[i] = st[ck]; hv[i] = st[cv]; }
    const float gh = a.in[16][j];
    float pq[TS], pk[TS], pv[TS], pbe[TS], pgg[TS], pzs[TS];
#pragma unroll
    for (int t = 0; t < TS; ++t) { const bf16* p = QS + (size_t)(b * TS + t) * DQKV; pq[t] = bf1(p[cq]); pk[t] = bf1(p[ck]); pv[t] = bf1(p[cv]);
        pbe[t] = BETAG[(size_t)(row0 + t) * 16 + h]; pgg[t] = BETAG[(size_t)(row0 + t) * 16 + 8 + h]; pzs[t] = bf1(ZS[(size_t)(row0 + t) * DM + cq]); }
#pragma unroll
    for (int t = 0; t < TS; ++t) {
        const size_t row = (size_t)(row0 + t);
        const float qp = pq[t], kp = pk[t], vp = pv[t];
        const float qc = siluf_(wq[0] * hq[0] + wq[1] * hq[1] + wq[2] * hq[2] + wq[3] * qp);
        const float kc = siluf_(wk[0] * hk[0] + wk[1] * hk[1] + wk[2] * hk[2] + wk[3] * kp);
        const float vc = siluf_(wv[0] * hv[0] + wv[1] * hv[1] + wv[2] * hv[2] + wv[3] * vp);
        hq[0] = hq[1]; hq[1] = hq[2]; hq[2] = qp; hk[0] = hk[1]; hk[1] = hk[2]; hk[2] = kp; hv[0] = hv[1]; hv[1] = hv[2]; hv[2] = vp;
        const float sq = wave_sum(qc * qc), sk = wave_sum(kc * kc);
        kq[j] = kc; kq[128 + j] = qc;
        if (lane == 0) { red[wu * 2] = sq; red[wu * 2 + 1] = sk; }
        const float beta = pbe[t], gg = pgg[t], zs = pzs[t];
        __syncthreads();
        const float nq = rsqf(red[0] + red[2] + 1e-6f) * 0.08838834764831845f, nk = rsqf(red[1] + red[3] + 1e-6f);
        const float alpha = __expf(gg);
        float ks0 = 0.f, ks1 = 0.f, ks2 = 0.f, ks3 = 0.f;
#pragma unroll
        for (int d = 0; d < DH; d += 4) { const f32x4 kk = *(const LAS f32x4*)(kq + d); ks0 += kk.x * S[d]; ks1 += kk.y * S[d + 1]; ks2 += kk.z * S[d + 2]; ks3 += kk.w * S[d + 3];
            if ((d & 31) == 28) asm volatile("" ::: "memory"); }
        const float kS = (ks0 + ks1) + (ks2 + ks3);
        const float u = beta * (vc - alpha * nk * kS), un = nk * u;
        float o0 = 0.f, o1 = 0.f, o2 = 0.f, o3 = 0.f;
#pragma unroll
        for (int d = 0; d < DH; d += 4) { const f32x4 kk = *(const LAS f32x4*)(kq + d); const f32x4 qq = *(const LAS f32x4*)(kq + 128 + d);
            S[d] = alpha * S[d] + kk.x * un; S[d + 1] = alpha * S[d + 1] + kk.y * un; S[d + 2] = alpha * S[d + 2] + kk.z * un; S[d + 3] = alpha * S[d + 3] + kk.w * un;
            o0 += qq.x * S[d]; o1 += qq.y * S[d + 1]; o2 += qq.z * S[d + 2]; o3 += qq.w * S[d + 3];
            if ((d & 15) == 12) asm volatile("" ::: "memory"); }
        const float o = ((o0 + o1) + (o2 + o3)) * nq;
        const float so = wave_sum(o * o);
        if (lane == 0) red2[wu] = so;
        __syncthreads();
        const float rms = rsqf((red2[0] + red2[1]) * (1.f / DH) + EPS);
        ZS[row * DM + cq] = (bf16)f2bf(o * rms * gh * zs);
    }
    { float* so = a.out + O_SD + ((size_t)(b * NH + h) * DH) * DH + j;
#pragma unroll
        for (int d = 0; d < DH; ++d) so[(size_t)d * DH] = S[d];
      float* qo = a.out + O_SQ + (size_t)b * 3 * DQKV;
#pragma unroll
        for (int i = 0; i < 3; ++i) { qo[i * DQKV + cq] = hq[i]; qo[i * DQKV + ck] = hk[i]; qo[i * DQKV + cv] = hv[i]; }
    }
    __syncthreads();
}

__host__ __device__ constexpr int perm_k(int x) { return (x & ~31) | (((x >> 2) & 3) << 3) | (((x >> 4) & 1) << 2) | (x & 3); }
typedef short bf16x8v __attribute__((ext_vector_type(8)));
constexpr int IH_QH = 0, IH_KH = 17408, IH_VH = 34816, IH_GV = 52224, IH_BYTES = 54272;
__device__ __forceinline__ void intra_pair(const Args& a, LAS unsigned char* lds_all, int pair) {
    asm volatile("" ::: "memory");
    const int tid = threadIdx.x, half = tid >> 8, lane = tid & 63, wq = (tid >> 6) & 3; int tu = tid & 255; asm volatile("" : "+v"(tu));
    const int uq = pair * 2 + half, h = uq & 7, bc = uq >> 3, b = bc / NCH, c = bc - b * NCH;
    const int nvalid = (c == NCH - 1) ? TP - 64 * (NCH - 1) : 64;
    LAS unsigned char* lds = lds_all + half * IH_BYTES;
    LAS bf16* QH = (LAS bf16*)(lds + IH_QH); LAS bf16* KH = (LAS bf16*)(lds + IH_KH); LAS bf16* VH = (LAS bf16*)(lds + IH_VH);
    LAS float* MF = (LAS float*)(lds + IH_KH); LAS bf16* ATL = (LAS bf16*)(lds + IH_VH); LAS float* GV = (LAS float*)(lds + IH_GV);
    unsigned char* ws = a.ws;
    bf16* blk = (bf16*)(ws + WS_QKVB) + (size_t)uq * QBLK; const bf16* HALOQ = (const bf16*)(ws + WS_HALOQ); const float* BETAG = (const float*)(ws + WS_BETAG);
    bf16* KDT = (bf16*)(ws + WS_KDT) + (size_t)uq * 8192; bf16* ATT = (bf16*)(ws + WS_ATTN) + (size_t)uq * 4096; float* LASTV = (float*)(ws + WS_LASTV);
    if (tu < 64) { const int i = tu; float g = 0.f, be = 0.f; { const float* p = BETAG + (size_t)(b * TP + 64 * c + (i < nvalid ? i : 0)) * 16; be = p[h]; g = p[8 + h]; } if (i >= nvalid) { g = 0.f; be = 0.f; }
        float G = g;
#pragma unroll
        for (int o = 1; o < 64; o <<= 1) { const float t = __shfl_up(G, o); if (lane >= o) G += t; }
        const float GL = __shfl(G, 63);
        GV[i] = G; GV[64 + i] = be; GV[128 + i] = expf(G); GV[192 + i] = expf(GL - G);
        if (i == 63) LASTV[uq] = expf(GL); }
    {   const int cp = tu & 15, rg = tu >> 4;
        v4u raw[3][7];
#pragma unroll
        for (int wh = 0; wh < 3; ++wh)
#pragma unroll
            for (int k = 0; k < 7; ++k) { const int rr = 4 * rg - 3 + k;
                const bf16* p = (rr >= 0) ? blk + wh * 8192 + rr * 128 + 8 * cp : HALOQ + ((size_t)(b * NCH + (c > 0 ? c - 1 : 0)) * 3 + (3 + rr)) * DQKV + wh * DM + h * DH + 8 * cp;
                raw[wh][k] = *(const GAS v4u*)p; }
#pragma unroll
        for (int wh = 0; wh < 3; ++wh) {
            const int col = wh * DM + h * DH + 8 * cp;
            f32x4 wl[4], wh4[4];
#pragma unroll
            for (int i = 0; i < 4; ++i) { wl[i] = *(const GAS f32x4*)(a.in[13] + i * DQKV + col); wh4[i] = *(const GAS f32x4*)(a.in[13] + i * DQKV + col + 4); }
            float xr[7][8];
#pragma unroll
            for (int k = 0; k < 7; ++k) { const int rr = 4 * rg - 3 + k; const bool ok = (rr >= 0) ? (rr < nvalid) : (c > 0); const v4u v = raw[wh][k];
                xr[k][0] = ok ? bflo(v.x) : 0.f; xr[k][1] = ok ? bfhi(v.x) : 0.f; xr[k][2] = ok ? bflo(v.y) : 0.f; xr[k][3] = ok ? bfhi(v.y) : 0.f;
                xr[k][4] = ok ? bflo(v.z) : 0.f; xr[k][5] = ok ? bfhi(v.z) : 0.f; xr[k][6] = ok ? bflo(v.w) : 0.f; xr[k][7] = ok ? bfhi(v.w) : 0.f; }
            if (c == NCH - 1 && rg == (nvalid - 1) / 4) {
                float* qo = a.out + O_PQ + (size_t)b * 3 * DQKV + col;
#pragma unroll
                for (int i = 0; i < 3; ++i) { *(GAS f32x4*)(qo + i * DQKV) = (f32x4){xr[4 + i][0], xr[4 + i][1], xr[4 + i][2], xr[4 + i][3]}; *(GAS f32x4*)(qo + i * DQKV + 4) = (f32x4){xr[4 + i][4], xr[4 + i][5], xr[4 + i][6], xr[4 + i][7]}; } }
            LAS bf16* tile = wh == 0 ? QH : (wh == 1 ? KH : VH);
#pragma unroll
            for (int r = 0; r < 4; ++r) { const bool ok = (4 * rg + r) < nvalid; float y[8];
#pragma unroll
                for (int e = 0; e < 8; ++e) { const float w0 = e < 4 ? wl[0][e & 3] : wh4[0][e & 3], w1 = e < 4 ? wl[1][e & 3] : wh4[1][e & 3], w2 = e < 4 ? wl[2][e & 3] : wh4[2][e & 3], w3 = e < 4 ? wl[3][e & 3] : wh4[3][e & 3];
                    const float t = w0 * xr[r][e] + w1 * xr[r + 1][e] + w2 * xr[r + 2][e] + w3 * xr[r + 3][e]; y[e] = ok ? siluf_(t) : 0.f; }
                v4u o; o.x = cvtpk(y[0], y[1]); o.y = cvtpk(y[2], y[3]); o.z = cvtpk(y[4], y[5]); o.w = cvtpk(y[6], y[7]);
                *(LAS v4u*)(tile + (4 * rg + r) * 136 + 8 * cp) = o; }
        }
    }
    __syncthreads();
    const int which = tu >> 7, d = tu & 127;
    float x[64];
    { const LAS bf16* colp = (which == 0 ? VH : KH) + d;
#pragma unroll
      for (int i = 0; i < 64; ++i) x[i] = bf1(colp[i * 136]); }
    const int fr = lane & 15, fq = lane >> 4;
    f32x4 kk[4], qk[4];
    {   bf16x8v ak[4], aq[4];
#pragma unroll
        for (int sI = 0; sI < 4; ++sI) { ak[sI] = *(const LAS bf16x8v*)(KH + (16 * wq + fr) * 136 + 32 * sI + 8 * fq); aq[sI] = *(const LAS bf16x8v*)(QH + (16 * wq + fr) * 136 + 32 * sI + 8 * fq); }
        f32x4 kkd = {0.f, 0.f, 0.f, 0.f}, qqd = {0.f, 0.f, 0.f, 0.f};
#pragma unroll
        for (int sI = 0; sI < 4; ++sI) { kkd = __builtin_amdgcn_mfma_f32_16x16x32_bf16(ak[sI], ak[sI], kkd, 0, 0, 0); qqd = __builtin_amdgcn_mfma_f32_16x16x32_bf16(aq[sI], aq[sI], qqd, 0, 0, 0); }
#pragma unroll
        for (int nt = 0; nt < 4; ++nt) { kk[nt] = (f32x4){0.f, 0.f, 0.f, 0.f}; qk[nt] = (f32x4){0.f, 0.f, 0.f, 0.f};
            if (nt <= wq) {
#pragma unroll
                for (int sI = 0; sI < 4; ++sI) { const bf16x8v bk = *(const LAS bf16x8v*)(KH + (16 * nt + fr) * 136 + 32 * sI + 8 * fq);
                    kk[nt] = __builtin_amdgcn_mfma_f32_16x16x32_bf16(ak[sI], bk, kk[nt], 0, 0, 0); qk[nt] = __builtin_amdgcn_mfma_f32_16x16x32_bf16(aq[sI], bk, qk[nt], 0, 0, 0); } } }
#pragma unroll
        for (int r = 0; r < 4; ++r) if (fr == 4 * fq + r) { GV[320 + 16 * wq + fr] = rsqf(kkd[r] + 1e-6f); GV[256 + 16 * wq + fr] = rsqf(qqd[r] + 1e-6f) * 0.08838834764831845f; }
    }
    __syncthreads();
    {
#pragma unroll
        for (int nt = 0; nt < 4; ++nt) { const int j = 16 * nt + fr;
            if (nt <= wq) { const float Gj = GV[j], nkj = GV[320 + j];
#pragma unroll
                for (int r = 0; r < 4; ++r) { const int i = 16 * wq + 4 * fq + r; const float dec = (i >= j) ? __expf(GV[i] - Gj) : 0.f;
                    MF[i * 68 + j] = (i > j) ? GV[64 + i] * GV[320 + i] * nkj * kk[nt][r] * dec : 0.f;
                    ATL[i * 72 + j] = (bf16)f2bf(GV[256 + i] * nkj * qk[nt][r] * dec); }
            } else {
#pragma unroll
                for (int r = 0; r < 4; ++r) ATL[(16 * wq + 4 * fq + r) * 72 + j] = (bf16)0; }
        }
#pragma unroll
        for (int k = 0; k < 4; ++k) { const int pc = tu + 256 * k, i = pc >> 4, p16 = pc & 15, c0 = 32 * (p16 >> 2) + 4 * (p16 & 3);
            const v2u lo = *(const LAS v2u*)(QH + i * 136 + c0), hi = *(const LAS v2u*)(QH + i * 136 + c0 + 16); const float f = GV[256 + i] * GV[128 + i];
            v4u o; o.x = cvtpk(bflo(lo.x) * f, bfhi(lo.x) * f); o.y = cvtpk(bflo(lo.y) * f, bfhi(lo.y) * f); o.z = cvtpk(bflo(hi.x) * f, bfhi(hi.x) * f); o.w = cvtpk(bflo(hi.y) * f, bfhi(hi.y) * f);
            *(GAS v4u*)(blk + i * 128 + 8 * p16) = o; }
        if (which == 0) {
#pragma unroll
            for (int i = 0; i < 64; i += 4) { const f32x4 be = *(const LAS f32x4*)(GV + 64 + i); x[i] *= be.x; x[i + 1] *= be.y; x[i + 2] *= be.z; x[i + 3] *= be.w; }
        } else {
            bf16* kd = KDT + d * 64;
#pragma unroll
            for (int i = 0; i < 64; i += 4) { const f32x4 nk = *(const LAS f32x4*)(GV + 320 + i); x[i] *= nk.x; x[i + 1] *= nk.y; x[i + 2] *= nk.z; x[i + 3] *= nk.w; }
#pragma unroll
            for (int g8 = 0; g8 < 8; ++g8) { const int i0 = 32 * (g8 >> 2) + 4 * (g8 & 3);
                const f32x4 e0 = *(const LAS f32x4*)(GV + 192 + i0), e1 = *(const LAS f32x4*)(GV + 192 + i0 + 16);
                v4u w; w.x = cvtpk(x[i0] * e0.x, x[i0 + 1] * e0.y); w.y = cvtpk(x[i0 + 2] * e0.z, x[i0 + 3] * e0.w); w.z = cvtpk(x[i0 + 16] * e1.x, x[i0 + 17] * e1.y); w.w = cvtpk(x[i0 + 18] * e1.z, x[i0 + 19] * e1.w);
                *(GAS v4u*)(kd + 8 * g8) = w; }
#pragma unroll
            for (int i = 0; i < 64; i += 4) { const f32x4 be = *(const LAS f32x4*)(GV + 64 + i), eg = *(const LAS f32x4*)(GV + 128 + i);
                x[i] *= be.x * eg.x; x[i + 1] *= be.y * eg.y; x[i + 2] *= be.z * eg.z; x[i + 3] *= be.w * eg.w; }
        }
    }
    __syncthreads();
    {   f32x4 mb[16];
#pragma unroll
        for (int i = 1; i < 64; ++i) {
#pragma unroll
            for (int g = 0; g < (i + 3) / 4; ++g) mb[g] = *(const LAS f32x4*)(MF + i * 68 + 4 * g);
            __builtin_amdgcn_sched_barrier(0);
            f32x2 a01 = {x[i], 0.f}, a23 = {0.f, 0.f};
#pragma unroll
            for (int g = 0; g < (i + 3) / 4; ++g) { const f32x4 mm = mb[g];
                a01 -= (f32x2){mm.x, mm.y} * (f32x2){x[4 * g], x[4 * g + 1]}; a23 -= (f32x2){mm.z, mm.w} * (f32x2){x[4 * g + 2], x[4 * g + 3]}; }
            x[i] = (a01.x + a01.y) + (a23.x + a23.y);
            __builtin_amdgcn_sched_barrier(0);
        }
    }
    if (which == 0) {
        bf16* u0 = blk + 2 * 8192 + (size_t)(d >> 4) * 1024 + (d & 15) * 4;
#pragma unroll
        for (int m = 0; m < 4; ++m)
#pragma unroll
            for (int q = 0; q < 4; ++q) { const int i = 16 * m + 4 * q; v2u w; w.x = cvtpk(x[i], x[i + 1]); w.y = cvtpk(x[i + 2], x[i + 3]); *(GAS v2u*)(u0 + m * 256 + q * 64) = w; }
    } else {
#pragma unroll
        for (int i = 0; i < 64; ++i) QH[i * 136 + d] = (bf16)f2bf(x[i]);
    }
    __syncthreads();
#pragma unroll
    for (int k = 0; k < 4; ++k) { const int pc = tu + 256 * k, i = pc >> 4, p16 = pc & 15, c0 = 32 * (p16 >> 2) + 4 * (p16 & 3);
        const v2u lo = *(const LAS v2u*)(QH + i * 136 + c0), hi = *(const LAS v2u*)(QH + i * 136 + c0 + 16);
        *(GAS v4u*)(blk + 8192 + i * 128 + 8 * p16) = (v4u){lo.x, lo.y, hi.x, hi.y}; }
#pragma unroll
    for (int k = 0; k < 2; ++k) { const int pc = tu + 256 * k, i = pc >> 3, p8 = pc & 7, c0 = 32 * (p8 >> 2) + 4 * (p8 & 3);
        const v2u lo = *(const LAS v2u*)(ATL + i * 72 + c0), hi = *(const LAS v2u*)(ATL + i * 72 + c0 + 16);
        *(GAS v4u*)(ATT + i * 64 + 8 * p8) = (v4u){lo.x, lo.y, hi.x, hi.y}; }
    __syncthreads();
}

constexpr int SC_W = 0, SC_QD = 16384, SC_KDT = 32768, SC_AT = 49152, SC_BUF = 57344, SC_RMS = 2 * SC_BUF, SC_ZT = SC_RMS + 4096, SC_END = SC_ZT + 2 * 16384;
__device__ __forceinline__ int swz256(int row, int chunk) { return row * 256 + ((chunk ^ (row & 15)) << 4); }
__device__ __forceinline__ int swz128(int row, int ch) { return (row >> 1) * 256 + (((8 * (row & 1) + ch) ^ ((row >> 1) & 7)) << 4); }
__device__ __forceinline__ void scan_chain(const Args& a, LAS unsigned char* lds, int chain) {
    const int tid = threadIdx.x, lane = tid & 63, wave = __builtin_amdgcn_readfirstlane(tid >> 6), fr = lane & 15, fq = lane >> 4;
    const int b = chain >> 3, h = chain & 7;
    unsigned char* ws = a.ws;
    const bf16* QKVB = (const bf16*)(ws + WS_QKVB); const bf16* KDTg = (const bf16*)(ws + WS_KDT); const bf16* ATTg = (const bf16*)(ws + WS_ATTN); const float* LASTV = (const float*)(ws + WS_LASTV);
    bf16* ZS = (bf16*)(ws + WS_ZS);
    LAS float* RMS = (LAS float*)(lds + SC_RMS);
    const float gh = a.in[16][16 * wave + fr];
    f32x4 Sacc[8];
#pragma unroll
    for (int mt = 0; mt < 8; ++mt) Sacc[mt] = (f32x4){0.f, 0.f, 0.f, 0.f};
    v4u ztn[2]; v2u u0n[4]; float lastn;
    auto chunk_dma = [&](int c) {
        const size_t uq = (size_t)(b * NCH + c) * NH + h; const bf16* blk = QKVB + uq * QBLK; LAS unsigned char* base = lds + (c & 1) * SC_BUF;
#pragma unroll
        for (int k = 0; k < 2; ++k) { const int P = (wave + 8 * k) * 64 + lane, row = P >> 4, ch = (P & 15) ^ (row & 15);
            __builtin_amdgcn_global_load_lds((const unsigned*)(blk + 8192 + row * 128 + 8 * ch), (LAS unsigned*)(base + SC_W + (wave + 8 * k) * 1024), 16, 0, 0);
            __builtin_amdgcn_global_load_lds((const unsigned*)(blk + row * 128 + 8 * ch), (LAS unsigned*)(base + SC_QD + (wave + 8 * k) * 1024), 16, 0, 0);
            const int line = P >> 4, t = (P & 15) ^ (line & 7), r2 = 2 * line + (t >> 3);
            __builtin_amdgcn_global_load_lds((const unsigned*)(KDTg + uq * 8192 + r2 * 64 + 8 * (t & 7)), (LAS unsigned*)(base + SC_KDT + (wave + 8 * k) * 1024), 16, 0, 0); }
        { const int P = wave * 64 + lane, line = P >> 4, t = (P & 15) ^ (line & 7), r2 = 2 * line + (t >> 3);
            __builtin_amdgcn_global_load_lds((const unsigned*)(ATTg + uq * 4096 + r2 * 64 + 8 * (t & 7)), (LAS unsigned*)(base + SC_AT + wave * 1024), 16, 0, 0); }
    };
    auto side_load = [&](int c) {
        const size_t uq = (size_t)(b * NCH + c) * NH + h;
#pragma unroll
        for (int k = 0; k < 2; ++k) { const int p = tid + 512 * k; ztn[k] = *(const GAS v4u*)(ZS + (size_t)(b * TP + 64 * c + (p >> 4)) * DM + h * DH + 8 * (p & 15)); }
        const bf16* u0 = QKVB + uq * QBLK + 2 * 8192 + wave * 1024 + lane * 4;
#pragma unroll
        for (int m = 0; m < 4; ++m) u0n[m] = *(const GAS v2u*)(u0 + m * 256);
        lastn = LASTV[uq];
    };
    auto side_store = [&](int buf) {
#pragma unroll
        for (int k = 0; k < 2; ++k) { const int p = tid + 512 * k; *(LAS v4u*)(lds + SC_ZT + buf * 16384 + swz256(p >> 4, p & 15)) = ztn[k]; }
    };
    chunk_dma(0); side_load(0); side_store(0);
    v2u u0p[4]; float last;
#pragma unroll
    for (int m = 0; m < 4; ++m) u0p[m] = u0n[m];
    last = lastn;
    chunk_dma(1); side_load(1);
    __syncthreads();
    for (int c = 0; c < NCH; ++c) {
        const int buf = c & 1; LAS unsigned char* base = lds + buf * SC_BUF; LAS unsigned char* zt = lds + SC_ZT + buf * 16384;
        const int nvalid = (c == NCH - 1) ? TP - 64 * (NCH - 1) : 64;
        bf16x8v F[2][8];
#define SC_LD_A(m, f) do { _Pragma("unroll") for (int sI = 0; sI < 4; ++sI) { const int off = swz256(16 * (m) + fr, 4 * sI + fq); \
            f[2 * sI] = *(const LAS bf16x8v*)(base + SC_W + off); f[2 * sI + 1] = *(const LAS bf16x8v*)(base + SC_QD + off); } } while (0)
#define SC_LD_D(f) do { _Pragma("unroll") for (int m = 0; m < 4; ++m) _Pragma("unroll") for (int s2 = 0; s2 < 2; ++s2) f[2 * m + s2] = *(const LAS bf16x8v*)(base + SC_AT + swz128(16 * m + fr, 4 * s2 + fq)); } while (0)
#define SC_LD_C(g, f) do { _Pragma("unroll") for (int mm = 0; mm < 4; ++mm) _Pragma("unroll") for (int s2 = 0; s2 < 2; ++s2) f[2 * mm + s2] = *(const LAS bf16x8v*)(base + SC_KDT + swz128(16 * (4 * (g) + mm) + fr, 4 * s2 + fq)); } while (0)
        SC_LD_A(0, F[0]);
        bf16x8v Sb[4];
#pragma unroll
        for (int sI = 0; sI < 4; ++sI) { v4u w; w.x = cvtpk(Sacc[2 * sI][0], Sacc[2 * sI][1]); w.y = cvtpk(Sacc[2 * sI][2], Sacc[2 * sI][3]); w.z = cvtpk(Sacc[2 * sI + 1][0], Sacc[2 * sI + 1][1]); w.w = cvtpk(Sacc[2 * sI + 1][2], Sacc[2 * sI + 1][3]);
            Sb[sI] = __builtin_bit_cast(bf16x8v, w); }
        f32x4 u[4], o[4];
#pragma unroll
        for (int m = 0; m < 4; ++m) {
            if (m == 0) SC_LD_A(1, F[1]); else if (m == 1) SC_LD_A(2, F[0]); else if (m == 2) SC_LD_A(3, F[1]); else SC_LD_D(F[0]);
            __builtin_amdgcn_sched_barrier(0);
            f32x4 p = {0.f, 0.f, 0.f, 0.f}, oo = {0.f, 0.f, 0.f, 0.f};
#pragma unroll
            for (int sI = 0; sI < 4; ++sI) { p = __builtin_amdgcn_mfma_f32_16x16x32_bf16(F[m & 1][2 * sI], Sb[sI], p, 0, 0, 0); oo = __builtin_amdgcn_mfma_f32_16x16x32_bf16(F[m & 1][2 * sI + 1], Sb[sI], oo, 0, 0, 0); }
            u[m] = (f32x4){bflo(u0p[m].x), bfhi(u0p[m].x), bflo(u0p[m].y), bfhi(u0p[m].y)} - p; o[m] = oo;
            __builtin_amdgcn_sched_barrier(0);
        }
        bf16x8v Ub[2];
#pragma unroll
        for (int s2 = 0; s2 < 2; ++s2) { v4u w; w.x = cvtpk(u[2 * s2][0], u[2 * s2][1]); w.y = cvtpk(u[2 * s2][2], u[2 * s2][3]); w.z = cvtpk(u[2 * s2 + 1][0], u[2 * s2 + 1][1]); w.w = cvtpk(u[2 * s2 + 1][2], u[2 * s2 + 1][3]);
            Ub[s2] = __builtin_bit_cast(bf16x8v, w); }
        SC_LD_C(0, F[1]);
        __builtin_amdgcn_sched_barrier(0);
#pragma unroll
        for (int m = 0; m < 4; ++m)
#pragma unroll
            for (int s2 = 0; s2 < 2; ++s2) o[m] = __builtin_amdgcn_mfma_f32_16x16x32_bf16(F[0][2 * m + s2], Ub[s2], o[m], 0, 0, 0);
        __builtin_amdgcn_sched_barrier(0);
        SC_LD_C(1, F[0]);
        __builtin_amdgcn_sched_barrier(0);
#pragma unroll
        for (int mt = 0; mt < 4; ++mt) { f32x4 sacc = Sacc[mt] * last;
#pragma unroll
            for (int s2 = 0; s2 < 2; ++s2) sacc = __builtin_amdgcn_mfma_f32_16x16x32_bf16(F[1][2 * mt + s2], Ub[s2], sacc, 0, 0, 0);
            Sacc[mt] = sacc; }
        __builtin_amdgcn_sched_barrier(0);
#pragma unroll
        for (int mt = 4; mt < 8; ++mt) { f32x4 sacc = Sacc[mt] * last;
#pragma unroll
            for (int s2 = 0; s2 < 2; ++s2) sacc = __builtin_amdgcn_mfma_f32_16x16x32_bf16(F[0][2 * (mt - 4) + s2], Ub[s2], sacc, 0, 0, 0);
            Sacc[mt] = sacc; }
#undef SC_LD_A
#undef SC_LD_D
#undef SC_LD_C
        LAS float* rm = RMS + (c & 1) * 512;
#pragma unroll
        for (int m = 0; m < 4; ++m)
#pragma unroll
            for (int r = 0; r < 4; ++r) { const float v = sum16(o[m][r] * o[m][r]); if (fr == 0) rm[(16 * m + 4 * fq + r) * 8 + wave] = v; }
        if (c + 1 < NCH) { side_store(buf ^ 1);
#pragma unroll
            for (int m = 0; m < 4; ++m) u0p[m] = u0n[m];
            last = lastn; }
        __syncthreads();
        if (c + 2 < NCH) side_load(c + 2);
        {   LAS float* rsw = RMS + ((c + 1) & 1) * 512 + wave * 64;
            const f32x4 p0 = *(const LAS f32x4*)(rm + lane * 8), p1 = *(const LAS f32x4*)(rm + lane * 8 + 4);
            LAS bf16* zp[16]; bf16 zv[16];
#pragma unroll
            for (int m = 0; m < 4; ++m)
#pragma unroll
                for (int r = 0; r < 4; ++r) { zp[4 * m + r] = (LAS bf16*)(zt + swz256(16 * m + 4 * fq + r, 2 * wave + (fr >> 3))) + (fr & 7); zv[4 * m + r] = *zp[4 * m + r]; }
            rsw[lane] = rsqf((((p0.x + p0.y) + (p0.z + p0.w)) + ((p1.x + p1.y) + (p1.z + p1.w))) * (1.f / DH) + EPS);
            f32x4 rs[4];
#pragma unroll
            for (int m = 0; m < 4; ++m) rs[m] = *(const LAS f32x4*)(rsw + 16 * m + 4 * fq);
            __builtin_amdgcn_sched_barrier(0);
#pragma unroll
            for (int m = 0; m < 4; ++m)
#pragma unroll
                for (int r = 0; r < 4; ++r) *zp[4 * m + r] = (bf16)f2bf(o[m][r] * rs[m][r] * gh * bf1(zv[4 * m + r]));
        }
        __syncthreads();
        if (c + 2 < NCH) chunk_dma(c + 2);
#pragma unroll
        for (int k = 0; k < 2; ++k) { const int p = tid + 512 * k, i = p >> 4;
            if (i < nvalid) *(GAS v4u*)(ZS + (size_t)(b * TP + 64 * c + i) * DM + h * DH + 8 * (p & 15)) = *(const LAS v4u*)(zt + swz256(i, p & 15)); }
    }
    { float* so = a.out + O_PD + ((size_t)(b * NH + h) * DH) * DH + 16 * wave + fr;
#pragma unroll
      for (int mt = 0; mt < 8; ++mt)
#pragma unroll
          for (int r = 0; r < 4; ++r) so[(size_t)(16 * mt + 4 * fq + r) * DH] = Sacc[mt][r]; }
    __syncthreads();
}

static_assert(SC_END <= LDSCTL_OFF && 2 * IH_BYTES <= LDSCTL_OFF && RING_BYTES <= LDSCTL_OFF, "LDS map");
constexpr int NPHASES = 10;
__global__ void __launch_bounds__(NWAVES * 64, 2) fwd_kernel(Args args) {
    extern __shared__ __attribute__((aligned(16))) unsigned char lds_raw[];
    LAS unsigned char* lds = (LAS unsigned char*)lds_raw;
    volatile LAS unsigned* MISC = (volatile LAS unsigned*)(lds + MISC_OFF);
    const int tid = threadIdx.x, lane = tid & 63, wave = __builtin_amdgcn_readfirstlane(tid >> 6);
    const int G = gridDim.x, bx = blockIdx.x;
    const int vcu = (G % 8 == 0) ? (bx % 8) * (G / 8) + bx / 8 : bx;
    unsigned char* ws = args.ws;
    gu32* ctl = (gu32*)(ws + WS_CTL);
    for (int u = tid; u < (LDS_BYTES - LDSCTL_OFF) / 4; u += NWAVES * 64) ((LAS unsigned*)(lds + LDSCTL_OFF))[u] = 0u;
    __syncthreads();
    XcdBarrier bar; bar.bar = (unsigned*)(ctl + CW_BAR); bar.x = 0; bar.st = nullptr;
    const int lo = args.ph_lo, hi = args.ph_hi;
    if (hi - lo > 1) bar = xcd_barrier_post((unsigned*)(ctl + CW_BAR), MISC + 8);
#ifndef PH_MASK
#define PH_MASK 0x3ff
#endif
#define IN(k) (((PH_MASK >> (k)) & 1) && lo <= (k) && (k) < hi)
#ifndef PROBE_K
#define PROBE_K -1
#endif
#if PROBE_K >= 0
    volatile LAS unsigned long long* stamps = (volatile LAS unsigned long long*)(lds + MISC_OFF + 128);
    if (tid == 0) stamps[0] = __builtin_amdgcn_s_memrealtime();
#define SEAM(k) do { if (IN(k) && IN((k) + 1)) xcd_barrier(bar); if (tid == 0) stamps[(k) + 1] = __builtin_amdgcn_s_memrealtime(); } while (0)
#else
#define SEAM(k) do { if (IN(k) && IN((k) + 1)) xcd_barrier(bar); } while (0)
#endif
    bf16* WIN = (bf16*)(ws + WS_WIN); bf16* WC = (bf16*)(ws + WS_WC); bf16* WD = (bf16*)(ws + WS_WD); bf16* WO = (bf16*)(ws + WS_WO); bf16* WUP = (bf16*)(ws + WS_WUP); bf16* WDN = (bf16*)(ws + WS_WDN);
    bf16* H = (bf16*)(ws + WS_H); bf16* GLU = (bf16*)(ws + WS_GLU); bf16* QKVB = (bf16*)(ws + WS_QKVB); bf16* QS = (bf16*)(ws + WS_QS); bf16* ZS = (bf16*)(ws + WS_ZS);
    bf16* HALOQ = (bf16*)(ws + WS_HALOQ); bf16* HALOC = (bf16*)(ws + WS_HALOC);
    bf16* SGC = (bf16*)args.out; bf16* SGD = (bf16*)args.out + (size_t)M2 * DM;
    bf16* X1B = (bf16*)(ws + WS_X1B);
    bf16* MIX = (bf16*)(ws + WS_MIX); bf16* XG = (bf16*)(ws + WS_XG); bf16* HM = (bf16*)(ws + WS_HM); bf16* C = (bf16*)(ws + WS_C);
    float* BETAG = (float*)(ws + WS_BETAG);
    const int gw = vcu * NWAVES + wave, NGW = G * NWAVES;

    constexpr int KB1 = DM / 32, KB4 = DFF / 32, I_SQ = KB1 * (DM / 64), I_UP = KB1 * (DFF / 64), I_DN = KB4 * (DM / 64);
    constexpr int NU1 = (MP / 256) * (NIN / 256), NU4 = (MP / 256) * (DM / 256), NU7 = (M2 / 256) * (DFF / 256);
#define CONVERT_ITEMS(lo_, hi_, w0_, nw_) do { for (int it_ = (lo_) + (w0_); it_ < (hi_); it_ += (nw_)) { int r = it_; \
        if (r < I_SQ) { p0_transpose_item(args.in[12], DM, DM, WC, (r / KB1) * 64, (r / KB1) * 64, 64, (r % KB1) * 32, lane); continue; } r -= I_SQ; \
        if (r < I_SQ) { p0_transpose_item(args.in[17], DM, DM, WD, (r / KB1) * 64, (r / KB1) * 64, 64, (r % KB1) * 32, lane); continue; } r -= I_SQ; \
        if (r < I_SQ) { p0_transpose_item(args.in[18], DM, DM, WO, (r / KB1) * 64, (r / KB1) * 64, 64, (r % KB1) * 32, lane); continue; } r -= I_SQ; \
        if (r < I_UP) { p0_transpose_item(args.in[20], DFF, DM, WUP, (r / KB1) * 64, (r / KB1) * 64, 64, (r % KB1) * 32, lane); continue; } r -= I_UP; \
        p0_transpose_item(args.in[21], DM, DFF, WDN, (r / KB4) * 64, (r / KB4) * 64, 64, (r % KB4) * 32, lane); } } while (0)
    if (IN(0)) {
        constexpr int I_IN = KB1 * (NIN / 64);
        for (int it = gw; it < I_IN; it += NGW) { const int nb = it / KB1, kb = it % KB1; int src, nv; win_src(nb, src, nv); p0_transpose_item(args.in[7], DIN, DM, WIN, nb * 64, src, nv, kb * 32, lane); }
        for (int m0 = gw; m0 < MP; m0 += 2 * NGW) {
            const float* src[2]; bool ok[2]; f32x4 v[2][4];
#pragma unroll
            for (int q = 0; q < 2; ++q) { const int m = m0 + q * NGW; ok[q] = m < MR; const int mm = ok[q] ? m : 0;
                if (mm >= RP) src[q] = args.in[1] + (size_t)(mm - RP) * DM;
                else { const int b = mm / TP, t = mm - b * TP; src[q] = t < NMETA ? args.in[5] + (size_t)t * DM : args.in[0] + ((size_t)b * SEQ + (t - NMETA)) * DM; }
#pragma unroll
                for (int j = 0; j < 4; ++j) v[q][j] = ((const GAS f32x4*)src[q])[lane + 64 * j]; }
#pragma unroll
            for (int q = 0; q < 2; ++q) { const int m = m0 + q * NGW; if (m >= MP) continue;
                float ss = 0.f;
#pragma unroll
                for (int j = 0; j < 4; ++j) ss += (v[q][j].x * v[q][j].x + v[q][j].y * v[q][j].y) + (v[q][j].z * v[q][j].z + v[q][j].w * v[q][j].w);
                const float rstd = ok[q] ? rsqf(wave_sum(ss) * (1.f / DM) + EPS) : 0.f;
                GAS v2u* o8 = (GAS v2u*)(H + (size_t)m * DM) + lane;
#pragma unroll
                for (int j = 0; j < 4; ++j) { const f32x4 g = ((const GAS f32x4*)args.in[6])[lane + 64 * j]; v2u o; o.x = cvtpk(v[q][j].x * rstd * g.x, v[q][j].y * rstd * g.y); o.y = cvtpk(v[q][j].z * rstd * g.z, v[q][j].w * rstd * g.w); o8[64 * j] = o; } }
        }
    }
    SEAM(0);
    if (IN(1)) {
        pg8::Gemm g{H, WIN, MP, NIN, DM}; pg8::StaticOrder S; S.init(MP, NIN, G, bx, DM);
        EpiIn E{GLU, QKVB, QS, HALOQ, HALOC, ZS, SGC, SGD, BETAG, args.in[14], args.in[15]};
        pg8::gemm_phase<EpiIn, pg8::StaticOrder, true, true>(lds + RING_OFF, g, S, E);
        if (G == 256) { if (bx >= NU1 % 256) CONVERT_ITEMS(0, 2 * I_SQ, (bx - NU1 % 256) * NWAVES + wave, (256 - NU1 % 256) * NWAVES); }
        else CONVERT_ITEMS(0, 3 * I_SQ + I_UP + I_DN, gw, NGW);
    }
    SEAM(1);
    if (IN(2)) {
        constexpr int N_CP = BP * NRUN, N_IP = BP * NCH * NH / 2, N_SD = BS * NH / 4, N_CS = BS, N_ITEMS = N_CP + N_IP + N_SD + N_CS;
        volatile LAS int* qslot = (volatile LAS int*)(lds + MISC_OFF + 64);
#if PROBE_K >= 0
        for (int sub = 0; sub < 3; ++sub) {
            const int lo_i = sub == 0 ? 0 : (sub == 1 ? N_CP : N_CP + N_IP), hi_i = sub == 0 ? N_CP : (sub == 1 ? N_CP + N_IP : N_CP + N_IP + N_SD);
            for (;;) {
                if (tid == 0) *qslot = (int)__hip_atomic_fetch_add((unsigned*)(ctl + 2048 + 64 * sub), 1u, __ATOMIC_RELAXED, __HIP_MEMORY_SCOPE_AGENT);
                __syncthreads();
                int it = *qslot + lo_i;
                __syncthreads();
                if (sub == 0 && it >= N_CP) { it += N_IP + N_SD; if (it >= N_ITEMS) break; conv_unit<1>(args, lds, it - (N_CP + N_IP + N_SD), 0); continue; }
                if (it >= hi_i) break;
                if (it < N_CP) { conv_unit<0>(args, lds, it / NRUN, it % NRUN); continue; } it -= N_CP;
                if (it < N_IP) { intra_pair(args, lds, it); continue; } it -= N_IP;
                (void)it;
            }
            if (sub < 2) { xcd_barrier(bar); if (tid == 0) stamps[12 + sub] = __builtin_amdgcn_s_memrealtime(); }
        }
#else
        for (;;) {
            if (tid == 0) *qslot = (int)__hip_atomic_fetch_add((unsigned*)(ctl + 2048), 1u, __ATOMIC_RELAXED, __HIP_MEMORY_SCOPE_AGENT);
            __syncthreads();
            int it = *qslot;
            __syncthreads();
            if (it >= N_CP + N_IP) it += N_SD;
            if (it >= N_ITEMS) break;
            if (it < N_CP) { conv_unit<0>(args, lds, it / NRUN, it % NRUN); continue; } it -= N_CP;
            if (it < N_IP) { intra_pair(args, lds, it); continue; } it -= N_IP;
            it -= N_SD; if (it < 0) continue;
            conv_unit<1>(args, lds, it, 0);
        }
#endif
    }
    SEAM(2);
    if (IN(3)) {
        if (bx < BP * NH) { scan_chain(args, lds, bx);
#if PROBE_K >= 0
            if (tid == 0) stamps[14] = __builtin_amdgcn_s_memrealtime();
#endif
        }
#if defined(PROBE_SCAN_ALONE)
        xcd_barrier(bar);
        if (bx < BP * NH) {}
#endif
        else {
            pg8::Gemm g{C, WC, MP, DM, DM}; pg8::StaticOrder S; S.init(MP, DM, G - BP * NH, bx - BP * NH, DM);
            EpiGate<0> E{SGC, nullptr, SGC};
            pg8::gemm_phase<EpiGate<0>, pg8::StaticOrder, true, true>(lds + RING_OFF, g, S, E);
            volatile LAS int* qslot = (volatile LAS int*)(lds + MISC_OFF + 64);
            for (;;) {
                if (tid == 0) *qslot = (int)__hip_atomic_fetch_add((unsigned*)(ctl + 2048 + 256), 1u, __ATOMIC_RELAXED, __HIP_MEMORY_SCOPE_AGENT);
                __syncthreads();
                const int it = *qslot;
                __syncthreads();
                if (it >= BS * NH / 4) break;
                delta_item(args, lds, it);
            }
        }
    }
    SEAM(3);
    if (IN(4)) {
        pg8::Gemm g{ZS, WD, MP, DM, DM}; pg8::StaticOrder S; S.init(MP, DM, G, bx, DM);
        EpiGate<1> E{SGD, SGC, MIX};
        pg8::gemm_phase<EpiGate<1>, pg8::StaticOrder, true, true>(lds + RING_OFF, g, S, E);
        if (G == 256 && bx >= NU4 % 256) CONVERT_ITEMS(2 * I_SQ, 3 * I_SQ + I_UP, (bx - NU4 % 256) * NWAVES + wave, (256 - NU4 % 256) * NWAVES);
    }
    SEAM(4);
    if (IN(5)) {
        pg8::Gemm g{MIX, WO, M2, DM, DM}; pg8::SplitOrder S; S.init(BP * SEQ, M2, DM, G, bx, DM, KSPLIT5);
        EpiWoP E; E.xp = args.in[0]; E.X1B = X1B; E.parts = (float*)(ws + WS_PART5);
        pg8::gemm_phase<EpiWoP, pg8::SplitOrder, true, true>(lds + RING_OFF, g, S, E);
    }
    SEAM(5);
    if (IN(6)) {
        for (int i = gw; i < M2; i += NGW) { const int m = i < RS ? BP * SEQ + i : i - RS;
            const GAS f32x4* gr = (const GAS f32x4*)args.in[19] + lane;
            f32x4 v[4]; float ss = 0.f;
            if (m >= BP * SEQ) {
                const GAS f32x4* x0 = (const GAS f32x4*)(args.in[1] + (size_t)(m - BP * SEQ) * DM) + lane;
                const GAS f32x4* pr = (const GAS f32x4*)((const float*)(ws + WS_PART5) + (size_t)(m - BP * SEQ) * DM) + lane;
                GAS v2u* xb = (GAS v2u*)(X1B + (size_t)m * DM) + lane;
#pragma unroll
                for (int jj = 0; jj < 4; ++jj) { v[jj] = x0[64 * jj];
#pragma unroll
                    for (int ks = 0; ks < KSPLIT5; ++ks) v[jj] += pr[(size_t)ks * RS * DM / 4 + 64 * jj];
                    v2u o; o.x = cvtpk(v[jj].x, v[jj].y); o.y = cvtpk(v[jj].z, v[jj].w); xb[64 * jj] = o;
                    v[jj] = (f32x4){bflo(o.x), bfhi(o.x), bflo(o.y), bfhi(o.y)}; }
            } else { const GAS v2u* xb = (const GAS v2u*)(X1B + (size_t)m * DM) + lane;
#pragma unroll
                for (int jj = 0; jj < 4; ++jj) { const v2u o = xb[64 * jj]; v[jj] = (f32x4){bflo(o.x), bfhi(o.x), bflo(o.y), bfhi(o.y)}; } }
#pragma unroll
            for (int jj = 0; jj < 4; ++jj) ss += (v[jj].x * v[jj].x + v[jj].y * v[jj].y) + (v[jj].z * v[jj].z + v[jj].w * v[jj].w);
            const float rstd = rsqf(wave_sum(ss) * (1.f / DM) + EPS);
            GAS v2u* o8 = (GAS v2u*)(XG + (size_t)m * DM) + lane;
#pragma unroll
            for (int jj = 0; jj < 4; ++jj) { const f32x4 g = gr[64 * jj]; v2u o; o.x = cvtpk(v[jj].x * rstd * g.x, v[jj].y * rstd * g.y); o.y = cvtpk(v[jj].z * rstd * g.z, v[jj].w * rstd * g.w); o8[64 * jj] = o; }
        }
    }
    SEAM(6);
    if (IN(7)) {
        pg8::Gemm g{XG, WUP, M2, DFF, DM}; pg8::StaticOrder S; S.init(M2, DFF, G, bx, DM);
        EpiUp E{HM};
        pg8::gemm_phase<EpiUp, pg8::StaticOrder, true, true>(lds + RING_OFF, g, S, E);
        if (G == 256 && bx >= NU7 % 256) CONVERT_ITEMS(3 * I_SQ + I_UP, 3 * I_SQ + I_UP + I_DN, (bx - NU7 % 256) * NWAVES + wave, (256 - NU7 % 256) * NWAVES);
    }
    SEAM(7);
    if (IN(8)) {
        pg8::Gemm g{HM, WDN, M2, DM, DFF}; pg8::SplitOrder S; S.init(BP * SEQ, M2, DM, G, bx, DFF, KSPLIT);
        EpiRes<1> E{nullptr, nullptr, args.out, (float*)(ws + WS_PART), X1B};
        pg8::gemm_phase<EpiRes<1>, pg8::SplitOrder, true, true>(lds + RING_OFF, g, S, E);
    }
    SEAM(8);
    if (IN(9)) {
        for (int i = gw; i < M2; i += NGW) { const int m = i < RS ? BP * SEQ + i : i - RS;
            float* xrow = args.out + (size_t)m * DM;
            GAS f32x4* xr = (GAS f32x4*)xrow + lane; const GAS f32x4* gr = (const GAS f32x4*)args.in[22] + lane;
            f32x4 v[4]; float s = 0.f;
#pragma unroll
            for (int jj = 0; jj < 4; ++jj) v[jj] = xr[64 * jj];
            if (m >= BP * SEQ) { const GAS v2u* xb = (const GAS v2u*)(X1B + (size_t)m * DM) + lane;
#pragma unroll
                for (int jj = 0; jj < 4; ++jj) { const v2u o = xb[64 * jj]; v[jj] = (f32x4){bflo(o.x), bfhi(o.x), bflo(o.y), bfhi(o.y)}; } }
            if (m >= BP * SEQ) { const GAS f32x4* pr = (const GAS f32x4*)((const float*)(ws + WS_PART) + (size_t)(m - BP * SEQ) * DM) + lane;
#pragma unroll 4
                for (int ks = 0; ks < KSPLIT; ++ks)
#pragma unroll
                    for (int jj = 0; jj < 4; ++jj) v[jj] += pr[(size_t)ks * RS * DM / 4 + 64 * jj]; }
#pragma unroll
            for (int jj = 0; jj < 4; ++jj) s += (v[jj].x * v[jj].x + v[jj].y * v[jj].y) + (v[jj].z * v[jj].z + v[jj].w * v[jj].w);
            const float rstd = 1.f / sqrtf(wave_sum(s) * (1.f / DM) + EPS);
#pragma unroll
            for (int jj = 0; jj < 4; ++jj) xr[64 * jj] = v[jj] * rstd * gr[64 * jj];
        }
    }
#if PROBE_K >= 0
    __syncthreads();
    if (bx == 0) { if (tid == 0) stamps[NPHASES] = __builtin_amdgcn_s_memrealtime(); __syncthreads();
        const float dt_us = (float)(stamps[PROBE_B] - stamps[PROBE_K]) * 0.01f; const float f = 1.f + dt_us * (1.f / (float)(PROBE_DIV));
        for (int i = tid; i < BP * 3 * DQKV; i += NWAVES * 64) args.out[O_PQ + i] *= f; }
#endif
#undef IN
#undef SEAM
}

extern "C" void kernel_launch(void* const* d_in, const int* in_sizes, int n_in, void* d_out, int out_size, void* d_ws, size_t ws_size, hipStream_t stream) {
    static int grid = 0;
    if (grid == 0) {
        if (n_in != 23 || (size_t)out_size != O_END || ws_size < WS_END) { fprintf(stderr, "kernel_launch: unexpected shapes n_in %d out %d ws %zu\n", n_in, out_size, ws_size); grid = -1; return; }
        int dev = 0, cus = 0, per_cu = 0;
        if (hipGetDevice(&dev) != hipSuccess || hipDeviceGetAttribute(&cus, hipDeviceAttributeMultiprocessorCount, dev) != hipSuccess) { grid = -1; return; }
        if (hipFuncSetAttribute((const void*)fwd_kernel, hipFuncAttributeMaxDynamicSharedMemorySize, LDS_BYTES) != hipSuccess) { fprintf(stderr, "kernel_launch: hipFuncSetAttribute failed\n"); grid = -1; return; }
        if (hipOccupancyMaxActiveBlocksPerMultiprocessor(&per_cu, (const void*)fwd_kernel, NWAVES * 64, LDS_BYTES) != hipSuccess || per_cu < 1)
            fprintf(stderr, "kernel_launch: occupancy query reports %d\n", per_cu);
        (void)hipGetLastError();
        grid = cus;
    }
    if (grid < 0) return;
    if (hipMemsetAsync((char*)d_ws + WS_CTL, 0, CTL_ZERO_BYTES, stream) != hipSuccess) return;
    Args a{};
    for (int i = 0; i < 23; ++i) a.in[i] = (const float*)d_in[i];
    a.out = (float*)d_out; a.ws = (unsigned char*)d_ws;
#if MK_N_LAUNCHES == 1
    a.ph_lo = 0; a.ph_hi = NPHASES;
    hipLaunchKernelGGL(fwd_kernel, dim3(grid), dim3(NWAVES * 64), LDS_BYTES, stream, a);
#else
    for (int p = 0; p < NPHASES; ++p) { a.ph_lo = p; a.ph_hi = p + 1; hipLaunchKernelGGL(fwd_kernel, dim3(grid), dim3(NWAVES * 64), LDS_BYTES, stream, a); }
#endif
}
```

```cpp
#include <hip/hip_runtime.h>
#include <cstdio>
#include <cstdint>

#ifndef MK_N_LAUNCHES
#define MK_N_LAUNCHES 1
#endif

namespace pg8 {
#define PG8_LAS __attribute__((address_space(3)))
typedef unsigned short bf16_t;
typedef short bf16x8 __attribute__((ext_vector_type(8)));
typedef float f32x4 __attribute__((ext_vector_type(4)));
typedef unsigned u32x4 __attribute__((ext_vector_type(4)));
constexpr int BM = 256, BK = 64, HALF = 128, HTB = HALF * BK * 2, STAGE_BYTES = 8 * HTB, NXCD = 8, WGM = 8;

__host__ __device__ __forceinline__ int lds_byte(int r, int c) { const int st = (r >> 4) * 2 + (c >> 5), rr = r & 15, cc = c & 31, ob = rr * 64 + cc * 2; return st * 1024 + (ob ^ (((ob >> 9) & 1) << 5)); }
__host__ __device__ __forceinline__ void stage_rc(int b, int& R, int& C) { const int st = b / 1024, sb = b % 1024, swz = sb ^ (((sb >> 9) & 1) << 5); R = (st >> 1) * 16 + swz / 64; C = (st & 1) * 32 + (swz % 64) / 2; }
__host__ __device__ __forceinline__ int perm32(int rho) { const int n = rho >> 4, i = rho & 15; return 8 * (i >> 2) + 4 * n + (i & 3); }

struct Unit { int pm, pn, k0, nt, typ; };
struct Gemm { const bf16_t* A; const bf16_t* Bt; int M, N, K;
    __device__ __forceinline__ const char* a(const Unit&) const { return (const char*)A; } __device__ __forceinline__ const char* b(const Unit&) const { return (const char*)Bt; } };
struct Gemm2 { const bf16_t *A0, *B0, *A1, *B1; int K;
    __device__ __forceinline__ const char* a(const Unit& u) const { return (const char*)(u.typ ? A1 : A0); } __device__ __forceinline__ const char* b(const Unit& u) const { return (const char*)(u.typ ? B1 : B0); } };

struct StaticOrder {
    int nM, nN, nwg, G, c, nt;
    __host__ __device__ void init(int M, int N, int G_, int c_, int K) { nM = M / BM; nN = N / BM; nwg = nM * nN; G = G_; c = c_; nt = K / BK; }
    __host__ __device__ __forceinline__ bool next(int i, Unit& u) const {
        const long L = (long)i * G + c; if (L >= nwg) return false;
        u.k0 = 0; u.nt = nt; u.typ = 0;
        int wgid = (int)L; { const int q = nwg / NXCD, r = nwg % NXCD, xcd = wgid % NXCD, off = wgid / NXCD; wgid = (xcd < r ? xcd * (q + 1) : r * (q + 1) + (xcd - r) * q) + off; }
        const int nig = WGM * nN, gid = wgid / nig, fm = gid * WGM, gsz = (nM - fm) < WGM ? (nM - fm) : WGM;
        u.pm = fm + ((wgid % nig) % gsz); u.pn = (wgid % nig) / gsz; return true;
    }
    __device__ __forceinline__ void a_ready(const Unit&) const {}
    __device__ __forceinline__ void done(const Unit&) const {}
};

struct SplitOrder {
    int nM, nN, nwg, G, c, ntfull, nsub, KS, ntsub;
    __host__ __device__ void init(int Mmain, int Mall, int N, int G_, int c_, int K, int KS_) { nM = Mmain / BM; nN = N / BM; nwg = nM * nN; G = G_; c = c_; ntfull = K / BK; KS = KS_; ntsub = K / BK / KS_; nsub = (Mall / BM - nM) * nN * KS_; }
    __host__ __device__ __forceinline__ bool next(int i, Unit& u) const {
        const long L = (long)i * G + c; if (L >= nwg + nsub) return false;
        int pm, pn, k0, ntu;
        if (L < nwg) {
            int wgid = (int)L; { const int q = nwg / NXCD, r = nwg % NXCD, xcd = wgid % NXCD, off = wgid / NXCD; wgid = (xcd < r ? xcd * (q + 1) : r * (q + 1) + (xcd - r) * q) + off; }
            const int nig = WGM * nN, gid = wgid / nig, fm = gid * WGM, gsz = (nM - fm) < WGM ? (nM - fm) : WGM;
            pm = fm + ((wgid % nig) % gsz); pn = (wgid % nig) / gsz; k0 = 0; ntu = ntfull;
        } else { const int j = (int)L - nwg, tile = j / KS, ks = j % KS; pm = nM + tile / nN; pn = tile % nN; k0 = ks * ntsub; ntu = ntsub; }
        u.pm = pm; u.pn = pn; u.k0 = k0; u.nt = ntu; u.typ = 0; return true;
    }
    __device__ __forceinline__ void a_ready(const Unit&) const {}
    __device__ __forceinline__ void done(const Unit&) const {}
};

__device__ __forceinline__ unsigned cvt_pk_bf16(float lo, float hi) { unsigned r; asm volatile("v_cvt_pk_bf16_f32 %0, %1, %2" : "=v"(r) : "v"(lo), "v"(hi)); return r; }

template <class Epi, class Sched, bool ALIGN_EPI = false, bool SP2 = false, class GemmT = Gemm>
__device__ __forceinline__ void gemm_phase(PG8_LAS unsigned char* lds, const GemmT g, const Sched& S, const Epi& E) {
    const int tid = threadIdx.x, wid = __builtin_amdgcn_readfirstlane(tid >> 6), lane = tid & 63, wr = wid >> 2, wc = wid & 3, fr = lane & 15, fq = lane >> 4;
    const int K = g.K;
    unsigned voffA[2], voffB[2];
#pragma unroll
    for (int i = 0; i < 2; ++i) { int R, C; stage_rc(tid * 16 + i * 8192, R, C); const int Rb = Epi::PERM ? ((R & ~31) + perm32(R & 31)) : R;
        voffA[i] = (unsigned)(R * K + C) * 2u; voffB[i] = (unsigned)(Rb * K + C) * 2u; }
    const size_t kstep = (size_t)(BK * 2);
    const size_t hstep = (size_t)HALF * K * 2;
    const size_t tstep = 2 * hstep;
    const unsigned ldsw = (unsigned)wid * 1024u;
    const int aoff = lds_byte(wr * 64 + fr, fq * 8), boff = lds_byte(wc * 32 + fr, fq * 8);
#define PG8_SA(b, h) (((b) * 2 + (h)) * HTB)
#define PG8_SB(b, h) ((4 + (b) * 2 + (h)) * HTB)
#define PG8_STAGE(bufoff, gbase, voff) do { _Pragma("unroll") for (int _i = 0; _i < 2; ++_i) \
        __builtin_amdgcn_global_load_lds((const unsigned*)((const char*)(gbase) + (voff)[_i]), (PG8_LAS unsigned*)(lds + (bufoff) + ldsw + _i * 8192), 16, 0, 0); } while (0)
#define PG8_LDA(dst, b, h) do { _Pragma("unroll") for (int m = 0; m < 4; ++m) _Pragma("unroll") for (int k = 0; k < 2; ++k) dst[m][k] = *(const PG8_LAS bf16x8*)(lds + PG8_SA(b, h) + aoff + m * 2048 + k * 1024); } while (0)
#define PG8_LDB(dst, b, h) do { _Pragma("unroll") for (int n = 0; n < 2; ++n) _Pragma("unroll") for (int k = 0; k < 2; ++k) dst[n][k] = *(const PG8_LAS bf16x8*)(lds + PG8_SB(b, h) + boff + n * 2048 + k * 1024); } while (0)
#define PG8_MMA(ai, bj, At, Bt) do { __builtin_amdgcn_s_setprio(1); _Pragma("unroll") for (int m = 0; m < 4; ++m) _Pragma("unroll") for (int n = 0; n < 2; ++n) _Pragma("unroll") for (int k = 0; k < 2; ++k) \
        acc[ai][bj][m][n] = __builtin_amdgcn_mfma_f32_16x16x32_bf16(Bt[n][k], At[m][k], acc[ai][bj][m][n], 0, 0, 0); __builtin_amdgcn_s_setprio(0); } while (0)
#define PG8_WAIT_V(n) asm volatile("s_waitcnt vmcnt(" #n ")" ::: "memory")
#define PG8_WAIT_L(n) asm volatile("s_waitcnt lgkmcnt(" #n ")" ::: "memory")
#define PG8_BAR __builtin_amdgcn_s_barrier()
#define PG8_SCHED __builtin_amdgcn_sched_barrier(0)
    Unit cur, nxt; int ui = 0;
    if (!S.next(0, cur)) return;
    f32x4 acc[2][2][4][2];
#pragma unroll
    for (int a = 0; a < 2; ++a)
#pragma unroll
        for (int b = 0; b < 2; ++b)
#pragma unroll
            for (int m = 0; m < 4; ++m)
#pragma unroll
                for (int n = 0; n < 2; ++n) acc[a][b][m][n] = (f32x4){0.f, 0.f, 0.f, 0.f};
    bf16x8 At[4][2], B0[2][2], B1[2][2];
    const char* cA = g.a(cur) + (size_t)cur.pm * tstep + (size_t)cur.k0 * kstep; const char* cB = g.b(cur) + (size_t)cur.pn * tstep + (size_t)cur.k0 * kstep;
    S.a_ready(cur);
    if constexpr (SP2) {
        PG8_STAGE(PG8_SB(0, 0), cB, voffB); PG8_STAGE(PG8_SB(0, 1), cB + hstep, voffB); PG8_STAGE(PG8_SA(0, 0), cA, voffA); PG8_STAGE(PG8_SA(0, 1), cA + hstep, voffA);
        if (wr == 1) PG8_BAR;
        PG8_WAIT_V(2); PG8_BAR;
        PG8_STAGE(PG8_SB(1, 0), cB + kstep, voffB); PG8_STAGE(PG8_SA(1, 0), cA + kstep, voffA); PG8_STAGE(PG8_SB(1, 1), cB + hstep + kstep, voffB);
        PG8_WAIT_V(6); PG8_BAR;
    } else {
        PG8_STAGE(PG8_SB(0, 0), cB, voffB); PG8_STAGE(PG8_SA(0, 0), cA, voffA); PG8_STAGE(PG8_SB(0, 1), cB + hstep, voffB); PG8_STAGE(PG8_SA(0, 1), cA + hstep, voffA);
        if (wr == 1) PG8_BAR;
        PG8_WAIT_V(4); PG8_BAR;
        PG8_STAGE(PG8_SB(1, 0), cB + kstep, voffB); PG8_STAGE(PG8_SA(1, 0), cA + kstep, voffA); PG8_STAGE(PG8_SB(1, 1), cB + hstep + kstep, voffB);
        PG8_WAIT_V(6); PG8_BAR;
    }
    for (;;) {
        const bool has_next = S.next(ui + 1, nxt);
        const char* nA = has_next ? g.a(nxt) + (size_t)nxt.pm * tstep + (size_t)nxt.k0 * kstep : cA; const char* nB = has_next ? g.b(nxt) + (size_t)nxt.pn * tstep + (size_t)nxt.k0 * kstep : cB;
        const int nt = cur.nt;
        for (int t = 0; t < nt; t += 2) {
            const bool last = (t == nt - 2);
            const char* a1 = cA + (size_t)(t + 1) * kstep;
            const char* a2 = last ? nA : cA + (size_t)(t + 2) * kstep; const char* b2 = last ? nB : cB + (size_t)(t + 2) * kstep;
            const char* a3 = a2 + kstep; const char* b3 = b2 + kstep;
            if (last && has_next) S.a_ready(nxt);
            if constexpr (SP2) {
            PG8_LDB(B0, 0, 0); PG8_LDB(B1, 0, 1); PG8_SCHED; PG8_LDA(At, 0, 0); PG8_STAGE(PG8_SA(1, 1), a1 + hstep, voffA);
            PG8_WAIT_V(8); PG8_WAIT_L(0); PG8_BAR; PG8_MMA(0, 0, At, B0); PG8_MMA(0, 1, At, B1); PG8_BAR; PG8_SCHED;
            PG8_LDA(At, 0, 1); PG8_STAGE(PG8_SB(0, 0), b2, voffB); PG8_STAGE(PG8_SB(0, 1), b2 + hstep, voffB); PG8_STAGE(PG8_SA(0, 0), a2, voffA);
            PG8_WAIT_V(8); PG8_WAIT_L(0); PG8_BAR; PG8_MMA(1, 0, At, B0); PG8_MMA(1, 1, At, B1); PG8_BAR; PG8_SCHED;
            PG8_LDB(B0, 1, 0); PG8_LDB(B1, 1, 1); PG8_SCHED; PG8_LDA(At, 1, 0); PG8_STAGE(PG8_SA(0, 1), a2 + hstep, voffA);
            PG8_WAIT_V(8); PG8_WAIT_L(0); PG8_BAR; PG8_MMA(0, 0, At, B0); PG8_MMA(0, 1, At, B1); PG8_BAR; PG8_SCHED;
            PG8_LDA(At, 1, 1); PG8_STAGE(PG8_SB(1, 0), b3, voffB); PG8_STAGE(PG8_SB(1, 1), b3 + hstep, voffB); PG8_STAGE(PG8_SA(1, 0), a3, voffA);
            PG8_WAIT_V(8); PG8_WAIT_L(0); PG8_BAR; PG8_MMA(1, 0, At, B0); PG8_MMA(1, 1, At, B1); PG8_BAR; PG8_SCHED;
            } else {
            PG8_LDB(B0, 0, 0); PG8_SCHED; PG8_LDA(At, 0, 0); PG8_STAGE(PG8_SA(1, 1), a1 + hstep, voffA);
            PG8_WAIT_L(8); PG8_BAR; PG8_WAIT_L(0); PG8_MMA(0, 0, At, B0); PG8_BAR; PG8_SCHED;
            PG8_LDB(B1, 0, 1); PG8_STAGE(PG8_SB(0, 0), b2, voffB);
            PG8_BAR; PG8_WAIT_L(0); PG8_MMA(0, 1, At, B1); PG8_BAR;
            PG8_LDA(At, 0, 1); PG8_STAGE(PG8_SA(0, 0), a2, voffA);
            PG8_BAR; PG8_WAIT_L(0); PG8_MMA(1, 0, At, B0); PG8_BAR; PG8_SCHED;
            PG8_STAGE(PG8_SB(0, 1), b2 + hstep, voffB);
            PG8_WAIT_V(6); PG8_BAR; PG8_MMA(1, 1, At, B1); PG8_BAR;
            PG8_LDB(B0, 1, 0); PG8_SCHED; PG8_LDA(At, 1, 0); PG8_STAGE(PG8_SA(0, 1), a2 + hstep, voffA);
            PG8_WAIT_L(8); PG8_BAR; PG8_WAIT_L(0); PG8_MMA(0, 0, At, B0); PG8_BAR; PG8_SCHED;
            PG8_LDB(B1, 1, 1); PG8_STAGE(PG8_SB(1, 0), b3, voffB);
            PG8_BAR; PG8_WAIT_L(0); PG8_MMA(0, 1, At, B1); PG8_BAR;
            PG8_LDA(At, 1, 1); PG8_STAGE(PG8_SA(1, 0), a3, voffA);
            PG8_BAR; PG8_WAIT_L(0); PG8_MMA(1, 0, At, B0); PG8_BAR; PG8_SCHED;
            PG8_STAGE(PG8_SB(1, 1), b3 + hstep, voffB);
            PG8_WAIT_V(6); PG8_BAR; PG8_MMA(1, 1, At, B1); PG8_BAR;
            }
        }
        if constexpr (ALIGN_EPI) { if (wr == 0) PG8_BAR; }
        E(acc, cur, wr, wc, fr, fq); S.done(cur);
        if (!has_next) break;
#pragma unroll
        for (int a = 0; a < 2; ++a)
#pragma unroll
            for (int b = 0; b < 2; ++b)
#pragma unroll
                for (int m = 0; m < 4; ++m)
#pragma unroll
                    for (int n = 0; n < 2; ++n) acc[a][b][m][n] = (f32x4){0.f, 0.f, 0.f, 0.f};
        cur = nxt; cA = nA; cB = nB; ++ui;
        if constexpr (ALIGN_EPI) { if (wr == 1) PG8_BAR; }
    }
    PG8_WAIT_V(0);
    if constexpr (!ALIGN_EPI) { if (wr == 0) PG8_BAR; }
    PG8_BAR;
#undef PG8_SA
#undef PG8_SB
#undef PG8_STAGE
#undef PG8_LDA
#undef PG8_LDB
#undef PG8_MMA
#undef PG8_WAIT_V
#undef PG8_WAIT_L
#undef PG8_BAR
#undef PG8_SCHED
}
}

constexpr int NWAVES = 8;
constexpr int DM = 1024, BP = 8, SEQ = 2048, NMETA = 16, TP = SEQ + NMETA, BS = 128, TS = 4;
constexpr int RP = BP * TP;
constexpr int RS = BS * TS;
constexpr int MR = RP + RS;
constexpr int MP = 17152;
constexpr int M2 = BP * SEQ + RS;
constexpr int NH = 8, DH = 128, DQKV = 3072, DFF = 4096, KC = 31, KS = 4;
constexpr int NIN = 8448;
constexpr int DIN = 8208;
constexpr float EPS = 1e-6f;

constexpr size_t O_YP = 0, O_YS = 16777216, O_PC = 17301504, O_PQ = 17547264, O_PD = 17620992, O_SC = 18669568, O_SQ = 22601728, O_SD = 23781376, O_END = 40558592;

constexpr size_t MiB = 1u << 20;
constexpr size_t WS_CTL = 0, CTL_ZERO_BYTES = 1 * MiB;
constexpr size_t WS_BETAG = 1 * MiB;
constexpr size_t WS_LASTV = 9 * MiB / 4;
constexpr size_t WS_HALOQ = 5 * MiB / 2;
constexpr size_t WS_WC = 29 * MiB / 4, WS_WD = WS_WC + 2 * MiB, WS_WO = WS_WD + 2 * MiB, WS_WUP = WS_WO + 2 * MiB, WS_WDN = WS_WUP + 8 * MiB;
constexpr size_t WS_GLU = 117 * MiB / 4;
constexpr size_t WS_QKVB = 63 * MiB;
constexpr size_t WS_QS = 162 * MiB;
constexpr size_t WS_ZS = 165 * MiB;
constexpr size_t WS_H = 397 * MiB / 2;
constexpr size_t WS_WIN = 232 * MiB;
constexpr size_t WS_HALOC = 497 * MiB / 2;
constexpr size_t WS_KDT = WS_H, WS_ATTN = 463 * MiB / 2;
constexpr size_t WS_MIX = WS_QKVB, WS_XG = WS_GLU, WS_HM = WS_QKVB, WS_C = WS_GLU;
constexpr int KSPLIT5 = 4; constexpr size_t WS_PART5 = 232 * MiB;
constexpr size_t WS_X1B = WS_H;
constexpr int CW_READY = 8192;
constexpr int KSPLIT = 16;
constexpr size_t WS_PART = WS_XG;
static_assert(WS_PART + (size_t)KSPLIT * RS * DM * 4 <= WS_QKVB, "ws map part");
constexpr size_t WS_END = 256 * MiB;
constexpr int NRUN = 16, RUNL = TP / NRUN;
static_assert(TP - 64 * 32 == 16 && NRUN * RUNL == TP && WS_HALOC + (size_t)BP * NRUN * 30 * DM * 2 <= WS_END, "conv runs");
constexpr int NCH = 33, QBLK = 3 * 64 * 128;
static_assert(WS_WIN + (size_t)NIN * DM * 2 <= WS_HALOC && WS_WDN + 8 * MiB <= WS_GLU && WS_GLU + (size_t)MP * DM * 2 <= WS_QKVB && WS_HALOQ + (size_t)BP * 33 * 3 * 3072 * 2 <= WS_WC, "ws map");
static_assert(WS_ZS + (size_t)MP * DM * 2 <= WS_H && WS_H + (size_t)MP * DM * 2 <= WS_WIN, "ws map 2");
static_assert(WS_QKVB + (size_t)BP * NCH * NH * QBLK * 2 <= WS_QS, "ws map qkvb");
static_assert(WS_HM + (size_t)M2 * DFF * 2 <= WS_H, "ws map hm");
static_assert(WS_KDT + (size_t)BP * NCH * NH * 8192 * 2 <= WS_ATTN && WS_ATTN + (size_t)BP * NCH * NH * 4096 * 2 <= WS_HALOC, "ws map kdt");
constexpr int CW_TMO = 0, CW_CODE = 1, CW_BAR = 4096;

constexpr int RING_OFF = 0, RING_BYTES = 131072;
constexpr int LDSCTL_OFF = 151552, MISC_OFF = LDSCTL_OFF + 320;
constexpr int LDS_BYTES = LDSCTL_OFF + 1024;

#define GAS __attribute__((address_space(1)))
#define LAS __attribute__((address_space(3)))
typedef unsigned short bf16;
typedef unsigned v4u __attribute__((ext_vector_type(4)));
typedef unsigned v2u __attribute__((ext_vector_type(2)));
typedef float f32x4 __attribute__((ext_vector_type(4)));
typedef float f32x2 __attribute__((ext_vector_type(2)));
typedef GAS unsigned gu32;
#define RLX_AGENT __ATOMIC_RELAXED, __HIP_MEMORY_SCOPE_AGENT
#define LDS_WAIT() asm volatile("s_waitcnt lgkmcnt(0)" ::: "memory")
#define VM_WAIT() asm volatile("s_waitcnt vmcnt(0)" ::: "memory")
__device__ __forceinline__ unsigned f2bf(float f) { unsigned u = __builtin_bit_cast(unsigned, f); return (u + 0x7fffu + ((u >> 16) & 1u)) >> 16; }
__device__ __forceinline__ unsigned pk2(float lo, float hi) { return f2bf(lo) | (f2bf(hi) << 16); }
typedef __bf16 bf16v2 __attribute__((ext_vector_type(2)));
__device__ __forceinline__ unsigned cvtpk(float lo, float hi) { const f32x2 v = {lo, hi}; const bf16v2 b = __builtin_convertvector(v, bf16v2); return __builtin_bit_cast(unsigned, b); }
__device__ __forceinline__ float bflo(unsigned w) { return __builtin_bit_cast(float, w << 16); }
__device__ __forceinline__ float bfhi(unsigned w) { return __builtin_bit_cast(float, w & 0xffff0000u); }
__device__ __forceinline__ float bf1(bf16 b) { return __builtin_bit_cast(float, ((unsigned)b) << 16); }
__device__ __forceinline__ float sigmoidf_(float x) { return __builtin_amdgcn_rcpf(1.f + __expf(-x)); }
__device__ __forceinline__ float siluf_(float x) { return x * sigmoidf_(x); }

#define XB_TMO      128
#define XB_XCNT(j)  (256  + 64 * (j))
#define XB_XSUB(j)  (1280 + 64 * (j))
#define XB_XGEN(j)  (2304 + 64 * (j))
#define XB_TOP      3328
#define XB_TOPGEN   3392
#define XCD_BAR_WORDS 3456
#define XB_SPIN_CAP (1u << 18)
__device__ __forceinline__ unsigned xb_ld(unsigned* p)              { return __hip_atomic_load(p, __ATOMIC_RELAXED, __HIP_MEMORY_SCOPE_AGENT); }
__device__ __forceinline__ unsigned xb_add(unsigned* p, unsigned v) { return __hip_atomic_fetch_add(p, v, __ATOMIC_RELAXED, __HIP_MEMORY_SCOPE_AGENT); }
__device__ __forceinline__ unsigned xb_xcc_id() { return (unsigned)__builtin_amdgcn_s_getreg((3 << 11) | 20) & 0xFu; }
#define XB_SPIN(cond, bar) do { unsigned _sp = 0; while (cond) { __builtin_amdgcn_s_sleep(1); \
    if ((++_sp & 255u) == 0u) { if (xb_ld(&(bar)[XB_TMO])) break; if (_sp > XB_SPIN_CAP) { atomicAdd(&(bar)[XB_TMO], 1u); break; } } } } while (0)
struct XcdBarrier { unsigned* bar; unsigned x; volatile LAS unsigned* st; };
__device__ __forceinline__ XcdBarrier xcd_barrier_post(unsigned* bar, volatile LAS unsigned* st) {
    XcdBarrier b; b.bar = bar; b.x = xb_xcc_id(); b.st = st;
    if (threadIdx.x == 0) (void)xb_add(&bar[XB_XCNT(b.x)], 1u);
    return b;
}
__device__ __forceinline__ void xcd_barrier_complete(unsigned* bar, unsigned x, unsigned& nloc, unsigned& nx) {
    const unsigned G = gridDim.x * gridDim.y * gridDim.z;
    unsigned sum, cnt, mine, sp = 0u;
    for (;;) {
        sum = 0u; cnt = 0u; mine = 0u;
#pragma unroll
        for (unsigned j = 0; j < 16; ++j) { const unsigned c = xb_ld(&bar[XB_XCNT(j)]); sum += c; cnt += (c > 0u) ? 1u : 0u; mine = (j == x) ? c : mine; }
        if (sum == G) break;
        __builtin_amdgcn_s_sleep(1);
        if ((++sp & 255u) == 0u) { if (xb_ld(&bar[XB_TMO])) break; if (sp > XB_SPIN_CAP) { atomicAdd(&bar[XB_TMO], 1u); break; } }
    }
    nloc = mine > 0u ? mine : 1u; nx = cnt > 0u ? cnt : 1u;
}
__device__ __forceinline__ void xcd_barrier(const XcdBarrier& b) {
    asm volatile("s_waitcnt vmcnt(0)" ::: "memory");
    __syncthreads();
    if (threadIdx.x == 0) {
        unsigned* bar = b.bar;
        __builtin_amdgcn_s_waitcnt(0);
        unsigned nloc = b.st[0], nx = b.st[1];
        if (nloc == 0u) { xcd_barrier_complete(bar, b.x, nloc, nx); b.st[0] = nloc; b.st[1] = nx; }
        const unsigned old = xb_add(&bar[XB_XSUB(b.x)], 1u);
        const unsigned gen = old / nloc;
        if (old + 1u == (gen + 1u) * nloc) {
            __builtin_amdgcn_fence(__ATOMIC_RELEASE, "agent");
            asm volatile("s_waitcnt vmcnt(0)" ::: "memory");
            const unsigned og = xb_add(&bar[XB_TOP], 1u);
            const unsigned tg = og / nx;
            if (og + 1u == (tg + 1u) * nx) xb_add(&bar[XB_TOPGEN], 1u);
            else XB_SPIN(xb_ld(&bar[XB_TOPGEN]) == tg, bar);
            __builtin_amdgcn_fence(__ATOMIC_ACQUIRE, "agent");
            xb_add(&bar[XB_XGEN(b.x)], 1u);
            asm volatile("s_waitcnt vmcnt(0)" ::: "memory");
        } else {
            XB_SPIN(xb_ld(&bar[XB_XGEN(b.x)]) == gen, bar);
            __builtin_amdgcn_fence(__ATOMIC_ACQUIRE, "agent");
            asm volatile("s_waitcnt vmcnt(0)" ::: "memory");
        }
    }
    __syncthreads();
}

struct Args { const float* in[23]; float* out; unsigned char* ws; int ph_lo, ph_hi; };

#define DPP_ADD(v, ctrl, rmask, bc) v += __builtin_bit_cast(float, __builtin_amdgcn_update_dpp(0, __builtin_bit_cast(int, v), ctrl, rmask, 0xF, bc))
__device__ __forceinline__ float sum16(float v) {
    DPP_ADD(v, 0xB1, 0xF, true); DPP_ADD(v, 0x4E, 0xF, true); DPP_ADD(v, 0x141, 0xF, true); DPP_ADD(v, 0x140, 0xF, true); return v; }
__device__ __forceinline__ float wave_sum(float v) {
    v = sum16(v); DPP_ADD(v, 0x142, 0xA, false); DPP_ADD(v, 0x143, 0xC, false);
    return __builtin_bit_cast(float, __builtin_amdgcn_readlane(__builtin_bit_cast(int, v), 63)); }
__device__ __forceinline__ float rsqf(float x) { return __builtin_amdgcn_rsqf(x); }
__device__ __forceinline__ int compact_row(int r) {
    if (r >= MR) return -1;
    if (r >= RP) return r - RP + BP * SEQ;
    const int b = r / TP, t = r - b * TP;
    return t < NMETA ? -1 : r - NMETA * (b + 1);
}

__device__ __forceinline__ void p0_transpose_item(const float* W, int Nsrc, int K, bf16* WT, int dst_row0, int src_col0, int nvalid, int k0, int lane) {
    const float* src = W + (size_t)k0 * Nsrc + src_col0 + (lane < nvalid ? lane : 0);
    float v[32];
#pragma unroll
    for (int j = 0; j < 32; ++j) v[j] = src[(size_t)j * Nsrc];
    if (lane >= nvalid) {
#pragma unroll
        for (int j = 0; j < 32; ++j) v[j] = 0.f; }
    GAS v4u* dst = (GAS v4u*)(WT + (size_t)(dst_row0 + lane) * K + k0);
#pragma unroll
    for (int q = 0; q < 4; ++q) { v4u o; o.x = cvtpk(v[8 * q], v[8 * q + 1]); o.y = cvtpk(v[8 * q + 2], v[8 * q + 3]); o.z = cvtpk(v[8 * q + 4], v[8 * q + 5]); o.w = cvtpk(v[8 * q + 6], v[8 * q + 7]); dst[q] = o; }
}
__device__ __forceinline__ void win_src(int nb, int& src, int& nvalid) {
    const int pn = nb >> 2, o = (nb & 3) * 64; nvalid = 64;
    if (pn < 8) src = (o < 128) ? 128 * pn + o : 1024 + 128 * pn + (o - 128);
    else if (pn < 20) src = 2048 + 256 * (pn - 8) + o;
    else if (pn < 24) src = 5120 + 256 * (pn - 20) + o;
    else if (pn < 28) src = 6160 + 256 * (pn - 24) + o;
    else if (pn < 32) src = 7184 + 256 * (pn - 28) + o;
    else { src = 6144; nvalid = (o == 0) ? 16 : 0; }
}
__device__ __forceinline__ void rms_row_to_bf16(const float* xrow, const float* gain, bf16* orow, int lane) {
    const GAS f32x4* xr = (const GAS f32x4*)xrow + lane; const GAS f32x4* gr = (const GAS f32x4*)gain + lane;
    f32x4 v[4]; float s = 0.f;
#pragma unroll
    for (int j = 0; j < 4; ++j) { v[j] = xr[64 * j]; s += (v[j].x * v[j].x + v[j].y * v[j].y) + (v[j].z * v[j].z + v[j].w * v[j].w); }
    const float rstd = 1.f / sqrtf(wave_sum(s) * (1.f / DM) + EPS);
    GAS unsigned long long* o8 = (GAS unsigned long long*)orow + lane;
#pragma unroll
    for (int j = 0; j < 4; ++j) { const f32x4 g = gr[64 * j]; o8[64 * j] = (unsigned long long)cvtpk(v[j].x * rstd * g.x, v[j].y * rstd * g.y) | ((unsigned long long)cvtpk(v[j].z * rstd * g.z, v[j].w * rstd * g.w) << 32); }
}

typedef pg8::f32x4 A4;
struct EpiIn {
    static constexpr bool PERM = true;
    bf16 *GLU, *QKVB, *QS, *HALOQ, *HALOC, *ZS, *SGC, *SGD; float* BETAG; const float *a_log, *dt_bias;
    __device__ __forceinline__ void operator()(const A4 (&acc)[2][2][4][2], const pg8::Unit& u, int wr, int wc, int fr, int fq) const {
#if defined(PROBE_EPI2)
        for (int rep = 0; rep < 2; ++rep) { asm volatile("" ::: "memory"); body(acc, u, wr, wc, fr, fq); }
#else
        body(acc, u, wr, wc, fr, fq);
#endif
    }
    __device__ __forceinline__ void body(const A4 (&acc)[2][2][4][2], const pg8::Unit& u, int wr, int wc, int fr, int fq) const {
        const int pn = u.pn, row0 = u.pm * 256 + wr * 64 + fr, cw = 32 * wc + 8 * fq;
        if (pn < 8) {
#pragma unroll
            for (int ai = 0; ai < 2; ++ai)
#pragma unroll
                for (int m = 0; m < 4; ++m) { const int r = row0 + ai * 128 + m * 16; float o[8];
#pragma unroll
                    for (int n = 0; n < 2; ++n)
#pragma unroll
                        for (int j = 0; j < 4; ++j) o[4 * n + j] = acc[ai][0][m][n][j] * sigmoidf_(acc[ai][1][m][n][j]);
                    v4u w; w.x = cvtpk(o[0], o[1]); w.y = cvtpk(o[2], o[3]); w.z = cvtpk(o[4], o[5]); w.w = cvtpk(o[6], o[7]);
                    *(GAS v4u*)(GLU + (size_t)r * DM + 128 * pn + cw) = w;
                    if (r < RP) { const int b = r / TP, t = r - b * TP, run = t / RUNL, pos = t - run * RUNL;
                        if (pos >= RUNL - 30 && run < NRUN - 1) *(GAS v4u*)(HALOC + ((size_t)(b * NRUN + run) * 30 + (pos - (RUNL - 30))) * DM + 128 * pn + cw) = w; } }
        } else if (pn < 20) {
            const int colb = 256 * (pn - 8);
#pragma unroll
            for (int ai = 0; ai < 2; ++ai)
#pragma unroll
                for (int m = 0; m < 4; ++m) { const int r = row0 + ai * 128 + m * 16; if (r >= MR) continue;
#pragma unroll
                    for (int bj = 0; bj < 2; ++bj) { const int col = colb + 128 * bj + cw;
                        const A4 a0 = acc[ai][bj][m][0], a1 = acc[ai][bj][m][1];
                        v4u w; w.x = cvtpk(a0[0], a0[1]); w.y = cvtpk(a0[2], a0[3]); w.z = cvtpk(a1[0], a1[1]); w.w = cvtpk(a1[2], a1[3]);
                        if (r >= RP) *(GAS v4u*)(QS + (size_t)(r - RP) * DQKV + col) = w;
                        else { const int b = r / TP, t = r - b * TP, c = t >> 6, i = t & 63, which = col >> 10, h = (col >> 7) & 7, d = col & 127;
                            *(GAS v4u*)(QKVB + ((size_t)((b * NCH + c) * NH + h) * 3 + which) * 8192 + i * 128 + d) = w;
                            if (i >= 61) *(GAS v4u*)(HALOQ + ((size_t)(b * NCH + c) * 3 + (i - 61)) * DQKV + col) = w; } } }
        } else if (pn < 24) {
            constexpr bool isz = true; bf16* dst = ZS; const int ld = DM, cb = 256 * (pn - 20);
#pragma unroll
            for (int ai = 0; ai < 2; ++ai)
#pragma unroll
                for (int m = 0; m < 4; ++m) { const int r = row0 + ai * 128 + m * 16;
#pragma unroll
                    for (int bj = 0; bj < 2; ++bj) { float o[8];
#pragma unroll
                        for (int n = 0; n < 2; ++n)
#pragma unroll
                            for (int j = 0; j < 4; ++j) { const float v = acc[ai][bj][m][n][j]; o[4 * n + j] = isz ? siluf_(v) : v; }
                        v4u w; w.x = cvtpk(o[0], o[1]); w.y = cvtpk(o[2], o[3]); w.z = cvtpk(o[4], o[5]); w.w = cvtpk(o[6], o[7]);
                        *(GAS v4u*)(dst + (size_t)r * ld + cb + 128 * bj + cw) = w; } }
        } else if (pn < 32) {
            bf16* dst = pn < 28 ? SGC : SGD; const int cb = 256 * ((pn - 24) & 3);
#pragma unroll
            for (int ai = 0; ai < 2; ++ai)
#pragma unroll
                for (int m = 0; m < 4; ++m) { const int rc = compact_row(row0 + ai * 128 + m * 16); if (rc < 0) continue;
#pragma unroll
                    for (int bj = 0; bj < 2; ++bj) { float o[8];
#pragma unroll
                        for (int n = 0; n < 2; ++n)
#pragma unroll
                            for (int j = 0; j < 4; ++j) o[4 * n + j] = sigmoidf_(acc[ai][bj][m][n][j]);
                        v4u w; w.x = cvtpk(o[0], o[1]); w.y = cvtpk(o[2], o[3]); w.z = cvtpk(o[4], o[5]); w.w = cvtpk(o[6], o[7]);
                        *(GAS v4u*)(dst + (size_t)rc * DM + cb + 128 * bj + cw) = w; } }
        } else {
            if (wc == 0 && fq < 2) {
#pragma unroll
                for (int ai = 0; ai < 2; ++ai)
#pragma unroll
                    for (int m = 0; m < 4; ++m) { const int r = row0 + ai * 128 + m * 16; float o[8];
#pragma unroll
                        for (int n = 0; n < 2; ++n)
#pragma unroll
                            for (int j = 0; j < 4; ++j) { const int h = 4 * n + j; const float v = acc[ai][0][m][n][j];
                                if (fq == 0) o[h] = 1.f / (1.f + expf(-v));
                                else { const float xx = v + dt_bias[h]; const float sp = xx > 20.f ? xx : log1pf(expf(xx)); o[h] = -expf(a_log[h]) * sp; } }
                        GAS f32x4* p = (GAS f32x4*)(BETAG + (size_t)r * 16 + 8 * fq);
                        p[0] = (f32x4){o[0], o[1], o[2], o[3]}; p[1] = (f32x4){o[4], o[5], o[6], o[7]}; }
            }
        }
    }
};
template <int MODE> struct EpiGate {
    static constexpr bool PERM = true;
    bf16 *SG, *MA, *OUT;
    __device__ __forceinline__ void operator()(const A4 (&acc)[2][2][4][2], const pg8::Unit& u, int wr, int wc, int fr, int fq) const {
        const int row0 = u.pm * 256 + wr * 64 + fr, c0 = 256 * u.pn + 32 * wc + 8 * fq;
#pragma unroll
        for (int ai = 0; ai < 2; ++ai) {
            size_t off[4]; bool ok[4]; v4u g[4][2], q[4][2];
#pragma unroll
            for (int m = 0; m < 4; ++m) { const int rc = compact_row(row0 + ai * 128 + m * 16); ok[m] = rc >= 0; off[m] = (size_t)(ok[m] ? rc : 0) * DM + c0; }
#pragma unroll
            for (int m = 0; m < 4; ++m)
#pragma unroll
                for (int bj = 0; bj < 2; ++bj) { g[m][bj] = *(const GAS v4u*)(SG + off[m] + 128 * bj); if (MODE == 1) q[m][bj] = *(const GAS v4u*)(MA + off[m] + 128 * bj); }
#pragma unroll
            for (int m = 0; m < 4; ++m)
#pragma unroll
                for (int bj = 0; bj < 2; ++bj) { const v4u gg = g[m][bj]; float o[8];
                    const A4 a0 = acc[ai][bj][m][0], a1 = acc[ai][bj][m][1];
                    o[0] = bflo(gg.x) * a0[0]; o[1] = bfhi(gg.x) * a0[1]; o[2] = bflo(gg.y) * a0[2]; o[3] = bfhi(gg.y) * a0[3];
                    o[4] = bflo(gg.z) * a1[0]; o[5] = bfhi(gg.z) * a1[1]; o[6] = bflo(gg.w) * a1[2]; o[7] = bfhi(gg.w) * a1[3];
                    if (MODE == 1) { const v4u qq = q[m][bj];
                        o[0] += bflo(qq.x); o[1] += bfhi(qq.x); o[2] += bflo(qq.y); o[3] += bfhi(qq.y); o[4] += bflo(qq.z); o[5] += bfhi(qq.z); o[6] += bflo(qq.w); o[7] += bfhi(qq.w); }
                    v4u w; w.x = cvtpk(o[0], o[1]); w.y = cvtpk(o[2], o[3]); w.z = cvtpk(o[4], o[5]); w.w = cvtpk(o[6], o[7]);
                    if (ok[m]) *(GAS v4u*)(OUT + off[m] + 128 * bj) = w; }
        }
    }
};
template <int MODE> struct EpiRes {
    static constexpr bool PERM = false;
    const float *xp, *xs; float* out; float* parts; const bf16* X1B;
    __device__ __forceinline__ void operator()(const A4 (&acc)[2][2][4][2], const pg8::Unit& u, int wr, int wc, int fr, int fq) const {
        const int row0 = u.pm * 256 + wr * 64 + fr, c0 = 256 * u.pn + 32 * wc + 4 * fq;
        if (u.pm >= BP * SEQ / 256) {
            float* part = parts + (size_t)(u.k0 / u.nt) * RS * DM;
#pragma unroll
            for (int ai = 0; ai < 2; ++ai)
#pragma unroll
                for (int m = 0; m < 4; ++m) { float* orow = part + (size_t)(row0 + ai * 128 + m * 16 - BP * SEQ) * DM;
#pragma unroll
                    for (int bj = 0; bj < 2; ++bj)
#pragma unroll
                        for (int n = 0; n < 2; ++n) *(GAS f32x4*)(orow + c0 + 128 * bj + 16 * n) = acc[ai][bj][m][n]; }
            return; }
#pragma unroll
        for (int ai = 0; ai < 2; ++ai)
#pragma unroll
            for (int m = 0; m < 4; ++m) { const int r = row0 + ai * 128 + m * 16;
                float* orow = out + (size_t)r * DM;
                if (MODE == 0) { const float* base = r < BP * SEQ ? xp + (size_t)r * DM : xs + (size_t)(r - BP * SEQ) * DM;
#pragma unroll
                    for (int bj = 0; bj < 2; ++bj)
#pragma unroll
                        for (int n = 0; n < 2; ++n) { const int c = c0 + 128 * bj + 16 * n; const f32x4 b = *(const GAS f32x4*)(base + c); *(GAS f32x4*)(orow + c) = b + acc[ai][bj][m][n]; }
                } else {
                } }
        if (MODE == 1) {
#pragma unroll
            for (int ai = 0; ai < 2; ++ai) { v2u xb[4][2][2];
#pragma unroll
                for (int m = 0; m < 4; ++m)
#pragma unroll
                    for (int bj = 0; bj < 2; ++bj)
#pragma unroll
                        for (int n = 0; n < 2; ++n) xb[m][bj][n] = *(const GAS v2u*)(X1B + (size_t)(row0 + ai * 128 + m * 16) * DM + c0 + 128 * bj + 16 * n);
#pragma unroll
                for (int m = 0; m < 4; ++m)
#pragma unroll
                    for (int bj = 0; bj < 2; ++bj)
#pragma unroll
                        for (int n = 0; n < 2; ++n) { const v2u b = xb[m][bj][n]; const f32x4 x2 = (f32x4){bflo(b.x), bfhi(b.x), bflo(b.y), bfhi(b.y)} + acc[ai][bj][m][n];
                            v2u w; w.x = cvtpk(x2[0], x2[1]); w.y = cvtpk(x2[2], x2[3]);
                            *(GAS v2u*)((bf16*)X1B + (size_t)(row0 + ai * 128 + m * 16) * DM + c0 + 128 * bj + 16 * n) = w; } }
        }
    }
};
struct EpiWo {
    const float *xp; bf16* X1B; float* parts;
    __device__ __forceinline__ void operator()(const A4 (&acc)[2][2][4][2], const pg8::Unit& u, int wr, int wc, int fr, int fq) const {
        const int row0 = u.pm * 256 + wr * 64 + fr, c0 = 256 * u.pn + 32 * wc + 8 * fq;
        if (u.pm >= BP * SEQ / 256) {
            float* part = parts + (size_t)(u.k0 / u.nt) * RS * DM;
#pragma unroll
            for (int ai = 0; ai < 2; ++ai)
#pragma unroll
                for (int m = 0; m < 4; ++m) { float* orow = part + (size_t)(row0 + ai * 128 + m * 16 - BP * SEQ) * DM + c0;
#pragma unroll
                    for (int bj = 0; bj < 2; ++bj) { *(GAS f32x4*)(orow + 128 * bj) = acc[ai][bj][m][0]; *(GAS f32x4*)(orow + 128 * bj + 4) = acc[ai][bj][m][1]; } }
            return; }
#pragma unroll
        for (int ai = 0; ai < 2; ++ai) { f32x4 xv[4][2][2];
#pragma unroll
            for (int m = 0; m < 4; ++m)
#pragma unroll
                for (int bj = 0; bj < 2; ++bj) { const float* xrow = xp + (size_t)(row0 + ai * 128 + m * 16) * DM + c0 + 128 * bj; xv[m][bj][0] = *(const GAS f32x4*)xrow; xv[m][bj][1] = *(const GAS f32x4*)(xrow + 4); }
#pragma unroll
            for (int m = 0; m < 4; ++m)
#pragma unroll
                for (int bj = 0; bj < 2; ++bj) { const f32x4 x0 = xv[m][bj][0] + acc[ai][bj][m][0], x1 = xv[m][bj][1] + acc[ai][bj][m][1];
                    v4u w; w.x = cvtpk(x0[0], x0[1]); w.y = cvtpk(x0[2], x0[3]); w.z = cvtpk(x1[0], x1[1]); w.w = cvtpk(x1[2], x1[3]);
                    *(GAS v4u*)(X1B + (size_t)(row0 + ai * 128 + m * 16) * DM + c0 + 128 * bj) = w; } }
    }
};
struct EpiWoP : EpiWo { static constexpr bool PERM = true; };
struct EpiUp {
    static constexpr bool PERM = true;
    bf16* HM;
    __device__ __forceinline__ void operator()(const A4 (&acc)[2][2][4][2], const pg8::Unit& u, int wr, int wc, int fr, int fq) const {
        const int row0 = u.pm * 256 + wr * 64 + fr, c0 = 256 * u.pn + 32 * wc + 8 * fq;
#pragma unroll
        for (int ai = 0; ai < 2; ++ai)
#pragma unroll
            for (int m = 0; m < 4; ++m) { const int r = row0 + ai * 128 + m * 16;
#pragma unroll
                for (int bj = 0; bj < 2; ++bj) { float o[8];
#pragma unroll
                    for (int n = 0; n < 2; ++n)
#pragma unroll
                        for (int j = 0; j < 4; ++j) { const float v = fmaxf(acc[ai][bj][m][n][j], 0.f); o[4 * n + j] = v * v; }
                    v4u w; w.x = cvtpk(o[0], o[1]); w.y = cvtpk(o[2], o[3]); w.z = cvtpk(o[4], o[5]); w.w = cvtpk(o[6], o[7]);
                    *(GAS v4u*)(HM + (size_t)r * DFF + c0 + 128 * bj) = w; } }
    }
};

template <int KIND>
__device__ __forceinline__ void conv_unit(const Args& a, LAS unsigned char* lds, int b, int run) {
    asm volatile("" ::: "memory");
    const int tid = threadIdx.x, lane = tid & 63, wave = tid >> 6; int ch = 2 * tid; asm volatile("" : "+v"(ch));
    unsigned char* ws = a.ws;
    bf16* GC = (bf16*)(ws + WS_GLU); const bf16* HALOC = (const bf16*)(ws + WS_HALOC);
    const float* w_dw = a.in[8];
    LAS float* red = (LAS float*)lds;
    constexpr int NTOK = KIND == 0 ? RUNL : TS, NSTEP = (NTOK + 3) / 4, REM = NTOK - 4 * (NSTEP - 1);
    f32x2 w[KC]; unsigned E[KC + 3];
#pragma unroll
    for (int i = 0; i < KC; ++i) w[i] = *(const GAS f32x2*)(w_dw + (size_t)i * DM + ch);
    const f32x2 bdw = *(const GAS f32x2*)(a.in[9] + ch), lng = *(const GAS f32x2*)(a.in[10] + ch), lnb = *(const GAS f32x2*)(a.in[11] + ch);
    const int row0 = KIND == 0 ? b * TP + run * RUNL : RP + b * TS;
    if (KIND == 0) {
#pragma unroll
        for (int i = 0; i < KC - 1; ++i) { unsigned v = *(const GAS unsigned*)(HALOC + ((size_t)(b * NRUN + (run > 0 ? run - 1 : 0)) * 30 + i) * DM + ch); E[i] = run > 0 ? v : 0u; }
    } else { const float* st = a.in[2] + (size_t)b * (KC - 1) * DM;
#pragma unroll
        for (int i = 0; i < KC - 1; ++i) { const f32x2 v = *(const GAS f32x2*)(st + (size_t)i * DM + ch); E[i] = cvtpk(v.x, v.y); }
    }
    unsigned nx[4];
#pragma unroll
    for (int k = 0; k < 4; ++k) nx[k] = *(const GAS unsigned*)(GC + (size_t)(row0 + (k < NTOK ? k : NTOK - 1)) * DM + ch);
    for (int st4 = 0; st4 < NSTEP; ++st4) {
        const int t0 = 4 * st4;
#pragma unroll
        for (int k = 0; k < 4; ++k) E[KC - 1 + k] = nx[k];
        if (st4 + 1 < NSTEP) {
#pragma unroll
            for (int k = 0; k < 4; ++k) { const int t = t0 + 4 + k; nx[k] = *(const GAS unsigned*)(GC + (size_t)(row0 + (t < NTOK ? t : NTOK - 1)) * DM + ch); }
        }
        f32x2 y[4] = {bdw, bdw, bdw, bdw};
#pragma unroll
        for (int j = 0; j < KC + 3; ++j) { const f32x2 e = {bflo(E[j]), bfhi(E[j])};
#pragma unroll
            for (int k = 0; k < 4; ++k) { const int i = j - k; if (i >= 0 && i < KC) y[k] += w[i] * e; } }
        float sv[8];
#pragma unroll
        for (int k = 0; k < 4; ++k) { sv[2 * k] = wave_sum(y[k].x + y[k].y); sv[2 * k + 1] = wave_sum(y[k].x * y[k].x + y[k].y * y[k].y); }
        LAS float* rb = red + (st4 & 1) * 64;
        if (lane == 0) { *(LAS f32x4*)(rb + wave * 8) = (f32x4){sv[0], sv[1], sv[2], sv[3]}; *(LAS f32x4*)(rb + wave * 8 + 4) = (f32x4){sv[4], sv[5], sv[6], sv[7]}; }
        __syncthreads();
        f32x4 ta = {0.f, 0.f, 0.f, 0.f}, tb = {0.f, 0.f, 0.f, 0.f};
#pragma unroll
        for (int i = 0; i < 8; ++i) { ta += *(const LAS f32x4*)(rb + i * 8); tb += *(const LAS f32x4*)(rb + i * 8 + 4); }
        const float tt[8] = {ta.x, ta.y, ta.z, ta.w, tb.x, tb.y, tb.z, tb.w};
#pragma unroll
        for (int k = 0; k < 4; ++k) { if (t0 + k < NTOK) {
            const float mu = tt[2 * k] * (1.f / DM), var = fmaxf(tt[2 * k + 1] * (1.f / DM) - mu * mu, 0.f), rstd = rsqf(var + EPS);
            const float z0 = (y[k].x - mu) * rstd * lng.x + lnb.x, z1 = (y[k].y - mu) * rstd * lng.y + lnb.y;
            *(GAS unsigned*)(GC + (size_t)(row0 + t0 + k) * DM + ch) = cvtpk(siluf_(z0), siluf_(z1)); } }
        if (st4 + 1 < NSTEP) {
#pragma unroll
            for (int i = 0; i < KC - 1; ++i) E[i] = E[i + 4];
        }
    }
    if (KIND == 1 || run == NRUN - 1) { float* o = a.out + (KIND == 0 ? O_PC : O_SC) + (size_t)b * (KC - 1) * DM;
        if (KIND == 0) {
#pragma unroll
            for (int i = 0; i < KC - 1; ++i) *(GAS f32x2*)(o + (size_t)i * DM + ch) = (f32x2){bflo(E[REM + i]), bfhi(E[REM + i])};
        } else {
            const float* st = a.in[2] + (size_t)b * (KC - 1) * DM;
#pragma unroll
            for (int i = 0; i < KC - 1 - TS; ++i) *(GAS f32x2*)(o + (size_t)i * DM + ch) = *(const GAS f32x2*)(st + (size_t)(i + TS) * DM + ch);
#pragma unroll
            for (int i = KC - 1 - TS; i < KC - 1; ++i) *(GAS f32x2*)(o + (size_t)i * DM + ch) = (f32x2){bflo(E[REM + i]), bfhi(E[REM + i])};
        }
    }
    __syncthreads();
}

__device__ __forceinline__ void delta_item(const Args& a, LAS unsigned char* lds, int item) {
    asm volatile("" ::: "memory");
    const int tid = threadIdx.x, lane = tid & 63, sub = tid >> 7, wu = (tid >> 6) & 1; int j = tid & 127; asm volatile("" : "+v"(j));
    const int unit = item * 4 + sub, b = unit >> 3, h = unit & 7;
    const int row0 = RP + b * TS;
    const bf16* QS = (const bf16*)(a.ws + WS_QS); bf16* ZS = (bf16*)(a.ws + WS_ZS); const float* BETAG = (const float*)(a.ws + WS_BETAG);
    LAS float* kq = (LAS float*)lds + sub * 256;
    LAS float* red = (LAS float*)lds + 1024 + sub * 4;
    LAS float* red2 = (LAS float*)lds + 1024 + 16 + sub * 2;
    float S[DH];
    { const float* s0 = a.in[4] + ((size_t)(b * NH + h) * DH) * DH + j;
#pragma unroll
        for (int d = 0; d < DH; ++d) S[d] = s0[(size_t)d * DH]; }
    const int cq = h * DH + j, ck = DM + cq, cv = 2 * DM + cq;
    float wq[KS], wk[KS], wv[KS];
#pragma unroll
    for (int i = 0; i < KS; ++i) { wq[i] = a.in[13][i * DQKV + cq]; wk[i] = a.in[13][i * DQKV + ck]; wv[i] = a.in[13][i * DQKV + cv]; }
    float hq[3], hk[3], hv[3];
#pragma unroll
    for (int i = 0; i < 3; ++i) { const float* st = a.in[3] + ((size_t)b * 3 + i) * DQKV; hq[i] = st[cq]; hk[i] = st[ck]; hv[i] = st[cv]; }
    const float gh = a.in[16][j];
    float pq[TS], pk[TS], pv[TS], pbe[TS], pgg[TS], pzs[TS];
#pragma unroll
    for (int t = 0; t < TS; ++t) { const bf16* p = QS + (size_t)(b * TS + t) * DQKV; pq[t] = bf1(p[cq]); pk[t] = bf1(p[ck]); pv[t] = bf1(p[cv]);
        pbe[t] = BETAG[(size_t)(row0 + t) * 16 + h]; pgg[t] = BETAG[(size_t)(row0 + t) * 16 + 8 + h]; pzs[t] = bf1(ZS[(size_t)(row0 + t) * DM + cq]); }
#pragma unroll
    for (int t = 0; t < TS; ++t) {
        const size_t row = (size_t)(row0 + t);
        const float qp = pq[t], kp = pk[t], vp = pv[t];
        const float qc = siluf_(wq[0] * hq[0] + wq[1] * hq[1] + wq[2] * hq[2] + wq[3] * qp);
        const float kc = siluf_(wk[0] * hk[0] + wk[1] * hk[1] + wk[2] * hk[2] + wk[3] * kp);
        const float vc = siluf_(wv[0] * hv[0] + wv[1] * hv[1] + wv[2] * hv[2] + wv[3] * vp);
        hq[0] = hq[1]; hq[1] = hq[2]; hq[2] = qp; hk[0] = hk[1]; hk[1] = hk[2]; hk[2] = kp; hv[0] = hv[1]; hv[1] = hv[2]; hv[2] = vp;
        const float sq = wave_sum(qc * qc), sk = wave_sum(kc * kc);
        kq[j] = kc; kq[128 + j] = qc;
        if (lane == 0) { red[wu * 2] = sq; red[wu * 2 + 1] = sk; }
        const float beta = pbe[t], gg = pgg[t], zs = pzs[t];
        __syncthreads();
        const float nq = rsqf(red[0] + red[2] + 1e-6f) * 0.08838834764831845f, nk = rsqf(red[1] + red[3] + 1e-6f);
        const float alpha = __expf(gg);
        float ks0 = 0.f, ks1 = 0.f, ks2 = 0.f, ks3 = 0.f;
#pragma unroll
        for (int d = 0; d < DH; d += 4) { const f32x4 kk = *(const LAS f32x4*)(kq + d); ks0 += kk.x * S[d]; ks1 += kk.y * S[d + 1]; ks2 += kk.z * S[d + 2]; ks3 += kk.w * S[d + 3];
            if ((d & 31) == 28) asm volatile("" ::: "memory"); }
        const float kS = (ks0 + ks1) + (ks2 + ks3);
        const float u = beta * (vc - alpha * nk * kS), un = nk * u;
        float o0 = 0.f, o1 = 0.f, o2 = 0.f, o3 = 0.f;
#pragma unroll
        for (int d = 0; d < DH; d += 4) { const f32x4 kk = *(const LAS f32x4*)(kq + d); const f32x4 qq = *(const LAS f32x4*)(kq + 128 + d);
            S[d] = alpha * S[d] + kk.x * un; S[d + 1] = alpha * S[d + 1] + kk.y * un; S[d + 2] = alpha * S[d + 2] + kk.z * un; S[d + 3] = alpha * S[d + 3] + kk.w * un;
            o0 += qq.x * S[d]; o1 += qq.y * S[d + 1]; o2 += qq.z * S[d + 2]; o3 += qq.w * S[d + 3];
            if ((d & 15) == 12) asm volatile("" ::: "memory"); }
        const float o = ((o0 + o1) + (o2 + o3)) * nq;
        const float so = wave_sum(o * o);
        if (lane == 0) red2[wu] = so;
        __syncthreads();
        const float rms = rsqf((red2[0] + red2[1]) * (1.f / DH) + EPS);
        ZS[row * DM + cq] = (bf16)f2bf(o * rms * gh * zs);
    }
    { float* so = a.out + O_SD + ((size_t)(b * NH + h) * DH) * DH + j;
#pragma unroll
        for (int d = 0; d < DH; ++d) so[(size_t)d * DH] = S[d];
      float* qo = a.out + O_SQ + (size_t)b * 3 * DQKV;
#pragma unroll
        for (int i = 0; i < 3; ++i) { qo[i * DQKV + cq] = hq[i]; qo[i * DQKV + ck] = hk[i]; qo[i * DQKV + cv] = hv[i]; }
    }
    __syncthreads();
}

__host__ __device__ constexpr int perm_k(int x) { return (x & ~31) | (((x >> 2) & 3) << 3) | (((x >> 4) & 1) << 2) | (x & 3); }
typedef short bf16x8v __attribute__((ext_vector_type(8)));
constexpr int IH_QH = 0, IH_KH = 17408, IH_VH = 34816, IH_GV = 52224, IH_BYTES = 54272;
__device__ __forceinline__ void intra_pair(const Args& a, LAS unsigned char* lds_all, int pair) {
    asm volatile("" ::: "memory");
    const int tid = threadIdx.x, half = tid >> 8, lane = tid & 63, wq = (tid >> 6) & 3; int tu = tid & 255; asm volatile("" : "+v"(tu));
    const int uq = pair * 2 + half, h = uq & 7, bc = uq >> 3, b = bc / NCH, c = bc - b * NCH;
    const int nvalid = (c == NCH - 1) ? TP - 64 * (NCH - 1) : 64;
    LAS unsigned char* lds = lds_all + half * IH_BYTES;
    LAS bf16* QH = (LAS bf16*)(lds + IH_QH); LAS bf16* KH = (LAS bf16*)(lds + IH_KH); LAS bf16* VH = (LAS bf16*)(lds + IH_VH);
    LAS float* MF = (LAS float*)(lds + IH_KH); LAS bf16* ATL = (LAS bf16*)(lds + IH_VH); LAS float* GV = (LAS float*)(lds + IH_GV);
    unsigned char* ws = a.ws;
    bf16* blk = (bf16*)(ws + WS_QKVB) + (size_t)uq * QBLK; const bf16* HALOQ = (const bf16*)(ws + WS_HALOQ); const float* BETAG = (const float*)(ws + WS_BETAG);
    bf16* KDT = (bf16*)(ws + WS_KDT) + (size_t)uq * 8192; bf16* ATT = (bf16*)(ws + WS_ATTN) + (size_t)uq * 4096; float* LASTV = (float*)(ws + WS_LASTV);
    if (tu < 64) { const int i = tu; float g = 0.f, be = 0.f; { const float* p = BETAG + (size_t)(b * TP + 64 * c + (i < nvalid ? i : 0)) * 16; be = p[h]; g = p[8 + h]; } if (i >= nvalid) { g = 0.f; be = 0.f; }
        float G = g;
#pragma unroll
        for (int o = 1; o < 64; o <<= 1) { const float t = __shfl_up(G, o); if (lane >= o) G += t; }
        const float GL = __shfl(G, 63);
        GV[i] = G; GV[64 + i] = be; GV[128 + i] = expf(G); GV[192 + i] = expf(GL - G);
        if (i == 63) LASTV[uq] = expf(GL); }
    {   const int cp = tu & 15, rg = tu >> 4;
        v4u raw[2][7];
#define IH_LOAD_ROWS(wh_, slot_) do { _Pragma("unroll") for (int k = 0; k < 7; ++k) { const int rr = 4 * rg - 3 + k; \
                const bf16* p = (rr >= 0) ? blk + (wh_) * 8192 + rr * 128 + 8 * cp : HALOQ + ((size_t)(b * NCH + (c > 0 ? c - 1 : 0)) * 3 + (3 + rr)) * DQKV + (wh_) * DM + h * DH + 8 * cp; \
                raw[slot_][k] = *(const GAS v4u*)p; } } while (0)
        IH_LOAD_ROWS(0, 0); IH_LOAD_ROWS(1, 1);
#pragma unroll
        for (int wh = 0; wh < 3; ++wh) {
            const int col = wh * DM + h * DH + 8 * cp;
            f32x4 wl[4], wh4[4];
#pragma unroll
            for (int i = 0; i < 4; ++i) { wl[i] = *(const GAS f32x4*)(a.in[13] + i * DQKV + col); wh4[i] = *(const GAS f32x4*)(a.in[13] + i * DQKV + col + 4); }
            float xr[7][8];
#pragma unroll
            for (int k = 0; k < 7; ++k) { const int rr = 4 * rg - 3 + k; const bool ok = (rr >= 0) ? (rr < nvalid) : (c > 0); const v4u v = raw[wh & 1][k];
                xr[k][0] = ok ? bflo(v.x) : 0.f; xr[k][1] = ok ? bfhi(v.x) : 0.f; xr[k][2] = ok ? bflo(v.y) : 0.f; xr[k][3] = ok ? bfhi(v.y) : 0.f;
                xr[k][4] = ok ? bflo(v.z) : 0.f; xr[k][5] = ok ? bfhi(v.z) : 0.f; xr[k][6] = ok ? bflo(v.w) : 0.f; xr[k][7] = ok ? bfhi(v.w) : 0.f; }
            if (wh == 0) IH_LOAD_ROWS(2, 0);
            if (c == NCH - 1 && rg == (nvalid - 1) / 4) {
                float* qo = a.out + O_PQ + (size_t)b * 3 * DQKV + col;
#pragma unroll
                for (int i = 0; i < 3; ++i) { *(GAS f32x4*)(qo + i * DQKV) = (f32x4){xr[4 + i][0], xr[4 + i][1], xr[4 + i][2], xr[4 + i][3]}; *(GAS f32x4*)(qo + i * DQKV + 4) = (f32x4){xr[4 + i][4], xr[4 + i][5], xr[4 + i][6], xr[4 + i][7]}; } }
            LAS bf16* tile = wh == 0 ? QH : (wh == 1 ? KH : VH);
#pragma unroll
            for (int r = 0; r < 4; ++r) { const bool ok = (4 * rg + r) < nvalid; float y[8];
#pragma unroll
                for (int e = 0; e < 8; ++e) { const float w0 = e < 4 ? wl[0][e & 3] : wh4[0][e & 3], w1 = e < 4 ? wl[1][e & 3] : wh4[1][e & 3], w2 = e < 4 ? wl[2][e & 3] : wh4[2][e & 3], w3 = e < 4 ? wl[3][e & 3] : wh4[3][e & 3];
                    const float t = w0 * xr[r][e] + w1 * xr[r + 1][e] + w2 * xr[r + 2][e] + w3 * xr[r + 3][e]; y[e] = ok ? siluf_(t) : 0.f; }
                v4u o; o.x = cvtpk(y[0], y[1]); o.y = cvtpk(y[2], y[3]); o.z = cvtpk(y[4], y[5]); o.w = cvtpk(y[6], y[7]);
                *(LAS v4u*)(tile + (4 * rg + r) * 136 + 8 * cp) = o; }
        }
    }
    __syncthreads();
    const int which = tu >> 7, d = tu & 127;
    float x[64];
    { const LAS bf16* colp = (which == 0 ? VH : KH) + d;
#pragma unroll
      for (int i = 0; i < 64; ++i) x[i] = bf1(colp[i * 136]); }
    const int fr = lane & 15, fq = lane >> 4;
    f32x4 kk[4], qk[4];
    {   bf16x8v ak[4], aq[4];
#pragma unroll
        for (int sI = 0; sI < 4; ++sI) { ak[sI] = *(const LAS bf16x8v*)(KH + (16 * wq + fr) * 136 + 32 * sI + 8 * fq); aq[sI] = *(const LAS bf16x8v*)(QH + (16 * wq + fr) * 136 + 32 * sI + 8 * fq); }
        f32x4 kkd = {0.f, 0.f, 0.f, 0.f}, qqd = {0.f, 0.f, 0.f, 0.f};
#pragma unroll
        for (int sI = 0; sI < 4; ++sI) { kkd = __builtin_amdgcn_mfma_f32_16x16x32_bf16(ak[sI], ak[sI], kkd, 0, 0, 0); qqd = __builtin_amdgcn_mfma_f32_16x16x32_bf16(aq[sI], aq[sI], qqd, 0, 0, 0); }
#pragma unroll
        for (int nt = 0; nt < 4; ++nt) { kk[nt] = (f32x4){0.f, 0.f, 0.f, 0.f}; qk[nt] = (f32x4){0.f, 0.f, 0.f, 0.f};
            if (nt <= wq) {
#pragma unroll
                for (int sI = 0; sI < 4; ++sI) { const bf16x8v bk = *(const LAS bf16x8v*)(KH + (16 * nt + fr) * 136 + 32 * sI + 8 * fq);
                    kk[nt] = __builtin_amdgcn_mfma_f32_16x16x32_bf16(ak[sI], bk, kk[nt], 0, 0, 0); qk[nt] = __builtin_amdgcn_mfma_f32_16x16x32_bf16(aq[sI], bk, qk[nt], 0, 0, 0); } } }
#pragma unroll
        for (int r = 0; r < 4; ++r) if (fr == 4 * fq + r) { GV[320 + 16 * wq + fr] = rsqf(kkd[r] + 1e-6f); GV[256 + 16 * wq + fr] = rsqf(qqd[r] + 1e-6f) * 0.08838834764831845f; }
    }
    __syncthreads();
    {
#pragma unroll
        for (int nt = 0; nt < 4; ++nt) { const int j = 16 * nt + fr;
            if (nt <= wq) { const float Gj = GV[j], nkj = GV[320 + j];
#pragma unroll
                for (int r = 0; r < 4; ++r) { const int i = 16 * wq + 4 * fq + r; const float dec = (i >= j) ? __expf(GV[i] - Gj) : 0.f;
                    MF[i * 68 + j] = (i > j) ? GV[64 + i] * GV[320 + i] * nkj * kk[nt][r] * dec : 0.f;
                    ATL[i * 72 + j] = (bf16)f2bf(GV[256 + i] * nkj * qk[nt][r] * dec); }
            } else {
#pragma unroll
                for (int r = 0; r < 4; ++r) ATL[(16 * wq + 4 * fq + r) * 72 + j] = (bf16)0; }
        }
#pragma unroll
        for (int k = 0; k < 4; ++k) { const int pc = tu + 256 * k, i = pc >> 4, p16 = pc & 15, c0 = 32 * (p16 >> 2) + 4 * (p16 & 3);
            const v2u lo = *(const LAS v2u*)(QH + i * 136 + c0), hi = *(const LAS v2u*)(QH + i * 136 + c0 + 16); const float f = GV[256 + i] * GV[128 + i];
            v4u o; o.x = cvtpk(bflo(lo.x) * f, bfhi(lo.x) * f); o.y = cvtpk(bflo(lo.y) * f, bfhi(lo.y) * f); o.z = cvtpk(bflo(hi.x) * f, bfhi(hi.x) * f); o.w = cvtpk(bflo(hi.y) * f, bfhi(hi.y) * f);
            *(GAS v4u*)(blk + i * 128 + 8 * p16) = o; if (k & 1) asm volatile("" ::: "memory"); }
        if (which == 0) {
#pragma unroll
            for (int i = 0; i < 64; i += 4) { const f32x4 be = *(const LAS f32x4*)(GV + 64 + i); x[i] *= be.x; x[i + 1] *= be.y; x[i + 2] *= be.z; x[i + 3] *= be.w; }
        } else {
            bf16* kd = KDT + d * 64;
#pragma unroll
            for (int i = 0; i < 64; i += 4) { const f32x4 nk = *(const LAS f32x4*)(GV + 320 + i); x[i] *= nk.x; x[i + 1] *= nk.y; x[i + 2] *= nk.z; x[i + 3] *= nk.w; }
#pragma unroll
            for (int g8 = 0; g8 < 8; ++g8) { const int i0 = 32 * (g8 >> 2) + 4 * (g8 & 3);
                const f32x4 e0 = *(const LAS f32x4*)(GV + 192 + i0), e1 = *(const LAS f32x4*)(GV + 192 + i0 + 16);
                v4u w; w.x = cvtpk(x[i0] * e0.x, x[i0 + 1] * e0.y); w.y = cvtpk(x[i0 + 2] * e0.z, x[i0 + 3] * e0.w); w.z = cvtpk(x[i0 + 16] * e1.x, x[i0 + 17] * e1.y); w.w = cvtpk(x[i0 + 18] * e1.z, x[i0 + 19] * e1.w);
                *(GAS v4u*)(kd + 8 * g8) = w; if (g8 & 1) asm volatile("" ::: "memory"); }
#pragma unroll
            for (int i = 0; i < 64; i += 4) { const f32x4 be = *(const LAS f32x4*)(GV + 64 + i), eg = *(const LAS f32x4*)(GV + 128 + i);
                x[i] *= be.x * eg.x; x[i + 1] *= be.y * eg.y; x[i + 2] *= be.z * eg.z; x[i + 3] *= be.w * eg.w; }
        }
    }
    __syncthreads();
    {   f32x4 mb[16];
#pragma unroll
        for (int i = 1; i < 64; ++i) {
#pragma unroll
            for (int g = 0; g < (i + 3) / 4; ++g) mb[g] = *(const LAS f32x4*)(MF + i * 68 + 4 * g);
            __builtin_amdgcn_sched_barrier(0);
            f32x2 a01 = {x[i], 0.f}, a23 = {0.f, 0.f};
#pragma unroll
            for (int g = 0; g < (i + 3) / 4; ++g) { const f32x4 mm = mb[g];
                a01 -= (f32x2){mm.x, mm.y} * (f32x2){x[4 * g], x[4 * g + 1]}; a23 -= (f32x2){mm.z, mm.w} * (f32x2){x[4 * g + 2], x[4 * g + 3]}; }
            x[i] = (a01.x + a01.y) + (a23.x + a23.y);
            __builtin_amdgcn_sched_barrier(0);
        }
    }
    if (which == 0) {
        bf16* u0 = blk + 2 * 8192 + (size_t)(d >> 4) * 1024 + (d & 15) * 4;
#pragma unroll
        for (int m = 0; m < 4; ++m)
#pragma unroll
            for (int q = 0; q < 4; ++q) { const int i = 16 * m + 4 * q; v2u w; w.x = cvtpk(x[i], x[i + 1]); w.y = cvtpk(x[i + 2], x[i + 3]); *(GAS v2u*)(u0 + m * 256 + q * 64) = w; }
    } else {
#pragma unroll
        for (int i = 0; i < 64; ++i) QH[i * 136 + d] = (bf16)f2bf(x[i]);
    }
    __syncthreads();
#pragma unroll
    for (int k = 0; k < 4; ++k) { const int pc = tu + 256 * k, i = pc >> 4, p16 = pc & 15, c0 = 32 * (p16 >> 2) + 4 * (p16 & 3);
        const v2u lo = *(const LAS v2u*)(QH + i * 136 + c0), hi = *(const LAS v2u*)(QH + i * 136 + c0 + 16);
        *(GAS v4u*)(blk + 8192 + i * 128 + 8 * p16) = (v4u){lo.x, lo.y, hi.x, hi.y}; }
#pragma unroll
    for (int k = 0; k < 2; ++k) { const int pc = tu + 256 * k, i = pc >> 3, p8 = pc & 7, c0 = 32 * (p8 >> 2) + 4 * (p8 & 3);
        const v2u lo = *(const LAS v2u*)(ATL + i * 72 + c0), hi = *(const LAS v2u*)(ATL + i * 72 + c0 + 16);
        *(GAS v4u*)(ATT + i * 64 + 8 * p8) = (v4u){lo.x, lo.y, hi.x, hi.y}; }
    __syncthreads();
}

constexpr int SC_W = 0, SC_QD = 16384, SC_KDT = 32768, SC_AT = 49152, SC_BUF = 57344, SC_RMS = 2 * SC_BUF, SC_ZT = SC_RMS + 4096, SC_END = SC_ZT + 2 * 16384;
__device__ __forceinline__ int swz256(int row, int chunk) { return row * 256 + ((chunk ^ (row & 15)) << 4); }
__device__ __forceinline__ int swz128(int row, int ch) { return (row >> 1) * 256 + (((8 * (row & 1) + ch) ^ ((row >> 1) & 7)) << 4); }
__device__ __forceinline__ void scan_chain(const Args& a, LAS unsigned char* lds, int chain) {
    const int tid = threadIdx.x, lane = tid & 63, wave = __builtin_amdgcn_readfirstlane(tid >> 6), fr = lane & 15, fq = lane >> 4;
    const int b = chain >> 3, h = chain & 7;
    unsigned char* ws = a.ws;
    const bf16* QKVB = (const bf16*)(ws + WS_QKVB); const bf16* KDTg = (const bf16*)(ws + WS_KDT); const bf16* ATTg = (const bf16*)(ws + WS_ATTN); const float* LASTV = (const float*)(ws + WS_LASTV);
    bf16* ZS = (bf16*)(ws + WS_ZS);
    LAS float* RMS = (LAS float*)(lds + SC_RMS);
    const float gh = a.in[16][16 * wave + fr];
    f32x4 Sacc[8];
#pragma unroll
    for (int mt = 0; mt < 8; ++mt) Sacc[mt] = (f32x4){0.f, 0.f, 0.f, 0.f};
    v4u ztn[2]; v2u u0n[4]; float lastn;
    auto chunk_dma = [&](int c) {
        const size_t uq = (size_t)(b * NCH + c) * NH + h; const bf16* blk = QKVB + uq * QBLK; LAS unsigned char* base = lds + (c & 1) * SC_BUF;
#pragma unroll
        for (int k = 0; k < 2; ++k) { const int P = (wave + 8 * k) * 64 + lane, row = P >> 4, ch = (P & 15) ^ (row & 15);
            __builtin_amdgcn_global_load_lds((const unsigned*)(blk + 8192 + row * 128 + 8 * ch), (LAS unsigned*)(base + SC_W + (wave + 8 * k) * 1024), 16, 0, 0);
            __builtin_amdgcn_global_load_lds((const unsigned*)(blk + row * 128 + 8 * ch), (LAS unsigned*)(base + SC_QD + (wave + 8 * k) * 1024), 16, 0, 0);
            const int line = P >> 4, t = (P & 15) ^ (line & 7), r2 = 2 * line + (t >> 3);
            __builtin_amdgcn_global_load_lds((const unsigned*)(KDTg + uq * 8192 + r2 * 64 + 8 * (t & 7)), (LAS unsigned*)(base + SC_KDT + (wave + 8 * k) * 1024), 16, 0, 0); }
        { const int P = wave * 64 + lane, line = P >> 4, t = (P & 15) ^ (line & 7), r2 = 2 * line + (t >> 3);
            __builtin_amdgcn_global_load_lds((const unsigned*)(ATTg + uq * 4096 + r2 * 64 + 8 * (t & 7)), (LAS unsigned*)(base + SC_AT + wave * 1024), 16, 0, 0); }
    };
    auto side_load = [&](int c) {
        const size_t uq = (size_t)(b * NCH + c) * NH + h;
#pragma unroll
        for (int k = 0; k < 2; ++k) { const int p = tid + 512 * k; ztn[k] = *(const GAS v4u*)(ZS + (size_t)(b * TP + 64 * c + (p >> 4)) * DM + h * DH + 8 * (p & 15)); }
        const bf16* u0 = QKVB + uq * QBLK + 2 * 8192 + wave * 1024 + lane * 4;
#pragma unroll
        for (int m = 0; m < 4; ++m) u0n[m] = *(const GAS v2u*)(u0 + m * 256);
        lastn = LASTV[uq];
    };
    auto side_store = [&](int buf) {
#pragma unroll
        for (int k = 0; k < 2; ++k) { const int p = tid + 512 * k; *(LAS v4u*)(lds + SC_ZT + buf * 16384 + swz256(p >> 4, p & 15)) = ztn[k]; }
    };
    chunk_dma(0); side_load(0); side_store(0);
    v2u u0p[4]; float last;
#pragma unroll
    for (int m = 0; m < 4; ++m) u0p[m] = u0n[m];
    last = lastn;
    chunk_dma(1); side_load(1);
    __syncthreads();
    for (int c = 0; c < NCH; ++c) {
        const int buf = c & 1; LAS unsigned char* base = lds + buf * SC_BUF; LAS unsigned char* zt = lds + SC_ZT + buf * 16384;
        const int nvalid = (c == NCH - 1) ? TP - 64 * (NCH - 1) : 64;
        bf16x8v F[2][8];
#define SC_LD_A(m, f) do { _Pragma("unroll") for (int sI = 0; sI < 4; ++sI) { const int off = swz256(16 * (m) + fr, 4 * sI + fq); \
            f[2 * sI] = *(const LAS bf16x8v*)(base + SC_W + off); f[2 * sI + 1] = *(const LAS bf16x8v*)(base + SC_QD + off); } } while (0)
#define SC_LD_D(f) do { _Pragma("unroll") for (int m = 0; m < 4; ++m) _Pragma("unroll") for (int s2 = 0; s2 < 2; ++s2) f[2 * m + s2] = *(const LAS bf16x8v*)(base + SC_AT + swz128(16 * m + fr, 4 * s2 + fq)); } while (0)
#define SC_LD_C(g, f) do { _Pragma("unroll") for (int mm = 0; mm < 4; ++mm) _Pragma("unroll") for (int s2 = 0; s2 < 2; ++s2) f[2 * mm + s2] = *(const LAS bf16x8v*)(base + SC_KDT + swz128(16 * (4 * (g) + mm) + fr, 4 * s2 + fq)); } while (0)
        SC_LD_A(0, F[0]);
        bf16x8v Sb[4];
#pragma unroll
        for (int sI = 0; sI < 4; ++sI) { v4u w; w.x = cvtpk(Sacc[2 * sI][0], Sacc[2 * sI][1]); w.y = cvtpk(Sacc[2 * sI][2], Sacc[2 * sI][3]); w.z = cvtpk(Sacc[2 * sI + 1][0], Sacc[2 * sI + 1][1]); w.w = cvtpk(Sacc[2 * sI + 1][2], Sacc[2 * sI + 1][3]);
            Sb[sI] = __builtin_bit_cast(bf16x8v, w); }
        f32x4 u[4], o[4];
#pragma unroll
        for (int m = 0; m < 4; ++m) {
            if (m == 0) SC_LD_A(1, F[1]); else if (m == 1) SC_LD_A(2, F[0]); else if (m == 2) SC_LD_A(3, F[1]); else SC_LD_D(F[0]);
            __builtin_amdgcn_sched_barrier(0);
            f32x4 p = {0.f, 0.f, 0.f, 0.f}, oo = {0.f, 0.f, 0.f, 0.f};
#pragma unroll
            for (int sI = 0; sI < 4; ++sI) { p = __builtin_amdgcn_mfma_f32_16x16x32_bf16(F[m & 1][2 * sI], Sb[sI], p, 0, 0, 0); oo = __builtin_amdgcn_mfma_f32_16x16x32_bf16(F[m & 1][2 * sI + 1], Sb[sI], oo, 0, 0, 0); }
            u[m] = (f32x4){bflo(u0p[m].x), bfhi(u0p[m].x), bflo(u0p[m].y), bfhi(u0p[m].y)} - p; o[m] = oo;
            __builtin_amdgcn_sched_barrier(0);
        }
        bf16x8v Ub[2];
#pragma unroll
        for (int s2 = 0; s2 < 2; ++s2) { v4u w; w.x = cvtpk(u[2 * s2][0], u[2 * s2][1]); w.y = cvtpk(u[2 * s2][2], u[2 * s2][3]); w.z = cvtpk(u[2 * s2 + 1][0], u[2 * s2 + 1][1]); w.w = cvtpk(u[2 * s2 + 1][2], u[2 * s2 + 1][3]);
            Ub[s2] = __builtin_bit_cast(bf16x8v, w); }
        SC_LD_C(0, F[1]);
        __builtin_amdgcn_sched_barrier(0);
#pragma unroll
        for (int m = 0; m < 4; ++m)
#pragma unroll
            for (int s2 = 0; s2 < 2; ++s2) o[m] = __builtin_amdgcn_mfma_f32_16x16x32_bf16(F[0][2 * m + s2], Ub[s2], o[m], 0, 0, 0);
        __builtin_amdgcn_sched_barrier(0);
        SC_LD_C(1, F[0]);
        __builtin_amdgcn_sched_barrier(0);
#pragma unroll
        for (int mt = 0; mt < 4; ++mt) { f32x4 sacc = Sacc[mt] * last;
#pragma unroll
            for (int s2 = 0; s2 < 2; ++s2) sacc = __builtin_amdgcn_mfma_f32_16x16x32_bf16(F[1][2 * mt + s2], Ub[s2], sacc, 0, 0, 0);
            Sacc[mt] = sacc; }
        __builtin_amdgcn_sched_barrier(0);
#pragma unroll
        for (int mt = 4; mt < 8; ++mt) { f32x4 sacc = Sacc[mt] * last;
#pragma unroll
            for (int s2 = 0; s2 < 2; ++s2) sacc = __builtin_amdgcn_mfma_f32_16x16x32_bf16(F[0][2 * (mt - 4) + s2], Ub[s2], sacc, 0, 0, 0);
            Sacc[mt] = sacc; }
#undef SC_LD_A
#undef SC_LD_D
#undef SC_LD_C
        LAS float* rm = RMS + (c & 1) * 512;
#pragma unroll
        for (int m = 0; m < 4; ++m)
#pragma unroll
            for (int r = 0; r < 4; ++r) { const float v = sum16(o[m][r] * o[m][r]); if (fr == 0) rm[(16 * m + 4 * fq + r) * 8 + wave] = v; }
        if (c + 1 < NCH) { side_store(buf ^ 1);
#pragma unroll
            for (int m = 0; m < 4; ++m) u0p[m] = u0n[m];
            last = lastn; }
        __syncthreads();
        if (c + 2 < NCH) side_load(c + 2);
        {   LAS float* rsw = RMS + ((c + 1) & 1) * 512 + wave * 64;
            const f32x4 p0 = *(const LAS f32x4*)(rm + lane * 8), p1 = *(const LAS f32x4*)(rm + lane * 8 + 4);
            LAS bf16* zp[16]; bf16 zv[16];
#pragma unroll
            for (int m = 0; m < 4; ++m)
#pragma unroll
                for (int r = 0; r < 4; ++r) { zp[4 * m + r] = (LAS bf16*)(zt + swz256(16 * m + 4 * fq + r, 2 * wave + (fr >> 3))) + (fr & 7); zv[4 * m + r] = *zp[4 * m + r]; }
            rsw[lane] = rsqf((((p0.x + p0.y) + (p0.z + p0.w)) + ((p1.x + p1.y) + (p1.z + p1.w))) * (1.f / DH) + EPS);
            f32x4 rs[4];
#pragma unroll
            for (int m = 0; m < 4; ++m) rs[m] = *(const LAS f32x4*)(rsw + 16 * m + 4 * fq);
            __builtin_amdgcn_sched_barrier(0);
#pragma unroll
            for (int m = 0; m < 4; ++m)
#pragma unroll
                for (int r = 0; r < 4; ++r) *zp[4 * m + r] = (bf16)f2bf(o[m][r] * rs[m][r] * gh * bf1(zv[4 * m + r]));
        }
        __syncthreads();
        if (c + 2 < NCH) chunk_dma(c + 2);
#pragma unroll
        for (int k = 0; k < 2; ++k) { const int p = tid + 512 * k, i = p >> 4;
            if (i < nvalid) *(GAS v4u*)(ZS + (size_t)(b * TP + 64 * c + i) * DM + h * DH + 8 * (p & 15)) = *(const LAS v4u*)(zt + swz256(i, p & 15)); }
    }
    { float* so = a.out + O_PD + ((size_t)(b * NH + h) * DH) * DH + 16 * wave + fr;
#pragma unroll
      for (int mt = 0; mt < 8; ++mt)
#pragma unroll
          for (int r = 0; r < 4; ++r) so[(size_t)(16 * mt + 4 * fq + r) * DH] = Sacc[mt][r]; }
    __syncthreads();
}

static_assert(SC_END <= LDSCTL_OFF && 2 * IH_BYTES <= LDSCTL_OFF && RING_BYTES <= LDSCTL_OFF, "LDS map");
constexpr int NPHASES = 10;
__global__ void __launch_bounds__(NWAVES * 64, 2) fwd_kernel(Args args) {
    extern __shared__ __attribute__((aligned(16))) unsigned char lds_raw[];
    LAS unsigned char* lds = (LAS unsigned char*)lds_raw;
    volatile LAS unsigned* MISC = (volatile LAS unsigned*)(lds + MISC_OFF);
    const int tid = threadIdx.x, lane = tid & 63, wave = __builtin_amdgcn_readfirstlane(tid >> 6);
    const int G = gridDim.x, bx = blockIdx.x;
    const int vcu = (G % 8 == 0) ? (bx % 8) * (G / 8) + bx / 8 : bx;
    unsigned char* ws = args.ws;
    gu32* ctl = (gu32*)(ws + WS_CTL);
    for (int u = tid; u < (LDS_BYTES - LDSCTL_OFF) / 4; u += NWAVES * 64) ((LAS unsigned*)(lds + LDSCTL_OFF))[u] = 0u;
    __syncthreads();
    XcdBarrier bar; bar.bar = (unsigned*)(ctl + CW_BAR); bar.x = 0; bar.st = nullptr;
    const int lo = args.ph_lo, hi = args.ph_hi;
    if (hi - lo > 1) bar = xcd_barrier_post((unsigned*)(ctl + CW_BAR), MISC + 8);
#ifndef PH_MASK
#define PH_MASK 0x3ff
#endif
#define IN(k) (((PH_MASK >> (k)) & 1) && lo <= (k) && (k) < hi)
#ifndef PROBE_K
#define PROBE_K -1
#endif
#if PROBE_K >= 0
    volatile LAS unsigned long long* stamps = (volatile LAS unsigned long long*)(lds + MISC_OFF + 128);
    if (tid == 0) stamps[0] = __builtin_amdgcn_s_memrealtime();
#define SEAM(k) do { if (IN(k) && IN((k) + 1)) xcd_barrier(bar); if (tid == 0) stamps[(k) + 1] = __builtin_amdgcn_s_memrealtime(); } while (0)
#else
#define SEAM(k) do { if (IN(k) && IN((k) + 1)) xcd_barrier(bar); } while (0)
#endif
    bf16* WIN = (bf16*)(ws + WS_WIN); bf16* WC = (bf16*)(ws + WS_WC); bf16* WD = (bf16*)(ws + WS_WD); bf16* WO = (bf16*)(ws + WS_WO); bf16* WUP = (bf16*)(ws + WS_WUP); bf16* WDN = (bf16*)(ws + WS_WDN);
    bf16* H = (bf16*)(ws + WS_H); bf16* GLU = (bf16*)(ws + WS_GLU); bf16* QKVB = (bf16*)(ws + WS_QKVB); bf16* QS = (bf16*)(ws + WS_QS); bf16* ZS = (bf16*)(ws + WS_ZS);
    bf16* HALOQ = (bf16*)(ws + WS_HALOQ); bf16* HALOC = (bf16*)(ws + WS_HALOC);
    bf16* SGC = (bf16*)args.out; bf16* SGD = (bf16*)args.out + (size_t)M2 * DM;
    bf16* X1B = (bf16*)(ws + WS_X1B);
    bf16* MIX = (bf16*)(ws + WS_MIX); bf16* XG = (bf16*)(ws + WS_XG); bf16* HM = (bf16*)(ws + WS_HM); bf16* C = (bf16*)(ws + WS_C);
    float* BETAG = (float*)(ws + WS_BETAG);
    const int gw = vcu * NWAVES + wave, NGW = G * NWAVES;

    constexpr int KB1 = DM / 32, KB4 = DFF / 32, I_SQ = KB1 * (DM / 64), I_UP = KB1 * (DFF / 64), I_DN = KB4 * (DM / 64);
    constexpr int NU1 = (MP / 256) * (NIN / 256), NU4 = (MP / 256) * (DM / 256), NU7 = (M2 / 256) * (DFF / 256);
#define CONVERT_ITEMS(lo_, hi_, w0_, nw_) do { for (int it_ = (lo_) + (w0_); it_ < (hi_); it_ += (nw_)) { int r = it_; \
        if (r < I_SQ) { p0_transpose_item(args.in[12], DM, DM, WC, (r / KB1) * 64, (r / KB1) * 64, 64, (r % KB1) * 32, lane); continue; } r -= I_SQ; \
        if (r < I_SQ) { p0_transpose_item(args.in[17], DM, DM, WD, (r / KB1) * 64, (r / KB1) * 64, 64, (r % KB1) * 32, lane); continue; } r -= I_SQ; \
        if (r < I_SQ) { p0_transpose_item(args.in[18], DM, DM, WO, (r / KB1) * 64, (r / KB1) * 64, 64, (r % KB1) * 32, lane); continue; } r -= I_SQ; \
        if (r < I_UP) { p0_transpose_item(args.in[20], DFF, DM, WUP, (r / KB1) * 64, (r / KB1) * 64, 64, (r % KB1) * 32, lane); continue; } r -= I_UP; \
        p0_transpose_item(args.in[21], DM, DFF, WDN, (r / KB4) * 64, (r / KB4) * 64, 64, (r % KB4) * 32, lane); } } while (0)
    if (IN(0)) {
        constexpr int I_IN = KB1 * (NIN / 64);
        for (int it = gw; it < I_IN; it += NGW) { const int nb = it / KB1, kb = it % KB1; int src, nv; win_src(nb, src, nv); p0_transpose_item(args.in[7], DIN, DM, WIN, nb * 64, src, nv, kb * 32, lane); }
        for (int m0 = gw; m0 < MP; m0 += 2 * NGW) {
            const float* src[2]; bool ok[2]; f32x4 v[2][4];
#pragma unroll
            for (int q = 0; q < 2; ++q) { const int m = m0 + q * NGW; ok[q] = m < MR; const int mm = ok[q] ? m : 0;
                if (mm >= RP) src[q] = args.in[1] + (size_t)(mm - RP) * DM;
                else { const int b = mm / TP, t = mm - b * TP; src[q] = t < NMETA ? args.in[5] + (size_t)t * DM : args.in[0] + ((size_t)b * SEQ + (t - NMETA)) * DM; }
#pragma unroll
                for (int j = 0; j < 4; ++j) v[q][j] = ((const GAS f32x4*)src[q])[lane + 64 * j]; }
#pragma unroll
            for (int q = 0; q < 2; ++q) { const int m = m0 + q * NGW; if (m >= MP) continue;
                float ss = 0.f;
#pragma unroll
                for (int j = 0; j < 4; ++j) ss += (v[q][j].x * v[q][j].x + v[q][j].y * v[q][j].y) + (v[q][j].z * v[q][j].z + v[q][j].w * v[q][j].w);
                const float rstd = ok[q] ? rsqf(wave_sum(ss) * (1.f / DM) + EPS) : 0.f;
                GAS v2u* o8 = (GAS v2u*)(H + (size_t)m * DM) + lane;
#pragma unroll
                for (int j = 0; j < 4; ++j) { const f32x4 g = ((const GAS f32x4*)args.in[6])[lane + 64 * j]; v2u o; o.x = cvtpk(v[q][j].x * rstd * g.x, v[q][j].y * rstd * g.y); o.y = cvtpk(v[q][j].z * rstd * g.z, v[q][j].w * rstd * g.w); o8[64 * j] = o; } }
        }
    }
    SEAM(0);
    if (IN(1)) {
        pg8::Gemm g{H, WIN, MP, NIN, DM}; pg8::StaticOrder S; S.init(MP, NIN, G, bx, DM);
        EpiIn E{GLU, QKVB, QS, HALOQ, HALOC, ZS, SGC, SGD, BETAG, args.in[14], args.in[15]};
        pg8::gemm_phase<EpiIn, pg8::StaticOrder, true, true>(lds + RING_OFF, g, S, E);
        if (G == 256) { if (bx >= NU1 % 256) CONVERT_ITEMS(0, 2 * I_SQ, (bx - NU1 % 256) * NWAVES + wave, (256 - NU1 % 256) * NWAVES); }
        else CONVERT_ITEMS(0, 3 * I_SQ + I_UP + I_DN, gw, NGW);
    }
    SEAM(1);
    if (IN(2)) {
        constexpr int N_CP = BP * NRUN, N_IP = BP * NCH * NH / 2, N_SD = BS * NH / 4, N_CS = BS, N_ITEMS = N_CP + N_IP + N_SD + N_CS;
        volatile LAS int* qslot = (volatile LAS int*)(lds + MISC_OFF + 64);
#if PROBE_K >= 0
        for (int sub = 0; sub < 3; ++sub) {
            const int lo_i = sub == 0 ? 0 : (sub == 1 ? N_CP : N_CP + N_IP), hi_i = sub == 0 ? N_CP : (sub == 1 ? N_CP + N_IP : N_CP + N_IP + N_SD);
            for (;;) {
                if (tid == 0) *qslot = (int)__hip_atomic_fetch_add((unsigned*)(ctl + 2048 + 64 * sub), 1u, __ATOMIC_RELAXED, __HIP_MEMORY_SCOPE_AGENT);
                __syncthreads();
                int it = *qslot + lo_i;
                __syncthreads();
                if (sub == 0 && it >= N_CP) { it += N_IP + N_SD; if (it >= N_ITEMS) break; conv_unit<1>(args, lds, it - (N_CP + N_IP + N_SD), 0); continue; }
                if (it >= hi_i) break;
                if (it < N_CP) { conv_unit<0>(args, lds, it / NRUN, it % NRUN); continue; } it -= N_CP;
                if (it < N_IP) { intra_pair(args, lds, it); continue; } it -= N_IP;
                (void)it;
            }
            if (sub < 2) { xcd_barrier(bar); if (tid == 0) stamps[12 + sub] = __builtin_amdgcn_s_memrealtime(); }
        }
#else
        for (;;) {
            if (tid == 0) *qslot = (int)__hip_atomic_fetch_add((unsigned*)(ctl + 2048), 1u, __ATOMIC_RELAXED, __HIP_MEMORY_SCOPE_AGENT);
            __syncthreads();
            int it = *qslot;
            __syncthreads();
            if (it >= N_CP + N_IP) it += N_SD;
            if (it >= N_ITEMS) break;
            if (it < N_CP) { conv_unit<0>(args, lds, it / NRUN, it % NRUN); continue; } it -= N_CP;
            if (it < N_IP) { intra_pair(args, lds, it); continue; } it -= N_IP;
            it -= N_SD; if (it < 0) continue;
            conv_unit<1>(args, lds, it, 0);
        }
#endif
    }
    SEAM(2);
    if (IN(3)) {
        if (bx < BP * NH) { scan_chain(args, lds, bx);
#if PROBE_K >= 0
            if (tid == 0) stamps[14] = __builtin_amdgcn_s_memrealtime();
#endif
        }
#if defined(PROBE_SCAN_ALONE)
        xcd_barrier(bar);
        if (bx < BP * NH) {}
#endif
        else {
            pg8::Gemm g{C, WC, MP, DM, DM}; pg8::StaticOrder S; S.init(MP, DM, G - BP * NH, bx - BP * NH, DM);
            EpiGate<0> E{SGC, nullptr, SGC};
            pg8::gemm_phase<EpiGate<0>, pg8::StaticOrder, true, true>(lds + RING_OFF, g, S, E);
            volatile LAS int* qslot = (volatile LAS int*)(lds + MISC_OFF + 64);
            for (;;) {
                if (tid == 0) *qslot = (int)__hip_atomic_fetch_add((unsigned*)(ctl + 2048 + 256), 1u, __ATOMIC_RELAXED, __HIP_MEMORY_SCOPE_AGENT);
                __syncthreads();
                const int it = *qslot;
                __syncthreads();
                if (it >= BS * NH / 4) break;
                delta_item(args, lds, it);
            }
        }
    }
    SEAM(3);
    if (IN(4)) {
        pg8::Gemm g{ZS, WD, MP, DM, DM}; pg8::StaticOrder S; S.init(MP, DM, G, bx, DM);
        EpiGate<1> E{SGD, SGC, MIX};
        pg8::gemm_phase<EpiGate<1>, pg8::StaticOrder, true, true>(lds + RING_OFF, g, S, E);
        if (G == 256 && bx >= NU4 % 256) CONVERT_ITEMS(2 * I_SQ, 3 * I_SQ + I_UP, (bx - NU4 % 256) * NWAVES + wave, (256 - NU4 % 256) * NWAVES);
    }
    SEAM(4);
    if (IN(5)) {
        pg8::Gemm g{MIX, WO, M2, DM, DM}; pg8::SplitOrder S; S.init(BP * SEQ, M2, DM, G, bx, DM, KSPLIT5);
        EpiWoP E; E.xp = args.in[0]; E.X1B = X1B; E.parts = (float*)(ws + WS_PART5);
        pg8::gemm_phase<EpiWoP, pg8::SplitOrder, true, true>(lds + RING_OFF, g, S, E);
    }
    SEAM(5);
    if (IN(6)) {
        for (int i0 = gw; i0 < M2; i0 += 2 * NGW) {
            f32x4 v[2][4]; int mrow[2]; bool ok[2];
#pragma unroll
            for (int q = 0; q < 2; ++q) { const int i = i0 + q * NGW; ok[q] = i < M2; const int ii = ok[q] ? i : 0; const int m = ii < RS ? BP * SEQ + ii : ii - RS; mrow[q] = m;
                if (m >= BP * SEQ) { const GAS f32x4* x0 = (const GAS f32x4*)(args.in[1] + (size_t)(m - BP * SEQ) * DM) + lane;
#pragma unroll
                    for (int jj = 0; jj < 4; ++jj) v[q][jj] = x0[64 * jj];
                } else { const GAS v2u* xb = (const GAS v2u*)(X1B + (size_t)m * DM) + lane;
#pragma unroll
                    for (int jj = 0; jj < 4; ++jj) { const v2u o = xb[64 * jj]; v[q][jj] = (f32x4){bflo(o.x), bfhi(o.x), bflo(o.y), bfhi(o.y)}; } } }
#pragma unroll
            for (int q = 0; q < 2; ++q) { const int m = mrow[q]; if (!ok[q]) continue;
                if (m >= BP * SEQ) {
                    const GAS f32x4* pr = (const GAS f32x4*)((const float*)(ws + WS_PART5) + (size_t)(m - BP * SEQ) * DM) + lane; GAS v2u* xb = (GAS v2u*)(X1B + (size_t)m * DM) + lane;
#pragma unroll
                    for (int jj = 0; jj < 4; ++jj) {
#pragma unroll
                        for (int ks = 0; ks < KSPLIT5; ++ks) v[q][jj] += pr[(size_t)ks * RS * DM / 4 + 64 * jj];
                        v2u o; o.x = cvtpk(v[q][jj].x, v[q][jj].y); o.y = cvtpk(v[q][jj].z, v[q][jj].w); xb[64 * jj] = o;
                        v[q][jj] = (f32x4){bflo(o.x), bfhi(o.x), bflo(o.y), bfhi(o.y)}; } }
                float ss = 0.f;
#pragma unroll
                for (int jj = 0; jj < 4; ++jj) ss += (v[q][jj].x * v[q][jj].x + v[q][jj].y * v[q][jj].y) + (v[q][jj].z * v[q][jj].z + v[q][jj].w * v[q][jj].w);
                const float rstd = rsqf(wave_sum(ss) * (1.f / DM) + EPS);
                GAS v2u* o8 = (GAS v2u*)(XG + (size_t)m * DM) + lane; const GAS f32x4* gr = (const GAS f32x4*)args.in[19] + lane;
#pragma unroll
                for (int jj = 0; jj < 4; ++jj) { const f32x4 g = gr[64 * jj]; v2u o; o.x = cvtpk(v[q][jj].x * rstd * g.x, v[q][jj].y * rstd * g.y); o.y = cvtpk(v[q][jj].z * rstd * g.z, v[q][jj].w * rstd * g.w); o8[64 * jj] = o; } }
        }
    }
    SEAM(6);
    if (IN(7)) {
        pg8::Gemm g{XG, WUP, M2, DFF, DM}; pg8::StaticOrder S; S.init(M2, DFF, G, bx, DM);
        EpiUp E{HM};
        pg8::gemm_phase<EpiUp, pg8::StaticOrder, true, true>(lds + RING_OFF, g, S, E);
        if (G == 256 && bx >= NU7 % 256) CONVERT_ITEMS(3 * I_SQ + I_UP, 3 * I_SQ + I_UP + I_DN, (bx - NU7 % 256) * NWAVES + wave, (256 - NU7 % 256) * NWAVES);
    }
    SEAM(7);
    if (IN(8)) {
        pg8::Gemm g{HM, WDN, M2, DM, DFF}; pg8::SplitOrder S; S.init(BP * SEQ, M2, DM, G, bx, DFF, KSPLIT);
        EpiRes<1> E{nullptr, nullptr, args.out, (float*)(ws + WS_PART), X1B};
        pg8::gemm_phase<EpiRes<1>, pg8::SplitOrder, true, true>(lds + RING_OFF, g, S, E);
    }
    SEAM(8);
    if (IN(9)) {
        for (int i0 = gw; i0 < M2; i0 += 2 * NGW) {
            f32x4 v[2][4]; int mrow[2]; bool ok[2];
#pragma unroll
            for (int q = 0; q < 2; ++q) { const int i = i0 + q * NGW; ok[q] = i < M2; const int ii = ok[q] ? i : 0; const int m = ii < RS ? BP * SEQ + ii : ii - RS; mrow[q] = m;
                const GAS v2u* xb = (const GAS v2u*)(X1B + (size_t)m * DM) + lane;
#pragma unroll
                for (int jj = 0; jj < 4; ++jj) { const v2u o = xb[64 * jj]; v[q][jj] = (f32x4){bflo(o.x), bfhi(o.x), bflo(o.y), bfhi(o.y)}; } }
#pragma unroll
            for (int q = 0; q < 2; ++q) { const int m = mrow[q]; if (!ok[q]) continue;
                if (m >= BP * SEQ) { const GAS f32x4* pr = (const GAS f32x4*)((const float*)(ws + WS_PART) + (size_t)(m - BP * SEQ) * DM) + lane;
#pragma unroll 4
                    for (int ks = 0; ks < KSPLIT; ++ks)
#pragma unroll
                        for (int jj = 0; jj < 4; ++jj) v[q][jj] += pr[(size_t)ks * RS * DM / 4 + 64 * jj]; }
                float s2 = 0.f;
#pragma unroll
                for (int jj = 0; jj < 4; ++jj) s2 += (v[q][jj].x * v[q][jj].x + v[q][jj].y * v[q][jj].y) + (v[q][jj].z * v[q][jj].z + v[q][jj].w * v[q][jj].w);
                const float rstd = rsqf(wave_sum(s2) * (1.f / DM) + EPS);
                GAS f32x4* xr = (GAS f32x4*)(args.out + (size_t)m * DM) + lane; const GAS f32x4* gr = (const GAS f32x4*)args.in[22] + lane;
#pragma unroll
                for (int jj = 0; jj < 4; ++jj) xr[64 * jj] = v[q][jj] * rstd * gr[64 * jj]; }
        }
    }
#if PROBE_K >= 0
    __syncthreads();
    if (bx == 0) { if (tid == 0) stamps[NPHASES] = __builtin_amdgcn_s_memrealtime(); __syncthreads();
        const float dt_us = (float)(stamps[PROBE_B] - stamps[PROBE_K]) * 0.01f; const float f = 1.f + dt_us * (1.f / (float)(PROBE_DIV));
        for (int i = tid; i < BP * 3 * DQKV; i += NWAVES * 64) args.out[O_PQ + i] *= f; }
#endif
#undef IN
#undef SEAM
}

extern "C" void kernel_launch(void* const* d_in, const int* in_sizes, int n_in, void* d_out, int out_size, void* d_ws, size_t ws_size, hipStream_t stream) {
    static int grid = 0;
    if (grid == 0) {
        if (n_in != 23 || (size_t)out_size != O_END || ws_size < WS_END) { fprintf(stderr, "kernel_launch: unexpected shapes n_in %d out %d ws %zu\n", n_in, out_size, ws_size); grid = -1; return; }
        int dev = 0, cus = 0, per_cu = 0;
        if (hipGetDevice(&dev) != hipSuccess || hipDeviceGetAttribute(&cus, hipDeviceAttributeMultiprocessorCount, dev) != hipSuccess) { grid = -1; return; }
        if (hipFuncSetAttribute((const void*)fwd_kernel, hipFuncAttributeMaxDynamicSharedMemorySize, LDS_BYTES) != hipSuccess) { fprintf(stderr, "kernel_launch: hipFuncSetAttribute failed\n"); grid = -1; return; }
        if (hipOccupancyMaxActiveBlocksPerMultiprocessor(&per_cu, (const void*)fwd_kernel, NWAVES * 64, LDS_BYTES) != hipSuccess || per_cu < 1)
            fprintf(stderr, "kernel_launch: occupancy query reports %d\n", per_cu);
        (void)hipGetLastError();
        grid = cus;
    }
    if (grid < 0) return;
    if (hipMemsetAsync((char*)d_ws + WS_CTL, 0, CTL_ZERO_BYTES, stream) != hipSuccess) return;
    Args a{};
    for (int i = 0; i < 23; ++i) a.in[i] = (const float*)d_in[i];
    a.out = (float*)d_out; a.ws = (unsigned char*)d_ws;
#if MK_N_LAUNCHES == 1
    a.ph_lo = 0; a.ph_hi = NPHASES;
    hipLaunchKernelGGL(fwd_kernel, dim3(grid), dim3(NWAVES * 64), LDS_BYTES, stream, a);
#else
    for (int p = 0; p < NPHASES; ++p) { a.ph_lo = p; a.ph_hi = p + 1; hipLaunchKernelGGL(fwd_kernel, dim3(grid), dim3(NWAVES * 64), LDS_BYTES, stream, a); }
#endif
}
```

```cpp
#include <hip/hip_runtime.h>
#include <cstdio>
#include <cstdint>

#ifndef MK_N_LAUNCHES
#define MK_N_LAUNCHES 1
#endif

namespace pg8 {
#define PG8_LAS __attribute__((address_space(3)))
typedef unsigned short bf16_t;
typedef short bf16x8 __attribute__((ext_vector_type(8)));
typedef float f32x4 __attribute__((ext_vector_type(4)));
typedef unsigned u32x4 __attribute__((ext_vector_type(4)));
constexpr int BM = 256, BK = 64, HALF = 128, HTB = HALF * BK * 2, STAGE_BYTES = 8 * HTB, NXCD = 8, WGM = 8;

__host__ __device__ __forceinline__ int lds_byte(int r, int c) { const int st = (r >> 4) * 2 + (c >> 5), rr = r & 15, cc = c & 31, ob = rr * 64 + cc * 2; return st * 1024 + (ob ^ (((ob >> 9) & 1) << 5)); }
__host__ __device__ __forceinline__ void stage_rc(int b, int& R, int& C) { const int st = b / 1024, sb = b % 1024, swz = sb ^ (((sb >> 9) & 1) << 5); R = (st >> 1) * 16 + swz / 64; C = (st & 1) * 32 + (swz % 64) / 2; }
__host__ __device__ __forceinline__ int perm32(int rho) { const int n = rho >> 4, i = rho & 15; return 8 * (i >> 2) + 4 * n + (i & 3); }

struct Unit { int pm, pn, k0, nt, typ; };
struct Gemm { const bf16_t* A; const bf16_t* Bt; int M, N, K;
    __device__ __forceinline__ const char* a(const Unit&) const { return (const char*)A; } __device__ __forceinline__ const char* b(const Unit&) const { return (const char*)Bt; } };
struct Gemm2 { const bf16_t *A0, *B0, *A1, *B1; int K;
    __device__ __forceinline__ const char* a(const Unit& u) const { return (const char*)(u.typ ? A1 : A0); } __device__ __forceinline__ const char* b(const Unit& u) const { return (const char*)(u.typ ? B1 : B0); } };

struct StaticOrder {
    int nM, nN, nwg, G, c, nt;
    __host__ __device__ void init(int M, int N, int G_, int c_, int K) { nM = M / BM; nN = N / BM; nwg = nM * nN; G = G_; c = c_; nt = K / BK; }
    __host__ __device__ __forceinline__ bool next(int i, Unit& u) const {
        const long L = (long)i * G + c; if (L >= nwg) return false;
        u.k0 = 0; u.nt = nt; u.typ = 0;
        int wgid = (int)L; { const int q = nwg / NXCD, r = nwg % NXCD, xcd = wgid % NXCD, off = wgid / NXCD; wgid = (xcd < r ? xcd * (q + 1) : r * (q + 1) + (xcd - r) * q) + off; }
        const int nig = WGM * nN, gid = wgid / nig, fm = gid * WGM, gsz = (nM - fm) < WGM ? (nM - fm) : WGM;
        u.pm = fm + ((wgid % nig) % gsz); u.pn = (wgid % nig) / gsz; return true;
    }
    __device__ __forceinline__ void a_ready(const Unit&) const {}
    __device__ __forceinline__ void done(const Unit&) const {}
};

struct SplitOrder {
    int nM, nN, nwg, G, c, ntfull, nsub, KS, ntsub;
    __host__ __device__ void init(int Mmain, int Mall, int N, int G_, int c_, int K, int KS_) { nM = Mmain / BM; nN = N / BM; nwg = nM * nN; G = G_; c = c_; ntfull = K / BK; KS = KS_; ntsub = K / BK / KS_; nsub = (Mall / BM - nM) * nN * KS_; }
    __host__ __device__ __forceinline__ bool next(int i, Unit& u) const {
        const long L = (long)i * G + c; if (L >= nwg + nsub) return false;
        int pm, pn, k0, ntu;
        if (L < nwg) {
            int wgid = (int)L; { const int q = nwg / NXCD, r = nwg % NXCD, xcd = wgid % NXCD, off = wgid / NXCD; wgid = (xcd < r ? xcd * (q + 1) : r * (q + 1) + (xcd - r) * q) + off; }
            const int nig = WGM * nN, gid = wgid / nig, fm = gid * WGM, gsz = (nM - fm) < WGM ? (nM - fm) : WGM;
            pm = fm + ((wgid % nig) % gsz); pn = (wgid % nig) / gsz; k0 = 0; ntu = ntfull;
        } else { const int j = (int)L - nwg, tile = j / KS, ks = j % KS; pm = nM + tile / nN; pn = tile % nN; k0 = ks * ntsub; ntu = ntsub; }
        u.pm = pm; u.pn = pn; u.k0 = k0; u.nt = ntu; u.typ = 0; return true;
    }
    __device__ __forceinline__ void a_ready(const Unit&) const {}
    __device__ __forceinline__ void done(const Unit&) const {}
};

__device__ __forceinline__ unsigned cvt_pk_bf16(float lo, float hi) { unsigned r; asm volatile("v_cvt_pk_bf16_f32 %0, %1, %2" : "=v"(r) : "v"(lo), "v"(hi)); return r; }

template <class Epi, class Sched, bool ALIGN_EPI = false, bool SP2 = false, class GemmT = Gemm>
__device__ __forceinline__ void gemm_phase(PG8_LAS unsigned char* lds, const GemmT g, const Sched& S, const Epi& E) {
    const int tid = threadIdx.x, wid = __builtin_amdgcn_readfirstlane(tid >> 6), lane = tid & 63, wr = wid >> 2, wc = wid & 3, fr = lane & 15, fq = lane >> 4;
    const int K = g.K;
    unsigned voffA[2], voffB[2];
#pragma unroll
    for (int i = 0; i < 2; ++i) { int R, C; stage_rc(tid * 16 + i * 8192, R, C); const int Rb = Epi::PERM ? ((R & ~31) + perm32(R & 31)) : R;
        voffA[i] = (unsigned)(R * K + C) * 2u; voffB[i] = (unsigned)(Rb * K + C) * 2u; }
    const size_t kstep = (size_t)(BK * 2);
    const size_t hstep = (size_t)HALF * K * 2;
    const size_t tstep = 2 * hstep;
    const unsigned ldsw = (unsigned)wid * 1024u;
    const int aoff = lds_byte(wr * 64 + fr, fq * 8), boff = lds_byte(wc * 32 + fr, fq * 8);
#define PG8_SA(b, h) (((b) * 2 + (h)) * HTB)
#define PG8_SB(b, h) ((4 + (b) * 2 + (h)) * HTB)
#define PG8_STAGE(bufoff, gbase, voff) do { _Pragma("unroll") for (int _i = 0; _i < 2; ++_i) \
        __builtin_amdgcn_global_load_lds((const unsigned*)((const char*)(gbase) + (voff)[_i]), (PG8_LAS unsigned*)(lds + (bufoff) + ldsw + _i * 8192), 16, 0, 0); } while (0)
#define PG8_LDA(dst, b, h) do { _Pragma("unroll") for (int m = 0; m < 4; ++m) _Pragma("unroll") for (int k = 0; k < 2; ++k) dst[m][k] = *(const PG8_LAS bf16x8*)(lds + PG8_SA(b, h) + aoff + m * 2048 + k * 1024); } while (0)
#define PG8_LDB(dst, b, h) do { _Pragma("unroll") for (int n = 0; n < 2; ++n) _Pragma("unroll") for (int k = 0; k < 2; ++k) dst[n][k] = *(const PG8_LAS bf16x8*)(lds + PG8_SB(b, h) + boff + n * 2048 + k * 1024); } while (0)
#define PG8_MMA(ai, bj, At, Bt) do { __builtin_amdgcn_s_setprio(1); _Pragma("unroll") for (int m = 0; m < 4; ++m) _Pragma("unroll") for (int n = 0; n < 2; ++n) _Pragma("unroll") for (int k = 0; k < 2; ++k) \
        acc[ai][bj][m][n] = __builtin_amdgcn_mfma_f32_16x16x32_bf16(Bt[n][k], At[m][k], acc[ai][bj][m][n], 0, 0, 0); __builtin_amdgcn_s_setprio(0); } while (0)
#define PG8_WAIT_V(n) asm volatile("s_waitcnt vmcnt(" #n ")" ::: "memory")
#define PG8_WAIT_L(n) asm volatile("s_waitcnt lgkmcnt(" #n ")" ::: "memory")
#define PG8_BAR __builtin_amdgcn_s_barrier()
#define PG8_SCHED __builtin_amdgcn_sched_barrier(0)
    Unit cur, nxt; int ui = 0;
    if (!S.next(0, cur)) return;
    f32x4 acc[2][2][4][2];
#pragma unroll
    for (int a = 0; a < 2; ++a)
#pragma unroll
        for (int b = 0; b < 2; ++b)
#pragma unroll
            for (int m = 0; m < 4; ++m)
#pragma unroll
                for (int n = 0; n < 2; ++n) acc[a][b][m][n] = (f32x4){0.f, 0.f, 0.f, 0.f};
    bf16x8 At[4][2], B0[2][2], B1[2][2];
    const char* cA = g.a(cur) + (size_t)cur.pm * tstep + (size_t)cur.k0 * kstep; const char* cB = g.b(cur) + (size_t)cur.pn * tstep + (size_t)cur.k0 * kstep;
    S.a_ready(cur);
    if constexpr (SP2) {
        PG8_STAGE(PG8_SB(0, 0), cB, voffB); PG8_STAGE(PG8_SB(0, 1), cB + hstep, voffB); PG8_STAGE(PG8_SA(0, 0), cA, voffA); PG8_STAGE(PG8_SA(0, 1), cA + hstep, voffA);
        if (wr == 1) PG8_BAR;
        PG8_WAIT_V(2); PG8_BAR;
        PG8_STAGE(PG8_SB(1, 0), cB + kstep, voffB); PG8_STAGE(PG8_SA(1, 0), cA + kstep, voffA); PG8_STAGE(PG8_SB(1, 1), cB + hstep + kstep, voffB);
        PG8_WAIT_V(6); PG8_BAR;
    } else {
        PG8_STAGE(PG8_SB(0, 0), cB, voffB); PG8_STAGE(PG8_SA(0, 0), cA, voffA); PG8_STAGE(PG8_SB(0, 1), cB + hstep, voffB); PG8_STAGE(PG8_SA(0, 1), cA + hstep, voffA);
        if (wr == 1) PG8_BAR;
        PG8_WAIT_V(4); PG8_BAR;
        PG8_STAGE(PG8_SB(1, 0), cB + kstep, voffB); PG8_STAGE(PG8_SA(1, 0), cA + kstep, voffA); PG8_STAGE(PG8_SB(1, 1), cB + hstep + kstep, voffB);
        PG8_WAIT_V(6); PG8_BAR;
    }
    for (;;) {
        const bool has_next = S.next(ui + 1, nxt);
        const char* nA = has_next ? g.a(nxt) + (size_t)nxt.pm * tstep + (size_t)nxt.k0 * kstep : cA; const char* nB = has_next ? g.b(nxt) + (size_t)nxt.pn * tstep + (size_t)nxt.k0 * kstep : cB;
        const int nt = cur.nt;
        for (int t = 0; t < nt; t += 2) {
            const bool last = (t == nt - 2);
            const char* a1 = cA + (size_t)(t + 1) * kstep;
            const char* a2 = last ? nA : cA + (size_t)(t + 2) * kstep; const char* b2 = last ? nB : cB + (size_t)(t + 2) * kstep;
            const char* a3 = a2 + kstep; const char* b3 = b2 + kstep;
            if (last && has_next) S.a_ready(nxt);
            if constexpr (SP2) {
            PG8_LDB(B0, 0, 0); PG8_LDB(B1, 0, 1); PG8_SCHED; PG8_LDA(At, 0, 0); PG8_STAGE(PG8_SA(1, 1), a1 + hstep, voffA);
            PG8_WAIT_V(8); PG8_WAIT_L(0); PG8_BAR; PG8_MMA(0, 0, At, B0); PG8_MMA(0, 1, At, B1); PG8_BAR; PG8_SCHED;
            PG8_LDA(At, 0, 1); PG8_STAGE(PG8_SB(0, 0), b2, voffB); PG8_STAGE(PG8_SB(0, 1), b2 + hstep, voffB); PG8_STAGE(PG8_SA(0, 0), a2, voffA);
            PG8_WAIT_V(8); PG8_WAIT_L(0); PG8_BAR; PG8_MMA(1, 0, At, B0); PG8_MMA(1, 1, At, B1); PG8_BAR; PG8_SCHED;
            PG8_LDB(B0, 1, 0); PG8_LDB(B1, 1, 1); PG8_SCHED; PG8_LDA(At, 1, 0); PG8_STAGE(PG8_SA(0, 1), a2 + hstep, voffA);
            PG8_WAIT_V(8); PG8_WAIT_L(0); PG8_BAR; PG8_MMA(0, 0, At, B0); PG8_MMA(0, 1, At, B1); PG8_BAR; PG8_SCHED;
            PG8_LDA(At, 1, 1); PG8_STAGE(PG8_SB(1, 0), b3, voffB); PG8_STAGE(PG8_SB(1, 1), b3 + hstep, voffB); PG8_STAGE(PG8_SA(1, 0), a3, voffA);
            PG8_WAIT_V(8); PG8_WAIT_L(0); PG8_BAR; PG8_MMA(1, 0, At, B0); PG8_MMA(1, 1, At, B1); PG8_BAR; PG8_SCHED;
            } else {
            PG8_LDB(B0, 0, 0); PG8_SCHED; PG8_LDA(At, 0, 0); PG8_STAGE(PG8_SA(1, 1), a1 + hstep, voffA);
            PG8_WAIT_L(8); PG8_BAR; PG8_WAIT_L(0); PG8_MMA(0, 0, At, B0); PG8_BAR; PG8_SCHED;
            PG8_LDB(B1, 0, 1); PG8_STAGE(PG8_SB(0, 0), b2, voffB);
            PG8_BAR; PG8_WAIT_L(0); PG8_MMA(0, 1, At, B1); PG8_BAR;
            PG8_LDA(At, 0, 1); PG8_STAGE(PG8_SA(0, 0), a2, voffA);
            PG8_BAR; PG8_WAIT_L(0); PG8_MMA(1, 0, At, B0); PG8_BAR; PG8_SCHED;
            PG8_STAGE(PG8_SB(0, 1), b2 + hstep, voffB);
            PG8_WAIT_V(6); PG8_BAR; PG8_MMA(1, 1, At, B1); PG8_BAR;
            PG8_LDB(B0, 1, 0); PG8_SCHED; PG8_LDA(At, 1, 0); PG8_STAGE(PG8_SA(0, 1), a2 + hstep, voffA);
            PG8_WAIT_L(8); PG8_BAR; PG8_WAIT_L(0); PG8_MMA(0, 0, At, B0); PG8_BAR; PG8_SCHED;
            PG8_LDB(B1, 1, 1); PG8_STAGE(PG8_SB(1, 0), b3, voffB);
            PG8_BAR; PG8_WAIT_L(0); PG8_MMA(0, 1, At, B1); PG8_BAR;
            PG8_LDA(At, 1, 1); PG8_STAGE(PG8_SA(1, 0), a3, voffA);
            PG8_BAR; PG8_WAIT_L(0); PG8_MMA(1, 0, At, B0); PG8_BAR; PG8_SCHED;
            PG8_STAGE(PG8_SB(1, 1), b3 + hstep, voffB);
            PG8_WAIT_V(6); PG8_BAR; PG8_MMA(1, 1, At, B1); PG8_BAR;
            }
        }
        if constexpr (ALIGN_EPI) { if (wr == 0) PG8_BAR; }
        E(acc, cur, wr, wc, fr, fq); S.done(cur);
        if (!has_next) break;
#pragma unroll
        for (int a = 0; a < 2; ++a)
#pragma unroll
            for (int b = 0; b < 2; ++b)
#pragma unroll
                for (int m = 0; m < 4; ++m)
#pragma unroll
                    for (int n = 0; n < 2; ++n) acc[a][b][m][n] = (f32x4){0.f, 0.f, 0.f, 0.f};
        cur = nxt; cA = nA; cB = nB; ++ui;
        if constexpr (ALIGN_EPI) { if (wr == 1) PG8_BAR; }
    }
    PG8_WAIT_V(0);
    if constexpr (!ALIGN_EPI) { if (wr == 0) PG8_BAR; }
    PG8_BAR;
#undef PG8_SA
#undef PG8_SB
#undef PG8_STAGE
#undef PG8_LDA
#undef PG8_LDB
#undef PG8_MMA
#undef PG8_WAIT_V
#undef PG8_WAIT_L
#undef PG8_BAR
#undef PG8_SCHED
}
}

constexpr int NWAVES = 8;
constexpr int DM = 1024, BP = 8, SEQ = 2048, NMETA = 16, TP = SEQ + NMETA, BS = 128, TS = 4;
constexpr int RP = BP * TP;
constexpr int RS = BS * TS;
constexpr int MR = RP + RS;
constexpr int MP = 17152;
constexpr int M2 = BP * SEQ + RS;
constexpr int NH = 8, DH = 128, DQKV = 3072, DFF = 4096, KC = 31, KS = 4;
constexpr int NIN = 8448;
constexpr int DIN = 8208;
constexpr float EPS = 1e-6f;

constexpr size_t O_YP = 0, O_YS = 16777216, O_PC = 17301504, O_PQ = 17547264, O_PD = 17620992, O_SC = 18669568, O_SQ = 22601728, O_SD = 23781376, O_END = 40558592;

constexpr size_t MiB = 1u << 20;
constexpr size_t WS_CTL = 0, CTL_ZERO_BYTES = 1 * MiB;
constexpr size_t WS_BETAG = 1 * MiB;
constexpr size_t WS_LASTV = 9 * MiB / 4;
constexpr size_t WS_HALOQ = 5 * MiB / 2;
constexpr size_t WS_WC = 29 * MiB / 4, WS_WD = WS_WC + 2 * MiB, WS_WO = WS_WD + 2 * MiB, WS_WUP = WS_WO + 2 * MiB, WS_WDN = WS_WUP + 8 * MiB;
constexpr size_t WS_GLU = 117 * MiB / 4;
constexpr size_t WS_QKVB = 63 * MiB;
constexpr size_t WS_QS = 162 * MiB;
constexpr size_t WS_ZS = 165 * MiB;
constexpr size_t WS_H = 397 * MiB / 2;
constexpr size_t WS_WIN = 232 * MiB;
constexpr size_t WS_HALOC = 497 * MiB / 2;
constexpr size_t WS_KDT = WS_H, WS_ATTN = 463 * MiB / 2;
constexpr size_t WS_MIX = WS_QKVB, WS_XG = WS_GLU, WS_HM = WS_QKVB, WS_C = WS_GLU;
constexpr int KSPLIT5 = 4; constexpr size_t WS_PART5 = 232 * MiB;
constexpr size_t WS_X1B = WS_H;
constexpr int CW_READY = 8192;
constexpr int KSPLIT = 16;
constexpr size_t WS_PART = WS_XG;
static_assert(WS_PART + (size_t)KSPLIT * RS * DM * 4 <= WS_QKVB, "ws map part");
constexpr size_t WS_END = 256 * MiB;
constexpr int NRUN = 16, RUNL = TP / NRUN;
static_assert(TP - 64 * 32 == 16 && NRUN * RUNL == TP && WS_HALOC + (size_t)BP * NRUN * 30 * DM * 2 <= WS_END, "conv runs");
constexpr int NCH = 33, QBLK = 3 * 64 * 128;
static_assert(WS_WIN + (size_t)NIN * DM * 2 <= WS_HALOC && WS_WDN + 8 * MiB <= WS_GLU && WS_GLU + (size_t)MP * DM * 2 <= WS_QKVB && WS_HALOQ + (size_t)BP * 33 * 3 * 3072 * 2 <= WS_WC, "ws map");
static_assert(WS_ZS + (size_t)MP * DM * 2 <= WS_H && WS_H + (size_t)MP * DM * 2 <= WS_WIN, "ws map 2");
static_assert(WS_QKVB + (size_t)BP * NCH * NH * QBLK * 2 <= WS_QS, "ws map qkvb");
static_assert(WS_HM + (size_t)M2 * DFF * 2 <= WS_H, "ws map hm");
static_assert(WS_KDT + (size_t)BP * NCH * NH * 8192 * 2 <= WS_ATTN && WS_ATTN + (size_t)BP * NCH * NH * 4096 * 2 <= WS_HALOC, "ws map kdt");
constexpr int CW_TMO = 0, CW_CODE = 1, CW_BAR = 4096;

constexpr int RING_OFF = 0, RING_BYTES = 131072;
constexpr int LDSCTL_OFF = 151552, MISC_OFF = LDSCTL_OFF + 320;
constexpr int LDS_BYTES = LDSCTL_OFF + 1024;

#define GAS __attribute__((address_space(1)))
#define LAS __attribute__((address_space(3)))
typedef unsigned short bf16;
typedef unsigned v4u __attribute__((ext_vector_type(4)));
typedef unsigned v2u __attribute__((ext_vector_type(2)));
typedef float f32x4 __attribute__((ext_vector_type(4)));
typedef float f32x2 __attribute__((ext_vector_type(2)));
typedef GAS unsigned gu32;
#define RLX_AGENT __ATOMIC_RELAXED, __HIP_MEMORY_SCOPE_AGENT
#define LDS_WAIT() asm volatile("s_waitcnt lgkmcnt(0)" ::: "memory")
#define VM_WAIT() asm volatile("s_waitcnt vmcnt(0)" ::: "memory")
__device__ __forceinline__ unsigned f2bf(float f) { unsigned u = __builtin_bit_cast(unsigned, f); return (u + 0x7fffu + ((u >> 16) & 1u)) >> 16; }
__device__ __forceinline__ unsigned pk2(float lo, float hi) { return f2bf(lo) | (f2bf(hi) << 16); }
typedef __bf16 bf16v2 __attribute__((ext_vector_type(2)));
__device__ __forceinline__ unsigned cvtpk(float lo, float hi) { const f32x2 v = {lo, hi}; const bf16v2 b = __builtin_convertvector(v, bf16v2); return __builtin_bit_cast(unsigned, b); }
__device__ __forceinline__ float bflo(unsigned w) { return __builtin_bit_cast(float, w << 16); }
__device__ __forceinline__ float bfhi(unsigned w) { return __builtin_bit_cast(float, w & 0xffff0000u); }
__device__ __forceinline__ float bf1(bf16 b) { return __builtin_bit_cast(float, ((unsigned)b) << 16); }
__device__ __forceinline__ float sigmoidf_(float x) { return __builtin_amdgcn_rcpf(1.f + __expf(-x)); }
__device__ __forceinline__ float siluf_(float x) { return x * sigmoidf_(x); }

#define XB_TMO      128
#define XB_XCNT(j)  (256  + 64 * (j))
#define XB_XSUB(j)  (1280 + 64 * (j))
#define XB_XGEN(j)  (2304 + 64 * (j))
#define XB_TOP      3328
#define XB_TOPGEN   3392
#define XCD_BAR_WORDS 3456
#define XB_SPIN_CAP (1u << 18)
__device__ __forceinline__ unsigned xb_ld(unsigned* p)              { return __hip_atomic_load(p, __ATOMIC_RELAXED, __HIP_MEMORY_SCOPE_AGENT); }
__device__ __forceinline__ unsigned xb_add(unsigned* p, unsigned v) { return __hip_atomic_fetch_add(p, v, __ATOMIC_RELAXED, __HIP_MEMORY_SCOPE_AGENT); }
__device__ __forceinline__ unsigned xb_xcc_id() { return (unsigned)__builtin_amdgcn_s_getreg((3 << 11) | 20) & 0xFu; }
#define XB_SPIN(cond, bar) do { unsigned _sp = 0; while (cond) { __builtin_amdgcn_s_sleep(1); \
    if ((++_sp & 255u) == 0u) { if (xb_ld(&(bar)[XB_TMO])) break; if (_sp > XB_SPIN_CAP) { atomicAdd(&(bar)[XB_TMO], 1u); break; } } } } while (0)
struct XcdBarrier { unsigned* bar; unsigned x; volatile LAS unsigned* st; };
__device__ __forceinline__ XcdBarrier xcd_barrier_post(unsigned* bar, volatile LAS unsigned* st) {
    XcdBarrier b; b.bar = bar; b.x = xb_xcc_id(); b.st = st;
    if (threadIdx.x == 0) (void)xb_add(&bar[XB_XCNT(b.x)], 1u);
    return b;
}
__device__ __forceinline__ void xcd_barrier_complete(unsigned* bar, unsigned x, unsigned& nloc, unsigned& nx) {
    const unsigned G = gridDim.x * gridDim.y * gridDim.z;
    unsigned sum, cnt, mine, sp = 0u;
    for (;;) {
        sum = 0u; cnt = 0u; mine = 0u;
#pragma unroll
        for (unsigned j = 0; j < 16; ++j) { const unsigned c = xb_ld(&bar[XB_XCNT(j)]); sum += c; cnt += (c > 0u) ? 1u : 0u; mine = (j == x) ? c : mine; }
        if (sum == G) break;
        __builtin_amdgcn_s_sleep(1);
        if ((++sp & 255u) == 0u) { if (xb_ld(&bar[XB_TMO])) break; if (sp > XB_SPIN_CAP) { atomicAdd(&bar[XB_TMO], 1u); break; } }
    }
    nloc = mine > 0u ? mine : 1u; nx = cnt > 0u ? cnt : 1u;
}
__device__ __forceinline__ void xcd_barrier(const XcdBarrier& b) {
    asm volatile("s_waitcnt vmcnt(0)" ::: "memory");
    __syncthreads();
    if (threadIdx.x == 0) {
        unsigned* bar = b.bar;
        __builtin_amdgcn_s_waitcnt(0);
        unsigned nloc = b.st[0], nx = b.st[1];
        if (nloc == 0u) { xcd_barrier_complete(bar, b.x, nloc, nx); b.st[0] = nloc; b.st[1] = nx; }
        const unsigned old = xb_add(&bar[XB_XSUB(b.x)], 1u);
        const unsigned gen = old / nloc;
        if (old + 1u == (gen + 1u) * nloc) {
            __builtin_amdgcn_fence(__ATOMIC_RELEASE, "agent");
            asm volatile("s_waitcnt vmcnt(0)" ::: "memory");
            const unsigned og = xb_add(&bar[XB_TOP], 1u);
            const unsigned tg = og / nx;
            if (og + 1u == (tg + 1u) * nx) xb_add(&bar[XB_TOPGEN], 1u);
            else XB_SPIN(xb_ld(&bar[XB_TOPGEN]) == tg, bar);
            __builtin_amdgcn_fence(__ATOMIC_ACQUIRE, "agent");
            xb_add(&bar[XB_XGEN(b.x)], 1u);
            asm volatile("s_waitcnt vmcnt(0)" ::: "memory");
        } else {
            XB_SPIN(xb_ld(&bar[XB_XGEN(b.x)]) == gen, bar);
            __builtin_amdgcn_fence(__ATOMIC_ACQUIRE, "agent");
            asm volatile("s_waitcnt vmcnt(0)" ::: "memory");
        }
    }
    __syncthreads();
}

struct Args { const float* in[23]; float* out; unsigned char* ws; int ph_lo, ph_hi; };

#define DPP_ADD(v, ctrl, rmask, bc) v += __builtin_bit_cast(float, __builtin_amdgcn_update_dpp(0, __builtin_bit_cast(int, v), ctrl, rmask, 0xF, bc))
__device__ __forceinline__ float sum16(float v) {
    DPP_ADD(v, 0xB1, 0xF, true); DPP_ADD(v, 0x4E, 0xF, true); DPP_ADD(v, 0x141, 0xF, true); DPP_ADD(v, 0x140, 0xF, true); return v; }
__device__ __forceinline__ float wave_sum(float v) {
    v = sum16(v); DPP_ADD(v, 0x142, 0xA, false); DPP_ADD(v, 0x143, 0xC, false);
    return __builtin_bit_cast(float, __builtin_amdgcn_readlane(__builtin_bit_cast(int, v), 63)); }
__device__ __forceinline__ float rsqf(float x) { return __builtin_amdgcn_rsqf(x); }
__device__ __forceinline__ int compact_row(int r) {
    if (r >= MR) return -1;
    if (r >= RP) return r - RP + BP * SEQ;
    const int b = r / TP, t = r - b * TP;
    return t < NMETA ? -1 : r - NMETA * (b + 1);
}

__device__ __forceinline__ void p0_transpose_item(const float* W, int Nsrc, int K, bf16* WT, int dst_row0, int src_col0, int nvalid, int k0, int lane) {
    const float* src = W + (size_t)k0 * Nsrc + src_col0 + (lane < nvalid ? lane : 0);
    float v[32];
#pragma unroll
    for (int j = 0; j < 32; ++j) v[j] = src[(size_t)j * Nsrc];
    if (lane >= nvalid) {
#pragma unroll
        for (int j = 0; j < 32; ++j) v[j] = 0.f; }
    GAS v4u* dst = (GAS v4u*)(WT + (size_t)(dst_row0 + lane) * K + k0);
#pragma unroll
    for (int q = 0; q < 4; ++q) { v4u o; o.x = cvtpk(v[8 * q], v[8 * q + 1]); o.y = cvtpk(v[8 * q + 2], v[8 * q + 3]); o.z = cvtpk(v[8 * q + 4], v[8 * q + 5]); o.w = cvtpk(v[8 * q + 6], v[8 * q + 7]); dst[q] = o; }
}
__device__ __forceinline__ void win_src(int nb, int& src, int& nvalid) {
    const int pn = nb >> 2, o = (nb & 3) * 64; nvalid = 64;
    if (pn < 8) src = (o < 128) ? 128 * pn + o : 1024 + 128 * pn + (o - 128);
    else if (pn < 20) src = 2048 + 256 * (pn - 8) + o;
    else if (pn < 24) src = 5120 + 256 * (pn - 20) + o;
    else if (pn < 28) src = 6160 + 256 * (pn - 24) + o;
    else if (pn < 32) src = 7184 + 256 * (pn - 28) + o;
    else { src = 6144; nvalid = (o == 0) ? 16 : 0; }
}
__device__ __forceinline__ void rms_row_to_bf16(const float* xrow, const float* gain, bf16* orow, int lane) {
    const GAS f32x4* xr = (const GAS f32x4*)xrow + lane; const GAS f32x4* gr = (const GAS f32x4*)gain + lane;
    f32x4 v[4]; float s = 0.f;
#pragma unroll
    for (int j = 0; j < 4; ++j) { v[j] = xr[64 * j]; s += (v[j].x * v[j].x + v[j].y * v[j].y) + (v[j].z * v[j].z + v[j].w * v[j].w); }
    const float rstd = 1.f / sqrtf(wave_sum(s) * (1.f / DM) + EPS);
    GAS unsigned long long* o8 = (GAS unsigned long long*)orow + lane;
#pragma unroll
    for (int j = 0; j < 4; ++j) { const f32x4 g = gr[64 * j]; o8[64 * j] = (unsigned long long)cvtpk(v[j].x * rstd * g.x, v[j].y * rstd * g.y) | ((unsigned long long)cvtpk(v[j].z * rstd * g.z, v[j].w * rstd * g.w) << 32); }
}

typedef pg8::f32x4 A4;
struct EpiIn {
    static constexpr bool PERM = true;
    bf16 *GLU, *QKVB, *QS, *HALOQ, *HALOC, *ZS, *SGC, *SGD; float* BETAG; const float *a_log, *dt_bias;
    __device__ __forceinline__ void operator()(const A4 (&acc)[2][2][4][2], const pg8::Unit& u, int wr, int wc, int fr, int fq) const {
#if defined(PROBE_EPI2)
        for (int rep = 0; rep < 2; ++rep) { asm volatile("" ::: "memory"); body(acc, u, wr, wc, fr, fq); }
#else
        body(acc, u, wr, wc, fr, fq);
#endif
    }
    __device__ __forceinline__ void body(const A4 (&acc)[2][2][4][2], const pg8::Unit& u, int wr, int wc, int fr, int fq) const {
        const int pn = u.pn, row0 = u.pm * 256 + wr * 64 + fr, cw = 32 * wc + 8 * fq;
        if (pn < 8) {
#pragma unroll
            for (int ai = 0; ai < 2; ++ai)
#pragma unroll
                for (int m = 0; m < 4; ++m) { const int r = row0 + ai * 128 + m * 16; float o[8];
#pragma unroll
                    for (int n = 0; n < 2; ++n)
#pragma unroll
                        for (int j = 0; j < 4; ++j) o[4 * n + j] = acc[ai][0][m][n][j] * sigmoidf_(acc[ai][1][m][n][j]);
                    v4u w; w.x = cvtpk(o[0], o[1]); w.y = cvtpk(o[2], o[3]); w.z = cvtpk(o[4], o[5]); w.w = cvtpk(o[6], o[7]);
                    *(GAS v4u*)(GLU + (size_t)r * DM + 128 * pn + cw) = w;
                    if (r < RP) { const int b = r / TP, t = r - b * TP, run = t / RUNL, pos = t - run * RUNL;
                        if (pos >= RUNL - 30 && run < NRUN - 1) *(GAS v4u*)(HALOC + ((size_t)(b * NRUN + run) * 30 + (pos - (RUNL - 30))) * DM + 128 * pn + cw) = w; } }
        } else if (pn < 20) {
            const int colb = 256 * (pn - 8);
#pragma unroll
            for (int ai = 0; ai < 2; ++ai)
#pragma unroll
                for (int m = 0; m < 4; ++m) { const int r = row0 + ai * 128 + m * 16; if (r >= MR) continue;
#pragma unroll
                    for (int bj = 0; bj < 2; ++bj) { const int col = colb + 128 * bj + cw;
                        const A4 a0 = acc[ai][bj][m][0], a1 = acc[ai][bj][m][1];
                        v4u w; w.x = cvtpk(a0[0], a0[1]); w.y = cvtpk(a0[2], a0[3]); w.z = cvtpk(a1[0], a1[1]); w.w = cvtpk(a1[2], a1[3]);
                        if (r >= RP) *(GAS v4u*)(QS + (size_t)(r - RP) * DQKV + col) = w;
                        else { const int b = r / TP, t = r - b * TP, c = t >> 6, i = t & 63, which = col >> 10, h = (col >> 7) & 7, d = col & 127;
                            *(GAS v4u*)(QKVB + ((size_t)((b * NCH + c) * NH + h) * 3 + which) * 8192 + i * 128 + d) = w;
                            if (i >= 61) *(GAS v4u*)(HALOQ + ((size_t)(b * NCH + c) * 3 + (i - 61)) * DQKV + col) = w; } } }
        } else if (pn < 24) {
            constexpr bool isz = true; bf16* dst = ZS; const int ld = DM, cb = 256 * (pn - 20);
#pragma unroll
            for (int ai = 0; ai < 2; ++ai)
#pragma unroll
                for (int m = 0; m < 4; ++m) { const int r = row0 + ai * 128 + m * 16;
#pragma unroll
                    for (int bj = 0; bj < 2; ++bj) { float o[8];
#pragma unroll
                        for (int n = 0; n < 2; ++n)
#pragma unroll
                            for (int j = 0; j < 4; ++j) { const float v = acc[ai][bj][m][n][j]; o[4 * n + j] = isz ? siluf_(v) : v; }
                        v4u w; w.x = cvtpk(o[0], o[1]); w.y = cvtpk(o[2], o[3]); w.z = cvtpk(o[4], o[5]); w.w = cvtpk(o[6], o[7]);
                        *(GAS v4u*)(dst + (size_t)r * ld + cb + 128 * bj + cw) = w; } }
        } else if (pn < 32) {
            bf16* dst = pn < 28 ? SGC : SGD; const int cb = 256 * ((pn - 24) & 3);
#pragma unroll
            for (int ai = 0; ai < 2; ++ai)
#pragma unroll
                for (int m = 0; m < 4; ++m) { const int rc = compact_row(row0 + ai * 128 + m * 16); if (rc < 0) continue;
#pragma unroll
                    for (int bj = 0; bj < 2; ++bj) { float o[8];
#pragma unroll
                        for (int n = 0; n < 2; ++n)
#pragma unroll
                            for (int j = 0; j < 4; ++j) o[4 * n + j] = sigmoidf_(acc[ai][bj][m][n][j]);
                        v4u w; w.x = cvtpk(o[0], o[1]); w.y = cvtpk(o[2], o[3]); w.z = cvtpk(o[4], o[5]); w.w = cvtpk(o[6], o[7]);
                        *(GAS v4u*)(dst + (size_t)rc * DM + cb + 128 * bj + cw) = w; } }
        } else {
            if (wc == 0 && fq < 2) {
#pragma unroll
                for (int ai = 0; ai < 2; ++ai)
#pragma unroll
                    for (int m = 0; m < 4; ++m) { const int r = row0 + ai * 128 + m * 16; float o[8];
#pragma unroll
                        for (int n = 0; n < 2; ++n)
#pragma unroll
                            for (int j = 0; j < 4; ++j) { const int h = 4 * n + j; const float v = acc[ai][0][m][n][j];
                                if (fq == 0) o[h] = 1.f / (1.f + expf(-v));
                                else { const float xx = v + dt_bias[h]; const float sp = xx > 20.f ? xx : log1pf(expf(xx)); o[h] = -expf(a_log[h]) * sp; } }
                        GAS f32x4* p = (GAS f32x4*)(BETAG + (size_t)r * 16 + 8 * fq);
                        p[0] = (f32x4){o[0], o[1], o[2], o[3]}; p[1] = (f32x4){o[4], o[5], o[6], o[7]}; }
            }
        }
    }
};
template <int MODE> struct EpiGate {
    static constexpr bool PERM = true;
    bf16 *SG, *MA, *OUT;
    __device__ __forceinline__ void operator()(const A4 (&acc)[2][2][4][2], const pg8::Unit& u, int wr, int wc, int fr, int fq) const {
        const int row0 = u.pm * 256 + wr * 64 + fr, c0 = 256 * u.pn + 32 * wc + 8 * fq;
#pragma unroll
        for (int ai = 0; ai < 2; ++ai) {
            size_t off[4]; bool ok[4]; v4u g[4][2], q[4][2];
#pragma unroll
            for (int m = 0; m < 4; ++m) { const int rc = compact_row(row0 + ai * 128 + m * 16); ok[m] = rc >= 0; off[m] = (size_t)(ok[m] ? rc : 0) * DM + c0; }
#pragma unroll
            for (int m = 0; m < 4; ++m)
#pragma unroll
                for (int bj = 0; bj < 2; ++bj) { g[m][bj] = *(const GAS v4u*)(SG + off[m] + 128 * bj); if (MODE == 1) q[m][bj] = *(const GAS v4u*)(MA + off[m] + 128 * bj); }
#pragma unroll
            for (int m = 0; m < 4; ++m)
#pragma unroll
                for (int bj = 0; bj < 2; ++bj) { const v4u gg = g[m][bj]; float o[8];
                    const A4 a0 = acc[ai][bj][m][0], a1 = acc[ai][bj][m][1];
                    o[0] = bflo(gg.x) * a0[0]; o[1] = bfhi(gg.x) * a0[1]; o[2] = bflo(gg.y) * a0[2]; o[3] = bfhi(gg.y) * a0[3];
                    o[4] = bflo(gg.z) * a1[0]; o[5] = bfhi(gg.z) * a1[1]; o[6] = bflo(gg.w) * a1[2]; o[7] = bfhi(gg.w) * a1[3];
                    if (MODE == 1) { const v4u qq = q[m][bj];
                        o[0] += bflo(qq.x); o[1] += bfhi(qq.x); o[2] += bflo(qq.y); o[3] += bfhi(qq.y); o[4] += bflo(qq.z); o[5] += bfhi(qq.z); o[6] += bflo(qq.w); o[7] += bfhi(qq.w); }
                    v4u w; w.x = cvtpk(o[0], o[1]); w.y = cvtpk(o[2], o[3]); w.z = cvtpk(o[4], o[5]); w.w = cvtpk(o[6], o[7]);
                    if (ok[m]) *(GAS v4u*)(OUT + off[m] + 128 * bj) = w; }
        }
    }
};
template <int MODE> struct EpiRes {
    static constexpr bool PERM = false;
    const float *xp, *xs; float* out; float* parts; const bf16* X1B;
    __device__ __forceinline__ void operator()(const A4 (&acc)[2][2][4][2], const pg8::Unit& u, int wr, int wc, int fr, int fq) const {
        const int row0 = u.pm * 256 + wr * 64 + fr, c0 = 256 * u.pn + 32 * wc + 4 * fq;
        if (u.pm >= BP * SEQ / 256) {
            float* part = parts + (size_t)(u.k0 / u.nt) * RS * DM;
#pragma unroll
            for (int ai = 0; ai < 2; ++ai)
#pragma unroll
                for (int m = 0; m < 4; ++m) { float* orow = part + (size_t)(row0 + ai * 128 + m * 16 - BP * SEQ) * DM;
#pragma unroll
                    for (int bj = 0; bj < 2; ++bj)
#pragma unroll
                        for (int n = 0; n < 2; ++n) *(GAS f32x4*)(orow + c0 + 128 * bj + 16 * n) = acc[ai][bj][m][n]; }
            return; }
#pragma unroll
        for (int ai = 0; ai < 2; ++ai)
#pragma unroll
            for (int m = 0; m < 4; ++m) { const int r = row0 + ai * 128 + m * 16;
                float* orow = out + (size_t)r * DM;
                if (MODE == 0) { const float* base = r < BP * SEQ ? xp + (size_t)r * DM : xs + (size_t)(r - BP * SEQ) * DM;
#pragma unroll
                    for (int bj = 0; bj < 2; ++bj)
#pragma unroll
                        for (int n = 0; n < 2; ++n) { const int c = c0 + 128 * bj + 16 * n; const f32x4 b = *(const GAS f32x4*)(base + c); *(GAS f32x4*)(orow + c) = b + acc[ai][bj][m][n]; }
                } else {
                } }
        if (MODE == 1) {
#pragma unroll
            for (int ai = 0; ai < 2; ++ai) { v2u xb[4][2][2];
#pragma unroll
                for (int m = 0; m < 4; ++m)
#pragma unroll
                    for (int bj = 0; bj < 2; ++bj)
#pragma unroll
                        for (int n = 0; n < 2; ++n) xb[m][bj][n] = *(const GAS v2u*)(X1B + (size_t)(row0 + ai * 128 + m * 16) * DM + c0 + 128 * bj + 16 * n);
#pragma unroll
                for (int m = 0; m < 4; ++m)
#pragma unroll
                    for (int bj = 0; bj < 2; ++bj)
#pragma unroll
                        for (int n = 0; n < 2; ++n) { const v2u b = xb[m][bj][n]; const f32x4 x2 = (f32x4){bflo(b.x), bfhi(b.x), bflo(b.y), bfhi(b.y)} + acc[ai][bj][m][n];
                            v2u w; w.x = cvtpk(x2[0], x2[1]); w.y = cvtpk(x2[2], x2[3]);
                            *(GAS v2u*)((bf16*)X1B + (size_t)(row0 + ai * 128 + m * 16) * DM + c0 + 128 * bj + 16 * n) = w; } }
        }
    }
};
struct EpiWo {
    const float *xp; bf16* X1B; float* parts;
    __device__ __forceinline__ void operator()(const A4 (&acc)[2][2][4][2], const pg8::Unit& u, int wr, int wc, int fr, int fq) const {
        const int row0 = u.pm * 256 + wr * 64 + fr, c0 = 256 * u.pn + 32 * wc + 8 * fq;
        if (u.pm >= BP * SEQ / 256) {
            float* part = parts + (size_t)(u.k0 / u.nt) * RS * DM;
#pragma unroll
            for (int ai = 0; ai < 2; ++ai)
#pragma unroll
                for (int m = 0; m < 4; ++m) { float* orow = part + (size_t)(row0 + ai * 128 + m * 16 - BP * SEQ) * DM + c0;
#pragma unroll
                    for (int bj = 0; bj < 2; ++bj) { *(GAS f32x4*)(orow + 128 * bj) = acc[ai][bj][m][0]; *(GAS f32x4*)(orow + 128 * bj + 4) = acc[ai][bj][m][1]; } }
            return; }
#pragma unroll
        for (int ai = 0; ai < 2; ++ai) { f32x4 xv[4][2][2];
#pragma unroll
            for (int m = 0; m < 4; ++m)
#pragma unroll
                for (int bj = 0; bj < 2; ++bj) { const float* xrow = xp + (size_t)(row0 + ai * 128 + m * 16) * DM + c0 + 128 * bj; xv[m][bj][0] = *(const GAS f32x4*)xrow; xv[m][bj][1] = *(const GAS f32x4*)(xrow + 4); }
#pragma unroll
            for (int m = 0; m < 4; ++m)
#pragma unroll
                for (int bj = 0; bj < 2; ++bj) { const f32x4 x0 = xv[m][bj][0] + acc[ai][bj][m][0], x1 = xv[m][bj][1] + acc[ai][bj][m][1];
                    v4u w; w.x = cvtpk(x0[0], x0[1]); w.y = cvtpk(x0[2], x0[3]); w.z = cvtpk(x1[0], x1[1]); w.w = cvtpk(x1[2], x1[3]);
                    *(GAS v4u*)(X1B + (size_t)(row0 + ai * 128 + m * 16) * DM + c0 + 128 * bj) = w; } }
    }
};
struct EpiWoP : EpiWo { static constexpr bool PERM = true; };
struct EpiUp {
    static constexpr bool PERM = true;
    bf16* HM;
    __device__ __forceinline__ void operator()(const A4 (&acc)[2][2][4][2], const pg8::Unit& u, int wr, int wc, int fr, int fq) const {
        const int row0 = u.pm * 256 + wr * 64 + fr, c0 = 256 * u.pn + 32 * wc + 8 * fq;
#pragma unroll
        for (int ai = 0; ai < 2; ++ai)
#pragma unroll
            for (int m = 0; m < 4; ++m) { const int r = row0 + ai * 128 + m * 16;
#pragma unroll
                for (int bj = 0; bj < 2; ++bj) { float o[8];
#pragma unroll
                    for (int n = 0; n < 2; ++n)
#pragma unroll
                        for (int j = 0; j < 4; ++j) { const float v = fmaxf(acc[ai][bj][m][n][j], 0.f); o[4 * n + j] = v * v; }
                    v4u w; w.x = cvtpk(o[0], o[1]); w.y = cvtpk(o[2], o[3]); w.z = cvtpk(o[4], o[5]); w.w = cvtpk(o[6], o[7]);
                    *(GAS v4u*)(HM + (size_t)r * DFF + c0 + 128 * bj) = w; } }
    }
};

template <int KIND>
__device__ __forceinline__ void conv_unit(const Args& a, LAS unsigned char* lds, int b, int run) {
    asm volatile("" ::: "memory");
    const int tid = threadIdx.x, lane = tid & 63, wave = tid >> 6; int ch = 2 * tid; asm volatile("" : "+v"(ch));
    unsigned char* ws = a.ws;
    bf16* GC = (bf16*)(ws + WS_GLU); const bf16* HALOC = (const bf16*)(ws + WS_HALOC);
    const float* w_dw = a.in[8];
    LAS float* red = (LAS float*)lds;
    constexpr int NTOK = KIND == 0 ? RUNL : TS, NSTEP = (NTOK + 3) / 4, REM = NTOK - 4 * (NSTEP - 1);
    f32x2 w[KC]; unsigned E[KC + 3];
#pragma unroll
    for (int i = 0; i < KC; ++i) w[i] = *(const GAS f32x2*)(w_dw + (size_t)i * DM + ch);
    const f32x2 bdw = *(const GAS f32x2*)(a.in[9] + ch), lng = *(const GAS f32x2*)(a.in[10] + ch), lnb = *(const GAS f32x2*)(a.in[11] + ch);
    const int row0 = KIND == 0 ? b * TP + run * RUNL : RP + b * TS;
    if (KIND == 0) {
#pragma unroll
        for (int i = 0; i < KC - 1; ++i) { unsigned v = *(const GAS unsigned*)(HALOC + ((size_t)(b * NRUN + (run > 0 ? run - 1 : 0)) * 30 + i) * DM + ch); E[i] = run > 0 ? v : 0u; }
    } else { const float* st = a.in[2] + (size_t)b * (KC - 1) * DM;
#pragma unroll
        for (int i = 0; i < KC - 1; ++i) { const f32x2 v = *(const GAS f32x2*)(st + (size_t)i * DM + ch); E[i] = cvtpk(v.x, v.y); }
    }
    unsigned nx[4];
#pragma unroll
    for (int k = 0; k < 4; ++k) nx[k] = *(const GAS unsigned*)(GC + (size_t)(row0 + (k < NTOK ? k : NTOK - 1)) * DM + ch);
    for (int st4 = 0; st4 < NSTEP; ++st4) {
        const int t0 = 4 * st4;
#pragma unroll
        for (int k = 0; k < 4; ++k) E[KC - 1 + k] = nx[k];
        if (st4 + 1 < NSTEP) {
#pragma unroll
            for (int k = 0; k < 4; ++k) { const int t = t0 + 4 + k; nx[k] = *(const GAS unsigned*)(GC + (size_t)(row0 + (t < NTOK ? t : NTOK - 1)) * DM + ch); }
        }
        f32x2 y[4] = {bdw, bdw, bdw, bdw};
#pragma unroll
        for (int j = 0; j < KC + 3; ++j) { const f32x2 e = {bflo(E[j]), bfhi(E[j])};
#pragma unroll
            for (int k = 0; k < 4; ++k) { const int i = j - k; if (i >= 0 && i < KC) y[k] += w[i] * e; } }
        float sv[8];
#pragma unroll
        for (int k = 0; k < 4; ++k) { sv[2 * k] = wave_sum(y[k].x + y[k].y); sv[2 * k + 1] = wave_sum(y[k].x * y[k].x + y[k].y * y[k].y); }
        LAS float* rb = red + (st4 & 1) * 64;
        if (lane == 0) { *(LAS f32x4*)(rb + wave * 8) = (f32x4){sv[0], sv[1], sv[2], sv[3]}; *(LAS f32x4*)(rb + wave * 8 + 4) = (f32x4){sv[4], sv[5], sv[6], sv[7]}; }
        __syncthreads();
        f32x4 ta = {0.f, 0.f, 0.f, 0.f}, tb = {0.f, 0.f, 0.f, 0.f};
#pragma unroll
        for (int i = 0; i < 8; ++i) { ta += *(const LAS f32x4*)(rb + i * 8); tb += *(const LAS f32x4*)(rb + i * 8 + 4); }
        const float tt[8] = {ta.x, ta.y, ta.z, ta.w, tb.x, tb.y, tb.z, tb.w};
#pragma unroll
        for (int k = 0; k < 4; ++k) { if (t0 + k < NTOK) {
            const float mu = tt[2 * k] * (1.f / DM), var = fmaxf(tt[2 * k + 1] * (1.f / DM) - mu * mu, 0.f), rstd = rsqf(var + EPS);
            const float z0 = (y[k].x - mu) * rstd * lng.x + lnb.x, z1 = (y[k].y - mu) * rstd * lng.y + lnb.y;
            *(GAS unsigned*)(GC + (size_t)(row0 + t0 + k) * DM + ch) = cvtpk(siluf_(z0), siluf_(z1)); } }
        if (st4 + 1 < NSTEP) {
#pragma unroll
            for (int i = 0; i < KC - 1; ++i) E[i] = E[i + 4];
        }
    }
    if (KIND == 1 || run == NRUN - 1) { float* o = a.out + (KIND == 0 ? O_PC : O_SC) + (size_t)b * (KC - 1) * DM;
        if (KIND == 0) {
#pragma unroll
            for (int i = 0; i < KC - 1; ++i) *(GAS f32x2*)(o + (size_t)i * DM + ch) = (f32x2){bflo(E[REM + i]), bfhi(E[REM + i])};
        } else {
            const float* st = a.in[2] + (size_t)b * (KC - 1) * DM;
#pragma unroll
            for (int i = 0; i < KC - 1 - TS; ++i) *(GAS f32x2*)(o + (size_t)i * DM + ch) = *(const GAS f32x2*)(st + (size_t)(i + TS) * DM + ch);
#pragma unroll
            for (int i = KC - 1 - TS; i < KC - 1; ++i) *(GAS f32x2*)(o + (size_t)i * DM + ch) = (f32x2){bflo(E[REM + i]), bfhi(E[REM + i])};
        }
    }
    __syncthreads();
}

__device__ __forceinline__ void delta_item(const Args& a, LAS unsigned char* lds, int item) {
    asm volatile("" ::: "memory");
    const int tid = threadIdx.x, lane = tid & 63, sub = tid >> 7, wu = (tid >> 6) & 1; int j = tid & 127; asm volatile("" : "+v"(j));
    const int unit = item * 4 + sub, b = unit >> 3, h = unit & 7;
    const int row0 = RP + b * TS;
    const bf16* QS = (const bf16*)(a.ws + WS_QS); bf16* ZS = (bf16*)(a.ws + WS_ZS); const float* BETAG = (const float*)(a.ws + WS_BETAG);
    LAS float* kq = (LAS float*)lds + sub * 256;
    LAS float* red = (LAS float*)lds + 1024 + sub * 4;
    LAS float* red2 = (LAS float*)lds + 1024 + 16 + sub * 2;
    float S[DH];
    { const float* s0 = a.in[4] + ((size_t)(b * NH + h) * DH) * DH + j;
#pragma unroll
        for (int d = 0; d < DH; ++d) S[d] = s0[(size_t)d * DH]; }
    const int cq = h * DH + j, ck = DM + cq, cv = 2 * DM + cq;
    float wq[KS], wk[KS], wv[KS];
#pragma unroll
    for (int i = 0; i < KS; ++i) { wq[i] = a.in[13][i * DQKV + cq]; wk[i] = a.in[13][i * DQKV + ck]; wv[i] = a.in[13][i * DQKV + cv]; }
    float hq[3], hk[3], hv[3];
#pragma unroll
    for (int i = 0; i < 3; ++i) { const float* st = a.in[3] + ((size_t)b * 3 + i) * DQKV; hq[i] = st[cq]; hk[i] = st[ck]; hv[i] = st[cv]; }
    const float gh = a.in[16][j];
    float pq[TS], pk[TS], pv[TS], pbe[TS], pgg[TS], pzs[TS];
#pragma unroll
    for (int t = 0; t < TS; ++t) { const bf16* p = QS + (size_t)(b * TS + t) * DQKV; pq[t] = bf1(p[cq]); pk[t] = bf1(p[ck]); pv[t] = bf1(p[cv]);
        pbe[t] = BETAG[(size_t)(row0 + t) * 16 + h]; pgg[t] = BETAG[(size_t)(row0 + t) * 16 + 8 + h]; pzs[t] = bf1(ZS[(size_t)(row0 + t) * DM + cq]); }
#pragma unroll
    for (int t = 0; t < TS; ++t) {
        const size_t row = (size_t)(row0 + t);
        const float qp = pq[t], kp = pk[t], vp = pv[t];
        const float qc = siluf_(wq[0] * hq[0] + wq[1] * hq[1] + wq[2] * hq[2] + wq[3] * qp);
        const float kc = siluf_(wk[0] * hk[0] + wk[1] * hk[1] + wk[2] * hk[2] + wk[3] * kp);
        const float vc = siluf_(wv[0] * hv[0] + wv[1] * hv[1] + wv[2] * hv[2] + wv[3] * vp);
        hq[0] = hq[1]; hq[1] = hq[2]; hq[2] = qp; hk[0] = hk[1]; hk[1] = hk[2]; hk[2] = kp; hv[0] = hv[1]; hv[1] = hv[2]; hv[2] = vp;
        const float sq = wave_sum(qc * qc), sk = wave_sum(kc * kc);
        kq[j] = kc; kq[128 + j] = qc;
        if (lane == 0) { red[wu * 2] = sq; red[wu * 2 + 1] = sk; }
        const float beta = pbe[t], gg = pgg[t], zs = pzs[t];
        __syncthreads();
        const float nq = rsqf(red[0] + red[2] + 1e-6f) * 0.08838834764831845f, nk = rsqf(red[1] + red[3] + 1e-6f);
        const float alpha = __expf(gg);
        float ks0 = 0.f, ks1 = 0.f, ks2 = 0.f, ks3 = 0.f;
#pragma unroll
        for (int d = 0; d < DH; d += 4) { const f32x4 kk = *(const LAS f32x4*)(kq + d); ks0 += kk.x * S[d]; ks1 += kk.y * S[d + 1]; ks2 += kk.z * S[d + 2]; ks3 += kk.w * S[d + 3];
            if ((d & 31) == 28) asm volatile("" ::: "memory"); }
        const float kS = (ks0 + ks1) + (ks2 + ks3);
        const float u = beta * (vc - alpha * nk * kS), un = nk * u;
        float o0 = 0.f, o1 = 0.f, o2 = 0.f, o3 = 0.f;
#pragma unroll
        for (int d = 0; d < DH; d += 4) { const f32x4 kk = *(const LAS f32x4*)(kq + d); const f32x4 qq = *(const LAS f32x4*)(kq + 128 + d);
            S[d] = alpha * S[d] + kk.x * un; S[d + 1] = alpha * S[d + 1] + kk.y * un; S[d + 2] = alpha * S[d + 2] + kk.z * un; S[d + 3] = alpha * S[d + 3] + kk.w * un;
            o0 += qq.x * S[d]; o1 += qq.y * S[d + 1]; o2 += qq.z * S[d + 2]; o3 += qq.w * S[d + 3];
            if ((d & 15) == 12) asm volatile("" ::: "memory"); }
        const float o = ((o0 + o1) + (o2 + o3)) * nq;
        const float so = wave_sum(o * o);
        if (lane == 0) red2[wu] = so;
        __syncthreads();
        const float rms = rsqf((red2[0] + red2[1]) * (1.f / DH) + EPS);
        ZS[row * DM + cq] = (bf16)f2bf(o * rms * gh * zs);
    }
    { float* so = a.out + O_SD + ((size_t)(b * NH + h) * DH) * DH + j;
#pragma unroll
        for (int d = 0; d < DH; ++d) so[(size_t)d * DH] = S[d];
      float* qo = a.out + O_SQ + (size_t)b * 3 * DQKV;
#pragma unroll
        for (int i = 0; i < 3; ++i) { qo[i * DQKV + cq] = hq[i]; qo[i * DQKV + ck] = hk[i]; qo[i * DQKV + cv] = hv[i]; }
    }
    __syncthreads();
}

__host__ __device__ constexpr int perm_k(int x) { return (x & ~31) | (((x >> 2) & 3) << 3) | (((x >> 4) & 1) << 2) | (x & 3); }
typedef short bf16x8v __attribute__((ext_vector_type(8)));
__device__ __forceinline__ int ih_swz128(int row, int ch) { return (row >> 1) * 256 + (((8 * (row & 1) + ch) ^ ((row >> 1) & 7)) << 4); }
constexpr int IH_QH = 0, IH_KH = 17408, IH_VH = 34816, IH_GV = 52224, IH_TB = 54272, IH_TD = 63488, IH_BYTES = 68608;
__device__ __forceinline__ void intra_pair(const Args& a, LAS unsigned char* lds_all, int pair) {
    asm volatile("" ::: "memory");
    const int tid = threadIdx.x, half = tid >> 8; int tu = tid & 255; asm volatile("" : "+v"(tu));
    const int lane = tu & 63, wq = __builtin_amdgcn_readfirstlane(tu >> 6);
    const int uq = pair * 2 + half, h = uq & 7, bc = uq >> 3, b = bc / NCH, c = bc - b * NCH;
    const int nvalid = (c == NCH - 1) ? TP - 64 * (NCH - 1) : 64;
    LAS unsigned char* lds = lds_all + half * IH_BYTES;
    LAS bf16* QH = (LAS bf16*)(lds + IH_QH); LAS bf16* KH = (LAS bf16*)(lds + IH_KH); LAS bf16* VH = (LAS bf16*)(lds + IH_VH);
    LAS float* MF = (LAS float*)(lds + IH_KH); LAS bf16* ATL = (LAS bf16*)(lds + IH_VH); LAS float* GV = (LAS float*)(lds + IH_GV);
    unsigned char* ws = a.ws;
    bf16* blk = (bf16*)(ws + WS_QKVB) + (size_t)uq * QBLK; const bf16* HALOQ = (const bf16*)(ws + WS_HALOQ); const float* BETAG = (const float*)(ws + WS_BETAG);
    bf16* KDT = (bf16*)(ws + WS_KDT) + (size_t)uq * 8192; bf16* ATT = (bf16*)(ws + WS_ATTN) + (size_t)uq * 4096; float* LASTV = (float*)(ws + WS_LASTV);
    if (tu < 64) { const int i = tu; float g = 0.f, be = 0.f; { const float* p = BETAG + (size_t)(b * TP + 64 * c + (i < nvalid ? i : 0)) * 16; be = p[h]; g = p[8 + h]; } if (i >= nvalid) { g = 0.f; be = 0.f; }
        float G = g;
#pragma unroll
        for (int o = 1; o < 64; o <<= 1) { const float t = __shfl_up(G, o); if (lane >= o) G += t; }
        const float GL = __shfl(G, 63);
        GV[i] = G; GV[64 + i] = be; GV[128 + i] = expf(G); GV[192 + i] = expf(GL - G);
        if (i == 63) LASTV[uq] = expf(GL); }
    {   const int cp = tu & 15, rg = tu >> 4;
        v4u raw[2][7];
#define IH_LOAD_ROWS(wh_, slot_) do { _Pragma("unroll") for (int k = 0; k < 7; ++k) { const int rr = 4 * rg - 3 + k; \
                const bf16* p = (rr >= 0) ? blk + (wh_) * 8192 + rr * 128 + 8 * cp : HALOQ + ((size_t)(b * NCH + (c > 0 ? c - 1 : 0)) * 3 + (3 + rr)) * DQKV + (wh_) * DM + h * DH + 8 * cp; \
                raw[slot_][k] = *(const GAS v4u*)p; } } while (0)
        IH_LOAD_ROWS(0, 0); IH_LOAD_ROWS(1, 1);
#pragma unroll
        for (int wh = 0; wh < 3; ++wh) {
            const int col = wh * DM + h * DH + 8 * cp;
            f32x4 wl[4], wh4[4];
#pragma unroll
            for (int i = 0; i < 4; ++i) { wl[i] = *(const GAS f32x4*)(a.in[13] + i * DQKV + col); wh4[i] = *(const GAS f32x4*)(a.in[13] + i * DQKV + col + 4); }
            float xr[7][8];
#pragma unroll
            for (int k = 0; k < 7; ++k) { const int rr = 4 * rg - 3 + k; const bool ok = (rr >= 0) ? (rr < nvalid) : (c > 0); const v4u v = raw[wh & 1][k];
                xr[k][0] = ok ? bflo(v.x) : 0.f; xr[k][1] = ok ? bfhi(v.x) : 0.f; xr[k][2] = ok ? bflo(v.y) : 0.f; xr[k][3] = ok ? bfhi(v.y) : 0.f;
                xr[k][4] = ok ? bflo(v.z) : 0.f; xr[k][5] = ok ? bfhi(v.z) : 0.f; xr[k][6] = ok ? bflo(v.w) : 0.f; xr[k][7] = ok ? bfhi(v.w) : 0.f; }
            if (wh == 0) IH_LOAD_ROWS(2, 0);
            if (c == NCH - 1 && rg == (nvalid - 1) / 4) {
                float* qo = a.out + O_PQ + (size_t)b * 3 * DQKV + col;
#pragma unroll
                for (int i = 0; i < 3; ++i) { *(GAS f32x4*)(qo + i * DQKV) = (f32x4){xr[4 + i][0], xr[4 + i][1], xr[4 + i][2], xr[4 + i][3]}; *(GAS f32x4*)(qo + i * DQKV + 4) = (f32x4){xr[4 + i][4], xr[4 + i][5], xr[4 + i][6], xr[4 + i][7]}; } }
            LAS bf16* tile = wh == 0 ? QH : (wh == 1 ? KH : VH);
#pragma unroll
            for (int r = 0; r < 4; ++r) { const bool ok = (4 * rg + r) < nvalid; float y[8];
#pragma unroll
                for (int e = 0; e < 8; ++e) { const float w0 = e < 4 ? wl[0][e & 3] : wh4[0][e & 3], w1 = e < 4 ? wl[1][e & 3] : wh4[1][e & 3], w2 = e < 4 ? wl[2][e & 3] : wh4[2][e & 3], w3 = e < 4 ? wl[3][e & 3] : wh4[3][e & 3];
                    const float t = w0 * xr[r][e] + w1 * xr[r + 1][e] + w2 * xr[r + 2][e] + w3 * xr[r + 3][e]; y[e] = ok ? siluf_(t) : 0.f; }
                v4u o; o.x = cvtpk(y[0], y[1]); o.y = cvtpk(y[2], y[3]); o.z = cvtpk(y[4], y[5]); o.w = cvtpk(y[6], y[7]);
                *(LAS v4u*)(tile + (4 * rg + r) * 136 + 8 * cp) = o; }
        }
    }
    __syncthreads();
    const int which = tu >> 7, d = tu & 127;
    float x[64];
    { const LAS bf16* colp = (which == 0 ? VH : KH) + d;
#pragma unroll
      for (int i = 0; i < 64; ++i) x[i] = bf1(colp[i * 136]); }
    const int fr = lane & 15, fq = lane >> 4;
    f32x4 kk[4], qk[4];
    {   bf16x8v ak[4], aq[4];
#pragma unroll
        for (int sI = 0; sI < 4; ++sI) { ak[sI] = *(const LAS bf16x8v*)(KH + (16 * wq + fr) * 136 + 32 * sI + 8 * fq); aq[sI] = *(const LAS bf16x8v*)(QH + (16 * wq + fr) * 136 + 32 * sI + 8 * fq); }
        f32x4 kkd = {0.f, 0.f, 0.f, 0.f}, qqd = {0.f, 0.f, 0.f, 0.f};
#pragma unroll
        for (int sI = 0; sI < 4; ++sI) { kkd = __builtin_amdgcn_mfma_f32_16x16x32_bf16(ak[sI], ak[sI], kkd, 0, 0, 0); qqd = __builtin_amdgcn_mfma_f32_16x16x32_bf16(aq[sI], aq[sI], qqd, 0, 0, 0); }
#pragma unroll
        for (int nt = 0; nt < 4; ++nt) { kk[nt] = (f32x4){0.f, 0.f, 0.f, 0.f}; qk[nt] = (f32x4){0.f, 0.f, 0.f, 0.f};
            if (nt <= wq) {
#pragma unroll
                for (int sI = 0; sI < 4; ++sI) { const bf16x8v bk = *(const LAS bf16x8v*)(KH + (16 * nt + fr) * 136 + 32 * sI + 8 * fq);
                    kk[nt] = __builtin_amdgcn_mfma_f32_16x16x32_bf16(ak[sI], bk, kk[nt], 0, 0, 0); qk[nt] = __builtin_amdgcn_mfma_f32_16x16x32_bf16(aq[sI], bk, qk[nt], 0, 0, 0); } } }
#pragma unroll
        for (int r = 0; r < 4; ++r) if (fr == 4 * fq + r) { GV[320 + 16 * wq + fr] = rsqf(kkd[r] + 1e-6f); GV[256 + 16 * wq + fr] = rsqf(qqd[r] + 1e-6f) * 0.08838834764831845f; }
    }
    __syncthreads();
    {
#pragma unroll
        for (int nt = 0; nt < 4; ++nt) { const int j = 16 * nt + fr;
            if (nt <= wq) { const float Gj = GV[j], nkj = GV[320 + j];
#pragma unroll
                for (int r = 0; r < 4; ++r) { const int i = 16 * wq + 4 * fq + r; const float dec = (i >= j) ? __expf(GV[i] - Gj) : 0.f;
                    MF[i * 68 + j] = (i > j) ? GV[64 + i] * GV[320 + i] * nkj * kk[nt][r] * dec : 0.f;
                    ATL[i * 72 + j] = (bf16)f2bf(GV[256 + i] * nkj * qk[nt][r] * dec); }
            } else {
#pragma unroll
                for (int r = 0; r < 4; ++r) ATL[(16 * wq + 4 * fq + r) * 72 + j] = (bf16)0; }
        }
#pragma unroll
        for (int k = 0; k < 4; ++k) { const int pc = tu + 256 * k, i = pc >> 4, p16 = pc & 15, c0 = 32 * (p16 >> 2) + 4 * (p16 & 3);
            const v2u lo = *(const LAS v2u*)(QH + i * 136 + c0), hi = *(const LAS v2u*)(QH + i * 136 + c0 + 16); const float f = GV[256 + i] * GV[128 + i];
            v4u o; o.x = cvtpk(bflo(lo.x) * f, bfhi(lo.x) * f); o.y = cvtpk(bflo(lo.y) * f, bfhi(lo.y) * f); o.z = cvtpk(bflo(hi.x) * f, bfhi(hi.x) * f); o.w = cvtpk(bflo(hi.y) * f, bfhi(hi.y) * f);
            *(GAS v4u*)(blk + i * 128 + 8 * p16) = o; if (k & 1) asm volatile("" ::: "memory"); }
        if (which == 0) {
#pragma unroll
            for (int i = 0; i < 64; i += 4) { const f32x4 be = *(const LAS f32x4*)(GV + 64 + i); x[i] *= be.x; x[i + 1] *= be.y; x[i + 2] *= be.z; x[i + 3] *= be.w; }
        } else {
            bf16* kd = KDT + d * 64;
#pragma unroll
            for (int i = 0; i < 64; i += 4) { const f32x4 nk = *(const LAS f32x4*)(GV + 320 + i); x[i] *= nk.x; x[i + 1] *= nk.y; x[i + 2] *= nk.z; x[i + 3] *= nk.w; }
#pragma unroll
            for (int g8 = 0; g8 < 8; ++g8) { const int i0 = 32 * (g8 >> 2) + 4 * (g8 & 3);
                const f32x4 e0 = *(const LAS f32x4*)(GV + 192 + i0), e1 = *(const LAS f32x4*)(GV + 192 + i0 + 16);
                v4u w; w.x = cvtpk(x[i0] * e0.x, x[i0 + 1] * e0.y); w.y = cvtpk(x[i0 + 2] * e0.z, x[i0 + 3] * e0.w); w.z = cvtpk(x[i0 + 16] * e1.x, x[i0 + 17] * e1.y); w.w = cvtpk(x[i0 + 18] * e1.z, x[i0 + 19] * e1.w);
                *(GAS v4u*)(kd + 8 * g8) = w; if (g8 & 1) asm volatile("" ::: "memory"); }
#pragma unroll
            for (int i = 0; i < 64; i += 4) { const f32x4 be = *(const LAS f32x4*)(GV + 64 + i), eg = *(const LAS f32x4*)(GV + 128 + i);
                x[i] *= be.x * eg.x; x[i + 1] *= be.y * eg.y; x[i + 2] *= be.z * eg.z; x[i + 3] *= be.w * eg.w; }
        }
    }
    __syncthreads();
    LAS unsigned char* RT = lds + IH_QH; LAS bf16* TB = (LAS bf16*)(lds + IH_TB); LAS float* TD = (LAS float*)(lds + IH_TD);
    if (which == 0) {
#pragma unroll
        for (int c8 = 0; c8 < 8; ++c8) { v4u w; w.x = cvtpk(x[8 * c8], x[8 * c8 + 1]); w.y = cvtpk(x[8 * c8 + 2], x[8 * c8 + 3]); w.z = cvtpk(x[8 * c8 + 4], x[8 * c8 + 5]); w.w = cvtpk(x[8 * c8 + 6], x[8 * c8 + 7]);
            *(LAS v4u*)(RT + ih_swz128(d, c8)) = w; } }
    float tdg[16];
    {   const LAS float* mrow = MF + (16 * wq) * 68 + 16 * wq;
#pragma unroll
        for (int i = 0; i < 16; ++i) { float acc = (i == fr) ? 1.f : 0.f;
#pragma unroll
            for (int g = 0; g < (i + 3) / 4; ++g) { const f32x4 mm = *(const LAS f32x4*)(mrow + i * 68 + 4 * g);
                acc -= mm.x * tdg[4 * g]; if (4 * g + 1 < i) acc -= mm.y * tdg[4 * g + 1]; if (4 * g + 2 < i) acc -= mm.z * tdg[4 * g + 2]; if (4 * g + 3 < i) acc -= mm.w * tdg[4 * g + 3]; }
            tdg[i] = acc; }
        if (fq == 0) {
#pragma unroll
            for (int i = 0; i < 16; ++i) { TD[(wq * 16 + i) * 20 + fr] = tdg[i]; TB[(16 * wq + i) * 72 + 16 * wq + fr] = (bf16)f2bf(tdg[i]); } }
        for (int r = fq; r < 16 * wq; r += 4) TB[r * 72 + 16 * wq + fr] = (bf16)0;
    }
    __syncthreads();
    {   f32x4 Tc[4];
#pragma unroll
        for (int l = 0; l < 4; ++l) Tc[l] = (f32x4){0.f, 0.f, 0.f, 0.f};
#pragma unroll
        for (int r = 0; r < 4; ++r) { const float v = fq == 0 ? tdg[r] : (fq == 1 ? tdg[4 + r] : (fq == 2 ? tdg[8 + r] : tdg[12 + r]));
#pragma unroll
            for (int l = 0; l < 4; ++l) if (l == wq) Tc[l][r] = v; }
#pragma unroll
        for (int k = 1; k < 4; ++k) { if (k <= wq) continue;
            f32x4 acc = {0.f, 0.f, 0.f, 0.f};
#pragma unroll
            for (int l = 0; l < k; ++l) { if (l < wq) continue;
                const f32x4 a4 = *(const LAS f32x4*)(MF + (16 * k + fr) * 68 + 16 * l + 4 * fq);
#pragma unroll
                for (int ks = 0; ks < 4; ++ks) acc = __builtin_amdgcn_mfma_f32_16x16x4f32(a4[ks], Tc[l][ks], acc, 0, 0, 0); }
            const f32x4 d4 = *(const LAS f32x4*)(TD + (k * 16 + fr) * 20 + 4 * fq);
            f32x4 res = {0.f, 0.f, 0.f, 0.f};
#pragma unroll
            for (int ks = 0; ks < 4; ++ks) res = __builtin_amdgcn_mfma_f32_16x16x4f32(d4[ks], acc[ks], res, 0, 0, 0);
            Tc[k] = -res;
#pragma unroll
            for (int r = 0; r < 4; ++r) TB[(16 * k + 4 * fq + r) * 72 + 16 * wq + fr] = (bf16)f2bf(Tc[k][r]);
        }
    }
    __syncthreads();
    {
        f32x4 acc[4][2];
#pragma unroll
        for (int m = 0; m < 4; ++m) { acc[m][0] = (f32x4){0.f, 0.f, 0.f, 0.f}; acc[m][1] = (f32x4){0.f, 0.f, 0.f, 0.f}; }
#pragma unroll
        for (int s2 = 0; s2 < 2; ++s2) { bf16x8v af[4], bfm[2];
#pragma unroll
            for (int m = 0; m < 4; ++m) af[m] = *(const LAS bf16x8v*)(TB + (16 * m + fr) * 72 + 32 * s2 + 8 * fq);
#pragma unroll
            for (int t2 = 0; t2 < 2; ++t2) bfm[t2] = *(const LAS bf16x8v*)(RT + ih_swz128(16 * (2 * wq + t2) + fr, 4 * s2 + fq));
#pragma unroll
            for (int m = 0; m < 4; ++m)
#pragma unroll
                for (int t2 = 0; t2 < 2; ++t2) acc[m][t2] = __builtin_amdgcn_mfma_f32_16x16x32_bf16(af[m], bfm[t2], acc[m][t2], 0, 0, 0); }
#pragma unroll
        for (int m = 0; m < 4; ++m)
#pragma unroll
            for (int t2 = 0; t2 < 2; ++t2) { v2u w; w.x = cvtpk(acc[m][t2][0], acc[m][t2][1]); w.y = cvtpk(acc[m][t2][2], acc[m][t2][3]);
                *(GAS v2u*)(blk + 2 * 8192 + (2 * wq + t2) * 1024 + m * 256 + lane * 4) = w; }
    }
    __syncthreads();
    if (which == 1) {
#pragma unroll
        for (int c8 = 0; c8 < 8; ++c8) { v4u w; w.x = cvtpk(x[8 * c8], x[8 * c8 + 1]); w.y = cvtpk(x[8 * c8 + 2], x[8 * c8 + 3]); w.z = cvtpk(x[8 * c8 + 4], x[8 * c8 + 5]); w.w = cvtpk(x[8 * c8 + 6], x[8 * c8 + 7]);
            *(LAS v4u*)(RT + ih_swz128(d, c8)) = w; } }
    __syncthreads();
    {
        f32x4 acw[2][4];
#pragma unroll
        for (int nt = 0; nt < 4; ++nt) { acw[0][nt] = (f32x4){0.f, 0.f, 0.f, 0.f}; acw[1][nt] = (f32x4){0.f, 0.f, 0.f, 0.f}; }
#pragma unroll
        for (int s2 = 0; s2 < 2; ++s2) { bf16x8v af[2], bfm[4];
#pragma unroll
            for (int aa = 0; aa < 2; ++aa) af[aa] = *(const LAS bf16x8v*)(RT + ih_swz128(16 * (2 * wq + aa) + fr, 4 * s2 + fq));
#pragma unroll
            for (int nt = 0; nt < 4; ++nt) bfm[nt] = *(const LAS bf16x8v*)(TB + (16 * nt + fr) * 72 + 32 * s2 + 8 * fq);
#pragma unroll
            for (int aa = 0; aa < 2; ++aa)
#pragma unroll
                for (int nt = 0; nt < 4; ++nt) acw[aa][nt] = __builtin_amdgcn_mfma_f32_16x16x32_bf16(af[aa], bfm[nt], acw[aa][nt], 0, 0, 0); }
#pragma unroll
        for (int nt = 0; nt < 4; ++nt) { v4u w; w.x = cvtpk(acw[0][nt][0], acw[0][nt][1]); w.y = cvtpk(acw[0][nt][2], acw[0][nt][3]); w.z = cvtpk(acw[1][nt][0], acw[1][nt][1]); w.w = cvtpk(acw[1][nt][2], acw[1][nt][3]);
            *(GAS v4u*)(blk + 8192 + (16 * nt + fr) * 128 + 32 * wq + 8 * fq) = w; }
    }
#pragma unroll
    for (int k = 0; k < 2; ++k) { const int pc = tu + 256 * k, i = pc >> 3, p8 = pc & 7, c0 = 32 * (p8 >> 2) + 4 * (p8 & 3);
        const v2u lo = *(const LAS v2u*)(ATL + i * 72 + c0), hi = *(const LAS v2u*)(ATL + i * 72 + c0 + 16);
        *(GAS v4u*)(ATT + i * 64 + 8 * p8) = (v4u){lo.x, lo.y, hi.x, hi.y}; }
    __syncthreads();
}

constexpr int SC_W = 0, SC_QD = 16384, SC_KDT = 32768, SC_AT = 49152, SC_BUF = 57344, SC_RMS = 2 * SC_BUF, SC_ZT = SC_RMS + 4096, SC_END = SC_ZT + 2 * 16384;
__device__ __forceinline__ int swz256(int row, int chunk) { return row * 256 + ((chunk ^ (row & 15)) << 4); }
__device__ __forceinline__ int swz128(int row, int ch) { return (row >> 1) * 256 + (((8 * (row & 1) + ch) ^ ((row >> 1) & 7)) << 4); }
__device__ __forceinline__ void scan_chain(const Args& a, LAS unsigned char* lds, int chain) {
    const int tid = threadIdx.x, lane = tid & 63, wave = __builtin_amdgcn_readfirstlane(tid >> 6), fr = lane & 15, fq = lane >> 4;
    const int b = chain >> 3, h = chain & 7;
    unsigned char* ws = a.ws;
    const bf16* QKVB = (const bf16*)(ws + WS_QKVB); const bf16* KDTg = (const bf16*)(ws + WS_KDT); const bf16* ATTg = (const bf16*)(ws + WS_ATTN); const float* LASTV = (const float*)(ws + WS_LASTV);
    bf16* ZS = (bf16*)(ws + WS_ZS);
    LAS float* RMS = (LAS float*)(lds + SC_RMS);
    const float gh = a.in[16][16 * wave + fr];
    f32x4 Sacc[8];
#pragma unroll
    for (int mt = 0; mt < 8; ++mt) Sacc[mt] = (f32x4){0.f, 0.f, 0.f, 0.f};
    v4u ztn[2]; v2u u0n[4]; float lastn;
    auto chunk_dma = [&](int c) {
        const size_t uq = (size_t)(b * NCH + c) * NH + h; const bf16* blk = QKVB + uq * QBLK; LAS unsigned char* base = lds + (c & 1) * SC_BUF;
#pragma unroll
        for (int k = 0; k < 2; ++k) { const int P = (wave + 8 * k) * 64 + lane, row = P >> 4, ch = (P & 15) ^ (row & 15);
            __builtin_amdgcn_global_load_lds((const unsigned*)(blk + 8192 + row * 128 + 8 * ch), (LAS unsigned*)(base + SC_W + (wave + 8 * k) * 1024), 16, 0, 0);
            __builtin_amdgcn_global_load_lds((const unsigned*)(blk + row * 128 + 8 * ch), (LAS unsigned*)(base + SC_QD + (wave + 8 * k) * 1024), 16, 0, 0);
            const int line = P >> 4, t = (P & 15) ^ (line & 7), r2 = 2 * line + (t >> 3);
            __builtin_amdgcn_global_load_lds((const unsigned*)(KDTg + uq * 8192 + r2 * 64 + 8 * (t & 7)), (LAS unsigned*)(base + SC_KDT + (wave + 8 * k) * 1024), 16, 0, 0); }
        { const int P = wave * 64 + lane, line = P >> 4, t = (P & 15) ^ (line & 7), r2 = 2 * line + (t >> 3);
            __builtin_amdgcn_global_load_lds((const unsigned*)(ATTg + uq * 4096 + r2 * 64 + 8 * (t & 7)), (LAS unsigned*)(base + SC_AT + wave * 1024), 16, 0, 0); }
    };
    auto side_load = [&](int c) {
        const size_t uq = (size_t)(b * NCH + c) * NH + h;
#pragma unroll
        for (int k = 0; k < 2; ++k) { const int p = tid + 512 * k; ztn[k] = *(const GAS v4u*)(ZS + (size_t)(b * TP + 64 * c + (p >> 4)) * DM + h * DH + 8 * (p & 15)); }
        const bf16* u0 = QKVB + uq * QBLK + 2 * 8192 + wave * 1024 + lane * 4;
#pragma unroll
        for (int m = 0; m < 4; ++m) u0n[m] = *(const GAS v2u*)(u0 + m * 256);
        lastn = LASTV[uq];
    };
    auto side_store = [&](int buf) {
#pragma unroll
        for (int k = 0; k < 2; ++k) { const int p = tid + 512 * k; *(LAS v4u*)(lds + SC_ZT + buf * 16384 + swz256(p >> 4, p & 15)) = ztn[k]; }
    };
    chunk_dma(0); side_load(0); side_store(0);
    v2u u0p[4]; float last;
#pragma unroll
    for (int m = 0; m < 4; ++m) u0p[m] = u0n[m];
    last = lastn;
    chunk_dma(1); side_load(1);
    __syncthreads();
    for (int c = 0; c < NCH; ++c) {
        const int buf = c & 1; LAS unsigned char* base = lds + buf * SC_BUF; LAS unsigned char* zt = lds + SC_ZT + buf * 16384;
        const int nvalid = (c == NCH - 1) ? TP - 64 * (NCH - 1) : 64;
        bf16x8v F[2][8];
#define SC_LD_A(m, f) do { _Pragma("unroll") for (int sI = 0; sI < 4; ++sI) { const int off = swz256(16 * (m) + fr, 4 * sI + fq); \
            f[2 * sI] = *(const LAS bf16x8v*)(base + SC_W + off); f[2 * sI + 1] = *(const LAS bf16x8v*)(base + SC_QD + off); } } while (0)
#define SC_LD_D(f) do { _Pragma("unroll") for (int m = 0; m < 4; ++m) _Pragma("unroll") for (int s2 = 0; s2 < 2; ++s2) f[2 * m + s2] = *(const LAS bf16x8v*)(base + SC_AT + swz128(16 * m + fr, 4 * s2 + fq)); } while (0)
#define SC_LD_C(g, f) do { _Pragma("unroll") for (int mm = 0; mm < 4; ++mm) _Pragma("unroll") for (int s2 = 0; s2 < 2; ++s2) f[2 * mm + s2] = *(const LAS bf16x8v*)(base + SC_KDT + swz128(16 * (4 * (g) + mm) + fr, 4 * s2 + fq)); } while (0)
        SC_LD_A(0, F[0]);
        bf16x8v Sb[4];
#pragma unroll
        for (int sI = 0; sI < 4; ++sI) { v4u w; w.x = cvtpk(Sacc[2 * sI][0], Sacc[2 * sI][1]); w.y = cvtpk(Sacc[2 * sI][2], Sacc[2 * sI][3]); w.z = cvtpk(Sacc[2 * sI + 1][0], Sacc[2 * sI + 1][1]); w.w = cvtpk(Sacc[2 * sI + 1][2], Sacc[2 * sI + 1][3]);
            Sb[sI] = __builtin_bit_cast(bf16x8v, w); }
        f32x4 u[4], o[4];
#pragma unroll
        for (int m = 0; m < 4; ++m) {
            if (m == 0) SC_LD_A(1, F[1]); else if (m == 1) SC_LD_A(2, F[0]); else if (m == 2) SC_LD_A(3, F[1]); else SC_LD_D(F[0]);
            __builtin_amdgcn_sched_barrier(0);
            f32x4 p = {0.f, 0.f, 0.f, 0.f}, oo = {0.f, 0.f, 0.f, 0.f};
#pragma unroll
            for (int sI = 0; sI < 4; ++sI) { p = __builtin_amdgcn_mfma_f32_16x16x32_bf16(F[m & 1][2 * sI], Sb[sI], p, 0, 0, 0); oo = __builtin_amdgcn_mfma_f32_16x16x32_bf16(F[m & 1][2 * sI + 1], Sb[sI], oo, 0, 0, 0); }
            u[m] = (f32x4){bflo(u0p[m].x), bfhi(u0p[m].x), bflo(u0p[m].y), bfhi(u0p[m].y)} - p; o[m] = oo;
            __builtin_amdgcn_sched_barrier(0);
        }
        bf16x8v Ub[2];
#pragma unroll
        for (int s2 = 0; s2 < 2; ++s2) { v4u w; w.x = cvtpk(u[2 * s2][0], u[2 * s2][1]); w.y = cvtpk(u[2 * s2][2], u[2 * s2][3]); w.z = cvtpk(u[2 * s2 + 1][0], u[2 * s2 + 1][1]); w.w = cvtpk(u[2 * s2 + 1][2], u[2 * s2 + 1][3]);
            Ub[s2] = __builtin_bit_cast(bf16x8v, w); }
        SC_LD_C(0, F[1]);
        __builtin_amdgcn_sched_barrier(0);
#pragma unroll
        for (int m = 0; m < 4; ++m)
#pragma unroll
            for (int s2 = 0; s2 < 2; ++s2) o[m] = __builtin_amdgcn_mfma_f32_16x16x32_bf16(F[0][2 * m + s2], Ub[s2], o[m], 0, 0, 0);
        __builtin_amdgcn_sched_barrier(0);
        SC_LD_C(1, F[0]);
        __builtin_amdgcn_sched_barrier(0);
#pragma unroll
        for (int mt = 0; mt < 4; ++mt) { f32x4 sacc = Sacc[mt] * last;
#pragma unroll
            for (int s2 = 0; s2 < 2; ++s2) sacc = __builtin_amdgcn_mfma_f32_16x16x32_bf16(F[1][2 * mt + s2], Ub[s2], sacc, 0, 0, 0);
            Sacc[mt] = sacc; }
        __builtin_amdgcn_sched_barrier(0);
#pragma unroll
        for (int mt = 4; mt < 8; ++mt) { f32x4 sacc = Sacc[mt] * last;
#pragma unroll
            for (int s2 = 0; s2 < 2; ++s2) sacc = __builtin_amdgcn_mfma_f32_16x16x32_bf16(F[0][2 * (mt - 4) + s2], Ub[s2], sacc, 0, 0, 0);
            Sacc[mt] = sacc; }
#undef SC_LD_A
#undef SC_LD_D
#undef SC_LD_C
        LAS float* rm = RMS + (c & 1) * 512;
#pragma unroll
        for (int m = 0; m < 4; ++m)
#pragma unroll
            for (int r = 0; r < 4; ++r) { const float v = sum16(o[m][r] * o[m][r]); if (fr == 0) rm[(16 * m + 4 * fq + r) * 8 + wave] = v; }
        if (c + 1 < NCH) { side_store(buf ^ 1);
#pragma unroll
            for (int m = 0; m < 4; ++m) u0p[m] = u0n[m];
            last = lastn; }
        asm volatile("s_waitcnt vmcnt(0) lgkmcnt(0)" ::: "memory"); __builtin_amdgcn_s_barrier(); asm volatile("" ::: "memory");
        if (c + 2 < NCH) side_load(c + 2);
        {   LAS float* rsw = RMS + ((c + 1) & 1) * 512 + wave * 64;
            const f32x4 p0 = *(const LAS f32x4*)(rm + lane * 8), p1 = *(const LAS f32x4*)(rm + lane * 8 + 4);
            LAS bf16* zp[16]; bf16 zv[16];
#pragma unroll
            for (int m = 0; m < 4; ++m)
#pragma unroll
                for (int r = 0; r < 4; ++r) { zp[4 * m + r] = (LAS bf16*)(zt + swz256(16 * m + 4 * fq + r, 2 * wave + (fr >> 3))) + (fr & 7); zv[4 * m + r] = *zp[4 * m + r]; }
            rsw[lane] = rsqf((((p0.x + p0.y) + (p0.z + p0.w)) + ((p1.x + p1.y) + (p1.z + p1.w))) * (1.f / DH) + EPS);
            f32x4 rs[4];
#pragma unroll
            for (int m = 0; m < 4; ++m) rs[m] = *(const LAS f32x4*)(rsw + 16 * m + 4 * fq);
            __builtin_amdgcn_sched_barrier(0);
#pragma unroll
            for (int m = 0; m < 4; ++m)
#pragma unroll
                for (int r = 0; r < 4; ++r) *zp[4 * m + r] = (bf16)f2bf(o[m][r] * rs[m][r] * gh * bf1(zv[4 * m + r]));
        }
        asm volatile("s_waitcnt lgkmcnt(0)" ::: "memory"); __builtin_amdgcn_s_barrier(); asm volatile("" ::: "memory");
        if (c + 2 < NCH) chunk_dma(c + 2);
#pragma unroll
        for (int k = 0; k < 2; ++k) { const int p = tid + 512 * k, i = p >> 4;
            if (i < nvalid) *(GAS v4u*)(ZS + (size_t)(b * TP + 64 * c + i) * DM + h * DH + 8 * (p & 15)) = *(const LAS v4u*)(zt + swz256(i, p & 15)); }
    }
    { float* so = a.out + O_PD + ((size_t)(b * NH + h) * DH) * DH + 16 * wave + fr;
#pragma unroll
      for (int mt = 0; mt < 8; ++mt)
#pragma unroll
          for (int r = 0; r < 4; ++r) so[(size_t)(16 * mt + 4 * fq + r) * DH] = Sacc[mt][r]; }
    __syncthreads();
}

static_assert(SC_END <= LDSCTL_OFF && 2 * IH_BYTES <= LDSCTL_OFF && RING_BYTES <= LDSCTL_OFF, "LDS map");
constexpr int NPHASES = 10;
__global__ void __launch_bounds__(NWAVES * 64, 2) fwd_kernel(Args args) {
    extern __shared__ __attribute__((aligned(16))) unsigned char lds_raw[];
    LAS unsigned char* lds = (LAS unsigned char*)lds_raw;
    volatile LAS unsigned* MISC = (volatile LAS unsigned*)(lds + MISC_OFF);
    const int tid = threadIdx.x, lane = tid & 63, wave = __builtin_amdgcn_readfirstlane(tid >> 6);
    const int G = gridDim.x, bx = blockIdx.x;
    const int vcu = (G % 8 == 0) ? (bx % 8) * (G / 8) + bx / 8 : bx;
    unsigned char* ws = args.ws;
    gu32* ctl = (gu32*)(ws + WS_CTL);
    for (int u = tid; u < (LDS_BYTES - LDSCTL_OFF) / 4; u += NWAVES * 64) ((LAS unsigned*)(lds + LDSCTL_OFF))[u] = 0u;
    __syncthreads();
    XcdBarrier bar; bar.bar = (unsigned*)(ctl + CW_BAR); bar.x = 0; bar.st = nullptr;
    const int lo = args.ph_lo, hi = args.ph_hi;
    if (hi - lo > 1) bar = xcd_barrier_post((unsigned*)(ctl + CW_BAR), MISC + 8);
#ifndef PH_MASK
#define PH_MASK 0x3ff
#endif
#define IN(k) (((PH_MASK >> (k)) & 1) && lo <= (k) && (k) < hi)
#ifndef PROBE_K
#define PROBE_K -1
#endif
#if PROBE_K >= 0
    volatile LAS unsigned long long* stamps = (volatile LAS unsigned long long*)(lds + MISC_OFF + 128);
    if (tid == 0) stamps[0] = __builtin_amdgcn_s_memrealtime();
#define SEAM(k) do { if (IN(k) && IN((k) + 1)) xcd_barrier(bar); if (tid == 0) stamps[(k) + 1] = __builtin_amdgcn_s_memrealtime(); } while (0)
#else
#define SEAM(k) do { if (IN(k) && IN((k) + 1)) xcd_barrier(bar); } while (0)
#endif
    bf16* WIN = (bf16*)(ws + WS_WIN); bf16* WC = (bf16*)(ws + WS_WC); bf16* WD = (bf16*)(ws + WS_WD); bf16* WO = (bf16*)(ws + WS_WO); bf16* WUP = (bf16*)(ws + WS_WUP); bf16* WDN = (bf16*)(ws + WS_WDN);
    bf16* H = (bf16*)(ws + WS_H); bf16* GLU = (bf16*)(ws + WS_GLU); bf16* QKVB = (bf16*)(ws + WS_QKVB); bf16* QS = (bf16*)(ws + WS_QS); bf16* ZS = (bf16*)(ws + WS_ZS);
    bf16* HALOQ = (bf16*)(ws + WS_HALOQ); bf16* HALOC = (bf16*)(ws + WS_HALOC);
    bf16* SGC = (bf16*)args.out; bf16* SGD = (bf16*)args.out + (size_t)M2 * DM;
    bf16* X1B = (bf16*)(ws + WS_X1B);
    bf16* MIX = (bf16*)(ws + WS_MIX); bf16* XG = (bf16*)(ws + WS_XG); bf16* HM = (bf16*)(ws + WS_HM); bf16* C = (bf16*)(ws + WS_C);
    float* BETAG = (float*)(ws + WS_BETAG);
    const int gw = vcu * NWAVES + wave, NGW = G * NWAVES;

    constexpr int KB1 = DM / 32, KB4 = DFF / 32, I_SQ = KB1 * (DM / 64), I_UP = KB1 * (DFF / 64), I_DN = KB4 * (DM / 64);
    constexpr int NU1 = (MP / 256) * (NIN / 256), NU4 = (MP / 256) * (DM / 256), NU7 = (M2 / 256) * (DFF / 256);
#define CONVERT_ITEMS(lo_, hi_, w0_, nw_) do { for (int it_ = (lo_) + (w0_); it_ < (hi_); it_ += (nw_)) { int r = it_; \
        if (r < I_SQ) { p0_transpose_item(args.in[12], DM, DM, WC, (r / KB1) * 64, (r / KB1) * 64, 64, (r % KB1) * 32, lane); continue; } r -= I_SQ; \
        if (r < I_SQ) { p0_transpose_item(args.in[17], DM, DM, WD, (r / KB1) * 64, (r / KB1) * 64, 64, (r % KB1) * 32, lane); continue; } r -= I_SQ; \
        if (r < I_SQ) { p0_transpose_item(args.in[18], DM, DM, WO, (r / KB1) * 64, (r / KB1) * 64, 64, (r % KB1) * 32, lane); continue; } r -= I_SQ; \
        if (r < I_UP) { p0_transpose_item(args.in[20], DFF, DM, WUP, (r / KB1) * 64, (r / KB1) * 64, 64, (r % KB1) * 32, lane); continue; } r -= I_UP; \
        p0_transpose_item(args.in[21], DM, DFF, WDN, (r / KB4) * 64, (r / KB4) * 64, 64, (r % KB4) * 32, lane); } } while (0)
    if (IN(0)) {
        constexpr int I_IN = KB1 * (NIN / 64);
        for (int it = gw; it < I_IN; it += NGW) { const int nb = it / KB1, kb = it % KB1; int src, nv; win_src(nb, src, nv); p0_transpose_item(args.in[7], DIN, DM, WIN, nb * 64, src, nv, kb * 32, lane); }
        for (int m0 = gw; m0 < MP; m0 += 2 * NGW) {
            const float* src[2]; bool ok[2]; f32x4 v[2][4];
#pragma unroll
            for (int q = 0; q < 2; ++q) { const int m = m0 + q * NGW; ok[q] = m < MR; const int mm = ok[q] ? m : 0;
                if (mm >= RP) src[q] = args.in[1] + (size_t)(mm - RP) * DM;
                else { const int b = mm / TP, t = mm - b * TP; src[q] = t < NMETA ? args.in[5] + (size_t)t * DM : args.in[0] + ((size_t)b * SEQ + (t - NMETA)) * DM; }
#pragma unroll
                for (int j = 0; j < 4; ++j) v[q][j] = ((const GAS f32x4*)src[q])[lane + 64 * j]; }
#pragma unroll
            for (int q = 0; q < 2; ++q) { const int m = m0 + q * NGW; if (m >= MP) continue;
                float ss = 0.f;
#pragma unroll
                for (int j = 0; j < 4; ++j) ss += (v[q][j].x * v[q][j].x + v[q][j].y * v[q][j].y) + (v[q][j].z * v[q][j].z + v[q][j].w * v[q][j].w);
                const float rstd = ok[q] ? rsqf(wave_sum(ss) * (1.f / DM) + EPS) : 0.f;
                GAS v2u* o8 = (GAS v2u*)(H + (size_t)m * DM) + lane;
#pragma unroll
                for (int j = 0; j < 4; ++j) { const f32x4 g = ((const GAS f32x4*)args.in[6])[lane + 64 * j]; v2u o; o.x = cvtpk(v[q][j].x * rstd * g.x, v[q][j].y * rstd * g.y); o.y = cvtpk(v[q][j].z * rstd * g.z, v[q][j].w * rstd * g.w); o8[64 * j] = o; } }
        }
    }
    SEAM(0);
    if (IN(1)) {
        pg8::Gemm g{H, WIN, MP, NIN, DM}; pg8::StaticOrder S; S.init(MP, NIN, G, bx, DM);
        EpiIn E{GLU, QKVB, QS, HALOQ, HALOC, ZS, SGC, SGD, BETAG, args.in[14], args.in[15]};
        pg8::gemm_phase<EpiIn, pg8::StaticOrder, true, true>(lds + RING_OFF, g, S, E);
        if (G == 256) { if (bx >= NU1 % 256) CONVERT_ITEMS(0, 2 * I_SQ, (bx - NU1 % 256) * NWAVES + wave, (256 - NU1 % 256) * NWAVES); }
        else CONVERT_ITEMS(0, 3 * I_SQ + I_UP + I_DN, gw, NGW);
    }
    SEAM(1);
    if (IN(2)) {
        constexpr int N_CP = BP * NRUN, N_IP = BP * NCH * NH / 2, N_SD = BS * NH / 4, N_CS = BS, N_ITEMS = N_CP + N_IP + N_SD + N_CS;
        volatile LAS int* qslot = (volatile LAS int*)(lds + MISC_OFF + 64);
#if PROBE_K >= 0 && !defined(PROBE_NOSPLIT)
        for (int sub = 0; sub < 3; ++sub) {
            const int lo_i = sub == 0 ? 0 : (sub == 1 ? N_CP : N_CP + N_IP), hi_i = sub == 0 ? N_CP : (sub == 1 ? N_CP + N_IP : N_CP + N_IP + N_SD);
            for (;;) {
                if (tid == 0) *qslot = (int)__hip_atomic_fetch_add((unsigned*)(ctl + 2048 + 64 * sub), 1u, __ATOMIC_RELAXED, __HIP_MEMORY_SCOPE_AGENT);
                __syncthreads();
                int it = *qslot + lo_i;
                __syncthreads();
                if (sub == 0 && it >= N_CP) { it += N_IP + N_SD; if (it >= N_ITEMS) break; conv_unit<1>(args, lds, it - (N_CP + N_IP + N_SD), 0); continue; }
                if (it >= hi_i) break;
                if (it < N_CP) { conv_unit<0>(args, lds, it / NRUN, it % NRUN); continue; } it -= N_CP;
                if (it < N_IP) { intra_pair(args, lds, it); continue; } it -= N_IP;
                (void)it;
            }
            if (sub < 2) { xcd_barrier(bar); if (tid == 0) stamps[12 + sub] = __builtin_amdgcn_s_memrealtime(); }
        }
#else
        for (;;) {
            if (tid == 0) *qslot = (int)__hip_atomic_fetch_add((unsigned*)(ctl + 2048), 1u, __ATOMIC_RELAXED, __HIP_MEMORY_SCOPE_AGENT);
            __syncthreads();
            int it = *qslot;
            __syncthreads();
            if (it >= N_CP + N_IP) it += N_SD;
            if (it >= N_ITEMS) break;
            if (it < N_CP) { conv_unit<0>(args, lds, it / NRUN, it % NRUN); continue; } it -= N_CP;
            if (it < N_IP) { intra_pair(args, lds, it); continue; } it -= N_IP;
            it -= N_SD; if (it < 0) continue;
            conv_unit<1>(args, lds, it, 0);
        }
#endif
    }
    SEAM(2);
    if (IN(3)) {
        if (bx < BP * NH) { scan_chain(args, lds, bx);
#if PROBE_K >= 0
            if (tid == 0) stamps[14] = __builtin_amdgcn_s_memrealtime();
#endif
        }
#if defined(PROBE_SCAN_ALONE)
        xcd_barrier(bar);
        if (bx < BP * NH) {}
#endif
        else {
            pg8::Gemm g{C, WC, MP, DM, DM}; pg8::StaticOrder S; S.init(MP, DM, G - BP * NH, bx - BP * NH, DM);
            EpiGate<0> E{SGC, nullptr, SGC};
            pg8::gemm_phase<EpiGate<0>, pg8::StaticOrder, true, true>(lds + RING_OFF, g, S, E);
            volatile LAS int* qslot = (volatile LAS int*)(lds + MISC_OFF + 64);
            for (;;) {
                if (tid == 0) *qslot = (int)__hip_atomic_fetch_add((unsigned*)(ctl + 2048 + 256), 1u, __ATOMIC_RELAXED, __HIP_MEMORY_SCOPE_AGENT);
                __syncthreads();
                const int it = *qslot;
                __syncthreads();
                if (it >= BS * NH / 4) break;
                delta_item(args, lds, it);
            }
        }
    }
    SEAM(3);
    if (IN(4)) {
        pg8::Gemm g{ZS, WD, MP, DM, DM}; pg8::StaticOrder S; S.init(MP, DM, G, bx, DM);
        EpiGate<1> E{SGD, SGC, MIX};
        pg8::gemm_phase<EpiGate<1>, pg8::StaticOrder, true, true>(lds + RING_OFF, g, S, E);
        if (G == 256 && bx >= NU4 % 256) CONVERT_ITEMS(2 * I_SQ, 3 * I_SQ + I_UP, (bx - NU4 % 256) * NWAVES + wave, (256 - NU4 % 256) * NWAVES);
    }
    SEAM(4);
    if (IN(5)) {
        pg8::Gemm g{MIX, WO, M2, DM, DM}; pg8::SplitOrder S; S.init(BP * SEQ, M2, DM, G, bx, DM, KSPLIT5);
        EpiWoP E; E.xp = args.in[0]; E.X1B = X1B; E.parts = (float*)(ws + WS_PART5);
        pg8::gemm_phase<EpiWoP, pg8::SplitOrder, true, true>(lds + RING_OFF, g, S, E);
    }
    SEAM(5);
    if (IN(6)) {
        for (int i0 = gw; i0 < M2; i0 += 2 * NGW) {
            f32x4 v[2][4]; int mrow[2]; bool ok[2];
#pragma unroll
            for (int q = 0; q < 2; ++q) { const int i = i0 + q * NGW; ok[q] = i < M2; const int ii = ok[q] ? i : 0; const int m = ii < RS ? BP * SEQ + ii : ii - RS; mrow[q] = m;
                if (m >= BP * SEQ) { const GAS f32x4* x0 = (const GAS f32x4*)(args.in[1] + (size_t)(m - BP * SEQ) * DM) + lane;
#pragma unroll
                    for (int jj = 0; jj < 4; ++jj) v[q][jj] = x0[64 * jj];
                } else { const GAS v2u* xb = (const GAS v2u*)(X1B + (size_t)m * DM) + lane;
#pragma unroll
                    for (int jj = 0; jj < 4; ++jj) { const v2u o = xb[64 * jj]; v[q][jj] = (f32x4){bflo(o.x), bfhi(o.x), bflo(o.y), bfhi(o.y)}; } } }
#pragma unroll
            for (int q = 0; q < 2; ++q) { const int m = mrow[q]; if (!ok[q]) continue;
                if (m >= BP * SEQ) {
                    const GAS f32x4* pr = (const GAS f32x4*)((const float*)(ws + WS_PART5) + (size_t)(m - BP * SEQ) * DM) + lane; GAS v2u* xb = (GAS v2u*)(X1B + (size_t)m * DM) + lane;
#pragma unroll
                    for (int jj = 0; jj < 4; ++jj) {
#pragma unroll
                        for (int ks = 0; ks < KSPLIT5; ++ks) v[q][jj] += pr[(size_t)ks * RS * DM / 4 + 64 * jj];
                        v2u o; o.x = cvtpk(v[q][jj].x, v[q][jj].y); o.y = cvtpk(v[q][jj].z, v[q][jj].w); xb[64 * jj] = o;
                        v[q][jj] = (f32x4){bflo(o.x), bfhi(o.x), bflo(o.y), bfhi(o.y)}; } }
                float ss = 0.f;
#pragma unroll
                for (int jj = 0; jj < 4; ++jj) ss += (v[q][jj].x * v[q][jj].x + v[q][jj].y * v[q][jj].y) + (v[q][jj].z * v[q][jj].z + v[q][jj].w * v[q][jj].w);
                const float rstd = rsqf(wave_sum(ss) * (1.f / DM) + EPS);
                GAS v2u* o8 = (GAS v2u*)(XG + (size_t)m * DM) + lane; const GAS f32x4* gr = (const GAS f32x4*)args.in[19] + lane;
#pragma unroll
                for (int jj = 0; jj < 4; ++jj) { const f32x4 g = gr[64 * jj]; v2u o; o.x = cvtpk(v[q][jj].x * rstd * g.x, v[q][jj].y * rstd * g.y); o.y = cvtpk(v[q][jj].z * rstd * g.z, v[q][jj].w * rstd * g.w); o8[64 * jj] = o; } }
        }
    }
    SEAM(6);
    if (IN(7)) {
        pg8::Gemm g{XG, WUP, M2, DFF, DM}; pg8::StaticOrder S; S.init(M2, DFF, G, bx, DM);
        EpiUp E{HM};
        pg8::gemm_phase<EpiUp, pg8::StaticOrder, true, true>(lds + RING_OFF, g, S, E);
        if (G == 256 && bx >= NU7 % 256) CONVERT_ITEMS(3 * I_SQ + I_UP, 3 * I_SQ + I_UP + I_DN, (bx - NU7 % 256) * NWAVES + wave, (256 - NU7 % 256) * NWAVES);
    }
    SEAM(7);
    if (IN(8)) {
        pg8::Gemm g{HM, WDN, M2, DM, DFF}; pg8::SplitOrder S; S.init(BP * SEQ, M2, DM, G, bx, DFF, KSPLIT);
        EpiRes<1> E{nullptr, nullptr, args.out, (float*)(ws + WS_PART), X1B};
        pg8::gemm_phase<EpiRes<1>, pg8::SplitOrder, true, true>(lds + RING_OFF, g, S, E);
    }
    SEAM(8);
    if (IN(9)) {
        for (int i0 = gw; i0 < M2; i0 += 2 * NGW) {
            f32x4 v[2][4]; int mrow[2]; bool ok[2];
#pragma unroll
            for (int q = 0; q < 2; ++q) { const int i = i0 + q * NGW; ok[q] = i < M2; const int ii = ok[q] ? i : 0; const int m = ii < RS ? BP * SEQ + ii : ii - RS; mrow[q] = m;
                const GAS v2u* xb = (const GAS v2u*)(X1B + (size_t)m * DM) + lane;
#pragma unroll
                for (int jj = 0; jj < 4; ++jj) { const v2u o = xb[64 * jj]; v[q][jj] = (f32x4){bflo(o.x), bfhi(o.x), bflo(o.y), bfhi(o.y)}; } }
#pragma unroll
            for (int q = 0; q < 2; ++q) { const int m = mrow[q]; if (!ok[q]) continue;
                if (m >= BP * SEQ) { const GAS f32x4* pr = (const GAS f32x4*)((const float*)(ws + WS_PART) + (size_t)(m - BP * SEQ) * DM) + lane;
#pragma unroll 4
                    for (int ks = 0; ks < KSPLIT; ++ks)
#pragma unroll
                        for (int jj = 0; jj < 4; ++jj) v[q][jj] += pr[(size_t)ks * RS * DM / 4 + 64 * jj]; }
                float s2 = 0.f;
#pragma unroll
                for (int jj = 0; jj < 4; ++jj) s2 += (v[q][jj].x * v[q][jj].x + v[q][jj].y * v[q][jj].y) + (v[q][jj].z * v[q][jj].z + v[q][jj].w * v[q][jj].w);
                const float rstd = rsqf(wave_sum(s2) * (1.f / DM) + EPS);
                GAS f32x4* xr = (GAS f32x4*)(args.out + (size_t)m * DM) + lane; const GAS f32x4* gr = (const GAS f32x4*)args.in[22] + lane;
#pragma unroll
                for (int jj = 0; jj < 4; ++jj) xr[64 * jj] = v[q][jj] * rstd * gr[64 * jj]; }
        }
    }
#if PROBE_K >= 0
    __syncthreads();
    if (bx == 0) { if (tid == 0) stamps[NPHASES] = __builtin_amdgcn_s_memrealtime(); __syncthreads();
        const float dt_us = (float)(stamps[PROBE_B] - stamps[PROBE_K]) * 0.01f; const float f = 1.f + dt_us * (1.f / (float)(PROBE_DIV));
        for (int i = tid; i < BP * 3 * DQKV; i += NWAVES * 64) args.out[O_PQ + i] *= f; }
#endif
#undef IN
#undef SEAM
}

extern "C" void kernel_launch(void* const* d_in, const int* in_sizes, int n_in, void* d_out, int out_size, void* d_ws, size_t ws_size, hipStream_t stream) {
    static int grid = 0;
    if (grid == 0) {
        if (n_in != 23 || (size_t)out_size != O_END || ws_size < WS_END) { fprintf(stderr, "kernel_launch: unexpected shapes n_in %d out %d ws %zu\n", n_in, out_size, ws_size); grid = -1; return; }
        int dev = 0, cus = 0, per_cu = 0;
        if (hipGetDevice(&dev) != hipSuccess || hipDeviceGetAttribute(&cus, hipDeviceAttributeMultiprocessorCount, dev) != hipSuccess) { grid = -1; return; }
        if (hipFuncSetAttribute((const void*)fwd_kernel, hipFuncAttributeMaxDynamicSharedMemorySize, LDS_BYTES) != hipSuccess) { fprintf(stderr, "kernel_launch: hipFuncSetAttribute failed\n"); grid = -1; return; }
        if (hipOccupancyMaxActiveBlocksPerMultiprocessor(&per_cu, (const void*)fwd_kernel, NWAVES * 64, LDS_BYTES) != hipSuccess || per_cu < 1)
            fprintf(stderr, "kernel_launch: occupancy query reports %d\n", per_cu);
        (void)hipGetLastError();
        grid = cus;
    }
    if (grid < 0) return;
    if (hipMemsetAsync((char*)d_ws + WS_CTL, 0, CTL_ZERO_BYTES, stream) != hipSuccess) return;
    Args a{};
    for (int i = 0; i < 23; ++i) a.in[i] = (const float*)d_in[i];
    a.out = (float*)d_out; a.ws = (unsigned char*)d_ws;
#if MK_N_LAUNCHES == 1
    a.ph_lo = 0; a.ph_hi = NPHASES;
    hipLaunchKernelGGL(fwd_kernel, dim3(grid), dim3(NWAVES * 64), LDS_BYTES, stream, a);
#else
    for (int p = 0; p < NPHASES; ++p) { a.ph_lo = p; a.ph_hi = p + 1; hipLaunchKernelGGL(fwd_kernel, dim3(grid), dim3(NWAVES * 64), LDS_BYTES, stream, a); }
#endif
}
```

```cpp
#include <hip/hip_runtime.h>
#include <cstdio>
#include <cstdint>

#ifndef MK_N_LAUNCHES
#define MK_N_LAUNCHES 1
#endif

namespace pg8 {
#define PG8_LAS __attribute__((address_space(3)))
typedef unsigned short bf16_t;
typedef short bf16x8 __attribute__((ext_vector_type(8)));
typedef float f32x4 __attribute__((ext_vector_type(4)));
typedef unsigned u32x4 __attribute__((ext_vector_type(4)));
constexpr int BM = 256, BK = 64, HALF = 128, HTB = HALF * BK * 2, STAGE_BYTES = 8 * HTB, NXCD = 8, WGM = 8;

__host__ __device__ __forceinline__ int lds_byte(int r, int c) { const int st = (r >> 4) * 2 + (c >> 5), rr = r & 15, cc = c & 31, ob = rr * 64 + cc * 2; return st * 1024 + (ob ^ (((ob >> 9) & 1) << 5)); }
__host__ __device__ __forceinline__ void stage_rc(int b, int& R, int& C) { const int st = b / 1024, sb = b % 1024, swz = sb ^ (((sb >> 9) & 1) << 5); R = (st >> 1) * 16 + swz / 64; C = (st & 1) * 32 + (swz % 64) / 2; }
__host__ __device__ __forceinline__ int perm32(int rho) { const int n = rho >> 4, i = rho & 15; return 8 * (i >> 2) + 4 * n + (i & 3); }

struct Unit { int pm, pn, k0, nt, typ; };
struct Gemm { const bf16_t* A; const bf16_t* Bt; int M, N, K;
    __device__ __forceinline__ const char* a(const Unit&) const { return (const char*)A; } __device__ __forceinline__ const char* b(const Unit&) const { return (const char*)Bt; } };
struct Gemm2 { const bf16_t *A0, *B0, *A1, *B1; int K;
    __device__ __forceinline__ const char* a(const Unit& u) const { return (const char*)(u.typ ? A1 : A0); } __device__ __forceinline__ const char* b(const Unit& u) const { return (const char*)(u.typ ? B1 : B0); } };

struct StaticOrder {
    int nM, nN, nwg, G, c, nt;
    __host__ __device__ void init(int M, int N, int G_, int c_, int K) { nM = M / BM; nN = N / BM; nwg = nM * nN; G = G_; c = c_; nt = K / BK; }
    __host__ __device__ __forceinline__ bool next(int i, Unit& u) const {
        const long L = (long)i * G + c; if (L >= nwg) return false;
        u.k0 = 0; u.nt = nt; u.typ = 0;
        int wgid = (int)L; { const int q = nwg / NXCD, r = nwg % NXCD, xcd = wgid % NXCD, off = wgid / NXCD; wgid = (xcd < r ? xcd * (q + 1) : r * (q + 1) + (xcd - r) * q) + off; }
        const int nig = WGM * nN, gid = wgid / nig, fm = gid * WGM, gsz = (nM - fm) < WGM ? (nM - fm) : WGM;
        u.pm = fm + ((wgid % nig) % gsz); u.pn = (wgid % nig) / gsz; return true;
    }
    __device__ __forceinline__ void a_ready(const Unit&) const {}
    __device__ __forceinline__ void done(const Unit&) const {}
};

struct SplitOrder {
    int nM, nN, nwg, G, c, ntfull, nsub, KS, ntsub;
    __host__ __device__ void init(int Mmain, int Mall, int N, int G_, int c_, int K, int KS_) { nM = Mmain / BM; nN = N / BM; nwg = nM * nN; G = G_; c = c_; ntfull = K / BK; KS = KS_; ntsub = K / BK / KS_; nsub = (Mall / BM - nM) * nN * KS_; }
    __host__ __device__ __forceinline__ bool next(int i, Unit& u) const {
        const long L = (long)i * G + c; if (L >= nwg + nsub) return false;
        int pm, pn, k0, ntu;
        if (L < nwg) {
            int wgid = (int)L; { const int q = nwg / NXCD, r = nwg % NXCD, xcd = wgid % NXCD, off = wgid / NXCD; wgid = (xcd < r ? xcd * (q + 1) : r * (q + 1) + (xcd - r) * q) + off; }
            const int nig = WGM * nN, gid = wgid / nig, fm = gid * WGM, gsz = (nM - fm) < WGM ? (nM - fm) : WGM;
            pm = fm + ((wgid % nig) % gsz); pn = (wgid % nig) / gsz; k0 = 0; ntu = ntfull;
        } else { const int j = (int)L - nwg, tile = j / KS, ks = j % KS; pm = nM + tile / nN; pn = tile % nN; k0 = ks * ntsub; ntu = ntsub; }
        u.pm = pm; u.pn = pn; u.k0 = k0; u.nt = ntu; u.typ = 0; return true;
    }
    __device__ __forceinline__ void a_ready(const Unit&) const {}
    __device__ __forceinline__ void done(const Unit&) const {}
};

__device__ __forceinline__ unsigned cvt_pk_bf16(float lo, float hi) { unsigned r; asm volatile("v_cvt_pk_bf16_f32 %0, %1, %2" : "=v"(r) : "v"(lo), "v"(hi)); return r; }

template <class Epi, class Sched, bool ALIGN_EPI = false, bool SP2 = false, class GemmT = Gemm>
__device__ __forceinline__ void gemm_phase(PG8_LAS unsigned char* lds, const GemmT g, const Sched& S, const Epi& E) {
    const int tid = threadIdx.x, wid = __builtin_amdgcn_readfirstlane(tid >> 6), lane = tid & 63, wr = wid >> 2, wc = wid & 3, fr = lane & 15, fq = lane >> 4;
    const int K = g.K;
    unsigned voffA[2], voffB[2];
#pragma unroll
    for (int i = 0; i < 2; ++i) { int R, C; stage_rc(tid * 16 + i * 8192, R, C); const int Rb = Epi::PERM ? ((R & ~31) + perm32(R & 31)) : R;
        voffA[i] = (unsigned)(R * K + C) * 2u; voffB[i] = (unsigned)(Rb * K + C) * 2u; }
    const size_t kstep = (size_t)(BK * 2);
    const size_t hstep = (size_t)HALF * K * 2;
    const size_t tstep = 2 * hstep;
    const unsigned ldsw = (unsigned)wid * 1024u;
    const int aoff = lds_byte(wr * 64 + fr, fq * 8), boff = lds_byte(wc * 32 + fr, fq * 8);
#define PG8_SA(b, h) (((b) * 2 + (h)) * HTB)
#define PG8_SB(b, h) ((4 + (b) * 2 + (h)) * HTB)
#define PG8_STAGE(bufoff, gbase, voff) do { _Pragma("unroll") for (int _i = 0; _i < 2; ++_i) \
        __builtin_amdgcn_global_load_lds((const unsigned*)((const char*)(gbase) + (voff)[_i]), (PG8_LAS unsigned*)(lds + (bufoff) + ldsw + _i * 8192), 16, 0, 0); } while (0)
#define PG8_LDA(dst, b, h) do { _Pragma("unroll") for (int m = 0; m < 4; ++m) _Pragma("unroll") for (int k = 0; k < 2; ++k) dst[m][k] = *(const PG8_LAS bf16x8*)(lds + PG8_SA(b, h) + aoff + m * 2048 + k * 1024); } while (0)
#define PG8_LDB(dst, b, h) do { _Pragma("unroll") for (int n = 0; n < 2; ++n) _Pragma("unroll") for (int k = 0; k < 2; ++k) dst[n][k] = *(const PG8_LAS bf16x8*)(lds + PG8_SB(b, h) + boff + n * 2048 + k * 1024); } while (0)
#define PG8_MMA(ai, bj, At, Bt) do { __builtin_amdgcn_s_setprio(1); _Pragma("unroll") for (int m = 0; m < 4; ++m) _Pragma("unroll") for (int n = 0; n < 2; ++n) _Pragma("unroll") for (int k = 0; k < 2; ++k) \
        acc[ai][bj][m][n] = __builtin_amdgcn_mfma_f32_16x16x32_bf16(Bt[n][k], At[m][k], acc[ai][bj][m][n], 0, 0, 0); __builtin_amdgcn_s_setprio(0); } while (0)
#define PG8_WAIT_V(n) asm volatile("s_waitcnt vmcnt(" #n ")" ::: "memory")
#define PG8_WAIT_L(n) asm volatile("s_waitcnt lgkmcnt(" #n ")" ::: "memory")
#define PG8_BAR __builtin_amdgcn_s_barrier()
#define PG8_SCHED __builtin_amdgcn_sched_barrier(0)
    Unit cur, nxt; int ui = 0;
    if (!S.next(0, cur)) return;
    f32x4 acc[2][2][4][2];
#pragma unroll
    for (int a = 0; a < 2; ++a)
#pragma unroll
        for (int b = 0; b < 2; ++b)
#pragma unroll
            for (int m = 0; m < 4; ++m)
#pragma unroll
                for (int n = 0; n < 2; ++n) acc[a][b][m][n] = (f32x4){0.f, 0.f, 0.f, 0.f};
    bf16x8 At[4][2], B0[2][2], B1[2][2];
    const char* cA = g.a(cur) + (size_t)cur.pm * tstep + (size_t)cur.k0 * kstep; const char* cB = g.b(cur) + (size_t)cur.pn * tstep + (size_t)cur.k0 * kstep;
    S.a_ready(cur);
    if constexpr (SP2) {
        PG8_STAGE(PG8_SB(0, 0), cB, voffB); PG8_STAGE(PG8_SB(0, 1), cB + hstep, voffB); PG8_STAGE(PG8_SA(0, 0), cA, voffA); PG8_STAGE(PG8_SA(0, 1), cA + hstep, voffA);
        if (wr == 1) PG8_BAR;
        PG8_WAIT_V(2); PG8_BAR;
        PG8_STAGE(PG8_SB(1, 0), cB + kstep, voffB); PG8_STAGE(PG8_SA(1, 0), cA + kstep, voffA); PG8_STAGE(PG8_SB(1, 1), cB + hstep + kstep, voffB);
        PG8_WAIT_V(6); PG8_BAR;
    } else {
        PG8_STAGE(PG8_SB(0, 0), cB, voffB); PG8_STAGE(PG8_SA(0, 0), cA, voffA); PG8_STAGE(PG8_SB(0, 1), cB + hstep, voffB); PG8_STAGE(PG8_SA(0, 1), cA + hstep, voffA);
        if (wr == 1) PG8_BAR;
        PG8_WAIT_V(4); PG8_BAR;
        PG8_STAGE(PG8_SB(1, 0), cB + kstep, voffB); PG8_STAGE(PG8_SA(1, 0), cA + kstep, voffA); PG8_STAGE(PG8_SB(1, 1), cB + hstep + kstep, voffB);
        PG8_WAIT_V(6); PG8_BAR;
    }
    for (;;) {
        const bool has_next = S.next(ui + 1, nxt);
        const char* nA = has_next ? g.a(nxt) + (size_t)nxt.pm * tstep + (size_t)nxt.k0 * kstep : cA; const char* nB = has_next ? g.b(nxt) + (size_t)nxt.pn * tstep + (size_t)nxt.k0 * kstep : cB;
        const int nt = cur.nt;
        for (int t = 0; t < nt; t += 2) {
            const bool last = (t == nt - 2);
            const char* a1 = cA + (size_t)(t + 1) * kstep;
            const char* a2 = last ? nA : cA + (size_t)(t + 2) * kstep; const char* b2 = last ? nB : cB + (size_t)(t + 2) * kstep;
            const char* a3 = a2 + kstep; const char* b3 = b2 + kstep;
            if (last && has_next) S.a_ready(nxt);
            if constexpr (SP2) {
            PG8_LDB(B0, 0, 0); PG8_LDB(B1, 0, 1); PG8_SCHED; PG8_LDA(At, 0, 0); PG8_STAGE(PG8_SA(1, 1), a1 + hstep, voffA);
            PG8_WAIT_V(8); PG8_WAIT_L(0); PG8_BAR; PG8_MMA(0, 0, At, B0); PG8_MMA(0, 1, At, B1); PG8_BAR; PG8_SCHED;
            PG8_LDA(At, 0, 1); PG8_STAGE(PG8_SB(0, 0), b2, voffB); PG8_STAGE(PG8_SB(0, 1), b2 + hstep, voffB); PG8_STAGE(PG8_SA(0, 0), a2, voffA);
            PG8_WAIT_V(8); PG8_WAIT_L(0); PG8_BAR; PG8_MMA(1, 0, At, B0); PG8_MMA(1, 1, At, B1); PG8_BAR; PG8_SCHED;
            PG8_LDB(B0, 1, 0); PG8_LDB(B1, 1, 1); PG8_SCHED; PG8_LDA(At, 1, 0); PG8_STAGE(PG8_SA(0, 1), a2 + hstep, voffA);
            PG8_WAIT_V(8); PG8_WAIT_L(0); PG8_BAR; PG8_MMA(0, 0, At, B0); PG8_MMA(0, 1, At, B1); PG8_BAR; PG8_SCHED;
            PG8_LDA(At, 1, 1); PG8_STAGE(PG8_SB(1, 0), b3, voffB); PG8_STAGE(PG8_SB(1, 1), b3 + hstep, voffB); PG8_STAGE(PG8_SA(1, 0), a3, voffA);
            PG8_WAIT_V(8); PG8_WAIT_L(0); PG8_BAR; PG8_MMA(1, 0, At, B0); PG8_MMA(1, 1, At, B1); PG8_BAR; PG8_SCHED;
            } else {
            PG8_LDB(B0, 0, 0); PG8_SCHED; PG8_LDA(At, 0, 0); PG8_STAGE(PG8_SA(1, 1), a1 + hstep, voffA);
            PG8_WAIT_L(8); PG8_BAR; PG8_WAIT_L(0); PG8_MMA(0, 0, At, B0); PG8_BAR; PG8_SCHED;
            PG8_LDB(B1, 0, 1); PG8_STAGE(PG8_SB(0, 0), b2, voffB);
            PG8_BAR; PG8_WAIT_L(0); PG8_MMA(0, 1, At, B1); PG8_BAR;
            PG8_LDA(At, 0, 1); PG8_STAGE(PG8_SA(0, 0), a2, voffA);
            PG8_BAR; PG8_WAIT_L(0); PG8_MMA(1, 0, At, B0); PG8_BAR; PG8_SCHED;
            PG8_STAGE(PG8_SB(0, 1), b2 + hstep, voffB);
            PG8_WAIT_V(6); PG8_BAR; PG8_MMA(1, 1, At, B1); PG8_BAR;
            PG8_LDB(B0, 1, 0); PG8_SCHED; PG8_LDA(At, 1, 0); PG8_STAGE(PG8_SA(0, 1), a2 + hstep, voffA);
            PG8_WAIT_L(8); PG8_BAR; PG8_WAIT_L(0); PG8_MMA(0, 0, At, B0); PG8_BAR; PG8_SCHED;
            PG8_LDB(B1, 1, 1); PG8_STAGE(PG8_SB(1, 0), b3, voffB);
            PG8_BAR; PG8_WAIT_L(0); PG8_MMA(0, 1, At, B1); PG8_BAR;
            PG8_LDA(At, 1, 1); PG8_STAGE(PG8_SA(1, 0), a3, voffA);
            PG8_BAR; PG8_WAIT_L(0); PG8_MMA(1, 0, At, B0); PG8_BAR; PG8_SCHED;
            PG8_STAGE(PG8_SB(1, 1), b3 + hstep, voffB);
            PG8_WAIT_V(6); PG8_BAR; PG8_MMA(1, 1, At, B1); PG8_BAR;
            }
        }
        if constexpr (ALIGN_EPI) { if (wr == 0) PG8_BAR; }
        E(acc, cur, wr, wc, fr, fq); S.done(cur);
        if (!has_next) break;
#pragma unroll
        for (int a = 0; a < 2; ++a)
#pragma unroll
            for (int b = 0; b < 2; ++b)
#pragma unroll
                for (int m = 0; m < 4; ++m)
#pragma unroll
                    for (int n = 0; n < 2; ++n) acc[a][b][m][n] = (f32x4){0.f, 0.f, 0.f, 0.f};
        cur = nxt; cA = nA; cB = nB; ++ui;
        if constexpr (ALIGN_EPI) { if (wr == 1) PG8_BAR; }
    }
    PG8_WAIT_V(0);
    if constexpr (!ALIGN_EPI) { if (wr == 0) PG8_BAR; }
    PG8_BAR;
#undef PG8_SA
#undef PG8_SB
#undef PG8_STAGE
#undef PG8_LDA
#undef PG8_LDB
#undef PG8_MMA
#undef PG8_WAIT_V
#undef PG8_WAIT_L
#undef PG8_BAR
#undef PG8_SCHED
}
}

constexpr int NWAVES = 8;
constexpr int DM = 1024, BP = 8, SEQ = 2048, NMETA = 16, TP = SEQ + NMETA, BS = 128, TS = 4;
constexpr int RP = BP * TP;
constexpr int RS = BS * TS;
constexpr int MR = RP + RS;
constexpr int MP = 17152;
constexpr int M2 = BP * SEQ + RS;
constexpr int NH = 8, DH = 128, DQKV = 3072, DFF = 4096, KC = 31, KS = 4;
constexpr int NIN = 8448;
constexpr int DIN = 8208;
constexpr float EPS = 1e-6f;

constexpr size_t O_YP = 0, O_YS = 16777216, O_PC = 17301504, O_PQ = 17547264, O_PD = 17620992, O_SC = 18669568, O_SQ = 22601728, O_SD = 23781376, O_END = 40558592;

constexpr size_t MiB = 1u << 20;
constexpr size_t WS_CTL = 0, CTL_ZERO_BYTES = 1 * MiB;
constexpr size_t WS_BETAG = 1 * MiB;
constexpr size_t WS_LASTV = 9 * MiB / 4;
constexpr size_t WS_HALOQ = 5 * MiB / 2;
constexpr size_t WS_WC = 29 * MiB / 4, WS_WD = WS_WC + 2 * MiB, WS_WO = WS_WD + 2 * MiB, WS_WUP = WS_WO + 2 * MiB, WS_WDN = WS_WUP + 8 * MiB;
constexpr size_t WS_GLU = 117 * MiB / 4;
constexpr size_t WS_QKVB = 63 * MiB;
constexpr size_t WS_QS = 162 * MiB;
constexpr size_t WS_ZS = 165 * MiB;
constexpr size_t WS_H = 397 * MiB / 2;
constexpr size_t WS_WIN = 232 * MiB;
constexpr size_t WS_HALOC = 497 * MiB / 2;
constexpr size_t WS_KDT = WS_H, WS_ATTN = 463 * MiB / 2;
constexpr size_t WS_MIX = WS_QKVB, WS_XG = WS_GLU, WS_HM = WS_QKVB, WS_C = WS_GLU;
constexpr int KSPLIT5 = 4; constexpr size_t WS_PART5 = 232 * MiB;
constexpr size_t WS_X1B = WS_H;
constexpr int CW_READY = 8192;
constexpr int KSPLIT = 16;
constexpr size_t WS_PART = WS_XG;
static_assert(WS_PART + (size_t)KSPLIT * RS * DM * 4 <= WS_QKVB, "ws map part");
constexpr size_t WS_END = 256 * MiB;
constexpr int NRUN = 16, RUNL = TP / NRUN;
static_assert(TP - 64 * 32 == 16 && NRUN * RUNL == TP && WS_HALOC + (size_t)BP * NRUN * 30 * DM * 2 <= WS_END, "conv runs");
constexpr int NCH = 33, QBLK = 3 * 64 * 128;
static_assert(WS_WIN + (size_t)NIN * DM * 2 <= WS_HALOC && WS_WDN + 8 * MiB <= WS_GLU && WS_GLU + (size_t)MP * DM * 2 <= WS_QKVB && WS_HALOQ + (size_t)BP * 33 * 3 * 3072 * 2 <= WS_WC, "ws map");
static_assert(WS_ZS + (size_t)MP * DM * 2 <= WS_H && WS_H + (size_t)MP * DM * 2 <= WS_WIN, "ws map 2");
static_assert(WS_QKVB + (size_t)BP * NCH * NH * QBLK * 2 <= WS_QS, "ws map qkvb");
static_assert(WS_HM + (size_t)M2 * DFF * 2 <= WS_H, "ws map hm");
static_assert(WS_KDT + (size_t)BP * NCH * NH * 8192 * 2 <= WS_ATTN && WS_ATTN + (size_t)BP * NCH * NH * 4096 * 2 <= WS_HALOC, "ws map kdt");
constexpr int CW_TMO = 0, CW_CODE = 1, CW_BAR = 4096;

constexpr int RING_OFF = 0, RING_BYTES = 131072;
constexpr int LDSCTL_OFF = 151552, MISC_OFF = LDSCTL_OFF + 320;
constexpr int LDS_BYTES = LDSCTL_OFF + 1024;

#define GAS __attribute__((address_space(1)))
#define LAS __attribute__((address_space(3)))
typedef unsigned short bf16;
typedef unsigned v4u __attribute__((ext_vector_type(4)));
typedef unsigned v2u __attribute__((ext_vector_type(2)));
typedef float f32x4 __attribute__((ext_vector_type(4)));
typedef float f32x2 __attribute__((ext_vector_type(2)));
typedef GAS unsigned gu32;
#define RLX_AGENT __ATOMIC_RELAXED, __HIP_MEMORY_SCOPE_AGENT
#define LDS_WAIT() asm volatile("s_waitcnt lgkmcnt(0)" ::: "memory")
#define VM_WAIT() asm volatile("s_waitcnt vmcnt(0)" ::: "memory")
__device__ __forceinline__ unsigned f2bf(float f) { unsigned u = __builtin_bit_cast(unsigned, f); return (u + 0x7fffu + ((u >> 16) & 1u)) >> 16; }
__device__ __forceinline__ unsigned pk2(float lo, float hi) { return f2bf(lo) | (f2bf(hi) << 16); }
typedef __bf16 bf16v2 __attribute__((ext_vector_type(2)));
__device__ __forceinline__ unsigned cvtpk(float lo, float hi) { const f32x2 v = {lo, hi}; const bf16v2 b = __builtin_convertvector(v, bf16v2); return __builtin_bit_cast(unsigned, b); }
__device__ __forceinline__ float bflo(unsigned w) { return __builtin_bit_cast(float, w << 16); }
__device__ __forceinline__ float bfhi(unsigned w) { return __builtin_bit_cast(float, w & 0xffff0000u); }
__device__ __forceinline__ float bf1(bf16 b) { return __builtin_bit_cast(float, ((unsigned)b) << 16); }
__device__ __forceinline__ float sigmoidf_(float x) { return __builtin_amdgcn_rcpf(1.f + __expf(-x)); }
__device__ __forceinline__ float siluf_(float x) { return x * sigmoidf_(x); }

#define XB_TMO      128
#define XB_XCNT(j)  (256  + 64 * (j))
#define XB_XSUB(j)  (1280 + 64 * (j))
#define XB_XGEN(j)  (2304 + 64 * (j))
#define XB_TOP      3328
#define XB_TOPGEN   3392
#define XCD_BAR_WORDS 3456
#define XB_SPIN_CAP (1u << 18)
__device__ __forceinline__ unsigned xb_ld(unsigned* p)              { return __hip_atomic_load(p, __ATOMIC_RELAXED, __HIP_MEMORY_SCOPE_AGENT); }
__device__ __forceinline__ unsigned xb_add(unsigned* p, unsigned v) { return __hip_atomic_fetch_add(p, v, __ATOMIC_RELAXED, __HIP_MEMORY_SCOPE_AGENT); }
__device__ __forceinline__ unsigned xb_xcc_id() { return (unsigned)__builtin_amdgcn_s_getreg((3 << 11) | 20) & 0xFu; }
#define XB_SPIN(cond, bar) do { unsigned _sp = 0; while (cond) { __builtin_amdgcn_s_sleep(1); \
    if ((++_sp & 255u) == 0u) { if (xb_ld(&(bar)[XB_TMO])) break; if (_sp > XB_SPIN_CAP) { atomicAdd(&(bar)[XB_TMO], 1u); break; } } } } while (0)
struct XcdBarrier { unsigned* bar; unsigned x; volatile LAS unsigned* st; };
__device__ __forceinline__ XcdBarrier xcd_barrier_post(unsigned* bar, volatile LAS unsigned* st) {
    XcdBarrier b; b.bar = bar; b.x = xb_xcc_id(); b.st = st;
    if (threadIdx.x == 0) (void)xb_add(&bar[XB_XCNT(b.x)], 1u);
    return b;
}
__device__ __forceinline__ void xcd_barrier_complete(unsigned* bar, unsigned x, unsigned& nloc, unsigned& nx) {
    const unsigned G = gridDim.x * gridDim.y * gridDim.z;
    unsigned sum, cnt, mine, sp = 0u;
    for (;;) {
        sum = 0u; cnt = 0u; mine = 0u;
#pragma unroll
        for (unsigned j = 0; j < 16; ++j) { const unsigned c = xb_ld(&bar[XB_XCNT(j)]); sum += c; cnt += (c > 0u) ? 1u : 0u; mine = (j == x) ? c : mine; }
        if (sum == G) break;
        __builtin_amdgcn_s_sleep(1);
        if ((++sp & 255u) == 0u) { if (xb_ld(&bar[XB_TMO])) break; if (sp > XB_SPIN_CAP) { atomicAdd(&bar[XB_TMO], 1u); break; } }
    }
    nloc = mine > 0u ? mine : 1u; nx = cnt > 0u ? cnt : 1u;
}
__device__ __forceinline__ void xcd_barrier(const XcdBarrier& b) {
    asm volatile("s_waitcnt vmcnt(0)" ::: "memory");
    __syncthreads();
    if (threadIdx.x == 0) {
        unsigned* bar = b.bar;
        __builtin_amdgcn_s_waitcnt(0);
        unsigned nloc = b.st[0], nx = b.st[1];
        if (nloc == 0u) { xcd_barrier_complete(bar, b.x, nloc, nx); b.st[0] = nloc; b.st[1] = nx; }
        const unsigned old = xb_add(&bar[XB_XSUB(b.x)], 1u);
        const unsigned gen = old / nloc;
        if (old + 1u == (gen + 1u) * nloc) {
            __builtin_amdgcn_fence(__ATOMIC_RELEASE, "agent");
            asm volatile("s_waitcnt vmcnt(0)" ::: "memory");
            const unsigned og = xb_add(&bar[XB_TOP], 1u);
            const unsigned tg = og / nx;
            if (og + 1u == (tg + 1u) * nx) xb_add(&bar[XB_TOPGEN], 1u);
            else XB_SPIN(xb_ld(&bar[XB_TOPGEN]) == tg, bar);
            __builtin_amdgcn_fence(__ATOMIC_ACQUIRE, "agent");
            xb_add(&bar[XB_XGEN(b.x)], 1u);
            asm volatile("s_waitcnt vmcnt(0)" ::: "memory");
        } else {
            XB_SPIN(xb_ld(&bar[XB_XGEN(b.x)]) == gen, bar);
            __builtin_amdgcn_fence(__ATOMIC_ACQUIRE, "agent");
            asm volatile("s_waitcnt vmcnt(0)" ::: "memory");
        }
    }
    __syncthreads();
}

struct Args { const float* in[23]; float* out; unsigned char* ws; int ph_lo, ph_hi; };

#define DPP_ADD(v, ctrl, rmask, bc) v += __builtin_bit_cast(float, __builtin_amdgcn_update_dpp(0, __builtin_bit_cast(int, v), ctrl, rmask, 0xF, bc))
__device__ __forceinline__ float sum16(float v) {
    DPP_ADD(v, 0xB1, 0xF, true); DPP_ADD(v, 0x4E, 0xF, true); DPP_ADD(v, 0x141, 0xF, true); DPP_ADD(v, 0x140, 0xF, true); return v; }
__device__ __forceinline__ float wave_sum(float v) {
    v = sum16(v); DPP_ADD(v, 0x142, 0xA, false); DPP_ADD(v, 0x143, 0xC, false);
    return __builtin_bit_cast(float, __builtin_amdgcn_readlane(__builtin_bit_cast(int, v), 63)); }
__device__ __forceinline__ float rsqf(float x) { return __builtin_amdgcn_rsqf(x); }
__device__ __forceinline__ int compact_row(int r) {
    if (r >= MR) return -1;
    if (r >= RP) return r - RP + BP * SEQ;
    const int b = r / TP, t = r - b * TP;
    return t < NMETA ? -1 : r - NMETA * (b + 1);
}

__device__ __forceinline__ void p0_transpose_item(const float* W, int Nsrc, int K, bf16* WT, int dst_row0, int src_col0, int nvalid, int k0, int lane) {
    const float* src = W + (size_t)k0 * Nsrc + src_col0 + (lane < nvalid ? lane : 0);
    float v[32];
#pragma unroll
    for (int j = 0; j < 32; ++j) v[j] = src[(size_t)j * Nsrc];
    if (lane >= nvalid) {
#pragma unroll
        for (int j = 0; j < 32; ++j) v[j] = 0.f; }
    GAS v4u* dst = (GAS v4u*)(WT + (size_t)(dst_row0 + lane) * K + k0);
#pragma unroll
    for (int q = 0; q < 4; ++q) { v4u o; o.x = cvtpk(v[8 * q], v[8 * q + 1]); o.y = cvtpk(v[8 * q + 2], v[8 * q + 3]); o.z = cvtpk(v[8 * q + 4], v[8 * q + 5]); o.w = cvtpk(v[8 * q + 6], v[8 * q + 7]); dst[q] = o; }
}
__device__ __forceinline__ void win_src(int nb, int& src, int& nvalid) {
    const int pn = nb >> 2, o = (nb & 3) * 64; nvalid = 64;
    if (pn < 8) src = (o < 128) ? 128 * pn + o : 1024 + 128 * pn + (o - 128);
    else if (pn < 20) src = 2048 + 256 * (pn - 8) + o;
    else if (pn < 24) src = 5120 + 256 * (pn - 20) + o;
    else if (pn < 28) src = 6160 + 256 * (pn - 24) + o;
    else if (pn < 32) src = 7184 + 256 * (pn - 28) + o;
    else { src = 6144; nvalid = (o == 0) ? 16 : 0; }
}
__device__ __forceinline__ void rms_row_to_bf16(const float* xrow, const float* gain, bf16* orow, int lane) {
    const GAS f32x4* xr = (const GAS f32x4*)xrow + lane; const GAS f32x4* gr = (const GAS f32x4*)gain + lane;
    f32x4 v[4]; float s = 0.f;
#pragma unroll
    for (int j = 0; j < 4; ++j) { v[j] = xr[64 * j]; s += (v[j].x * v[j].x + v[j].y * v[j].y) + (v[j].z * v[j].z + v[j].w * v[j].w); }
    const float rstd = 1.f / sqrtf(wave_sum(s) * (1.f / DM) + EPS);
    GAS unsigned long long* o8 = (GAS unsigned long long*)orow + lane;
#pragma unroll
    for (int j = 0; j < 4; ++j) { const f32x4 g = gr[64 * j]; o8[64 * j] = (unsigned long long)cvtpk(v[j].x * rstd * g.x, v[j].y * rstd * g.y) | ((unsigned long long)cvtpk(v[j].z * rstd * g.z, v[j].w * rstd * g.w) << 32); }
}

typedef pg8::f32x4 A4;
struct EpiIn {
    static constexpr bool PERM = true;
    bf16 *GLU, *QKVB, *QS, *HALOQ, *HALOC, *ZS, *SGC, *SGD; float* BETAG; const float *a_log, *dt_bias;
    __device__ __forceinline__ void operator()(const A4 (&acc)[2][2][4][2], const pg8::Unit& u, int wr, int wc, int fr, int fq) const {
#if defined(PROBE_EPI2)
        for (int rep = 0; rep < 2; ++rep) { asm volatile("" ::: "memory"); body(acc, u, wr, wc, fr, fq); }
#else
        body(acc, u, wr, wc, fr, fq);
#endif
    }
    __device__ __forceinline__ void body(const A4 (&acc)[2][2][4][2], const pg8::Unit& u, int wr, int wc, int fr, int fq) const {
        const int pn = u.pn, row0 = u.pm * 256 + wr * 64 + fr, cw = 32 * wc + 8 * fq;
        if (pn < 8) {
#pragma unroll
            for (int ai = 0; ai < 2; ++ai)
#pragma unroll
                for (int m = 0; m < 4; ++m) { const int r = row0 + ai * 128 + m * 16; float o[8];
#pragma unroll
                    for (int n = 0; n < 2; ++n)
#pragma unroll
                        for (int j = 0; j < 4; ++j) o[4 * n + j] = acc[ai][0][m][n][j] * sigmoidf_(acc[ai][1][m][n][j]);
                    v4u w; w.x = cvtpk(o[0], o[1]); w.y = cvtpk(o[2], o[3]); w.z = cvtpk(o[4], o[5]); w.w = cvtpk(o[6], o[7]);
                    *(GAS v4u*)(GLU + (size_t)r * DM + 128 * pn + cw) = w;
                    if (r < RP) { const int b = r / TP, t = r - b * TP, run = t / RUNL, pos = t - run * RUNL;
                        if (pos >= RUNL - 30 && run < NRUN - 1) *(GAS v4u*)(HALOC + ((size_t)(b * NRUN + run) * 30 + (pos - (RUNL - 30))) * DM + 128 * pn + cw) = w; } }
        } else if (pn < 20) {
            const int colb = 256 * (pn - 8);
#pragma unroll
            for (int ai = 0; ai < 2; ++ai)
#pragma unroll
                for (int m = 0; m < 4; ++m) { const int r = row0 + ai * 128 + m * 16; if (r >= MR) continue;
#pragma unroll
                    for (int bj = 0; bj < 2; ++bj) { const int col = colb + 128 * bj + cw;
                        const A4 a0 = acc[ai][bj][m][0], a1 = acc[ai][bj][m][1];
                        v4u w; w.x = cvtpk(a0[0], a0[1]); w.y = cvtpk(a0[2], a0[3]); w.z = cvtpk(a1[0], a1[1]); w.w = cvtpk(a1[2], a1[3]);
                        if (r >= RP) *(GAS v4u*)(QS + (size_t)(r - RP) * DQKV + col) = w;
                        else { const int b = r / TP, t = r - b * TP, c = t >> 6, i = t & 63, which = col >> 10, h = (col >> 7) & 7, d = col & 127;
                            *(GAS v4u*)(QKVB + ((size_t)((b * NCH + c) * NH + h) * 3 + which) * 8192 + i * 128 + d) = w;
                            if (i >= 61) *(GAS v4u*)(HALOQ + ((size_t)(b * NCH + c) * 3 + (i - 61)) * DQKV + col) = w; } } }
        } else if (pn < 24) {
            constexpr bool isz = true; bf16* dst = ZS; const int ld = DM, cb = 256 * (pn - 20);
#pragma unroll
            for (int ai = 0; ai < 2; ++ai)
#pragma unroll
                for (int m = 0; m < 4; ++m) { const int r = row0 + ai * 128 + m * 16;
#pragma unroll
                    for (int bj = 0; bj < 2; ++bj) { float o[8];
#pragma unroll
                        for (int n = 0; n < 2; ++n)
#pragma unroll
                            for (int j = 0; j < 4; ++j) { const float v = acc[ai][bj][m][n][j]; o[4 * n + j] = isz ? siluf_(v) : v; }
                        v4u w; w.x = cvtpk(o[0], o[1]); w.y = cvtpk(o[2], o[3]); w.z = cvtpk(o[4], o[5]); w.w = cvtpk(o[6], o[7]);
                        *(GAS v4u*)(dst + (size_t)r * ld + cb + 128 * bj + cw) = w; } }
        } else if (pn < 32) {
            bf16* dst = pn < 28 ? SGC : SGD; const int cb = 256 * ((pn - 24) & 3);
#pragma unroll
            for (int ai = 0; ai < 2; ++ai)
#pragma unroll
                for (int m = 0; m < 4; ++m) { const int rc = compact_row(row0 + ai * 128 + m * 16); if (rc < 0) continue;
#pragma unroll
                    for (int bj = 0; bj < 2; ++bj) { float o[8];
#pragma unroll
                        for (int n = 0; n < 2; ++n)
#pragma unroll
                            for (int j = 0; j < 4; ++j) o[4 * n + j] = sigmoidf_(acc[ai][bj][m][n][j]);
                        v4u w; w.x = cvtpk(o[0], o[1]); w.y = cvtpk(o[2], o[3]); w.z = cvtpk(o[4], o[5]); w.w = cvtpk(o[6], o[7]);
                        *(GAS v4u*)(dst + (size_t)rc * DM + cb + 128 * bj + cw) = w; } }
        } else {
            if (wc == 0 && fq < 2) {
#pragma unroll
                for (int ai = 0; ai < 2; ++ai)
#pragma unroll
                    for (int m = 0; m < 4; ++m) { const int r = row0 + ai * 128 + m * 16; float o[8];
#pragma unroll
                        for (int n = 0; n < 2; ++n)
#pragma unroll
                            for (int j = 0; j < 4; ++j) { const int h = 4 * n + j; const float v = acc[ai][0][m][n][j];
                                if (fq == 0) o[h] = 1.f / (1.f + expf(-v));
                                else { const float xx = v + dt_bias[h]; const float sp = xx > 20.f ? xx : log1pf(expf(xx)); o[h] = -expf(a_log[h]) * sp; } }
                        GAS f32x4* p = (GAS f32x4*)(BETAG + (size_t)r * 16 + 8 * fq);
                        p[0] = (f32x4){o[0], o[1], o[2], o[3]}; p[1] = (f32x4){o[4], o[5], o[6], o[7]}; }
            }
        }
    }
};
template <int MODE> struct EpiGate {
    static constexpr bool PERM = true;
    bf16 *SG, *MA, *OUT;
    __device__ __forceinline__ void operator()(const A4 (&acc)[2][2][4][2], const pg8::Unit& u, int wr, int wc, int fr, int fq) const {
        const int row0 = u.pm * 256 + wr * 64 + fr, c0 = 256 * u.pn + 32 * wc + 8 * fq;
#pragma unroll
        for (int ai = 0; ai < 2; ++ai) {
            size_t off[4]; bool ok[4]; v4u g[4][2], q[4][2];
#pragma unroll
            for (int m = 0; m < 4; ++m) { const int rc = compact_row(row0 + ai * 128 + m * 16); ok[m] = rc >= 0; off[m] = (size_t)(ok[m] ? rc : 0) * DM + c0; }
#pragma unroll
            for (int m = 0; m < 4; ++m)
#pragma unroll
                for (int bj = 0; bj < 2; ++bj) { g[m][bj] = *(const GAS v4u*)(SG + off[m] + 128 * bj); if (MODE == 1) q[m][bj] = *(const GAS v4u*)(MA + off[m] + 128 * bj); }
#pragma unroll
            for (int m = 0; m < 4; ++m)
#pragma unroll
                for (int bj = 0; bj < 2; ++bj) { const v4u gg = g[m][bj]; float o[8];
                    const A4 a0 = acc[ai][bj][m][0], a1 = acc[ai][bj][m][1];
                    o[0] = bflo(gg.x) * a0[0]; o[1] = bfhi(gg.x) * a0[1]; o[2] = bflo(gg.y) * a0[2]; o[3] = bfhi(gg.y) * a0[3];
                    o[4] = bflo(gg.z) * a1[0]; o[5] = bfhi(gg.z) * a1[1]; o[6] = bflo(gg.w) * a1[2]; o[7] = bfhi(gg.w) * a1[3];
                    if (MODE == 1) { const v4u qq = q[m][bj];
                        o[0] += bflo(qq.x); o[1] += bfhi(qq.x); o[2] += bflo(qq.y); o[3] += bfhi(qq.y); o[4] += bflo(qq.z); o[5] += bfhi(qq.z); o[6] += bflo(qq.w); o[7] += bfhi(qq.w); }
                    v4u w; w.x = cvtpk(o[0], o[1]); w.y = cvtpk(o[2], o[3]); w.z = cvtpk(o[4], o[5]); w.w = cvtpk(o[6], o[7]);
                    if (ok[m]) *(GAS v4u*)(OUT + off[m] + 128 * bj) = w; }
        }
    }
};
template <int MODE> struct EpiRes {
    static constexpr bool PERM = false;
    const float *xp, *xs; float* out; float* parts; const bf16* X1B;
    __device__ __forceinline__ void operator()(const A4 (&acc)[2][2][4][2], const pg8::Unit& u, int wr, int wc, int fr, int fq) const {
        const int row0 = u.pm * 256 + wr * 64 + fr, c0 = 256 * u.pn + 32 * wc + 4 * fq;
        if (u.pm >= BP * SEQ / 256) {
            float* part = parts + (size_t)(u.k0 / u.nt) * RS * DM;
#pragma unroll
            for (int ai = 0; ai < 2; ++ai)
#pragma unroll
                for (int m = 0; m < 4; ++m) { float* orow = part + (size_t)(row0 + ai * 128 + m * 16 - BP * SEQ) * DM;
#pragma unroll
                    for (int bj = 0; bj < 2; ++bj)
#pragma unroll
                        for (int n = 0; n < 2; ++n) *(GAS f32x4*)(orow + c0 + 128 * bj + 16 * n) = acc[ai][bj][m][n]; }
            return; }
#pragma unroll
        for (int ai = 0; ai < 2; ++ai)
#pragma unroll
            for (int m = 0; m < 4; ++m) { const int r = row0 + ai * 128 + m * 16;
                float* orow = out + (size_t)r * DM;
                if (MODE == 0) { const float* base = r < BP * SEQ ? xp + (size_t)r * DM : xs + (size_t)(r - BP * SEQ) * DM;
#pragma unroll
                    for (int bj = 0; bj < 2; ++bj)
#pragma unroll
                        for (int n = 0; n < 2; ++n) { const int c = c0 + 128 * bj + 16 * n; const f32x4 b = *(const GAS f32x4*)(base + c); *(GAS f32x4*)(orow + c) = b + acc[ai][bj][m][n]; }
                } else {
                } }
        if (MODE == 1) {
#pragma unroll
            for (int ai = 0; ai < 2; ++ai) { v2u xb[4][2][2];
#pragma unroll
                for (int m = 0; m < 4; ++m)
#pragma unroll
                    for (int bj = 0; bj < 2; ++bj)
#pragma unroll
                        for (int n = 0; n < 2; ++n) xb[m][bj][n] = *(const GAS v2u*)(X1B + (size_t)(row0 + ai * 128 + m * 16) * DM + c0 + 128 * bj + 16 * n);
#pragma unroll
                for (int m = 0; m < 4; ++m)
#pragma unroll
                    for (int bj = 0; bj < 2; ++bj)
#pragma unroll
                        for (int n = 0; n < 2; ++n) { const v2u b = xb[m][bj][n]; const f32x4 x2 = (f32x4){bflo(b.x), bfhi(b.x), bflo(b.y), bfhi(b.y)} + acc[ai][bj][m][n];
                            v2u w; w.x = cvtpk(x2[0], x2[1]); w.y = cvtpk(x2[2], x2[3]);
                            *(GAS v2u*)((bf16*)X1B + (size_t)(row0 + ai * 128 + m * 16) * DM + c0 + 128 * bj + 16 * n) = w; } }
        }
    }
};
struct EpiWo {
    const float *xp; bf16* X1B; float* parts;
    __device__ __forceinline__ void operator()(const A4 (&acc)[2][2][4][2], const pg8::Unit& u, int wr, int wc, int fr, int fq) const {
        const int row0 = u.pm * 256 + wr * 64 + fr, c0 = 256 * u.pn + 32 * wc + 8 * fq;
        if (u.pm >= BP * SEQ / 256) {
            float* part = parts + (size_t)(u.k0 / u.nt) * RS * DM;
#pragma unroll
            for (int ai = 0; ai < 2; ++ai)
#pragma unroll
                for (int m = 0; m < 4; ++m) { float* orow = part + (size_t)(row0 + ai * 128 + m * 16 - BP * SEQ) * DM + c0;
#pragma unroll
                    for (int bj = 0; bj < 2; ++bj) { *(GAS f32x4*)(orow + 128 * bj) = acc[ai][bj][m][0]; *(GAS f32x4*)(orow + 128 * bj + 4) = acc[ai][bj][m][1]; } }
            return; }
#pragma unroll
        for (int ai = 0; ai < 2; ++ai) { f32x4 xv[4][2][2];
#pragma unroll
            for (int m = 0; m < 4; ++m)
#pragma unroll
                for (int bj = 0; bj < 2; ++bj) { const float* xrow = xp + (size_t)(row0 + ai * 128 + m * 16) * DM + c0 + 128 * bj; xv[m][bj][0] = *(const GAS f32x4*)xrow; xv[m][bj][1] = *(const GAS f32x4*)(xrow + 4); }
#pragma unroll
            for (int m = 0; m < 4; ++m)
#pragma unroll
                for (int bj = 0; bj < 2; ++bj) { const f32x4 x0 = xv[m][bj][0] + acc[ai][bj][m][0], x1 = xv[m][bj][1] + acc[ai][bj][m][1];
                    v4u w; w.x = cvtpk(x0[0], x0[1]); w.y = cvtpk(x0[2], x0[3]); w.z = cvtpk(x1[0], x1[1]); w.w = cvtpk(x1[2], x1[3]);
                    *(GAS v4u*)(X1B + (size_t)(row0 + ai * 128 + m * 16) * DM + c0 + 128 * bj) = w; } }
    }
};
struct EpiWoP : EpiWo { static constexpr bool PERM = true; };
struct EpiUp {
    static constexpr bool PERM = true;
    bf16* HM;
    __device__ __forceinline__ void operator()(const A4 (&acc)[2][2][4][2], const pg8::Unit& u, int wr, int wc, int fr, int fq) const {
        const int row0 = u.pm * 256 + wr * 64 + fr, c0 = 256 * u.pn + 32 * wc + 8 * fq;
#pragma unroll
        for (int ai = 0; ai < 2; ++ai)
#pragma unroll
            for (int m = 0; m < 4; ++m) { const int r = row0 + ai * 128 + m * 16;
#pragma unroll
                for (int bj = 0; bj < 2; ++bj) { float o[8];
#pragma unroll
                    for (int n = 0; n < 2; ++n)
#pragma unroll
                        for (int j = 0; j < 4; ++j) { const float v = fmaxf(acc[ai][bj][m][n][j], 0.f); o[4 * n + j] = v * v; }
                    v4u w; w.x = cvtpk(o[0], o[1]); w.y = cvtpk(o[2], o[3]); w.z = cvtpk(o[4], o[5]); w.w = cvtpk(o[6], o[7]);
                    *(GAS v4u*)(HM + (size_t)r * DFF + c0 + 128 * bj) = w; } }
    }
};

template <int KIND>
__device__ __forceinline__ void conv_unit(const Args& a, LAS unsigned char* lds, int b, int run) {
    asm volatile("" ::: "memory");
    const int tid = threadIdx.x, lane = tid & 63, wave = tid >> 6; int ch = 2 * tid; asm volatile("" : "+v"(ch));
    unsigned char* ws = a.ws;
    bf16* GC = (bf16*)(ws + WS_GLU); const bf16* HALOC = (const bf16*)(ws + WS_HALOC);
    const float* w_dw = a.in[8];
    LAS float* red = (LAS float*)lds;
    constexpr int NTOK = KIND == 0 ? RUNL : TS, NSTEP = (NTOK + 3) / 4, REM = NTOK - 4 * (NSTEP - 1);
    f32x2 w[KC]; unsigned E[KC + 3];
#pragma unroll
    for (int i = 0; i < KC; ++i) w[i] = *(const GAS f32x2*)(w_dw + (size_t)i * DM + ch);
    const f32x2 bdw = *(const GAS f32x2*)(a.in[9] + ch), lng = *(const GAS f32x2*)(a.in[10] + ch), lnb = *(const GAS f32x2*)(a.in[11] + ch);
    const int row0 = KIND == 0 ? b * TP + run * RUNL : RP + b * TS;
    if (KIND == 0) {
#pragma unroll
        for (int i = 0; i < KC - 1; ++i) { unsigned v = *(const GAS unsigned*)(HALOC + ((size_t)(b * NRUN + (run > 0 ? run - 1 : 0)) * 30 + i) * DM + ch); E[i] = run > 0 ? v : 0u; }
    } else { const float* st = a.in[2] + (size_t)b * (KC - 1) * DM;
#pragma unroll
        for (int i = 0; i < KC - 1; ++i) { const f32x2 v = *(const GAS f32x2*)(st + (size_t)i * DM + ch); E[i] = cvtpk(v.x, v.y); }
    }
    unsigned nx[4];
#pragma unroll
    for (int k = 0; k < 4; ++k) nx[k] = *(const GAS unsigned*)(GC + (size_t)(row0 + (k < NTOK ? k : NTOK - 1)) * DM + ch);
    for (int st4 = 0; st4 < NSTEP; ++st4) {
        const int t0 = 4 * st4;
#pragma unroll
        for (int k = 0; k < 4; ++k) E[KC - 1 + k] = nx[k];
        if (st4 + 1 < NSTEP) {
#pragma unroll
            for (int k = 0; k < 4; ++k) { const int t = t0 + 4 + k; nx[k] = *(const GAS unsigned*)(GC + (size_t)(row0 + (t < NTOK ? t : NTOK - 1)) * DM + ch); }
        }
        f32x2 y[4] = {bdw, bdw, bdw, bdw};
#pragma unroll
        for (int j = 0; j < KC + 3; ++j) { const f32x2 e = {bflo(E[j]), bfhi(E[j])};
#pragma unroll
            for (int k = 0; k < 4; ++k) { const int i = j - k; if (i >= 0 && i < KC) y[k] += w[i] * e; } }
        float sv[8];
#pragma unroll
        for (int k = 0; k < 4; ++k) { sv[2 * k] = wave_sum(y[k].x + y[k].y); sv[2 * k + 1] = wave_sum(y[k].x * y[k].x + y[k].y * y[k].y); }
        LAS float* rb = red + (st4 & 1) * 64;
        if (lane == 0) { *(LAS f32x4*)(rb + wave * 8) = (f32x4){sv[0], sv[1], sv[2], sv[3]}; *(LAS f32x4*)(rb + wave * 8 + 4) = (f32x4){sv[4], sv[5], sv[6], sv[7]}; }
        __syncthreads();
        f32x4 ta = {0.f, 0.f, 0.f, 0.f}, tb = {0.f, 0.f, 0.f, 0.f};
#pragma unroll
        for (int i = 0; i < 8; ++i) { ta += *(const LAS f32x4*)(rb + i * 8); tb += *(const LAS f32x4*)(rb + i * 8 + 4); }
        const float tt[8] = {ta.x, ta.y, ta.z, ta.w, tb.x, tb.y, tb.z, tb.w};
#pragma unroll
        for (int k = 0; k < 4; ++k) { if (t0 + k < NTOK) {
            const float mu = tt[2 * k] * (1.f / DM), var = fmaxf(tt[2 * k + 1] * (1.f / DM) - mu * mu, 0.f), rstd = rsqf(var + EPS);
            const float z0 = (y[k].x - mu) * rstd * lng.x + lnb.x, z1 = (y[k].y - mu) * rstd * lng.y + lnb.y;
            *(GAS unsigned*)(GC + (size_t)(row0 + t0 + k) * DM + ch) = cvtpk(siluf_(z0), siluf_(z1)); } }
        if (st4 + 1 < NSTEP) {
#pragma unroll
            for (int i = 0; i < KC - 1; ++i) E[i] = E[i + 4];
        }
    }
    if (KIND == 1 || run == NRUN - 1) { float* o = a.out + (KIND == 0 ? O_PC : O_SC) + (size_t)b * (KC - 1) * DM;
        if (KIND == 0) {
#pragma unroll
            for (int i = 0; i < KC - 1; ++i) *(GAS f32x2*)(o + (size_t)i * DM + ch) = (f32x2){bflo(E[REM + i]), bfhi(E[REM + i])};
        } else {
            const float* st = a.in[2] + (size_t)b * (KC - 1) * DM;
#pragma unroll
            for (int i = 0; i < KC - 1 - TS; ++i) *(GAS f32x2*)(o + (size_t)i * DM + ch) = *(const GAS f32x2*)(st + (size_t)(i + TS) * DM + ch);
#pragma unroll
            for (int i = KC - 1 - TS; i < KC - 1; ++i) *(GAS f32x2*)(o + (size_t)i * DM + ch) = (f32x2){bflo(E[REM + i]), bfhi(E[REM + i])};
        }
    }
    __syncthreads();
}

__device__ __forceinline__ void delta_item(const Args& a, LAS unsigned char* lds, int item) {
    asm volatile("" ::: "memory");
    const int tid = threadIdx.x, lane = tid & 63, sub = tid >> 7, wu = (tid >> 6) & 1; int j = tid & 127; asm volatile("" : "+v"(j));
    const int unit = item * 4 + sub, b = unit >> 3, h = unit & 7;
    const int row0 = RP + b * TS;
    const bf16* QS = (const bf16*)(a.ws + WS_QS); bf16* ZS = (bf16*)(a.ws + WS_ZS); const float* BETAG = (const float*)(a.ws + WS_BETAG);
    LAS float* kq = (LAS float*)lds + sub * 256;
    LAS float* red = (LAS float*)lds + 1024 + sub * 4;
    LAS float* red2 = (LAS float*)lds + 1024 + 16 + sub * 2;
    float S[DH];
    { const float* s0 = a.in[4] + ((size_t)(b * NH + h) * DH) * DH + j;
#pragma unroll
        for (int d = 0; d < DH; ++d) S[d] = s0[(size_t)d * DH]; }
    const int cq = h * DH + j, ck = DM + cq, cv = 2 * DM + cq;
    float wq[KS], wk[KS], wv[KS];
#pragma unroll
    for (int i = 0; i < KS; ++i) { wq[i] = a.in[13][i * DQKV + cq]; wk[i] = a.in[13][i * DQKV + ck]; wv[i] = a.in[13][i * DQKV + cv]; }
    float hq[3], hk[3], hv[3];
#pragma unroll
    for (int i = 0; i < 3; ++i) { const float* st = a.in[3] + ((size_t)b * 3 + i) * DQKV; hq[i] = st[cq]; hk[i] = st[ck]; hv[i] = st[cv]; }
    const float gh = a.in[16][j];
    float pq[TS], pk[TS], pv[TS], pbe[TS], pgg[TS], pzs[TS];
#pragma unroll
    for (int t = 0; t < TS; ++t) { const bf16* p = QS + (size_t)(b * TS + t) * DQKV; pq[t] = bf1(p[cq]); pk[t] = bf1(p[ck]); pv[t] = bf1(p[cv]);
        pbe[t] = BETAG[(size_t)(row0 + t) * 16 + h]; pgg[t] = BETAG[(size_t)(row0 + t) * 16 + 8 + h]; pzs[t] = bf1(ZS[(size_t)(row0 + t) * DM + cq]); }
#pragma unroll
    for (int t = 0; t < TS; ++t) {
        const size_t row = (size_t)(row0 + t);
        const float qp = pq[t], kp = pk[t], vp = pv[t];
        const float qc = siluf_(wq[0] * hq[0] + wq[1] * hq[1] + wq[2] * hq[2] + wq[3] * qp);
        const float kc = siluf_(wk[0] * hk[0] + wk[1] * hk[1] + wk[2] * hk[2] + wk[3] * kp);
        const float vc = siluf_(wv[0] * hv[0] + wv[1] * hv[1] + wv[2] * hv[2] + wv[3] * vp);
        hq[0] = hq[1]; hq[1] = hq[2]; hq[2] = qp; hk[0] = hk[1]; hk[1] = hk[2]; hk[2] = kp; hv[0] = hv[1]; hv[1] = hv[2]; hv[2] = vp;
        const float sq = wave_sum(qc * qc), sk = wave_sum(kc * kc);
        kq[j] = kc; kq[128 + j] = qc;
        if (lane == 0) { red[wu * 2] = sq; red[wu * 2 + 1] = sk; }
        const float beta = pbe[t], gg = pgg[t], zs = pzs[t];
        __syncthreads();
        const float nq = rsqf(red[0] + red[2] + 1e-6f) * 0.08838834764831845f, nk = rsqf(red[1] + red[3] + 1e-6f);
        const float alpha = __expf(gg);
        float ks0 = 0.f, ks1 = 0.f, ks2 = 0.f, ks3 = 0.f;
#pragma unroll
        for (int d = 0; d < DH; d += 4) { const f32x4 kk = *(const LAS f32x4*)(kq + d); ks0 += kk.x * S[d]; ks1 += kk.y * S[d + 1]; ks2 += kk.z * S[d + 2]; ks3 += kk.w * S[d + 3];
            if ((d & 31) == 28) asm volatile("" ::: "memory"); }
        const float kS = (ks0 + ks1) + (ks2 + ks3);
        const float u = beta * (vc - alpha * nk * kS), un = nk * u;
        float o0 = 0.f, o1 = 0.f, o2 = 0.f, o3 = 0.f;
#pragma unroll
        for (int d = 0; d < DH; d += 4) { const f32x4 kk = *(const LAS f32x4*)(kq + d); const f32x4 qq = *(const LAS f32x4*)(kq + 128 + d);
            S[d] = alpha * S[d] + kk.x * un; S[d + 1] = alpha * S[d + 1] + kk.y * un; S[d + 2] = alpha * S[d + 2] + kk.z * un; S[d + 3] = alpha * S[d + 3] + kk.w * un;
            o0 += qq.x * S[d]; o1 += qq.y * S[d + 1]; o2 += qq.z * S[d + 2]; o3 += qq.w * S[d + 3];
            if ((d & 15) == 12) asm volatile("" ::: "memory"); }
        const float o = ((o0 + o1) + (o2 + o3)) * nq;
        const float so = wave_sum(o * o);
        if (lane == 0) red2[wu] = so;
        __syncthreads();
        const float rms = rsqf((red2[0] + red2[1]) * (1.f / DH) + EPS);
        ZS[row * DM + cq] = (bf16)f2bf(o * rms * gh * zs);
    }
    { float* so = a.out + O_SD + ((size_t)(b * NH + h) * DH) * DH + j;
#pragma unroll
        for (int d = 0; d < DH; ++d) so[(size_t)d * DH] = S[d];
      float* qo = a.out + O_SQ + (size_t)b * 3 * DQKV;
#pragma unroll
        for (int i = 0; i < 3; ++i) { qo[i * DQKV + cq] = hq[i]; qo[i * DQKV + ck] = hk[i]; qo[i * DQKV + cv] = hv[i]; }
    }
    __syncthreads();
}

__host__ __device__ constexpr int perm_k(int x) { return (x & ~31) | (((x >> 2) & 3) << 3) | (((x >> 4) & 1) << 2) | (x & 3); }
typedef short bf16x8v __attribute__((ext_vector_type(8)));
__device__ __forceinline__ int ih_swz128(int row, int ch) { return (row >> 1) * 256 + (((8 * (row & 1) + ch) ^ ((row >> 1) & 7)) << 4); }
constexpr int IH_QH = 0, IH_KH = 17408, IH_VH = 34816, IH_GV = 52224, IH_TB = 54272, IH_TD = 63488, IH_BYTES = 68608;
__device__ __forceinline__ void intra_pair(const Args& a, LAS unsigned char* lds_all, int pair) {
    asm volatile("" ::: "memory");
    const int tid = threadIdx.x, half = tid >> 8; int tu = tid & 255; asm volatile("" : "+v"(tu));
    const int lane = tu & 63, wq = __builtin_amdgcn_readfirstlane(tu >> 6);
    const int uq = pair * 2 + half, h = uq & 7, bc = uq >> 3, b = bc / NCH, c = bc - b * NCH;
    const int nvalid = (c == NCH - 1) ? TP - 64 * (NCH - 1) : 64;
    LAS unsigned char* lds = lds_all + half * IH_BYTES;
    LAS bf16* QH = (LAS bf16*)(lds + IH_QH); LAS bf16* KH = (LAS bf16*)(lds + IH_KH); LAS bf16* VH = (LAS bf16*)(lds + IH_VH);
    LAS float* MF = (LAS float*)(lds + IH_KH); LAS bf16* ATL = (LAS bf16*)(lds + IH_VH); LAS float* GV = (LAS float*)(lds + IH_GV);
    unsigned char* ws = a.ws;
    bf16* blk = (bf16*)(ws + WS_QKVB) + (size_t)uq * QBLK; const bf16* HALOQ = (const bf16*)(ws + WS_HALOQ); const float* BETAG = (const float*)(ws + WS_BETAG);
    bf16* KDT = (bf16*)(ws + WS_KDT) + (size_t)uq * 8192; bf16* ATT = (bf16*)(ws + WS_ATTN) + (size_t)uq * 4096; float* LASTV = (float*)(ws + WS_LASTV);
    if (tu < 64) { const int i = tu; float g = 0.f, be = 0.f; { const float* p = BETAG + (size_t)(b * TP + 64 * c + (i < nvalid ? i : 0)) * 16; be = p[h]; g = p[8 + h]; } if (i >= nvalid) { g = 0.f; be = 0.f; }
        float G = g;
#pragma unroll
        for (int o = 1; o < 64; o <<= 1) { const float t = __shfl_up(G, o); if (lane >= o) G += t; }
        const float GL = __shfl(G, 63);
        GV[i] = G; GV[64 + i] = be; GV[128 + i] = expf(G); GV[192 + i] = expf(GL - G);
        if (i == 63) LASTV[uq] = expf(GL); }
    {   const int cp = tu & 15, rg = tu >> 4;
        const bool fullc = (c > 0) && (nvalid == 64);
        v4u raw[2][7];
#define IH_LOAD_ROWS(wh_, slot_) do { _Pragma("unroll") for (int k = 0; k < 7; ++k) { const int rr = 4 * rg - 3 + k; \
                const bf16* p = (rr >= 0) ? blk + (wh_) * 8192 + rr * 128 + 8 * cp : HALOQ + ((size_t)(b * NCH + (c > 0 ? c - 1 : 0)) * 3 + (3 + rr)) * DQKV + (wh_) * DM + h * DH + 8 * cp; \
                raw[slot_][k] = *(const GAS v4u*)p; } } while (0)
        IH_LOAD_ROWS(0, 0); IH_LOAD_ROWS(1, 1);
#pragma unroll
        for (int wh = 0; wh < 3; ++wh) {
            const int col = wh * DM + h * DH + 8 * cp;
            f32x4 wl[4], wh4[4];
#pragma unroll
            for (int i = 0; i < 4; ++i) { wl[i] = *(const GAS f32x4*)(a.in[13] + i * DQKV + col); wh4[i] = *(const GAS f32x4*)(a.in[13] + i * DQKV + col + 4); }
            float xr[7][8];
#pragma unroll
            for (int k = 0; k < 7; ++k) { const int rr = 4 * rg - 3 + k; const bool ok = fullc || ((rr >= 0) ? (rr < nvalid) : (c > 0)); const v4u v = raw[wh & 1][k];
                xr[k][0] = ok ? bflo(v.x) : 0.f; xr[k][1] = ok ? bfhi(v.x) : 0.f; xr[k][2] = ok ? bflo(v.y) : 0.f; xr[k][3] = ok ? bfhi(v.y) : 0.f;
                xr[k][4] = ok ? bflo(v.z) : 0.f; xr[k][5] = ok ? bfhi(v.z) : 0.f; xr[k][6] = ok ? bflo(v.w) : 0.f; xr[k][7] = ok ? bfhi(v.w) : 0.f; }
            if (wh == 0) IH_LOAD_ROWS(2, 0);
            if (c == NCH - 1 && rg == (nvalid - 1) / 4) {
                float* qo = a.out + O_PQ + (size_t)b * 3 * DQKV + col;
#pragma unroll
                for (int i = 0; i < 3; ++i) { *(GAS f32x4*)(qo + i * DQKV) = (f32x4){xr[4 + i][0], xr[4 + i][1], xr[4 + i][2], xr[4 + i][3]}; *(GAS f32x4*)(qo + i * DQKV + 4) = (f32x4){xr[4 + i][4], xr[4 + i][5], xr[4 + i][6], xr[4 + i][7]}; } }
            LAS bf16* tile = wh == 0 ? QH : (wh == 1 ? KH : VH);
#pragma unroll
            for (int r = 0; r < 4; ++r) { const bool ok = fullc || (4 * rg + r) < nvalid; float y[8];
#pragma unroll
                for (int e = 0; e < 8; ++e) { const float w0 = e < 4 ? wl[0][e & 3] : wh4[0][e & 3], w1 = e < 4 ? wl[1][e & 3] : wh4[1][e & 3], w2 = e < 4 ? wl[2][e & 3] : wh4[2][e & 3], w3 = e < 4 ? wl[3][e & 3] : wh4[3][e & 3];
                    const float t = w0 * xr[r][e] + w1 * xr[r + 1][e] + w2 * xr[r + 2][e] + w3 * xr[r + 3][e]; y[e] = ok ? siluf_(t) : 0.f; }
                v4u o; o.x = cvtpk(y[0], y[1]); o.y = cvtpk(y[2], y[3]); o.z = cvtpk(y[4], y[5]); o.w = cvtpk(y[6], y[7]);
                *(LAS v4u*)(tile + (4 * rg + r) * 136 + 8 * cp) = o; }
        }
    }
    __syncthreads();
    const int which = tu >> 7, d = tu & 127;
    float x[64];
    { const LAS bf16* colp = (which == 0 ? VH : KH) + d;
#pragma unroll
      for (int i = 0; i < 64; ++i) x[i] = bf1(colp[i * 136]); }
    const int fr = lane & 15, fq = lane >> 4;
    f32x4 kk[4], qk[4];
    {   bf16x8v ak[4], aq[4];
#pragma unroll
        for (int sI = 0; sI < 4; ++sI) { ak[sI] = *(const LAS bf16x8v*)(KH + (16 * wq + fr) * 136 + 32 * sI + 8 * fq); aq[sI] = *(const LAS bf16x8v*)(QH + (16 * wq + fr) * 136 + 32 * sI + 8 * fq); }
        f32x4 kkd = {0.f, 0.f, 0.f, 0.f}, qqd = {0.f, 0.f, 0.f, 0.f};
#pragma unroll
        for (int sI = 0; sI < 4; ++sI) { kkd = __builtin_amdgcn_mfma_f32_16x16x32_bf16(ak[sI], ak[sI], kkd, 0, 0, 0); qqd = __builtin_amdgcn_mfma_f32_16x16x32_bf16(aq[sI], aq[sI], qqd, 0, 0, 0); }
#pragma unroll
        for (int nt = 0; nt < 4; ++nt) { kk[nt] = (f32x4){0.f, 0.f, 0.f, 0.f}; qk[nt] = (f32x4){0.f, 0.f, 0.f, 0.f};
            if (nt <= wq) {
#pragma unroll
                for (int sI = 0; sI < 4; ++sI) { const bf16x8v bk = *(const LAS bf16x8v*)(KH + (16 * nt + fr) * 136 + 32 * sI + 8 * fq);
                    kk[nt] = __builtin_amdgcn_mfma_f32_16x16x32_bf16(ak[sI], bk, kk[nt], 0, 0, 0); qk[nt] = __builtin_amdgcn_mfma_f32_16x16x32_bf16(aq[sI], bk, qk[nt], 0, 0, 0); } } }
#pragma unroll
        for (int r = 0; r < 4; ++r) if (fr == 4 * fq + r) { GV[320 + 16 * wq + fr] = rsqf(kkd[r] + 1e-6f); GV[256 + 16 * wq + fr] = rsqf(qqd[r] + 1e-6f) * 0.08838834764831845f; }
    }
    __syncthreads();
    {
        const f32x4 Gi4 = *(const LAS f32x4*)(GV + 16 * wq + 4 * fq), Be4 = *(const LAS f32x4*)(GV + 64 + 16 * wq + 4 * fq), Nk4 = *(const LAS f32x4*)(GV + 320 + 16 * wq + 4 * fq), Nq4 = *(const LAS f32x4*)(GV + 256 + 16 * wq + 4 * fq);
        float Gjv[4], nkjv[4];
#pragma unroll
        for (int nt = 0; nt < 4; ++nt) { Gjv[nt] = GV[16 * nt + fr]; nkjv[nt] = GV[320 + 16 * nt + fr]; }
#pragma unroll
        for (int nt = 0; nt < 4; ++nt) { const int j = 16 * nt + fr;
            if (nt <= wq) { const float Gj = Gjv[nt], nkj = nkjv[nt];
#pragma unroll
                for (int r = 0; r < 4; ++r) { const int i = 16 * wq + 4 * fq + r; const float dec = (i >= j) ? __expf(Gi4[r] - Gj) : 0.f;
                    MF[i * 68 + j] = (i > j) ? Be4[r] * Nk4[r] * nkj * kk[nt][r] * dec : 0.f;
                    ATL[i * 72 + j] = (bf16)f2bf(Nq4[r] * nkj * qk[nt][r] * dec); }
            } else {
#pragma unroll
                for (int r = 0; r < 4; ++r) ATL[(16 * wq + 4 * fq + r) * 72 + j] = (bf16)0; }
        }
#pragma unroll
        for (int k = 0; k < 4; ++k) { const int pc = tu + 256 * k, i = pc >> 4, p16 = pc & 15, c0 = 32 * (p16 >> 2) + 4 * (p16 & 3);
            const v2u lo = *(const LAS v2u*)(QH + i * 136 + c0), hi = *(const LAS v2u*)(QH + i * 136 + c0 + 16); const float f = GV[256 + i] * GV[128 + i];
            v4u o; o.x = cvtpk(bflo(lo.x) * f, bfhi(lo.x) * f); o.y = cvtpk(bflo(lo.y) * f, bfhi(lo.y) * f); o.z = cvtpk(bflo(hi.x) * f, bfhi(hi.x) * f); o.w = cvtpk(bflo(hi.y) * f, bfhi(hi.y) * f);
            *(GAS v4u*)(blk + i * 128 + 8 * p16) = o; if (k & 1) asm volatile("" ::: "memory"); }
        if (which == 0) {
#pragma unroll
            for (int i = 0; i < 64; i += 4) { const f32x4 be = *(const LAS f32x4*)(GV + 64 + i); x[i] *= be.x; x[i + 1] *= be.y; x[i + 2] *= be.z; x[i + 3] *= be.w; }
        } else {
            bf16* kd = KDT + d * 64;
#pragma unroll
            for (int i = 0; i < 64; i += 4) { const f32x4 nk = *(const LAS f32x4*)(GV + 320 + i); x[i] *= nk.x; x[i + 1] *= nk.y; x[i + 2] *= nk.z; x[i + 3] *= nk.w; }
#pragma unroll
            for (int g8 = 0; g8 < 8; ++g8) { const int i0 = 32 * (g8 >> 2) + 4 * (g8 & 3);
                const f32x4 e0 = *(const LAS f32x4*)(GV + 192 + i0), e1 = *(const LAS f32x4*)(GV + 192 + i0 + 16);
                v4u w; w.x = cvtpk(x[i0] * e0.x, x[i0 + 1] * e0.y); w.y = cvtpk(x[i0 + 2] * e0.z, x[i0 + 3] * e0.w); w.z = cvtpk(x[i0 + 16] * e1.x, x[i0 + 17] * e1.y); w.w = cvtpk(x[i0 + 18] * e1.z, x[i0 + 19] * e1.w);
                *(GAS v4u*)(kd + 8 * g8) = w; if (g8 & 1) asm volatile("" ::: "memory"); }
#pragma unroll
            for (int i = 0; i < 64; i += 4) { const f32x4 be = *(const LAS f32x4*)(GV + 64 + i), eg = *(const LAS f32x4*)(GV + 128 + i);
                x[i] *= be.x * eg.x; x[i + 1] *= be.y * eg.y; x[i + 2] *= be.z * eg.z; x[i + 3] *= be.w * eg.w; }
        }
    }
    __syncthreads();
    LAS unsigned char* RT = lds + IH_QH; LAS bf16* TB = (LAS bf16*)(lds + IH_TB); LAS float* TD = (LAS float*)(lds + IH_TD);
    if (which == 0) {
#pragma unroll
        for (int c8 = 0; c8 < 8; ++c8) { v4u w; w.x = cvtpk(x[8 * c8], x[8 * c8 + 1]); w.y = cvtpk(x[8 * c8 + 2], x[8 * c8 + 3]); w.z = cvtpk(x[8 * c8 + 4], x[8 * c8 + 5]); w.w = cvtpk(x[8 * c8 + 6], x[8 * c8 + 7]);
            *(LAS v4u*)(RT + ih_swz128(d, c8)) = w; } }
    float tdg[16];
    {   const LAS float* mrow = MF + (16 * wq) * 68 + 16 * wq;
#pragma unroll
        for (int i = 0; i < 16; ++i) { float acc = (i == fr) ? 1.f : 0.f;
#pragma unroll
            for (int g = 0; g < (i + 3) / 4; ++g) { const f32x4 mm = *(const LAS f32x4*)(mrow + i * 68 + 4 * g);
                acc -= mm.x * tdg[4 * g]; if (4 * g + 1 < i) acc -= mm.y * tdg[4 * g + 1]; if (4 * g + 2 < i) acc -= mm.z * tdg[4 * g + 2]; if (4 * g + 3 < i) acc -= mm.w * tdg[4 * g + 3]; }
            tdg[i] = acc; }
        if (fq == 0) {
#pragma unroll
            for (int i = 0; i < 16; ++i) { TD[(wq * 16 + i) * 20 + fr] = tdg[i]; TB[(16 * wq + i) * 72 + 16 * wq + fr] = (bf16)f2bf(tdg[i]); } }
        for (int r = fq; r < 16 * wq; r += 4) TB[r * 72 + 16 * wq + fr] = (bf16)0;
    }
    __syncthreads();
    {   f32x4 Tc[4];
#pragma unroll
        for (int l = 0; l < 4; ++l) Tc[l] = (f32x4){0.f, 0.f, 0.f, 0.f};
#pragma unroll
        for (int r = 0; r < 4; ++r) { const float v = fq == 0 ? tdg[r] : (fq == 1 ? tdg[4 + r] : (fq == 2 ? tdg[8 + r] : tdg[12 + r]));
#pragma unroll
            for (int l = 0; l < 4; ++l) if (l == wq) Tc[l][r] = v; }
#pragma unroll
        for (int k = 1; k < 4; ++k) { if (k <= wq) continue;
            f32x4 acc = {0.f, 0.f, 0.f, 0.f};
#pragma unroll
            for (int l = 0; l < k; ++l) { if (l < wq) continue;
                const f32x4 a4 = *(const LAS f32x4*)(MF + (16 * k + fr) * 68 + 16 * l + 4 * fq);
#pragma unroll
                for (int ks = 0; ks < 4; ++ks) acc = __builtin_amdgcn_mfma_f32_16x16x4f32(a4[ks], Tc[l][ks], acc, 0, 0, 0); }
            const f32x4 d4 = *(const LAS f32x4*)(TD + (k * 16 + fr) * 20 + 4 * fq);
            f32x4 res = {0.f, 0.f, 0.f, 0.f};
#pragma unroll
            for (int ks = 0; ks < 4; ++ks) res = __builtin_amdgcn_mfma_f32_16x16x4f32(d4[ks], acc[ks], res, 0, 0, 0);
            Tc[k] = -res;
#pragma unroll
            for (int r = 0; r < 4; ++r) TB[(16 * k + 4 * fq + r) * 72 + 16 * wq + fr] = (bf16)f2bf(Tc[k][r]);
        }
    }
    __syncthreads();
    {
        f32x4 acc[4][2];
#pragma unroll
        for (int m = 0; m < 4; ++m) { acc[m][0] = (f32x4){0.f, 0.f, 0.f, 0.f}; acc[m][1] = (f32x4){0.f, 0.f, 0.f, 0.f}; }
#pragma unroll
        for (int s2 = 0; s2 < 2; ++s2) { bf16x8v af[4], bfm[2];
#pragma unroll
            for (int m = 0; m < 4; ++m) af[m] = *(const LAS bf16x8v*)(TB + (16 * m + fr) * 72 + 32 * s2 + 8 * fq);
#pragma unroll
            for (int t2 = 0; t2 < 2; ++t2) bfm[t2] = *(const LAS bf16x8v*)(RT + ih_swz128(16 * (2 * wq + t2) + fr, 4 * s2 + fq));
#pragma unroll
            for (int m = 0; m < 4; ++m)
#pragma unroll
                for (int t2 = 0; t2 < 2; ++t2) acc[m][t2] = __builtin_amdgcn_mfma_f32_16x16x32_bf16(af[m], bfm[t2], acc[m][t2], 0, 0, 0); }
#pragma unroll
        for (int m = 0; m < 4; ++m)
#pragma unroll
            for (int t2 = 0; t2 < 2; ++t2) { v2u w; w.x = cvtpk(acc[m][t2][0], acc[m][t2][1]); w.y = cvtpk(acc[m][t2][2], acc[m][t2][3]);
                *(GAS v2u*)(blk + 2 * 8192 + (2 * wq + t2) * 1024 + m * 256 + lane * 4) = w; }
    }
    __syncthreads();
    if (which == 1) {
#pragma unroll
        for (int c8 = 0; c8 < 8; ++c8) { v4u w; w.x = cvtpk(x[8 * c8], x[8 * c8 + 1]); w.y = cvtpk(x[8 * c8 + 2], x[8 * c8 + 3]); w.z = cvtpk(x[8 * c8 + 4], x[8 * c8 + 5]); w.w = cvtpk(x[8 * c8 + 6], x[8 * c8 + 7]);
            *(LAS v4u*)(RT + ih_swz128(d, c8)) = w; } }
    __syncthreads();
    {
        f32x4 acw[2][4];
#pragma unroll
        for (int nt = 0; nt < 4; ++nt) { acw[0][nt] = (f32x4){0.f, 0.f, 0.f, 0.f}; acw[1][nt] = (f32x4){0.f, 0.f, 0.f, 0.f}; }
#pragma unroll
        for (int s2 = 0; s2 < 2; ++s2) { bf16x8v af[2], bfm[4];
#pragma unroll
            for (int aa = 0; aa < 2; ++aa) af[aa] = *(const LAS bf16x8v*)(RT + ih_swz128(16 * (2 * wq + aa) + fr, 4 * s2 + fq));
#pragma unroll
            for (int nt = 0; nt < 4; ++nt) bfm[nt] = *(const LAS bf16x8v*)(TB + (16 * nt + fr) * 72 + 32 * s2 + 8 * fq);
#pragma unroll
            for (int aa = 0; aa < 2; ++aa)
#pragma unroll
                for (int nt = 0; nt < 4; ++nt) acw[aa][nt] = __builtin_amdgcn_mfma_f32_16x16x32_bf16(af[aa], bfm[nt], acw[aa][nt], 0, 0, 0); }
#pragma unroll
        for (int nt = 0; nt < 4; ++nt) { v4u w; w.x = cvtpk(acw[0][nt][0], acw[0][nt][1]); w.y = cvtpk(acw[0][nt][2], acw[0][nt][3]); w.z = cvtpk(acw[1][nt][0], acw[1][nt][1]); w.w = cvtpk(acw[1][nt][2], acw[1][nt][3]);
            *(GAS v4u*)(blk + 8192 + (16 * nt + fr) * 128 + 32 * wq + 8 * fq) = w; }
    }
#pragma unroll
    for (int k = 0; k < 2; ++k) { const int pc = tu + 256 * k, i = pc >> 3, p8 = pc & 7, c0 = 32 * (p8 >> 2) + 4 * (p8 & 3);
        const v2u lo = *(const LAS v2u*)(ATL + i * 72 + c0), hi = *(const LAS v2u*)(ATL + i * 72 + c0 + 16);
        *(GAS v4u*)(ATT + i * 64 + 8 * p8) = (v4u){lo.x, lo.y, hi.x, hi.y}; }
    __syncthreads();
}

constexpr int SC_W = 0, SC_QD = 16384, SC_KDT = 32768, SC_AT = 49152, SC_BUF = 57344, SC_RMS = 2 * SC_BUF, SC_ZT = SC_RMS + 4096, SC_END = SC_ZT + 2 * 16384;
__device__ __forceinline__ int swz256(int row, int chunk) { return row * 256 + ((chunk ^ (row & 15)) << 4); }
__device__ __forceinline__ int swz128(int row, int ch) { return (row >> 1) * 256 + (((8 * (row & 1) + ch) ^ ((row >> 1) & 7)) << 4); }
__device__ __forceinline__ void scan_chain(const Args& a, LAS unsigned char* lds, int chain) {
    const int tid = threadIdx.x, lane = tid & 63, wave = __builtin_amdgcn_readfirstlane(tid >> 6), fr = lane & 15, fq = lane >> 4;
    const int b = chain >> 3, h = chain & 7;
    unsigned char* ws = a.ws;
    const bf16* QKVB = (const bf16*)(ws + WS_QKVB); const bf16* KDTg = (const bf16*)(ws + WS_KDT); const bf16* ATTg = (const bf16*)(ws + WS_ATTN); const float* LASTV = (const float*)(ws + WS_LASTV);
    bf16* ZS = (bf16*)(ws + WS_ZS);
    LAS float* RMS = (LAS float*)(lds + SC_RMS);
    const float gh = a.in[16][16 * wave + fr];
    f32x4 Sacc[8];
#pragma unroll
    for (int mt = 0; mt < 8; ++mt) Sacc[mt] = (f32x4){0.f, 0.f, 0.f, 0.f};
    v4u ztn[2]; v2u u0n[4]; float lastn;
    auto chunk_dma = [&](int c) {
        const size_t uq = (size_t)(b * NCH + c) * NH + h; const bf16* blk = QKVB + uq * QBLK; LAS unsigned char* base = lds + (c & 1) * SC_BUF;
#pragma unroll
        for (int k = 0; k < 2; ++k) { const int P = (wave + 8 * k) * 64 + lane, row = P >> 4, ch = (P & 15) ^ (row & 15);
            __builtin_amdgcn_global_load_lds((const unsigned*)(blk + 8192 + row * 128 + 8 * ch), (LAS unsigned*)(base + SC_W + (wave + 8 * k) * 1024), 16, 0, 0);
            __builtin_amdgcn_global_load_lds((const unsigned*)(blk + row * 128 + 8 * ch), (LAS unsigned*)(base + SC_QD + (wave + 8 * k) * 1024), 16, 0, 0);
            const int line = P >> 4, t = (P & 15) ^ (line & 7), r2 = 2 * line + (t >> 3);
            __builtin_amdgcn_global_load_lds((const unsigned*)(KDTg + uq * 8192 + r2 * 64 + 8 * (t & 7)), (LAS unsigned*)(base + SC_KDT + (wave + 8 * k) * 1024), 16, 0, 0); }
        { const int P = wave * 64 + lane, line = P >> 4, t = (P & 15) ^ (line & 7), r2 = 2 * line + (t >> 3);
            __builtin_amdgcn_global_load_lds((const unsigned*)(ATTg + uq * 4096 + r2 * 64 + 8 * (t & 7)), (LAS unsigned*)(base + SC_AT + wave * 1024), 16, 0, 0); }
    };
    auto side_load = [&](int c) {
        const size_t uq = (size_t)(b * NCH + c) * NH + h;
#pragma unroll
        for (int k = 0; k < 2; ++k) { const int p = tid + 512 * k; ztn[k] = *(const GAS v4u*)(ZS + (size_t)(b * TP + 64 * c + (p >> 4)) * DM + h * DH + 8 * (p & 15)); }
        const bf16* u0 = QKVB + uq * QBLK + 2 * 8192 + wave * 1024 + lane * 4;
#pragma unroll
        for (int m = 0; m < 4; ++m) u0n[m] = *(const GAS v2u*)(u0 + m * 256);
        lastn = LASTV[uq];
    };
    auto side_store = [&](int buf) {
#pragma unroll
        for (int k = 0; k < 2; ++k) { const int p = tid + 512 * k; *(LAS v4u*)(lds + SC_ZT + buf * 16384 + swz256(p >> 4, p & 15)) = ztn[k]; }
    };
    chunk_dma(0); side_load(0); side_store(0);
    v2u u0p[4]; float last;
#pragma unroll
    for (int m = 0; m < 4; ++m) u0p[m] = u0n[m];
    last = lastn;
    chunk_dma(1); side_load(1);
    __syncthreads();
    for (int c = 0; c < NCH; ++c) {
        const int buf = c & 1; LAS unsigned char* base = lds + buf * SC_BUF; LAS unsigned char* zt = lds + SC_ZT + buf * 16384;
        const int nvalid = (c == NCH - 1) ? TP - 64 * (NCH - 1) : 64;
        bf16x8v F[2][8];
#define SC_LD_A(m, f) do { _Pragma("unroll") for (int sI = 0; sI < 4; ++sI) { const int off = swz256(16 * (m) + fr, 4 * sI + fq); \
            f[2 * sI] = *(const LAS bf16x8v*)(base + SC_W + off); f[2 * sI + 1] = *(const LAS bf16x8v*)(base + SC_QD + off); } } while (0)
#define SC_LD_D(f) do { _Pragma("unroll") for (int m = 0; m < 4; ++m) _Pragma("unroll") for (int s2 = 0; s2 < 2; ++s2) f[2 * m + s2] = *(const LAS bf16x8v*)(base + SC_AT + swz128(16 * m + fr, 4 * s2 + fq)); } while (0)
#define SC_LD_C(g, f) do { _Pragma("unroll") for (int mm = 0; mm < 4; ++mm) _Pragma("unroll") for (int s2 = 0; s2 < 2; ++s2) f[2 * mm + s2] = *(const LAS bf16x8v*)(base + SC_KDT + swz128(16 * (4 * (g) + mm) + fr, 4 * s2 + fq)); } while (0)
        SC_LD_A(0, F[0]);
        bf16x8v Sb[4];
#pragma unroll
        for (int sI = 0; sI < 4; ++sI) { v4u w; w.x = cvtpk(Sacc[2 * sI][0], Sacc[2 * sI][1]); w.y = cvtpk(Sacc[2 * sI][2], Sacc[2 * sI][3]); w.z = cvtpk(Sacc[2 * sI + 1][0], Sacc[2 * sI + 1][1]); w.w = cvtpk(Sacc[2 * sI + 1][2], Sacc[2 * sI + 1][3]);
            Sb[sI] = __builtin_bit_cast(bf16x8v, w); }
        f32x4 u[4], o[4];
#pragma unroll
        for (int m = 0; m < 4; ++m) {
            if (m == 0) SC_LD_A(1, F[1]); else if (m == 1) SC_LD_A(2, F[0]); else if (m == 2) SC_LD_A(3, F[1]); else SC_LD_D(F[0]);
            __builtin_amdgcn_sched_barrier(0);
            f32x4 p = {0.f, 0.f, 0.f, 0.f}, oo = {0.f, 0.f, 0.f, 0.f};
#pragma unroll
            for (int sI = 0; sI < 4; ++sI) { p = __builtin_amdgcn_mfma_f32_16x16x32_bf16(F[m & 1][2 * sI], Sb[sI], p, 0, 0, 0); oo = __builtin_amdgcn_mfma_f32_16x16x32_bf16(F[m & 1][2 * sI + 1], Sb[sI], oo, 0, 0, 0); }
            u[m] = (f32x4){bflo(u0p[m].x), bfhi(u0p[m].x), bflo(u0p[m].y), bfhi(u0p[m].y)} - p; o[m] = oo;
            __builtin_amdgcn_sched_barrier(0);
        }
        bf16x8v Ub[2];
#pragma unroll
        for (int s2 = 0; s2 < 2; ++s2) { v4u w; w.x = cvtpk(u[2 * s2][0], u[2 * s2][1]); w.y = cvtpk(u[2 * s2][2], u[2 * s2][3]); w.z = cvtpk(u[2 * s2 + 1][0], u[2 * s2 + 1][1]); w.w = cvtpk(u[2 * s2 + 1][2], u[2 * s2 + 1][3]);
            Ub[s2] = __builtin_bit_cast(bf16x8v, w); }
        SC_LD_C(0, F[1]);
        __builtin_amdgcn_sched_barrier(0);
#pragma unroll
        for (int m = 0; m < 4; ++m)
#pragma unroll
            for (int s2 = 0; s2 < 2; ++s2) o[m] = __builtin_amdgcn_mfma_f32_16x16x32_bf16(F[0][2 * m + s2], Ub[s2], o[m], 0, 0, 0);
        __builtin_amdgcn_sched_barrier(0);
        SC_LD_C(1, F[0]);
        __builtin_amdgcn_sched_barrier(0);
#pragma unroll
        for (int mt = 0; mt < 4; ++mt) { f32x4 sacc = Sacc[mt] * last;
#pragma unroll
            for (int s2 = 0; s2 < 2; ++s2) sacc = __builtin_amdgcn_mfma_f32_16x16x32_bf16(F[1][2 * mt + s2], Ub[s2], sacc, 0, 0, 0);
            Sacc[mt] = sacc; }
        __builtin_amdgcn_sched_barrier(0);
#pragma unroll
        for (int mt = 4; mt < 8; ++mt) { f32x4 sacc = Sacc[mt] * last;
#pragma unroll
            for (int s2 = 0; s2 < 2; ++s2) sacc = __builtin_amdgcn_mfma_f32_16x16x32_bf16(F[0][2 * (mt - 4) + s2], Ub[s2], sacc, 0, 0, 0);
            Sacc[mt] = sacc; }
#undef SC_LD_A
#undef SC_LD_D
#undef SC_LD_C
        LAS float* rm = RMS + (c & 1) * 512;
#pragma unroll
        for (int m = 0; m < 4; ++m)
#pragma unroll
            for (int r = 0; r < 4; ++r) { const float v = sum16(o[m][r] * o[m][r]); if (fr == 0) rm[(16 * m + 4 * fq + r) * 8 + wave] = v; }
        if (c + 1 < NCH) { side_store(buf ^ 1);
#pragma unroll
            for (int m = 0; m < 4; ++m) u0p[m] = u0n[m];
            last = lastn; }
        asm volatile("s_waitcnt vmcnt(0) lgkmcnt(0)" ::: "memory"); __builtin_amdgcn_s_barrier(); asm volatile("" ::: "memory");
        if (c + 2 < NCH) side_load(c + 2);
        {   LAS float* rsw = RMS + ((c + 1) & 1) * 512 + wave * 64;
            const f32x4 p0 = *(const LAS f32x4*)(rm + lane * 8), p1 = *(const LAS f32x4*)(rm + lane * 8 + 4);
            LAS bf16* zp[16]; bf16 zv[16];
#pragma unroll
            for (int m = 0; m < 4; ++m)
#pragma unroll
                for (int r = 0; r < 4; ++r) { zp[4 * m + r] = (LAS bf16*)(zt + swz256(16 * m + 4 * fq + r, 2 * wave + (fr >> 3))) + (fr & 7); zv[4 * m + r] = *zp[4 * m + r]; }
            rsw[lane] = rsqf((((p0.x + p0.y) + (p0.z + p0.w)) + ((p1.x + p1.y) + (p1.z + p1.w))) * (1.f / DH) + EPS);
            f32x4 rs[4];
#pragma unroll
            for (int m = 0; m < 4; ++m) rs[m] = *(const LAS f32x4*)(rsw + 16 * m + 4 * fq);
            __builtin_amdgcn_sched_barrier(0);
#pragma unroll
            for (int m = 0; m < 4; ++m)
#pragma unroll
                for (int r = 0; r < 4; ++r) *zp[4 * m + r] = (bf16)f2bf(o[m][r] * rs[m][r] * gh * bf1(zv[4 * m + r]));
        }
        asm volatile("s_waitcnt lgkmcnt(0)" ::: "memory"); __builtin_amdgcn_s_barrier(); asm volatile("" ::: "memory");
        if (c + 2 < NCH) chunk_dma(c + 2);
#pragma unroll
        for (int k = 0; k < 2; ++k) { const int p = tid + 512 * k, i = p >> 4;
            if (i < nvalid) *(GAS v4u*)(ZS + (size_t)(b * TP + 64 * c + i) * DM + h * DH + 8 * (p & 15)) = *(const LAS v4u*)(zt + swz256(i, p & 15)); }
    }
    { float* so = a.out + O_PD + ((size_t)(b * NH + h) * DH) * DH + 16 * wave + fr;
#pragma unroll
      for (int mt = 0; mt < 8; ++mt)
#pragma unroll
          for (int r = 0; r < 4; ++r) so[(size_t)(16 * mt + 4 * fq + r) * DH] = Sacc[mt][r]; }
    __syncthreads();
}

static_assert(SC_END <= LDSCTL_OFF && 2 * IH_BYTES <= LDSCTL_OFF && RING_BYTES <= LDSCTL_OFF, "LDS map");
constexpr int NPHASES = 10;
__global__ void __launch_bounds__(NWAVES * 64, 2) fwd_kernel(Args args) {
    extern __shared__ __attribute__((aligned(16))) unsigned char lds_raw[];
    LAS unsigned char* lds = (LAS unsigned char*)lds_raw;
    volatile LAS unsigned* MISC = (volatile LAS unsigned*)(lds + MISC_OFF);
    const int tid = threadIdx.x, lane = tid & 63, wave = __builtin_amdgcn_readfirstlane(tid >> 6);
    const int G = gridDim.x, bx = blockIdx.x;
    const int vcu = (G % 8 == 0) ? (bx % 8) * (G / 8) + bx / 8 : bx;
    unsigned char* ws = args.ws;
    gu32* ctl = (gu32*)(ws + WS_CTL);
    for (int u = tid; u < (LDS_BYTES - LDSCTL_OFF) / 4; u += NWAVES * 64) ((LAS unsigned*)(lds + LDSCTL_OFF))[u] = 0u;
    __syncthreads();
    XcdBarrier bar; bar.bar = (unsigned*)(ctl + CW_BAR); bar.x = 0; bar.st = nullptr;
    const int lo = args.ph_lo, hi = args.ph_hi;
    if (hi - lo > 1) bar = xcd_barrier_post((unsigned*)(ctl + CW_BAR), MISC + 8);
#ifndef PH_MASK
#define PH_MASK 0x3ff
#endif
#define IN(k) (((PH_MASK >> (k)) & 1) && lo <= (k) && (k) < hi)
#ifndef PROBE_K
#define PROBE_K -1
#endif
#if PROBE_K >= 0
    volatile LAS unsigned long long* stamps = (volatile LAS unsigned long long*)(lds + MISC_OFF + 128);
    if (tid == 0) stamps[0] = __builtin_amdgcn_s_memrealtime();
#define SEAM(k) do { if (IN(k) && IN((k) + 1)) xcd_barrier(bar); if (tid == 0) stamps[(k) + 1] = __builtin_amdgcn_s_memrealtime(); } while (0)
#else
#define SEAM(k) do { if (IN(k) && IN((k) + 1)) xcd_barrier(bar); } while (0)
#endif
    bf16* WIN = (bf16*)(ws + WS_WIN); bf16* WC = (bf16*)(ws + WS_WC); bf16* WD = (bf16*)(ws + WS_WD); bf16* WO = (bf16*)(ws + WS_WO); bf16* WUP = (bf16*)(ws + WS_WUP); bf16* WDN = (bf16*)(ws + WS_WDN);
    bf16* H = (bf16*)(ws + WS_H); bf16* GLU = (bf16*)(ws + WS_GLU); bf16* QKVB = (bf16*)(ws + WS_QKVB); bf16* QS = (bf16*)(ws + WS_QS); bf16* ZS = (bf16*)(ws + WS_ZS);
    bf16* HALOQ = (bf16*)(ws + WS_HALOQ); bf16* HALOC = (bf16*)(ws + WS_HALOC);
    bf16* SGC = (bf16*)args.out; bf16* SGD = (bf16*)args.out + (size_t)M2 * DM;
    bf16* X1B = (bf16*)(ws + WS_X1B);
    bf16* MIX = (bf16*)(ws + WS_MIX); bf16* XG = (bf16*)(ws + WS_XG); bf16* HM = (bf16*)(ws + WS_HM); bf16* C = (bf16*)(ws + WS_C);
    float* BETAG = (float*)(ws + WS_BETAG);
    const int gw = vcu * NWAVES + wave, NGW = G * NWAVES;

    constexpr int KB1 = DM / 32, KB4 = DFF / 32, I_SQ = KB1 * (DM / 64), I_UP = KB1 * (DFF / 64), I_DN = KB4 * (DM / 64);
    constexpr int NU1 = (MP / 256) * (NIN / 256), NU4 = (MP / 256) * (DM / 256), NU7 = (M2 / 256) * (DFF / 256);
#define CONVERT_ITEMS(lo_, hi_, w0_, nw_) do { for (int it_ = (lo_) + (w0_); it_ < (hi_); it_ += (nw_)) { int r = it_; \
        if (r < I_SQ) { p0_transpose_item(args.in[12], DM, DM, WC, (r / KB1) * 64, (r / KB1) * 64, 64, (r % KB1) * 32, lane); continue; } r -= I_SQ; \
        if (r < I_SQ) { p0_transpose_item(args.in[17], DM, DM, WD, (r / KB1) * 64, (r / KB1) * 64, 64, (r % KB1) * 32, lane); continue; } r -= I_SQ; \
        if (r < I_SQ) { p0_transpose_item(args.in[18], DM, DM, WO, (r / KB1) * 64, (r / KB1) * 64, 64, (r % KB1) * 32, lane); continue; } r -= I_SQ; \
        if (r < I_UP) { p0_transpose_item(args.in[20], DFF, DM, WUP, (r / KB1) * 64, (r / KB1) * 64, 64, (r % KB1) * 32, lane); continue; } r -= I_UP; \
        p0_transpose_item(args.in[21], DM, DFF, WDN, (r / KB4) * 64, (r / KB4) * 64, 64, (r % KB4) * 32, lane); } } while (0)
    if (IN(0)) {
        constexpr int I_IN = KB1 * (NIN / 64);
        for (int it = gw; it < I_IN; it += NGW) { const int nb = it / KB1, kb = it % KB1; int src, nv; win_src(nb, src, nv); p0_transpose_item(args.in[7], DIN, DM, WIN, nb * 64, src, nv, kb * 32, lane); }
        for (int m0 = gw; m0 < MP; m0 += 2 * NGW) {
            const float* src[2]; bool ok[2]; f32x4 v[2][4];
#pragma unroll
            for (int q = 0; q < 2; ++q) { const int m = m0 + q * NGW; ok[q] = m < MR; const int mm = ok[q] ? m : 0;
                if (mm >= RP) src[q] = args.in[1] + (size_t)(mm - RP) * DM;
                else { const int b = mm / TP, t = mm - b * TP; src[q] = t < NMETA ? args.in[5] + (size_t)t * DM : args.in[0] + ((size_t)b * SEQ + (t - NMETA)) * DM; }
#pragma unroll
                for (int j = 0; j < 4; ++j) v[q][j] = ((const GAS f32x4*)src[q])[lane + 64 * j]; }
#pragma unroll
            for (int q = 0; q < 2; ++q) { const int m = m0 + q * NGW; if (m >= MP) continue;
                float ss = 0.f;
#pragma unroll
                for (int j = 0; j < 4; ++j) ss += (v[q][j].x * v[q][j].x + v[q][j].y * v[q][j].y) + (v[q][j].z * v[q][j].z + v[q][j].w * v[q][j].w);
                const float rstd = ok[q] ? rsqf(wave_sum(ss) * (1.f / DM) + EPS) : 0.f;
                GAS v2u* o8 = (GAS v2u*)(H + (size_t)m * DM) + lane;
#pragma unroll
                for (int j = 0; j < 4; ++j) { const f32x4 g = ((const GAS f32x4*)args.in[6])[lane + 64 * j]; v2u o; o.x = cvtpk(v[q][j].x * rstd * g.x, v[q][j].y * rstd * g.y); o.y = cvtpk(v[q][j].z * rstd * g.z, v[q][j].w * rstd * g.w); o8[64 * j] = o; } }
        }
    }
    SEAM(0);
    if (IN(1)) {
        pg8::Gemm g{H, WIN, MP, NIN, DM}; pg8::StaticOrder S; S.init(MP, NIN, G, bx, DM);
        EpiIn E{GLU, QKVB, QS, HALOQ, HALOC, ZS, SGC, SGD, BETAG, args.in[14], args.in[15]};
        pg8::gemm_phase<EpiIn, pg8::StaticOrder, true, true>(lds + RING_OFF, g, S, E);
        if (G == 256) { if (bx >= NU1 % 256) CONVERT_ITEMS(0, 2 * I_SQ, (bx - NU1 % 256) * NWAVES + wave, (256 - NU1 % 256) * NWAVES); }
        else CONVERT_ITEMS(0, 3 * I_SQ + I_UP + I_DN, gw, NGW);
    }
    SEAM(1);
    if (IN(2)) {
        constexpr int N_CP = BP * NRUN, N_IP = BP * NCH * NH / 2, N_SD = BS * NH / 4, N_CS = BS, N_ITEMS = N_CP + N_IP + N_SD + N_CS;
        volatile LAS int* qslot = (volatile LAS int*)(lds + MISC_OFF + 64);
#if PROBE_K >= 0 && !defined(PROBE_NOSPLIT)
        for (int sub = 0; sub < 3; ++sub) {
            const int lo_i = sub == 0 ? 0 : (sub == 1 ? N_CP : N_CP + N_IP), hi_i = sub == 0 ? N_CP : (sub == 1 ? N_CP + N_IP : N_CP + N_IP + N_SD);
            for (;;) {
                if (tid == 0) *qslot = (int)__hip_atomic_fetch_add((unsigned*)(ctl + 2048 + 64 * sub), 1u, __ATOMIC_RELAXED, __HIP_MEMORY_SCOPE_AGENT);
                __syncthreads();
                int it = *qslot + lo_i;
                __syncthreads();
                if (sub == 0 && it >= N_CP) { it += N_IP + N_SD; if (it >= N_ITEMS) break; conv_unit<1>(args, lds, it - (N_CP + N_IP + N_SD), 0); continue; }
                if (it >= hi_i) break;
                if (it < N_CP) { conv_unit<0>(args, lds, it / NRUN, it % NRUN); continue; } it -= N_CP;
                if (it < N_IP) { intra_pair(args, lds, it); continue; } it -= N_IP;
                (void)it;
            }
            if (sub < 2) { xcd_barrier(bar); if (tid == 0) stamps[12 + sub] = __builtin_amdgcn_s_memrealtime(); }
        }
#else
        for (;;) {
            if (tid == 0) *qslot = (int)__hip_atomic_fetch_add((unsigned*)(ctl + 2048), 1u, __ATOMIC_RELAXED, __HIP_MEMORY_SCOPE_AGENT);
            __syncthreads();
            int it = *qslot;
            __syncthreads();
            if (it >= N_CP + N_IP) it += N_SD;
            if (it >= N_ITEMS) break;
            if (it < N_CP) { conv_unit<0>(args, lds, it / NRUN, it % NRUN); continue; } it -= N_CP;
            if (it < N_IP) { intra_pair(args, lds, it); continue; } it -= N_IP;
            it -= N_SD; if (it < 0) continue;
            conv_unit<1>(args, lds, it, 0);
        }
#endif
    }
    SEAM(2);
    if (IN(3)) {
        if (bx < BP * NH) { scan_chain(args, lds, bx);
#if PROBE_K >= 0
            if (tid == 0) stamps[14] = __builtin_amdgcn_s_memrealtime();
#endif
        }
#if defined(PROBE_SCAN_ALONE)
        xcd_barrier(bar);
        if (bx < BP * NH) {}
#endif
        else {
            pg8::Gemm g{C, WC, MP, DM, DM}; pg8::StaticOrder S; S.init(MP, DM, G - BP * NH, bx - BP * NH, DM);
            EpiGate<0> E{SGC, nullptr, SGC};
            pg8::gemm_phase<EpiGate<0>, pg8::StaticOrder, true, true>(lds + RING_OFF, g, S, E);
            volatile LAS int* qslot = (volatile LAS int*)(lds + MISC_OFF + 64);
            for (;;) {
                if (tid == 0) *qslot = (int)__hip_atomic_fetch_add((unsigned*)(ctl + 2048 + 256), 1u, __ATOMIC_RELAXED, __HIP_MEMORY_SCOPE_AGENT);
                __syncthreads();
                const int it = *qslot;
                __syncthreads();
                if (it >= BS * NH / 4) break;
                delta_item(args, lds, it);
            }
        }
    }
    SEAM(3);
    if (IN(4)) {
        pg8::Gemm g{ZS, WD, MP, DM, DM}; pg8::StaticOrder S; S.init(MP, DM, G, bx, DM);
        EpiGate<1> E{SGD, SGC, MIX};
        pg8::gemm_phase<EpiGate<1>, pg8::StaticOrder, true, true>(lds + RING_OFF, g, S, E);
        if (G == 256 && bx >= NU4 % 256) CONVERT_ITEMS(2 * I_SQ, 3 * I_SQ + I_UP, (bx - NU4 % 256) * NWAVES + wave, (256 - NU4 % 256) * NWAVES);
    }
    SEAM(4);
    if (IN(5)) {
        pg8::Gemm g{MIX, WO, M2, DM, DM}; pg8::SplitOrder S; S.init(BP * SEQ, M2, DM, G, bx, DM, KSPLIT5);
        EpiWoP E; E.xp = args.in[0]; E.X1B = X1B; E.parts = (float*)(ws + WS_PART5);
        pg8::gemm_phase<EpiWoP, pg8::SplitOrder, true, true>(lds + RING_OFF, g, S, E);
    }
    SEAM(5);
    if (IN(6)) {
        for (int i0 = gw; i0 < M2; i0 += 2 * NGW) {
            f32x4 v[2][4]; int mrow[2]; bool ok[2];
#pragma unroll
            for (int q = 0; q < 2; ++q) { const int i = i0 + q * NGW; ok[q] = i < M2; const int ii = ok[q] ? i : 0; const int m = ii < RS ? BP * SEQ + ii : ii - RS; mrow[q] = m;
                if (m >= BP * SEQ) { const GAS f32x4* x0 = (const GAS f32x4*)(args.in[1] + (size_t)(m - BP * SEQ) * DM) + lane;
#pragma unroll
                    for (int jj = 0; jj < 4; ++jj) v[q][jj] = x0[64 * jj];
                } else { const GAS v2u* xb = (const GAS v2u*)(X1B + (size_t)m * DM) + lane;
#pragma unroll
                    for (int jj = 0; jj < 4; ++jj) { const v2u o = xb[64 * jj]; v[q][jj] = (f32x4){bflo(o.x), bfhi(o.x), bflo(o.y), bfhi(o.y)}; } } }
#pragma unroll
            for (int q = 0; q < 2; ++q) { const int m = mrow[q]; if (!ok[q]) continue;
                if (m >= BP * SEQ) {
                    const GAS f32x4* pr = (const GAS f32x4*)((const float*)(ws + WS_PART5) + (size_t)(m - BP * SEQ) * DM) + lane; GAS v2u* xb = (GAS v2u*)(X1B + (size_t)m * DM) + lane;
#pragma unroll
                    for (int jj = 0; jj < 4; ++jj) {
#pragma unroll
                        for (int ks = 0; ks < KSPLIT5; ++ks) v[q][jj] += pr[(size_t)ks * RS * DM / 4 + 64 * jj];
                        v2u o; o.x = cvtpk(v[q][jj].x, v[q][jj].y); o.y = cvtpk(v[q][jj].z, v[q][jj].w); xb[64 * jj] = o;
                        v[q][jj] = (f32x4){bflo(o.x), bfhi(o.x), bflo(o.y), bfhi(o.y)}; } }
                float ss = 0.f;
#pragma unroll
                for (int jj = 0; jj < 4; ++jj) ss += (v[q][jj].x * v[q][jj].x + v[q][jj].y * v[q][jj].y) + (v[q][jj].z * v[q][jj].z + v[q][jj].w * v[q][jj].w);
                const float rstd = rsqf(wave_sum(ss) * (1.f / DM) + EPS);
                GAS v2u* o8 = (GAS v2u*)(XG + (size_t)m * DM) + lane; const GAS f32x4* gr = (const GAS f32x4*)args.in[19] + lane;
#pragma unroll
                for (int jj = 0; jj < 4; ++jj) { const f32x4 g = gr[64 * jj]; v2u o; o.x = cvtpk(v[q][jj].x * rstd * g.x, v[q][jj].y * rstd * g.y); o.y = cvtpk(v[q][jj].z * rstd * g.z, v[q][jj].w * rstd * g.w); o8[64 * jj] = o; } }
        }
    }
    SEAM(6);
    if (IN(7)) {
        pg8::Gemm g{XG, WUP, M2, DFF, DM}; pg8::StaticOrder S; S.init(M2, DFF, G, bx, DM);
        EpiUp E{HM};
        pg8::gemm_phase<EpiUp, pg8::StaticOrder, true, true>(lds + RING_OFF, g, S, E);
        if (G == 256 && bx >= NU7 % 256) CONVERT_ITEMS(3 * I_SQ + I_UP, 3 * I_SQ + I_UP + I_DN, (bx - NU7 % 256) * NWAVES + wave, (256 - NU7 % 256) * NWAVES);
    }
    SEAM(7);
    if (IN(8)) {
        pg8::Gemm g{HM, WDN, M2, DM, DFF}; pg8::SplitOrder S; S.init(BP * SEQ, M2, DM, G, bx, DFF, KSPLIT);
        EpiRes<1> E{nullptr, nullptr, args.out, (float*)(ws + WS_PART), X1B};
        pg8::gemm_phase<EpiRes<1>, pg8::SplitOrder, true, true>(lds + RING_OFF, g, S, E);
    }
    SEAM(8);
    if (IN(9)) {
        for (int i0 = gw; i0 < M2; i0 += 2 * NGW) {
            f32x4 v[2][4]; int mrow[2]; bool ok[2];
#pragma unroll
            for (int q = 0; q < 2; ++q) { const int i = i0 + q * NGW; ok[q] = i < M2; const int ii = ok[q] ? i : 0; const int m = ii < RS ? BP * SEQ + ii : ii - RS; mrow[q] = m;
                const GAS v2u* xb = (const GAS v2u*)(X1B + (size_t)m * DM) + lane;
#pragma unroll
                for (int jj = 0; jj < 4; ++jj) { const v2u o = xb[64 * jj]; v[q][jj] = (f32x4){bflo(o.x), bfhi(o.x), bflo(o.y), bfhi(o.y)}; } }
#pragma unroll
            for (int q = 0; q < 2; ++q) { const int m = mrow[q]; if (!ok[q]) continue;
                if (m >= BP * SEQ) { const GAS f32x4* pr = (const GAS f32x4*)((const float*)(ws + WS_PART) + (size_t)(m - BP * SEQ) * DM) + lane;
#pragma unroll 4
                    for (int ks = 0; ks < KSPLIT; ++ks)
#pragma unroll
                        for (int jj = 0; jj < 4; ++jj) v[q][jj] += pr[(size_t)ks * RS * DM / 4 + 64 * jj]; }
                float s2 = 0.f;
#pragma unroll
                for (int jj = 0; jj < 4; ++jj) s2 += (v[q][jj].x * v[q][jj].x + v[q][jj].y * v[q][jj].y) + (v[q][jj].z * v[q][jj].z + v[q][jj].w * v[q][jj].w);
                const float rstd = rsqf(wave_sum(s2) * (1.f / DM) + EPS);
                GAS f32x4* xr = (GAS f32x4*)(args.out + (size_t)m * DM) + lane; const GAS f32x4* gr = (const GAS f32x4*)args.in[22] + lane;
#pragma unroll
                for (int jj = 0; jj < 4; ++jj) xr[64 * jj] = v[q][jj] * rstd * gr[64 * jj]; }
        }
    }
#if PROBE_K >= 0
    __syncthreads();
    if (bx == 0) { if (tid == 0) stamps[NPHASES] = __builtin_amdgcn_s_memrealtime(); __syncthreads();
        const float dt_us = (float)(stamps[PROBE_B] - stamps[PROBE_K]) * 0.01f; const float f = 1.f + dt_us * (1.f / (float)(PROBE_DIV));
        for (int i = tid; i < BP * 3 * DQKV; i += NWAVES * 64) args.out[O_PQ + i] *= f; }
#endif
#undef IN
#undef SEAM
}

extern "C" void kernel_launch(void* const* d_in, const int* in_sizes, int n_in, void* d_out, int out_size, void* d_ws, size_t ws_size, hipStream_t stream) {
    static int grid = 0;
    if (grid == 0) {
        if (n_in != 23 || (size_t)out_size != O_END || ws_size < WS_END) { fprintf(stderr, "kernel_launch: unexpected shapes n_in %d out %d ws %zu\n", n_in, out_size, ws_size); grid = -1; return; }
        int dev = 0, cus = 0, per_cu = 0;
        if (hipGetDevice(&dev) != hipSuccess || hipDeviceGetAttribute(&cus, hipDeviceAttributeMultiprocessorCount, dev) != hipSuccess) { grid = -1; return; }
        if (hipFuncSetAttribute((const void*)fwd_kernel, hipFuncAttributeMaxDynamicSharedMemorySize, LDS_BYTES) != hipSuccess) { fprintf(stderr, "kernel_launch: hipFuncSetAttribute failed\n"); grid = -1; return; }
        if (hipOccupancyMaxActiveBlocksPerMultiprocessor(&per_cu, (const void*)fwd_kernel, NWAVES * 64, LDS_BYTES) != hipSuccess || per_cu < 1)
            fprintf(stderr, "kernel_launch: occupancy query reports %d\n", per_cu);
        (void)hipGetLastError();
        grid = cus;
    }
    if (grid < 0) return;
    if (hipMemsetAsync((char*)d_ws + WS_CTL, 0, CTL_ZERO_BYTES, stream) != hipSuccess) return;
    Args a{};
    for (int i = 0; i < 23; ++i) a.in[i] = (const float*)d_in[i];
    a.out = (float*)d_out; a.ws = (unsigned char*)d_ws;
#if MK_N_LAUNCHES == 1
    a.ph_lo = 0; a.ph_hi = NPHASES;
    hipLaunchKernelGGL(fwd_kernel, dim3(grid), dim3(NWAVES * 64), LDS_BYTES, stream, a);
#else
    for (int p = 0; p < NPHASES; ++p) { a.ph_lo = p; a.ph_hi = p + 1; hipLaunchKernelGGL(fwd_kernel, dim3(grid), dim3(NWAVES * 64), LDS_BYTES, stream, a); }
#endif
}
```

```cpp
#include <hip/hip_runtime.h>
#include <cstdio>
#include <cstdint>

#ifndef MK_N_LAUNCHES
#define MK_N_LAUNCHES 1
#endif

namespace pg8 {
#define PG8_LAS __attribute__((address_space(3)))
typedef unsigned short bf16_t;
typedef short bf16x8 __attribute__((ext_vector_type(8)));
typedef float f32x4 __attribute__((ext_vector_type(4)));
typedef unsigned u32x4 __attribute__((ext_vector_type(4)));
constexpr int BM = 256, BK = 64, HALF = 128, HTB = HALF * BK * 2, STAGE_BYTES = 8 * HTB, NXCD = 8, WGM = 4;

__host__ __device__ __forceinline__ int lds_byte(int r, int c) { const int st = (r >> 4) * 2 + (c >> 5), rr = r & 15, cc = c & 31, ob = rr * 64 + cc * 2; return st * 1024 + (ob ^ (((ob >> 9) & 1) << 5)); }
__host__ __device__ __forceinline__ void stage_rc(int b, int& R, int& C) { const int st = b / 1024, sb = b % 1024, swz = sb ^ (((sb >> 9) & 1) << 5); R = (st >> 1) * 16 + swz / 64; C = (st & 1) * 32 + (swz % 64) / 2; }
__host__ __device__ __forceinline__ int perm32(int rho) { const int n = rho >> 4, i = rho & 15; return 8 * (i >> 2) + 4 * n + (i & 3); }

struct Unit { int pm, pn, k0, nt, typ; };
struct Gemm { const bf16_t* A; const bf16_t* Bt; int M, N, K;
    __device__ __forceinline__ const char* a(const Unit&) const { return (const char*)A; } __device__ __forceinline__ const char* b(const Unit&) const { return (const char*)Bt; } };
struct Gemm2 { const bf16_t *A0, *B0, *A1, *B1; int K;
    __device__ __forceinline__ const char* a(const Unit& u) const { return (const char*)(u.typ ? A1 : A0); } __device__ __forceinline__ const char* b(const Unit& u) const { return (const char*)(u.typ ? B1 : B0); } };

struct StaticOrder {
    int nM, nN, nwg, G, c, nt;
    __host__ __device__ void init(int M, int N, int G_, int c_, int K) { nM = M / BM; nN = N / BM; nwg = nM * nN; G = G_; c = c_; nt = K / BK; }
    __host__ __device__ __forceinline__ bool next(int i, Unit& u) const {
        const long L = (long)i * G + c; if (L >= nwg) return false;
        u.k0 = 0; u.nt = nt; u.typ = 0;
        int wgid = (int)L; { const int q = nwg / NXCD, r = nwg % NXCD, xcd = wgid % NXCD, off = wgid / NXCD; wgid = (xcd < r ? xcd * (q + 1) : r * (q + 1) + (xcd - r) * q) + off; }
        const int nig = WGM * nN, gid = wgid / nig, fm = gid * WGM, gsz = (nM - fm) < WGM ? (nM - fm) : WGM;
        u.pm = fm + ((wgid % nig) % gsz); u.pn = (wgid % nig) / gsz; return true;
    }
    __device__ __forceinline__ void a_ready(const Unit&) const {}
    __device__ __forceinline__ void done(const Unit&) const {}
};

struct SplitOrder {
    int nM, nN, nwg, G, c, ntfull, nsub, KS, ntsub;
    __host__ __device__ void init(int Mmain, int Mall, int N, int G_, int c_, int K, int KS_) { nM = Mmain / BM; nN = N / BM; nwg = nM * nN; G = G_; c = c_; ntfull = K / BK; KS = KS_; ntsub = K / BK / KS_; nsub = (Mall / BM - nM) * nN * KS_; }
    __host__ __device__ __forceinline__ bool next(int i, Unit& u) const {
        const long L = (long)i * G + c; if (L >= nwg + nsub) return false;
        int pm, pn, k0, ntu;
        if (L < nwg) {
            int wgid = (int)L; { const int q = nwg / NXCD, r = nwg % NXCD, xcd = wgid % NXCD, off = wgid / NXCD; wgid = (xcd < r ? xcd * (q + 1) : r * (q + 1) + (xcd - r) * q) + off; }
            const int nig = WGM * nN, gid = wgid / nig, fm = gid * WGM, gsz = (nM - fm) < WGM ? (nM - fm) : WGM;
            pm = fm + ((wgid % nig) % gsz); pn = (wgid % nig) / gsz; k0 = 0; ntu = ntfull;
        } else { const int j = (int)L - nwg, tile = j / KS, ks = j % KS; pm = nM + tile / nN; pn = tile % nN; k0 = ks * ntsub; ntu = ntsub; }
        u.pm = pm; u.pn = pn; u.k0 = k0; u.nt = ntu; u.typ = 0; return true;
    }
    __device__ __forceinline__ void a_ready(const Unit&) const {}
    __device__ __forceinline__ void done(const Unit&) const {}
};

__device__ __forceinline__ unsigned cvt_pk_bf16(float lo, float hi) { unsigned r; asm volatile("v_cvt_pk_bf16_f32 %0, %1, %2" : "=v"(r) : "v"(lo), "v"(hi)); return r; }

template <class Epi, class Sched, bool ALIGN_EPI = false, bool SP2 = false, class GemmT = Gemm>
__device__ __forceinline__ void gemm_phase(PG8_LAS unsigned char* lds, const GemmT g, const Sched& S, const Epi& E) {
    const int tid = threadIdx.x, wid = __builtin_amdgcn_readfirstlane(tid >> 6), lane = tid & 63, wr = wid >> 2, wc = wid & 3, fr = lane & 15, fq = lane >> 4;
    const int K = g.K;
    unsigned voffA[2], voffB[2];
#pragma unroll
    for (int i = 0; i < 2; ++i) { int R, C; stage_rc(tid * 16 + i * 8192, R, C); const int Rb = Epi::PERM ? ((R & ~31) + perm32(R & 31)) : R;
        voffA[i] = (unsigned)(R * K + C) * 2u; voffB[i] = (unsigned)(Rb * K + C) * 2u; }
    const size_t kstep = (size_t)(BK * 2);
    const size_t hstep = (size_t)HALF * K * 2;
    const size_t tstep = 2 * hstep;
    const unsigned ldsw = (unsigned)wid * 1024u;
    const int aoff = lds_byte(wr * 64 + fr, fq * 8), boff = lds_byte(wc * 32 + fr, fq * 8);
#define PG8_SA(b, h) (((b) * 2 + (h)) * HTB)
#define PG8_SB(b, h) ((4 + (b) * 2 + (h)) * HTB)
#define PG8_STAGE(bufoff, gbase, voff) do { _Pragma("unroll") for (int _i = 0; _i < 2; ++_i) \
        __builtin_amdgcn_global_load_lds((const unsigned*)((const char*)(gbase) + (voff)[_i]), (PG8_LAS unsigned*)(lds + (bufoff) + ldsw + _i * 8192), 16, 0, 0); } while (0)
#define PG8_LDA(dst, b, h) do { _Pragma("unroll") for (int m = 0; m < 4; ++m) _Pragma("unroll") for (int k = 0; k < 2; ++k) dst[m][k] = *(const PG8_LAS bf16x8*)(lds + PG8_SA(b, h) + aoff + m * 2048 + k * 1024); } while (0)
#define PG8_LDB(dst, b, h) do { _Pragma("unroll") for (int n = 0; n < 2; ++n) _Pragma("unroll") for (int k = 0; k < 2; ++k) dst[n][k] = *(const PG8_LAS bf16x8*)(lds + PG8_SB(b, h) + boff + n * 2048 + k * 1024); } while (0)
#define PG8_MMA(ai, bj, At, Bt) do { __builtin_amdgcn_s_setprio(1); _Pragma("unroll") for (int m = 0; m < 4; ++m) _Pragma("unroll") for (int n = 0; n < 2; ++n) _Pragma("unroll") for (int k = 0; k < 2; ++k) \
        acc[ai][bj][m][n] = __builtin_amdgcn_mfma_f32_16x16x32_bf16(Bt[n][k], At[m][k], acc[ai][bj][m][n], 0, 0, 0); __builtin_amdgcn_s_setprio(0); } while (0)
#define PG8_WAIT_V(n) asm volatile("s_waitcnt vmcnt(" #n ")" ::: "memory")
#define PG8_WAIT_L(n) asm volatile("s_waitcnt lgkmcnt(" #n ")" ::: "memory")
#define PG8_BAR __builtin_amdgcn_s_barrier()
#define PG8_SCHED __builtin_amdgcn_sched_barrier(0)
    Unit cur, nxt; int ui = 0;
    if (!S.next(0, cur)) return;
    f32x4 acc[2][2][4][2];
#pragma unroll
    for (int a = 0; a < 2; ++a)
#pragma unroll
        for (int b = 0; b < 2; ++b)
#pragma unroll
            for (int m = 0; m < 4; ++m)
#pragma unroll
                for (int n = 0; n < 2; ++n) acc[a][b][m][n] = (f32x4){0.f, 0.f, 0.f, 0.f};
    bf16x8 At[4][2], B0[2][2], B1[2][2];
    const char* cA = g.a(cur) + (size_t)cur.pm * tstep + (size_t)cur.k0 * kstep; const char* cB = g.b(cur) + (size_t)cur.pn * tstep + (size_t)cur.k0 * kstep;
    S.a_ready(cur);
    if constexpr (SP2) {
        PG8_STAGE(PG8_SB(0, 0), cB, voffB); PG8_STAGE(PG8_SB(0, 1), cB + hstep, voffB); PG8_STAGE(PG8_SA(0, 0), cA, voffA); PG8_STAGE(PG8_SA(0, 1), cA + hstep, voffA);
        if (wr == 1) PG8_BAR;
        PG8_WAIT_V(2); PG8_BAR;
        PG8_STAGE(PG8_SB(1, 0), cB + kstep, voffB); PG8_STAGE(PG8_SA(1, 0), cA + kstep, voffA); PG8_STAGE(PG8_SB(1, 1), cB + hstep + kstep, voffB);
        PG8_WAIT_V(6); PG8_BAR;
    } else {
        PG8_STAGE(PG8_SB(0, 0), cB, voffB); PG8_STAGE(PG8_SA(0, 0), cA, voffA); PG8_STAGE(PG8_SB(0, 1), cB + hstep, voffB); PG8_STAGE(PG8_SA(0, 1), cA + hstep, voffA);
        if (wr == 1) PG8_BAR;
        PG8_WAIT_V(4); PG8_BAR;
        PG8_STAGE(PG8_SB(1, 0), cB + kstep, voffB); PG8_STAGE(PG8_SA(1, 0), cA + kstep, voffA); PG8_STAGE(PG8_SB(1, 1), cB + hstep + kstep, voffB);
        PG8_WAIT_V(6); PG8_BAR;
    }
    for (;;) {
        const bool has_next = S.next(ui + 1, nxt);
        const char* nA = has_next ? g.a(nxt) + (size_t)nxt.pm * tstep + (size_t)nxt.k0 * kstep : cA; const char* nB = has_next ? g.b(nxt) + (size_t)nxt.pn * tstep + (size_t)nxt.k0 * kstep : cB;
        const int nt = cur.nt;
        for (int t = 0; t < nt; t += 2) {
            const bool last = (t == nt - 2);
            const char* a1 = cA + (size_t)(t + 1) * kstep;
            const char* a2 = last ? nA : cA + (size_t)(t + 2) * kstep; const char* b2 = last ? nB : cB + (size_t)(t + 2) * kstep;
            const char* a3 = a2 + kstep; const char* b3 = b2 + kstep;
            if (last && has_next) S.a_ready(nxt);
            if constexpr (SP2) {
            PG8_LDB(B0, 0, 0); PG8_LDB(B1, 0, 1); PG8_SCHED; PG8_LDA(At, 0, 0); PG8_STAGE(PG8_SA(1, 1), a1 + hstep, voffA);
            PG8_WAIT_V(8); PG8_WAIT_L(0); PG8_BAR; PG8_MMA(0, 0, At, B0); PG8_MMA(0, 1, At, B1); PG8_BAR; PG8_SCHED;
            PG8_LDA(At, 0, 1); PG8_STAGE(PG8_SB(0, 0), b2, voffB); PG8_STAGE(PG8_SB(0, 1), b2 + hstep, voffB); PG8_STAGE(PG8_SA(0, 0), a2, voffA);
            PG8_WAIT_V(8); PG8_WAIT_L(0); PG8_BAR; PG8_MMA(1, 0, At, B0); PG8_MMA(1, 1, At, B1); PG8_BAR; PG8_SCHED;
            PG8_LDB(B0, 1, 0); PG8_LDB(B1, 1, 1); PG8_SCHED; PG8_LDA(At, 1, 0); PG8_STAGE(PG8_SA(0, 1), a2 + hstep, voffA);
            PG8_WAIT_V(8); PG8_WAIT_L(0); PG8_BAR; PG8_MMA(0, 0, At, B0); PG8_MMA(0, 1, At, B1); PG8_BAR; PG8_SCHED;
            PG8_LDA(At, 1, 1); PG8_STAGE(PG8_SB(1, 0), b3, voffB); PG8_STAGE(PG8_SB(1, 1), b3 + hstep, voffB); PG8_STAGE(PG8_SA(1, 0), a3, voffA);
            PG8_WAIT_V(8); PG8_WAIT_L(0); PG8_BAR; PG8_MMA(1, 0, At, B0); PG8_MMA(1, 1, At, B1); PG8_BAR; PG8_SCHED;
            } else {
            PG8_LDB(B0, 0, 0); PG8_SCHED; PG8_LDA(At, 0, 0); PG8_STAGE(PG8_SA(1, 1), a1 + hstep, voffA);
            PG8_WAIT_L(8); PG8_BAR; PG8_WAIT_L(0); PG8_MMA(0, 0, At, B0); PG8_BAR; PG8_SCHED;
            PG8_LDB(B1, 0, 1); PG8_STAGE(PG8_SB(0, 0), b2, voffB);
            PG8_BAR; PG8_WAIT_L(0); PG8_MMA(0, 1, At, B1); PG8_BAR;
            PG8_LDA(At, 0, 1); PG8_STAGE(PG8_SA(0, 0), a2, voffA);
            PG8_BAR; PG8_WAIT_L(0); PG8_MMA(1, 0, At, B0); PG8_BAR; PG8_SCHED;
            PG8_STAGE(PG8_SB(0, 1), b2 + hstep, voffB);
            PG8_WAIT_V(6); PG8_BAR; PG8_MMA(1, 1, At, B1); PG8_BAR;
            PG8_LDB(B0, 1, 0); PG8_SCHED; PG8_LDA(At, 1, 0); PG8_STAGE(PG8_SA(0, 1), a2 + hstep, voffA);
            PG8_WAIT_L(8); PG8_BAR; PG8_WAIT_L(0); PG8_MMA(0, 0, At, B0); PG8_BAR; PG8_SCHED;
            PG8_LDB(B1, 1, 1); PG8_STAGE(PG8_SB(1, 0), b3, voffB);
            PG8_BAR; PG8_WAIT_L(0); PG8_MMA(0, 1, At, B1); PG8_BAR;
            PG8_LDA(At, 1, 1); PG8_STAGE(PG8_SA(1, 0), a3, voffA);
            PG8_BAR; PG8_WAIT_L(0); PG8_MMA(1, 0, At, B0); PG8_BAR; PG8_SCHED;
            PG8_STAGE(PG8_SB(1, 1), b3 + hstep, voffB);
            PG8_WAIT_V(6); PG8_BAR; PG8_MMA(1, 1, At, B1); PG8_BAR;
            }
        }
        if constexpr (ALIGN_EPI) { if (wr == 0) PG8_BAR; }
        E(acc, cur, wr, wc, fr, fq); S.done(cur);
        if (!has_next) break;
#pragma unroll
        for (int a = 0; a < 2; ++a)
#pragma unroll
            for (int b = 0; b < 2; ++b)
#pragma unroll
                for (int m = 0; m < 4; ++m)
#pragma unroll
                    for (int n = 0; n < 2; ++n) acc[a][b][m][n] = (f32x4){0.f, 0.f, 0.f, 0.f};
        cur = nxt; cA = nA; cB = nB; ++ui;
        if constexpr (ALIGN_EPI) { if (wr == 1) PG8_BAR; }
    }
    PG8_WAIT_V(0);
    if constexpr (!ALIGN_EPI) { if (wr == 0) PG8_BAR; }
    PG8_BAR;
#undef PG8_SA
#undef PG8_SB
#undef PG8_STAGE
#undef PG8_LDA
#undef PG8_LDB
#undef PG8_MMA
#undef PG8_WAIT_V
#undef PG8_WAIT_L
#undef PG8_BAR
#undef PG8_SCHED
}
}

constexpr int NWAVES = 8;
constexpr int DM = 1024, BP = 8, SEQ = 2048, NMETA = 16, TP = SEQ + NMETA, BS = 128, TS = 4;
constexpr int RP = BP * TP;
constexpr int RS = BS * TS;
constexpr int MR = RP + RS;
constexpr int MP = 17152;
constexpr int M2 = BP * SEQ + RS;
constexpr int NH = 8, DH = 128, DQKV = 3072, DFF = 4096, KC = 31, KS = 4;
constexpr int NIN = 8448;
constexpr int DIN = 8208;
constexpr float EPS = 1e-6f;

constexpr size_t O_YP = 0, O_YS = 16777216, O_PC = 17301504, O_PQ = 17547264, O_PD = 17620992, O_SC = 18669568, O_SQ = 22601728, O_SD = 23781376, O_END = 40558592;

constexpr size_t MiB = 1u << 20;
constexpr size_t WS_CTL = 0, CTL_ZERO_BYTES = 1 * MiB;
constexpr size_t WS_BETAG = 1 * MiB;
constexpr size_t WS_LASTV = 9 * MiB / 4;
constexpr size_t WS_HALOQ = 5 * MiB / 2;
constexpr size_t WS_WC = 29 * MiB / 4, WS_WD = WS_WC + 2 * MiB, WS_WO = WS_WD + 2 * MiB, WS_WUP = WS_WO + 2 * MiB, WS_WDN = WS_WUP + 8 * MiB;
constexpr size_t WS_GLU = 117 * MiB / 4;
constexpr size_t WS_QKVB = 63 * MiB;
constexpr size_t WS_QS = 162 * MiB;
constexpr size_t WS_ZS = 165 * MiB;
constexpr size_t WS_H = 397 * MiB / 2;
constexpr size_t WS_WIN = 232 * MiB;
constexpr size_t WS_HALOC = 497 * MiB / 2;
constexpr size_t WS_KDT = WS_H, WS_ATTN = 463 * MiB / 2;
constexpr size_t WS_MIX = WS_QKVB, WS_XG = WS_GLU, WS_HM = WS_QKVB, WS_C = WS_GLU;
constexpr int KSPLIT5 = 4; constexpr size_t WS_PART5 = 232 * MiB;
constexpr size_t WS_X1B = WS_H;
constexpr int CW_READY = 8192;
constexpr int KSPLIT = 16;
constexpr size_t WS_PART = WS_XG;
static_assert(WS_PART + (size_t)KSPLIT * RS * DM * 4 <= WS_QKVB, "ws map part");
constexpr size_t WS_END = 256 * MiB;
constexpr int NRUN = 16, RUNL = TP / NRUN;
static_assert(TP - 64 * 32 == 16 && NRUN * RUNL == TP && WS_HALOC + (size_t)BP * NRUN * 30 * DM * 2 <= WS_END, "conv runs");
constexpr int NCH = 33, QBLK = 3 * 64 * 128;
static_assert(WS_WIN + (size_t)NIN * DM * 2 <= WS_HALOC && WS_WDN + 8 * MiB <= WS_GLU && WS_GLU + (size_t)MP * DM * 2 <= WS_QKVB && WS_HALOQ + (size_t)BP * 33 * 3 * 3072 * 2 <= WS_WC, "ws map");
static_assert(WS_ZS + (size_t)MP * DM * 2 <= WS_H && WS_H + (size_t)MP * DM * 2 <= WS_WIN, "ws map 2");
static_assert(WS_QKVB + (size_t)BP * NCH * NH * QBLK * 2 <= WS_QS, "ws map qkvb");
static_assert(WS_HM + (size_t)M2 * DFF * 2 <= WS_H, "ws map hm");
static_assert(WS_KDT + (size_t)BP * NCH * NH * 8192 * 2 <= WS_ATTN && WS_ATTN + (size_t)BP * NCH * NH * 4096 * 2 <= WS_HALOC, "ws map kdt");
constexpr int CW_TMO = 0, CW_CODE = 1, CW_BAR = 4096;

constexpr int RING_OFF = 0, RING_BYTES = 131072;
constexpr int LDSCTL_OFF = 151552, MISC_OFF = LDSCTL_OFF + 320;
constexpr int LDS_BYTES = LDSCTL_OFF + 1024;

#define GAS __attribute__((address_space(1)))
#define LAS __attribute__((address_space(3)))
typedef unsigned short bf16;
typedef unsigned v4u __attribute__((ext_vector_type(4)));
typedef unsigned v2u __attribute__((ext_vector_type(2)));
typedef float f32x4 __attribute__((ext_vector_type(4)));
typedef float f32x2 __attribute__((ext_vector_type(2)));
typedef GAS unsigned gu32;
#define RLX_AGENT __ATOMIC_RELAXED, __HIP_MEMORY_SCOPE_AGENT
#define LDS_WAIT() asm volatile("s_waitcnt lgkmcnt(0)" ::: "memory")
#define VM_WAIT() asm volatile("s_waitcnt vmcnt(0)" ::: "memory")
__device__ __forceinline__ unsigned f2bf(float f) { unsigned u = __builtin_bit_cast(unsigned, f); return (u + 0x7fffu + ((u >> 16) & 1u)) >> 16; }
__device__ __forceinline__ unsigned pk2(float lo, float hi) { return f2bf(lo) | (f2bf(hi) << 16); }
typedef __bf16 bf16v2 __attribute__((ext_vector_type(2)));
__device__ __forceinline__ unsigned cvtpk(float lo, float hi) { const f32x2 v = {lo, hi}; const bf16v2 b = __builtin_convertvector(v, bf16v2); return __builtin_bit_cast(unsigned, b); }
__device__ __forceinline__ float bflo(unsigned w) { return __builtin_bit_cast(float, w << 16); }
__device__ __forceinline__ float bfhi(unsigned w) { return __builtin_bit_cast(float, w & 0xffff0000u); }
__device__ __forceinline__ float bf1(bf16 b) { return __builtin_bit_cast(float, ((unsigned)b) << 16); }
__device__ __forceinline__ float sigmoidf_(float x) { return __builtin_amdgcn_rcpf(1.f + __expf(-x)); }
__device__ __forceinline__ float siluf_(float x) { return x * sigmoidf_(x); }

#define XB_TMO      128
#define XB_XCNT(j)  (256  + 64 * (j))
#define XB_XSUB(j)  (1280 + 64 * (j))
#define XB_XGEN(j)  (2304 + 64 * (j))
#define XB_TOP      3328
#define XB_TOPGEN   3392
#define XCD_BAR_WORDS 3456
#define XB_SPIN_CAP (1u << 18)
__device__ __forceinline__ unsigned xb_ld(unsigned* p)              { return __hip_atomic_load(p, __ATOMIC_RELAXED, __HIP_MEMORY_SCOPE_AGENT); }
__device__ __forceinline__ unsigned xb_add(unsigned* p, unsigned v) { return __hip_atomic_fetch_add(p, v, __ATOMIC_RELAXED, __HIP_MEMORY_SCOPE_AGENT); }
__device__ __forceinline__ unsigned xb_xcc_id() { return (unsigned)__builtin_amdgcn_s_getreg((3 << 11) | 20) & 0xFu; }
#define XB_SPIN(cond, bar) do { unsigned _sp = 0; while (cond) { __builtin_amdgcn_s_sleep(1); \
    if ((++_sp & 255u) == 0u) { if (xb_ld(&(bar)[XB_TMO])) break; if (_sp > XB_SPIN_CAP) { atomicAdd(&(bar)[XB_TMO], 1u); break; } } } } while (0)
struct XcdBarrier { unsigned* bar; unsigned x; volatile LAS unsigned* st; };
__device__ __forceinline__ XcdBarrier xcd_barrier_post(unsigned* bar, volatile LAS unsigned* st) {
    XcdBarrier b; b.bar = bar; b.x = xb_xcc_id(); b.st = st;
    if (threadIdx.x == 0) (void)xb_add(&bar[XB_XCNT(b.x)], 1u);
    return b;
}
__device__ __forceinline__ void xcd_barrier_complete(unsigned* bar, unsigned x, unsigned& nloc, unsigned& nx) {
    const unsigned G = gridDim.x * gridDim.y * gridDim.z;
    unsigned sum, cnt, mine, sp = 0u;
    for (;;) {
        sum = 0u; cnt = 0u; mine = 0u;
#pragma unroll
        for (unsigned j = 0; j < 16; ++j) { const unsigned c = xb_ld(&bar[XB_XCNT(j)]); sum += c; cnt += (c > 0u) ? 1u : 0u; mine = (j == x) ? c : mine; }
        if (sum == G) break;
        __builtin_amdgcn_s_sleep(1);
        if ((++sp & 255u) == 0u) { if (xb_ld(&bar[XB_TMO])) break; if (sp > XB_SPIN_CAP) { atomicAdd(&bar[XB_TMO], 1u); break; } }
    }
    nloc = mine > 0u ? mine : 1u; nx = cnt > 0u ? cnt : 1u;
}
__device__ __forceinline__ void xcd_barrier(const XcdBarrier& b) {
    asm volatile("s_waitcnt vmcnt(0)" ::: "memory");
    __syncthreads();
    if (threadIdx.x == 0) {
        unsigned* bar = b.bar;
        __builtin_amdgcn_s_waitcnt(0);
        unsigned nloc = b.st[0], nx = b.st[1];
        if (nloc == 0u) { xcd_barrier_complete(bar, b.x, nloc, nx); b.st[0] = nloc; b.st[1] = nx; }
        const unsigned old = xb_add(&bar[XB_XSUB(b.x)], 1u);
        const unsigned gen = old / nloc;
        if (old + 1u == (gen + 1u) * nloc) {
            __builtin_amdgcn_fence(__ATOMIC_RELEASE, "agent");
            asm volatile("s_waitcnt vmcnt(0)" ::: "memory");
            const unsigned og = xb_add(&bar[XB_TOP], 1u);
            const unsigned tg = og / nx;
            if (og + 1u == (tg + 1u) * nx) xb_add(&bar[XB_TOPGEN], 1u);
            else XB_SPIN(xb_ld(&bar[XB_TOPGEN]) == tg, bar);
            __builtin_amdgcn_fence(__ATOMIC_ACQUIRE, "agent");
            xb_add(&bar[XB_XGEN(b.x)], 1u);
            asm volatile("s_waitcnt vmcnt(0)" ::: "memory");
        } else {
            XB_SPIN(xb_ld(&bar[XB_XGEN(b.x)]) == gen, bar);
            __builtin_amdgcn_fence(__ATOMIC_ACQUIRE, "agent");
            asm volatile("s_waitcnt vmcnt(0)" ::: "memory");
        }
    }
    __syncthreads();
}

struct Args { const float* in[23]; float* out; unsigned char* ws; int ph_lo, ph_hi; };

#define DPP_ADD(v, ctrl, rmask, bc) v += __builtin_bit_cast(float, __builtin_amdgcn_update_dpp(0, __builtin_bit_cast(int, v), ctrl, rmask, 0xF, bc))
__device__ __forceinline__ float sum16(float v) {
    DPP_ADD(v, 0xB1, 0xF, true); DPP_ADD(v, 0x4E, 0xF, true); DPP_ADD(v, 0x141, 0xF, true); DPP_ADD(v, 0x140, 0xF, true); return v; }
__device__ __forceinline__ float wave_sum(float v) {
    v = sum16(v); DPP_ADD(v, 0x142, 0xA, false); DPP_ADD(v, 0x143, 0xC, false);
    return __builtin_bit_cast(float, __builtin_amdgcn_readlane(__builtin_bit_cast(int, v), 63)); }
__device__ __forceinline__ float rsqf(float x) { return __builtin_amdgcn_rsqf(x); }
__device__ __forceinline__ int compact_row(int r) {
    if (r >= MR) return -1;
    if (r >= RP) return r - RP + BP * SEQ;
    const int b = r / TP, t = r - b * TP;
    return t < NMETA ? -1 : r - NMETA * (b + 1);
}

__device__ __forceinline__ void p0_transpose_item(const float* W, int Nsrc, int K, bf16* WT, int dst_row0, int src_col0, int nvalid, int k0, int lane) {
    const float* src = W + (size_t)k0 * Nsrc + src_col0 + (lane < nvalid ? lane : 0);
    float v[32];
#pragma unroll
    for (int j = 0; j < 32; ++j) v[j] = src[(size_t)j * Nsrc];
    if (lane >= nvalid) {
#pragma unroll
        for (int j = 0; j < 32; ++j) v[j] = 0.f; }
    GAS v4u* dst = (GAS v4u*)(WT + (size_t)(dst_row0 + lane) * K + k0);
#pragma unroll
    for (int q = 0; q < 4; ++q) { v4u o; o.x = cvtpk(v[8 * q], v[8 * q + 1]); o.y = cvtpk(v[8 * q + 2], v[8 * q + 3]); o.z = cvtpk(v[8 * q + 4], v[8 * q + 5]); o.w = cvtpk(v[8 * q + 6], v[8 * q + 7]); dst[q] = o; }
}
__device__ __forceinline__ void win_src(int nb, int& src, int& nvalid) {
    const int pn = nb >> 2, o = (nb & 3) * 64; nvalid = 64;
    if (pn < 8) src = (o < 128) ? 128 * pn + o : 1024 + 128 * pn + (o - 128);
    else if (pn < 20) src = 2048 + 256 * (pn - 8) + o;
    else if (pn < 24) src = 5120 + 256 * (pn - 20) + o;
    else if (pn < 28) src = 6160 + 256 * (pn - 24) + o;
    else if (pn < 32) src = 7184 + 256 * (pn - 28) + o;
    else { src = 6144; nvalid = (o == 0) ? 16 : 0; }
}
__device__ __forceinline__ void rms_row_to_bf16(const float* xrow, const float* gain, bf16* orow, int lane) {
    const GAS f32x4* xr = (const GAS f32x4*)xrow + lane; const GAS f32x4* gr = (const GAS f32x4*)gain + lane;
    f32x4 v[4]; float s = 0.f;
#pragma unroll
    for (int j = 0; j < 4; ++j) { v[j] = xr[64 * j]; s += (v[j].x * v[j].x + v[j].y * v[j].y) + (v[j].z * v[j].z + v[j].w * v[j].w); }
    const float rstd = 1.f / sqrtf(wave_sum(s) * (1.f / DM) + EPS);
    GAS unsigned long long* o8 = (GAS unsigned long long*)orow + lane;
#pragma unroll
    for (int j = 0; j < 4; ++j) { const f32x4 g = gr[64 * j]; o8[64 * j] = (unsigned long long)cvtpk(v[j].x * rstd * g.x, v[j].y * rstd * g.y) | ((unsigned long long)cvtpk(v[j].z * rstd * g.z, v[j].w * rstd * g.w) << 32); }
}

typedef pg8::f32x4 A4;
struct EpiIn {
    static constexpr bool PERM = true;
    bf16 *GLU, *QKVB, *QS, *HALOQ, *HALOC, *ZS, *SGC, *SGD; float* BETAG; const float *a_log, *dt_bias;
    __device__ __forceinline__ void operator()(const A4 (&acc)[2][2][4][2], const pg8::Unit& u, int wr, int wc, int fr, int fq) const {
#if defined(PROBE_EPI2)
        for (int rep = 0; rep < 2; ++rep) { asm volatile("" ::: "memory"); body(acc, u, wr, wc, fr, fq); }
#else
        body(acc, u, wr, wc, fr, fq);
#endif
    }
    __device__ __forceinline__ void body(const A4 (&acc)[2][2][4][2], const pg8::Unit& u, int wr, int wc, int fr, int fq) const {
        const int pn = u.pn, row0 = u.pm * 256 + wr * 64 + fr, cw = 32 * wc + 8 * fq;
        if (pn < 8) {
#pragma unroll
            for (int ai = 0; ai < 2; ++ai)
#pragma unroll
                for (int m = 0; m < 4; ++m) { const int r = row0 + ai * 128 + m * 16; float o[8];
#pragma unroll
                    for (int n = 0; n < 2; ++n)
#pragma unroll
                        for (int j = 0; j < 4; ++j) o[4 * n + j] = acc[ai][0][m][n][j] * sigmoidf_(acc[ai][1][m][n][j]);
                    v4u w; w.x = cvtpk(o[0], o[1]); w.y = cvtpk(o[2], o[3]); w.z = cvtpk(o[4], o[5]); w.w = cvtpk(o[6], o[7]);
                    *(GAS v4u*)(GLU + (size_t)r * DM + 128 * pn + cw) = w;
                    if (r < RP) { const int b = r / TP, t = r - b * TP, run = t / RUNL, pos = t - run * RUNL;
                        if (pos >= RUNL - 30 && run < NRUN - 1) *(GAS v4u*)(HALOC + ((size_t)(b * NRUN + run) * 30 + (pos - (RUNL - 30))) * DM + 128 * pn + cw) = w; } }
        } else if (pn < 20) {
            const int colb = 256 * (pn - 8);
#pragma unroll
            for (int ai = 0; ai < 2; ++ai)
#pragma unroll
                for (int m = 0; m < 4; ++m) { const int r = row0 + ai * 128 + m * 16; if (r >= MR) continue;
#pragma unroll
                    for (int bj = 0; bj < 2; ++bj) { const int col = colb + 128 * bj + cw;
                        const A4 a0 = acc[ai][bj][m][0], a1 = acc[ai][bj][m][1];
                        v4u w; w.x = cvtpk(a0[0], a0[1]); w.y = cvtpk(a0[2], a0[3]); w.z = cvtpk(a1[0], a1[1]); w.w = cvtpk(a1[2], a1[3]);
                        if (r >= RP) *(GAS v4u*)(QS + (size_t)(r - RP) * DQKV + col) = w;
                        else { const int b = r / TP, t = r - b * TP, c = t >> 6, i = t & 63, which = col >> 10, h = (col >> 7) & 7, d = col & 127;
                            *(GAS v4u*)(QKVB + ((size_t)((b * NCH + c) * NH + h) * 3 + which) * 8192 + i * 128 + d) = w;
                            if (i >= 61) *(GAS v4u*)(HALOQ + ((size_t)(b * NCH + c) * 3 + (i - 61)) * DQKV + col) = w; } } }
        } else if (pn < 24) {
            constexpr bool isz = true; bf16* dst = ZS; const int ld = DM, cb = 256 * (pn - 20);
#pragma unroll
            for (int ai = 0; ai < 2; ++ai)
#pragma unroll
                for (int m = 0; m < 4; ++m) { const int r = row0 + ai * 128 + m * 16;
#pragma unroll
                    for (int bj = 0; bj < 2; ++bj) { float o[8];
#pragma unroll
                        for (int n = 0; n < 2; ++n)
#pragma unroll
                            for (int j = 0; j < 4; ++j) { const float v = acc[ai][bj][m][n][j]; o[4 * n + j] = isz ? siluf_(v) : v; }
                        v4u w; w.x = cvtpk(o[0], o[1]); w.y = cvtpk(o[2], o[3]); w.z = cvtpk(o[4], o[5]); w.w = cvtpk(o[6], o[7]);
                        *(GAS v4u*)(dst + (size_t)r * ld + cb + 128 * bj + cw) = w; } }
        } else if (pn < 32) {
            bf16* dst = pn < 28 ? SGC : SGD; const int cb = 256 * ((pn - 24) & 3);
#pragma unroll
            for (int ai = 0; ai < 2; ++ai)
#pragma unroll
                for (int m = 0; m < 4; ++m) { const int rc = compact_row(row0 + ai * 128 + m * 16); if (rc < 0) continue;
#pragma unroll
                    for (int bj = 0; bj < 2; ++bj) { float o[8];
#pragma unroll
                        for (int n = 0; n < 2; ++n)
#pragma unroll
                            for (int j = 0; j < 4; ++j) o[4 * n + j] = sigmoidf_(acc[ai][bj][m][n][j]);
                        v4u w; w.x = cvtpk(o[0], o[1]); w.y = cvtpk(o[2], o[3]); w.z = cvtpk(o[4], o[5]); w.w = cvtpk(o[6], o[7]);
                        *(GAS v4u*)(dst + (size_t)rc * DM + cb + 128 * bj + cw) = w; } }
        } else {
            if (wc == 0 && fq < 2) {
#pragma unroll
                for (int ai = 0; ai < 2; ++ai)
#pragma unroll
                    for (int m = 0; m < 4; ++m) { const int r = row0 + ai * 128 + m * 16; float o[8];
#pragma unroll
                        for (int n = 0; n < 2; ++n)
#pragma unroll
                            for (int j = 0; j < 4; ++j) { const int h = 4 * n + j; const float v = acc[ai][0][m][n][j];
                                if (fq == 0) o[h] = 1.f / (1.f + expf(-v));
                                else { const float xx = v + dt_bias[h]; const float sp = xx > 20.f ? xx : log1pf(expf(xx)); o[h] = -expf(a_log[h]) * sp; } }
                        GAS f32x4* p = (GAS f32x4*)(BETAG + (size_t)r * 16 + 8 * fq);
                        p[0] = (f32x4){o[0], o[1], o[2], o[3]}; p[1] = (f32x4){o[4], o[5], o[6], o[7]}; }
            }
        }
    }
};
template <int MODE> struct EpiGate {
    static constexpr bool PERM = true;
    bf16 *SG, *MA, *OUT;
    __device__ __forceinline__ void operator()(const A4 (&acc)[2][2][4][2], const pg8::Unit& u, int wr, int wc, int fr, int fq) const {
        const int row0 = u.pm * 256 + wr * 64 + fr, c0 = 256 * u.pn + 32 * wc + 8 * fq;
#pragma unroll
        for (int ai = 0; ai < 2; ++ai) {
            size_t off[4]; bool ok[4]; v4u g[4][2], q[4][2];
#pragma unroll
            for (int m = 0; m < 4; ++m) { const int rc = compact_row(row0 + ai * 128 + m * 16); ok[m] = rc >= 0; off[m] = (size_t)(ok[m] ? rc : 0) * DM + c0; }
#pragma unroll
            for (int m = 0; m < 4; ++m)
#pragma unroll
                for (int bj = 0; bj < 2; ++bj) { g[m][bj] = *(const GAS v4u*)(SG + off[m] + 128 * bj); if (MODE == 1) q[m][bj] = *(const GAS v4u*)(MA + off[m] + 128 * bj); }
#pragma unroll
            for (int m = 0; m < 4; ++m)
#pragma unroll
                for (int bj = 0; bj < 2; ++bj) { const v4u gg = g[m][bj]; float o[8];
                    const A4 a0 = acc[ai][bj][m][0], a1 = acc[ai][bj][m][1];
                    o[0] = bflo(gg.x) * a0[0]; o[1] = bfhi(gg.x) * a0[1]; o[2] = bflo(gg.y) * a0[2]; o[3] = bfhi(gg.y) * a0[3];
                    o[4] = bflo(gg.z) * a1[0]; o[5] = bfhi(gg.z) * a1[1]; o[6] = bflo(gg.w) * a1[2]; o[7] = bfhi(gg.w) * a1[3];
                    if (MODE == 1) { const v4u qq = q[m][bj];
                        o[0] += bflo(qq.x); o[1] += bfhi(qq.x); o[2] += bflo(qq.y); o[3] += bfhi(qq.y); o[4] += bflo(qq.z); o[5] += bfhi(qq.z); o[6] += bflo(qq.w); o[7] += bfhi(qq.w); }
                    v4u w; w.x = cvtpk(o[0], o[1]); w.y = cvtpk(o[2], o[3]); w.z = cvtpk(o[4], o[5]); w.w = cvtpk(o[6], o[7]);
                    if (ok[m]) *(GAS v4u*)(OUT + off[m] + 128 * bj) = w; }
        }
    }
};
template <int MODE> struct EpiRes {
    static constexpr bool PERM = false;
    const float *xp, *xs; float* out; float* parts; const bf16* X1B;
    __device__ __forceinline__ void operator()(const A4 (&acc)[2][2][4][2], const pg8::Unit& u, int wr, int wc, int fr, int fq) const {
        const int row0 = u.pm * 256 + wr * 64 + fr, c0 = 256 * u.pn + 32 * wc + 4 * fq;
        if (u.pm >= BP * SEQ / 256) {
            float* part = parts + (size_t)(u.k0 / u.nt) * RS * DM;
#pragma unroll
            for (int ai = 0; ai < 2; ++ai)
#pragma unroll
                for (int m = 0; m < 4; ++m) { float* orow = part + (size_t)(row0 + ai * 128 + m * 16 - BP * SEQ) * DM;
#pragma unroll
                    for (int bj = 0; bj < 2; ++bj)
#pragma unroll
                        for (int n = 0; n < 2; ++n) *(GAS f32x4*)(orow + c0 + 128 * bj + 16 * n) = acc[ai][bj][m][n]; }
            return; }
#pragma unroll
        for (int ai = 0; ai < 2; ++ai)
#pragma unroll
            for (int m = 0; m < 4; ++m) { const int r = row0 + ai * 128 + m * 16;
                float* orow = out + (size_t)r * DM;
                if (MODE == 0) { const float* base = r < BP * SEQ ? xp + (size_t)r * DM : xs + (size_t)(r - BP * SEQ) * DM;
#pragma unroll
                    for (int bj = 0; bj < 2; ++bj)
#pragma unroll
                        for (int n = 0; n < 2; ++n) { const int c = c0 + 128 * bj + 16 * n; const f32x4 b = *(const GAS f32x4*)(base + c); *(GAS f32x4*)(orow + c) = b + acc[ai][bj][m][n]; }
                } else {
                } }
        if (MODE == 1) {
#pragma unroll
            for (int ai = 0; ai < 2; ++ai) { v2u xb[4][2][2];
#pragma unroll
                for (int m = 0; m < 4; ++m)
#pragma unroll
                    for (int bj = 0; bj < 2; ++bj)
#pragma unroll
                        for (int n = 0; n < 2; ++n) xb[m][bj][n] = *(const GAS v2u*)(X1B + (size_t)(row0 + ai * 128 + m * 16) * DM + c0 + 128 * bj + 16 * n);
#pragma unroll
                for (int m = 0; m < 4; ++m)
#pragma unroll
                    for (int bj = 0; bj < 2; ++bj)
#pragma unroll
                        for (int n = 0; n < 2; ++n) { const v2u b = xb[m][bj][n]; const f32x4 x2 = (f32x4){bflo(b.x), bfhi(b.x), bflo(b.y), bfhi(b.y)} + acc[ai][bj][m][n];
                            v2u w; w.x = cvtpk(x2[0], x2[1]); w.y = cvtpk(x2[2], x2[3]);
                            *(GAS v2u*)((bf16*)X1B + (size_t)(row0 + ai * 128 + m * 16) * DM + c0 + 128 * bj + 16 * n) = w; } }
        }
    }
};
struct EpiWo {
    const float *xp; bf16* X1B; float* parts;
    __device__ __forceinline__ void operator()(const A4 (&acc)[2][2][4][2], const pg8::Unit& u, int wr, int wc, int fr, int fq) const {
        const int row0 = u.pm * 256 + wr * 64 + fr, c0 = 256 * u.pn + 32 * wc + 8 * fq;
        if (u.pm >= BP * SEQ / 256) {
            float* part = parts + (size_t)(u.k0 / u.nt) * RS * DM;
#pragma unroll
            for (int ai = 0; ai < 2; ++ai)
#pragma unroll
                for (int m = 0; m < 4; ++m) { float* orow = part + (size_t)(row0 + ai * 128 + m * 16 - BP * SEQ) * DM + c0;
#pragma unroll
                    for (int bj = 0; bj < 2; ++bj) { *(GAS f32x4*)(orow + 128 * bj) = acc[ai][bj][m][0]; *(GAS f32x4*)(orow + 128 * bj + 4) = acc[ai][bj][m][1]; } }
            return; }
#pragma unroll
        for (int ai = 0; ai < 2; ++ai) { f32x4 xv[4][2][2];
#pragma unroll
            for (int m = 0; m < 4; ++m)
#pragma unroll
                for (int bj = 0; bj < 2; ++bj) { const float* xrow = xp + (size_t)(row0 + ai * 128 + m * 16) * DM + c0 + 128 * bj; xv[m][bj][0] = *(const GAS f32x4*)xrow; xv[m][bj][1] = *(const GAS f32x4*)(xrow + 4); }
#pragma unroll
            for (int m = 0; m < 4; ++m)
#pragma unroll
                for (int bj = 0; bj < 2; ++bj) { const f32x4 x0 = xv[m][bj][0] + acc[ai][bj][m][0], x1 = xv[m][bj][1] + acc[ai][bj][m][1];
                    v4u w; w.x = cvtpk(x0[0], x0[1]); w.y = cvtpk(x0[2], x0[3]); w.z = cvtpk(x1[0], x1[1]); w.w = cvtpk(x1[2], x1[3]);
                    *(GAS v4u*)(X1B + (size_t)(row0 + ai * 128 + m * 16) * DM + c0 + 128 * bj) = w; } }
    }
};
struct EpiWoP : EpiWo { static constexpr bool PERM = true; };
struct EpiUp {
    static constexpr bool PERM = true;
    bf16* HM;
    __device__ __forceinline__ void operator()(const A4 (&acc)[2][2][4][2], const pg8::Unit& u, int wr, int wc, int fr, int fq) const {
        const int row0 = u.pm * 256 + wr * 64 + fr, c0 = 256 * u.pn + 32 * wc + 8 * fq;
#pragma unroll
        for (int ai = 0; ai < 2; ++ai)
#pragma unroll
            for (int m = 0; m < 4; ++m) { const int r = row0 + ai * 128 + m * 16;
#pragma unroll
                for (int bj = 0; bj < 2; ++bj) { float o[8];
#pragma unroll
                    for (int n = 0; n < 2; ++n)
#pragma unroll
                        for (int j = 0; j < 4; ++j) { const float v = fmaxf(acc[ai][bj][m][n][j], 0.f); o[4 * n + j] = v * v; }
                    v4u w; w.x = cvtpk(o[0], o[1]); w.y = cvtpk(o[2], o[3]); w.z = cvtpk(o[4], o[5]); w.w = cvtpk(o[6], o[7]);
                    *(GAS v4u*)(HM + (size_t)r * DFF + c0 + 128 * bj) = w; } }
    }
};

template <int KIND>
__device__ __forceinline__ void conv_unit(const Args& a, LAS unsigned char* lds, int b, int run) {
    asm volatile("" ::: "memory");
    const int tid = threadIdx.x, lane = tid & 63, wave = tid >> 6; int ch = 2 * tid; asm volatile("" : "+v"(ch));
    unsigned char* ws = a.ws;
    bf16* GC = (bf16*)(ws + WS_GLU); const bf16* HALOC = (const bf16*)(ws + WS_HALOC);
    const float* w_dw = a.in[8];
    constexpr int TK = KIND == 0 ? 8 : 4;
    LAS float* red = (LAS float*)lds;
    constexpr int NTOK = KIND == 0 ? RUNL : TS, NSTEP = (NTOK + TK - 1) / TK, REM = NTOK - TK * (NSTEP - 1);
    f32x2 w[KC]; unsigned E[KC - 1 + TK];
#pragma unroll
    for (int i = 0; i < KC; ++i) w[i] = *(const GAS f32x2*)(w_dw + (size_t)i * DM + ch);
    const f32x2 bdw = *(const GAS f32x2*)(a.in[9] + ch), lng = *(const GAS f32x2*)(a.in[10] + ch), lnb = *(const GAS f32x2*)(a.in[11] + ch);
    const int row0 = KIND == 0 ? b * TP + run * RUNL : RP + b * TS;
    if (KIND == 0) {
#pragma unroll
        for (int i = 0; i < KC - 1; ++i) { unsigned v = *(const GAS unsigned*)(HALOC + ((size_t)(b * NRUN + (run > 0 ? run - 1 : 0)) * 30 + i) * DM + ch); E[i] = run > 0 ? v : 0u; }
    } else { const float* st = a.in[2] + (size_t)b * (KC - 1) * DM;
#pragma unroll
        for (int i = 0; i < KC - 1; ++i) { const f32x2 v = *(const GAS f32x2*)(st + (size_t)i * DM + ch); E[i] = cvtpk(v.x, v.y); }
    }
    unsigned nx[TK];
#pragma unroll
    for (int k = 0; k < TK; ++k) nx[k] = *(const GAS unsigned*)(GC + (size_t)(row0 + (k < NTOK ? k : NTOK - 1)) * DM + ch);
    for (int st4 = 0; st4 < NSTEP; ++st4) {
        const int t0 = TK * st4;
#pragma unroll
        for (int k = 0; k < TK; ++k) E[KC - 1 + k] = nx[k];
        if (st4 + 1 < NSTEP) {
#pragma unroll
            for (int k = 0; k < TK; ++k) { const int t = t0 + TK + k; nx[k] = *(const GAS unsigned*)(GC + (size_t)(row0 + (t < NTOK ? t : NTOK - 1)) * DM + ch); }
        }
        f32x2 y[TK];
#pragma unroll
        for (int k = 0; k < TK; ++k) y[k] = bdw;
#pragma unroll
        for (int j = 0; j < KC - 1 + TK; ++j) { const f32x2 e = {bflo(E[j]), bfhi(E[j])};
#pragma unroll
            for (int k = 0; k < TK; ++k) { const int i = j - k; if (i >= 0 && i < KC) y[k] += w[i] * e; } }
        float sv[2 * TK];
#pragma unroll
        for (int k = 0; k < TK; ++k) { sv[2 * k] = wave_sum(y[k].x + y[k].y); sv[2 * k + 1] = wave_sum(y[k].x * y[k].x + y[k].y * y[k].y); }
        LAS float* rb = red + (st4 & 1) * (16 * TK);
        if (lane == 0) {
#pragma unroll
            for (int q = 0; q < TK / 2; ++q) *(LAS f32x4*)(rb + wave * 2 * TK + 4 * q) = (f32x4){sv[4 * q], sv[4 * q + 1], sv[4 * q + 2], sv[4 * q + 3]}; }
        __syncthreads();
        f32x4 tq[TK / 2];
#pragma unroll
        for (int q = 0; q < TK / 2; ++q) tq[q] = (f32x4){0.f, 0.f, 0.f, 0.f};
#pragma unroll
        for (int i = 0; i < 8; ++i)
#pragma unroll
            for (int q = 0; q < TK / 2; ++q) tq[q] += *(const LAS f32x4*)(rb + i * 2 * TK + 4 * q);
#pragma unroll
        for (int k = 0; k < TK; ++k) { if (t0 + k < NTOK) {
            const float s1 = tq[k >> 1][2 * (k & 1)], s2 = tq[k >> 1][2 * (k & 1) + 1];
            const float mu = s1 * (1.f / DM), var = fmaxf(s2 * (1.f / DM) - mu * mu, 0.f), rstd = rsqf(var + EPS);
            const float z0 = (y[k].x - mu) * rstd * lng.x + lnb.x, z1 = (y[k].y - mu) * rstd * lng.y + lnb.y;
            *(GAS unsigned*)(GC + (size_t)(row0 + t0 + k) * DM + ch) = cvtpk(siluf_(z0), siluf_(z1)); } }
        if (st4 + 1 < NSTEP) {
#pragma unroll
            for (int i = 0; i < KC - 1; ++i) E[i] = E[i + TK];
        }
    }
    if (KIND == 1 || run == NRUN - 1) { float* o = a.out + (KIND == 0 ? O_PC : O_SC) + (size_t)b * (KC - 1) * DM;
        if (KIND == 0) {
#pragma unroll
            for (int i = 0; i < KC - 1; ++i) *(GAS f32x2*)(o + (size_t)i * DM + ch) = (f32x2){bflo(E[REM + i]), bfhi(E[REM + i])};
        } else {
            const float* st = a.in[2] + (size_t)b * (KC - 1) * DM;
#pragma unroll
            for (int i = 0; i < KC - 1 - TS; ++i) *(GAS f32x2*)(o + (size_t)i * DM + ch) = *(const GAS f32x2*)(st + (size_t)(i + TS) * DM + ch);
#pragma unroll
            for (int i = KC - 1 - TS; i < KC - 1; ++i) *(GAS f32x2*)(o + (size_t)i * DM + ch) = (f32x2){bflo(E[REM + i]), bfhi(E[REM + i])};
        }
    }
    __syncthreads();
}

__device__ __forceinline__ void delta_item(const Args& a, LAS unsigned char* lds, int item) {
    asm volatile("" ::: "memory");
    const int tid = threadIdx.x, lane = tid & 63, sub = tid >> 7, wu = (tid >> 6) & 1; int j = tid & 127; asm volatile("" : "+v"(j));
    const int unit = item * 4 + sub, b = unit >> 3, h = unit & 7;
    const int row0 = RP + b * TS;
    const bf16* QS = (const bf16*)(a.ws + WS_QS); bf16* ZS = (bf16*)(a.ws + WS_ZS); const float* BETAG = (const float*)(a.ws + WS_BETAG);
    LAS float* kq = (LAS float*)lds + sub * 256;
    LAS float* red = (LAS float*)lds + 1024 + sub * 4;
    LAS float* red2 = (LAS float*)lds + 1024 + 16 + sub * 2;
    float S[DH];
    { const float* s0 = a.in[4] + ((size_t)(b * NH + h) * DH) * DH + j;
#pragma unroll
        for (int d = 0; d < DH; ++d) S[d] = s0[(size_t)d * DH]; }
    const int cq = h * DH + j, ck = DM + cq, cv = 2 * DM + cq;
    float wq[KS], wk[KS], wv[KS];
#pragma unroll
    for (int i = 0; i < KS; ++i) { wq[i] = a.in[13][i * DQKV + cq]; wk[i] = a.in[13][i * DQKV + ck]; wv[i] = a.in[13][i * DQKV + cv]; }
    float hq[3], hk[3], hv[3];
#pragma unroll
    for (int i = 0; i < 3; ++i) { const float* st = a.in[3] + ((size_t)b * 3 + i) * DQKV; hq[i] = st[cq]; hk[i] = st[ck]; hv[i] = st[cv]; }
    const float gh = a.in[16][j];
    float pq[TS], pk[TS], pv[TS], pbe[TS], pgg[TS], pzs[TS];
#pragma unroll
    for (int t = 0; t < TS; ++t) { const bf16* p = QS + (size_t)(b * TS + t) * DQKV; pq[t] = bf1(p[cq]); pk[t] = bf1(p[ck]); pv[t] = bf1(p[cv]);
        pbe[t] = BETAG[(size_t)(row0 + t) * 16 + h]; pgg[t] = BETAG[(size_t)(row0 + t) * 16 + 8 + h]; pzs[t] = bf1(ZS[(size_t)(row0 + t) * DM + cq]); }
#pragma unroll
    for (int t = 0; t < TS; ++t) {
        const size_t row = (size_t)(row0 + t);
        const float qp = pq[t], kp = pk[t], vp = pv[t];
        const float qc = siluf_(wq[0] * hq[0] + wq[1] * hq[1] + wq[2] * hq[2] + wq[3] * qp);
        const float kc = siluf_(wk[0] * hk[0] + wk[1] * hk[1] + wk[2] * hk[2] + wk[3] * kp);
        const float vc = siluf_(wv[0] * hv[0] + wv[1] * hv[1] + wv[2] * hv[2] + wv[3] * vp);
        hq[0] = hq[1]; hq[1] = hq[2]; hq[2] = qp; hk[0] = hk[1]; hk[1] = hk[2]; hk[2] = kp; hv[0] = hv[1]; hv[1] = hv[2]; hv[2] = vp;
        const float sq = wave_sum(qc * qc), sk = wave_sum(kc * kc);
        kq[j] = kc; kq[128 + j] = qc;
        if (lane == 0) { red[wu * 2] = sq; red[wu * 2 + 1] = sk; }
        const float beta = pbe[t], gg = pgg[t], zs = pzs[t];
        __syncthreads();
        const float nq = rsqf(red[0] + red[2] + 1e-6f) * 0.08838834764831845f, nk = rsqf(red[1] + red[3] + 1e-6f);
        const float alpha = __expf(gg);
        float ks0 = 0.f, ks1 = 0.f, ks2 = 0.f, ks3 = 0.f;
#pragma unroll
        for (int d = 0; d < DH; d += 4) { const f32x4 kk = *(const LAS f32x4*)(kq + d); ks0 += kk.x * S[d]; ks1 += kk.y * S[d + 1]; ks2 += kk.z * S[d + 2]; ks3 += kk.w * S[d + 3];
            if ((d & 31) == 28) asm volatile("" ::: "memory"); }
        const float kS = (ks0 + ks1) + (ks2 + ks3);
        const float u = beta * (vc - alpha * nk * kS), un = nk * u;
        float o0 = 0.f, o1 = 0.f, o2 = 0.f, o3 = 0.f;
#pragma unroll
        for (int d = 0; d < DH; d += 4) { const f32x4 kk = *(const LAS f32x4*)(kq + d); const f32x4 qq = *(const LAS f32x4*)(kq + 128 + d);
            S[d] = alpha * S[d] + kk.x * un; S[d + 1] = alpha * S[d + 1] + kk.y * un; S[d + 2] = alpha * S[d + 2] + kk.z * un; S[d + 3] = alpha * S[d + 3] + kk.w * un;
            o0 += qq.x * S[d]; o1 += qq.y * S[d + 1]; o2 += qq.z * S[d + 2]; o3 += qq.w * S[d + 3];
            if ((d & 15) == 12) asm volatile("" ::: "memory"); }
        const float o = ((o0 + o1) + (o2 + o3)) * nq;
        const float so = wave_sum(o * o);
        if (lane == 0) red2[wu] = so;
        __syncthreads();
        const float rms = rsqf((red2[0] + red2[1]) * (1.f / DH) + EPS);
        ZS[row * DM + cq] = (bf16)f2bf(o * rms * gh * zs);
    }
    { float* so = a.out + O_SD + ((size_t)(b * NH + h) * DH) * DH + j;
#pragma unroll
        for (int d = 0; d < DH; ++d) so[(size_t)d * DH] = S[d];
      float* qo = a.out + O_SQ + (size_t)b * 3 * DQKV;
#pragma unroll
        for (int i = 0; i < 3; ++i) { qo[i * DQKV + cq] = hq[i]; qo[i * DQKV + ck] = hk[i]; qo[i * DQKV + cv] = hv[i]; }
    }
    __syncthreads();
}

__host__ __device__ constexpr int perm_k(int x) { return (x & ~31) | (((x >> 2) & 3) << 3) | (((x >> 4) & 1) << 2) | (x & 3); }
typedef short bf16x8v __attribute__((ext_vector_type(8)));
__device__ __forceinline__ int ih_swz128(int row, int ch) { return (row >> 1) * 256 + (((8 * (row & 1) + ch) ^ ((row >> 1) & 7)) << 4); }
constexpr int IH_QH = 0, IH_KH = 17408, IH_VH = 34816, IH_GV = 52224, IH_TB = 54272, IH_TD = 63488, IH_BYTES = 68608;
__device__ __forceinline__ void intra_pair(const Args& a, LAS unsigned char* lds_all, int pair) {
    asm volatile("" ::: "memory");
    const int tid = threadIdx.x, half = tid >> 8; int tu = tid & 255; asm volatile("" : "+v"(tu));
    const int lane = tu & 63, wq = __builtin_amdgcn_readfirstlane(tu >> 6);
    const int uq = pair * 2 + half, h = uq & 7, bc = uq >> 3, b = bc / NCH, c = bc - b * NCH;
    const int nvalid = (c == NCH - 1) ? TP - 64 * (NCH - 1) : 64;
    LAS unsigned char* lds = lds_all + half * IH_BYTES;
    LAS bf16* QH = (LAS bf16*)(lds + IH_QH); LAS bf16* KH = (LAS bf16*)(lds + IH_KH); LAS bf16* VH = (LAS bf16*)(lds + IH_VH);
    LAS float* MF = (LAS float*)(lds + IH_KH); LAS bf16* ATL = (LAS bf16*)(lds + IH_VH); LAS float* GV = (LAS float*)(lds + IH_GV);
    unsigned char* ws = a.ws;
    bf16* blk = (bf16*)(ws + WS_QKVB) + (size_t)uq * QBLK; const bf16* HALOQ = (const bf16*)(ws + WS_HALOQ); const float* BETAG = (const float*)(ws + WS_BETAG);
    bf16* KDT = (bf16*)(ws + WS_KDT) + (size_t)uq * 8192; bf16* ATT = (bf16*)(ws + WS_ATTN) + (size_t)uq * 4096; float* LASTV = (float*)(ws + WS_LASTV);
    if (tu < 64) { const int i = tu; float g = 0.f, be = 0.f; { const float* p = BETAG + (size_t)(b * TP + 64 * c + (i < nvalid ? i : 0)) * 16; be = p[h]; g = p[8 + h]; } if (i >= nvalid) { g = 0.f; be = 0.f; }
        float G = g;
#pragma unroll
        for (int o = 1; o < 64; o <<= 1) { const float t = __shfl_up(G, o); if (lane >= o) G += t; }
        const float GL = __shfl(G, 63);
        GV[i] = G; GV[64 + i] = be; GV[128 + i] = expf(G); GV[192 + i] = expf(GL - G);
        if (i == 63) LASTV[uq] = expf(GL); }
    {   const int cp = tu & 15, rg = tu >> 4;
        const bool fullc = (c > 0) && (nvalid == 64);
        v4u raw[2][7];
#define IH_LOAD_ROWS(wh_, slot_) do { _Pragma("unroll") for (int k = 0; k < 7; ++k) { const int rr = 4 * rg - 3 + k; \
                const bf16* p = (rr >= 0) ? blk + (wh_) * 8192 + rr * 128 + 8 * cp : HALOQ + ((size_t)(b * NCH + (c > 0 ? c - 1 : 0)) * 3 + (3 + rr)) * DQKV + (wh_) * DM + h * DH + 8 * cp; \
                raw[slot_][k] = *(const GAS v4u*)p; } } while (0)
        IH_LOAD_ROWS(0, 0); IH_LOAD_ROWS(1, 1);
#pragma unroll
        for (int wh = 0; wh < 3; ++wh) {
            const int col = wh * DM + h * DH + 8 * cp;
            f32x4 wl[4], wh4[4];
#pragma unroll
            for (int i = 0; i < 4; ++i) { wl[i] = *(const GAS f32x4*)(a.in[13] + i * DQKV + col); wh4[i] = *(const GAS f32x4*)(a.in[13] + i * DQKV + col + 4); }
            float xr[7][8];
#pragma unroll
            for (int k = 0; k < 7; ++k) { const int rr = 4 * rg - 3 + k; const bool ok = fullc || ((rr >= 0) ? (rr < nvalid) : (c > 0)); const v4u v = raw[wh & 1][k];
                xr[k][0] = ok ? bflo(v.x) : 0.f; xr[k][1] = ok ? bfhi(v.x) : 0.f; xr[k][2] = ok ? bflo(v.y) : 0.f; xr[k][3] = ok ? bfhi(v.y) : 0.f;
                xr[k][4] = ok ? bflo(v.z) : 0.f; xr[k][5] = ok ? bfhi(v.z) : 0.f; xr[k][6] = ok ? bflo(v.w) : 0.f; xr[k][7] = ok ? bfhi(v.w) : 0.f; }
            if (wh == 0) IH_LOAD_ROWS(2, 0);
            if (c == NCH - 1 && rg == (nvalid - 1) / 4) {
                float* qo = a.out + O_PQ + (size_t)b * 3 * DQKV + col;
#pragma unroll
                for (int i = 0; i < 3; ++i) { *(GAS f32x4*)(qo + i * DQKV) = (f32x4){xr[4 + i][0], xr[4 + i][1], xr[4 + i][2], xr[4 + i][3]}; *(GAS f32x4*)(qo + i * DQKV + 4) = (f32x4){xr[4 + i][4], xr[4 + i][5], xr[4 + i][6], xr[4 + i][7]}; } }
            LAS bf16* tile = wh == 0 ? QH : (wh == 1 ? KH : VH);
#pragma unroll
            for (int r = 0; r < 4; ++r) { const bool ok = fullc || (4 * rg + r) < nvalid; float y[8];
#pragma unroll
                for (int e = 0; e < 8; ++e) { const float w0 = e < 4 ? wl[0][e & 3] : wh4[0][e & 3], w1 = e < 4 ? wl[1][e & 3] : wh4[1][e & 3], w2 = e < 4 ? wl[2][e & 3] : wh4[2][e & 3], w3 = e < 4 ? wl[3][e & 3] : wh4[3][e & 3];
                    const float t = w0 * xr[r][e] + w1 * xr[r + 1][e] + w2 * xr[r + 2][e] + w3 * xr[r + 3][e]; y[e] = ok ? siluf_(t) : 0.f; }
                v4u o; o.x = cvtpk(y[0], y[1]); o.y = cvtpk(y[2], y[3]); o.z = cvtpk(y[4], y[5]); o.w = cvtpk(y[6], y[7]);
                *(LAS v4u*)(tile + (4 * rg + r) * 136 + 8 * cp) = o; }
        }
    }
    __syncthreads();
    const int which = tu >> 7, d = tu & 127;
    float x[64];
    { const LAS bf16* colp = (which == 0 ? VH : KH) + d;
#pragma unroll
      for (int i = 0; i < 64; ++i) x[i] = bf1(colp[i * 136]); }
    const int fr = lane & 15, fq = lane >> 4;
    f32x4 kk[4], qk[4];
    {   bf16x8v ak[4], aq[4];
#pragma unroll
        for (int sI = 0; sI < 4; ++sI) { ak[sI] = *(const LAS bf16x8v*)(KH + (16 * wq + fr) * 136 + 32 * sI + 8 * fq); aq[sI] = *(const LAS bf16x8v*)(QH + (16 * wq + fr) * 136 + 32 * sI + 8 * fq); }
        f32x4 kkd = {0.f, 0.f, 0.f, 0.f}, qqd = {0.f, 0.f, 0.f, 0.f};
#pragma unroll
        for (int sI = 0; sI < 4; ++sI) { kkd = __builtin_amdgcn_mfma_f32_16x16x32_bf16(ak[sI], ak[sI], kkd, 0, 0, 0); qqd = __builtin_amdgcn_mfma_f32_16x16x32_bf16(aq[sI], aq[sI], qqd, 0, 0, 0); }
#pragma unroll
        for (int nt = 0; nt < 4; ++nt) { kk[nt] = (f32x4){0.f, 0.f, 0.f, 0.f}; qk[nt] = (f32x4){0.f, 0.f, 0.f, 0.f};
            if (nt <= wq) {
#pragma unroll
                for (int sI = 0; sI < 4; ++sI) { const bf16x8v bk = *(const LAS bf16x8v*)(KH + (16 * nt + fr) * 136 + 32 * sI + 8 * fq);
                    kk[nt] = __builtin_amdgcn_mfma_f32_16x16x32_bf16(ak[sI], bk, kk[nt], 0, 0, 0); qk[nt] = __builtin_amdgcn_mfma_f32_16x16x32_bf16(aq[sI], bk, qk[nt], 0, 0, 0); } } }
#pragma unroll
        for (int r = 0; r < 4; ++r) if (fr == 4 * fq + r) { GV[320 + 16 * wq + fr] = rsqf(kkd[r] + 1e-6f); GV[256 + 16 * wq + fr] = rsqf(qqd[r] + 1e-6f) * 0.08838834764831845f; }
    }
    __syncthreads();
    {
        const f32x4 Gi4 = *(const LAS f32x4*)(GV + 16 * wq + 4 * fq), Be4 = *(const LAS f32x4*)(GV + 64 + 16 * wq + 4 * fq), Nk4 = *(const LAS f32x4*)(GV + 320 + 16 * wq + 4 * fq), Nq4 = *(const LAS f32x4*)(GV + 256 + 16 * wq + 4 * fq);
        float Gjv[4], nkjv[4];
#pragma unroll
        for (int nt = 0; nt < 4; ++nt) { Gjv[nt] = GV[16 * nt + fr]; nkjv[nt] = GV[320 + 16 * nt + fr]; }
#pragma unroll
        for (int nt = 0; nt < 4; ++nt) { const int j = 16 * nt + fr;
            if (nt <= wq) { const float Gj = Gjv[nt], nkj = nkjv[nt];
#pragma unroll
                for (int r = 0; r < 4; ++r) { const int i = 16 * wq + 4 * fq + r; const float dec = (i >= j) ? __expf(Gi4[r] - Gj) : 0.f;
                    MF[i * 68 + j] = (i > j) ? Be4[r] * Nk4[r] * nkj * kk[nt][r] * dec : 0.f;
                    ATL[i * 72 + j] = (bf16)f2bf(Nq4[r] * nkj * qk[nt][r] * dec); }
            } else {
#pragma unroll
                for (int r = 0; r < 4; ++r) ATL[(16 * wq + 4 * fq + r) * 72 + j] = (bf16)0; }
        }
#pragma unroll
        for (int k = 0; k < 4; ++k) { const int pc = tu + 256 * k, i = pc >> 4, p16 = pc & 15, c0 = 32 * (p16 >> 2) + 4 * (p16 & 3);
            const v2u lo = *(const LAS v2u*)(QH + i * 136 + c0), hi = *(const LAS v2u*)(QH + i * 136 + c0 + 16); const float f = GV[256 + i] * GV[128 + i];
            v4u o; o.x = cvtpk(bflo(lo.x) * f, bfhi(lo.x) * f); o.y = cvtpk(bflo(lo.y) * f, bfhi(lo.y) * f); o.z = cvtpk(bflo(hi.x) * f, bfhi(hi.x) * f); o.w = cvtpk(bflo(hi.y) * f, bfhi(hi.y) * f);
            *(GAS v4u*)(blk + i * 128 + 8 * p16) = o; if (k & 1) asm volatile("" ::: "memory"); }
        if (which == 0) {
#pragma unroll
            for (int i = 0; i < 64; i += 4) { const f32x4 be = *(const LAS f32x4*)(GV + 64 + i); x[i] *= be.x; x[i + 1] *= be.y; x[i + 2] *= be.z; x[i + 3] *= be.w; }
        } else {
            bf16* kd = KDT + d * 64;
#pragma unroll
            for (int i = 0; i < 64; i += 4) { const f32x4 nk = *(const LAS f32x4*)(GV + 320 + i); x[i] *= nk.x; x[i + 1] *= nk.y; x[i + 2] *= nk.z; x[i + 3] *= nk.w; }
#pragma unroll
            for (int g8 = 0; g8 < 8; ++g8) { const int i0 = 32 * (g8 >> 2) + 4 * (g8 & 3);
                const f32x4 e0 = *(const LAS f32x4*)(GV + 192 + i0), e1 = *(const LAS f32x4*)(GV + 192 + i0 + 16);
                v4u w; w.x = cvtpk(x[i0] * e0.x, x[i0 + 1] * e0.y); w.y = cvtpk(x[i0 + 2] * e0.z, x[i0 + 3] * e0.w); w.z = cvtpk(x[i0 + 16] * e1.x, x[i0 + 17] * e1.y); w.w = cvtpk(x[i0 + 18] * e1.z, x[i0 + 19] * e1.w);
                *(GAS v4u*)(kd + 8 * g8) = w; if (g8 & 1) asm volatile("" ::: "memory"); }
#pragma unroll
            for (int i = 0; i < 64; i += 4) { const f32x4 be = *(const LAS f32x4*)(GV + 64 + i), eg = *(const LAS f32x4*)(GV + 128 + i);
                x[i] *= be.x * eg.x; x[i + 1] *= be.y * eg.y; x[i + 2] *= be.z * eg.z; x[i + 3] *= be.w * eg.w; }
        }
    }
    __syncthreads();
    LAS unsigned char* RT = lds + IH_QH; LAS bf16* TB = (LAS bf16*)(lds + IH_TB); LAS float* TD = (LAS float*)(lds + IH_TD);
    if (which == 0) {
#pragma unroll
        for (int c8 = 0; c8 < 8; ++c8) { v4u w; w.x = cvtpk(x[8 * c8], x[8 * c8 + 1]); w.y = cvtpk(x[8 * c8 + 2], x[8 * c8 + 3]); w.z = cvtpk(x[8 * c8 + 4], x[8 * c8 + 5]); w.w = cvtpk(x[8 * c8 + 6], x[8 * c8 + 7]);
            *(LAS v4u*)(RT + ih_swz128(d, c8)) = w; } }
    float tdg[16];
    {   const LAS float* mrow = MF + (16 * wq) * 68 + 16 * wq;
#pragma unroll
        for (int i = 0; i < 16; ++i) { float acc = (i == fr) ? 1.f : 0.f;
#pragma unroll
            for (int g = 0; g < (i + 3) / 4; ++g) { const f32x4 mm = *(const LAS f32x4*)(mrow + i * 68 + 4 * g);
                acc -= mm.x * tdg[4 * g]; if (4 * g + 1 < i) acc -= mm.y * tdg[4 * g + 1]; if (4 * g + 2 < i) acc -= mm.z * tdg[4 * g + 2]; if (4 * g + 3 < i) acc -= mm.w * tdg[4 * g + 3]; }
            tdg[i] = acc; }
        if (fq == 0) {
#pragma unroll
            for (int i = 0; i < 16; ++i) { TD[(wq * 16 + i) * 20 + fr] = tdg[i]; TB[(16 * wq + i) * 72 + 16 * wq + fr] = (bf16)f2bf(tdg[i]); } }
        for (int r = fq; r < 16 * wq; r += 4) TB[r * 72 + 16 * wq + fr] = (bf16)0;
    }
    __syncthreads();
    {   f32x4 Tc[4];
#pragma unroll
        for (int l = 0; l < 4; ++l) Tc[l] = (f32x4){0.f, 0.f, 0.f, 0.f};
#pragma unroll
        for (int r = 0; r < 4; ++r) { const float v = fq == 0 ? tdg[r] : (fq == 1 ? tdg[4 + r] : (fq == 2 ? tdg[8 + r] : tdg[12 + r]));
#pragma unroll
            for (int l = 0; l < 4; ++l) if (l == wq) Tc[l][r] = v; }
#pragma unroll
        for (int k = 1; k < 4; ++k) { if (k <= wq) continue;
            f32x4 acc = {0.f, 0.f, 0.f, 0.f};
#pragma unroll
            for (int l = 0; l < k; ++l) { if (l < wq) continue;
                const f32x4 a4 = *(const LAS f32x4*)(MF + (16 * k + fr) * 68 + 16 * l + 4 * fq);
#pragma unroll
                for (int ks = 0; ks < 4; ++ks) acc = __builtin_amdgcn_mfma_f32_16x16x4f32(a4[ks], Tc[l][ks], acc, 0, 0, 0); }
            const f32x4 d4 = *(const LAS f32x4*)(TD + (k * 16 + fr) * 20 + 4 * fq);
            f32x4 res = {0.f, 0.f, 0.f, 0.f};
#pragma unroll
            for (int ks = 0; ks < 4; ++ks) res = __builtin_amdgcn_mfma_f32_16x16x4f32(d4[ks], acc[ks], res, 0, 0, 0);
            Tc[k] = -res;
#pragma unroll
            for (int r = 0; r < 4; ++r) TB[(16 * k + 4 * fq + r) * 72 + 16 * wq + fr] = (bf16)f2bf(Tc[k][r]);
        }
    }
    __syncthreads();
    {
        f32x4 acc[4][2];
#pragma unroll
        for (int m = 0; m < 4; ++m) { acc[m][0] = (f32x4){0.f, 0.f, 0.f, 0.f}; acc[m][1] = (f32x4){0.f, 0.f, 0.f, 0.f}; }
#pragma unroll
        for (int s2 = 0; s2 < 2; ++s2) { bf16x8v af[4], bfm[2];
#pragma unroll
            for (int m = 0; m < 4; ++m) af[m] = *(const LAS bf16x8v*)(TB + (16 * m + fr) * 72 + 32 * s2 + 8 * fq);
#pragma unroll
            for (int t2 = 0; t2 < 2; ++t2) bfm[t2] = *(const LAS bf16x8v*)(RT + ih_swz128(16 * (2 * wq + t2) + fr, 4 * s2 + fq));
#pragma unroll
            for (int m = 0; m < 4; ++m)
#pragma unroll
                for (int t2 = 0; t2 < 2; ++t2) acc[m][t2] = __builtin_amdgcn_mfma_f32_16x16x32_bf16(af[m], bfm[t2], acc[m][t2], 0, 0, 0); }
#pragma unroll
        for (int m = 0; m < 4; ++m)
#pragma unroll
            for (int t2 = 0; t2 < 2; ++t2) { v2u w; w.x = cvtpk(acc[m][t2][0], acc[m][t2][1]); w.y = cvtpk(acc[m][t2][2], acc[m][t2][3]);
                *(GAS v2u*)(blk + 2 * 8192 + (2 * wq + t2) * 1024 + m * 256 + lane * 4) = w; }
    }
    __syncthreads();
    if (which == 1) {
#pragma unroll
        for (int c8 = 0; c8 < 8; ++c8) { v4u w; w.x = cvtpk(x[8 * c8], x[8 * c8 + 1]); w.y = cvtpk(x[8 * c8 + 2], x[8 * c8 + 3]); w.z = cvtpk(x[8 * c8 + 4], x[8 * c8 + 5]); w.w = cvtpk(x[8 * c8 + 6], x[8 * c8 + 7]);
            *(LAS v4u*)(RT + ih_swz128(d, c8)) = w; } }
    __syncthreads();
    {
        f32x4 acw[2][4];
#pragma unroll
        for (int nt = 0; nt < 4; ++nt) { acw[0][nt] = (f32x4){0.f, 0.f, 0.f, 0.f}; acw[1][nt] = (f32x4){0.f, 0.f, 0.f, 0.f}; }
#pragma unroll
        for (int s2 = 0; s2 < 2; ++s2) { bf16x8v af[2], bfm[4];
#pragma unroll
            for (int aa = 0; aa < 2; ++aa) af[aa] = *(const LAS bf16x8v*)(RT + ih_swz128(16 * (2 * wq + aa) + fr, 4 * s2 + fq));
#pragma unroll
            for (int nt = 0; nt < 4; ++nt) bfm[nt] = *(const LAS bf16x8v*)(TB + (16 * nt + fr) * 72 + 32 * s2 + 8 * fq);
#pragma unroll
            for (int aa = 0; aa < 2; ++aa)
#pragma unroll
                for (int nt = 0; nt < 4; ++nt) acw[aa][nt] = __builtin_amdgcn_mfma_f32_16x16x32_bf16(af[aa], bfm[nt], acw[aa][nt], 0, 0, 0); }
#pragma unroll
        for (int nt = 0; nt < 4; ++nt) { v4u w; w.x = cvtpk(acw[0][nt][0], acw[0][nt][1]); w.y = cvtpk(acw[0][nt][2], acw[0][nt][3]); w.z = cvtpk(acw[1][nt][0], acw[1][nt][1]); w.w = cvtpk(acw[1][nt][2], acw[1][nt][3]);
            *(GAS v4u*)(blk + 8192 + (16 * nt + fr) * 128 + 32 * wq + 8 * fq) = w; }
    }
#pragma unroll
    for (int k = 0; k < 2; ++k) { const int pc = tu + 256 * k, i = pc >> 3, p8 = pc & 7, c0 = 32 * (p8 >> 2) + 4 * (p8 & 3);
        const v2u lo = *(const LAS v2u*)(ATL + i * 72 + c0), hi = *(const LAS v2u*)(ATL + i * 72 + c0 + 16);
        *(GAS v4u*)(ATT + i * 64 + 8 * p8) = (v4u){lo.x, lo.y, hi.x, hi.y}; }
    __syncthreads();
}

constexpr int SC_W = 0, SC_QD = 16384, SC_KDT = 32768, SC_AT = 49152, SC_BUF = 57344, SC_RMS = 2 * SC_BUF, SC_ZT = SC_RMS + 4096, SC_END = SC_ZT + 2 * 16384;
__device__ __forceinline__ int swz256(int row, int chunk) { return row * 256 + ((chunk ^ (row & 15)) << 4); }
__device__ __forceinline__ int swz128(int row, int ch) { return (row >> 1) * 256 + (((8 * (row & 1) + ch) ^ ((row >> 1) & 7)) << 4); }
__device__ __forceinline__ void scan_chain(const Args& a, LAS unsigned char* lds, int chain) {
    const int tid = threadIdx.x, lane = tid & 63, wave = __builtin_amdgcn_readfirstlane(tid >> 6), fr = lane & 15, fq = lane >> 4;
    const int b = chain >> 3, h = chain & 7;
    unsigned char* ws = a.ws;
    const bf16* QKVB = (const bf16*)(ws + WS_QKVB); const bf16* KDTg = (const bf16*)(ws + WS_KDT); const bf16* ATTg = (const bf16*)(ws + WS_ATTN); const float* LASTV = (const float*)(ws + WS_LASTV);
    bf16* ZS = (bf16*)(ws + WS_ZS);
    LAS float* RMS = (LAS float*)(lds + SC_RMS);
    const float gh = a.in[16][16 * wave + fr];
    f32x4 Sacc[8];
#pragma unroll
    for (int mt = 0; mt < 8; ++mt) Sacc[mt] = (f32x4){0.f, 0.f, 0.f, 0.f};
    v4u ztn[2]; v2u u0n[4]; float lastn;
    auto chunk_dma = [&](int c) {
        const size_t uq = (size_t)(b * NCH + c) * NH + h; const bf16* blk = QKVB + uq * QBLK; LAS unsigned char* base = lds + (c & 1) * SC_BUF;
#pragma unroll
        for (int k = 0; k < 2; ++k) { const int P = (wave + 8 * k) * 64 + lane, row = P >> 4, ch = (P & 15) ^ (row & 15);
            __builtin_amdgcn_global_load_lds((const unsigned*)(blk + 8192 + row * 128 + 8 * ch), (LAS unsigned*)(base + SC_W + (wave + 8 * k) * 1024), 16, 0, 0);
            __builtin_amdgcn_global_load_lds((const unsigned*)(blk + row * 128 + 8 * ch), (LAS unsigned*)(base + SC_QD + (wave + 8 * k) * 1024), 16, 0, 0);
            const int line = P >> 4, t = (P & 15) ^ (line & 7), r2 = 2 * line + (t >> 3);
            __builtin_amdgcn_global_load_lds((const unsigned*)(KDTg + uq * 8192 + r2 * 64 + 8 * (t & 7)), (LAS unsigned*)(base + SC_KDT + (wave + 8 * k) * 1024), 16, 0, 0); }
        { const int P = wave * 64 + lane, line = P >> 4, t = (P & 15) ^ (line & 7), r2 = 2 * line + (t >> 3);
            __builtin_amdgcn_global_load_lds((const unsigned*)(ATTg + uq * 4096 + r2 * 64 + 8 * (t & 7)), (LAS unsigned*)(base + SC_AT + wave * 1024), 16, 0, 0); }
    };
    auto side_load = [&](int c) {
        const size_t uq = (size_t)(b * NCH + c) * NH + h;
#pragma unroll
        for (int k = 0; k < 2; ++k) { const int p = tid + 512 * k; ztn[k] = *(const GAS v4u*)(ZS + (size_t)(b * TP + 64 * c + (p >> 4)) * DM + h * DH + 8 * (p & 15)); }
        const bf16* u0 = QKVB + uq * QBLK + 2 * 8192 + wave * 1024 + lane * 4;
#pragma unroll
        for (int m = 0; m < 4; ++m) u0n[m] = *(const GAS v2u*)(u0 + m * 256);
        lastn = LASTV[uq];
    };
    auto side_store = [&](int buf) {
#pragma unroll
        for (int k = 0; k < 2; ++k) { const int p = tid + 512 * k; *(LAS v4u*)(lds + SC_ZT + buf * 16384 + swz256(p >> 4, p & 15)) = ztn[k]; }
    };
    chunk_dma(0); side_load(0); side_store(0);
    v2u u0p[4]; float last;
#pragma unroll
    for (int m = 0; m < 4; ++m) u0p[m] = u0n[m];
    last = lastn;
    chunk_dma(1); side_load(1);
    __syncthreads();
    for (int c = 0; c < NCH; ++c) {
        const int buf = c & 1; LAS unsigned char* base = lds + buf * SC_BUF; LAS unsigned char* zt = lds + SC_ZT + buf * 16384;
        const int nvalid = (c == NCH - 1) ? TP - 64 * (NCH - 1) : 64;
        bf16x8v F[2][8];
#define SC_LD_A(m, f) do { _Pragma("unroll") for (int sI = 0; sI < 4; ++sI) { const int off = swz256(16 * (m) + fr, 4 * sI + fq); \
            f[2 * sI] = *(const LAS bf16x8v*)(base + SC_W + off); f[2 * sI + 1] = *(const LAS bf16x8v*)(base + SC_QD + off); } } while (0)
#define SC_LD_D(f) do { _Pragma("unroll") for (int m = 0; m < 4; ++m) _Pragma("unroll") for (int s2 = 0; s2 < 2; ++s2) f[2 * m + s2] = *(const LAS bf16x8v*)(base + SC_AT + swz128(16 * m + fr, 4 * s2 + fq)); } while (0)
#define SC_LD_C(g, f) do { _Pragma("unroll") for (int mm = 0; mm < 4; ++mm) _Pragma("unroll") for (int s2 = 0; s2 < 2; ++s2) f[2 * mm + s2] = *(const LAS bf16x8v*)(base + SC_KDT + swz128(16 * (4 * (g) + mm) + fr, 4 * s2 + fq)); } while (0)
        SC_LD_A(0, F[0]);
        bf16x8v Sb[4];
#pragma unroll
        for (int sI = 0; sI < 4; ++sI) { v4u w; w.x = cvtpk(Sacc[2 * sI][0], Sacc[2 * sI][1]); w.y = cvtpk(Sacc[2 * sI][2], Sacc[2 * sI][3]); w.z = cvtpk(Sacc[2 * sI + 1][0], Sacc[2 * sI + 1][1]); w.w = cvtpk(Sacc[2 * sI + 1][2], Sacc[2 * sI + 1][3]);
            Sb[sI] = __builtin_bit_cast(bf16x8v, w); }
        f32x4 u[4], o[4];
#pragma unroll
        for (int m = 0; m < 4; ++m) {
            if (m == 0) SC_LD_A(1, F[1]); else if (m == 1) SC_LD_A(2, F[0]); else if (m == 2) SC_LD_A(3, F[1]); else SC_LD_D(F[0]);
            __builtin_amdgcn_sched_barrier(0);
            f32x4 p = {0.f, 0.f, 0.f, 0.f}, oo = {0.f, 0.f, 0.f, 0.f};
#pragma unroll
            for (int sI = 0; sI < 4; ++sI) { p = __builtin_amdgcn_mfma_f32_16x16x32_bf16(F[m & 1][2 * sI], Sb[sI], p, 0, 0, 0); oo = __builtin_amdgcn_mfma_f32_16x16x32_bf16(F[m & 1][2 * sI + 1], Sb[sI], oo, 0, 0, 0); }
            u[m] = (f32x4){bflo(u0p[m].x), bfhi(u0p[m].x), bflo(u0p[m].y), bfhi(u0p[m].y)} - p; o[m] = oo;
            __builtin_amdgcn_sched_barrier(0);
        }
        bf16x8v Ub[2];
#pragma unroll
        for (int s2 = 0; s2 < 2; ++s2) { v4u w; w.x = cvtpk(u[2 * s2][0], u[2 * s2][1]); w.y = cvtpk(u[2 * s2][2], u[2 * s2][3]); w.z = cvtpk(u[2 * s2 + 1][0], u[2 * s2 + 1][1]); w.w = cvtpk(u[2 * s2 + 1][2], u[2 * s2 + 1][3]);
            Ub[s2] = __builtin_bit_cast(bf16x8v, w); }
        SC_LD_C(0, F[1]);
        __builtin_amdgcn_sched_barrier(0);
#pragma unroll
        for (int m = 0; m < 4; ++m)
#pragma unroll
            for (int s2 = 0; s2 < 2; ++s2) o[m] = __builtin_amdgcn_mfma_f32_16x16x32_bf16(F[0][2 * m + s2], Ub[s2], o[m], 0, 0, 0);
        __builtin_amdgcn_sched_barrier(0);
        SC_LD_C(1, F[0]);
        __builtin_amdgcn_sched_barrier(0);
#pragma unroll
        for (int mt = 0; mt < 4; ++mt) { f32x4 sacc = Sacc[mt] * last;
#pragma unroll
            for (int s2 = 0; s2 < 2; ++s2) sacc = __builtin_amdgcn_mfma_f32_16x16x32_bf16(F[1][2 * mt + s2], Ub[s2], sacc, 0, 0, 0);
            Sacc[mt] = sacc; }
        __builtin_amdgcn_sched_barrier(0);
#pragma unroll
        for (int mt = 4; mt < 8; ++mt) { f32x4 sacc = Sacc[mt] * last;
#pragma unroll
            for (int s2 = 0; s2 < 2; ++s2) sacc = __builtin_amdgcn_mfma_f32_16x16x32_bf16(F[0][2 * (mt - 4) + s2], Ub[s2], sacc, 0, 0, 0);
            Sacc[mt] = sacc; }
#undef SC_LD_A
#undef SC_LD_D
#undef SC_LD_C
        LAS float* rm = RMS + (c & 1) * 512;
#pragma unroll
        for (int m = 0; m < 4; ++m)
#pragma unroll
            for (int r = 0; r < 4; ++r) { const float v = sum16(o[m][r] * o[m][r]); if (fr == 0) rm[(16 * m + 4 * fq + r) * 8 + wave] = v; }
        if (c + 1 < NCH) { side_store(buf ^ 1);
#pragma unroll
            for (int m = 0; m < 4; ++m) u0p[m] = u0n[m];
            last = lastn; }
        asm volatile("s_waitcnt vmcnt(0) lgkmcnt(0)" ::: "memory"); __builtin_amdgcn_s_barrier(); asm volatile("" ::: "memory");
        if (c + 2 < NCH) side_load(c + 2);
        {   LAS float* rsw = RMS + ((c + 1) & 1) * 512 + wave * 64;
            const f32x4 p0 = *(const LAS f32x4*)(rm + lane * 8), p1 = *(const LAS f32x4*)(rm + lane * 8 + 4);
            LAS bf16* zp[16]; bf16 zv[16];
#pragma unroll
            for (int m = 0; m < 4; ++m)
#pragma unroll
                for (int r = 0; r < 4; ++r) { zp[4 * m + r] = (LAS bf16*)(zt + swz256(16 * m + 4 * fq + r, 2 * wave + (fr >> 3))) + (fr & 7); zv[4 * m + r] = *zp[4 * m + r]; }
            rsw[lane] = rsqf((((p0.x + p0.y) + (p0.z + p0.w)) + ((p1.x + p1.y) + (p1.z + p1.w))) * (1.f / DH) + EPS);
            f32x4 rs[4];
#pragma unroll
            for (int m = 0; m < 4; ++m) rs[m] = *(const LAS f32x4*)(rsw + 16 * m + 4 * fq);
            __builtin_amdgcn_sched_barrier(0);
#pragma unroll
            for (int m = 0; m < 4; ++m)
#pragma unroll
                for (int r = 0; r < 4; ++r) *zp[4 * m + r] = (bf16)f2bf(o[m][r] * rs[m][r] * gh * bf1(zv[4 * m + r]));
        }
        asm volatile("s_waitcnt lgkmcnt(0)" ::: "memory"); __builtin_amdgcn_s_barrier(); asm volatile("" ::: "memory");
        if (c + 2 < NCH) chunk_dma(c + 2);
#pragma unroll
        for (int k = 0; k < 2; ++k) { const int p = tid + 512 * k, i = p >> 4;
            if (i < nvalid) *(GAS v4u*)(ZS + (size_t)(b * TP + 64 * c + i) * DM + h * DH + 8 * (p & 15)) = *(const LAS v4u*)(zt + swz256(i, p & 15)); }
    }
    { float* so = a.out + O_PD + ((size_t)(b * NH + h) * DH) * DH + 16 * wave + fr;
#pragma unroll
      for (int mt = 0; mt < 8; ++mt)
#pragma unroll
          for (int r = 0; r < 4; ++r) so[(size_t)(16 * mt + 4 * fq + r) * DH] = Sacc[mt][r]; }
    __syncthreads();
}

static_assert(SC_END <= LDSCTL_OFF && 2 * IH_BYTES <= LDSCTL_OFF && RING_BYTES <= LDSCTL_OFF, "LDS map");
constexpr int NPHASES = 10;
__global__ void __launch_bounds__(NWAVES * 64, 2) fwd_kernel(Args args) {
    extern __shared__ __attribute__((aligned(16))) unsigned char lds_raw[];
    LAS unsigned char* lds = (LAS unsigned char*)lds_raw;
    volatile LAS unsigned* MISC = (volatile LAS unsigned*)(lds + MISC_OFF);
    const int tid = threadIdx.x, lane = tid & 63, wave = __builtin_amdgcn_readfirstlane(tid >> 6);
    const int G = gridDim.x, bx = blockIdx.x;
    const int vcu = (G % 8 == 0) ? (bx % 8) * (G / 8) + bx / 8 : bx;
    unsigned char* ws = args.ws;
    gu32* ctl = (gu32*)(ws + WS_CTL);
    for (int u = tid; u < (LDS_BYTES - LDSCTL_OFF) / 4; u += NWAVES * 64) ((LAS unsigned*)(lds + LDSCTL_OFF))[u] = 0u;
    __syncthreads();
    XcdBarrier bar; bar.bar = (unsigned*)(ctl + CW_BAR); bar.x = 0; bar.st = nullptr;
    const int lo = args.ph_lo, hi = args.ph_hi;
    if (hi - lo > 1) bar = xcd_barrier_post((unsigned*)(ctl + CW_BAR), MISC + 8);
#ifndef PH_MASK
#define PH_MASK 0x3ff
#endif
#define IN(k) (((PH_MASK >> (k)) & 1) && lo <= (k) && (k) < hi)
#ifndef PROBE_K
#define PROBE_K -1
#endif
#if PROBE_K >= 0
    volatile LAS unsigned long long* stamps = (volatile LAS unsigned long long*)(lds + MISC_OFF + 128);
    if (tid == 0) stamps[0] = __builtin_amdgcn_s_memrealtime();
#define SEAM(k) do { if (IN(k) && IN((k) + 1)) xcd_barrier(bar); if (tid == 0) stamps[(k) + 1] = __builtin_amdgcn_s_memrealtime(); } while (0)
#else
#define SEAM(k) do { if (IN(k) && IN((k) + 1)) xcd_barrier(bar); } while (0)
#endif
    bf16* WIN = (bf16*)(ws + WS_WIN); bf16* WC = (bf16*)(ws + WS_WC); bf16* WD = (bf16*)(ws + WS_WD); bf16* WO = (bf16*)(ws + WS_WO); bf16* WUP = (bf16*)(ws + WS_WUP); bf16* WDN = (bf16*)(ws + WS_WDN);
    bf16* H = (bf16*)(ws + WS_H); bf16* GLU = (bf16*)(ws + WS_GLU); bf16* QKVB = (bf16*)(ws + WS_QKVB); bf16* QS = (bf16*)(ws + WS_QS); bf16* ZS = (bf16*)(ws + WS_ZS);
    bf16* HALOQ = (bf16*)(ws + WS_HALOQ); bf16* HALOC = (bf16*)(ws + WS_HALOC);
    bf16* SGC = (bf16*)args.out; bf16* SGD = (bf16*)args.out + (size_t)M2 * DM;
    bf16* X1B = (bf16*)(ws + WS_X1B);
    bf16* MIX = (bf16*)(ws + WS_MIX); bf16* XG = (bf16*)(ws + WS_XG); bf16* HM = (bf16*)(ws + WS_HM); bf16* C = (bf16*)(ws + WS_C);
    float* BETAG = (float*)(ws + WS_BETAG);
    const int gw = vcu * NWAVES + wave, NGW = G * NWAVES;

    constexpr int KB1 = DM / 32, KB4 = DFF / 32, I_SQ = KB1 * (DM / 64), I_UP = KB1 * (DFF / 64), I_DN = KB4 * (DM / 64);
    constexpr int NU1 = (MP / 256) * (NIN / 256), NU4 = (MP / 256) * (DM / 256), NU7 = (M2 / 256) * (DFF / 256);
#define CONVERT_ITEMS(lo_, hi_, w0_, nw_) do { for (int it_ = (lo_) + (w0_); it_ < (hi_); it_ += (nw_)) { int r = it_; \
        if (r < I_SQ) { p0_transpose_item(args.in[12], DM, DM, WC, (r / KB1) * 64, (r / KB1) * 64, 64, (r % KB1) * 32, lane); continue; } r -= I_SQ; \
        if (r < I_SQ) { p0_transpose_item(args.in[17], DM, DM, WD, (r / KB1) * 64, (r / KB1) * 64, 64, (r % KB1) * 32, lane); continue; } r -= I_SQ; \
        if (r < I_SQ) { p0_transpose_item(args.in[18], DM, DM, WO, (r / KB1) * 64, (r / KB1) * 64, 64, (r % KB1) * 32, lane); continue; } r -= I_SQ; \
        if (r < I_UP) { p0_transpose_item(args.in[20], DFF, DM, WUP, (r / KB1) * 64, (r / KB1) * 64, 64, (r % KB1) * 32, lane); continue; } r -= I_UP; \
        p0_transpose_item(args.in[21], DM, DFF, WDN, (r / KB4) * 64, (r / KB4) * 64, 64, (r % KB4) * 32, lane); } } while (0)
    if (IN(0)) {
        constexpr int I_IN = KB1 * (NIN / 64);
        for (int it = gw; it < I_IN; it += NGW) { const int nb = it / KB1, kb = it % KB1; int src, nv; win_src(nb, src, nv); p0_transpose_item(args.in[7], DIN, DM, WIN, nb * 64, src, nv, kb * 32, lane); }
        for (int m0 = gw; m0 < MP; m0 += 2 * NGW) {
            const float* src[2]; bool ok[2]; f32x4 v[2][4];
#pragma unroll
            for (int q = 0; q < 2; ++q) { const int m = m0 + q * NGW; ok[q] = m < MR; const int mm = ok[q] ? m : 0;
                if (mm >= RP) src[q] = args.in[1] + (size_t)(mm - RP) * DM;
                else { const int b = mm / TP, t = mm - b * TP; src[q] = t < NMETA ? args.in[5] + (size_t)t * DM : args.in[0] + ((size_t)b * SEQ + (t - NMETA)) * DM; }
#pragma unroll
                for (int j = 0; j < 4; ++j) v[q][j] = ((const GAS f32x4*)src[q])[lane + 64 * j]; }
#pragma unroll
            for (int q = 0; q < 2; ++q) { const int m = m0 + q * NGW; if (m >= MP) continue;
                float ss = 0.f;
#pragma unroll
                for (int j = 0; j < 4; ++j) ss += (v[q][j].x * v[q][j].x + v[q][j].y * v[q][j].y) + (v[q][j].z * v[q][j].z + v[q][j].w * v[q][j].w);
                const float rstd = ok[q] ? rsqf(wave_sum(ss) * (1.f / DM) + EPS) : 0.f;
                GAS v2u* o8 = (GAS v2u*)(H + (size_t)m * DM) + lane;
#pragma unroll
                for (int j = 0; j < 4; ++j) { const f32x4 g = ((const GAS f32x4*)args.in[6])[lane + 64 * j]; v2u o; o.x = cvtpk(v[q][j].x * rstd * g.x, v[q][j].y * rstd * g.y); o.y = cvtpk(v[q][j].z * rstd * g.z, v[q][j].w * rstd * g.w); o8[64 * j] = o; } }
        }
    }
    SEAM(0);
    if (IN(1)) {
        pg8::Gemm g{H, WIN, MP, NIN, DM}; pg8::StaticOrder S; S.init(MP, NIN, G, bx, DM);
        EpiIn E{GLU, QKVB, QS, HALOQ, HALOC, ZS, SGC, SGD, BETAG, args.in[14], args.in[15]};
        pg8::gemm_phase<EpiIn, pg8::StaticOrder, true, true>(lds + RING_OFF, g, S, E);
        if (G == 256) { if (bx >= NU1 % 256) CONVERT_ITEMS(0, 2 * I_SQ, (bx - NU1 % 256) * NWAVES + wave, (256 - NU1 % 256) * NWAVES); }
        else CONVERT_ITEMS(0, 3 * I_SQ + I_UP + I_DN, gw, NGW);
    }
    SEAM(1);
    if (IN(2)) {
        constexpr int N_CP = BP * NRUN, N_IP = BP * NCH * NH / 2, N_SD = BS * NH / 4, N_CS = BS, N_ITEMS = N_CP + N_IP + N_SD + N_CS;
        volatile LAS int* qslot = (volatile LAS int*)(lds + MISC_OFF + 64);
#if PROBE_K >= 0 && !defined(PROBE_NOSPLIT)
        for (int sub = 0; sub < 3; ++sub) {
            const int lo_i = sub == 0 ? 0 : (sub == 1 ? N_CP : N_CP + N_IP), hi_i = sub == 0 ? N_CP : (sub == 1 ? N_CP + N_IP : N_CP + N_IP + N_SD);
            for (;;) {
                if (tid == 0) *qslot = (int)__hip_atomic_fetch_add((unsigned*)(ctl + 2048 + 64 * sub), 1u, __ATOMIC_RELAXED, __HIP_MEMORY_SCOPE_AGENT);
                __syncthreads();
                int it = *qslot + lo_i;
                __syncthreads();
                if (sub == 0 && it >= N_CP) { it += N_IP + N_SD; if (it >= N_ITEMS) break; conv_unit<1>(args, lds, it - (N_CP + N_IP + N_SD), 0); continue; }
                if (it >= hi_i) break;
                if (it < N_CP) { conv_unit<0>(args, lds, it / NRUN, it % NRUN); continue; } it -= N_CP;
                if (it < N_IP) { intra_pair(args, lds, it); continue; } it -= N_IP;
                (void)it;
            }
            if (sub < 2) { xcd_barrier(bar); if (tid == 0) stamps[12 + sub] = __builtin_amdgcn_s_memrealtime(); }
        }
#else
        for (;;) {
            if (tid == 0) *qslot = (int)__hip_atomic_fetch_add((unsigned*)(ctl + 2048), 1u, __ATOMIC_RELAXED, __HIP_MEMORY_SCOPE_AGENT);
            __syncthreads();
            int it = *qslot;
            __syncthreads();
            if (it >= N_CP + N_IP) it += N_SD;
            if (it >= N_ITEMS) break;
            if (it < N_CP) { conv_unit<0>(args, lds, it / NRUN, it % NRUN); continue; } it -= N_CP;
            if (it < N_IP) { intra_pair(args, lds, it); continue; } it -= N_IP;
            it -= N_SD; if (it < 0) continue;
            conv_unit<1>(args, lds, it, 0);
        }
#endif
    }
    SEAM(2);
    if (IN(3)) {
        if (bx < BP * NH) { scan_chain(args, lds, bx);
#if PROBE_K >= 0
            if (tid == 0) stamps[14] = __builtin_amdgcn_s_memrealtime();
#endif
        }
#if defined(PROBE_SCAN_ALONE)
        xcd_barrier(bar);
        if (bx < BP * NH) {}
#endif
        else {
            pg8::Gemm g{C, WC, MP, DM, DM}; pg8::StaticOrder S; S.init(MP, DM, G - BP * NH, bx - BP * NH, DM);
            EpiGate<0> E{SGC, nullptr, SGC};
            pg8::gemm_phase<EpiGate<0>, pg8::StaticOrder, true, true>(lds + RING_OFF, g, S, E);
            volatile LAS int* qslot = (volatile LAS int*)(lds + MISC_OFF + 64);
            for (;;) {
                if (tid == 0) *qslot = (int)__hip_atomic_fetch_add((unsigned*)(ctl + 2048 + 256), 1u, __ATOMIC_RELAXED, __HIP_MEMORY_SCOPE_AGENT);
                __syncthreads();
                const int it = *qslot;
                __syncthreads();
                if (it >= BS * NH / 4) break;
                delta_item(args, lds, it);
            }
        }
    }
    SEAM(3);
    if (IN(4)) {
        pg8::Gemm g{ZS, WD, MP, DM, DM}; pg8::StaticOrder S; S.init(MP, DM, G, bx, DM);
        EpiGate<1> E{SGD, SGC, MIX};
        pg8::gemm_phase<EpiGate<1>, pg8::StaticOrder, true, true>(lds + RING_OFF, g, S, E);
        if (G == 256 && bx >= NU4 % 256) CONVERT_ITEMS(2 * I_SQ, 3 * I_SQ + I_UP, (bx - NU4 % 256) * NWAVES + wave, (256 - NU4 % 256) * NWAVES);
    }
    SEAM(4);
    if (IN(5)) {
        pg8::Gemm g{MIX, WO, M2, DM, DM}; pg8::SplitOrder S; S.init(BP * SEQ, M2, DM, G, bx, DM, KSPLIT5);
        EpiWoP E; E.xp = args.in[0]; E.X1B = X1B; E.parts = (float*)(ws + WS_PART5);
        pg8::gemm_phase<EpiWoP, pg8::SplitOrder, true, true>(lds + RING_OFF, g, S, E);
    }
    SEAM(5);
    if (IN(6)) {
        for (int i0 = gw; i0 < M2; i0 += 2 * NGW) {
            f32x4 v[2][4]; int mrow[2]; bool ok[2];
#pragma unroll
            for (int q = 0; q < 2; ++q) { const int i = i0 + q * NGW; ok[q] = i < M2; const int ii = ok[q] ? i : 0; const int m = ii < RS ? BP * SEQ + ii : ii - RS; mrow[q] = m;
                if (m >= BP * SEQ) { const GAS f32x4* x0 = (const GAS f32x4*)(args.in[1] + (size_t)(m - BP * SEQ) * DM) + lane;
#pragma unroll
                    for (int jj = 0; jj < 4; ++jj) v[q][jj] = x0[64 * jj];
                } else { const GAS v2u* xb = (const GAS v2u*)(X1B + (size_t)m * DM) + lane;
#pragma unroll
                    for (int jj = 0; jj < 4; ++jj) { const v2u o = xb[64 * jj]; v[q][jj] = (f32x4){bflo(o.x), bfhi(o.x), bflo(o.y), bfhi(o.y)}; } } }
#pragma unroll
            for (int q = 0; q < 2; ++q) { const int m = mrow[q]; if (!ok[q]) continue;
                if (m >= BP * SEQ) {
                    const GAS f32x4* pr = (const GAS f32x4*)((const float*)(ws + WS_PART5) + (size_t)(m - BP * SEQ) * DM) + lane; GAS v2u* xb = (GAS v2u*)(X1B + (size_t)m * DM) + lane;
#pragma unroll
                    for (int jj = 0; jj < 4; ++jj) {
#pragma unroll
                        for (int ks = 0; ks < KSPLIT5; ++ks) v[q][jj] += pr[(size_t)ks * RS * DM / 4 + 64 * jj];
                        v2u o; o.x = cvtpk(v[q][jj].x, v[q][jj].y); o.y = cvtpk(v[q][jj].z, v[q][jj].w); xb[64 * jj] = o;
                        v[q][jj] = (f32x4){bflo(o.x), bfhi(o.x), bflo(o.y), bfhi(o.y)}; } }
                float ss = 0.f;
#pragma unroll
                for (int jj = 0; jj < 4; ++jj) ss += (v[q][jj].x * v[q][jj].x + v[q][jj].y * v[q][jj].y) + (v[q][jj].z * v[q][jj].z + v[q][jj].w * v[q][jj].w);
                const float rstd = rsqf(wave_sum(ss) * (1.f / DM) + EPS);
                GAS v2u* o8 = (GAS v2u*)(XG + (size_t)m * DM) + lane; const GAS f32x4* gr = (const GAS f32x4*)args.in[19] + lane;
#pragma unroll
                for (int jj = 0; jj < 4; ++jj) { const f32x4 g = gr[64 * jj]; v2u o; o.x = cvtpk(v[q][jj].x * rstd * g.x, v[q][jj].y * rstd * g.y); o.y = cvtpk(v[q][jj].z * rstd * g.z, v[q][jj].w * rstd * g.w); o8[64 * jj] = o; } }
        }
    }
    SEAM(6);
    if (IN(7)) {
        pg8::Gemm g{XG, WUP, M2, DFF, DM}; pg8::StaticOrder S; S.init(M2, DFF, G, bx, DM);
        EpiUp E{HM};
        pg8::gemm_phase<EpiUp, pg8::StaticOrder, true, true>(lds + RING_OFF, g, S, E);
        if (G == 256 && bx >= NU7 % 256) CONVERT_ITEMS(3 * I_SQ + I_UP, 3 * I_SQ + I_UP + I_DN, (bx - NU7 % 256) * NWAVES + wave, (256 - NU7 % 256) * NWAVES);
    }
    SEAM(7);
    if (IN(8)) {
        pg8::Gemm g{HM, WDN, M2, DM, DFF}; pg8::SplitOrder S; S.init(BP * SEQ, M2, DM, G, bx, DFF, KSPLIT);
        EpiRes<1> E{nullptr, nullptr, args.out, (float*)(ws + WS_PART), X1B};
        pg8::gemm_phase<EpiRes<1>, pg8::SplitOrder, true, true>(lds + RING_OFF, g, S, E);
    }
    SEAM(8);
    if (IN(9)) {
        for (int i0 = gw; i0 < M2; i0 += 2 * NGW) {
            f32x4 v[2][4]; int mrow[2]; bool ok[2];
#pragma unroll
            for (int q = 0; q < 2; ++q) { const int i = i0 + q * NGW; ok[q] = i < M2; const int ii = ok[q] ? i : 0; const int m = ii < RS ? BP * SEQ + ii : ii - RS; mrow[q] = m;
                const GAS v2u* xb = (const GAS v2u*)(X1B + (size_t)m * DM) + lane;
#pragma unroll
                for (int jj = 0; jj < 4; ++jj) { const v2u o = xb[64 * jj]; v[q][jj] = (f32x4){bflo(o.x), bfhi(o.x), bflo(o.y), bfhi(o.y)}; } }
#pragma unroll
            for (int q = 0; q < 2; ++q) { const int m = mrow[q]; if (!ok[q]) continue;
                if (m >= BP * SEQ) { const GAS f32x4* pr = (const GAS f32x4*)((const float*)(ws + WS_PART) + (size_t)(m - BP * SEQ) * DM) + lane;
#pragma unroll 4
                    for (int ks = 0; ks < KSPLIT; ++ks)
#pragma unroll
                        for (int jj = 0; jj < 4; ++jj) v[q][jj] += pr[(size_t)ks * RS * DM / 4 + 64 * jj]; }
                float s2 = 0.f;
#pragma unroll
                for (int jj = 0; jj < 4; ++jj) s2 += (v[q][jj].x * v[q][jj].x + v[q][jj].y * v[q][jj].y) + (v[q][jj].z * v[q][jj].z + v[q][jj].w * v[q][jj].w);
                const float rstd = rsqf(wave_sum(s2) * (1.f / DM) + EPS);
                GAS f32x4* xr = (GAS f32x4*)(args.out + (size_t)m * DM) + lane; const GAS f32x4* gr = (const GAS f32x4*)args.in[22] + lane;
#pragma unroll
                for (int jj = 0; jj < 4; ++jj) xr[64 * jj] = v[q][jj] * rstd * gr[64 * jj]; }
        }
    }
#if PROBE_K >= 0
    __syncthreads();
    if (bx == 0) { if (tid == 0) stamps[NPHASES] = __builtin_amdgcn_s_memrealtime(); __syncthreads();
        const float dt_us = (float)(stamps[PROBE_B] - stamps[PROBE_K]) * 0.01f; const float f = 1.f + dt_us * (1.f / (float)(PROBE_DIV));
        for (int i = tid; i < BP * 3 * DQKV; i += NWAVES * 64) args.out[O_PQ + i] *= f; }
#endif
#undef IN
#undef SEAM
}

extern "C" void kernel_launch(void* const* d_in, const int* in_sizes, int n_in, void* d_out, int out_size, void* d_ws, size_t ws_size, hipStream_t stream) {
    static int grid = 0;
    if (grid == 0) {
        if (n_in != 23 || (size_t)out_size != O_END || ws_size < WS_END) { fprintf(stderr, "kernel_launch: unexpected shapes n_in %d out %d ws %zu\n", n_in, out_size, ws_size); grid = -1; return; }
        int dev = 0, cus = 0, per_cu = 0;
        if (hipGetDevice(&dev) != hipSuccess || hipDeviceGetAttribute(&cus, hipDeviceAttributeMultiprocessorCount, dev) != hipSuccess) { grid = -1; return; }
        if (hipFuncSetAttribute((const void*)fwd_kernel, hipFuncAttributeMaxDynamicSharedMemorySize, LDS_BYTES) != hipSuccess) { fprintf(stderr, "kernel_launch: hipFuncSetAttribute failed\n"); grid = -1; return; }
        if (hipOccupancyMaxActiveBlocksPerMultiprocessor(&per_cu, (const void*)fwd_kernel, NWAVES * 64, LDS_BYTES) != hipSuccess || per_cu < 1)
            fprintf(stderr, "kernel_launch: occupancy query reports %d\n", per_cu);
        (void)hipGetLastError();
        grid = cus;
    }
    if (grid < 0) return;
    if (hipMemsetAsync((char*)d_ws + WS_CTL, 0, CTL_ZERO_BYTES, stream) != hipSuccess) return;
    Args a{};
    for (int i = 0; i < 23; ++i) a.in[i] = (const float*)d_in[i];
    a.out = (float*)d_out; a.ws = (unsigned char*)d_ws;
#if MK_N_LAUNCHES == 1
    a.ph_lo = 0; a.ph_hi = NPHASES;
    hipLaunchKernelGGL(fwd_kernel, dim3(grid), dim3(NWAVES * 64), LDS_BYTES, stream, a);
#else
    for (int p = 0; p < NPHASES; ++p) { a.ph_lo = p; a.ph_hi = p + 1; hipLaunchKernelGGL(fwd_kernel, dim3(grid), dim3(NWAVES * 64), LDS_BYTES, stream, a); }
#endif
}
```
